# Optimizing an MI355X kernel written in HIP

```python
import math
import jax, jax.numpy as jnp
from jax import lax
import numpy as np

D_MODEL = 2048
BATCH = 4
SEQ = 2048
DEPTH = 2
DEC_BATCH = 128
DEC_SEQ = 1
PAST_LEN = 16384
PAGE_SIZE = 128

D_A = 512
S5_GROUP = 16
G_A = D_A // S5_GROUP
P_A = 64
D_B = 512
H_B = 8
GM_CHUNK = 128
D_C = 1024
HD_C = 64
H_C = D_C // HD_C
N_C = 128
G_C = 2
K_C = 4
SSD_CHUNK = 128
D_XBC = D_C + 2 * G_C * N_C
D_FF = 5632
K_F = 3
N_IN = D_A + 2 * D_B + D_C + D_XBC + H_C + 3 * D_MODEL
EPS = 1e-6

kernel_name = "hybrid_s5_gmlp_ssd_convffn_step"


def rmsnorm(x, g):
    xf = x.astype(jnp.float32)
    y = xf * lax.rsqrt(jnp.mean(xf * xf, axis=-1, keepdims=True) + EPS)
    return (y * g.astype(jnp.float32)).astype(x.dtype)


def causal_dwconv(x, buf, w, b):
    K = w.shape[0]
    L = x.shape[1]
    xp = jnp.concatenate([buf.astype(x.dtype), x], axis=1)
    y = b
    for k in range(K):
        y = y + w[k] * xp[:, k:k + L]
    return y, xp[:, L:]


def s5_combine(e1, e2):
    a1r, a1i, b1r, b1i = e1
    a2r, a2i, b2r, b2i = e2
    return (a2r * a1r - a2i * a1i, a2r * a1i + a2i * a1r,
            a2r * b1r - a2i * b1i + b2r, a2r * b1i + a2i * b1r + b2i)


def s5_branch(u, h0_re, h0_im, lam_re, lam_im, log_dt, b_re, b_im, c_re, c_im, d_skip, w_glu):
    Bsz, L, _ = u.shape
    uf = u.astype(jnp.float32)
    ug = uf.reshape(Bsz, L, G_A, S5_GROUP)
    dt = jnp.exp(log_dt.astype(jnp.float32))[:, None]
    lr = lam_re.astype(jnp.float32)
    li = lam_im.astype(jnp.float32)
    mag = jnp.exp(lr * dt)
    ar = mag * jnp.cos(li * dt)
    ai = mag * jnp.sin(li * dt)
    den = lr * lr + li * li
    nr = ar - 1.0
    kr = (nr * lr + ai * li) / den
    ki = (ai * lr - nr * li) / den
    bre = b_re.astype(jnp.float32)
    bim = b_im.astype(jnp.float32)
    bbr = kr[..., None] * bre - ki[..., None] * bim
    bbi = kr[..., None] * bim + ki[..., None] * bre
    bu_r = jnp.einsum('gph,blgh->blgp', bbr, ug)
    bu_i = jnp.einsum('gph,blgh->blgp', bbi, ug)
    h0r = h0_re.astype(jnp.float32)
    h0i = h0_im.astype(jnp.float32)
    bu_r = bu_r.at[:, 0].add(ar * h0r - ai * h0i)
    bu_i = bu_i.at[:, 0].add(ar * h0i + ai * h0r)
    a_r = jnp.broadcast_to(ar, bu_r.shape)
    a_i = jnp.broadcast_to(ai, bu_i.shape)
    _, _, hr, hi = lax.associative_scan(s5_combine, (a_r, a_i, bu_r, bu_i), axis=1)
    y = (jnp.einsum('ghp,blgp->blgh', c_re.astype(jnp.float32), hr)
         - jnp.einsum('ghp,blgp->blgh', c_im.astype(jnp.float32), hi))
    y = y.reshape(Bsz, L, D_A) + d_skip.astype(jnp.float32) * uf
    y = jax.nn.gelu(y)
    y = y * jax.nn.sigmoid(y @ w_glu.astype(jnp.float32))
    return y.astype(u.dtype), hr[:, -1], hi[:, -1]


def gmlp_branch(u, v, g_v, w_s, b_s):
    Bsz, L, _ = u.shape
    vn = rmsnorm(v, g_v)
    nc = -(-L // GM_CHUNK)
    pad = nc * GM_CHUNK - L
    vp = jnp.pad(vn, ((0, 0), (0, pad), (0, 0))).reshape(Bsz, nc, GM_CHUNK, H_B, D_B // H_B)
    mask = jnp.tril(jnp.ones((GM_CHUNK, GM_CHUNK), dtype=bool))
    ws = jnp.where(mask, w_s, 0.0)
    s = jnp.einsum('hij,bcjhd->bcihd', ws, vp) + b_s.T[:, :, None]
    s = s.reshape(Bsz, nc * GM_CHUNK, D_B)[:, :L]
    return u * s, vn


def ssd_scan(x, dt, a, bm, cm, h0):
    Bsz, L = x.shape[:2]
    Q = SSD_CHUNK if L % SSD_CHUNK == 0 else L
    nc = L // Q

    def chunk(t):
        return t.reshape((Bsz, nc, Q) + t.shape[2:])

    xc, dtc, bc, cc = chunk(x), chunk(dt), chunk(bm), chunk(cm)
    da_cs = jnp.cumsum(dtc * a, axis=2)
    xdt = xc * dtc[..., None]
    seg = da_cs[:, :, :, None, :] - da_cs[:, :, None, :, :]
    causal = jnp.tril(jnp.ones((Q, Q), dtype=bool))[:, :, None]
    decay = jnp.exp(jnp.where(causal, seg, -jnp.inf))
    scores = jnp.einsum('bcihn,bcjhn->bcijh', cc, bc) * decay
    y_diag = jnp.einsum('bcijh,bcjhp->bcihp', scores, xdt)
    dec_end = jnp.exp(da_cs[:, :, -1:, :] - da_cs)
    states = jnp.einsum('bcjhn,bcjh,bcjhp->bchpn', bc, dec_end, xdt)
    chunk_decay = jnp.exp(da_cs[:, :, -1, :])

    def step(h, inp):
        s_c, d_c = inp
        return h * d_c[..., None, None] + s_c, h

    h_last, h_prev = lax.scan(step, h0, (jnp.moveaxis(states, 1, 0), jnp.moveaxis(chunk_decay, 1, 0)))
    h_prev = jnp.moveaxis(h_prev, 0, 1)
    y_off = jnp.einsum('bcihn,bchpn,bcih->bcihp', cc, h_prev, jnp.exp(da_cs))
    y = (y_diag + y_off).reshape(Bsz, L, x.shape[2], x.shape[3])
    return y, h_last


def ssd_branch(z, xbc, dt_raw, conv_buf, h0, conv_w, conv_b, dt_bias, a_log, d_skip, g_norm):
    xbc, new_buf = causal_dwconv(xbc, conv_buf, conv_w, conv_b)
    xbc = jax.nn.silu(xbc)
    Bsz, L, _ = xbc.shape
    xs = xbc[..., :D_C].reshape(Bsz, L, H_C, HD_C).astype(jnp.float32)
    bm = xbc[..., D_C:D_C + G_C * N_C].reshape(Bsz, L, G_C, N_C)
    cm = xbc[..., D_C + G_C * N_C:].reshape(Bsz, L, G_C, N_C)
    bm = jnp.repeat(bm, H_C // G_C, axis=2).astype(jnp.float32)
    cm = jnp.repeat(cm, H_C // G_C, axis=2).astype(jnp.float32)
    dt = jax.nn.softplus(dt_raw.astype(jnp.float32) + dt_bias.astype(jnp.float32))
    a = -jnp.exp(a_log.astype(jnp.float32))
    y, h_last = ssd_scan(xs, dt, a, bm, cm, h0.astype(jnp.float32))
    y = y + d_skip.astype(jnp.float32)[:, None] * xs
    y = y.reshape(Bsz, L, D_C)
    y = rmsnorm(y * jax.nn.silu(z.astype(jnp.float32)), g_norm)
    return y.astype(z.dtype), h_last, new_buf


def conv_ffn(h, buf, w_up, conv_w, conv_b, w_down):
    up = h @ w_up
    up, new_buf = causal_dwconv(up, buf, conv_w, conv_b)
    a, b = jnp.split(up, 2, axis=-1)
    return (jax.nn.silu(a) * b) @ w_down, new_buf


def layer(x, c, s5_re, s5_im, ssm, conv_c, conv_f, p):
    mod = jax.nn.silu(c) @ p['w_mod'] + p['b_mod']
    sh_m, sc_m, gt_m, sh_f, sc_f, gt_f = [m[:, None, :] for m in jnp.split(mod, 6, axis=-1)]
    h = rmsnorm(x, p['g_mix']) * (1.0 + sc_m) + sh_m
    proj = h @ p['w_in']
    i1 = D_A
    i2 = i1 + D_B
    i3 = i2 + D_B
    i4 = i3 + D_C
    i5 = i4 + D_XBC
    i6 = i5 + H_C
    u_a, u_b, v_b, z_c, xbc_c, dt_c, gates = jnp.split(proj, [i1, i2, i3, i4, i5, i6], axis=-1)
    o_a, s5r_new, s5i_new = s5_branch(u_a, s5_re, s5_im, p['lam_re'], p['lam_im'], p['log_dt'],
                                      p['b_re'], p['b_im'], p['c_re'], p['c_im'], p['s5_d'], p['w_glu'])
    o_b, v_rows = gmlp_branch(jax.nn.gelu(u_b), jax.nn.gelu(v_b), p['g_v'], p['w_s'], p['b_s'])
    o_c, ssm_new, convc_new = ssd_branch(z_c, xbc_c, dt_c, conv_c, ssm, p['ssd_conv_w'], p['ssd_conv_b'],
                                         p['dt_bias'], p['a_log'], p['ssd_d'], p['ssd_g'])
    g_a, g_b, g_c = jnp.split(jax.nn.sigmoid(gates), 3, axis=-1)
    merged = g_a * (o_a @ p['w_pa']) + g_b * (o_b @ p['w_pb']) + g_c * (o_c @ p['w_pc'])
    x = x + gt_m * (merged @ p['w_out'])
    h2 = rmsnorm(x, p['g_ffn']) * (1.0 + sc_f) + sh_f
    f, convf_new = conv_ffn(h2, conv_f, p['w_up'], p['ffn_conv_w'], p['ffn_conv_b'], p['w_down'])
    x = x + gt_f * f
    return x, s5r_new, s5i_new, ssm_new, convc_new, convf_new, v_rows


def setup_inputs(seed: int = 0) -> dict:
    key = jax.random.key(seed)
    ks = iter(jax.random.split(key, 64))

    def nrm(shape, scale):
        return scale * jax.random.normal(next(ks), shape, jnp.float32)

    def unif(shape, lo, hi):
        return jax.random.uniform(next(ks), shape, jnp.float32, lo, hi)

    L = DEPTH
    dt0 = jnp.exp(unif((L, H_C), math.log(1e-3), math.log(1e-1)))
    lam_im0 = jnp.broadcast_to(math.pi * jnp.arange(P_A, dtype=jnp.float32), (L, G_A, P_A))
    return {
        'x_prompt': nrm((BATCH, SEQ, D_MODEL), 1.0),
        'x_sample': nrm((DEC_BATCH, DEC_SEQ, D_MODEL), 1.0),
        'c_prompt': nrm((BATCH, D_MODEL), 1.0),
        'c_sample': nrm((DEC_BATCH, D_MODEL), 1.0),
        'state_s5_re': nrm((L, DEC_BATCH, G_A, P_A), 0.3),
        'state_s5_im': nrm((L, DEC_BATCH, G_A, P_A), 0.3),
        'state_ssm': nrm((L, DEC_BATCH, H_C, HD_C, N_C), 0.1),
        'state_ssd_conv': nrm((L, DEC_BATCH, K_C - 1, D_XBC), 1.0),
        'state_ffn_conv': nrm((L, DEC_BATCH, K_F - 1, 2 * D_FF), 1.0),
        'w_mod': nrm((L, D_MODEL, 6 * D_MODEL), 0.3 * D_MODEL ** -0.5),
        'b_mod': nrm((L, 6 * D_MODEL), 0.02),
        'g_mix': 1.0 + nrm((L, D_MODEL), 0.02),
        'w_in': nrm((L, D_MODEL, N_IN), D_MODEL ** -0.5),
        's5_lam_re': -0.5 + nrm((L, G_A, P_A), 0.01),
        's5_lam_im': lam_im0 + nrm((L, G_A, P_A), 0.01),
        's5_log_dt': unif((L, G_A), math.log(1e-3), math.log(1e-1)),
        's5_b_re': nrm((L, G_A, P_A, S5_GROUP), (2 * S5_GROUP) ** -0.5),
        's5_b_im': nrm((L, G_A, P_A, S5_GROUP), (2 * S5_GROUP) ** -0.5),
        's5_c_re': nrm((L, G_A, S5_GROUP, P_A), P_A ** -0.5),
        's5_c_im': nrm((L, G_A, S5_GROUP, P_A), P_A ** -0.5),
        's5_d': nrm((L, D_A), 1.0),
        's5_w_glu': nrm((L, D_A, D_A), D_A ** -0.5),
        'gm_g_v': 1.0 + nrm((L, D_B), 0.02),
        'gm_w_s': nrm((L, H_B, GM_CHUNK, GM_CHUNK), 0.5 * GM_CHUNK ** -0.5),
        'gm_b_s': 1.0 + nrm((L, H_B, GM_CHUNK), 0.02),
        'ssd_conv_w': nrm((L, K_C, D_XBC), K_C ** -0.5),
        'ssd_conv_b': nrm((L, D_XBC), 0.02),
        'ssd_dt_bias': dt0 + jnp.log(-jnp.expm1(-dt0)),
        'ssd_a_log': jnp.log(unif((L, H_C), 1.0, 16.0)),
        'ssd_d': 1.0 + nrm((L, H_C), 0.1),
        'ssd_g_norm': 1.0 + nrm((L, D_C), 0.02),
        'w_pa': nrm((L, D_A, D_MODEL), D_A ** -0.5),
        'w_pb': nrm((L, D_B, D_MODEL), D_B ** -0.5),
        'w_pc': nrm((L, D_C, D_MODEL), D_C ** -0.5),
        'w_out': nrm((L, D_MODEL, D_MODEL), D_MODEL ** -0.5),
        'g_ffn': 1.0 + nrm((L, D_MODEL), 0.02),
        'ffn_w_up': nrm((L, D_MODEL, 2 * D_FF), D_MODEL ** -0.5),
        'ffn_conv_w': nrm((L, K_F, 2 * D_FF), K_F ** -0.5),
        'ffn_conv_b': nrm((L, 2 * D_FF), 0.02),
        'ffn_w_down': nrm((L, D_FF, D_MODEL), D_FF ** -0.5),
        'g_final': 1.0 + nrm((D_MODEL,), 0.02),
    }


def reference(x_prompt, x_sample, c_prompt, c_sample, state_s5_re, state_s5_im, state_ssm,
              state_ssd_conv, state_ffn_conv, w_mod, b_mod, g_mix, w_in, s5_lam_re, s5_lam_im,
              s5_log_dt, s5_b_re, s5_b_im, s5_c_re, s5_c_im, s5_d, s5_w_glu, gm_g_v, gm_w_s, gm_b_s,
              ssd_conv_w, ssd_conv_b, ssd_dt_bias, ssd_a_log, ssd_d, ssd_g_norm, w_pa, w_pb, w_pc,
              w_out, g_ffn, ffn_w_up, ffn_conv_w, ffn_conv_b, ffn_w_down, g_final):
    bp = x_prompt.shape[0]
    dtp = x_prompt.dtype
    xp, xs = x_prompt, x_sample
    s5r_p, s5i_p, ssm_p, cc_p, cf_p = [], [], [], [], []
    s5r_s, s5i_s, ssm_s, cc_s, cf_s, gv_s = [], [], [], [], [], []
    for l in range(DEPTH):
        p = {
            'w_mod': w_mod[l], 'b_mod': b_mod[l], 'g_mix': g_mix[l], 'w_in': w_in[l],
            'lam_re': s5_lam_re[l], 'lam_im': s5_lam_im[l], 'log_dt': s5_log_dt[l],
            'b_re': s5_b_re[l], 'b_im': s5_b_im[l], 'c_re': s5_c_re[l], 'c_im': s5_c_im[l],
            's5_d': s5_d[l], 'w_glu': s5_w_glu[l],
            'g_v': gm_g_v[l], 'w_s': gm_w_s[l], 'b_s': gm_b_s[l],
            'ssd_conv_w': ssd_conv_w[l], 'ssd_conv_b': ssd_conv_b[l], 'dt_bias': ssd_dt_bias[l],
            'a_log': ssd_a_log[l], 'ssd_d': ssd_d[l], 'ssd_g': ssd_g_norm[l],
            'w_pa': w_pa[l], 'w_pb': w_pb[l], 'w_pc': w_pc[l], 'w_out': w_out[l],
            'g_ffn': g_ffn[l], 'w_up': ffn_w_up[l], 'ffn_conv_w': ffn_conv_w[l],
            'ffn_conv_b': ffn_conv_b[l], 'w_down': ffn_w_down[l],
        }
        xp, a1, a2, a3, a4, a5, _ = layer(
            xp, c_prompt,
            jnp.zeros((bp, G_A, P_A), dtp), jnp.zeros((bp, G_A, P_A), dtp),
            jnp.zeros((bp, H_C, HD_C, N_C), dtp), jnp.zeros((bp, K_C - 1, D_XBC), dtp),
            jnp.zeros((bp, K_F - 1, 2 * D_FF), dtp), p)
        s5r_p.append(a1); s5i_p.append(a2); ssm_p.append(a3); cc_p.append(a4); cf_p.append(a5)
        xs, b1, b2, b3, b4, b5, b6 = layer(
            xs, c_sample, state_s5_re[l], state_s5_im[l], state_ssm[l],
            state_ssd_conv[l], state_ffn_conv[l], p)
        s5r_s.append(b1); s5i_s.append(b2); ssm_s.append(b3); cc_s.append(b4); cf_s.append(b5); gv_s.append(b6)
    y_prompt = rmsnorm(xp, g_final)
    y_sample = rmsnorm(xs, g_final)
    return (y_prompt, y_sample,
            jnp.stack(s5r_p), jnp.stack(s5i_p), jnp.stack(ssm_p), jnp.stack(cc_p), jnp.stack(cf_p),
            jnp.stack(s5r_s), jnp.stack(s5i_s), jnp.stack(ssm_s), jnp.stack(cc_s), jnp.stack(cf_s),
            jnp.stack(gv_s))
```

```cpp
#include <hip/hip_runtime.h>
#include <cstdio>
#include <cstdint>
namespace pg8 {
#define PG8_LAS __attribute__((address_space(3)))
typedef unsigned short bf16_t;
typedef short bf16x8 __attribute__((ext_vector_type(8)));
typedef float f32x4 __attribute__((ext_vector_type(4)));
typedef unsigned u32x4 __attribute__((ext_vector_type(4)));
constexpr int BM = 256, BK = 64, HALF = 128, HTB = HALF * BK * 2  , STAGE_BYTES = 8 * HTB, NXCD = 8, WGM = 8;

__host__ __device__ __forceinline__ int lds_byte(int r, int c) { const int st = (r >> 4) * 2 + (c >> 5), rr = r & 15, cc = c & 31, ob = rr * 64 + cc * 2; return st * 1024 + (ob ^ (((ob >> 9) & 1) << 5)); }
__host__ __device__ __forceinline__ void stage_rc(int b, int& R, int& C) { const int st = b / 1024, sb = b % 1024, swz = sb ^ (((sb >> 9) & 1) << 5); R = (st >> 1) * 16 + swz / 64; C = (st & 1) * 32 + (swz % 64) / 2; }
__host__ __device__ __forceinline__ int perm32(int rho) { const int n = rho >> 4, i = rho & 15; return 8 * (i >> 2) + 4 * n + (i & 3); }

struct Unit { int pm, pn, k0, nt, cidx, sid; };
struct Gemm { const bf16_t* A; const bf16_t* Bt; int M, N, K; };

struct StaticOrder {
    int nM, nN, nwg, G, c, ntk;
    __host__ __device__ void init(int M, int N, int G_, int c_, int K_) { nM = M / BM; nN = N / BM; nwg = nM * nN; G = G_; c = c_; ntk = K_ / BK; }
    __host__ __device__ bool next(int i, Unit& u) const {
        const long L = (long)i * G + c; if (L >= nwg) return false;
        int wgid = (int)L; { const int q = nwg / NXCD, r = nwg % NXCD, xcd = wgid % NXCD, off = wgid / NXCD; wgid = (xcd < r ? xcd * (q + 1) : r * (q + 1) + (xcd - r) * q) + off; }
        const int nig = WGM * nN, gid = wgid / nig, fm = gid * WGM, gsz = (nM - fm) < WGM ? (nM - fm) : WGM;
        u.pm = fm + ((wgid % nig) % gsz); u.pn = (wgid % nig) / gsz; u.k0 = 0; u.nt = ntk; u.cidx = -1; u.sid = 0; return true;
    }
    __device__ __forceinline__ void a_ready(const Unit&) const {}
    __device__ __forceinline__ void done(const Unit&) const {}
};
__device__ __forceinline__ unsigned cvt_pk_bf16(float lo, float hi) { unsigned r; asm volatile("s_nop 0\n\tv_cvt_pk_bf16_f32 %0, %1, %2" : "=v"(r) : "v"(lo), "v"(hi)); return r; }
template <class Epi, class Sched, bool ALIGN_EPI = false, bool SP2 = false, bool CHAIN_IN = false>
__device__ __forceinline__ void gemm_phase(PG8_LAS unsigned char* lds, const Gemm g, const Sched& S, const Epi& E, f32x4 (&acc)[2][2][4][2]) {
    int tid_ = threadIdx.x; asm volatile("" : "+v"(tid_));
    const int tid = tid_, wid = __builtin_amdgcn_readfirstlane(tid >> 6), lane = tid & 63, wr = wid >> 2, wc = wid & 3, fr = lane & 15, fq = lane >> 4;
    const int K = g.K;
    unsigned voffA[2], voffB[2];
#pragma unroll
    for (int i = 0; i < 2; ++i) { int R, C; stage_rc(tid * 16 + i * 8192, R, C); const int Rb = Epi::PERM ? ((R & ~31) + perm32(R & 31)) : R;
        voffA[i] = (unsigned)(R * K + C) * 2u; voffB[i] = (unsigned)(Rb * K + C) * 2u; }
    const size_t kstep = (size_t)(BK * 2);
    const size_t hstep = (size_t)HALF * K * 2;
    const size_t tstep = 2 * hstep;
    const unsigned ldsw = (unsigned)wid * 1024u;
    const int aoff = lds_byte(wr * 64 + fr, fq * 8), boff = lds_byte(wc * 32 + fr, fq * 8);
#define PG8_SA(b, h) (((b) * 2 + (h)) * HTB)
#define PG8_SB(b, h) ((4 + (b) * 2 + (h)) * HTB)
#define PG8_STAGE(bufoff, gbase, voff) do { _Pragma("unroll") for (int _i = 0; _i < 2; ++_i) \
        __builtin_amdgcn_global_load_lds((const unsigned*)((const char*)(gbase) + (voff)[_i]), (PG8_LAS unsigned*)(lds + (bufoff) + ldsw + _i * 8192), 16, 0, 0); } while (0)
#define PG8_LDA(dst, b, h) do { _Pragma("unroll") for (int m = 0; m < 4; ++m) _Pragma("unroll") for (int k = 0; k < 2; ++k) dst[m][k] = *(const PG8_LAS bf16x8*)(lds + PG8_SA(b, h) + aoff + m * 2048 + k * 1024); } while (0)
#define PG8_LDB(dst, b, h) do { _Pragma("unroll") for (int n = 0; n < 2; ++n) _Pragma("unroll") for (int k = 0; k < 2; ++k) dst[n][k] = *(const PG8_LAS bf16x8*)(lds + PG8_SB(b, h) + boff + n * 2048 + k * 1024); } while (0)
#define PG8_MMA(ai, bj, At, Bt) do { __builtin_amdgcn_s_setprio(1); _Pragma("unroll") for (int m = 0; m < 4; ++m) _Pragma("unroll") for (int n = 0; n < 2; ++n) _Pragma("unroll") for (int k = 0; k < 2; ++k) \
        acc[ai][bj][m][n] = __builtin_amdgcn_mfma_f32_16x16x32_bf16(Bt[n][k], At[m][k], acc[ai][bj][m][n], 0, 0, 0); __builtin_amdgcn_s_setprio(0); } while (0)
#define PG8_WAIT_V(n) asm volatile("s_waitcnt vmcnt(" #n ")" ::: "memory")
#define PG8_WAIT_L(n) asm volatile("s_waitcnt lgkmcnt(" #n ")" ::: "memory")
#define PG8_BAR __builtin_amdgcn_s_barrier()
#define PG8_SCHED __builtin_amdgcn_sched_barrier(0)
    Unit cur, nxt; int ui = 0;
    if (!S.next(0, cur)) return;
    if constexpr (!CHAIN_IN) {
#pragma unroll
    for (int a = 0; a < 2; ++a)
#pragma unroll
        for (int b = 0; b < 2; ++b)
#pragma unroll
            for (int m = 0; m < 4; ++m)
#pragma unroll
                for (int n = 0; n < 2; ++n) acc[a][b][m][n] = (f32x4){0.f, 0.f, 0.f, 0.f};
    }
    bf16x8 At[4][2], B0[2][2], B1[2][2];
    const char* cA = (const char*)g.A + (size_t)cur.pm * tstep + (size_t)cur.k0 * 2; const char* cB = (const char*)g.Bt + (size_t)cur.pn * tstep + (size_t)cur.k0 * 2;
    S.a_ready(cur);
    if constexpr (SP2) {
        PG8_STAGE(PG8_SB(0, 0), cB, voffB); PG8_STAGE(PG8_SB(0, 1), cB + hstep, voffB); PG8_STAGE(PG8_SA(0, 0), cA, voffA); PG8_STAGE(PG8_SA(0, 1), cA + hstep, voffA);
        if (wr == 1) PG8_BAR;
        PG8_WAIT_V(2); PG8_BAR;
        PG8_STAGE(PG8_SB(1, 0), cB + kstep, voffB); PG8_STAGE(PG8_SA(1, 0), cA + kstep, voffA); PG8_STAGE(PG8_SB(1, 1), cB + hstep + kstep, voffB);
        PG8_WAIT_V(6); PG8_BAR;
    } else {
        PG8_STAGE(PG8_SB(0, 0), cB, voffB); PG8_STAGE(PG8_SA(0, 0), cA, voffA); PG8_STAGE(PG8_SB(0, 1), cB + hstep, voffB); PG8_STAGE(PG8_SA(0, 1), cA + hstep, voffA);
        if (wr == 1) PG8_BAR;
        PG8_WAIT_V(4); PG8_BAR;
        PG8_STAGE(PG8_SB(1, 0), cB + kstep, voffB); PG8_STAGE(PG8_SA(1, 0), cA + kstep, voffA); PG8_STAGE(PG8_SB(1, 1), cB + hstep + kstep, voffB);
        PG8_WAIT_V(6); PG8_BAR;
    }
    for (;;) {
        const bool has_next = S.next(ui + 1, nxt);
        const char* nA = has_next ? (const char*)g.A + (size_t)nxt.pm * tstep + (size_t)nxt.k0 * 2 : cA; const char* nB = has_next ? (const char*)g.Bt + (size_t)nxt.pn * tstep + (size_t)nxt.k0 * 2 : cB;
        const int nt = cur.nt; const bool halfu = cur.cidx >= 0;
        for (int t = 0; t < nt; t += 2) {
            const bool last = (t == nt - 2);
            const char* a1 = cA + (size_t)(t + 1) * kstep;
            const char* a2 = last ? nA : cA + (size_t)(t + 2) * kstep; const char* b2 = last ? nB : cB + (size_t)(t + 2) * kstep;
            const char* a3 = a2 + kstep; const char* b3 = b2 + kstep;
            if (last && has_next) S.a_ready(nxt);
            if constexpr (SP2) {
            PG8_LDB(B0, 0, 0); PG8_LDB(B1, 0, 1); PG8_SCHED; PG8_LDA(At, 0, 0); PG8_STAGE(PG8_SA(1, 1), a1 + hstep, voffA);
            PG8_WAIT_V(8); PG8_WAIT_L(0); PG8_BAR; PG8_MMA(0, 0, At, B0); PG8_MMA(0, 1, At, B1); PG8_BAR; PG8_SCHED;
            PG8_LDA(At, 0, 1); PG8_STAGE(PG8_SB(0, 0), b2, voffB); PG8_STAGE(PG8_SB(0, 1), b2 + hstep, voffB); PG8_STAGE(PG8_SA(0, 0), a2, voffA);
            PG8_WAIT_V(8); PG8_WAIT_L(0); PG8_BAR; if (!halfu) { PG8_MMA(1, 0, At, B0); PG8_MMA(1, 1, At, B1); } PG8_BAR; PG8_SCHED;
            PG8_LDB(B0, 1, 0); PG8_LDB(B1, 1, 1); PG8_SCHED; PG8_LDA(At, 1, 0); PG8_STAGE(PG8_SA(0, 1), a2 + hstep, voffA);
            PG8_WAIT_V(8); PG8_WAIT_L(0); PG8_BAR; PG8_MMA(0, 0, At, B0); PG8_MMA(0, 1, At, B1); PG8_BAR; PG8_SCHED;
            PG8_LDA(At, 1, 1); PG8_STAGE(PG8_SB(1, 0), b3, voffB); PG8_STAGE(PG8_SB(1, 1), b3 + hstep, voffB); PG8_STAGE(PG8_SA(1, 0), a3, voffA);
            PG8_WAIT_V(8); PG8_WAIT_L(0); PG8_BAR; if (!halfu) { PG8_MMA(1, 0, At, B0); PG8_MMA(1, 1, At, B1); } PG8_BAR; PG8_SCHED;
            } else {
            PG8_LDB(B0, 0, 0); PG8_SCHED; PG8_LDA(At, 0, 0); PG8_STAGE(PG8_SA(1, 1), a1 + hstep, voffA);
            PG8_WAIT_L(8); PG8_BAR; PG8_WAIT_L(0); PG8_MMA(0, 0, At, B0); PG8_BAR; PG8_SCHED;
            PG8_LDB(B1, 0, 1); PG8_STAGE(PG8_SB(0, 0), b2, voffB);
            PG8_BAR; PG8_WAIT_L(0); PG8_MMA(0, 1, At, B1); PG8_BAR;
            PG8_LDA(At, 0, 1); PG8_STAGE(PG8_SA(0, 0), a2, voffA);
            PG8_BAR; PG8_WAIT_L(0); PG8_MMA(1, 0, At, B0); PG8_BAR; PG8_SCHED;
            PG8_STAGE(PG8_SB(0, 1), b2 + hstep, voffB);
            PG8_WAIT_V(6); PG8_BAR; PG8_MMA(1, 1, At, B1); PG8_BAR;
            PG8_LDB(B0, 1, 0); PG8_SCHED; PG8_LDA(At, 1, 0); PG8_STAGE(PG8_SA(0, 1), a2 + hstep, voffA);
            PG8_WAIT_L(8); PG8_BAR; PG8_WAIT_L(0); PG8_MMA(0, 0, At, B0); PG8_BAR; PG8_SCHED;
            PG8_LDB(B1, 1, 1); PG8_STAGE(PG8_SB(1, 0), b3, voffB);
            PG8_BAR; PG8_WAIT_L(0); PG8_MMA(0, 1, At, B1); PG8_BAR;
            PG8_LDA(At, 1, 1); PG8_STAGE(PG8_SA(1, 0), a3, voffA);
            PG8_BAR; PG8_WAIT_L(0); PG8_MMA(1, 0, At, B0); PG8_BAR; PG8_SCHED;
            PG8_STAGE(PG8_SB(1, 1), b3 + hstep, voffB);
            PG8_WAIT_V(6); PG8_BAR; PG8_MMA(1, 1, At, B1); PG8_BAR;
            }
        }
        if constexpr (ALIGN_EPI) { if (wr == 0) PG8_BAR; }
        if constexpr (!Epi::AFTER_DRAIN) { int t2 = threadIdx.x; asm volatile("" : "+v"(t2)); const int lane2 = t2 & 63, fr2 = lane2 & 15, fq2 = lane2 >> 4;
            if (cur.cidx < 0) E(acc, cur, wr, wc, fr2, fq2); else E.partial(acc, cur, wr, wc, fr2, fq2, wid, lane2); S.done(cur); }
        else { if (cur.cidx >= 0) { int t2 = threadIdx.x; asm volatile("" : "+v"(t2)); const int lane2 = t2 & 63; E.partial(acc, cur, wr, wc, lane2 & 15, lane2 >> 4, wid, lane2); } }
        if (!has_next) break;
#pragma unroll
        for (int a = 0; a < 2; ++a)
#pragma unroll
            for (int b = 0; b < 2; ++b)
#pragma unroll
                for (int m = 0; m < 4; ++m)
#pragma unroll
                    for (int n = 0; n < 2; ++n) acc[a][b][m][n] = (f32x4){0.f, 0.f, 0.f, 0.f};
        cur = nxt; cA = nA; cB = nB; ++ui;
        if constexpr (ALIGN_EPI) { if (wr == 1) PG8_BAR; }
    }
    PG8_WAIT_V(0);
    if constexpr (!ALIGN_EPI) { if (wr == 0) PG8_BAR; }
    PG8_BAR;
    if constexpr (Epi::AFTER_DRAIN) { E.fused(acc, cur, wr, wc, fr, fq, lds, wid, lane); S.done(cur); }
#undef PG8_SA
#undef PG8_SB
#undef PG8_STAGE
#undef PG8_LDA
#undef PG8_LDB
#undef PG8_MMA
#undef PG8_WAIT_V
#undef PG8_WAIT_L
#undef PG8_BAR
#undef PG8_SCHED
}
template <class Epi, class Sched, bool ALIGN_EPI = false, bool SP2 = false>
__device__ __forceinline__ void gemm_phase(PG8_LAS unsigned char* lds, const Gemm g, const Sched& S, const Epi& E) {
    f32x4 acc[2][2][4][2];
    gemm_phase<Epi, Sched, ALIGN_EPI, SP2, false>(lds, g, S, E, acc);
}

}
constexpr int DM = 2048, NB = 4, SEQ = 2048, NS = 128, DEPTH = 2;
constexpr int MPROMPT = NB * SEQ;
constexpr int MREAL = MPROMPT + NS;
constexpr int MP = 8448;
constexpr int D_A = 512, G_A = 32, P_A = 64, S5G = 16;
constexpr int D_B = 512, H_B = 8, GMC = 128;
constexpr int D_C = 1024, HD_C = 64, H_C = 16, N_C = 128, G_C = 2, K_C = 4, D_XBC = 1536;
constexpr int D_FF = 5632, K_F = 3, D_UP = 2 * D_FF;
constexpr int N_IN = 10256, N_INP = 10240;
constexpr int N_MOD = 6 * DM, MOD_PITCH = 2 * N_MOD;
constexpr float EPS = 1e-6f;
constexpr int PC_UA = 0, PC_UB = 512, PC_VB = 1024, PC_Z = 1536, PC_XBC = 2560, PC_GA = 4096, PC_GB = 6144, PC_GC = 8192;
constexpr int S5Q = 64, S5NC = SEQ / S5Q;
constexpr int SSDQ = 128, SSDNC = SEQ / SSDQ;

enum { I_XP = 0, I_XS, I_CP, I_CS, I_S5RE, I_S5IM, I_SSM, I_SSDCONV, I_FFNCONV, I_WMOD, I_BMOD, I_GMIX, I_WIN, I_LAMRE, I_LAMIM, I_LOGDT,
       I_BRE, I_BIM, I_CRE, I_CIM, I_S5D, I_WGLU, I_GV, I_WS, I_BS, I_CONVW, I_CONVB, I_DTBIAS, I_ALOG, I_SSDD, I_GNORM, I_WPA, I_WPB, I_WPC,
       I_WOUT, I_GFFN, I_WUP, I_FCONVW, I_FCONVB, I_WDOWN, I_GFINAL, N_INPUTS };
constexpr size_t O_YP = 0, O_YS = 16777216, O_S5RP = 17039360, O_S5IP = 17055744, O_SSMP = 17072128, O_CCP = 18120704, O_CFP = 18157568,
                 O_S5RS = 18337792, O_S5IS = 18862080, O_SSMS = 19386368, O_CCS = 52940800, O_CFS = 54120448, O_GVS = 59887616, O_END = 60018688;

constexpr size_t MiB = 1u << 20;
constexpr size_t WS_CTL = 0, CTL_ZERO_BYTES = 1 * MiB;
constexpr size_t SZ_WIN = (size_t)N_INP * DM * 2, SZ_WGLU = 512 * 512 * 2, SZ_WPA = (size_t)DM * 512 * 2, SZ_WPC = (size_t)DM * 1024 * 2,
                 SZ_WOUT = (size_t)DM * DM * 2, SZ_WUP = (size_t)D_UP * DM * 2, SZ_WDOWN = (size_t)DM * D_FF * 2;
constexpr size_t WL_IN = 0, WL_GLU = WL_IN + SZ_WIN, WL_PA = WL_GLU + SZ_WGLU, WL_PB = WL_PA + SZ_WPA, WL_PC = WL_PB + SZ_WPA, WL_OUT = WL_PC + SZ_WPC,
                 WL_UP = WL_OUT + SZ_WOUT, WL_DOWN = WL_UP + SZ_WUP, WL_END = WL_DOWN + SZ_WDOWN;
constexpr size_t WS_W = 2 * MiB;
constexpr size_t WS_SMALL = WS_W + 2 * WL_END;
constexpr size_t SM_WS = 0;
constexpr size_t SM_S5BB = SM_WS + 2 * 8 * 128 * 128 * 2;
constexpr size_t SM_S5CT = SM_S5BB + 2 * 32 * 64 * 32 * 4;
constexpr size_t SM_S5A = SM_S5CT + 2 * 32 * 16 * 128 * 2;
constexpr size_t SM_DT = SM_S5A + 2 * 32 * 64 * 4 * 4;
constexpr size_t SM_VSQ = SM_DT + (size_t)MP * 16 * 4;
constexpr size_t SM_CSQ = SM_VSQ + (size_t)2 * MP * 4;
constexpr size_t SM_SLOC = SM_CSQ + (size_t)2 * MP * 4;
constexpr size_t SM_SDEC = SM_SLOC + (size_t)NB * G_A * S5NC * 128 * 4;
constexpr size_t SM_CSILU = SM_SDEC + 4096;
constexpr size_t SM_WDT = SM_CSILU + 256 * 2048 * 2;
constexpr size_t SM_END = SM_WDT + (size_t)2 * 16 * DM * 4;
constexpr size_t WS_MOD = (WS_SMALL + SM_END + 4095) / 4096 * 4096;
constexpr size_t WS_X0 = WS_MOD + (size_t)2 * 256 * N_MOD * 4;
constexpr size_t WS_X1 = WS_X0 + (size_t)MP * DM * 4;
constexpr size_t WS_H = WS_X1 + (size_t)MP * DM * 4;
constexpr size_t WS_BIG = WS_H + (size_t)MP * DM * 2;
constexpr size_t WS_T = WS_BIG + (size_t)MP * D_UP * 2;
constexpr size_t WS_MERGED = WS_T + (size_t)MP * DM * 4;
constexpr size_t WS_OA = WS_MERGED + (size_t)MP * DM * 2;
constexpr size_t WS_OB = WS_OA + (size_t)MP * 512 * 2;
constexpr size_t WS_YB = WS_OB + (size_t)MP * 512 * 2;
constexpr size_t WS_OC = WS_YB + (size_t)MP * 512 * 2;
constexpr size_t WS_STATES = WS_OC + (size_t)MP * 1024 * 2;
constexpr size_t WS_SLAB = WS_STATES + (size_t)NB * SSDNC * H_C * HD_C * N_C * 4;
constexpr size_t WS_HALO = WS_SLAB + (size_t)176 * 131072;
constexpr size_t WS_END = WS_HALO + (size_t)33 * 4 * D_UP * 4;
static_assert((size_t)MP * D_FF * 2 <= (size_t)MP * DM * 6, "ACT overlays T+MERGED");
constexpr int CW_PC = 12288;
constexpr int CW_S5F = 20480;
constexpr int CW_SSDF = 16384;
constexpr int CW_BAR = 4096, CW_CNT = 8192;
struct Args { const float* in[N_INPUTS]; float* out; unsigned char* ws; };
typedef const __attribute__((address_space(4))) Args* KArgs;
__device__ __forceinline__ KArgs launder_args(KArgs a) { unsigned long long t = (unsigned long long)a; asm volatile("" : "+s"(t)); return (KArgs)t; }
#define GAS __attribute__((address_space(1)))
#define LAS __attribute__((address_space(3)))
typedef unsigned short bf16;
typedef unsigned v4u __attribute__((ext_vector_type(4)));
typedef unsigned v2u __attribute__((ext_vector_type(2)));
typedef float f32x4 __attribute__((ext_vector_type(4)));
typedef float f32x2 __attribute__((ext_vector_type(2)));
typedef short bf16x8 __attribute__((ext_vector_type(8)));
typedef short bf16x4 __attribute__((ext_vector_type(4)));
typedef GAS unsigned gu32;
#define RLX_AGENT __ATOMIC_RELAXED, __HIP_MEMORY_SCOPE_AGENT
#define LDS_WAIT() asm volatile("s_waitcnt lgkmcnt(0)" ::: "memory")
#define VM_WAIT() asm volatile("s_waitcnt vmcnt(0)" ::: "memory")
constexpr int NWAVES = 8, NTHR = 512, GRID = 256;
__device__ __forceinline__ unsigned f2bf(float f) { unsigned u = __builtin_bit_cast(unsigned, f); return (u + 0x7fffu + ((u >> 16) & 1u)) >> 16; }
__device__ __forceinline__ unsigned pk2(float lo, float hi) { return f2bf(lo) | (f2bf(hi) << 16); }
__device__ __forceinline__ float bf2f(unsigned short b) { return __builtin_bit_cast(float, (unsigned)b << 16); }
__device__ __forceinline__ float bflo(unsigned w) { return __builtin_bit_cast(float, w << 16); }
__device__ __forceinline__ float bfhi(unsigned w) { return __builtin_bit_cast(float, w & 0xffff0000u); }
__device__ __forceinline__ float sigmoidf_(float x) { return __builtin_amdgcn_rcpf(1.0f + __expf(-x)); }
__device__ __forceinline__ float siluf_(float x) { return x * __builtin_amdgcn_rcpf(1.0f + __expf(-x)); }
__device__ __forceinline__ float gelu_tanh(float x) {
    const float u = 0.7978845608028654f * (x + 0.044715f * x * x * x);
    const float e = __expf(2.0f * u);
    const float t = 1.0f - 2.0f * __builtin_amdgcn_rcpf(e + 1.0f);
    return 0.5f * x * (1.0f + t);
}
__device__ __forceinline__ float softplusf_(float x) { return fmaxf(x, 0.f) + __logf(1.0f + __expf(-fabsf(x))); }
template <int M> __device__ __forceinline__ float xor_lt32(float x) {
    return __builtin_bit_cast(float, __builtin_amdgcn_ds_swizzle(__builtin_bit_cast(int, x), (M << 10) | 0x1f)); }
__device__ __forceinline__ float add_xor32(float x) {
    const unsigned b = __builtin_bit_cast(unsigned, x); const auto r = __builtin_amdgcn_permlane32_swap(b, b, false, false);
    return __builtin_bit_cast(float, (unsigned)r[0]) + __builtin_bit_cast(float, (unsigned)r[1]); }
__device__ __forceinline__ float wave_sum(float v) {
    v += xor_lt32<1>(v); v += xor_lt32<2>(v); v += xor_lt32<4>(v); v += xor_lt32<8>(v); v += xor_lt32<16>(v);
    return add_xor32(v);
}
__device__ __forceinline__ float wave_sum16(const float (&a)[16], int lane) {
    float b[8], c[4], d[2];
    const bool o1 = lane & 1, o2 = lane & 2, o4 = lane & 4, o8 = lane & 8;
#pragma unroll
    for (int i = 0; i < 8; ++i) { const float keep = o1 ? a[2 * i + 1] : a[2 * i], send = o1 ? a[2 * i] : a[2 * i + 1]; b[i] = keep + xor_lt32<1>(send); }
#pragma unroll
    for (int i = 0; i < 4; ++i) { const float keep = o2 ? b[2 * i + 1] : b[2 * i], send = o2 ? b[2 * i] : b[2 * i + 1]; c[i] = keep + xor_lt32<2>(send); }
#pragma unroll
    for (int i = 0; i < 2; ++i) { const float keep = o4 ? c[2 * i + 1] : c[2 * i], send = o4 ? c[2 * i] : c[2 * i + 1]; d[i] = keep + xor_lt32<4>(send); }
    const float keep = o8 ? d[1] : d[0], send = o8 ? d[0] : d[1];
    float e = keep + xor_lt32<8>(send);
    e += xor_lt32<16>(e);
    return add_xor32(e);
}
__device__ __forceinline__ float half_sum32(const float (&a)[32], int lane) {
    float b[16], c[8], d[4], e[2];
    const bool o1 = lane & 1, o2 = lane & 2, o4 = lane & 4, o8 = lane & 8, o16 = lane & 16;
#pragma unroll
    for (int i = 0; i < 16; ++i) { const float keep = o1 ? a[2 * i + 1] : a[2 * i], send = o1 ? a[2 * i] : a[2 * i + 1]; b[i] = keep + xor_lt32<1>(send); }
#pragma unroll
    for (int i = 0; i < 8; ++i) { const float keep = o2 ? b[2 * i + 1] : b[2 * i], send = o2 ? b[2 * i] : b[2 * i + 1]; c[i] = keep + xor_lt32<2>(send); }
#pragma unroll
    for (int i = 0; i < 4; ++i) { const float keep = o4 ? c[2 * i + 1] : c[2 * i], send = o4 ? c[2 * i] : c[2 * i + 1]; d[i] = keep + xor_lt32<4>(send); }
#pragma unroll
    for (int i = 0; i < 2; ++i) { const float keep = o8 ? d[2 * i + 1] : d[2 * i], send = o8 ? d[2 * i] : d[2 * i + 1]; e[i] = keep + xor_lt32<8>(send); }
    const float keep = o16 ? e[1] : e[0], send = o16 ? e[0] : e[1];
    return keep + xor_lt32<16>(send);
}
__device__ __forceinline__ float lane_bcast(float x, int src) {
    return __builtin_bit_cast(float, __builtin_amdgcn_readlane(__builtin_bit_cast(int, x), src)); }
__device__ __forceinline__ int mod_row(int r) { return r < MPROMPT ? (r >> 11) : (r < MREAL ? 4 + (r - MPROMPT) : 4 + NS - 1); }

template <int MODE>
__device__ __forceinline__ void prep_row(const bf16* xrow, const float* g, const float* mr, int sh_idx, int sc_idx, bf16* hrow, float* yrow, float* dtrow, const LAS float* wT, int lane) {
    const GAS v2u* xr = (const GAS v2u*)xrow + lane;
    f32x4 v[8]; float s = 0.f;
#pragma unroll
    for (int j = 0; j < 8; ++j) { const v2u w = xr[64 * j]; v[j] = (f32x4){bflo(w.x), bfhi(w.x), bflo(w.y), bfhi(w.y)}; s += (v[j].x * v[j].x + v[j].y * v[j].y) + (v[j].z * v[j].z + v[j].w * v[j].w); }
    const float rinv = rsqrtf(wave_sum(s) * (1.0f / DM) + EPS);
    const GAS f32x4* gp = (const GAS f32x4*)g + lane;
    if (MODE == 2) { GAS f32x4* o = (GAS f32x4*)yrow + lane;
#pragma unroll
        for (int j = 0; j < 8; ++j) o[64 * j] = v[j] * rinv * gp[64 * j];
        return; }
    const GAS f32x4* shp = (const GAS f32x4*)(mr + sh_idx * DM) + lane; const GAS f32x4* scp = (const GAS f32x4*)(mr + sc_idx * DM) + lane;
    GAS v2u* o = (GAS v2u*)hrow + lane;
#pragma unroll
    for (int j = 0; j < 8; ++j) { const f32x4 gg = gp[64 * j], sh = shp[64 * j], sc = scp[64 * j];
        v[j] = v[j] * rinv * gg * (sc + 1.0f) + sh;
        v2u w; w.x = pk2(v[j].x, v[j].y); w.y = pk2(v[j].z, v[j].w); o[64 * j] = w; }
    if (MODE == 1) {
        float a16[16];
#pragma unroll
        for (int hh = 0; hh < 16; ++hh) { float a = 0.f;
#pragma unroll
            for (int j = 0; j < 8; ++j) { const f32x4 w = *(const LAS f32x4*)(wT + hh * DM + 4 * lane + 256 * j); a += (v[j].x * w.x + v[j].y * w.y) + (v[j].z * w.z + v[j].w * w.w); }
            a16[hh] = a; }
        const float mine = wave_sum16(a16, lane);
        if (lane < 16) dtrow[lane] = mine;
    }
}

template <int MODE>
__device__ __forceinline__ void prep_rows4(const bf16* x0, const float* g, const float* mr, int sh_idx, int sc_idx, bf16* h0, float* y0, float* dt0, const LAS float* wT, int lane) {
    f32x4 v[4][8];
#pragma unroll
    for (int q = 0; q < 4; ++q) { const GAS v2u* xr = (const GAS v2u*)(x0 + (size_t)q * DM) + lane;
#pragma unroll
        for (int j = 0; j < 8; ++j) { const v2u w = xr[64 * j]; v[q][j] = (f32x4){bflo(w.x), bfhi(w.x), bflo(w.y), bfhi(w.y)}; } }
    f32x4 gm[8], sh[8];
    {   const GAS f32x4* gp = (const GAS f32x4*)g + lane;
        if (MODE == 2) {
#pragma unroll
            for (int j = 0; j < 8; ++j) gm[j] = gp[64 * j];
        } else { const GAS f32x4* shp = (const GAS f32x4*)(mr + sh_idx * DM) + lane; const GAS f32x4* scp = (const GAS f32x4*)(mr + sc_idx * DM) + lane;
#pragma unroll
            for (int j = 0; j < 8; ++j) { gm[j] = gp[64 * j] * (scp[64 * j] + 1.0f); sh[j] = shp[64 * j]; } } }
#pragma unroll
    for (int q = 0; q < 4; ++q) { float s = 0.f;
#pragma unroll
        for (int j = 0; j < 8; ++j) s += (v[q][j].x * v[q][j].x + v[q][j].y * v[q][j].y) + (v[q][j].z * v[q][j].z + v[q][j].w * v[q][j].w);
        const float rinv = rsqrtf(wave_sum(s) * (1.0f / DM) + EPS);
        if (MODE == 2) { GAS f32x4* o = (GAS f32x4*)(y0 + (size_t)q * DM) + lane;
#pragma unroll
            for (int j = 0; j < 8; ++j) o[64 * j] = v[q][j] * rinv * gm[j];
        } else { GAS v2u* o = (GAS v2u*)(h0 + (size_t)q * DM) + lane;
#pragma unroll
            for (int j = 0; j < 8; ++j) { v[q][j] = v[q][j] * rinv * gm[j] + sh[j]; v2u w; w.x = pk2(v[q][j].x, v[q][j].y); w.y = pk2(v[q][j].z, v[q][j].w); o[64 * j] = w; }
            if (MODE == 1) { float a16[16];
#pragma unroll
                for (int hh = 0; hh < 16; ++hh) { float a = 0.f;
#pragma unroll
                    for (int j = 0; j < 8; ++j) { const f32x4 w = *(const LAS f32x4*)(wT + hh * DM + 4 * lane + 256 * j); a += (v[q][j].x * w.x + v[q][j].y * w.y) + (v[q][j].z * w.z + v[q][j].w * w.w); }
                    a16[hh] = a; }
                const float mine = wave_sum16(a16, lane);
                if (lane < 16) dt0[q * 16 + lane] = mine; } }
    }
}
#define XB_TMO      128
#define XB_XCNT(j)  (256  + 64 * (j))
#define XB_XSUB(j)  (1280 + 64 * (j))
#define XB_XGEN(j)  (2304 + 64 * (j))
#define XB_TOP      3328
#define XB_TOPGEN   3392
#define XCD_BAR_WORDS 3456
#define XB_SPIN_CAP (1u << 18)

__device__ __forceinline__ unsigned xb_ld(unsigned* p)              { return __hip_atomic_load(p, __ATOMIC_RELAXED, __HIP_MEMORY_SCOPE_AGENT); }
__device__ __forceinline__ unsigned xb_add(unsigned* p, unsigned v) { return __hip_atomic_fetch_add(p, v, __ATOMIC_RELAXED, __HIP_MEMORY_SCOPE_AGENT); }
__device__ __forceinline__ unsigned xb_xcc_id() { return (unsigned)__builtin_amdgcn_s_getreg((3 << 11) | 20) & 0xFu; }
#define XB_SPIN(cond, bar) do { unsigned _sp = 0; while (cond) { __builtin_amdgcn_s_sleep(1); \
    if ((++_sp & 255u) == 0u) { if (xb_ld(&(bar)[XB_TMO])) break; if (_sp > XB_SPIN_CAP) { atomicAdd(&(bar)[XB_TMO], 1u); break; } } } } while (0)

struct XcdBarrier {
    unsigned* bar; unsigned x;
    volatile LAS unsigned* st;
};

__device__ __forceinline__ XcdBarrier xcd_barrier_post(unsigned* bar, volatile LAS unsigned* st) {
    XcdBarrier b; b.bar = bar; b.x = xb_xcc_id(); b.st = st;
    if (threadIdx.x == 0) (void)xb_add(&bar[XB_XCNT(b.x)], 1u);
    return b;
}
__device__ __forceinline__ void xcd_barrier_complete(unsigned* bar, unsigned x, unsigned& nloc, unsigned& nx) {
    const unsigned G = gridDim.x * gridDim.y * gridDim.z;
    unsigned sum, cnt, mine, sp = 0u;
    for (;;) {
        sum = 0u; cnt = 0u; mine = 0u;
#pragma unroll
        for (unsigned j = 0; j < 16; ++j) { const unsigned c = xb_ld(&bar[XB_XCNT(j)]); sum += c; cnt += (c > 0u) ? 1u : 0u; mine = (j == x) ? c : mine; }
        if (sum == G) break;
        __builtin_amdgcn_s_sleep(1);
        if ((++sp & 255u) == 0u) { if (xb_ld(&bar[XB_TMO])) break; if (sp > XB_SPIN_CAP) { atomicAdd(&bar[XB_TMO], 1u); break; } }
    }
    nloc = mine > 0u ? mine : 1u; nx = cnt > 0u ? cnt : 1u;
}

__device__ __forceinline__ void xcd_barrier(const XcdBarrier& b) {
    asm volatile("s_waitcnt vmcnt(0)" ::: "memory");
    __syncthreads();
    if (threadIdx.x == 0) {
        unsigned* bar = b.bar;
        __builtin_amdgcn_s_waitcnt(0);
        unsigned nloc = b.st[0], nx = b.st[1];
        if (nloc == 0u) { xcd_barrier_complete(bar, b.x, nloc, nx); b.st[0] = nloc; b.st[1] = nx; }
        const unsigned old = xb_add(&bar[XB_XSUB(b.x)], 1u);
        const unsigned gen = old / nloc;
        if (old + 1u == (gen + 1u) * nloc) {
            __builtin_amdgcn_fence(__ATOMIC_RELEASE, "agent");
            asm volatile("s_waitcnt vmcnt(0)" ::: "memory");
            const unsigned og = xb_add(&bar[XB_TOP], 1u);
            const unsigned tg = og / nx;
            if (og + 1u == (tg + 1u) * nx) xb_add(&bar[XB_TOPGEN], 1u);
            else XB_SPIN(xb_ld(&bar[XB_TOPGEN]) == tg, bar);
            __builtin_amdgcn_fence(__ATOMIC_ACQUIRE, "agent");
            xb_add(&bar[XB_XGEN(b.x)], 1u);
            asm volatile("s_waitcnt vmcnt(0)" ::: "memory");
        } else {
            XB_SPIN(xb_ld(&bar[XB_XGEN(b.x)]) == gen, bar);
            __builtin_amdgcn_fence(__ATOMIC_ACQUIRE, "agent");
            asm volatile("s_waitcnt vmcnt(0)" ::: "memory");
        }
    }
    __syncthreads();
}

namespace epi {
using pg8::Unit; using pg8::f32x4; using pg8::u32x4; using pg8::cvt_pk_bf16;
typedef unsigned u32x2 __attribute__((ext_vector_type(2)));
constexpr int BM = 256, HALF = 128;

constexpr int SLAB_F4 = 8 * 16 * 64;
constexpr int SLAB_BYTES_ALL = 176 * 131072;
typedef unsigned v4u_ __attribute__((ext_vector_type(4)));
template <bool PERM> __device__ __forceinline__ int split_col(const Unit& u, int wc, int fq, int bj, int n) { return u.pn * BM + bj * HALF + wc * 32 + (PERM ? 8 * fq + 4 * n : 16 * n + 4 * fq); }
__device__ __forceinline__ __amdgpu_buffer_rsrc_t slab_rsrc(const f32x4* SLAB) { return __builtin_amdgcn_make_buffer_rsrc((void*)SLAB, (short)0, SLAB_BYTES_ALL, 0x00020000); }
__device__ __forceinline__ void split_store(const f32x4 (&acc)[2][2][4][2], f32x4* SLAB, int sid, int wid, int lane) {
    asm volatile("" : "+v"(lane));
    const __amdgpu_buffer_rsrc_t rs = slab_rsrc(SLAB);
    const unsigned vo = (unsigned)(wid * 16 * 64 + lane) * 16u, so = (unsigned)sid * (unsigned)(SLAB_F4 * 16);
#pragma unroll
    for (int m = 0; m < 4; ++m)
#pragma unroll
        for (int bj = 0; bj < 2; ++bj)
#pragma unroll
            for (int n = 0; n < 2; ++n) __builtin_amdgcn_raw_buffer_store_b128(__builtin_bit_cast(v4u_, acc[0][bj][m][n]), rs, vo + (unsigned)(((m * 2 + bj) * 2 + n) * 64 * 16), so,   16);
}
__device__ __forceinline__ bool split_arrive(unsigned* cnt, unsigned target, int lane) {
    asm volatile("s_waitcnt vmcnt(0)" ::: "memory");
    unsigned old = 0u;
    if (lane == 0) old = __hip_atomic_fetch_add(cnt, 1u, __ATOMIC_RELAXED, __HIP_MEMORY_SCOPE_AGENT);
    old = __builtin_amdgcn_readlane(old, 0);
    asm volatile("" ::: "memory");
    if (old != target - 1u) return false;
    __builtin_amdgcn_fence(__ATOMIC_ACQUIRE, "agent"); asm volatile("s_waitcnt vmcnt(0)" ::: "memory");
    return true;
}
__device__ __forceinline__ f32x4 slab_ld(const __amdgpu_buffer_rsrc_t rs, unsigned vo, unsigned so) { return __builtin_bit_cast(f32x4, __builtin_amdgcn_raw_buffer_load_b128(rs, vo, so,   16)); }
__device__ __forceinline__ f32x4 split_sum1(const f32x4* SLAB, int sid0, int ns, int wid, int lane, int reg) {
    const __amdgpu_buffer_rsrc_t rs = slab_rsrc(SLAB);
    const unsigned vo = (unsigned)((wid * 16 + reg) * 64 + lane) * 16u;
    f32x4 s = slab_ld(rs, vo, (unsigned)sid0 * (unsigned)(SLAB_F4 * 16));
    for (int j = 1; j < ns; ++j) s = s + slab_ld(rs, vo, (unsigned)(sid0 + j) * (unsigned)(SLAB_F4 * 16));
    return s;
}
__device__ __forceinline__ void split_sum(f32x4 (&acc)[2][2][4][2], const f32x4* SLAB, int sid0, int ns, int wid, int lane) {
    asm volatile("" : "+v"(lane));
    const __amdgpu_buffer_rsrc_t rs = slab_rsrc(SLAB);
    const unsigned vo = (unsigned)(wid * 16 * 64 + lane) * 16u;
#pragma unroll
    for (int m = 0; m < 4; ++m)
#pragma unroll
        for (int bj = 0; bj < 2; ++bj) {
            const unsigned vr = vo + (unsigned)((m * 2 + bj) * 2) * 1024u;
            unsigned so = (unsigned)sid0 * (unsigned)(SLAB_F4 * 16);
            f32x4 s0 = {0.f, 0.f, 0.f, 0.f}, s1 = s0;
            int j = 0;
#pragma unroll 1
            for (; j + 4 <= ns; j += 4) {
                f32x4 t[4][2];
#pragma unroll
                for (int q = 0; q < 4; ++q) { const unsigned sq = so + (unsigned)q * (unsigned)(SLAB_F4 * 16); t[q][0] = slab_ld(rs, vr, sq); t[q][1] = slab_ld(rs, vr + 1024u, sq); }
#pragma unroll
                for (int q = 0; q < 4; ++q) { s0 = s0 + t[q][0]; s1 = s1 + t[q][1]; }
                so += 4u * (unsigned)(SLAB_F4 * 16); }
#pragma unroll 1
            for (; j < ns; ++j) { s0 = s0 + slab_ld(rs, vr, so); s1 = s1 + slab_ld(rs, vr + 1024u, so); so += (unsigned)(SLAB_F4 * 16); }
            acc[0][bj][m][0] = s0; acc[0][bj][m][1] = s1;
            asm volatile("" ::: "memory");
        }
}
__device__ __forceinline__ void split_zero_pad(f32x4 (&acc)[2][2][4][2]) {
#pragma unroll
    for (int bj = 0; bj < 2; ++bj)
#pragma unroll
        for (int m = 0; m < 4; ++m)
#pragma unroll
            for (int n = 0; n < 2; ++n) acc[1][bj][m][n] = (f32x4){0.f, 0.f, 0.f, 0.f};
}
struct SplitCtl { f32x4* SLAB; unsigned* cnt; unsigned nsl; };

struct EpiIn {
    static constexpr bool PERM = true, AFTER_DRAIN = false;
    bf16* O; float* vsq; SplitCtl sp;
    template <int ACT> __device__ __forceinline__ void run(const f32x4 (&acc)[2][2][4][2], const Unit& u, int wr, int wc, int fr, int fq, bool dosq) const {
        const int row0 = u.pm * BM + wr * 64 + fr, col0 = u.pn * BM + wc * 32 + 8 * fq;
#pragma unroll
        for (int ai = 0; ai < 2; ++ai)
#pragma unroll
            for (int m = 0; m < 4; ++m) { const int row = row0 + ai * HALF + m * 16; bf16* rowp = O + (size_t)row * N_INP + col0; float sq = 0.f;
#pragma unroll
                for (int bj = 0; bj < 2; ++bj) { f32x4 v0 = acc[ai][bj][m][0], v1 = acc[ai][bj][m][1];
#pragma unroll
                    for (int j = 0; j < 4; ++j) {
                        if (ACT == 1) { v0[j] = gelu_tanh(v0[j]); v1[j] = gelu_tanh(v1[j]); }
                        if (ACT == 2) { v0[j] = sigmoidf_(v0[j]); v1[j] = sigmoidf_(v1[j]); }
                        sq += v0[j] * v0[j] + v1[j] * v1[j]; }
                    u32x4 w; w.x = cvt_pk_bf16(v0[0], v0[1]); w.y = cvt_pk_bf16(v0[2], v0[3]); w.z = cvt_pk_bf16(v1[0], v1[1]); w.w = cvt_pk_bf16(v1[2], v1[3]);
                    *(GAS u32x4*)(rowp + bj * HALF) = w; }
                if (ACT == 1) { if (dosq && vsq) { sq += xor_lt32<16>(sq); sq = add_xor32(sq); if (fq == 0) atomicAdd(vsq + row, sq); } }
            }
    }
    __device__ __forceinline__ void operator()(const f32x4 (&acc)[2][2][4][2], const Unit& u, int wr, int wc, int fr, int fq) const {
        const int pn = u.pn;
        if (pn >= 16) run<2>(acc, u, wr, wc, fr, fq, false);
        else if (pn >= 2 && pn < 6) run<1>(acc, u, wr, wc, fr, fq, pn >= 4);
        else run<0>(acc, u, wr, wc, fr, fq, false);
    }
    __device__ __forceinline__ void partial(f32x4 (&acc)[2][2][4][2], const Unit& u, int wr, int wc, int fr, int fq, int wid, int lane) const {
        split_store(acc, sp.SLAB, u.sid, wid, lane);
        if (split_arrive(sp.cnt + u.cidx * 8 + wid, sp.nsl, lane)) { split_zero_pad(acc); split_sum(acc, sp.SLAB, u.pn * (int)sp.nsl, (int)sp.nsl, wid, lane); (*this)(acc, u, wr, wc, fr, fq); }
    }
};
struct EpiBf16Plain {
    static constexpr bool PERM = true, AFTER_DRAIN = false;
    bf16* O; int ldc;
    __device__ __forceinline__ void partial(f32x4 (&)[2][2][4][2], const Unit&, int, int, int, int, int, int) const {}
    __device__ __forceinline__ void operator()(const f32x4 (&acc)[2][2][4][2], const Unit& u, int wr, int wc, int fr, int fq) const {
        const int row0 = u.pm * BM + wr * 64 + fr, col0 = u.pn * BM + wc * 32 + 8 * fq;
#pragma unroll
        for (int ai = 0; ai < 2; ++ai)
#pragma unroll
            for (int m = 0; m < 4; ++m) { bf16* rowp = O + (size_t)(row0 + ai * HALF + m * 16) * ldc + col0;
#pragma unroll
                for (int bj = 0; bj < 2; ++bj) { const f32x4 v0 = acc[ai][bj][m][0], v1 = acc[ai][bj][m][1];
                    u32x4 w; w.x = cvt_pk_bf16(v0[0], v0[1]); w.y = cvt_pk_bf16(v0[2], v0[3]); w.z = cvt_pk_bf16(v1[0], v1[1]); w.w = cvt_pk_bf16(v1[2], v1[3]);
                    *(GAS u32x4*)(rowp + bj * HALF) = w; } }
    }
};
__device__ __forceinline__ float dpp_ror1(float x) { return __builtin_bit_cast(float, __builtin_amdgcn_update_dpp(0, __builtin_bit_cast(int, x), 0x121, 0xf, 0xf, false)); }
__device__ __forceinline__ float dpp_ror2(float x) { return __builtin_bit_cast(float, __builtin_amdgcn_update_dpp(0, __builtin_bit_cast(int, x), 0x122, 0xf, 0xf, false)); }
__device__ __forceinline__ float dpp_shr1(float old, float x) { return __builtin_bit_cast(float, __builtin_amdgcn_update_dpp(__builtin_bit_cast(int, old), __builtin_bit_cast(int, x), 0x111, 0xf, 0xf, false)); }
__device__ __forceinline__ float dpp_shr2(float old, float x) { return __builtin_bit_cast(float, __builtin_amdgcn_update_dpp(__builtin_bit_cast(int, old), __builtin_bit_cast(int, x), 0x112, 0xf, 0xf, false)); }
struct EpiUpConv {
    static constexpr bool PERM = true, AFTER_DRAIN = false;
    bf16* ACT; float* HALO; const float* cw; const float* cb; const float* st; float* cfs; LAS float* EX; int dry;
    __device__ __forceinline__ void partial(f32x4 (&)[2][2][4][2], const Unit&, int, int, int, int, int, int) const {}
    __device__ __forceinline__ void operator()(const f32x4 (&acc)[2][2][4][2], const Unit& u, int wr, int wc, int fr, int fq) const {
        asm volatile("" : "+v"(fr), "+v"(fq));
        if (dry) {
#pragma unroll
            for (int ai = 0; ai < 2; ++ai)
#pragma unroll
                for (int bj = 0; bj < 2; ++bj)
#pragma unroll
                    for (int m = 0; m < 4; ++m)
#pragma unroll
                        for (int n = 0; n < 2; ++n) asm volatile("" :: "v"(acc[ai][bj][m][n]));
            return; }
        const int cl = wc * 32 + 8 * fq;
        if (u.pm == MPROMPT / 256) {
#pragma unroll
            for (int n = 0; n < 2; ++n) { const int c = u.pn * 128 + cl + 4 * n;
                f32x4 wa0, wa1, wa2, wb0, wb1, wb2, ba, bb;
                wa0 = *(const GAS f32x4*)(cw + c); wa1 = *(const GAS f32x4*)(cw + D_UP + c); wa2 = *(const GAS f32x4*)(cw + 2 * D_UP + c); wb0 = *(const GAS f32x4*)(cw + D_FF + c); wb1 = *(const GAS f32x4*)(cw + D_UP + D_FF + c); wb2 = *(const GAS f32x4*)(cw + 2 * D_UP + D_FF + c);
                ba = *(const GAS f32x4*)(cb + c); bb = *(const GAS f32x4*)(cb + D_FF + c);
#pragma unroll
                for (int m = 0; m < 4; ++m) { const int s = wr * 64 + m * 16 + fr; const float* sp = st + (size_t)s * 2 * D_UP; float* op = cfs + (size_t)s * 2 * D_UP;
                    const f32x4 a2 = *(const GAS f32x4*)(sp + c), a1 = *(const GAS f32x4*)(sp + D_UP + c), b2 = *(const GAS f32x4*)(sp + D_FF + c), b1 = *(const GAS f32x4*)(sp + D_UP + D_FF + c);
                    const f32x4 ua = acc[0][0][m][n], ub = acc[0][1][m][n];
                    *(GAS f32x4*)(op + c) = a1; *(GAS f32x4*)(op + D_FF + c) = b1; *(GAS f32x4*)(op + D_UP + c) = ua; *(GAS f32x4*)(op + D_UP + D_FF + c) = ub;
                    const f32x4 ca = ba + wa0 * a2 + wa1 * a1 + wa2 * ua, cbv = bb + wb0 * b2 + wb1 * b1 + wb2 * ub;
                    u32x2 w; w.x = cvt_pk_bf16(siluf_(ca[0]) * cbv[0], siluf_(ca[1]) * cbv[1]); w.y = cvt_pk_bf16(siluf_(ca[2]) * cbv[2], siluf_(ca[3]) * cbv[3]);
                    *(GAS u32x2*)(ACT + (size_t)(MPROMPT + s) * D_FF + c) = w; }
                asm volatile("" ::: "memory"); }
            return;
        }
        f32x4 wts[2][8];
#pragma unroll
        for (int n = 0; n < 2; ++n) { const int c = u.pn * 128 + cl + 4 * n;
            wts[n][0] = *(const GAS f32x4*)(cw + c); wts[n][1] = *(const GAS f32x4*)(cw + D_UP + c); wts[n][2] = *(const GAS f32x4*)(cw + 2 * D_UP + c);
            wts[n][3] = *(const GAS f32x4*)(cw + D_FF + c); wts[n][4] = *(const GAS f32x4*)(cw + D_UP + D_FF + c); wts[n][5] = *(const GAS f32x4*)(cw + 2 * D_UP + D_FF + c);
            wts[n][6] = *(const GAS f32x4*)(cb + c); wts[n][7] = *(const GAS f32x4*)(cb + D_FF + c); }
        if (fr >= 14) {
#pragma unroll
            for (int ai = 0; ai < 2; ++ai)
#pragma unroll
                for (int bj = 0; bj < 2; ++bj)
#pragma unroll
                    for (int n = 0; n < 2; ++n) *(LAS f32x4*)(EX + ((ai * 2 + wr) * 2 + (fr - 14)) * 256 + bj * 128 + cl + 4 * n) = acc[ai][bj][3][n];
            if (wr == 1) {
#pragma unroll
                for (int bj = 0; bj < 2; ++bj)
#pragma unroll
                    for (int n = 0; n < 2; ++n) *(GAS f32x4*)(HALO + ((size_t)u.pm * 4 + 2 + (fr - 14)) * D_UP + u.pn * 256 + bj * 128 + cl + 4 * n) = acc[1][bj][3][n]; }
        }
        if (fr < 2 && wr == 0) {
#pragma unroll
            for (int bj = 0; bj < 2; ++bj)
#pragma unroll
                for (int n = 0; n < 2; ++n) *(GAS f32x4*)(HALO + ((size_t)u.pm * 4 + fr) * D_UP + u.pn * 256 + bj * 128 + cl + 4 * n) = acc[0][bj][0][n]; }
        asm volatile("s_waitcnt lgkmcnt(0)" ::: "memory"); __builtin_amdgcn_s_barrier(); asm volatile("" ::: "memory");
#pragma unroll
        for (int n = 0; n < 2; ++n) { const int c = u.pn * 128 + cl + 4 * n;
            const f32x4 wa0 = wts[n][0], wa1 = wts[n][1], wa2 = wts[n][2], wb0 = wts[n][3], wb1 = wts[n][4], wb2 = wts[n][5], ba = wts[n][6], bb = wts[n][7];
#pragma unroll
            for (int ai = 0; ai < 2; ++ai)
#pragma unroll
                for (int m = 0; m < 4; ++m) {
                    f32x4 cv[2];
#pragma unroll
                    for (int bj = 0; bj < 2; ++bj) { const f32x4 cur = acc[ai][bj][m][n]; f32x4 pb;
                        if (m > 0) pb = acc[ai][bj][m - 1][n];
                        else { pb = (f32x4){0.f, 0.f, 0.f, 0.f};
                            const int sa = wr == 1 ? ai : 0, sw = wr == 1 ? 0 : 1; const bool have = (wr == 1) || (ai == 1);
                            if (have && fr >= 14) pb = *(const LAS f32x4*)(EX + ((sa * 2 + sw) * 2 + (fr - 14)) * 256 + bj * 128 + cl + 4 * n); }
                        f32x4 x1, x2;
#pragma unroll
                        for (int j = 0; j < 4; ++j) { x1[j] = dpp_shr1(dpp_ror1(pb[j]), cur[j]); x2[j] = dpp_shr2(dpp_ror2(pb[j]), cur[j]); }
                        cv[bj] = bj == 0 ? ba + wa0 * x2 + wa1 * x1 + wa2 * cur : bb + wb0 * x2 + wb1 * x1 + wb2 * cur; }
                    u32x2 w; w.x = cvt_pk_bf16(siluf_(cv[0][0]) * cv[1][0], siluf_(cv[0][1]) * cv[1][1]); w.y = cvt_pk_bf16(siluf_(cv[0][2]) * cv[1][2], siluf_(cv[0][3]) * cv[1][3]);
                    *(GAS u32x2*)(ACT + (size_t)(u.pm * BM + ai * HALF + wr * 64 + m * 16 + fr) * D_FF + c) = w; }
            asm volatile("" ::: "memory"); }
    }
};
struct EpiGlu {
    static constexpr bool PERM = true, AFTER_DRAIN = false;
    const bf16* Y; bf16* O;
    __device__ __forceinline__ void partial(f32x4 (&)[2][2][4][2], const Unit&, int, int, int, int, int, int) const {}
    __device__ __forceinline__ void operator()(const f32x4 (&acc)[2][2][4][2], const Unit& u, int wr, int wc, int fr, int fq) const {
        const int row0 = u.pm * BM + wr * 64 + fr, col0 = u.pn * BM + wc * 32 + 8 * fq;
#pragma unroll
        for (int ai = 0; ai < 2; ++ai)
#pragma unroll
            for (int m = 0; m < 4; ++m) { const size_t off = (size_t)(row0 + ai * HALF + m * 16) * 512 + col0;
#pragma unroll
                for (int bj = 0; bj < 2; ++bj) { const f32x4 v0 = acc[ai][bj][m][0], v1 = acc[ai][bj][m][1];
                    const u32x4 y = *(const GAS u32x4*)(Y + off + bj * HALF);
                    u32x4 w;
                    w.x = cvt_pk_bf16(bflo(y.x) * sigmoidf_(v0[0]), bfhi(y.x) * sigmoidf_(v0[1]));
                    w.y = cvt_pk_bf16(bflo(y.y) * sigmoidf_(v0[2]), bfhi(y.y) * sigmoidf_(v0[3]));
                    w.z = cvt_pk_bf16(bflo(y.z) * sigmoidf_(v1[0]), bfhi(y.z) * sigmoidf_(v1[1]));
                    w.w = cvt_pk_bf16(bflo(y.w) * sigmoidf_(v1[2]), bfhi(y.w) * sigmoidf_(v1[3]));
                    *(GAS u32x4*)(O + off + bj * HALF) = w; } }
    }
};
template <int MODE> struct EpiMerge {
    static constexpr bool PERM = false, AFTER_DRAIN = false;
    const bf16* G;
    float* T; bf16* MG; const float* csq;
    f32x4* SLAB; const bf16* PRJ; unsigned* cnt;
    __device__ __forceinline__ void partial(f32x4 (&acc)[2][2][4][2], const Unit& u, int wr, int wc, int fr, int fq, int wid, int lane) const {
        split_store(acc, SLAB, u.sid, wid, lane);
        if (!split_arrive(cnt + u.cidx * 8 + wid, 8u, lane)) return;
        asm volatile("" : "+v"(fr), "+v"(fq), "+v"(lane));
#pragma unroll
        for (int m = 0; m < 4; ++m) { const int r = wr * 64 + m * 16 + fr, row = MPROMPT + r; const float rs = rsqrtf(csq[row] * (1.0f / 1024.0f) + EPS);
#pragma unroll
            for (int bj = 0; bj < 2; ++bj)
#pragma unroll
                for (int n = 0; n < 2; ++n) { const int col = split_col<PERM>(u, wc, fq, bj, n), reg = (m * 2 + bj) * 2 + n; const bf16* gp = PRJ + ((unsigned)row * N_INP + col);
                    const f32x4 a = split_sum1(SLAB, u.pn * 2, 2, wid, lane, reg), b = split_sum1(SLAB, 16 + u.pn * 2, 2, wid, lane, reg), c = split_sum1(SLAB, 32 + u.pn * 4, 4, wid, lane, reg);
                    const u32x2 ga = *(const GAS u32x2*)(gp + PC_GA), gb = *(const GAS u32x2*)(gp + PC_GB), gc = *(const GAS u32x2*)(gp + PC_GC);
                    f32x4 t; t[0] = bflo(ga.x) * a[0] + bflo(gb.x) * b[0] + bflo(gc.x) * rs * c[0]; t[1] = bfhi(ga.x) * a[1] + bfhi(gb.x) * b[1] + bfhi(gc.x) * rs * c[1];
                    t[2] = bflo(ga.y) * a[2] + bflo(gb.y) * b[2] + bflo(gc.y) * rs * c[2]; t[3] = bfhi(ga.y) * a[3] + bfhi(gb.y) * b[3] + bfhi(gc.y) * rs * c[3];
                    u32x2 w; w.x = cvt_pk_bf16(t[0], t[1]); w.y = cvt_pk_bf16(t[2], t[3]); *(GAS u32x2*)(MG + ((unsigned)row * DM + col)) = w; }
            asm volatile("" ::: "memory"); }
    }
    __device__ __forceinline__ void operator()(const f32x4 (&acc)[2][2][4][2], const Unit& u, int wr, int wc, int fr, int fq) const {
        const int row0 = u.pm * BM + wr * 64 + fr, col0 = u.pn * BM + wc * 32 + 4 * fq;
#pragma unroll
        for (int ai = 0; ai < 2; ++ai)
#pragma unroll
            for (int m = 0; m < 4; ++m) { const int row = row0 + ai * HALF + m * 16; const size_t off = (size_t)row * DM + col0; const bf16* gp = G + (size_t)row * N_INP + col0;
                float rs = 1.f; if (MODE == 2) rs = rsqrtf(csq[row] * (1.0f / 1024.0f) + EPS);
#pragma unroll
                for (int bj = 0; bj < 2; ++bj)
#pragma unroll
                    for (int n = 0; n < 2; ++n) { const int co = bj * HALF + n * 16; const u32x2 g = *(const GAS u32x2*)(gp + co); f32x4 v = acc[ai][bj][m][n];
                        v[0] *= bflo(g.x); v[1] *= bfhi(g.x); v[2] *= bflo(g.y); v[3] *= bfhi(g.y);
                        bf16* Tb = (bf16*)T;
                        if (MODE == 0) { u32x2 w; w.x = cvt_pk_bf16(v[0], v[1]); w.y = cvt_pk_bf16(v[2], v[3]); *(GAS u32x2*)(Tb + off + co) = w; }
                        if (MODE == 1) { const u32x2 tb = *(const GAS u32x2*)(Tb + off + co); u32x2 w; w.x = cvt_pk_bf16(bflo(tb.x) + v[0], bfhi(tb.x) + v[1]); w.y = cvt_pk_bf16(bflo(tb.y) + v[2], bfhi(tb.y) + v[3]); *(GAS u32x2*)(Tb + off + co) = w; }
                        if (MODE == 2) { const u32x2 tb = *(const GAS u32x2*)(Tb + off + co); f32x4 t = {bflo(tb.x), bfhi(tb.x), bflo(tb.y), bfhi(tb.y)}; t = t + v * rs; u32x2 w; w.x = cvt_pk_bf16(t[0], t[1]); w.y = cvt_pk_bf16(t[2], t[3]); *(GAS u32x2*)(MG + off + co) = w; } } }
    }
};
template <int SEG> struct EpiChain {
    static constexpr bool PERM = false, AFTER_DRAIN = false;
    const bf16* PRJ; bf16* MG; const float* csq;
    __device__ __forceinline__ void partial(f32x4 (&)[2][2][4][2], const Unit&, int, int, int, int, int, int) const {}
    __device__ __forceinline__ void operator()(f32x4 (&acc)[2][2][4][2], const Unit& u, int wr, int wc, int fr, int fq) const {
        const int row0 = u.pm * BM + wr * 64 + fr, col0 = u.pn * BM + wc * 32 + 4 * fq;
#pragma unroll
        for (int ai = 0; ai < 2; ++ai)
#pragma unroll
            for (int m = 0; m < 4; ++m) { const int row = row0 + ai * HALF + m * 16; const bf16* gp = PRJ + ((unsigned)row * N_INP + col0);
                float rs = 1.f; if (SEG >= 1) rs = rsqrtf(csq[row] * (1.0f / 1024.0f) + EPS);
#pragma unroll
                for (int bj = 0; bj < 2; ++bj)
#pragma unroll
                    for (int n = 0; n < 2; ++n) { const int co = bj * HALF + n * 16; f32x4 v = acc[ai][bj][m][n];
                        if (SEG == 0) { const u32x2 ga = *(const GAS u32x2*)(gp + PC_GA + co), gb = *(const GAS u32x2*)(gp + PC_GB + co);
                            v[0] *= bflo(ga.x) * __builtin_amdgcn_rcpf(fmaxf(bflo(gb.x), 1e-20f)); v[1] *= bfhi(ga.x) * __builtin_amdgcn_rcpf(fmaxf(bfhi(gb.x), 1e-20f));
                            v[2] *= bflo(ga.y) * __builtin_amdgcn_rcpf(fmaxf(bflo(gb.y), 1e-20f)); v[3] *= bfhi(ga.y) * __builtin_amdgcn_rcpf(fmaxf(bfhi(gb.y), 1e-20f)); acc[ai][bj][m][n] = v; }
                        if (SEG == 1) { const u32x2 gb = *(const GAS u32x2*)(gp + PC_GB + co), gc = *(const GAS u32x2*)(gp + PC_GC + co);
                            v[0] *= fmaxf(bflo(gb.x), 1e-20f) * __builtin_amdgcn_rcpf(fmaxf(bflo(gc.x) * rs, 1e-20f)); v[1] *= fmaxf(bfhi(gb.x), 1e-20f) * __builtin_amdgcn_rcpf(fmaxf(bfhi(gc.x) * rs, 1e-20f));
                            v[2] *= fmaxf(bflo(gb.y), 1e-20f) * __builtin_amdgcn_rcpf(fmaxf(bflo(gc.y) * rs, 1e-20f)); v[3] *= fmaxf(bfhi(gb.y), 1e-20f) * __builtin_amdgcn_rcpf(fmaxf(bfhi(gc.y) * rs, 1e-20f)); acc[ai][bj][m][n] = v; }
                        if (SEG == 2) { const u32x2 gc = *(const GAS u32x2*)(gp + PC_GC + co);
                            v[0] *= fmaxf(bflo(gc.x) * rs, 1e-20f); v[1] *= fmaxf(bfhi(gc.x) * rs, 1e-20f); v[2] *= fmaxf(bflo(gc.y) * rs, 1e-20f); v[3] *= fmaxf(bfhi(gc.y) * rs, 1e-20f);
                            u32x2 w; w.x = cvt_pk_bf16(v[0], v[1]); w.y = cvt_pk_bf16(v[2], v[3]); *(GAS u32x2*)(MG + ((unsigned)row * DM + col0 + co)) = w; } }
                asm volatile("" ::: "memory"); }
    }
};
struct EpiResid {
    static constexpr bool PERM = false, AFTER_DRAIN = false;
    const bf16* XI; const bf16* XIS; bf16* XO; const float* gate; SplitCtl sp;
    __device__ __forceinline__ void partial(f32x4 (&acc)[2][2][4][2], const Unit& u, int wr, int wc, int fr, int fq, int wid, int lane) const {
        split_store(acc, sp.SLAB, u.sid, wid, lane);
        if (split_arrive(sp.cnt + u.cidx * 8 + wid, sp.nsl, lane)) { split_zero_pad(acc); split_sum(acc, sp.SLAB, u.pn * (int)sp.nsl, (int)sp.nsl, wid, lane); (*this)(acc, u, wr, wc, fr, fq); }
    }
    __device__ __forceinline__ void operator()(const f32x4 (&acc)[2][2][4][2], const Unit& u, int wr, int wc, int fr, int fq) const {
        const int row0 = u.pm * BM + wr * 64 + fr, col0 = u.pn * BM + wc * 32 + 4 * fq;
        const __amdgpu_buffer_rsrc_t xr = __builtin_amdgcn_make_buffer_rsrc((void*)XO, (short)0, (int)((size_t)MP * DM * 2), 0x00020000);
        const bool samp = u.pm == MPROMPT / 256;
        const bf16* xs16 = samp ? XIS - (size_t)MPROMPT * DM : XI;
#pragma unroll
        for (int ai = 0; ai < 2; ++ai) { if (ai == 1 && samp) break;
            u32x2 xw[4][2][2]; f32x4 gg[4][2][2];
#pragma unroll
            for (int m = 0; m < 4; ++m) { const int row = row0 + ai * HALF + m * 16; const size_t off = (size_t)row * DM + col0; const float* gp = gate + (size_t)mod_row(row) * MOD_PITCH + col0;
#pragma unroll
                for (int bj = 0; bj < 2; ++bj)
#pragma unroll
                    for (int n = 0; n < 2; ++n) { const int co = bj * HALF + n * 16; xw[m][bj][n] = *(const GAS u32x2*)(xs16 + off + co); gg[m][bj][n] = *(const GAS f32x4*)(gp + co); } }
#pragma unroll
            for (int m = 0; m < 4; ++m) { const int row = row0 + ai * HALF + m * 16; const size_t off = (size_t)row * DM + col0;
#pragma unroll
                for (int bj = 0; bj < 2; ++bj)
#pragma unroll
                    for (int n = 0; n < 2; ++n) { const int co = bj * HALF + n * 16; const u32x2 w = xw[m][bj][n]; const f32x4 xi = {bflo(w.x), bfhi(w.x), bflo(w.y), bfhi(w.y)};
                        const f32x4 xo = xi + gg[m][bj][n] * acc[ai][bj][m][n]; u32x2 wo; wo.x = cvt_pk_bf16(xo[0], xo[1]); wo.y = cvt_pk_bf16(xo[2], xo[3]);
                        __builtin_amdgcn_raw_buffer_store_b64(wo, xr, (unsigned)(off + co) * 2u, 0,   16); } } }
    }
};
template <int MODE> struct EpiResidPrep {
    static constexpr bool PERM = false, AFTER_DRAIN = true;
    EpiResid R; bf16* H; float* yp; float* ys; const float* g; const float* mod2; int sh_idx, sc_idx; const float* wdt; float* DT; unsigned* pc;
    __device__ __forceinline__ void partial(f32x4 (&acc)[2][2][4][2], const Unit& u, int wr, int wc, int fr, int fq, int wid, int lane) const {
        split_store(acc, R.sp.SLAB, u.sid, wid, lane);
        if (split_arrive(R.sp.cnt + u.cidx * 8 + wid, R.sp.nsl, lane)) { split_zero_pad(acc); split_sum(acc, R.sp.SLAB, u.pn * (int)R.sp.nsl, (int)R.sp.nsl, wid, lane); R(acc, u, wr, wc, fr, fq);
            asm volatile("s_waitcnt vmcnt(0)" ::: "memory");
            if (lane == 0) __hip_atomic_fetch_add(pc + 32, 1u, __ATOMIC_RELAXED, __HIP_MEMORY_SCOPE_AGENT); }
    }
    __device__ __forceinline__ void operator()(const f32x4 (&acc)[2][2][4][2], const Unit& u, int wr, int wc, int fr, int fq) const { R(acc, u, wr, wc, fr, fq); }
    __device__ __forceinline__ void fused(f32x4 (&acc)[2][2][4][2], const Unit& u, int wr, int wc, int fr, int fq, LAS unsigned char* lds, int wid, int lane) const {
        R(acc, u, wr, wc, fr, fq);
        asm volatile("s_waitcnt vmcnt(0)" ::: "memory"); __syncthreads();
        if (wid == 0 && lane == 0) {
            __hip_atomic_fetch_add(pc + u.pm, 1u, __ATOMIC_RELAXED, __HIP_MEMORY_SCOPE_AGENT);
            unsigned sp_ = 0; while (__hip_atomic_load(pc + u.pm, __ATOMIC_RELAXED, __HIP_MEMORY_SCOPE_AGENT) < 8u && ++sp_ < (1u << 22)) __builtin_amdgcn_s_sleep(2);
            if (u.pn == 0) { sp_ = 0; while (__hip_atomic_load(pc + 32, __ATOMIC_RELAXED, __HIP_MEMORY_SCOPE_AGENT) < 64u && ++sp_ < (1u << 22)) __builtin_amdgcn_s_sleep(2); }
            __builtin_amdgcn_fence(__ATOMIC_ACQUIRE, "agent"); asm volatile("s_waitcnt vmcnt(0)" ::: "memory");
        }
        __syncthreads();
        LAS float* wT = (LAS float*)lds;
        if (MODE == 1) { f32x4 tw[16];
#pragma unroll
            for (int i = 0; i < 16; ++i) tw[i] = ((const f32x4*)wdt)[wid * 64 + lane + i * NTHR];
#pragma unroll
            for (int i = 0; i < 16; ++i) ((LAS f32x4*)wT)[wid * 64 + lane + i * NTHR] = tw[i];
            __syncthreads(); }
        const bf16* X = R.XO;
        {   const int row = u.pm * BM + u.pn * 32 + wid * 4;
            prep_rows4<MODE>(X + (size_t)row * DM, g, mod2 + (size_t)mod_row(row) * MOD_PITCH, sh_idx, sc_idx, H + (size_t)row * DM, yp + (size_t)row * DM, DT + (size_t)row * 16, wT, lane); }
        if (u.pn == 0 && wid < 4) { const int s = u.pm * 4 + wid, row = MPROMPT + s;
            prep_row<MODE>(X + (size_t)row * DM, g, mod2 + (size_t)mod_row(row) * MOD_PITCH, sh_idx, sc_idx, H + (size_t)row * DM, ys + (size_t)s * DM, DT + (size_t)row * 16, wT, lane); }
        if (MODE == 1) __syncthreads();
    }
};
struct EpiMod {
    static constexpr bool PERM = false, AFTER_DRAIN = false;
    float* MOD; const float* bmod;
    __device__ __forceinline__ void partial(f32x4 (&)[2][2][4][2], const Unit&, int, int, int, int, int, int) const {}
    __device__ __forceinline__ void operator()(const f32x4 (&acc)[2][2][4][2], const Unit& u, int wr, int wc, int fr, int fq) const {
        const int row0 = wr * 64 + fr, col0 = u.pn * BM + wc * 32 + 4 * fq;
        f32x4 bv[2][2];
#pragma unroll
        for (int bj = 0; bj < 2; ++bj)
#pragma unroll
            for (int n = 0; n < 2; ++n) bv[bj][n] = *(const GAS f32x4*)(bmod + col0 + bj * HALF + n * 16);
#pragma unroll
        for (int ai = 0; ai < 2; ++ai)
#pragma unroll
            for (int m = 0; m < 4; ++m) { float* rowp = MOD + (size_t)(row0 + ai * HALF + m * 16) * MOD_PITCH + col0;
#pragma unroll
                for (int bj = 0; bj < 2; ++bj)
#pragma unroll
                    for (int n = 0; n < 2; ++n) *(GAS f32x4*)(rowp + bj * HALF + n * 16) = acc[ai][bj][m][n] + bv[bj][n]; }
    }
};
}
struct Frame {
    LAS unsigned char* lds;
    int tid, lane, wave, gw;
    float* out; unsigned char* ws;
};
#define WSP(T, off) ((T*)(F.ws + (off)))
__device__ __forceinline__ Frame launder(const Frame& F0) {
    Frame F = F0; int t = F0.tid; asm volatile("" : "+v"(t)); F.tid = t; F.lane = t & 63; F.wave = __builtin_amdgcn_readfirstlane(t >> 6);
    unsigned long long w = (unsigned long long)F0.ws, o = (unsigned long long)F0.out; asm volatile("" : "+s"(w), "+s"(o)); F.ws = (unsigned char*)w; F.out = (float*)o;
    F.gw = blockIdx.x * NWAVES + F.wave; return F;
}

__device__ __forceinline__ void transpose_item(const float* W, int ld, int K, int ncols, int c0, bf16* WT, int row_off, LAS float* scr, int item, int lane) {
    const int nblk = ncols / 32, kb = item / nblk, nb = item % nblk, k0 = 64 * kb, n0 = 32 * nb;
    const int rbase = row_off >= 0 ? row_off + n0 : (n0 < D_FF ? 256 * (n0 / 128) + n0 % 128 : 256 * ((n0 - D_FF) / 128) + 128 + (n0 - D_FF) % 128);
    float tv[32];
#pragma unroll
    for (int i = 0; i < 32; ++i) { const int kk = 2 * i + (lane >> 5); tv[i] = __builtin_nontemporal_load(W + (size_t)(k0 + kk) * ld + c0 + n0 + (lane & 31)); }
#pragma unroll
    for (int i = 0; i < 32; ++i) { const int kk = 2 * i + (lane >> 5); scr[kk * 33 + (lane & 31)] = tv[i]; }
    if (false) for (int i = 0; i < 32; ++i) { const int kk = 2 * i + (lane >> 5); scr[kk * 33 + (lane & 31)] = __builtin_nontemporal_load(W + (size_t)(k0 + kk) * ld + c0 + n0 + (lane & 31)); }
    LDS_WAIT(); asm volatile("" ::: "memory");
    const int c = lane & 7;
#pragma unroll
    for (int j = 0; j < 4; ++j) { const int n = (lane >> 3) + 8 * j; const LAS float* s = scr + (8 * c) * 33 + n;
        v4u o; o.x = pk2(s[0 * 33], s[1 * 33]); o.y = pk2(s[2 * 33], s[3 * 33]); o.z = pk2(s[4 * 33], s[5 * 33]); o.w = pk2(s[6 * 33], s[7 * 33]);
        *(GAS v4u*)(WT + (size_t)(rbase + n) * K + k0 + 8 * c) = o; }
    LDS_WAIT(); asm volatile("" ::: "memory");
}
constexpr int MODC = 96, MODK = 128, MODP = 136;
__device__ __forceinline__ void phase_mod(const Frame& F0, KArgs A) {
    Frame F = launder(F0);
    const int n0 = blockIdx.x * MODC, l = n0 / N_MOD, cl = n0 - l * N_MOD;
    const float* W = A->in[I_WMOD] + (size_t)l * DM * N_MOD + cl;
    LAS bf16* Bt = (LAS bf16*)F.lds;
    LAS bf16* As = (LAS bf16*)(F.lds + 2 * MODC * MODP * 2);
    for (int i = F.tid; i < 2 * 12 * MODP; i += NTHR) { const int b = i / (12 * MODP), r = i % (12 * MODP); As[(b * 144 + 132) * MODP + r] = (bf16)0; }
    f32x4 wa[6], wb[6], creg[9];
    auto load_w = [&](f32x4 (&wr)[6], int kc) {
#pragma unroll
        for (int j = 0; j < 6; ++j) { const int idx = F.tid + NTHR * j, n = idx % MODC, k = 4 * (idx / MODC); const float* p = W + (size_t)(kc * MODK + k) * N_MOD + n;
            wr[j].x = __builtin_nontemporal_load(p); wr[j].y = __builtin_nontemporal_load(p + N_MOD); wr[j].z = __builtin_nontemporal_load(p + 2 * N_MOD); wr[j].w = __builtin_nontemporal_load(p + 3 * (size_t)N_MOD); }
    };
    auto load_c = [&](int kc) {
#pragma unroll
        for (int j = 0; j < 9; ++j) { const int idx = F.tid + NTHR * j, r = idx >> 5, k4 = (idx & 31) * 4;
            const float* src = r < NB ? A->in[I_CP] + (size_t)r * DM : A->in[I_CS] + (size_t)(r - NB) * DM;
            creg[j] = r < NB + NS ? *(const GAS f32x4*)(src + kc * MODK + k4) : (f32x4){0.f, 0.f, 0.f, 0.f}; }
    };
    auto store_w = [&](const f32x4 (&wr)[6], int buf) {
#pragma unroll
        for (int j = 0; j < 6; ++j) { const int idx = F.tid + NTHR * j, n = idx % MODC, k = 4 * (idx / MODC);
            v2u w; w.x = pk2(wr[j].x, wr[j].y); w.y = pk2(wr[j].z, wr[j].w); *(LAS v2u*)(Bt + (buf * MODC + n) * MODP + k) = w; }
    };
    auto store_c = [&](int buf) {
#pragma unroll
        for (int j = 0; j < 9; ++j) { const int idx = F.tid + NTHR * j, r = idx >> 5, k4 = (idx & 31) * 4;
            if (r < NB + NS) { v2u w; w.x = pk2(siluf_(creg[j].x), siluf_(creg[j].y)); w.y = pk2(siluf_(creg[j].z), siluf_(creg[j].w)); *(LAS v2u*)(As + (buf * 144 + r) * MODP + k4) = w; } }
    };
    f32x4 acc[9];
#pragma unroll
    for (int m = 0; m < 9; ++m) acc[m] = (f32x4){0.f, 0.f, 0.f, 0.f};
    auto compute = [&](int buf) {
        if (F.wave < 6) {
#pragma unroll
            for (int ks = 0; ks < MODK / 32; ++ks) { const bf16x8 bfr = *(const LAS bf16x8*)(Bt + (buf * MODC + 16 * F.wave + (F.lane & 15)) * MODP + 32 * ks + 8 * (F.lane >> 4));
#pragma unroll
                for (int m = 0; m < 9; ++m) { const bf16x8 af = *(const LAS bf16x8*)(As + (buf * 144 + 16 * m + (F.lane & 15)) * MODP + 32 * ks + 8 * (F.lane >> 4));
                    acc[m] = __builtin_amdgcn_mfma_f32_16x16x32_bf16(af, bfr, acc[m], 0, 0, 0); } }
        }
    };
    const int kst = blockIdx.x & 15;
    load_w(wa, kst); load_c(kst); load_w(wb, (1 + kst) & 15);
    store_w(wa, 0); store_c(0); __syncthreads();
#pragma unroll 1
    for (int kc = 0; kc < DM / MODK; kc += 2) {
        load_c((kc + 1 + kst) & 15); if (kc + 2 < DM / MODK) load_w(wa, (kc + 2 + kst) & 15);
        compute(0);
        store_w(wb, 1); store_c(1); __syncthreads();
        if (kc + 2 < DM / MODK) { load_c((kc + 2 + kst) & 15); if (kc + 3 < DM / MODK) load_w(wb, (kc + 3 + kst) & 15); }
        compute(1);
        if (kc + 2 < DM / MODK) { store_w(wa, 0); store_c(0); }
        __syncthreads();
    }
    if (F.wave < 6) { float* MOD = WSP(float, WS_MOD); const int col = n0 + 16 * F.wave + (F.lane & 15); const float bias = A->in[I_BMOD][col];
#pragma unroll
        for (int m = 0; m < 9; ++m)
#pragma unroll
            for (int r = 0; r < 4; ++r) { const int row = 16 * m + 4 * (F.lane >> 4) + r; if (row < NB + NS) MOD[(size_t)row * MOD_PITCH + col] = acc[m][r] + bias; } }
    __syncthreads();
}
__device__ __forceinline__ void tjob(Frame& F, LAS float* scr, const float* W, int ld, int K, int ncols, int c0, bf16* WT, int row_off) {
    const int nit = (K / 64) * (ncols / 32);
    for (int it = F.gw; it < nit; it += (GRID * NWAVES)) transpose_item(W, ld, K, ncols, c0, WT, row_off, scr, it, F.lane);
}
__device__ __forceinline__ void phase_prologue(const Frame& F0, KArgs A) {
    Frame F = launder(F0);
    LAS float* scr = (LAS float*)(F.lds + F.wave * 16384);
#pragma unroll 1
    for (int l = 0; l < DEPTH; ++l) {
        unsigned char* wl = F.ws + WS_W + (size_t)l * WL_END;
        tjob(F, scr, A->in[I_WIN] + (size_t)l * DM * N_IN, N_IN, DM, 4096, 0, (bf16*)(wl + WL_IN), 0);
        tjob(F, scr, A->in[I_WIN] + (size_t)l * DM * N_IN, N_IN, DM, 6144, 4112, (bf16*)(wl + WL_IN), 4096);
        tjob(F, scr, A->in[I_WGLU] + (size_t)l * 512 * 512, 512, 512, 512, 0, (bf16*)(wl + WL_GLU), 0);
        tjob(F, scr, A->in[I_WPA] + (size_t)l * 512 * DM, DM, 512, DM, 0, (bf16*)(wl + WL_PA), 0);
        tjob(F, scr, A->in[I_WPB] + (size_t)l * 512 * DM, DM, 512, DM, 0, (bf16*)(wl + WL_PB), 0);
        tjob(F, scr, A->in[I_WPC] + (size_t)l * 1024 * DM, DM, 1024, DM, 0, (bf16*)(wl + WL_PC), 0);
        tjob(F, scr, A->in[I_WOUT] + (size_t)l * DM * DM, DM, DM, DM, 0, (bf16*)(wl + WL_OUT), 0);
        tjob(F, scr, A->in[I_WUP] + (size_t)l * DM * D_UP, D_UP, DM, D_UP, 0, (bf16*)(wl + WL_UP), -1);
        tjob(F, scr, A->in[I_WDOWN] + (size_t)l * D_FF * DM, DM, D_FF, DM, 0, (bf16*)(wl + WL_DOWN), 0);
    }
    {   bf16* X0 = WSP(bf16, WS_X0);
        for (int r = F.gw; r < MREAL; r += (GRID * NWAVES)) {
            const float* src = r < MPROMPT ? A->in[I_XP] + (size_t)r * DM : A->in[I_XS] + (size_t)(r - MPROMPT) * DM;
            GAS v2u* o = (GAS v2u*)(X0 + (size_t)r * DM) + F.lane;
#pragma unroll
            for (int j = 0; j < 8; ++j) { const f32x4 v = __builtin_nontemporal_load((const f32x4*)src + F.lane + 64 * j); v2u w; w.x = pk2(v.x, v.y); w.y = pk2(v.z, v.w); o[64 * j] = w; }
        }
    }
    {   float* z = WSP(float, WS_SMALL + SM_VSQ);
        const int gt = blockIdx.x * NTHR + F.tid;
        for (int i = gt; i < 4 * MP; i += GRID * NTHR) z[i] = 0.f;
    }
    {   const int gt = blockIdx.x * NTHR + F.tid, NT = GRID * NTHR;
        bf16* WSb = WSP(bf16, WS_SMALL + SM_WS);
        for (int i = gt; i < DEPTH * H_B * 128 * 128; i += NT) { const int jj = i & 127, ii = (i >> 7) & 127; WSb[i] = (bf16)(jj <= ii ? f2bf(A->in[I_WS][i]) : 0u); }
        float* AA = WSP(float, WS_SMALL + SM_S5A); float* BB = WSP(float, WS_SMALL + SM_S5BB); bf16* CT = WSP(bf16, WS_SMALL + SM_S5CT);
        for (int i = gt; i < DEPTH * G_A * P_A; i += NT) {
            const int l = i / (G_A * P_A), g = (i / P_A) % G_A;
            const float dt = expf(A->in[I_LOGDT][l * G_A + g]), lr = A->in[I_LAMRE][i], li = A->in[I_LAMIM][i];
            const float mag = expf(lr * dt); float sn, cs; sincosf(li * dt, &sn, &cs);
            const float ar = mag * cs, ai = mag * sn, den = lr * lr + li * li, nr = ar - 1.0f;
            const float kr = (nr * lr + ai * li) / den, ki = (ai * lr - nr * li) / den;
            float qr = ar, qi = ai;
#pragma unroll
            for (int s = 0; s < 6; ++s) { const float t = qr * qr - qi * qi; qi = 2.0f * qr * qi; qr = t; }
            AA[i * 4 + 0] = ar; AA[i * 4 + 1] = ai; AA[i * 4 + 2] = qr; AA[i * 4 + 3] = qi;
#pragma unroll
            for (int h = 0; h < S5G; ++h) { const float bre = A->in[I_BRE][(size_t)i * S5G + h], bim = A->in[I_BIM][(size_t)i * S5G + h];
                BB[(size_t)i * 32 + h] = kr * bre - ki * bim; BB[(size_t)i * 32 + 16 + h] = kr * bim + ki * bre; }
        }
        {   float* WDT = WSP(float, WS_SMALL + SM_WDT);
            for (int i = gt; i < DEPTH * 16 * DM; i += NT) { const int k = i % DM, hh = (i / DM) & 15, l = i / (16 * DM); WDT[i] = A->in[I_WIN][((size_t)l * DM + k) * N_IN + 4096 + hh]; } }
        for (int i = gt; i < DEPTH * G_A * S5G * 128; i += NT) { const int k = i & 127, lgh = i >> 7;
            const float v = k < 64 ? A->in[I_CRE][(size_t)lgh * 64 + k] : -A->in[I_CIM][(size_t)lgh * 64 + (k - 64)]; CT[i] = (bf16)f2bf(v); }
    }
}

template <bool WITH_DT>
__device__ __forceinline__ void phase_prep(const Frame& F0, const float* X, const float* XS, const float* g, const float* modl, int sh_idx, int sc_idx, const float* win_l, float* DT) {
    Frame F = launder(F0);
    bf16* H = WSP(bf16, WS_H);
    LAS float* wT = (LAS float*)F.lds;
    if (WITH_DT) {
        for (int k = F.tid; k < DM; k += NTHR) { const GAS f32x4* s = (const GAS f32x4*)(win_l + (size_t)k * N_IN + 4096);
#pragma unroll
            for (int q = 0; q < 4; ++q) { const f32x4 v = s[q]; wT[(4 * q + 0) * DM + k] = v.x; wT[(4 * q + 1) * DM + k] = v.y; wT[(4 * q + 2) * DM + k] = v.z; wT[(4 * q + 3) * DM + k] = v.w; } }
        __syncthreads();
    }
    f32x4 vn[8];
    {   const int r0 = blockIdx.x * NWAVES + F.wave; const int rr0 = r0 < MREAL ? r0 : 0; const GAS f32x4* xr = (const GAS f32x4*)(rr0 < MPROMPT ? X + (size_t)rr0 * DM : XS + (size_t)(rr0 - MPROMPT) * DM) + F.lane;
#pragma unroll
        for (int j = 0; j < 8; ++j) vn[j] = xr[64 * j]; }
    for (int r = blockIdx.x * NWAVES + F.wave; r < MREAL; r += GRID * NWAVES) {
        f32x4 v[8]; float s = 0.f;
#pragma unroll
        for (int j = 0; j < 8; ++j) { v[j] = vn[j]; s += (v[j].x * v[j].x + v[j].y * v[j].y) + (v[j].z * v[j].z + v[j].w * v[j].w); }
        {   const int rn = r + GRID * NWAVES; const int rr1 = rn < MREAL ? rn : r; const GAS f32x4* xr = (const GAS f32x4*)(rr1 < MPROMPT ? X + (size_t)rr1 * DM : XS + (size_t)(rr1 - MPROMPT) * DM) + F.lane;
#pragma unroll
            for (int j = 0; j < 8; ++j) vn[j] = xr[64 * j]; }
        const float rinv = rsqrtf(wave_sum(s) * (1.0f / DM) + EPS);
        const float* mr = modl + (size_t)mod_row(r) * MOD_PITCH;
        const GAS f32x4* gp = (const GAS f32x4*)g + F.lane; const GAS f32x4* shp = (const GAS f32x4*)(mr + sh_idx * DM) + F.lane; const GAS f32x4* scp = (const GAS f32x4*)(mr + sc_idx * DM) + F.lane;
        GAS v2u* o = (GAS v2u*)(H + (size_t)r * DM) + F.lane;
#pragma unroll
        for (int j = 0; j < 8; ++j) { const f32x4 gg = gp[64 * j], sh = shp[64 * j], sc = scp[64 * j];
            v[j] = v[j] * rinv * gg * (sc + 1.0f) + sh;
            v2u w; w.x = pk2(v[j].x, v[j].y); w.y = pk2(v[j].z, v[j].w); o[64 * j] = w; }
        if (WITH_DT) {
            float a16[16];
#pragma unroll
            for (int hh = 0; hh < 16; ++hh) { float a = 0.f;
#pragma unroll
                for (int j = 0; j < 8; ++j) { const f32x4 w = *(const LAS f32x4*)(wT + hh * DM + 4 * F.lane + 256 * j); a += (v[j].x * w.x + v[j].y * w.y) + (v[j].z * w.z + v[j].w * w.w); }
                a16[hh] = a; }
            const float mine = wave_sum16(a16, F.lane);
            if (F.lane < 16) DT[(size_t)r * 16 + F.lane] = mine;
        }
    }
    if (WITH_DT) __syncthreads();
}

__device__ __forceinline__ void phase_final(const Frame& F0, KArgs A, const float* X) {
    Frame F = launder(F0);
    const float* g = A->in[I_GFINAL];
    for (int r = blockIdx.x * NWAVES + F.wave; r < MREAL; r += GRID * NWAVES) {
        const GAS f32x4* xr = (const GAS f32x4*)(X + (size_t)r * DM) + F.lane;
        f32x4 v[8]; float s = 0.f;
#pragma unroll
        for (int j = 0; j < 8; ++j) { v[j] = xr[64 * j]; s += (v[j].x * v[j].x + v[j].y * v[j].y) + (v[j].z * v[j].z + v[j].w * v[j].w); }
        const float rinv = rsqrtf(wave_sum(s) * (1.0f / DM) + EPS);
        GAS f32x4* o = (GAS f32x4*)(F.out + (r < MPROMPT ? O_YP + (size_t)r * DM : O_YS + (size_t)(r - MPROMPT) * DM)) + F.lane;
        const GAS f32x4* gp = (const GAS f32x4*)g + F.lane;
#pragma unroll
        for (int j = 0; j < 8; ++j) o[64 * j] = v[j] * rinv * gp[64 * j];
    }
}
typedef __bf16 bf16x2_t __attribute__((ext_vector_type(2)));
constexpr int HS_PITCH = 136;
template <bool FINAL>
__device__ __forceinline__ void s5_item(KArgs A, unsigned char* ws, float* out, int l, int item, LAS unsigned char* wl, int lane, unsigned* flags = nullptr) {
    const int c = item & 31, g = (item >> 5) & 31, b = item >> 10;
    const int lgp = (l * G_A + g) * P_A + lane;
    const f32x4 aq = *(const GAS f32x4*)((const float*)(ws + WS_SMALL + SM_S5A) + (size_t)lgp * 4);
    const float ar = aq.x, ai = aq.y;
    float br[16], bi[16];
    {   const GAS f32x4* bb = (const GAS f32x4*)((const float*)(ws + WS_SMALL + SM_S5BB) + (size_t)lgp * 32);
#pragma unroll
        for (int q = 0; q < 4; ++q) { const f32x4 v = bb[q]; br[4 * q] = v.x; br[4 * q + 1] = v.y; br[4 * q + 2] = v.z; br[4 * q + 3] = v.w;
                                      const f32x4 w = bb[4 + q]; bi[4 * q] = w.x; bi[4 * q + 1] = w.y; bi[4 * q + 2] = w.z; bi[4 * q + 3] = w.w; } }
    unsigned brp[8], bip[8];
#pragma unroll
    for (int k = 0; k < 8; ++k) { brp[k] = pk2(br[2 * k], br[2 * k + 1]); bip[k] = pk2(bi[2 * k], bi[2 * k + 1]); }
    const int row0 = b * SEQ + c * S5Q;
    const bf16* PROJ = (const bf16*)(ws + WS_BIG);
    const GAS v4u* up = (const GAS v4u*)(PROJ + (size_t)(row0 + lane) * N_INP + PC_UA + g * 16);
    const v4u u0 = up[0], u1 = up[1];
    LAS bf16* Us = (LAS bf16*)(wl + 8704);
    if (FINAL) { *(LAS v4u*)(Us + lane * 16) = u0; *(LAS v4u*)(Us + lane * 16 + 8) = u1; }
    float hr = 0.f, hi = 0.f;
    float* SLOC = (float*)(ws + WS_SMALL + SM_SLOC);
    if (FINAL && flags) {
        float lr = 0.f, li = 0.f;
#pragma unroll 2
        for (int t = 0; t < 64; ++t) {
            unsigned w[8];
            w[0] = __builtin_amdgcn_readlane(u0.x, t); w[1] = __builtin_amdgcn_readlane(u0.y, t); w[2] = __builtin_amdgcn_readlane(u0.z, t); w[3] = __builtin_amdgcn_readlane(u0.w, t);
            w[4] = __builtin_amdgcn_readlane(u1.x, t); w[5] = __builtin_amdgcn_readlane(u1.y, t); w[6] = __builtin_amdgcn_readlane(u1.z, t); w[7] = __builtin_amdgcn_readlane(u1.w, t);
            float sr0 = 0.f, si0 = 0.f, sr1 = 0.f, si1 = 0.f;
#pragma unroll
            for (int k = 0; k < 8; k += 2) {
                sr0 = __builtin_amdgcn_fdot2_f32_bf16(__builtin_bit_cast(bf16x2_t, brp[k]), __builtin_bit_cast(bf16x2_t, w[k]), sr0, false);
                si0 = __builtin_amdgcn_fdot2_f32_bf16(__builtin_bit_cast(bf16x2_t, bip[k]), __builtin_bit_cast(bf16x2_t, w[k]), si0, false);
                sr1 = __builtin_amdgcn_fdot2_f32_bf16(__builtin_bit_cast(bf16x2_t, brp[k + 1]), __builtin_bit_cast(bf16x2_t, w[k + 1]), sr1, false);
                si1 = __builtin_amdgcn_fdot2_f32_bf16(__builtin_bit_cast(bf16x2_t, bip[k + 1]), __builtin_bit_cast(bf16x2_t, w[k + 1]), si1, false); }
            const float nr = ar * lr - ai * li + (sr0 + sr1); li = ar * li + ai * lr + (si0 + si1); lr = nr;
        }
        float* sl = SLOC + (size_t)item * 128 + lane;
        __hip_atomic_store(sl, lr, __ATOMIC_RELAXED, __HIP_MEMORY_SCOPE_AGENT); __hip_atomic_store(sl + 64, li, __ATOMIC_RELAXED, __HIP_MEMORY_SCOPE_AGENT);
        asm volatile("s_waitcnt vmcnt(0)" ::: "memory");
        if (lane == 0) __hip_atomic_store(flags + item, 1u, __ATOMIC_RELAXED, __HIP_MEMORY_SCOPE_AGENT);
        {
            unsigned sp_ = 0;
            for (;;) { const unsigned f = lane < c ? __hip_atomic_load(flags + (item - c + lane), __ATOMIC_RELAXED, __HIP_MEMORY_SCOPE_AGENT) : 1u;
                if (__builtin_amdgcn_ballot_w64(f == 0u) == 0ull || ++sp_ > (1u << 20)) break; __builtin_amdgcn_s_sleep(1); }
            __builtin_amdgcn_fence(__ATOMIC_ACQUIRE, "agent"); }
        asm volatile("s_waitcnt vmcnt(0)" ::: "memory");
    }
    if (FINAL) {
        const float qr = aq.z, qi = aq.w;
        const float* sl = SLOC + (size_t)((b * G_A + g) * S5NC) * 128 + lane;
        float psr[31], psi[31];
#pragma unroll
        for (int k = 0; k < 31; ++k) { const int kk = k < c ? k : 0; psr[k] = sl[kk * 128]; psi[k] = sl[kk * 128 + 64]; }
#pragma unroll
        for (int k = 0; k < 31; ++k) if (k < c) { const float t = qr * hr - qi * hi + psr[k]; hi = qr * hi + qi * hr + psi[k]; hr = t; }
    }
    LAS bf16* Hs = (LAS bf16*)wl;
    bf16x8 cfr[4];
    if (FINAL) { const bf16* ct = (const bf16*)(ws + WS_SMALL + SM_S5CT) + (size_t)((l * G_A + g) * S5G + (lane & 15)) * 128 + 8 * (lane >> 4);
#pragma unroll
        for (int ks = 0; ks < 4; ++ks) cfr[ks] = *(const GAS bf16x8*)(ct + 32 * ks); }
#pragma unroll 1
    for (int half = 0; half < 2; ++half) {
#pragma unroll 2
        for (int tt = 0; tt < 32; ++tt) {
            const int t = half * 32 + tt;
            unsigned w[8];
            w[0] = __builtin_amdgcn_readlane(u0.x, t); w[1] = __builtin_amdgcn_readlane(u0.y, t); w[2] = __builtin_amdgcn_readlane(u0.z, t); w[3] = __builtin_amdgcn_readlane(u0.w, t);
            w[4] = __builtin_amdgcn_readlane(u1.x, t); w[5] = __builtin_amdgcn_readlane(u1.y, t); w[6] = __builtin_amdgcn_readlane(u1.z, t); w[7] = __builtin_amdgcn_readlane(u1.w, t);
            float sr0 = 0.f, si0 = 0.f, sr1 = 0.f, si1 = 0.f;
#pragma unroll
            for (int k = 0; k < 8; k += 2) {
                sr0 = __builtin_amdgcn_fdot2_f32_bf16(__builtin_bit_cast(bf16x2_t, brp[k]), __builtin_bit_cast(bf16x2_t, w[k]), sr0, false);
                si0 = __builtin_amdgcn_fdot2_f32_bf16(__builtin_bit_cast(bf16x2_t, bip[k]), __builtin_bit_cast(bf16x2_t, w[k]), si0, false);
                sr1 = __builtin_amdgcn_fdot2_f32_bf16(__builtin_bit_cast(bf16x2_t, brp[k + 1]), __builtin_bit_cast(bf16x2_t, w[k + 1]), sr1, false);
                si1 = __builtin_amdgcn_fdot2_f32_bf16(__builtin_bit_cast(bf16x2_t, bip[k + 1]), __builtin_bit_cast(bf16x2_t, w[k + 1]), si1, false); }
            const float sr = sr0 + sr1, si = si0 + si1;
            const float nr = ar * hr - ai * hi + sr; hi = ar * hi + ai * hr + si; hr = nr;
            if (FINAL) { Hs[tt * HS_PITCH + lane] = (bf16)f2bf(hr); Hs[tt * HS_PITCH + 64 + lane] = (bf16)f2bf(hi); }
        }
        if (FINAL) {
            bf16* YB = (bf16*)(ws + WS_YB);
            const float* dsk = A->in[I_S5D] + l * D_A + g * 16;
#pragma unroll
            for (int tile = 0; tile < 2; ++tile) {
                f32x4 acc = {0.f, 0.f, 0.f, 0.f};
#pragma unroll
                for (int ks = 0; ks < 4; ++ks) { const bf16x8 a = *(const LAS bf16x8*)(Hs + (tile * 16 + (lane & 15)) * HS_PITCH + 32 * ks + 8 * (lane >> 4));
                    acc = __builtin_amdgcn_mfma_f32_16x16x32_bf16(a, cfr[ks], acc, 0, 0, 0); }
                const int hh = lane & 15; const float dd = dsk[hh];
#pragma unroll
                for (int r = 0; r < 4; ++r) { const int row = row0 + half * 32 + tile * 16 + 4 * (lane >> 4) + r;
                    const float u = bf2f(Us[(row - row0) * 16 + hh]);
                    YB[(size_t)row * 512 + g * 16 + hh] = (bf16)f2bf(gelu_tanh(acc[r] + dd * u)); }
            }
        }
    }
    if (!FINAL) { float* sl = SLOC + (size_t)item * 128 + lane; sl[0] = hr; sl[64] = hi; }
    if (FINAL && c == S5NC - 1) { const size_t o = (size_t)((l * NB + b) * G_A + g) * P_A + lane; out[O_S5RP + o] = hr; out[O_S5IP + o] = hi; }
}

__device__ __forceinline__ void s5_sample_item(KArgs A, unsigned char* ws, float* out, int l, int item, int lane) {
    const int g = item & 31, s = item >> 5, row = MPROMPT + s;
    const int lgp = (l * G_A + g) * P_A + lane;
    const f32x4 aq = *(const GAS f32x4*)((const float*)(ws + WS_SMALL + SM_S5A) + (size_t)lgp * 4);
    const bf16* PROJ = (const bf16*)(ws + WS_BIG);
    const GAS v4u* up = (const GAS v4u*)(PROJ + (size_t)row * N_INP + PC_UA + g * 16);
    const v4u u0 = up[0], u1 = up[1];
    float u[16]; u[0] = bflo(u0.x); u[1] = bfhi(u0.x); u[2] = bflo(u0.y); u[3] = bfhi(u0.y); u[4] = bflo(u0.z); u[5] = bfhi(u0.z); u[6] = bflo(u0.w); u[7] = bfhi(u0.w);
    u[8] = bflo(u1.x); u[9] = bfhi(u1.x); u[10] = bflo(u1.y); u[11] = bfhi(u1.y); u[12] = bflo(u1.z); u[13] = bfhi(u1.z); u[14] = bflo(u1.w); u[15] = bfhi(u1.w);
    const GAS f32x4* bb = (const GAS f32x4*)((const float*)(ws + WS_SMALL + SM_S5BB) + (size_t)lgp * 32);
    float sr = 0.f, si = 0.f;
#pragma unroll
    for (int q = 0; q < 4; ++q) { const f32x4 v = bb[q], w = bb[4 + q];
        sr += v.x * u[4 * q] + v.y * u[4 * q + 1] + v.z * u[4 * q + 2] + v.w * u[4 * q + 3];
        si += w.x * u[4 * q] + w.y * u[4 * q + 1] + w.z * u[4 * q + 2] + w.w * u[4 * q + 3]; }
    const size_t so = (size_t)((l * NS + s) * G_A + g) * P_A + lane;
    const float h0r = A->in[I_S5RE][so], h0i = A->in[I_S5IM][so];
    const float hr = aq.x * h0r - aq.y * h0i + sr, hi = aq.x * h0i + aq.y * h0r + si;
    out[O_S5RS + so] = hr; out[O_S5IS + so] = hi;
    const float* cre = A->in[I_CRE] + (size_t)((l * G_A + g) * S5G) * P_A + lane; const float* cim = A->in[I_CIM] + (size_t)((l * G_A + g) * S5G) * P_A + lane;
    float y16[16];
#pragma unroll
    for (int hh = 0; hh < 16; ++hh) y16[hh] = cre[hh * P_A] * hr - cim[hh * P_A] * hi;
    const float mine = wave_sum16(y16, lane);
    if (lane < 16) { const float dd = A->in[I_S5D][l * D_A + g * 16 + lane]; float uu = 0.f;
#pragma unroll
        for (int hh = 0; hh < 16; ++hh) uu = (lane == hh) ? u[hh] : uu;
        ((bf16*)(ws + WS_YB))[(size_t)row * 512 + g * 16 + lane] = (bf16)f2bf(gelu_tanh(mine + dd * uu)); }
}
__device__ __forceinline__ void gmlp_sample_item(KArgs A, unsigned char* ws, float* out, int l, int s, int lane) {
    const int row = MPROMPT + s, ch0 = lane * 8;
    const bf16* PROJ = (const bf16*)(ws + WS_BIG);
    const v4u vv = *(const GAS v4u*)(PROJ + (size_t)row * N_INP + PC_VB + ch0), uu = *(const GAS v4u*)(PROJ + (size_t)row * N_INP + PC_UB + ch0);
    const float rinv = rsqrtf(((const float*)(ws + WS_SMALL + SM_VSQ))[l * MP + row] * (1.0f / D_B) + EPS);
    const int h = ch0 >> 6;
    const float w00 = A->in[I_WS][(size_t)(l * H_B + h) * 128 * 128], b0 = A->in[I_BS][(l * H_B + h) * 128];
    float v[8] = {bflo(vv.x), bfhi(vv.x), bflo(vv.y), bfhi(vv.y), bflo(vv.z), bfhi(vv.z), bflo(vv.w), bfhi(vv.w)};
    float u[8] = {bflo(uu.x), bfhi(uu.x), bflo(uu.y), bfhi(uu.y), bflo(uu.z), bfhi(uu.z), bflo(uu.w), bfhi(uu.w)};
    const float* gv = A->in[I_GV] + l * D_B + ch0;
    float o[8];
#pragma unroll
    for (int j = 0; j < 8; ++j) { const float vn = v[j] * rinv * gv[j]; out[O_GVS + (size_t)(l * NS + s) * D_B + ch0 + j] = vn; o[j] = u[j] * (w00 * vn + b0); }
    v4u w; w.x = pk2(o[0], o[1]); w.y = pk2(o[2], o[3]); w.z = pk2(o[4], o[5]); w.w = pk2(o[6], o[7]);
    *(GAS v4u*)((bf16*)(ws + WS_OB) + (size_t)row * 512 + ch0) = w;
}
__device__ __forceinline__ void ssd_sample_item(KArgs A, unsigned char* ws, float* out, int l, int item, int lane, bool acc) {
    const int h = item & 15, s = item >> 4, row = MPROMPT + s, g = h >> 3;
    const bf16* PROJ = (const bf16*)(ws + WS_BIG);
    const float* cw = A->in[I_CONVW] + (size_t)l * K_C * D_XBC; const float* cb = A->in[I_CONVB] + l * D_XBC;
    const float* cst = A->in[I_SSDCONV] + (size_t)(l * NS + s) * 3 * D_XBC;
    float* cso = out + O_CCS + (size_t)(l * NS + s) * 3 * D_XBC;
    float x;
    {   const int ch = h * 64 + lane; const float p0 = cst[ch], p1 = cst[D_XBC + ch], p2 = cst[2 * D_XBC + ch], p3 = bf2f(PROJ[(size_t)row * N_INP + PC_XBC + ch]);
        x = siluf_(cb[ch] + cw[ch] * p0 + cw[D_XBC + ch] * p1 + cw[2 * D_XBC + ch] * p2 + cw[3 * D_XBC + ch] * p3);
        cso[ch] = p1; cso[D_XBC + ch] = p2; cso[2 * D_XBC + ch] = p3; }
    const int n4 = (lane & 31) * 4; float Bv[4], Cv[4];
#pragma unroll
    for (int j = 0; j < 4; ++j) {
        {   const int ch = D_C + g * N_C + n4 + j; const float p0 = cst[ch], p1 = cst[D_XBC + ch], p2 = cst[2 * D_XBC + ch], p3 = bf2f(PROJ[(size_t)row * N_INP + PC_XBC + ch]);
            Bv[j] = siluf_(cb[ch] + cw[ch] * p0 + cw[D_XBC + ch] * p1 + cw[2 * D_XBC + ch] * p2 + cw[3 * D_XBC + ch] * p3);
            if ((h & 7) == 0 && lane < 32) { cso[ch] = p1; cso[D_XBC + ch] = p2; cso[2 * D_XBC + ch] = p3; } }
        {   const int ch = D_C + G_C * N_C + g * N_C + n4 + j; const float p0 = cst[ch], p1 = cst[D_XBC + ch], p2 = cst[2 * D_XBC + ch], p3 = bf2f(PROJ[(size_t)row * N_INP + PC_XBC + ch]);
            Cv[j] = siluf_(cb[ch] + cw[ch] * p0 + cw[D_XBC + ch] * p1 + cw[2 * D_XBC + ch] * p2 + cw[3 * D_XBC + ch] * p3);
            if ((h & 7) == 0 && lane < 32) { cso[ch] = p1; cso[D_XBC + ch] = p2; cso[2 * D_XBC + ch] = p3; } }
    }
    const float dt = softplusf_(((const float*)(ws + WS_SMALL + SM_DT))[(size_t)row * 16 + h] + A->in[I_DTBIAS][l * H_C + h]);
    const float dA = __expf(dt * -__expf(A->in[I_ALOG][l * H_C + h]));
    const size_t sbase = (size_t)((l * NS + s) * H_C + h) * HD_C * N_C;
    const GAS f32x4* st = (const GAS f32x4*)(A->in[I_SSM] + sbase) + lane;
    GAS f32x4* so = (GAS f32x4*)(out + O_SSMS + sbase) + lane;
    float part[32];
#pragma unroll
    for (int i = 0; i < 32; ++i) {
        const float xe = lane_bcast(x, 2 * i), xo = lane_bcast(x, 2 * i + 1); const float xv = lane < 32 ? xe : xo; const float xd = xv * dt;
        f32x4 v = __builtin_nontemporal_load(st + 64 * i);
        v.x = v.x * dA + xd * Bv[0]; v.y = v.y * dA + xd * Bv[1]; v.z = v.z * dA + xd * Bv[2]; v.w = v.w * dA + xd * Bv[3];
        __builtin_nontemporal_store(v, so + 64 * i);
        part[i] = v.x * Cv[0] + v.y * Cv[1] + v.z * Cv[2] + v.w * Cv[3];
    }
    const float ymine = half_sum32(part, lane);
    const float xmine = __builtin_bit_cast(float, __builtin_amdgcn_ds_bpermute((2 * (lane & 31) + (lane >> 5)) << 2, __builtin_bit_cast(int, x)));
    const int p = 2 * (lane & 31) + (lane >> 5), ch = h * 64 + p;
    const float y = ymine + A->in[I_SSDD][l * H_C + h] * xmine;
    const float z = bf2f(PROJ[(size_t)row * N_INP + PC_Z + ch]);
    const float yz = y * siluf_(z);
    const float sq = wave_sum(yz * yz);
    if (lane == 0 && acc) atomicAdd((float*)(ws + WS_SMALL + SM_CSQ) + l * MP + row, sq);
    ((bf16*)(ws + WS_OC))[(size_t)row * 1024 + ch] = (bf16)f2bf(yz * A->in[I_GNORM][l * D_C + ch]);
}
constexpr int TP = 136;
__device__ __forceinline__ void gmlp_item(KArgs A, unsigned char* ws, int l, int item, LAS unsigned char* lds, int tid, int wave, int lane) {
    const int h = item & 7, c = (item >> 3) & 15, b = item >> 7, row0 = b * SEQ + c * GMC;
    const bf16* PROJ = (const bf16*)(ws + WS_BIG);
    LAS bf16* vT = (LAS bf16*)lds;
    {   const int tok = tid >> 2, part = tid & 3, d0 = part * 16, row = row0 + tok;
        const float rinv = rsqrtf(((const float*)(ws + WS_SMALL + SM_VSQ))[l * MP + row] * (1.0f / D_B) + EPS);
        const GAS v4u* vp = (const GAS v4u*)(PROJ + (size_t)row * N_INP + PC_VB + h * 64 + d0);
        const v4u a = vp[0], b2 = vp[1];
        const float* gv = A->in[I_GV] + l * D_B + h * 64 + d0;
        const unsigned wv[8] = {a.x, a.y, a.z, a.w, b2.x, b2.y, b2.z, b2.w};
#pragma unroll
        for (int k = 0; k < 8; ++k) { vT[(d0 + 2 * k) * TP + tok] = (bf16)f2bf(bflo(wv[k]) * rinv * gv[2 * k]); vT[(d0 + 2 * k + 1) * TP + tok] = (bf16)f2bf(bfhi(wv[k]) * rinv * gv[2 * k + 1]); }
    }
    const bf16* WSb = (const bf16*)(ws + WS_SMALL + SM_WS) + (size_t)(l * H_B + h) * 128 * 128;
    bf16x8 afr[4];
#pragma unroll
    for (int ks = 0; ks < 4; ++ks) afr[ks] = *(const GAS bf16x8*)(WSb + (size_t)(16 * wave + (lane & 15)) * 128 + 32 * ks + 8 * (lane >> 4));
    __syncthreads();
    f32x4 acc[4];
#pragma unroll
    for (int t = 0; t < 4; ++t) acc[t] = (f32x4){0.f, 0.f, 0.f, 0.f};
    const int nks = (wave >> 1) + 1;
#pragma unroll
    for (int ks = 0; ks < 4; ++ks) if (ks < nks) {
#pragma unroll
        for (int t = 0; t < 4; ++t) { const bf16x8 bfr = *(const LAS bf16x8*)(vT + (16 * t + (lane & 15)) * TP + 32 * ks + 8 * (lane >> 4));
            acc[t] = __builtin_amdgcn_mfma_f32_16x16x32_bf16(afr[ks], bfr, acc[t], 0, 0, 0); }
    }
    bf16* OB = (bf16*)(ws + WS_OB);
#pragma unroll
    for (int r = 0; r < 4; ++r) { const int i = 16 * wave + 4 * (lane >> 4) + r, row = row0 + i; const float bs = A->in[I_BS][(l * H_B + h) * 128 + i];
#pragma unroll
        for (int t = 0; t < 4; ++t) { const int ch = h * 64 + 16 * t + (lane & 15);
            const float u = bf2f(PROJ[(size_t)row * N_INP + PC_UB + ch]);
            OB[(size_t)row * 512 + ch] = (bf16)f2bf(u * (acc[t][r] + bs)); } }
    __syncthreads();
}

template <int NCH, bool TRANS>
__device__ __forceinline__ void conv_tile(KArgs A, const bf16* PROJ, int l, int b, int c, int chb, LAS bf16* tile, const LAS float* scale, int tid) {
    constexpr int LPR = NCH / 8, SLOTS = NTHR / LPR, TPT = 128 / SLOTS;
    const int cl = tid % LPR, slot = tid / LPR, ch0 = chb + cl * 8, t0 = slot * TPT;
    const float* cw = A->in[I_CONVW] + (size_t)l * K_C * D_XBC + ch0; const float* cb = A->in[I_CONVB] + l * D_XBC + ch0;
    float w[4][8], bias[8];
#pragma unroll
    for (int k = 0; k < 4; ++k) { const f32x4 a = *(const GAS f32x4*)(cw + k * D_XBC), b2 = *(const GAS f32x4*)(cw + k * D_XBC + 4);
        w[k][0] = a.x; w[k][1] = a.y; w[k][2] = a.z; w[k][3] = a.w; w[k][4] = b2.x; w[k][5] = b2.y; w[k][6] = b2.z; w[k][7] = b2.w; }
    {   const f32x4 a = *(const GAS f32x4*)cb, b2 = *(const GAS f32x4*)(cb + 4); bias[0] = a.x; bias[1] = a.y; bias[2] = a.z; bias[3] = a.w; bias[4] = b2.x; bias[5] = b2.y; bias[6] = b2.z; bias[7] = b2.w; }
    const int trow0 = c * SSDQ + t0;
    v4u raw[TPT + 3];
#pragma unroll
    for (int i = 0; i < TPT + 3; ++i) { const int tt = trow0 - 3 + i;
        raw[i] = tt >= 0 ? *(const GAS v4u*)(PROJ + (size_t)(b * SEQ + tt) * N_INP + PC_XBC + ch0) : (v4u){0u, 0u, 0u, 0u}; }
    float o[TPT][8];
#pragma unroll
    for (int t = 0; t < TPT; ++t) {
#pragma unroll
        for (int e = 0; e < 8; ++e) o[t][e] = bias[e];
#pragma unroll
        for (int k = 0; k < 4; ++k) { const v4u r = raw[t + k]; const unsigned rw[4] = {r.x, r.y, r.z, r.w};
#pragma unroll
            for (int e2 = 0; e2 < 4; ++e2) { o[t][2 * e2] = fmaf(w[k][2 * e2], bflo(rw[e2]), o[t][2 * e2]); o[t][2 * e2 + 1] = fmaf(w[k][2 * e2 + 1], bfhi(rw[e2]), o[t][2 * e2 + 1]); } }
        const float sc = scale ? scale[t0 + t] : 1.0f;
#pragma unroll
        for (int e = 0; e < 8; ++e) o[t][e] = siluf_(o[t][e]) * sc;
    }
    if (!TRANS) {
#pragma unroll
        for (int t = 0; t < TPT; ++t) { v4u wv; wv.x = pk2(o[t][0], o[t][1]); wv.y = pk2(o[t][2], o[t][3]); wv.z = pk2(o[t][4], o[t][5]); wv.w = pk2(o[t][6], o[t][7]);
            *(LAS v4u*)(tile + (t0 + t) * TP + cl * 8) = wv; }
    } else {
#pragma unroll
        for (int e = 0; e < 8; ++e) {
            if (TPT == 4) { v2u wv; wv.x = pk2(o[0][e], o[1][e]); wv.y = pk2(o[TPT > 2 ? 2 : 0][e], o[TPT > 3 ? 3 : 0][e]); *(LAS v2u*)(tile + (cl * 8 + e) * TP + t0) = wv; }
            else { *(LAS unsigned*)(tile + (cl * 8 + e) * TP + t0) = pk2(o[0][e], o[1][e]); }
        }
    }
}

__device__ __forceinline__ void ssd_dt_scan(KArgs A, unsigned char* ws, int l, int b, int c, int h, LAS float* dtv, LAS float* cs, int tid, int lane) {
    if (tid < 64) {
        const float* DT = (const float*)(ws + WS_SMALL + SM_DT); const float bias = A->in[I_DTBIAS][l * H_C + h], a = -__expf(A->in[I_ALOG][l * H_C + h]);
        const int row = b * SEQ + c * SSDQ + 2 * lane;
        const float d0 = softplusf_(DT[(size_t)row * 16 + h] + bias), d1 = softplusf_(DT[(size_t)(row + 1) * 16 + h] + bias);
        const float v0 = d0 * a, v1 = d1 * a; float s = v0 + v1;
#pragma unroll
        for (int o = 1; o < 64; o <<= 1) { const float t = __builtin_bit_cast(float, __builtin_amdgcn_ds_bpermute((lane - o) << 2, __builtin_bit_cast(int, s))); if (lane >= o) s += t; }
        dtv[2 * lane] = d0; dtv[2 * lane + 1] = d1; cs[2 * lane] = s - v1; cs[2 * lane + 1] = s;
    }
    __syncthreads();
}

constexpr int SL_CN = 0, SL_BN = 34816, SL_MW = 69632, SL_XT = 104448, SL_HP = 121856, SL_DT = 139264, SL_CS = SL_DT + 512, SL_SC = SL_CS + 512, SL_END = SL_SC + 512;

__device__ __forceinline__ void ssd_item1(KArgs A, unsigned char* ws, int l, int item, LAS unsigned char* lds, int tid, int wave, int lane) {
    const int h = item & 15, c = (item >> 4) & 15, b = item >> 8, g = h >> 3;
    const bf16* PROJ = (const bf16*)(ws + WS_BIG);
    LAS float* dtv = (LAS float*)(lds + SL_DT); LAS float* cs = (LAS float*)(lds + SL_CS); LAS float* sc = (LAS float*)(lds + SL_SC);
    LAS bf16* Xt = (LAS bf16*)(lds + SL_XT); LAS bf16* Bt = (LAS bf16*)(lds + SL_BN);
    (void)sc;
    conv_tile<64, true>(A, PROJ, l, b, c, h * 64, Xt, nullptr, tid);
    conv_tile<128, true>(A, PROJ, l, b, c, D_C + g * N_C, Bt, nullptr, tid);
    ssd_dt_scan(A, ws, l, b, c, h, dtv, cs, tid, lane);
    f32x4 acc[4];
#pragma unroll
    for (int t = 0; t < 4; ++t) acc[t] = (f32x4){0.f, 0.f, 0.f, 0.f};
    const float cse = cs[127];
#pragma unroll
    for (int ks = 0; ks < 4; ++ks) { const int j0 = 32 * ks + 8 * (lane >> 4);
        const v4u braw = *(const LAS v4u*)(Bt + (16 * wave + (lane & 15)) * TP + j0);
        const f32x4 d0 = *(const LAS f32x4*)(dtv + j0), d1 = *(const LAS f32x4*)(dtv + j0 + 4), c0 = *(const LAS f32x4*)(cs + j0), c1 = *(const LAS f32x4*)(cs + j0 + 4);
        v4u bs;
        bs.x = pk2(bflo(braw.x) * d0.x * __expf(cse - c0.x), bfhi(braw.x) * d0.y * __expf(cse - c0.y)); bs.y = pk2(bflo(braw.y) * d0.z * __expf(cse - c0.z), bfhi(braw.y) * d0.w * __expf(cse - c0.w));
        bs.z = pk2(bflo(braw.z) * d1.x * __expf(cse - c1.x), bfhi(braw.z) * d1.y * __expf(cse - c1.y)); bs.w = pk2(bflo(braw.w) * d1.z * __expf(cse - c1.z), bfhi(braw.w) * d1.w * __expf(cse - c1.w));
        const bf16x8 bfr = __builtin_bit_cast(bf16x8, bs);
#pragma unroll
        for (int t = 0; t < 4; ++t) { const bf16x8 af = *(const LAS bf16x8*)(Xt + (16 * t + (lane & 15)) * TP + 32 * ks + 8 * (lane >> 4));
            acc[t] = __builtin_amdgcn_mfma_f32_16x16x32_bf16(af, bfr, acc[t], 0, 0, 0); } }
    float* ST = (float*)(ws + WS_STATES) + (size_t)item * HD_C * N_C;
#pragma unroll
    for (int t = 0; t < 4; ++t)
#pragma unroll
        for (int r = 0; r < 4; ++r) ST[(size_t)(16 * t + 4 * (lane >> 4) + r) * N_C + 16 * wave + (lane & 15)] = acc[t][r];
    if (tid == 0) ((float*)(ws + WS_SMALL + SM_SDEC))[item] = __expf(cs[127]);
    __syncthreads();
}

__device__ __forceinline__ void ssd_item2(KArgs A, unsigned char* ws, float* out, int l, int item, LAS unsigned char* lds, int tid, int wave, int lane, bool acc) {
    const int h = item & 15, c = (item >> 4) & 15, b = item >> 8, g = h >> 3, row0 = b * SEQ + c * SSDQ;
    const bf16* PROJ = (const bf16*)(ws + WS_BIG);
    LAS float* dtv = (LAS float*)(lds + SL_DT); LAS float* cs = (LAS float*)(lds + SL_CS);
    LAS bf16* Cn = (LAS bf16*)(lds + SL_CN); LAS bf16* Bn = (LAS bf16*)(lds + SL_BN); LAS bf16* Mw = (LAS bf16*)(lds + SL_MW);
    LAS bf16* Xt = (LAS bf16*)(lds + SL_XT); LAS bf16* Hp = (LAS bf16*)(lds + SL_HP);
    conv_tile<64, true>(A, PROJ, l, b, c, h * 64, Xt, nullptr, tid);
    conv_tile<128, false>(A, PROJ, l, b, c, D_C + g * N_C, Bn, nullptr, tid);
    conv_tile<128, false>(A, PROJ, l, b, c, D_C + G_C * N_C + g * N_C, Cn, nullptr, tid);
    {   const float* ST = (const float*)(ws + WS_STATES) + (size_t)((b * 16) * 16 + h) * HD_C * N_C + tid * 4;
        const float* SD = (const float*)(ws + WS_SMALL + SM_SDEC) + (b * 16) * 16 + h;
        f32x4 hv[4];
#pragma unroll
        for (int k = 0; k < 4; ++k) hv[k] = (f32x4){0.f, 0.f, 0.f, 0.f};
        int cc = 0;
        for (; cc + 4 <= c; cc += 4) { f32x4 sv[4][4]; float d[4];
#pragma unroll
            for (int q = 0; q < 4; ++q) { d[q] = SD[(cc + q) * 16];
#pragma unroll
                for (int k = 0; k < 4; ++k) sv[q][k] = *(const GAS f32x4*)(ST + (size_t)(cc + q) * 16 * 8192 + 2048 * k); }
#pragma unroll
            for (int q = 0; q < 4; ++q)
#pragma unroll
                for (int k = 0; k < 4; ++k) hv[k] = hv[k] * d[q] + sv[q][k]; }
        for (; cc < c; ++cc) { const float d = SD[cc * 16];
#pragma unroll
            for (int k = 0; k < 4; ++k) hv[k] = hv[k] * d + *(const GAS f32x4*)(ST + (size_t)cc * 16 * 8192 + 2048 * k); }
#pragma unroll
        for (int k = 0; k < 4; ++k) { v2u wv; wv.x = pk2(hv[k].x, hv[k].y); wv.y = pk2(hv[k].z, hv[k].w); *(LAS v2u*)(Hp + ((tid >> 5) + 16 * k) * TP + (tid & 31) * 4) = wv; }
        if (c == SSDNC - 1) { const float d = SD[c * 16]; float* o = out + O_SSMP + (size_t)((l * NB + b) * H_C + h) * HD_C * N_C + tid * 4;
#pragma unroll
            for (int k = 0; k < 4; ++k) *(GAS f32x4*)(o + 2048 * k) = hv[k] * d + *(const GAS f32x4*)(ST + (size_t)c * 16 * 8192 + 2048 * k); }
    }
    ssd_dt_scan(A, ws, l, b, c, h, dtv, cs, tid, lane);
    bf16x8 cf[4];
#pragma unroll
    for (int ks = 0; ks < 4; ++ks) cf[ks] = *(const LAS bf16x8*)(Cn + (16 * wave + (lane & 15)) * TP + 32 * ks + 8 * (lane >> 4));
    const int jtmax = wave | 1;
    for (int jt = 0; jt <= jtmax; ++jt) {
        f32x4 gacc = {0.f, 0.f, 0.f, 0.f};
        if (jt <= wave) {
#pragma unroll
            for (int ks = 0; ks < 4; ++ks) { const bf16x8 bfr = *(const LAS bf16x8*)(Bn + (16 * jt + (lane & 15)) * TP + 32 * ks + 8 * (lane >> 4));
                gacc = __builtin_amdgcn_mfma_f32_16x16x32_bf16(cf[ks], bfr, gacc, 0, 0, 0); }
        }
        const int j = 16 * jt + (lane & 15); const float csj = cs[j], dtj = dtv[j];
#pragma unroll
        for (int r = 0; r < 4; ++r) { const int i = 16 * wave + 4 * (lane >> 4) + r;
            const float m = (j <= i) ? gacc[r] * __expf(cs[i] - csj) * dtj : 0.f;
            Mw[i * TP + j] = (bf16)f2bf(m); }
    }
    f32x4 yd[4], yo[4];
#pragma unroll
    for (int t = 0; t < 4; ++t) { yd[t] = (f32x4){0.f, 0.f, 0.f, 0.f}; yo[t] = (f32x4){0.f, 0.f, 0.f, 0.f}; }
    const int nks = (wave >> 1) + 1;
    for (int ks = 0; ks < nks; ++ks) { const bf16x8 mf = *(const LAS bf16x8*)(Mw + (16 * wave + (lane & 15)) * TP + 32 * ks + 8 * (lane >> 4));
#pragma unroll
        for (int t = 0; t < 4; ++t) { const bf16x8 xf = *(const LAS bf16x8*)(Xt + (16 * t + (lane & 15)) * TP + 32 * ks + 8 * (lane >> 4));
            yd[t] = __builtin_amdgcn_mfma_f32_16x16x32_bf16(mf, xf, yd[t], 0, 0, 0); } }
#pragma unroll
    for (int ks = 0; ks < 4; ++ks)
#pragma unroll
        for (int t = 0; t < 4; ++t) { const bf16x8 hf = *(const LAS bf16x8*)(Hp + (16 * t + (lane & 15)) * TP + 32 * ks + 8 * (lane >> 4));
            yo[t] = __builtin_amdgcn_mfma_f32_16x16x32_bf16(cf[ks], hf, yo[t], 0, 0, 0); }
    const float dsk = A->in[I_SSDD][l * H_C + h];
    bf16* OC = (bf16*)(ws + WS_OC); float* csq = (float*)(ws + WS_SMALL + SM_CSQ) + l * MP;
#pragma unroll
    for (int r = 0; r < 4; ++r) { const int i = 16 * wave + 4 * (lane >> 4) + r, row = row0 + i; const float ecs = __expf(cs[i]); float sq = 0.f;
#pragma unroll
        for (int t = 0; t < 4; ++t) { const int p = 16 * t + (lane & 15), ch = h * 64 + p;
            const float x = bf2f(Xt[p * TP + i]);
            const float y = yd[t][r] + ecs * yo[t][r] + dsk * x;
            const float z = bf2f(PROJ[(size_t)row * N_INP + PC_Z + ch]);
            const float yz = y * siluf_(z); sq += yz * yz;
            OC[(size_t)row * 1024 + ch] = (bf16)f2bf(yz * A->in[I_GNORM][l * D_C + ch]); }
        sq += xor_lt32<1>(sq); sq += xor_lt32<2>(sq); sq += xor_lt32<4>(sq); sq += xor_lt32<8>(sq);
        if ((lane & 15) == 0 && acc) atomicAdd(csq + row, sq); }
    __syncthreads();
}

__device__ __forceinline__ void ssd_item_fused(KArgs A, unsigned char* ws, float* out, int l, int item, LAS unsigned char* lds, int tid, int wave, int lane, bool acc, unsigned* flags) {
    const int h = item & 15, c = (item >> 4) & 15, b = item >> 8, g = h >> 3, row0 = b * SEQ + c * SSDQ;
    const bf16* PROJ = (const bf16*)(ws + WS_BIG);
    LAS float* dtv = (LAS float*)(lds + SL_DT); LAS float* cs = (LAS float*)(lds + SL_CS);
    LAS bf16* Cn = (LAS bf16*)(lds + SL_CN); LAS bf16* Bn = (LAS bf16*)(lds + SL_BN); LAS bf16* Mw = (LAS bf16*)(lds + SL_MW);
    LAS bf16* Xt = (LAS bf16*)(lds + SL_XT); LAS bf16* Hp = (LAS bf16*)(lds + SL_HP);
    conv_tile<64, true>(A, PROJ, l, b, c, h * 64, Xt, nullptr, tid);
    conv_tile<128, false>(A, PROJ, l, b, c, D_C + g * N_C, Bn, nullptr, tid);
    conv_tile<128, true>(A, PROJ, l, b, c, D_C + g * N_C, Mw, nullptr, tid);
    conv_tile<128, false>(A, PROJ, l, b, c, D_C + G_C * N_C + g * N_C, Cn, nullptr, tid);
    bf16 zz[4][4];
#pragma unroll
    for (int r = 0; r < 4; ++r)
#pragma unroll
        for (int t = 0; t < 4; ++t) zz[r][t] = PROJ[(size_t)(row0 + 16 * wave + 4 * (lane >> 4) + r) * N_INP + PC_Z + h * 64 + 16 * t + (lane & 15)];
    ssd_dt_scan(A, ws, l, b, c, h, dtv, cs, tid, lane);
    {   f32x4 sacc[4];
#pragma unroll
        for (int t = 0; t < 4; ++t) sacc[t] = (f32x4){0.f, 0.f, 0.f, 0.f};
        const float cse = cs[127];
#pragma unroll
        for (int ks = 0; ks < 4; ++ks) { const int j0 = 32 * ks + 8 * (lane >> 4);
            const v4u braw = *(const LAS v4u*)(Mw + (16 * wave + (lane & 15)) * TP + j0);
            const f32x4 d0 = *(const LAS f32x4*)(dtv + j0), d1 = *(const LAS f32x4*)(dtv + j0 + 4), c0 = *(const LAS f32x4*)(cs + j0), c1 = *(const LAS f32x4*)(cs + j0 + 4);
            v4u bs;
            bs.x = pk2(bflo(braw.x) * d0.x * __expf(cse - c0.x), bfhi(braw.x) * d0.y * __expf(cse - c0.y)); bs.y = pk2(bflo(braw.y) * d0.z * __expf(cse - c0.z), bfhi(braw.y) * d0.w * __expf(cse - c0.w));
            bs.z = pk2(bflo(braw.z) * d1.x * __expf(cse - c1.x), bfhi(braw.z) * d1.y * __expf(cse - c1.y)); bs.w = pk2(bflo(braw.w) * d1.z * __expf(cse - c1.z), bfhi(braw.w) * d1.w * __expf(cse - c1.w));
            const bf16x8 bfr = __builtin_bit_cast(bf16x8, bs);
#pragma unroll
            for (int t = 0; t < 4; ++t) { const bf16x8 af = *(const LAS bf16x8*)(Xt + (16 * t + (lane & 15)) * TP + 32 * ks + 8 * (lane >> 4));
                sacc[t] = __builtin_amdgcn_mfma_f32_16x16x32_bf16(bfr, af, sacc[t], 0, 0, 0); } }
        {   const __amdgpu_buffer_rsrc_t srs = __builtin_amdgcn_make_buffer_rsrc((void*)((float*)(ws + WS_STATES) + (size_t)item * HD_C * N_C), (short)0, HD_C * N_C * 4, 0x00020000);
#pragma unroll
            for (int t = 0; t < 4; ++t) __builtin_amdgcn_raw_buffer_store_b128(__builtin_bit_cast(v4u, sacc[t]), srs, (unsigned)((16 * t + (lane & 15)) * N_C + 16 * wave + 4 * (lane >> 4)) * 4u, 0,   16); }
        if (tid == 0) __hip_atomic_store((float*)(ws + WS_SMALL + SM_SDEC) + item, __expf(cse), __ATOMIC_RELAXED, __HIP_MEMORY_SCOPE_AGENT);
        asm volatile("s_waitcnt vmcnt(0)" ::: "memory"); __syncthreads();
        if (tid == 0) __hip_atomic_store(flags + item, 1u, __ATOMIC_RELAXED, __HIP_MEMORY_SCOPE_AGENT);
    }
    bf16x8 cf[4];
#pragma unroll
    for (int ks = 0; ks < 4; ++ks) cf[ks] = *(const LAS bf16x8*)(Cn + (16 * wave + (lane & 15)) * TP + 32 * ks + 8 * (lane >> 4));
    const int jtmax = wave | 1;
    for (int jt = 0; jt <= jtmax; ++jt) {
        f32x4 gacc = {0.f, 0.f, 0.f, 0.f};
        if (jt <= wave) {
#pragma unroll
            for (int ks = 0; ks < 4; ++ks) { const bf16x8 bfr = *(const LAS bf16x8*)(Bn + (16 * jt + (lane & 15)) * TP + 32 * ks + 8 * (lane >> 4));
                gacc = __builtin_amdgcn_mfma_f32_16x16x32_bf16(cf[ks], bfr, gacc, 0, 0, 0); }
        }
        const int j = 16 * jt + (lane & 15); const float csj = cs[j], dtj = dtv[j];
#pragma unroll
        for (int r = 0; r < 4; ++r) { const int i = 16 * wave + 4 * (lane >> 4) + r;
            const float m = (j <= i) ? gacc[r] * __expf(cs[i] - csj) * dtj : 0.f;
            Mw[i * TP + j] = (bf16)f2bf(m); }
    }
    f32x4 yd[4], yo[4];
#pragma unroll
    for (int t = 0; t < 4; ++t) { yd[t] = (f32x4){0.f, 0.f, 0.f, 0.f}; yo[t] = (f32x4){0.f, 0.f, 0.f, 0.f}; }
    const int nks = (wave >> 1) + 1;
    for (int ks = 0; ks < nks; ++ks) { const bf16x8 mf = *(const LAS bf16x8*)(Mw + (16 * wave + (lane & 15)) * TP + 32 * ks + 8 * (lane >> 4));
#pragma unroll
        for (int t = 0; t < 4; ++t) { const bf16x8 xf = *(const LAS bf16x8*)(Xt + (16 * t + (lane & 15)) * TP + 32 * ks + 8 * (lane >> 4));
            yd[t] = __builtin_amdgcn_mfma_f32_16x16x32_bf16(mf, xf, yd[t], 0, 0, 0); } }
    if (tid < 64) {
        unsigned sp_ = 0;
        for (;;) { const unsigned f = lane < c ? __hip_atomic_load(flags + ((b * 16 + lane) * 16 + h), __ATOMIC_RELAXED, __HIP_MEMORY_SCOPE_AGENT) : 1u;
            if (__builtin_amdgcn_ballot_w64(f == 0u) == 0ull || ++sp_ > (1u << 20)) break; __builtin_amdgcn_s_sleep(1); }
        __builtin_amdgcn_fence(__ATOMIC_ACQUIRE, "agent"); asm volatile("s_waitcnt vmcnt(0)" ::: "memory"); }
    __syncthreads();
    {   const float* ST = (const float*)(ws + WS_STATES) + (size_t)((b * 16) * 16 + h) * HD_C * N_C + tid * 4;
        const float* SD = (const float*)(ws + WS_SMALL + SM_SDEC) + (b * 16) * 16 + h;
        f32x4 hv[4];
#pragma unroll
        for (int k = 0; k < 4; ++k) hv[k] = (f32x4){0.f, 0.f, 0.f, 0.f};
        for (int cc = 0; cc < c; cc += 4) { f32x4 sv[4][4]; float d[4];
#pragma unroll
            for (int q = 0; q < 4; ++q) { const int cq = cc + q < c ? cc + q : c - 1; d[q] = SD[cq * 16];
#pragma unroll
                for (int k = 0; k < 4; ++k) sv[q][k] = *(const GAS f32x4*)(ST + (size_t)cq * 16 * 8192 + 2048 * k); }
#pragma unroll
            for (int q = 0; q < 4; ++q) if (cc + q < c) {
#pragma unroll
                for (int k = 0; k < 4; ++k) hv[k] = hv[k] * d[q] + sv[q][k]; } }
#pragma unroll
        for (int k = 0; k < 4; ++k) { v2u wv; wv.x = pk2(hv[k].x, hv[k].y); wv.y = pk2(hv[k].z, hv[k].w); *(LAS v2u*)(Hp + ((tid >> 5) + 16 * k) * TP + (tid & 31) * 4) = wv; }
        if (c == SSDNC - 1) { const float d = SD[c * 16]; float* o = out + O_SSMP + (size_t)((l * NB + b) * H_C + h) * HD_C * N_C + tid * 4;
#pragma unroll
            for (int k = 0; k < 4; ++k) *(GAS f32x4*)(o + 2048 * k) = hv[k] * d + *(const GAS f32x4*)(ST + (size_t)c * 16 * 8192 + 2048 * k); }
    }
    __syncthreads();
#pragma unroll
    for (int ks = 0; ks < 4; ++ks)
#pragma unroll
        for (int t = 0; t < 4; ++t) { const bf16x8 hf = *(const LAS bf16x8*)(Hp + (16 * t + (lane & 15)) * TP + 32 * ks + 8 * (lane >> 4));
            yo[t] = __builtin_amdgcn_mfma_f32_16x16x32_bf16(cf[ks], hf, yo[t], 0, 0, 0); }
    const float dsk = A->in[I_SSDD][l * H_C + h];
    bf16* OC = (bf16*)(ws + WS_OC); float* csq = (float*)(ws + WS_SMALL + SM_CSQ) + l * MP;
#pragma unroll
    for (int r = 0; r < 4; ++r) { const int i = 16 * wave + 4 * (lane >> 4) + r, row = row0 + i; const float ecs = __expf(cs[i]); float sq = 0.f;
#pragma unroll
        for (int t = 0; t < 4; ++t) { const int p = 16 * t + (lane & 15), ch = h * 64 + p;
            const float x = bf2f(Xt[p * TP + i]);
            const float y = yd[t][r] + ecs * yo[t][r] + dsk * x;
            const float z = bf2f(zz[r][t]);
            const float yz = y * siluf_(z); sq += yz * yz;
            OC[(size_t)row * 1024 + ch] = (bf16)f2bf(yz * A->in[I_GNORM][l * D_C + ch]); }
        sq += xor_lt32<1>(sq); sq += xor_lt32<2>(sq); sq += xor_lt32<4>(sq); sq += xor_lt32<8>(sq);
        if ((lane & 15) == 0 && acc) atomicAdd(csq + row, sq); }
    __syncthreads();
}
__device__ __forceinline__ void phase_upfix(const Frame& F0, KArgs A, int l) {
    Frame F = launder(F0);
    const float* HALO = WSP(const float, WS_HALO); bf16* ACT = WSP(bf16, WS_T);
    const float* cw = A->in[I_FCONVW] + (size_t)l * K_F * D_UP; const float* cb = A->in[I_FCONVB] + (size_t)l * D_UP;
    const int gt = blockIdx.x * NTHR + F.tid, NT = GRID * NTHR;
    for (int i = gt; i < 32 * D_FF; i += NT) { const int ch = i % D_FF, pm = i / D_FF; if ((pm & 7) == 0) continue;
        const int ca_ = 256 * (ch / 128) + ch % 128, cb_ = ca_ + 128;
        const float* hp = HALO + ((size_t)(pm - 1) * 4 + 2) * D_UP; const float* hc = HALO + (size_t)pm * 4 * D_UP;
        const float am2 = hp[ca_], am1 = hp[D_UP + ca_], a0 = hc[ca_], a1 = hc[D_UP + ca_], bm2 = hp[cb_], bm1 = hp[D_UP + cb_], b0 = hc[cb_], b1 = hc[D_UP + cb_];
        const float wa0 = cw[ch], wa1 = cw[D_UP + ch], wa2 = cw[2 * D_UP + ch], wb0 = cw[D_FF + ch], wb1 = cw[D_UP + D_FF + ch], wb2 = cw[2 * D_UP + D_FF + ch], ba = cb[ch], bb = cb[D_FF + ch];
        const float r0 = siluf_(ba + wa0 * am2 + wa1 * am1 + wa2 * a0) * (bb + wb0 * bm2 + wb1 * bm1 + wb2 * b0);
        const float r1 = siluf_(ba + wa0 * am1 + wa1 * a0 + wa2 * a1) * (bb + wb0 * bm1 + wb1 * b0 + wb2 * b1);
        ACT[(size_t)(pm * 256) * D_FF + ch] = (bf16)f2bf(r0); ACT[(size_t)(pm * 256 + 1) * D_FF + ch] = (bf16)f2bf(r1); }
    for (int i = gt; i < NB * 2 * D_UP; i += NT) { const int oc = i % D_UP, k = (i / D_UP) & 1, b = i / (2 * D_UP);
        const int c = oc < D_FF ? 256 * (oc / 128) + oc % 128 : 256 * ((oc - D_FF) / 128) + 128 + (oc - D_FF) % 128;
        F.out[O_CFP + (size_t)l * NB * 2 * D_UP + i] = HALO[((size_t)(8 * b + 7) * 4 + 2 + k) * D_UP + c]; }
}
__device__ __forceinline__ void ssd_conv_p_out(const Frame& F0, int l) {
    Frame F = launder(F0);
    const bf16* PROJ = WSP(const bf16, WS_BIG);
    const int gt = blockIdx.x * NTHR + F.tid, NT = GRID * NTHR;
    for (int i = gt; i < NB * 3 * D_XBC; i += NT) { const int ch = i % D_XBC, k = (i / D_XBC) % 3, b = i / (3 * D_XBC);
        F.out[O_CCP + (size_t)l * NB * 3 * D_XBC + i] = bf2f(PROJ[(size_t)(b * SEQ + SEQ - 3 + k) * N_INP + PC_XBC + ch]); }
}

__device__ __forceinline__ void phase_mix1(const Frame& F0, KArgs A, int l, bool acc) {
    {   Frame F = launder(F0);
        for (int it = F.gw; it < NS * G_A; it += (GRID * NWAVES)) s5_sample_item(A, F.ws, F.out, l, it, F.lane); }
    {   Frame F = launder(F0);
        for (int it = F.gw; it < NS; it += (GRID * NWAVES)) gmlp_sample_item(A, F.ws, F.out, l, it, F.lane); }
    {   Frame F = launder(F0);
        for (int it = F.gw; it < NS * H_C; it += (GRID * NWAVES)) ssd_sample_item(A, F.ws, F.out, l, it, F.lane, acc); }
    ssd_conv_p_out(F0, l);
}
__device__ __forceinline__ void phase_mix2(const Frame& F0, KArgs A, int l, bool acc) {
#ifndef REP_SSD2
#define REP_SSD2 1
#endif
#ifndef REP_GMLP
#define REP_GMLP 1
#endif
#ifndef REP_S5F
#define REP_S5F 1
#endif
    _Pragma("unroll 1") for (int r2 = 0; r2 < REP_SSD2; ++r2) {   Frame F = launder(F0);
        for (int it = blockIdx.x; it < NB * SSDNC * H_C; it += GRID) ssd_item_fused(A, F.ws, F.out, l, it, F.lds, F.tid, F.wave, F.lane, acc && r2 == 0, (unsigned*)(F.ws + WS_CTL) + CW_SSDF + l * 1024); }
    _Pragma("unroll 1") for (int r2 = 0; r2 < REP_GMLP; ++r2) {   Frame F = launder(F0);
        for (int it = blockIdx.x; it < NB * (SEQ / GMC) * H_B; it += GRID) gmlp_item(A, F.ws, l, it, F.lds, F.tid, F.wave, F.lane); }
    _Pragma("unroll 1") for (int r2 = 0; r2 < REP_S5F; ++r2) {   Frame F = launder(F0);
        for (int it = F.gw; it < NB * G_A * S5NC; it += (GRID * NWAVES)) s5_item<true>(A, F.ws, F.out, l, it, F.lds + F.wave * 10752, F.lane, (unsigned*)(F.ws + WS_CTL) + CW_S5F + l * 4096); }
}

constexpr int LDS_BYTES = 147456, MISC_OFF = 147456 - 256;
#ifndef GEMM_SP2
#define GEMM_SP2 true
#endif
template <class Epi>
__device__ __forceinline__ void run_gemm(const Frame& F, const bf16* Am, const bf16* Bt, int M, int N, int K, const Epi& E) {
    pg8::Gemm g{Am, Bt, M, N, K}; pg8::StaticOrder S; S.init(M, N, GRID, (int)blockIdx.x, K);
    pg8::gemm_phase<Epi, pg8::StaticOrder, true, GEMM_SP2>(F.lds, g, S, E);
}
struct SplitSched {
    pg8::StaticOrder P; int c, np, nsl, ntsl, ns, cbase, cu0, sid0;
    __device__ void init(int N, int K, int c_, int nsl_, int cbase_, int cu0_, int sid0_) { sid0 = sid0_; P.init(MPROMPT, N, GRID, c_, K); c = c_; np = (MPROMPT / 256) * (N / 256) / GRID; nsl = nsl_; ntsl = (K / 64) / nsl_; ns = (N / 256) * nsl_; cbase = cbase_; cu0 = cu0_; }
    __device__ bool next(int i, pg8::Unit& u) const {
        const int s = c - cu0; const bool has = s >= 0 && s < ns;
        if (!has || i > 0) return (i - (has ? 1 : 0)) < np ? P.next(i - (has ? 1 : 0), u) : false;
        u.pm = MPROMPT / 256; u.pn = s / nsl; u.k0 = (s % nsl) * ntsl * 64; u.nt = ntsl; u.cidx = cbase + u.pn; u.sid = sid0 + s; return true;
    }
    __device__ __forceinline__ void a_ready(const pg8::Unit&) const {}
    __device__ __forceinline__ void done(const pg8::Unit&) const {}
};
template <class Epi, bool CHAIN_IN>
__device__ __forceinline__ void run_gemm_chain(const Frame& F, const bf16* Am, const bf16* Bt, int K, const Epi& E, pg8::f32x4 (&acc)[2][2][4][2]) {
    pg8::Gemm g{Am, Bt, MPROMPT, DM, K}; pg8::StaticOrder S; S.init(MPROMPT, DM, GRID, (int)blockIdx.x, K);
    pg8::gemm_phase<Epi, pg8::StaticOrder, true, GEMM_SP2, CHAIN_IN>(F.lds, g, S, E, acc);
}
template <class Epi>
__device__ __forceinline__ void run_gemm_split(const Frame& F, const bf16* Am, const bf16* Bt, int N, int K, const Epi& E, int nsl, int cbase, int cu0, int sid0 = 0, bool slices_only = false) {
    pg8::Gemm g{Am, Bt, MP, N, K}; SplitSched S; S.init(N, K, (int)blockIdx.x, nsl, cbase, cu0, sid0); if (slices_only) S.np = 0;
    pg8::gemm_phase<Epi, SplitSched, true, GEMM_SP2>(F.lds, g, S, E);
}

#ifndef REP_PROLOGUE
#define REP_PROLOGUE 1
#endif
#ifndef REP_MOD
#define REP_MOD 1
#endif
#ifndef REP_PREP
#define REP_PREP 1
#endif
#ifndef REP_WIN
#define REP_WIN 1
#endif
#ifndef REP_MIX1
#define REP_MIX1 1
#endif
#ifndef REP_MIX2
#define REP_MIX2 1
#endif
#ifndef REP_GLU
#define REP_GLU 1
#endif
#ifndef REP_MERGE
#define REP_MERGE 1
#endif
#ifndef REP_OUT
#define REP_OUT 1
#endif
#ifndef REP_UP
#define REP_UP 1
#endif
#ifndef REP_CONV
#define REP_CONV 1
#endif
#ifndef REP_DOWN
#define REP_DOWN 1
#endif
#ifndef REP_BAR
#define REP_BAR 1
#endif
#define REP(n) _Pragma("unroll 1") for (int rep_ = 0; rep_ < (n); ++rep_)
__device__ __forceinline__ void grid_bar(const Frame& F0) {
    unsigned long long w = (unsigned long long)F0.ws; unsigned x = xb_xcc_id(); asm volatile("" : "+s"(w), "+s"(x));
    XcdBarrier b; b.bar = (unsigned*)((unsigned char*)w + WS_CTL) + CW_BAR; b.x = x; b.st = (volatile LAS unsigned*)(F0.lds + MISC_OFF) + 8;
    xcd_barrier(b);
}
__global__ void __launch_bounds__(NTHR, 2) mega_fwd(Args Aarg) {
    const KArgs A0 = (KArgs)__builtin_amdgcn_kernarg_segment_ptr(); (void)Aarg;
#define A launder_args(A0)
    extern __shared__ __attribute__((aligned(16))) unsigned char lds_raw[];
    Frame F;
    F.lds = (LAS unsigned char*)lds_raw;
    F.tid = threadIdx.x; F.lane = F.tid & 63; F.wave = __builtin_amdgcn_readfirstlane(F.tid >> 6);
    F.gw = blockIdx.x * NWAVES + F.wave;
    F.out = A0->out; F.ws = A0->ws;
    volatile LAS unsigned* MISC = (volatile LAS unsigned*)(F.lds + MISC_OFF);
    if (F.tid < 64) MISC[F.tid] = 0u;
    __syncthreads();
    (void)xcd_barrier_post((unsigned*)(F.ws + WS_CTL) + CW_BAR, MISC + 8);
#define GRID_BAR() do { REP(REP_BAR) grid_bar(F); } while (0)

#ifndef REP_MODS
#define REP_MODS 1
#endif
    REP(REP_PROLOGUE) { _Pragma("unroll 1") for (int rm = 0; rm < REP_MODS; ++rm) phase_mod(F, A); phase_prologue(F, A);
    GRID_BAR(); }
#pragma unroll 1
    for (int l = 0; l < DEPTH; ++l) {
#define PH_FRAME() const Frame Fq = launder(F); unsigned char* const wsq = Fq.ws; unsigned char* const wl = wsq + WS_W + (size_t)l * WL_END; \
        const float* const modl = (const float*)(wsq + WS_MOD) + (size_t)l * N_MOD; pg8::f32x4* const slab = (pg8::f32x4*)(wsq + WS_SLAB); \
        unsigned* const cnt = (unsigned*)(wsq + WS_CTL) + CW_CNT; (void)wl; (void)modl; (void)slab; (void)cnt
#define WSQ(T, off) ((T*)(wsq + (off)))
        if (l == 0) REP(REP_PREP) { { PH_FRAME(); phase_prep<true>(Fq, A->in[I_XP], A->in[I_XS], A->in[I_GMIX] + l * DM, modl, 0, 1, A->in[I_WIN] + (size_t)l * DM * N_IN, WSQ(float, WS_SMALL + SM_DT)); }
        GRID_BAR(); }
        REP(REP_WIN) { { PH_FRAME(); epi::EpiIn E{WSQ(bf16, WS_BIG), rep_ == 0 ? WSQ(float, WS_SMALL + SM_VSQ) + l * MP : nullptr, epi::SplitCtl{slab, cnt, 4u}};
            run_gemm_split(Fq, WSQ(const bf16, WS_H), (const bf16*)(wl + WL_IN), N_INP, DM, E, 4, (l * 4 + 0) * 64, 0); }
        GRID_BAR(); }
        REP(REP_MIX2) { phase_mix2(F, A, l, rep_ == 0); phase_mix1(F, A, l, rep_ == 0);
        GRID_BAR(); }
        REP(REP_GLU) { { PH_FRAME(); epi::EpiGlu E{WSQ(const bf16, WS_YB), WSQ(bf16, WS_OA)};
            run_gemm(Fq, WSQ(const bf16, WS_YB), (const bf16*)(wl + WL_GLU), MP, 512, 512, E); }
        GRID_BAR(); }
        REP(REP_MERGE) {
            {   PH_FRAME(); bf16* BIG = WSQ(bf16, WS_BIG);
                epi::EpiMerge<0> Ea{BIG + PC_GA, WSQ(float, WS_T), WSQ(bf16, WS_MERGED), WSQ(const float, WS_SMALL + SM_CSQ) + l * MP, slab, BIG, cnt};
                run_gemm_split(Fq, WSQ(const bf16, WS_OA), (const bf16*)(wl + WL_PA), DM, 512, Ea, 2, (l * 4 + 1) * 64, 0, 0); }
            {   PH_FRAME(); bf16* BIG = WSQ(bf16, WS_BIG);
                epi::EpiMerge<1> Eb{BIG + PC_GB, WSQ(float, WS_T), WSQ(bf16, WS_MERGED), WSQ(const float, WS_SMALL + SM_CSQ) + l * MP, slab, BIG, cnt};
                run_gemm_split(Fq, WSQ(const bf16, WS_OB), (const bf16*)(wl + WL_PB), DM, 512, Eb, 2, (l * 4 + 1) * 64, 16, 16); }
            {   PH_FRAME(); bf16* BIG = WSQ(bf16, WS_BIG);
                epi::EpiMerge<2> Ec{BIG + PC_GC, WSQ(float, WS_T), WSQ(bf16, WS_MERGED), WSQ(const float, WS_SMALL + SM_CSQ) + l * MP, slab, BIG, cnt};
                run_gemm_split(Fq, WSQ(const bf16, WS_OC), (const bf16*)(wl + WL_PC), DM, 1024, Ec, 4, (l * 4 + 1) * 64, 32, 32); }
        GRID_BAR(); }
        REP(REP_OUT) { { PH_FRAME(); epi::EpiResidPrep<0> E{epi::EpiResid{WSQ(const bf16, WS_X0), WSQ(const bf16, WS_X0) + (size_t)MPROMPT * DM, WSQ(bf16, WS_X1), modl + 2 * DM, epi::SplitCtl{slab, cnt, 4u}},
                WSQ(bf16, WS_H), nullptr, nullptr, A->in[I_GFFN] + l * DM, modl, 3, 4, nullptr, WSQ(float, WS_SMALL + SM_DT), (unsigned*)(wsq + WS_CTL) + CW_PC + (l * 2 + 0) * 64};
            run_gemm_split(Fq, WSQ(const bf16, WS_MERGED), (const bf16*)(wl + WL_OUT), DM, DM, E, 4, (l * 4 + 2) * 64, 0); }
        GRID_BAR(); }
        REP(REP_UP) { { PH_FRAME(); epi::EpiUpConv E{WSQ(bf16, WS_T), WSQ(float, WS_HALO), A->in[I_FCONVW] + (size_t)l * K_F * D_UP, A->in[I_FCONVB] + (size_t)l * D_UP,
                A->in[I_FFNCONV] + (size_t)l * NS * 2 * D_UP, Fq.out + O_CFS + (size_t)l * NS * 2 * D_UP, (LAS float*)(Fq.lds + 131072), rep_ < REP_UP - 1 ? 1 : 0};
            run_gemm(Fq, WSQ(const bf16, WS_H), (const bf16*)(wl + WL_UP), MP, D_UP, DM, E); }
        GRID_BAR(); }
        REP(REP_CONV) { phase_upfix(F, A, l);
        GRID_BAR(); }
        REP(REP_DOWN) {
            if (l + 1 < DEPTH) { PH_FRAME(); const float* mod2 = (const float*)(wsq + WS_MOD) + (size_t)(l + 1) * N_MOD;
                epi::EpiResidPrep<1> E{epi::EpiResid{WSQ(const bf16, WS_X1), WSQ(const bf16, WS_X1) + (size_t)MPROMPT * DM, WSQ(bf16, WS_X0), modl + 5 * DM, epi::SplitCtl{slab, cnt, 4u}},
                    WSQ(bf16, WS_H), nullptr, nullptr, A->in[I_GMIX] + (l + 1) * DM, mod2, 0, 1, WSQ(const float, WS_SMALL + SM_WDT) + (size_t)(l + 1) * 16 * DM, WSQ(float, WS_SMALL + SM_DT), (unsigned*)(wsq + WS_CTL) + CW_PC + (l * 2 + 1) * 64};
                run_gemm_split(Fq, WSQ(const bf16, WS_T), (const bf16*)(wl + WL_DOWN), DM, D_FF, E, 4, (l * 4 + 3) * 64, 0);
            } else { PH_FRAME();
                epi::EpiResidPrep<2> E{epi::EpiResid{WSQ(const bf16, WS_X1), WSQ(const bf16, WS_X1) + (size_t)MPROMPT * DM, WSQ(bf16, WS_X0), modl + 5 * DM, epi::SplitCtl{slab, cnt, 4u}},
                    nullptr, Fq.out + O_YP, Fq.out + O_YS, A->in[I_GFINAL], modl, 0, 1, nullptr, WSQ(float, WS_SMALL + SM_DT), (unsigned*)(wsq + WS_CTL) + CW_PC + (l * 2 + 1) * 64};
                run_gemm_split(Fq, WSQ(const bf16, WS_T), (const bf16*)(wl + WL_DOWN), DM, D_FF, E, 4, (l * 4 + 3) * 64, 0); }
        if (l + 1 < DEPTH) GRID_BAR(); }
    }
#undef A
}

extern "C" void kernel_launch(void* const* d_in, const int* in_sizes, int n_in, void* d_out, int out_size, void* d_ws, size_t ws_size, hipStream_t stream) {
    static int grid = 0;
    if (grid == 0) {
        if (n_in != N_INPUTS || (size_t)out_size != O_END || ws_size < WS_END) { fprintf(stderr, "kernel_launch: unexpected shapes (n_in %d, out %d, ws %zu, need %zu)\n", n_in, out_size, ws_size, (size_t)WS_END); grid = -1; return; }
        int dev = 0, cus = 0, per_cu = 0;
        if (hipGetDevice(&dev) != hipSuccess || hipDeviceGetAttribute(&cus, hipDeviceAttributeMultiprocessorCount, dev) != hipSuccess) { grid = -1; return; }
        if (hipFuncSetAttribute((const void*)mega_fwd, hipFuncAttributeMaxDynamicSharedMemorySize, LDS_BYTES) != hipSuccess) { fprintf(stderr, "kernel_launch: hipFuncSetAttribute failed\n"); grid = -1; return; }
        if (hipOccupancyMaxActiveBlocksPerMultiprocessor(&per_cu, (const void*)mega_fwd, NTHR, LDS_BYTES) != hipSuccess || per_cu < 1) { fprintf(stderr, "kernel_launch: occupancy query reports %d blocks per CU\n", per_cu); (void)hipGetLastError(); grid = -1; return; }
        if (cus * per_cu < GRID) { fprintf(stderr, "kernel_launch: %d CUs x %d blocks cannot hold the %d-workgroup grid\n", cus, per_cu, GRID); grid = -1; return; }
        grid = GRID;
    }
    if (grid < 0) return;
    if (hipMemsetAsync((char*)d_ws + WS_CTL, 0, CTL_ZERO_BYTES, stream) != hipSuccess) return;
    Args a{};
    for (int i = 0; i < N_INPUTS; ++i) a.in[i] = (const float*)d_in[i];
    a.out = (float*)d_out; a.ws = (unsigned char*)d_ws;
    void* params[] = {&a};
    hipError_t e = hipLaunchCooperativeKernel((const void*)mega_fwd, dim3(grid), dim3(NTHR), params, LDS_BYTES, stream);
    if (e != hipSuccess) fprintf(stderr, "kernel_launch: cooperative launch failed: %s (grid %d)\n", hipGetErrorString(e), grid);
}
```

```cpp
#include <hip/hip_runtime.h>
#include <cstdio>
#include <cstdint>
namespace pg8 {
#define PG8_LAS __attribute__((address_space(3)))
typedef unsigned short bf16_t;
typedef short bf16x8 __attribute__((ext_vector_type(8)));
typedef float f32x4 __attribute__((ext_vector_type(4)));
typedef unsigned u32x4 __attribute__((ext_vector_type(4)));
constexpr int BM = 256, BK = 64, HALF = 128, HTB = HALF * BK * 2  , STAGE_BYTES = 8 * HTB, NXCD = 8, WGM = 8;

__host__ __device__ __forceinline__ int lds_byte(int r, int c) { const int st = (r >> 4) * 2 + (c >> 5), rr = r & 15, cc = c & 31, ob = rr * 64 + cc * 2; return st * 1024 + (ob ^ (((ob >> 9) & 1) << 5)); }
__host__ __device__ __forceinline__ void stage_rc(int b, int& R, int& C) { const int st = b / 1024, sb = b % 1024, swz = sb ^ (((sb >> 9) & 1) << 5); R = (st >> 1) * 16 + swz / 64; C = (st & 1) * 32 + (swz % 64) / 2; }
__host__ __device__ __forceinline__ int perm32(int rho) { const int n = rho >> 4, i = rho & 15; return 8 * (i >> 2) + 4 * n + (i & 3); }

struct Unit { int pm, pn, k0, nt, cidx, sid; };
struct Gemm { const bf16_t* A; const bf16_t* Bt; int M, N, K; };

struct StaticOrder {
    int nM, nN, nwg, G, c, ntk;
    __host__ __device__ void init(int M, int N, int G_, int c_, int K_) { nM = M / BM; nN = N / BM; nwg = nM * nN; G = G_; c = c_; ntk = K_ / BK; }
    __host__ __device__ bool next(int i, Unit& u) const {
        const long L = (long)i * G + c; if (L >= nwg) return false;
        int wgid = (int)L; { const int q = nwg / NXCD, r = nwg % NXCD, xcd = wgid % NXCD, off = wgid / NXCD; wgid = (xcd < r ? xcd * (q + 1) : r * (q + 1) + (xcd - r) * q) + off; }
        const int nig = WGM * nN, gid = wgid / nig, fm = gid * WGM, gsz = (nM - fm) < WGM ? (nM - fm) : WGM;
        u.pm = fm + ((wgid % nig) % gsz); u.pn = (wgid % nig) / gsz; u.k0 = 0; u.nt = ntk; u.cidx = -1; u.sid = 0; return true;
    }
    __device__ __forceinline__ void a_ready(const Unit&) const {}
    __device__ __forceinline__ void done(const Unit&) const {}
};
__device__ __forceinline__ unsigned cvt_pk_bf16(float lo, float hi) { unsigned r; asm volatile("s_nop 0\n\tv_cvt_pk_bf16_f32 %0, %1, %2" : "=v"(r) : "v"(lo), "v"(hi)); return r; }
template <class Epi, class Sched, bool ALIGN_EPI = false, bool SP2 = false, bool CHAIN_IN = false>
__device__ __forceinline__ void gemm_phase(PG8_LAS unsigned char* lds, const Gemm g, const Sched& S, const Epi& E, f32x4 (&acc)[2][2][4][2]) {
    int tid_ = threadIdx.x; asm volatile("" : "+v"(tid_));
    const int tid = tid_, wid = __builtin_amdgcn_readfirstlane(tid >> 6), lane = tid & 63, wr = wid >> 2, wc = wid & 3, fr = lane & 15, fq = lane >> 4;
    const int K = g.K;
    unsigned voffA[2], voffB[2];
#pragma unroll
    for (int i = 0; i < 2; ++i) { int R, C; stage_rc(tid * 16 + i * 8192, R, C); const int Rb = Epi::PERM ? ((R & ~31) + perm32(R & 31)) : R;
        voffA[i] = (unsigned)(R * K + C) * 2u; voffB[i] = (unsigned)(Rb * K + C) * 2u; }
    const size_t kstep = (size_t)(BK * 2);
    const size_t hstep = (size_t)HALF * K * 2;
    const size_t tstep = 2 * hstep;
    const unsigned ldsw = (unsigned)wid * 1024u;
    const int aoff = lds_byte(wr * 64 + fr, fq * 8), boff = lds_byte(wc * 32 + fr, fq * 8);
#define PG8_SA(b, h) (((b) * 2 + (h)) * HTB)
#define PG8_SB(b, h) ((4 + (b) * 2 + (h)) * HTB)
#define PG8_STAGE(bufoff, gbase, voff) do { _Pragma("unroll") for (int _i = 0; _i < 2; ++_i) \
        __builtin_amdgcn_global_load_lds((const unsigned*)((const char*)(gbase) + (voff)[_i]), (PG8_LAS unsigned*)(lds + (bufoff) + ldsw + _i * 8192), 16, 0, 0); } while (0)
#define PG8_LDA(dst, b, h) do { _Pragma("unroll") for (int m = 0; m < 4; ++m) _Pragma("unroll") for (int k = 0; k < 2; ++k) dst[m][k] = *(const PG8_LAS bf16x8*)(lds + PG8_SA(b, h) + aoff + m * 2048 + k * 1024); } while (0)
#define PG8_LDB(dst, b, h) do { _Pragma("unroll") for (int n = 0; n < 2; ++n) _Pragma("unroll") for (int k = 0; k < 2; ++k) dst[n][k] = *(const PG8_LAS bf16x8*)(lds + PG8_SB(b, h) + boff + n * 2048 + k * 1024); } while (0)
#define PG8_MMA(ai, bj, At, Bt) do { __builtin_amdgcn_s_setprio(1); _Pragma("unroll") for (int m = 0; m < 4; ++m) _Pragma("unroll") for (int n = 0; n < 2; ++n) _Pragma("unroll") for (int k = 0; k < 2; ++k) \
        acc[ai][bj][m][n] = __builtin_amdgcn_mfma_f32_16x16x32_bf16(Bt[n][k], At[m][k], acc[ai][bj][m][n], 0, 0, 0); __builtin_amdgcn_s_setprio(0); } while (0)
#define PG8_WAIT_V(n) asm volatile("s_waitcnt vmcnt(" #n ")" ::: "memory")
#define PG8_WAIT_L(n) asm volatile("s_waitcnt lgkmcnt(" #n ")" ::: "memory")
#define PG8_BAR __builtin_amdgcn_s_barrier()
#define PG8_SCHED __builtin_amdgcn_sched_barrier(0)
    Unit cur, nxt; int ui = 0;
    if (!S.next(0, cur)) return;
    if constexpr (!CHAIN_IN) {
#pragma unroll
    for (int a = 0; a < 2; ++a)
#pragma unroll
        for (int b = 0; b < 2; ++b)
#pragma unroll
            for (int m = 0; m < 4; ++m)
#pragma unroll
                for (int n = 0; n < 2; ++n) acc[a][b][m][n] = (f32x4){0.f, 0.f, 0.f, 0.f};
    }
    bf16x8 At[4][2], B0[2][2], B1[2][2];
    const char* cA = (const char*)g.A + (size_t)cur.pm * tstep + (size_t)cur.k0 * 2; const char* cB = (const char*)g.Bt + (size_t)cur.pn * tstep + (size_t)cur.k0 * 2;
    S.a_ready(cur);
    if constexpr (SP2) {
        PG8_STAGE(PG8_SB(0, 0), cB, voffB); PG8_STAGE(PG8_SB(0, 1), cB + hstep, voffB); PG8_STAGE(PG8_SA(0, 0), cA, voffA); PG8_STAGE(PG8_SA(0, 1), cA + hstep, voffA);
        if (wr == 1) PG8_BAR;
        PG8_WAIT_V(2); PG8_BAR;
        PG8_STAGE(PG8_SB(1, 0), cB + kstep, voffB); PG8_STAGE(PG8_SA(1, 0), cA + kstep, voffA); PG8_STAGE(PG8_SB(1, 1), cB + hstep + kstep, voffB);
        PG8_WAIT_V(6); PG8_BAR;
    } else {
        PG8_STAGE(PG8_SB(0, 0), cB, voffB); PG8_STAGE(PG8_SA(0, 0), cA, voffA); PG8_STAGE(PG8_SB(0, 1), cB + hstep, voffB); PG8_STAGE(PG8_SA(0, 1), cA + hstep, voffA);
        if (wr == 1) PG8_BAR;
        PG8_WAIT_V(4); PG8_BAR;
        PG8_STAGE(PG8_SB(1, 0), cB + kstep, voffB); PG8_STAGE(PG8_SA(1, 0), cA + kstep, voffA); PG8_STAGE(PG8_SB(1, 1), cB + hstep + kstep, voffB);
        PG8_WAIT_V(6); PG8_BAR;
    }
    for (;;) {
        const bool has_next = S.next(ui + 1, nxt);
        const char* nA = has_next ? (const char*)g.A + (size_t)nxt.pm * tstep + (size_t)nxt.k0 * 2 : cA; const char* nB = has_next ? (const char*)g.Bt + (size_t)nxt.pn * tstep + (size_t)nxt.k0 * 2 : cB;
        const int nt = cur.nt; const bool halfu = cur.cidx >= 0;
        for (int t = 0; t < nt; t += 2) {
            const bool last = (t == nt - 2);
            const char* a1 = cA + (size_t)(t + 1) * kstep;
            const char* a2 = last ? nA : cA + (size_t)(t + 2) * kstep; const char* b2 = last ? nB : cB + (size_t)(t + 2) * kstep;
            const char* a3 = a2 + kstep; const char* b3 = b2 + kstep;
            if (last && has_next) S.a_ready(nxt);
            if constexpr (SP2) {
            PG8_LDB(B0, 0, 0); PG8_LDB(B1, 0, 1); PG8_SCHED; PG8_LDA(At, 0, 0); PG8_STAGE(PG8_SA(1, 1), a1 + hstep, voffA);
            PG8_WAIT_V(8); PG8_WAIT_L(0); PG8_BAR; PG8_MMA(0, 0, At, B0); PG8_MMA(0, 1, At, B1); PG8_BAR; PG8_SCHED;
            PG8_LDA(At, 0, 1); PG8_STAGE(PG8_SB(0, 0), b2, voffB); PG8_STAGE(PG8_SB(0, 1), b2 + hstep, voffB); PG8_STAGE(PG8_SA(0, 0), a2, voffA);
            PG8_WAIT_V(8); PG8_WAIT_L(0); PG8_BAR; if (!halfu) { PG8_MMA(1, 0, At, B0); PG8_MMA(1, 1, At, B1); } PG8_BAR; PG8_SCHED;
            PG8_LDB(B0, 1, 0); PG8_LDB(B1, 1, 1); PG8_SCHED; PG8_LDA(At, 1, 0); PG8_STAGE(PG8_SA(0, 1), a2 + hstep, voffA);
            PG8_WAIT_V(8); PG8_WAIT_L(0); PG8_BAR; PG8_MMA(0, 0, At, B0); PG8_MMA(0, 1, At, B1); PG8_BAR; PG8_SCHED;
            PG8_LDA(At, 1, 1); PG8_STAGE(PG8_SB(1, 0), b3, voffB); PG8_STAGE(PG8_SB(1, 1), b3 + hstep, voffB); PG8_STAGE(PG8_SA(1, 0), a3, voffA);
            PG8_WAIT_V(8); PG8_WAIT_L(0); PG8_BAR; if (!halfu) { PG8_MMA(1, 0, At, B0); PG8_MMA(1, 1, At, B1); } PG8_BAR; PG8_SCHED;
            } else {
            PG8_LDB(B0, 0, 0); PG8_SCHED; PG8_LDA(At, 0, 0); PG8_STAGE(PG8_SA(1, 1), a1 + hstep, voffA);
            PG8_WAIT_L(8); PG8_BAR; PG8_WAIT_L(0); PG8_MMA(0, 0, At, B0); PG8_BAR; PG8_SCHED;
            PG8_LDB(B1, 0, 1); PG8_STAGE(PG8_SB(0, 0), b2, voffB);
            PG8_BAR; PG8_WAIT_L(0); PG8_MMA(0, 1, At, B1); PG8_BAR;
            PG8_LDA(At, 0, 1); PG8_STAGE(PG8_SA(0, 0), a2, voffA);
            PG8_BAR; PG8_WAIT_L(0); PG8_MMA(1, 0, At, B0); PG8_BAR; PG8_SCHED;
            PG8_STAGE(PG8_SB(0, 1), b2 + hstep, voffB);
            PG8_WAIT_V(6); PG8_BAR; PG8_MMA(1, 1, At, B1); PG8_BAR;
            PG8_LDB(B0, 1, 0); PG8_SCHED; PG8_LDA(At, 1, 0); PG8_STAGE(PG8_SA(0, 1), a2 + hstep, voffA);
            PG8_WAIT_L(8); PG8_BAR; PG8_WAIT_L(0); PG8_MMA(0, 0, At, B0); PG8_BAR; PG8_SCHED;
            PG8_LDB(B1, 1, 1); PG8_STAGE(PG8_SB(1, 0), b3, voffB);
            PG8_BAR; PG8_WAIT_L(0); PG8_MMA(0, 1, At, B1); PG8_BAR;
            PG8_LDA(At, 1, 1); PG8_STAGE(PG8_SA(1, 0), a3, voffA);
            PG8_BAR; PG8_WAIT_L(0); PG8_MMA(1, 0, At, B0); PG8_BAR; PG8_SCHED;
            PG8_STAGE(PG8_SB(1, 1), b3 + hstep, voffB);
            PG8_WAIT_V(6); PG8_BAR; PG8_MMA(1, 1, At, B1); PG8_BAR;
            }
        }
        if constexpr (ALIGN_EPI) { if (wr == 0) PG8_BAR; }
        if constexpr (!Epi::AFTER_DRAIN) { int t2 = threadIdx.x; asm volatile("" : "+v"(t2)); const int lane2 = t2 & 63, fr2 = lane2 & 15, fq2 = lane2 >> 4;
            if (cur.cidx < 0) E(acc, cur, wr, wc, fr2, fq2); else E.partial(acc, cur, wr, wc, fr2, fq2, wid, lane2); S.done(cur); }
        else { if (cur.cidx >= 0) { int t2 = threadIdx.x; asm volatile("" : "+v"(t2)); const int lane2 = t2 & 63; E.partial(acc, cur, wr, wc, lane2 & 15, lane2 >> 4, wid, lane2); } }
        if (!has_next) break;
#pragma unroll
        for (int a = 0; a < 2; ++a)
#pragma unroll
            for (int b = 0; b < 2; ++b)
#pragma unroll
                for (int m = 0; m < 4; ++m)
#pragma unroll
                    for (int n = 0; n < 2; ++n) acc[a][b][m][n] = (f32x4){0.f, 0.f, 0.f, 0.f};
        cur = nxt; cA = nA; cB = nB; ++ui;
        if constexpr (ALIGN_EPI) { if (wr == 1) PG8_BAR; }
    }
    PG8_WAIT_V(0);
    if constexpr (!ALIGN_EPI) { if (wr == 0) PG8_BAR; }
    PG8_BAR;
    if constexpr (Epi::AFTER_DRAIN) { E.fused(acc, cur, wr, wc, fr, fq, lds, wid, lane); S.done(cur); }
#undef PG8_SA
#undef PG8_SB
#undef PG8_STAGE
#undef PG8_LDA
#undef PG8_LDB
#undef PG8_MMA
#undef PG8_WAIT_V
#undef PG8_WAIT_L
#undef PG8_BAR
#undef PG8_SCHED
}
template <class Epi, class Sched, bool ALIGN_EPI = false, bool SP2 = false>
__device__ __forceinline__ void gemm_phase(PG8_LAS unsigned char* lds, const Gemm g, const Sched& S, const Epi& E) {
    f32x4 acc[2][2][4][2];
    gemm_phase<Epi, Sched, ALIGN_EPI, SP2, false>(lds, g, S, E, acc);
}

}
constexpr int DM = 2048, NB = 4, SEQ = 2048, NS = 128, DEPTH = 2;
constexpr int MPROMPT = NB * SEQ;
constexpr int MREAL = MPROMPT + NS;
constexpr int MP = 8448;
constexpr int D_A = 512, G_A = 32, P_A = 64, S5G = 16;
constexpr int D_B = 512, H_B = 8, GMC = 128;
constexpr int D_C = 1024, HD_C = 64, H_C = 16, N_C = 128, G_C = 2, K_C = 4, D_XBC = 1536;
constexpr int D_FF = 5632, K_F = 3, D_UP = 2 * D_FF;
constexpr int N_IN = 10256, N_INP = 10240;
constexpr int N_MOD = 6 * DM, MOD_PITCH = 2 * N_MOD;
constexpr float EPS = 1e-6f;
constexpr int PC_UA = 0, PC_UB = 512, PC_VB = 1024, PC_Z = 1536, PC_XBC = 2560, PC_GA = 4096, PC_GB = 6144, PC_GC = 8192;
constexpr int S5Q = 64, S5NC = SEQ / S5Q;
constexpr int SSDQ = 128, SSDNC = SEQ / SSDQ;

enum { I_XP = 0, I_XS, I_CP, I_CS, I_S5RE, I_S5IM, I_SSM, I_SSDCONV, I_FFNCONV, I_WMOD, I_BMOD, I_GMIX, I_WIN, I_LAMRE, I_LAMIM, I_LOGDT,
       I_BRE, I_BIM, I_CRE, I_CIM, I_S5D, I_WGLU, I_GV, I_WS, I_BS, I_CONVW, I_CONVB, I_DTBIAS, I_ALOG, I_SSDD, I_GNORM, I_WPA, I_WPB, I_WPC,
       I_WOUT, I_GFFN, I_WUP, I_FCONVW, I_FCONVB, I_WDOWN, I_GFINAL, N_INPUTS };
constexpr size_t O_YP = 0, O_YS = 16777216, O_S5RP = 17039360, O_S5IP = 17055744, O_SSMP = 17072128, O_CCP = 18120704, O_CFP = 18157568,
                 O_S5RS = 18337792, O_S5IS = 18862080, O_SSMS = 19386368, O_CCS = 52940800, O_CFS = 54120448, O_GVS = 59887616, O_END = 60018688;

constexpr size_t MiB = 1u << 20;
constexpr size_t WS_CTL = 0, CTL_ZERO_BYTES = 1 * MiB;
constexpr size_t SZ_WIN = (size_t)N_INP * DM * 2, SZ_WGLU = 512 * 512 * 2, SZ_WPA = (size_t)DM * 512 * 2, SZ_WPC = (size_t)DM * 1024 * 2,
                 SZ_WOUT = (size_t)DM * DM * 2, SZ_WUP = (size_t)D_UP * DM * 2, SZ_WDOWN = (size_t)DM * D_FF * 2;
constexpr size_t WL_IN = 0, WL_GLU = WL_IN + SZ_WIN, WL_PA = WL_GLU + SZ_WGLU, WL_PB = WL_PA + SZ_WPA, WL_PC = WL_PB + SZ_WPA, WL_OUT = WL_PC + SZ_WPC,
                 WL_UP = WL_OUT + SZ_WOUT, WL_DOWN = WL_UP + SZ_WUP, WL_END = WL_DOWN + SZ_WDOWN;
constexpr size_t WS_W = 2 * MiB;
constexpr size_t WS_SMALL = WS_W + 2 * WL_END;
constexpr size_t SM_WS = 0;
constexpr size_t SM_S5BB = SM_WS + 2 * 8 * 128 * 128 * 2;
constexpr size_t SM_S5CT = SM_S5BB + 2 * 32 * 64 * 32 * 4;
constexpr size_t SM_S5A = SM_S5CT + 2 * 32 * 16 * 128 * 2;
constexpr size_t SM_DT = SM_S5A + 2 * 32 * 64 * 4 * 4;
constexpr size_t SM_VSQ = SM_DT + (size_t)MP * 16 * 4;
constexpr size_t SM_CSQ = SM_VSQ + (size_t)2 * MP * 4;
constexpr size_t SM_SLOC = SM_CSQ + (size_t)2 * MP * 4;
constexpr size_t SM_SDEC = SM_SLOC + (size_t)NB * G_A * S5NC * 128 * 4;
constexpr size_t SM_CSILU = SM_SDEC + 4096;
constexpr size_t SM_WDT = SM_CSILU + 256 * 2048 * 2;
constexpr size_t SM_END = SM_WDT + (size_t)2 * 16 * DM * 4;
constexpr size_t WS_MOD = (WS_SMALL + SM_END + 4095) / 4096 * 4096;
constexpr size_t WS_X0 = WS_MOD + (size_t)2 * 256 * N_MOD * 4;
constexpr size_t WS_X1 = WS_X0 + (size_t)MP * DM * 4;
constexpr size_t WS_H = WS_X1 + (size_t)MP * DM * 4;
constexpr size_t WS_BIG = WS_H + (size_t)MP * DM * 2;
constexpr size_t WS_T = WS_BIG + (size_t)MP * D_UP * 2;
constexpr size_t WS_MERGED = WS_T + (size_t)MP * DM * 4;
constexpr size_t WS_OA = WS_MERGED + (size_t)MP * DM * 2;
constexpr size_t WS_OB = WS_OA + (size_t)MP * 512 * 2;
constexpr size_t WS_YB = WS_OB + (size_t)MP * 512 * 2;
constexpr size_t WS_OC = WS_YB + (size_t)MP * 512 * 2;
constexpr size_t WS_STATES = WS_OC + (size_t)MP * 1024 * 2;
constexpr size_t WS_SLAB = WS_STATES + (size_t)NB * SSDNC * H_C * HD_C * N_C * 4;
constexpr size_t WS_HALO = WS_SLAB + (size_t)176 * 131072;
constexpr size_t WS_END = WS_HALO + (size_t)33 * 4 * D_UP * 4;
static_assert((size_t)MP * D_FF * 2 <= (size_t)MP * DM * 6, "ACT overlays T+MERGED");
constexpr int CW_PC = 12288;
constexpr int CW_S5F = 20480;
constexpr int CW_SSDF = 16384;
constexpr int CW_BAR = 4096, CW_CNT = 8192;
struct Args { const float* in[N_INPUTS]; float* out; unsigned char* ws; };
typedef const __attribute__((address_space(4))) Args* KArgs;
__device__ __forceinline__ KArgs launder_args(KArgs a) { unsigned long long t = (unsigned long long)a; asm volatile("" : "+s"(t)); return (KArgs)t; }
#define GAS __attribute__((address_space(1)))
#define LAS __attribute__((address_space(3)))
typedef unsigned short bf16;
typedef unsigned v4u __attribute__((ext_vector_type(4)));
typedef unsigned v2u __attribute__((ext_vector_type(2)));
typedef float f32x4 __attribute__((ext_vector_type(4)));
typedef float f32x2 __attribute__((ext_vector_type(2)));
typedef short bf16x8 __attribute__((ext_vector_type(8)));
typedef short bf16x4 __attribute__((ext_vector_type(4)));
typedef GAS unsigned gu32;
#define RLX_AGENT __ATOMIC_RELAXED, __HIP_MEMORY_SCOPE_AGENT
#define LDS_WAIT() asm volatile("s_waitcnt lgkmcnt(0)" ::: "memory")
#define VM_WAIT() asm volatile("s_waitcnt vmcnt(0)" ::: "memory")
constexpr int NWAVES = 8, NTHR = 512, GRID = 256;
__device__ __forceinline__ unsigned f2bf(float f) { unsigned u = __builtin_bit_cast(unsigned, f); return (u + 0x7fffu + ((u >> 16) & 1u)) >> 16; }
__device__ __forceinline__ unsigned pk2(float lo, float hi) { return f2bf(lo) | (f2bf(hi) << 16); }
__device__ __forceinline__ float bf2f(unsigned short b) { return __builtin_bit_cast(float, (unsigned)b << 16); }
__device__ __forceinline__ float bflo(unsigned w) { return __builtin_bit_cast(float, w << 16); }
__device__ __forceinline__ float bfhi(unsigned w) { return __builtin_bit_cast(float, w & 0xffff0000u); }
__device__ __forceinline__ float sigmoidf_(float x) { return __builtin_amdgcn_rcpf(1.0f + __expf(-x)); }
__device__ __forceinline__ float siluf_(float x) { return x * __builtin_amdgcn_rcpf(1.0f + __expf(-x)); }
__device__ __forceinline__ float gelu_tanh(float x) {
    const float u = 0.7978845608028654f * (x + 0.044715f * x * x * x);
    const float e = __expf(2.0f * u);
    const float t = 1.0f - 2.0f * __builtin_amdgcn_rcpf(e + 1.0f);
    return 0.5f * x * (1.0f + t);
}
__device__ __forceinline__ float softplusf_(float x) { return fmaxf(x, 0.f) + __logf(1.0f + __expf(-fabsf(x))); }
template <int M> __device__ __forceinline__ float xor_lt32(float x) {
    return __builtin_bit_cast(float, __builtin_amdgcn_ds_swizzle(__builtin_bit_cast(int, x), (M << 10) | 0x1f)); }
__device__ __forceinline__ float add_xor32(float x) {
    const unsigned b = __builtin_bit_cast(unsigned, x); const auto r = __builtin_amdgcn_permlane32_swap(b, b, false, false);
    return __builtin_bit_cast(float, (unsigned)r[0]) + __builtin_bit_cast(float, (unsigned)r[1]); }
__device__ __forceinline__ float wave_sum(float v) {
    v += xor_lt32<1>(v); v += xor_lt32<2>(v); v += xor_lt32<4>(v); v += xor_lt32<8>(v); v += xor_lt32<16>(v);
    return add_xor32(v);
}
__device__ __forceinline__ float wave_sum16(const float (&a)[16], int lane) {
    float b[8], c[4], d[2];
    const bool o1 = lane & 1, o2 = lane & 2, o4 = lane & 4, o8 = lane & 8;
#pragma unroll
    for (int i = 0; i < 8; ++i) { const float keep = o1 ? a[2 * i + 1] : a[2 * i], send = o1 ? a[2 * i] : a[2 * i + 1]; b[i] = keep + xor_lt32<1>(send); }
#pragma unroll
    for (int i = 0; i < 4; ++i) { const float keep = o2 ? b[2 * i + 1] : b[2 * i], send = o2 ? b[2 * i] : b[2 * i + 1]; c[i] = keep + xor_lt32<2>(send); }
#pragma unroll
    for (int i = 0; i < 2; ++i) { const float keep = o4 ? c[2 * i + 1] : c[2 * i], send = o4 ? c[2 * i] : c[2 * i + 1]; d[i] = keep + xor_lt32<4>(send); }
    const float keep = o8 ? d[1] : d[0], send = o8 ? d[0] : d[1];
    float e = keep + xor_lt32<8>(send);
    e += xor_lt32<16>(e);
    return add_xor32(e);
}
__device__ __forceinline__ float half_sum32(const float (&a)[32], int lane) {
    float b[16], c[8], d[4], e[2];
    const bool o1 = lane & 1, o2 = lane & 2, o4 = lane & 4, o8 = lane & 8, o16 = lane & 16;
#pragma unroll
    for (int i = 0; i < 16; ++i) { const float keep = o1 ? a[2 * i + 1] : a[2 * i], send = o1 ? a[2 * i] : a[2 * i + 1]; b[i] = keep + xor_lt32<1>(send); }
#pragma unroll
    for (int i = 0; i < 8; ++i) { const float keep = o2 ? b[2 * i + 1] : b[2 * i], send = o2 ? b[2 * i] : b[2 * i + 1]; c[i] = keep + xor_lt32<2>(send); }
#pragma unroll
    for (int i = 0; i < 4; ++i) { const float keep = o4 ? c[2 * i + 1] : c[2 * i], send = o4 ? c[2 * i] : c[2 * i + 1]; d[i] = keep + xor_lt32<4>(send); }
#pragma unroll
    for (int i = 0; i < 2; ++i) { const float keep = o8 ? d[2 * i + 1] : d[2 * i], send = o8 ? d[2 * i] : d[2 * i + 1]; e[i] = keep + xor_lt32<8>(send); }
    const float keep = o16 ? e[1] : e[0], send = o16 ? e[0] : e[1];
    return keep + xor_lt32<16>(send);
}
__device__ __forceinline__ float lane_bcast(float x, int src) {
    return __builtin_bit_cast(float, __builtin_amdgcn_readlane(__builtin_bit_cast(int, x), src)); }
__device__ __forceinline__ int mod_row(int r) { return r < MPROMPT ? (r >> 11) : (r < MREAL ? 4 + (r - MPROMPT) : 4 + NS - 1); }

template <int MODE>
__device__ __forceinline__ void prep_row(const bf16* xrow, const float* g, const float* mr, int sh_idx, int sc_idx, bf16* hrow, float* yrow, float* dtrow, const LAS float* wT, int lane) {
    const GAS v2u* xr = (const GAS v2u*)xrow + lane;
    f32x4 v[8]; float s = 0.f;
#pragma unroll
    for (int j = 0; j < 8; ++j) { const v2u w = xr[64 * j]; v[j] = (f32x4){bflo(w.x), bfhi(w.x), bflo(w.y), bfhi(w.y)}; s += (v[j].x * v[j].x + v[j].y * v[j].y) + (v[j].z * v[j].z + v[j].w * v[j].w); }
    const float rinv = rsqrtf(wave_sum(s) * (1.0f / DM) + EPS);
    const GAS f32x4* gp = (const GAS f32x4*)g + lane;
    if (MODE == 2) { GAS f32x4* o = (GAS f32x4*)yrow + lane;
#pragma unroll
        for (int j = 0; j < 8; ++j) o[64 * j] = v[j] * rinv * gp[64 * j];
        return; }
    const GAS f32x4* shp = (const GAS f32x4*)(mr + sh_idx * DM) + lane; const GAS f32x4* scp = (const GAS f32x4*)(mr + sc_idx * DM) + lane;
    GAS v2u* o = (GAS v2u*)hrow + lane;
#pragma unroll
    for (int j = 0; j < 8; ++j) { const f32x4 gg = gp[64 * j], sh = shp[64 * j], sc = scp[64 * j];
        v[j] = v[j] * rinv * gg * (sc + 1.0f) + sh;
        v2u w; w.x = pk2(v[j].x, v[j].y); w.y = pk2(v[j].z, v[j].w); o[64 * j] = w; }
    if (MODE == 1) {
        float a16[16];
#pragma unroll
        for (int hh = 0; hh < 16; ++hh) { float a = 0.f;
#pragma unroll
            for (int j = 0; j < 8; ++j) { const f32x4 w = *(const LAS f32x4*)(wT + hh * DM + 4 * lane + 256 * j); a += (v[j].x * w.x + v[j].y * w.y) + (v[j].z * w.z + v[j].w * w.w); }
            a16[hh] = a; }
        const float mine = wave_sum16(a16, lane);
        if (lane < 16) dtrow[lane] = mine;
    }
}

template <int MODE>
__device__ __forceinline__ void prep_rows4(const bf16* x0, const float* g, const float* mr, int sh_idx, int sc_idx, bf16* h0, float* y0, float* dt0, const LAS float* wT, int lane) {
    f32x4 v[4][8];
#pragma unroll
    for (int q = 0; q < 4; ++q) { const GAS v2u* xr = (const GAS v2u*)(x0 + (size_t)q * DM) + lane;
#pragma unroll
        for (int j = 0; j < 8; ++j) { const v2u w = xr[64 * j]; v[q][j] = (f32x4){bflo(w.x), bfhi(w.x), bflo(w.y), bfhi(w.y)}; } }
    f32x4 gm[8], sh[8];
    {   const GAS f32x4* gp = (const GAS f32x4*)g + lane;
        if (MODE == 2) {
#pragma unroll
            for (int j = 0; j < 8; ++j) gm[j] = gp[64 * j];
        } else { const GAS f32x4* shp = (const GAS f32x4*)(mr + sh_idx * DM) + lane; const GAS f32x4* scp = (const GAS f32x4*)(mr + sc_idx * DM) + lane;
#pragma unroll
            for (int j = 0; j < 8; ++j) { gm[j] = gp[64 * j] * (scp[64 * j] + 1.0f); sh[j] = shp[64 * j]; } } }
#pragma unroll
    for (int q = 0; q < 4; ++q) { float s = 0.f;
#pragma unroll
        for (int j = 0; j < 8; ++j) s += (v[q][j].x * v[q][j].x + v[q][j].y * v[q][j].y) + (v[q][j].z * v[q][j].z + v[q][j].w * v[q][j].w);
        const float rinv = rsqrtf(wave_sum(s) * (1.0f / DM) + EPS);
        if (MODE == 2) { GAS f32x4* o = (GAS f32x4*)(y0 + (size_t)q * DM) + lane;
#pragma unroll
            for (int j = 0; j < 8; ++j) o[64 * j] = v[q][j] * rinv * gm[j];
        } else { GAS v2u* o = (GAS v2u*)(h0 + (size_t)q * DM) + lane;
#pragma unroll
            for (int j = 0; j < 8; ++j) { v[q][j] = v[q][j] * rinv * gm[j] + sh[j]; v2u w; w.x = pk2(v[q][j].x, v[q][j].y); w.y = pk2(v[q][j].z, v[q][j].w); o[64 * j] = w; }
        }
    }
    if (MODE == 1) {
#pragma unroll
        for (int pr = 0; pr < 2; ++pr) { float a16[2][16];
#pragma unroll
            for (int hh = 0; hh < 16; ++hh) { float a0 = 0.f, a1 = 0.f;
#pragma unroll
                for (int j = 0; j < 8; ++j) { const f32x4 w = *(const LAS f32x4*)(wT + hh * DM + 4 * lane + 256 * j);
                    a0 += (v[2 * pr][j].x * w.x + v[2 * pr][j].y * w.y) + (v[2 * pr][j].z * w.z + v[2 * pr][j].w * w.w);
                    a1 += (v[2 * pr + 1][j].x * w.x + v[2 * pr + 1][j].y * w.y) + (v[2 * pr + 1][j].z * w.z + v[2 * pr + 1][j].w * w.w); }
                a16[0][hh] = a0; a16[1][hh] = a1; }
            { const float m0 = wave_sum16(a16[0], lane), m1 = wave_sum16(a16[1], lane); if (lane < 16) { dt0[(2 * pr) * 16 + lane] = m0; dt0[(2 * pr + 1) * 16 + lane] = m1; } } }
    }
}
#define XB_TMO      128
#define XB_XCNT(j)  (256  + 64 * (j))
#define XB_XSUB(j)  (1280 + 64 * (j))
#define XB_XGEN(j)  (2304 + 64 * (j))
#define XB_TOP      3328
#define XB_TOPGEN   3392
#define XCD_BAR_WORDS 3456
#define XB_SPIN_CAP (1u << 18)

__device__ __forceinline__ unsigned xb_ld(unsigned* p)              { return __hip_atomic_load(p, __ATOMIC_RELAXED, __HIP_MEMORY_SCOPE_AGENT); }
__device__ __forceinline__ unsigned xb_add(unsigned* p, unsigned v) { return __hip_atomic_fetch_add(p, v, __ATOMIC_RELAXED, __HIP_MEMORY_SCOPE_AGENT); }
__device__ __forceinline__ unsigned xb_xcc_id() { return (unsigned)__builtin_amdgcn_s_getreg((3 << 11) | 20) & 0xFu; }
#define XB_SPIN(cond, bar) do { unsigned _sp = 0; while (cond) { __builtin_amdgcn_s_sleep(1); \
    if ((++_sp & 255u) == 0u) { if (xb_ld(&(bar)[XB_TMO])) break; if (_sp > XB_SPIN_CAP) { atomicAdd(&(bar)[XB_TMO], 1u); break; } } } } while (0)

struct XcdBarrier {
    unsigned* bar; unsigned x;
    volatile LAS unsigned* st;
};

__device__ __forceinline__ XcdBarrier xcd_barrier_post(unsigned* bar, volatile LAS unsigned* st) {
    XcdBarrier b; b.bar = bar; b.x = xb_xcc_id(); b.st = st;
    if (threadIdx.x == 0) (void)xb_add(&bar[XB_XCNT(b.x)], 1u);
    return b;
}
__device__ __forceinline__ void xcd_barrier_complete(unsigned* bar, unsigned x, unsigned& nloc, unsigned& nx) {
    const unsigned G = gridDim.x * gridDim.y * gridDim.z;
    unsigned sum, cnt, mine, sp = 0u;
    for (;;) {
        sum = 0u; cnt = 0u; mine = 0u;
#pragma unroll
        for (unsigned j = 0; j < 16; ++j) { const unsigned c = xb_ld(&bar[XB_XCNT(j)]); sum += c; cnt += (c > 0u) ? 1u : 0u; mine = (j == x) ? c : mine; }
        if (sum == G) break;
        __builtin_amdgcn_s_sleep(1);
        if ((++sp & 255u) == 0u) { if (xb_ld(&bar[XB_TMO])) break; if (sp > XB_SPIN_CAP) { atomicAdd(&bar[XB_TMO], 1u); break; } }
    }
    nloc = mine > 0u ? mine : 1u; nx = cnt > 0u ? cnt : 1u;
}

__device__ __forceinline__ void xcd_barrier(const XcdBarrier& b) {
    asm volatile("s_waitcnt vmcnt(0)" ::: "memory");
    __syncthreads();
    if (threadIdx.x == 0) {
        unsigned* bar = b.bar;
        __builtin_amdgcn_s_waitcnt(0);
        unsigned nloc = b.st[0], nx = b.st[1];
        if (nloc == 0u) { xcd_barrier_complete(bar, b.x, nloc, nx); b.st[0] = nloc; b.st[1] = nx; }
        const unsigned old = xb_add(&bar[XB_XSUB(b.x)], 1u);
        const unsigned gen = old / nloc;
        if (old + 1u == (gen + 1u) * nloc) {
            __builtin_amdgcn_fence(__ATOMIC_RELEASE, "agent");
            asm volatile("s_waitcnt vmcnt(0)" ::: "memory");
            const unsigned og = xb_add(&bar[XB_TOP], 1u);
            const unsigned tg = og / nx;
            if (og + 1u == (tg + 1u) * nx) xb_add(&bar[XB_TOPGEN], 1u);
            else XB_SPIN(xb_ld(&bar[XB_TOPGEN]) == tg, bar);
            __builtin_amdgcn_fence(__ATOMIC_ACQUIRE, "agent");
            xb_add(&bar[XB_XGEN(b.x)], 1u);
            asm volatile("s_waitcnt vmcnt(0)" ::: "memory");
        } else {
            XB_SPIN(xb_ld(&bar[XB_XGEN(b.x)]) == gen, bar);
            __builtin_amdgcn_fence(__ATOMIC_ACQUIRE, "agent");
            asm volatile("s_waitcnt vmcnt(0)" ::: "memory");
        }
    }
    __syncthreads();
}

namespace epi {
using pg8::Unit; using pg8::f32x4; using pg8::u32x4; using pg8::cvt_pk_bf16;
typedef unsigned u32x2 __attribute__((ext_vector_type(2)));
constexpr int BM = 256, HALF = 128;

constexpr int SLAB_F4 = 8 * 16 * 64;
constexpr int SLAB_BYTES_ALL = 176 * 131072;
typedef unsigned v4u_ __attribute__((ext_vector_type(4)));
template <bool PERM> __device__ __forceinline__ int split_col(const Unit& u, int wc, int fq, int bj, int n) { return u.pn * BM + bj * HALF + wc * 32 + (PERM ? 8 * fq + 4 * n : 16 * n + 4 * fq); }
__device__ __forceinline__ __amdgpu_buffer_rsrc_t slab_rsrc(const f32x4* SLAB) { return __builtin_amdgcn_make_buffer_rsrc((void*)SLAB, (short)0, SLAB_BYTES_ALL, 0x00020000); }
__device__ __forceinline__ void split_store(const f32x4 (&acc)[2][2][4][2], f32x4* SLAB, int sid, int wid, int lane) {
    asm volatile("" : "+v"(lane));
    const __amdgpu_buffer_rsrc_t rs = slab_rsrc(SLAB);
    const unsigned vo = (unsigned)(wid * 16 * 64 + lane) * 16u, so = (unsigned)sid * (unsigned)(SLAB_F4 * 16);
#pragma unroll
    for (int m = 0; m < 4; ++m)
#pragma unroll
        for (int bj = 0; bj < 2; ++bj)
#pragma unroll
            for (int n = 0; n < 2; ++n) __builtin_amdgcn_raw_buffer_store_b128(__builtin_bit_cast(v4u_, acc[0][bj][m][n]), rs, vo + (unsigned)(((m * 2 + bj) * 2 + n) * 64 * 16), so,   16);
}
__device__ __forceinline__ bool split_arrive(unsigned* cnt, unsigned target, int lane) {
    asm volatile("s_waitcnt vmcnt(0)" ::: "memory");
    unsigned old = 0u;
    if (lane == 0) old = __hip_atomic_fetch_add(cnt, 1u, __ATOMIC_RELAXED, __HIP_MEMORY_SCOPE_AGENT);
    old = __builtin_amdgcn_readlane(old, 0);
    asm volatile("" ::: "memory");
    if (old != target - 1u) return false;
    __builtin_amdgcn_fence(__ATOMIC_ACQUIRE, "agent"); asm volatile("s_waitcnt vmcnt(0)" ::: "memory");
    return true;
}
__device__ __forceinline__ f32x4 slab_ld(const __amdgpu_buffer_rsrc_t rs, unsigned vo, unsigned so) { return __builtin_bit_cast(f32x4, __builtin_amdgcn_raw_buffer_load_b128(rs, vo, so,   16)); }
__device__ __forceinline__ f32x4 split_sum1(const f32x4* SLAB, int sid0, int ns, int wid, int lane, int reg) {
    const __amdgpu_buffer_rsrc_t rs = slab_rsrc(SLAB);
    const unsigned vo = (unsigned)((wid * 16 + reg) * 64 + lane) * 16u;
    f32x4 s = slab_ld(rs, vo, (unsigned)sid0 * (unsigned)(SLAB_F4 * 16));
    for (int j = 1; j < ns; ++j) s = s + slab_ld(rs, vo, (unsigned)(sid0 + j) * (unsigned)(SLAB_F4 * 16));
    return s;
}
__device__ __forceinline__ void split_sum(f32x4 (&acc)[2][2][4][2], const f32x4* SLAB, int sid0, int ns, int wid, int lane) {
    asm volatile("" : "+v"(lane));
    const __amdgpu_buffer_rsrc_t rs = slab_rsrc(SLAB);
    const unsigned vo = (unsigned)(wid * 16 * 64 + lane) * 16u;
#pragma unroll
    for (int m = 0; m < 4; ++m)
#pragma unroll
        for (int bj = 0; bj < 2; ++bj) {
            const unsigned vr = vo + (unsigned)((m * 2 + bj) * 2) * 1024u;
            unsigned so = (unsigned)sid0 * (unsigned)(SLAB_F4 * 16);
            f32x4 s0 = {0.f, 0.f, 0.f, 0.f}, s1 = s0;
            int j = 0;
#pragma unroll 1
            for (; j + 4 <= ns; j += 4) {
                f32x4 t[4][2];
#pragma unroll
                for (int q = 0; q < 4; ++q) { const unsigned sq = so + (unsigned)q * (unsigned)(SLAB_F4 * 16); t[q][0] = slab_ld(rs, vr, sq); t[q][1] = slab_ld(rs, vr + 1024u, sq); }
#pragma unroll
                for (int q = 0; q < 4; ++q) { s0 = s0 + t[q][0]; s1 = s1 + t[q][1]; }
                so += 4u * (unsigned)(SLAB_F4 * 16); }
#pragma unroll 1
            for (; j < ns; ++j) { s0 = s0 + slab_ld(rs, vr, so); s1 = s1 + slab_ld(rs, vr + 1024u, so); so += (unsigned)(SLAB_F4 * 16); }
            acc[0][bj][m][0] = s0; acc[0][bj][m][1] = s1;
            asm volatile("" ::: "memory");
        }
}
__device__ __forceinline__ void split_zero_pad(f32x4 (&acc)[2][2][4][2]) {
#pragma unroll
    for (int bj = 0; bj < 2; ++bj)
#pragma unroll
        for (int m = 0; m < 4; ++m)
#pragma unroll
            for (int n = 0; n < 2; ++n) acc[1][bj][m][n] = (f32x4){0.f, 0.f, 0.f, 0.f};
}
struct SplitCtl { f32x4* SLAB; unsigned* cnt; unsigned nsl; };

struct EpiIn {
    static constexpr bool PERM = true, AFTER_DRAIN = false;
    bf16* O; float* vsq; SplitCtl sp;
    template <int ACT> __device__ __forceinline__ void run(const f32x4 (&acc)[2][2][4][2], const Unit& u, int wr, int wc, int fr, int fq, bool dosq) const {
        const int row0 = u.pm * BM + wr * 64 + fr, col0 = u.pn * BM + wc * 32 + 8 * fq;
#pragma unroll
        for (int ai = 0; ai < 2; ++ai)
#pragma unroll
            for (int m = 0; m < 4; ++m) { const int row = row0 + ai * HALF + m * 16; bf16* rowp = O + (size_t)row * N_INP + col0; float sq = 0.f;
#pragma unroll
                for (int bj = 0; bj < 2; ++bj) { f32x4 v0 = acc[ai][bj][m][0], v1 = acc[ai][bj][m][1];
#pragma unroll
                    for (int j = 0; j < 4; ++j) {
                        if (ACT == 1) { v0[j] = gelu_tanh(v0[j]); v1[j] = gelu_tanh(v1[j]); }
                        if (ACT == 2) { v0[j] = sigmoidf_(v0[j]); v1[j] = sigmoidf_(v1[j]); }
                        sq += v0[j] * v0[j] + v1[j] * v1[j]; }
                    u32x4 w; w.x = cvt_pk_bf16(v0[0], v0[1]); w.y = cvt_pk_bf16(v0[2], v0[3]); w.z = cvt_pk_bf16(v1[0], v1[1]); w.w = cvt_pk_bf16(v1[2], v1[3]);
                    *(GAS u32x4*)(rowp + bj * HALF) = w; }
                if (ACT == 1) { if (dosq && vsq) { sq += xor_lt32<16>(sq); sq = add_xor32(sq); if (fq == 0) atomicAdd(vsq + row, sq); } }
            }
    }
    __device__ __forceinline__ void operator()(const f32x4 (&acc)[2][2][4][2], const Unit& u, int wr, int wc, int fr, int fq) const {
        const int pn = u.pn;
        if (pn >= 16) run<2>(acc, u, wr, wc, fr, fq, false);
        else if (pn >= 2 && pn < 6) run<1>(acc, u, wr, wc, fr, fq, pn >= 4);
        else run<0>(acc, u, wr, wc, fr, fq, false);
    }
    __device__ __forceinline__ void partial(f32x4 (&acc)[2][2][4][2], const Unit& u, int wr, int wc, int fr, int fq, int wid, int lane) const {
        split_store(acc, sp.SLAB, u.sid, wid, lane);
        if (split_arrive(sp.cnt + u.cidx * 8 + wid, sp.nsl, lane)) { split_zero_pad(acc); split_sum(acc, sp.SLAB, u.pn * (int)sp.nsl, (int)sp.nsl, wid, lane); (*this)(acc, u, wr, wc, fr, fq); }
    }
};
struct EpiBf16Plain {
    static constexpr bool PERM = true, AFTER_DRAIN = false;
    bf16* O; int ldc;
    __device__ __forceinline__ void partial(f32x4 (&)[2][2][4][2], const Unit&, int, int, int, int, int, int) const {}
    __device__ __forceinline__ void operator()(const f32x4 (&acc)[2][2][4][2], const Unit& u, int wr, int wc, int fr, int fq) const {
        const int row0 = u.pm * BM + wr * 64 + fr, col0 = u.pn * BM + wc * 32 + 8 * fq;
#pragma unroll
        for (int ai = 0; ai < 2; ++ai)
#pragma unroll
            for (int m = 0; m < 4; ++m) { bf16* rowp = O + (size_t)(row0 + ai * HALF + m * 16) * ldc + col0;
#pragma unroll
                for (int bj = 0; bj < 2; ++bj) { const f32x4 v0 = acc[ai][bj][m][0], v1 = acc[ai][bj][m][1];
                    u32x4 w; w.x = cvt_pk_bf16(v0[0], v0[1]); w.y = cvt_pk_bf16(v0[2], v0[3]); w.z = cvt_pk_bf16(v1[0], v1[1]); w.w = cvt_pk_bf16(v1[2], v1[3]);
                    *(GAS u32x4*)(rowp + bj * HALF) = w; } }
    }
};
__device__ __forceinline__ float dpp_ror1(float x) { return __builtin_bit_cast(float, __builtin_amdgcn_update_dpp(0, __builtin_bit_cast(int, x), 0x121, 0xf, 0xf, false)); }
__device__ __forceinline__ float dpp_ror2(float x) { return __builtin_bit_cast(float, __builtin_amdgcn_update_dpp(0, __builtin_bit_cast(int, x), 0x122, 0xf, 0xf, false)); }
__device__ __forceinline__ float dpp_shr1(float old, float x) { return __builtin_bit_cast(float, __builtin_amdgcn_update_dpp(__builtin_bit_cast(int, old), __builtin_bit_cast(int, x), 0x111, 0xf, 0xf, false)); }
__device__ __forceinline__ float dpp_shr2(float old, float x) { return __builtin_bit_cast(float, __builtin_amdgcn_update_dpp(__builtin_bit_cast(int, old), __builtin_bit_cast(int, x), 0x112, 0xf, 0xf, false)); }
struct EpiUpConv {
    static constexpr bool PERM = true, AFTER_DRAIN = false;
    bf16* ACT; float* HALO; const float* cw; const float* cb; const float* st; float* cfs; LAS float* EX; int dry;
    __device__ __forceinline__ void partial(f32x4 (&)[2][2][4][2], const Unit&, int, int, int, int, int, int) const {}
    __device__ __forceinline__ void operator()(const f32x4 (&acc)[2][2][4][2], const Unit& u, int wr, int wc, int fr, int fq) const {
        asm volatile("" : "+v"(fr), "+v"(fq));
        if (dry) {
#pragma unroll
            for (int ai = 0; ai < 2; ++ai)
#pragma unroll
                for (int bj = 0; bj < 2; ++bj)
#pragma unroll
                    for (int m = 0; m < 4; ++m)
#pragma unroll
                        for (int n = 0; n < 2; ++n) asm volatile("" :: "v"(acc[ai][bj][m][n]));
            return; }
        const int cl = wc * 32 + 8 * fq;
        if (u.pm == MPROMPT / 256) {
#pragma unroll
            for (int n = 0; n < 2; ++n) { const int c = u.pn * 128 + cl + 4 * n;
                f32x4 wa0, wa1, wa2, wb0, wb1, wb2, ba, bb;
                wa0 = *(const GAS f32x4*)(cw + c); wa1 = *(const GAS f32x4*)(cw + D_UP + c); wa2 = *(const GAS f32x4*)(cw + 2 * D_UP + c); wb0 = *(const GAS f32x4*)(cw + D_FF + c); wb1 = *(const GAS f32x4*)(cw + D_UP + D_FF + c); wb2 = *(const GAS f32x4*)(cw + 2 * D_UP + D_FF + c);
                ba = *(const GAS f32x4*)(cb + c); bb = *(const GAS f32x4*)(cb + D_FF + c);
#pragma unroll
                for (int m = 0; m < 4; ++m) { const int s = wr * 64 + m * 16 + fr; const float* sp = st + (size_t)s * 2 * D_UP; float* op = cfs + (size_t)s * 2 * D_UP;
                    const f32x4 a2 = *(const GAS f32x4*)(sp + c), a1 = *(const GAS f32x4*)(sp + D_UP + c), b2 = *(const GAS f32x4*)(sp + D_FF + c), b1 = *(const GAS f32x4*)(sp + D_UP + D_FF + c);
                    const f32x4 ua = acc[0][0][m][n], ub = acc[0][1][m][n];
                    *(GAS f32x4*)(op + c) = a1; *(GAS f32x4*)(op + D_FF + c) = b1; *(GAS f32x4*)(op + D_UP + c) = ua; *(GAS f32x4*)(op + D_UP + D_FF + c) = ub;
                    const f32x4 ca = ba + wa0 * a2 + wa1 * a1 + wa2 * ua, cbv = bb + wb0 * b2 + wb1 * b1 + wb2 * ub;
                    u32x2 w; w.x = cvt_pk_bf16(siluf_(ca[0]) * cbv[0], siluf_(ca[1]) * cbv[1]); w.y = cvt_pk_bf16(siluf_(ca[2]) * cbv[2], siluf_(ca[3]) * cbv[3]);
                    *(GAS u32x2*)(ACT + (size_t)(MPROMPT + s) * D_FF + c) = w; }
                asm volatile("" ::: "memory"); }
            return;
        }
        f32x4 wts[2][8];
#pragma unroll
        for (int n = 0; n < 2; ++n) { const int c = u.pn * 128 + cl + 4 * n;
            wts[n][0] = *(const GAS f32x4*)(cw + c); wts[n][1] = *(const GAS f32x4*)(cw + D_UP + c); wts[n][2] = *(const GAS f32x4*)(cw + 2 * D_UP + c);
            wts[n][3] = *(const GAS f32x4*)(cw + D_FF + c); wts[n][4] = *(const GAS f32x4*)(cw + D_UP + D_FF + c); wts[n][5] = *(const GAS f32x4*)(cw + 2 * D_UP + D_FF + c);
            wts[n][6] = *(const GAS f32x4*)(cb + c); wts[n][7] = *(const GAS f32x4*)(cb + D_FF + c); }
        if (fr >= 14) {
#pragma unroll
            for (int ai = 0; ai < 2; ++ai)
#pragma unroll
                for (int bj = 0; bj < 2; ++bj)
#pragma unroll
                    for (int n = 0; n < 2; ++n) *(LAS f32x4*)(EX + ((ai * 2 + wr) * 2 + (fr - 14)) * 256 + bj * 128 + cl + 4 * n) = acc[ai][bj][3][n];
            if (wr == 1) {
#pragma unroll
                for (int bj = 0; bj < 2; ++bj)
#pragma unroll
                    for (int n = 0; n < 2; ++n) *(GAS f32x4*)(HALO + ((size_t)u.pm * 4 + 2 + (fr - 14)) * D_UP + u.pn * 256 + bj * 128 + cl + 4 * n) = acc[1][bj][3][n]; }
        }
        if (fr < 2 && wr == 0) {
#pragma unroll
            for (int bj = 0; bj < 2; ++bj)
#pragma unroll
                for (int n = 0; n < 2; ++n) *(GAS f32x4*)(HALO + ((size_t)u.pm * 4 + fr) * D_UP + u.pn * 256 + bj * 128 + cl + 4 * n) = acc[0][bj][0][n]; }
        asm volatile("s_waitcnt lgkmcnt(0)" ::: "memory"); __builtin_amdgcn_s_barrier(); asm volatile("" ::: "memory");
#pragma unroll
        for (int n = 0; n < 2; ++n) { const int c = u.pn * 128 + cl + 4 * n;
            const f32x4 wa0 = wts[n][0], wa1 = wts[n][1], wa2 = wts[n][2], wb0 = wts[n][3], wb1 = wts[n][4], wb2 = wts[n][5], ba = wts[n][6], bb = wts[n][7];
#pragma unroll
            for (int ai = 0; ai < 2; ++ai)
#pragma unroll
                for (int m = 0; m < 4; ++m) {
                    f32x4 cv[2];
#pragma unroll
                    for (int bj = 0; bj < 2; ++bj) { const f32x4 cur = acc[ai][bj][m][n]; f32x4 pb;
                        if (m > 0) pb = acc[ai][bj][m - 1][n];
                        else { pb = (f32x4){0.f, 0.f, 0.f, 0.f};
                            const int sa = wr == 1 ? ai : 0, sw = wr == 1 ? 0 : 1; const bool have = (wr == 1) || (ai == 1);
                            if (have && fr >= 14) pb = *(const LAS f32x4*)(EX + ((sa * 2 + sw) * 2 + (fr - 14)) * 256 + bj * 128 + cl + 4 * n); }
                        f32x4 x1, x2;
#pragma unroll
                        for (int j = 0; j < 4; ++j) { x1[j] = dpp_shr1(dpp_ror1(pb[j]), cur[j]); x2[j] = dpp_shr2(dpp_ror2(pb[j]), cur[j]); }
                        cv[bj] = bj == 0 ? ba + wa0 * x2 + wa1 * x1 + wa2 * cur : bb + wb0 * x2 + wb1 * x1 + wb2 * cur; }
                    u32x2 w; w.x = cvt_pk_bf16(siluf_(cv[0][0]) * cv[1][0], siluf_(cv[0][1]) * cv[1][1]); w.y = cvt_pk_bf16(siluf_(cv[0][2]) * cv[1][2], siluf_(cv[0][3]) * cv[1][3]);
                    *(GAS u32x2*)(ACT + (size_t)(u.pm * BM + ai * HALF + wr * 64 + m * 16 + fr) * D_FF + c) = w; }
            asm volatile("" ::: "memory"); }
    }
};
struct EpiGlu {
    static constexpr bool PERM = true, AFTER_DRAIN = false;
    const bf16* Y; bf16* O;
    __device__ __forceinline__ void partial(f32x4 (&)[2][2][4][2], const Unit&, int, int, int, int, int, int) const {}
    __device__ __forceinline__ void operator()(const f32x4 (&acc)[2][2][4][2], const Unit& u, int wr, int wc, int fr, int fq) const {
        const int row0 = u.pm * BM + wr * 64 + fr, col0 = u.pn * BM + wc * 32 + 8 * fq;
#pragma unroll
        for (int ai = 0; ai < 2; ++ai)
#pragma unroll
            for (int m = 0; m < 4; ++m) { const size_t off = (size_t)(row0 + ai * HALF + m * 16) * 512 + col0;
#pragma unroll
                for (int bj = 0; bj < 2; ++bj) { const f32x4 v0 = acc[ai][bj][m][0], v1 = acc[ai][bj][m][1];
                    const u32x4 y = *(const GAS u32x4*)(Y + off + bj * HALF);
                    u32x4 w;
                    w.x = cvt_pk_bf16(bflo(y.x) * sigmoidf_(v0[0]), bfhi(y.x) * sigmoidf_(v0[1]));
                    w.y = cvt_pk_bf16(bflo(y.y) * sigmoidf_(v0[2]), bfhi(y.y) * sigmoidf_(v0[3]));
                    w.z = cvt_pk_bf16(bflo(y.z) * sigmoidf_(v1[0]), bfhi(y.z) * sigmoidf_(v1[1]));
                    w.w = cvt_pk_bf16(bflo(y.w) * sigmoidf_(v1[2]), bfhi(y.w) * sigmoidf_(v1[3]));
                    *(GAS u32x4*)(O + off + bj * HALF) = w; } }
    }
};
template <int MODE> struct EpiMerge {
    static constexpr bool PERM = false, AFTER_DRAIN = false;
    const bf16* G;
    float* T; bf16* MG; const float* csq;
    f32x4* SLAB; const bf16* PRJ; unsigned* cnt;
    __device__ __forceinline__ void partial(f32x4 (&acc)[2][2][4][2], const Unit& u, int wr, int wc, int fr, int fq, int wid, int lane) const {
        split_store(acc, SLAB, u.sid, wid, lane);
        if (!split_arrive(cnt + u.cidx * 8 + wid, 8u, lane)) return;
        asm volatile("" : "+v"(fr), "+v"(fq), "+v"(lane));
#pragma unroll
        for (int m = 0; m < 4; ++m) { const int r = wr * 64 + m * 16 + fr, row = MPROMPT + r; const float rs = rsqrtf(csq[row] * (1.0f / 1024.0f) + EPS);
#pragma unroll
            for (int bj = 0; bj < 2; ++bj)
#pragma unroll
                for (int n = 0; n < 2; ++n) { const int col = split_col<PERM>(u, wc, fq, bj, n), reg = (m * 2 + bj) * 2 + n; const bf16* gp = PRJ + ((unsigned)row * N_INP + col);
                    const f32x4 a = split_sum1(SLAB, u.pn * 2, 2, wid, lane, reg), b = split_sum1(SLAB, 16 + u.pn * 2, 2, wid, lane, reg), c = split_sum1(SLAB, 32 + u.pn * 4, 4, wid, lane, reg);
                    const u32x2 ga = *(const GAS u32x2*)(gp + PC_GA), gb = *(const GAS u32x2*)(gp + PC_GB), gc = *(const GAS u32x2*)(gp + PC_GC);
                    f32x4 t; t[0] = bflo(ga.x) * a[0] + bflo(gb.x) * b[0] + bflo(gc.x) * rs * c[0]; t[1] = bfhi(ga.x) * a[1] + bfhi(gb.x) * b[1] + bfhi(gc.x) * rs * c[1];
                    t[2] = bflo(ga.y) * a[2] + bflo(gb.y) * b[2] + bflo(gc.y) * rs * c[2]; t[3] = bfhi(ga.y) * a[3] + bfhi(gb.y) * b[3] + bfhi(gc.y) * rs * c[3];
                    u32x2 w; w.x = cvt_pk_bf16(t[0], t[1]); w.y = cvt_pk_bf16(t[2], t[3]); *(GAS u32x2*)(MG + ((unsigned)row * DM + col)) = w; }
            asm volatile("" ::: "memory"); }
    }
    __device__ __forceinline__ void operator()(const f32x4 (&acc)[2][2][4][2], const Unit& u, int wr, int wc, int fr, int fq) const {
        const int row0 = u.pm * BM + wr * 64 + fr, col0 = u.pn * BM + wc * 32 + 4 * fq;
#pragma unroll
        for (int ai = 0; ai < 2; ++ai)
#pragma unroll
            for (int m = 0; m < 4; ++m) { const int row = row0 + ai * HALF + m * 16; const size_t off = (size_t)row * DM + col0; const bf16* gp = G + (size_t)row * N_INP + col0;
                float rs = 1.f; if (MODE == 2) rs = rsqrtf(csq[row] * (1.0f / 1024.0f) + EPS);
#pragma unroll
                for (int bj = 0; bj < 2; ++bj)
#pragma unroll
                    for (int n = 0; n < 2; ++n) { const int co = bj * HALF + n * 16; const u32x2 g = *(const GAS u32x2*)(gp + co); f32x4 v = acc[ai][bj][m][n];
                        v[0] *= bflo(g.x); v[1] *= bfhi(g.x); v[2] *= bflo(g.y); v[3] *= bfhi(g.y);
                        bf16* Tb = (bf16*)T;
                        if (MODE == 0) { u32x2 w; w.x = cvt_pk_bf16(v[0], v[1]); w.y = cvt_pk_bf16(v[2], v[3]); *(GAS u32x2*)(Tb + off + co) = w; }
                        if (MODE == 1) { const u32x2 tb = *(const GAS u32x2*)(Tb + off + co); u32x2 w; w.x = cvt_pk_bf16(bflo(tb.x) + v[0], bfhi(tb.x) + v[1]); w.y = cvt_pk_bf16(bflo(tb.y) + v[2], bfhi(tb.y) + v[3]); *(GAS u32x2*)(Tb + off + co) = w; }
                        if (MODE == 2) { const u32x2 tb = *(const GAS u32x2*)(Tb + off + co); f32x4 t = {bflo(tb.x), bfhi(tb.x), bflo(tb.y), bfhi(tb.y)}; t = t + v * rs; u32x2 w; w.x = cvt_pk_bf16(t[0], t[1]); w.y = cvt_pk_bf16(t[2], t[3]); *(GAS u32x2*)(MG + off + co) = w; } } }
    }
};
template <int SEG> struct EpiChain {
    static constexpr bool PERM = false, AFTER_DRAIN = false;
    const bf16* PRJ; bf16* MG; const float* csq;
    __device__ __forceinline__ void partial(f32x4 (&)[2][2][4][2], const Unit&, int, int, int, int, int, int) const {}
    __device__ __forceinline__ void operator()(f32x4 (&acc)[2][2][4][2], const Unit& u, int wr, int wc, int fr, int fq) const {
        const int row0 = u.pm * BM + wr * 64 + fr, col0 = u.pn * BM + wc * 32 + 4 * fq;
#pragma unroll
        for (int ai = 0; ai < 2; ++ai)
#pragma unroll
            for (int m = 0; m < 4; ++m) { const int row = row0 + ai * HALF + m * 16; const bf16* gp = PRJ + ((unsigned)row * N_INP + col0);
                float rs = 1.f; if (SEG >= 1) rs = rsqrtf(csq[row] * (1.0f / 1024.0f) + EPS);
#pragma unroll
                for (int bj = 0; bj < 2; ++bj)
#pragma unroll
                    for (int n = 0; n < 2; ++n) { const int co = bj * HALF + n * 16; f32x4 v = acc[ai][bj][m][n];
                        if (SEG == 0) { const u32x2 ga = *(const GAS u32x2*)(gp + PC_GA + co), gb = *(const GAS u32x2*)(gp + PC_GB + co);
                            v[0] *= bflo(ga.x) * __builtin_amdgcn_rcpf(fmaxf(bflo(gb.x), 1e-20f)); v[1] *= bfhi(ga.x) * __builtin_amdgcn_rcpf(fmaxf(bfhi(gb.x), 1e-20f));
                            v[2] *= bflo(ga.y) * __builtin_amdgcn_rcpf(fmaxf(bflo(gb.y), 1e-20f)); v[3] *= bfhi(ga.y) * __builtin_amdgcn_rcpf(fmaxf(bfhi(gb.y), 1e-20f)); acc[ai][bj][m][n] = v; }
                        if (SEG == 1) { const u32x2 gb = *(const GAS u32x2*)(gp + PC_GB + co), gc = *(const GAS u32x2*)(gp + PC_GC + co);
                            v[0] *= fmaxf(bflo(gb.x), 1e-20f) * __builtin_amdgcn_rcpf(fmaxf(bflo(gc.x) * rs, 1e-20f)); v[1] *= fmaxf(bfhi(gb.x), 1e-20f) * __builtin_amdgcn_rcpf(fmaxf(bfhi(gc.x) * rs, 1e-20f));
                            v[2] *= fmaxf(bflo(gb.y), 1e-20f) * __builtin_amdgcn_rcpf(fmaxf(bflo(gc.y) * rs, 1e-20f)); v[3] *= fmaxf(bfhi(gb.y), 1e-20f) * __builtin_amdgcn_rcpf(fmaxf(bfhi(gc.y) * rs, 1e-20f)); acc[ai][bj][m][n] = v; }
                        if (SEG == 2) { const u32x2 gc = *(const GAS u32x2*)(gp + PC_GC + co);
                            v[0] *= fmaxf(bflo(gc.x) * rs, 1e-20f); v[1] *= fmaxf(bfhi(gc.x) * rs, 1e-20f); v[2] *= fmaxf(bflo(gc.y) * rs, 1e-20f); v[3] *= fmaxf(bfhi(gc.y) * rs, 1e-20f);
                            u32x2 w; w.x = cvt_pk_bf16(v[0], v[1]); w.y = cvt_pk_bf16(v[2], v[3]); *(GAS u32x2*)(MG + ((unsigned)row * DM + col0 + co)) = w; } }
                asm volatile("" ::: "memory"); }
    }
};
struct EpiResid {
    static constexpr bool PERM = false, AFTER_DRAIN = false;
    const bf16* XI; const bf16* XIS; bf16* XO; const float* gate; SplitCtl sp;
    __device__ __forceinline__ void partial(f32x4 (&acc)[2][2][4][2], const Unit& u, int wr, int wc, int fr, int fq, int wid, int lane) const {
        split_store(acc, sp.SLAB, u.sid, wid, lane);
        if (split_arrive(sp.cnt + u.cidx * 8 + wid, sp.nsl, lane)) { split_zero_pad(acc); split_sum(acc, sp.SLAB, u.pn * (int)sp.nsl, (int)sp.nsl, wid, lane); (*this)(acc, u, wr, wc, fr, fq); }
    }
    __device__ __forceinline__ void operator()(const f32x4 (&acc)[2][2][4][2], const Unit& u, int wr, int wc, int fr, int fq) const {
        const int row0 = u.pm * BM + wr * 64 + fr, col0 = u.pn * BM + wc * 32 + 4 * fq;
        const __amdgpu_buffer_rsrc_t xr = __builtin_amdgcn_make_buffer_rsrc((void*)XO, (short)0, (int)((size_t)MP * DM * 2), 0x00020000);
        const bool samp = u.pm == MPROMPT / 256;
        const bf16* xs16 = samp ? XIS - (size_t)MPROMPT * DM : XI;
#pragma unroll
        for (int ai = 0; ai < 2; ++ai) { if (ai == 1 && samp) break;
            u32x2 xw[4][2][2]; f32x4 gg[4][2][2];
#pragma unroll
            for (int m = 0; m < 4; ++m) { const int row = row0 + ai * HALF + m * 16; const size_t off = (size_t)row * DM + col0; const float* gp = gate + (size_t)mod_row(row) * MOD_PITCH + col0;
#pragma unroll
                for (int bj = 0; bj < 2; ++bj)
#pragma unroll
                    for (int n = 0; n < 2; ++n) { const int co = bj * HALF + n * 16; xw[m][bj][n] = *(const GAS u32x2*)(xs16 + off + co); gg[m][bj][n] = *(const GAS f32x4*)(gp + co); } }
#pragma unroll
            for (int m = 0; m < 4; ++m) { const int row = row0 + ai * HALF + m * 16; const size_t off = (size_t)row * DM + col0;
#pragma unroll
                for (int bj = 0; bj < 2; ++bj)
#pragma unroll
                    for (int n = 0; n < 2; ++n) { const int co = bj * HALF + n * 16; const u32x2 w = xw[m][bj][n]; const f32x4 xi = {bflo(w.x), bfhi(w.x), bflo(w.y), bfhi(w.y)};
                        const f32x4 xo = xi + gg[m][bj][n] * acc[ai][bj][m][n]; u32x2 wo; wo.x = cvt_pk_bf16(xo[0], xo[1]); wo.y = cvt_pk_bf16(xo[2], xo[3]);
                        __builtin_amdgcn_raw_buffer_store_b64(wo, xr, (unsigned)(off + co) * 2u, 0,   16); } } }
    }
};
template <int MODE> struct EpiResidPrep {
    static constexpr bool PERM = false, AFTER_DRAIN = true;
    EpiResid R; bf16* H; float* yp; float* ys; const float* g; const float* mod2; int sh_idx, sc_idx; const float* wdt; float* DT; unsigned* pc;
    __device__ __forceinline__ void partial(f32x4 (&acc)[2][2][4][2], const Unit& u, int wr, int wc, int fr, int fq, int wid, int lane) const {
        split_store(acc, R.sp.SLAB, u.sid, wid, lane);
        if (split_arrive(R.sp.cnt + u.cidx * 8 + wid, R.sp.nsl, lane)) { split_zero_pad(acc); split_sum(acc, R.sp.SLAB, u.pn * (int)R.sp.nsl, (int)R.sp.nsl, wid, lane); R(acc, u, wr, wc, fr, fq);
            asm volatile("s_waitcnt vmcnt(0)" ::: "memory");
            if (lane == 0) __hip_atomic_fetch_add(pc + 32, 1u, __ATOMIC_RELAXED, __HIP_MEMORY_SCOPE_AGENT); }
    }
    __device__ __forceinline__ void operator()(const f32x4 (&acc)[2][2][4][2], const Unit& u, int wr, int wc, int fr, int fq) const { R(acc, u, wr, wc, fr, fq); }
    __device__ __forceinline__ void fused(f32x4 (&acc)[2][2][4][2], const Unit& u, int wr, int wc, int fr, int fq, LAS unsigned char* lds, int wid, int lane) const {
        R(acc, u, wr, wc, fr, fq);
        asm volatile("s_waitcnt vmcnt(0)" ::: "memory"); __syncthreads();
        if (wid == 0 && lane == 0) {
            __hip_atomic_fetch_add(pc + u.pm, 1u, __ATOMIC_RELAXED, __HIP_MEMORY_SCOPE_AGENT);
            unsigned sp_ = 0; while (__hip_atomic_load(pc + u.pm, __ATOMIC_RELAXED, __HIP_MEMORY_SCOPE_AGENT) < 8u && ++sp_ < (1u << 22)) __builtin_amdgcn_s_sleep(2);
            if (u.pn == 0) { sp_ = 0; while (__hip_atomic_load(pc + 32, __ATOMIC_RELAXED, __HIP_MEMORY_SCOPE_AGENT) < 64u && ++sp_ < (1u << 22)) __builtin_amdgcn_s_sleep(2); }
            __builtin_amdgcn_fence(__ATOMIC_ACQUIRE, "agent"); asm volatile("s_waitcnt vmcnt(0)" ::: "memory");
        }
        __syncthreads();
        LAS float* wT = (LAS float*)lds;
        if (MODE == 1) { f32x4 tw[16];
#pragma unroll
            for (int i = 0; i < 16; ++i) tw[i] = ((const f32x4*)wdt)[wid * 64 + lane + i * NTHR];
#pragma unroll
            for (int i = 0; i < 16; ++i) ((LAS f32x4*)wT)[wid * 64 + lane + i * NTHR] = tw[i];
            __syncthreads(); }
        const bf16* X = R.XO;
        {   const int row = u.pm * BM + u.pn * 32 + wid * 4;
            prep_rows4<MODE>(X + (size_t)row * DM, g, mod2 + (size_t)mod_row(row) * MOD_PITCH, sh_idx, sc_idx, H + (size_t)row * DM, yp + (size_t)row * DM, DT + (size_t)row * 16, wT, lane); }
        if (u.pn == 0 && wid < 4) { const int s = u.pm * 4 + wid, row = MPROMPT + s;
            prep_row<MODE>(X + (size_t)row * DM, g, mod2 + (size_t)mod_row(row) * MOD_PITCH, sh_idx, sc_idx, H + (size_t)row * DM, ys + (size_t)s * DM, DT + (size_t)row * 16, wT, lane); }
        if (MODE == 1) __syncthreads();
    }
};
struct EpiMod {
    static constexpr bool PERM = false, AFTER_DRAIN = false;
    float* MOD; const float* bmod;
    __device__ __forceinline__ void partial(f32x4 (&)[2][2][4][2], const Unit&, int, int, int, int, int, int) const {}
    __device__ __forceinline__ void operator()(const f32x4 (&acc)[2][2][4][2], const Unit& u, int wr, int wc, int fr, int fq) const {
        const int row0 = wr * 64 + fr, col0 = u.pn * BM + wc * 32 + 4 * fq;
        f32x4 bv[2][2];
#pragma unroll
        for (int bj = 0; bj < 2; ++bj)
#pragma unroll
            for (int n = 0; n < 2; ++n) bv[bj][n] = *(const GAS f32x4*)(bmod + col0 + bj * HALF + n * 16);
#pragma unroll
        for (int ai = 0; ai < 2; ++ai)
#pragma unroll
            for (int m = 0; m < 4; ++m) { float* rowp = MOD + (size_t)(row0 + ai * HALF + m * 16) * MOD_PITCH + col0;
#pragma unroll
                for (int bj = 0; bj < 2; ++bj)
#pragma unroll
                    for (int n = 0; n < 2; ++n) *(GAS f32x4*)(rowp + bj * HALF + n * 16) = acc[ai][bj][m][n] + bv[bj][n]; }
    }
};
}
struct Frame {
    LAS unsigned char* lds;
    int tid, lane, wave, gw;
    float* out; unsigned char* ws;
};
#define WSP(T, off) ((T*)(F.ws + (off)))
__device__ __forceinline__ Frame launder(const Frame& F0) {
    Frame F = F0; int t = F0.tid; asm volatile("" : "+v"(t)); F.tid = t; F.lane = t & 63; F.wave = __builtin_amdgcn_readfirstlane(t >> 6);
    unsigned long long w = (unsigned long long)F0.ws, o = (unsigned long long)F0.out; asm volatile("" : "+s"(w), "+s"(o)); F.ws = (unsigned char*)w; F.out = (float*)o;
    F.gw = blockIdx.x * NWAVES + F.wave; return F;
}

__device__ __forceinline__ void transpose_item(const float* W, int ld, int K, int ncols, int c0, bf16* WT, int row_off, LAS float* scr, int item, int lane) {
    const int nblk = ncols / 32, kb = item / nblk, nb = item % nblk, k0 = 64 * kb, n0 = 32 * nb;
    const int rbase = row_off >= 0 ? row_off + n0 : (n0 < D_FF ? 256 * (n0 / 128) + n0 % 128 : 256 * ((n0 - D_FF) / 128) + 128 + (n0 - D_FF) % 128);
    float tv[32];
#pragma unroll
    for (int i = 0; i < 32; ++i) { const int kk = 2 * i + (lane >> 5); tv[i] = __builtin_nontemporal_load(W + (size_t)(k0 + kk) * ld + c0 + n0 + (lane & 31)); }
#pragma unroll
    for (int i = 0; i < 32; ++i) { const int kk = 2 * i + (lane >> 5); scr[kk * 33 + (lane & 31)] = tv[i]; }
    if (false) for (int i = 0; i < 32; ++i) { const int kk = 2 * i + (lane >> 5); scr[kk * 33 + (lane & 31)] = __builtin_nontemporal_load(W + (size_t)(k0 + kk) * ld + c0 + n0 + (lane & 31)); }
    LDS_WAIT(); asm volatile("" ::: "memory");
    const int c = lane & 7;
#pragma unroll
    for (int j = 0; j < 4; ++j) { const int n = (lane >> 3) + 8 * j; const LAS float* s = scr + (8 * c) * 33 + n;
        v4u o; o.x = pk2(s[0 * 33], s[1 * 33]); o.y = pk2(s[2 * 33], s[3 * 33]); o.z = pk2(s[4 * 33], s[5 * 33]); o.w = pk2(s[6 * 33], s[7 * 33]);
        *(GAS v4u*)(WT + (size_t)(rbase + n) * K + k0 + 8 * c) = o; }
    LDS_WAIT(); asm volatile("" ::: "memory");
}
constexpr int MODC = 96, MODK = 128, MODP = 136;
__device__ __forceinline__ void phase_mod(const Frame& F0, KArgs A) {
    Frame F = launder(F0);
    const int n0 = blockIdx.x * MODC, l = n0 / N_MOD, cl = n0 - l * N_MOD;
    const float* W = A->in[I_WMOD] + (size_t)l * DM * N_MOD + cl;
    LAS bf16* Bt = (LAS bf16*)F.lds;
    LAS bf16* As = (LAS bf16*)(F.lds + 2 * MODC * MODP * 2);
    for (int i = F.tid; i < 2 * 12 * MODP; i += NTHR) { const int b = i / (12 * MODP), r = i % (12 * MODP); As[(b * 144 + 132) * MODP + r] = (bf16)0; }
    f32x4 wa[6], wb[6], creg[9];
    auto load_w = [&](f32x4 (&wr)[6], int kc) {
#pragma unroll
        for (int j = 0; j < 6; ++j) { const int idx = F.tid + NTHR * j, n = idx % MODC, k = 4 * (idx / MODC); const float* p = W + (size_t)(kc * MODK + k) * N_MOD + n;
            wr[j].x = __builtin_nontemporal_load(p); wr[j].y = __builtin_nontemporal_load(p + N_MOD); wr[j].z = __builtin_nontemporal_load(p + 2 * N_MOD); wr[j].w = __builtin_nontemporal_load(p + 3 * (size_t)N_MOD); }
    };
    auto load_c = [&](int kc) {
#pragma unroll
        for (int j = 0; j < 9; ++j) { const int idx = F.tid + NTHR * j, r = idx >> 5, k4 = (idx & 31) * 4;
            const float* src = r < NB ? A->in[I_CP] + (size_t)r * DM : A->in[I_CS] + (size_t)(r - NB) * DM;
            creg[j] = r < NB + NS ? *(const GAS f32x4*)(src + kc * MODK + k4) : (f32x4){0.f, 0.f, 0.f, 0.f}; }
    };
    auto store_w = [&](const f32x4 (&wr)[6], int buf) {
#pragma unroll
        for (int j = 0; j < 6; ++j) { const int idx = F.tid + NTHR * j, n = idx % MODC, k = 4 * (idx / MODC);
            v2u w; w.x = pk2(wr[j].x, wr[j].y); w.y = pk2(wr[j].z, wr[j].w); *(LAS v2u*)(Bt + (buf * MODC + n) * MODP + k) = w; }
    };
    auto store_c = [&](int buf) {
#pragma unroll
        for (int j = 0; j < 9; ++j) { const int idx = F.tid + NTHR * j, r = idx >> 5, k4 = (idx & 31) * 4;
            if (r < NB + NS) { v2u w; w.x = pk2(siluf_(creg[j].x), siluf_(creg[j].y)); w.y = pk2(siluf_(creg[j].z), siluf_(creg[j].w)); *(LAS v2u*)(As + (buf * 144 + r) * MODP + k4) = w; } }
    };
    f32x4 acc[9];
#pragma unroll
    for (int m = 0; m < 9; ++m) acc[m] = (f32x4){0.f, 0.f, 0.f, 0.f};
    auto compute = [&](int buf) {
        if (F.wave < 6) {
#pragma unroll
            for (int ks = 0; ks < MODK / 32; ++ks) { const bf16x8 bfr = *(const LAS bf16x8*)(Bt + (buf * MODC + 16 * F.wave + (F.lane & 15)) * MODP + 32 * ks + 8 * (F.lane >> 4));
#pragma unroll
                for (int m = 0; m < 9; ++m) { const bf16x8 af = *(const LAS bf16x8*)(As + (buf * 144 + 16 * m + (F.lane & 15)) * MODP + 32 * ks + 8 * (F.lane >> 4));
                    acc[m] = __builtin_amdgcn_mfma_f32_16x16x32_bf16(af, bfr, acc[m], 0, 0, 0); } }
        }
    };
    const int kst = blockIdx.x & 15;
    load_w(wa, kst); load_c(kst); load_w(wb, (1 + kst) & 15);
    store_w(wa, 0); store_c(0); __syncthreads();
#pragma unroll 1
    for (int kc = 0; kc < DM / MODK; kc += 2) {
        load_c((kc + 1 + kst) & 15); if (kc + 2 < DM / MODK) load_w(wa, (kc + 2 + kst) & 15);
        compute(0);
        store_w(wb, 1); store_c(1); __syncthreads();
        if (kc + 2 < DM / MODK) { load_c((kc + 2 + kst) & 15); if (kc + 3 < DM / MODK) load_w(wb, (kc + 3 + kst) & 15); }
        compute(1);
        if (kc + 2 < DM / MODK) { store_w(wa, 0); store_c(0); }
        __syncthreads();
    }
    if (F.wave < 6) { float* MOD = WSP(float, WS_MOD); const int col = n0 + 16 * F.wave + (F.lane & 15); const float bias = A->in[I_BMOD][col];
#pragma unroll
        for (int m = 0; m < 9; ++m)
#pragma unroll
            for (int r = 0; r < 4; ++r) { const int row = 16 * m + 4 * (F.lane >> 4) + r; if (row < NB + NS) MOD[(size_t)row * MOD_PITCH + col] = acc[m][r] + bias; } }
    __syncthreads();
}
__device__ __forceinline__ void tjob(Frame& F, LAS float* scr, const float* W, int ld, int K, int ncols, int c0, bf16* WT, int row_off) {
    const int nit = (K / 64) * (ncols / 32);
    for (int it = F.gw; it < nit; it += (GRID * NWAVES)) transpose_item(W, ld, K, ncols, c0, WT, row_off, scr, it, F.lane);
}
__device__ __forceinline__ void phase_prologue(const Frame& F0, KArgs A) {
    Frame F = launder(F0);
    LAS float* scr = (LAS float*)(F.lds + F.wave * 16384);
#pragma unroll 1
    for (int l = 0; l < DEPTH; ++l) {
        unsigned char* wl = F.ws + WS_W + (size_t)l * WL_END;
        tjob(F, scr, A->in[I_WIN] + (size_t)l * DM * N_IN, N_IN, DM, 4096, 0, (bf16*)(wl + WL_IN), 0);
        tjob(F, scr, A->in[I_WIN] + (size_t)l * DM * N_IN, N_IN, DM, 6144, 4112, (bf16*)(wl + WL_IN), 4096);
        tjob(F, scr, A->in[I_WGLU] + (size_t)l * 512 * 512, 512, 512, 512, 0, (bf16*)(wl + WL_GLU), 0);
        tjob(F, scr, A->in[I_WPA] + (size_t)l * 512 * DM, DM, 512, DM, 0, (bf16*)(wl + WL_PA), 0);
        tjob(F, scr, A->in[I_WPB] + (size_t)l * 512 * DM, DM, 512, DM, 0, (bf16*)(wl + WL_PB), 0);
        tjob(F, scr, A->in[I_WPC] + (size_t)l * 1024 * DM, DM, 1024, DM, 0, (bf16*)(wl + WL_PC), 0);
        tjob(F, scr, A->in[I_WOUT] + (size_t)l * DM * DM, DM, DM, DM, 0, (bf16*)(wl + WL_OUT), 0);
        tjob(F, scr, A->in[I_WUP] + (size_t)l * DM * D_UP, D_UP, DM, D_UP, 0, (bf16*)(wl + WL_UP), -1);
        tjob(F, scr, A->in[I_WDOWN] + (size_t)l * D_FF * DM, DM, D_FF, DM, 0, (bf16*)(wl + WL_DOWN), 0);
    }
    {   bf16* X0 = WSP(bf16, WS_X0);
        for (int r = F.gw; r < MREAL; r += (GRID * NWAVES)) {
            const float* src = r < MPROMPT ? A->in[I_XP] + (size_t)r * DM : A->in[I_XS] + (size_t)(r - MPROMPT) * DM;
            GAS v2u* o = (GAS v2u*)(X0 + (size_t)r * DM) + F.lane;
#pragma unroll
            for (int j = 0; j < 8; ++j) { const f32x4 v = __builtin_nontemporal_load((const f32x4*)src + F.lane + 64 * j); v2u w; w.x = pk2(v.x, v.y); w.y = pk2(v.z, v.w); o[64 * j] = w; }
        }
    }
    {   float* z = WSP(float, WS_SMALL + SM_VSQ);
        const int gt = blockIdx.x * NTHR + F.tid;
        for (int i = gt; i < 4 * MP; i += GRID * NTHR) z[i] = 0.f;
    }
    {   const int gt = blockIdx.x * NTHR + F.tid, NT = GRID * NTHR;
        bf16* WSb = WSP(bf16, WS_SMALL + SM_WS);
        for (int i = gt; i < DEPTH * H_B * 128 * 128; i += NT) { const int jj = i & 127, ii = (i >> 7) & 127; WSb[i] = (bf16)(jj <= ii ? f2bf(A->in[I_WS][i]) : 0u); }
        float* AA = WSP(float, WS_SMALL + SM_S5A); float* BB = WSP(float, WS_SMALL + SM_S5BB); bf16* CT = WSP(bf16, WS_SMALL + SM_S5CT);
        for (int i = gt; i < DEPTH * G_A * P_A; i += NT) {
            const int l = i / (G_A * P_A), g = (i / P_A) % G_A;
            const float dt = expf(A->in[I_LOGDT][l * G_A + g]), lr = A->in[I_LAMRE][i], li = A->in[I_LAMIM][i];
            const float mag = expf(lr * dt); float sn, cs; sincosf(li * dt, &sn, &cs);
            const float ar = mag * cs, ai = mag * sn, den = lr * lr + li * li, nr = ar - 1.0f;
            const float kr = (nr * lr + ai * li) / den, ki = (ai * lr - nr * li) / den;
            float qr = ar, qi = ai;
#pragma unroll
            for (int s = 0; s < 6; ++s) { const float t = qr * qr - qi * qi; qi = 2.0f * qr * qi; qr = t; }
            AA[i * 4 + 0] = ar; AA[i * 4 + 1] = ai; AA[i * 4 + 2] = qr; AA[i * 4 + 3] = qi;
#pragma unroll
            for (int h = 0; h < S5G; ++h) { const float bre = A->in[I_BRE][(size_t)i * S5G + h], bim = A->in[I_BIM][(size_t)i * S5G + h];
                BB[(size_t)i * 32 + h] = kr * bre - ki * bim; BB[(size_t)i * 32 + 16 + h] = kr * bim + ki * bre; }
        }
        {   float* WDT = WSP(float, WS_SMALL + SM_WDT);
            for (int i = gt; i < DEPTH * 16 * DM; i += NT) { const int k = i % DM, hh = (i / DM) & 15, l = i / (16 * DM); WDT[i] = A->in[I_WIN][((size_t)l * DM + k) * N_IN + 4096 + hh]; } }
        for (int i = gt; i < DEPTH * G_A * S5G * 128; i += NT) { const int k = i & 127, lgh = i >> 7;
            const float v = k < 64 ? A->in[I_CRE][(size_t)lgh * 64 + k] : -A->in[I_CIM][(size_t)lgh * 64 + (k - 64)]; CT[i] = (bf16)f2bf(v); }
    }
}

template <bool WITH_DT>
__device__ __forceinline__ void phase_prep(const Frame& F0, const float* X, const float* XS, const float* g, const float* modl, int sh_idx, int sc_idx, const float* win_l, float* DT) {
    Frame F = launder(F0);
    bf16* H = WSP(bf16, WS_H);
    LAS float* wT = (LAS float*)F.lds;
    if (WITH_DT) {
        {   const GAS f32x4* wd = (const GAS f32x4*)WSP(const float, WS_SMALL + SM_WDT);
            f32x4 tw[16];
#pragma unroll
            for (int i = 0; i < 16; ++i) tw[i] = wd[F.tid + i * NTHR];
#pragma unroll
            for (int i = 0; i < 16; ++i) ((LAS f32x4*)wT)[F.tid + i * NTHR] = tw[i]; }
        (void)win_l;
        __syncthreads();
    }
    if (WITH_DT) {
        const bf16* X0 = WSP(const bf16, WS_X0); float* DTo = DT; const int gwv = blockIdx.x * NWAVES + F.wave;
        {   const int row = 4 * gwv; prep_rows4<1>(X0 + (size_t)row * DM, g, modl + (size_t)mod_row(row) * MOD_PITCH, sh_idx, sc_idx, H + (size_t)row * DM, nullptr, DTo + (size_t)row * 16, wT, F.lane); }
        if (gwv < NS) { const int row = MPROMPT + gwv; prep_row<1>(X0 + (size_t)row * DM, g, modl + (size_t)mod_row(row) * MOD_PITCH, sh_idx, sc_idx, H + (size_t)row * DM, nullptr, DTo + (size_t)row * 16, wT, F.lane); }
    } else {
    f32x4 vn[8];
    {   const int r0 = blockIdx.x * NWAVES + F.wave; const int rr0 = r0 < MREAL ? r0 : 0; const GAS f32x4* xr = (const GAS f32x4*)(rr0 < MPROMPT ? X + (size_t)rr0 * DM : XS + (size_t)(rr0 - MPROMPT) * DM) + F.lane;
#pragma unroll
        for (int j = 0; j < 8; ++j) vn[j] = xr[64 * j]; }
    for (int r = blockIdx.x * NWAVES + F.wave; r < MREAL; r += GRID * NWAVES) {
        f32x4 v[8]; float s = 0.f;
#pragma unroll
        for (int j = 0; j < 8; ++j) { v[j] = vn[j]; s += (v[j].x * v[j].x + v[j].y * v[j].y) + (v[j].z * v[j].z + v[j].w * v[j].w); }
        {   const int rn = r + GRID * NWAVES; const int rr1 = rn < MREAL ? rn : r; const GAS f32x4* xr = (const GAS f32x4*)(rr1 < MPROMPT ? X + (size_t)rr1 * DM : XS + (size_t)(rr1 - MPROMPT) * DM) + F.lane;
#pragma unroll
            for (int j = 0; j < 8; ++j) vn[j] = xr[64 * j]; }
        const float rinv = rsqrtf(wave_sum(s) * (1.0f / DM) + EPS);
        const float* mr = modl + (size_t)mod_row(r) * MOD_PITCH;
        const GAS f32x4* gp = (const GAS f32x4*)g + F.lane; const GAS f32x4* shp = (const GAS f32x4*)(mr + sh_idx * DM) + F.lane; const GAS f32x4* scp = (const GAS f32x4*)(mr + sc_idx * DM) + F.lane;
        GAS v2u* o = (GAS v2u*)(H + (size_t)r * DM) + F.lane;
#pragma unroll
        for (int j = 0; j < 8; ++j) { const f32x4 gg = gp[64 * j], sh = shp[64 * j], sc = scp[64 * j];
            v[j] = v[j] * rinv * gg * (sc + 1.0f) + sh;
            v2u w; w.x = pk2(v[j].x, v[j].y); w.y = pk2(v[j].z, v[j].w); o[64 * j] = w; }
        if (WITH_DT) {
            float a16[16];
#pragma unroll
            for (int hh = 0; hh < 16; ++hh) { float a = 0.f;
#pragma unroll
                for (int j = 0; j < 8; ++j) { const f32x4 w = *(const LAS f32x4*)(wT + hh * DM + 4 * F.lane + 256 * j); a += (v[j].x * w.x + v[j].y * w.y) + (v[j].z * w.z + v[j].w * w.w); }
                a16[hh] = a; }
            const float mine = wave_sum16(a16, F.lane);
            if (F.lane < 16) DT[(size_t)r * 16 + F.lane] = mine;
        }
    }
    }
    if (WITH_DT) __syncthreads();
}

__device__ __forceinline__ void phase_final(const Frame& F0, KArgs A, const float* X) {
    Frame F = launder(F0);
    const float* g = A->in[I_GFINAL];
    for (int r = blockIdx.x * NWAVES + F.wave; r < MREAL; r += GRID * NWAVES) {
        const GAS f32x4* xr = (const GAS f32x4*)(X + (size_t)r * DM) + F.lane;
        f32x4 v[8]; float s = 0.f;
#pragma unroll
        for (int j = 0; j < 8; ++j) { v[j] = xr[64 * j]; s += (v[j].x * v[j].x + v[j].y * v[j].y) + (v[j].z * v[j].z + v[j].w * v[j].w); }
        const float rinv = rsqrtf(wave_sum(s) * (1.0f / DM) + EPS);
        GAS f32x4* o = (GAS f32x4*)(F.out + (r < MPROMPT ? O_YP + (size_t)r * DM : O_YS + (size_t)(r - MPROMPT) * DM)) + F.lane;
        const GAS f32x4* gp = (const GAS f32x4*)g + F.lane;
#pragma unroll
        for (int j = 0; j < 8; ++j) o[64 * j] = v[j] * rinv * gp[64 * j];
    }
}
typedef __bf16 bf16x2_t __attribute__((ext_vector_type(2)));
constexpr int HS_PITCH = 136;
template <bool FINAL>
__device__ __forceinline__ void s5_item(KArgs A, unsigned char* ws, float* out, int l, int item, LAS unsigned char* wl, int lane, unsigned* flags = nullptr) {
    const int c = item & 31, g = (item >> 5) & 31, b = item >> 10;
    const int lgp = (l * G_A + g) * P_A + lane;
    const f32x4 aq = *(const GAS f32x4*)((const float*)(ws + WS_SMALL + SM_S5A) + (size_t)lgp * 4);
    const float ar = aq.x, ai = aq.y;
    float br[16], bi[16];
    {   const GAS f32x4* bb = (const GAS f32x4*)((const float*)(ws + WS_SMALL + SM_S5BB) + (size_t)lgp * 32);
#pragma unroll
        for (int q = 0; q < 4; ++q) { const f32x4 v = bb[q]; br[4 * q] = v.x; br[4 * q + 1] = v.y; br[4 * q + 2] = v.z; br[4 * q + 3] = v.w;
                                      const f32x4 w = bb[4 + q]; bi[4 * q] = w.x; bi[4 * q + 1] = w.y; bi[4 * q + 2] = w.z; bi[4 * q + 3] = w.w; } }
    unsigned brp[8], bip[8];
#pragma unroll
    for (int k = 0; k < 8; ++k) { brp[k] = pk2(br[2 * k], br[2 * k + 1]); bip[k] = pk2(bi[2 * k], bi[2 * k + 1]); }
    const int row0 = b * SEQ + c * S5Q;
    const bf16* PROJ = (const bf16*)(ws + WS_BIG);
    const GAS v4u* up = (const GAS v4u*)(PROJ + (size_t)(row0 + lane) * N_INP + PC_UA + g * 16);
    const v4u u0 = up[0], u1 = up[1];
    LAS bf16* Us = (LAS bf16*)(wl + 8704);
    if (FINAL) { *(LAS v4u*)(Us + lane * 16) = u0; *(LAS v4u*)(Us + lane * 16 + 8) = u1; }
    float hr = 0.f, hi = 0.f;
    float* SLOC = (float*)(ws + WS_SMALL + SM_SLOC);
    if (FINAL && flags) {
        float lr = 0.f, li = 0.f;
#pragma unroll 2
        for (int t = 0; t < 64; ++t) {
            unsigned w[8];
            w[0] = __builtin_amdgcn_readlane(u0.x, t); w[1] = __builtin_amdgcn_readlane(u0.y, t); w[2] = __builtin_amdgcn_readlane(u0.z, t); w[3] = __builtin_amdgcn_readlane(u0.w, t);
            w[4] = __builtin_amdgcn_readlane(u1.x, t); w[5] = __builtin_amdgcn_readlane(u1.y, t); w[6] = __builtin_amdgcn_readlane(u1.z, t); w[7] = __builtin_amdgcn_readlane(u1.w, t);
            float sr0 = 0.f, si0 = 0.f, sr1 = 0.f, si1 = 0.f;
#pragma unroll
            for (int k = 0; k < 8; k += 2) {
                sr0 = __builtin_amdgcn_fdot2_f32_bf16(__builtin_bit_cast(bf16x2_t, brp[k]), __builtin_bit_cast(bf16x2_t, w[k]), sr0, false);
                si0 = __builtin_amdgcn_fdot2_f32_bf16(__builtin_bit_cast(bf16x2_t, bip[k]), __builtin_bit_cast(bf16x2_t, w[k]), si0, false);
                sr1 = __builtin_amdgcn_fdot2_f32_bf16(__builtin_bit_cast(bf16x2_t, brp[k + 1]), __builtin_bit_cast(bf16x2_t, w[k + 1]), sr1, false);
                si1 = __builtin_amdgcn_fdot2_f32_bf16(__builtin_bit_cast(bf16x2_t, bip[k + 1]), __builtin_bit_cast(bf16x2_t, w[k + 1]), si1, false); }
            const float nr = ar * lr - ai * li + (sr0 + sr1); li = ar * li + ai * lr + (si0 + si1); lr = nr;
        }
        float* sl = SLOC + (size_t)item * 128 + lane;
        __hip_atomic_store(sl, lr, __ATOMIC_RELAXED, __HIP_MEMORY_SCOPE_AGENT); __hip_atomic_store(sl + 64, li, __ATOMIC_RELAXED, __HIP_MEMORY_SCOPE_AGENT);
        asm volatile("s_waitcnt vmcnt(0)" ::: "memory");
        if (lane == 0) __hip_atomic_store(flags + item, 1u, __ATOMIC_RELAXED, __HIP_MEMORY_SCOPE_AGENT);
        {
            unsigned sp_ = 0;
            for (;;) { const unsigned f = lane < c ? __hip_atomic_load(flags + (item - c + lane), __ATOMIC_RELAXED, __HIP_MEMORY_SCOPE_AGENT) : 1u;
                if (__builtin_amdgcn_ballot_w64(f == 0u) == 0ull || ++sp_ > (1u << 20)) break; __builtin_amdgcn_s_sleep(1); }
            __builtin_amdgcn_fence(__ATOMIC_ACQUIRE, "agent"); }
        asm volatile("s_waitcnt vmcnt(0)" ::: "memory");
    }
    if (FINAL) {
        const float qr = aq.z, qi = aq.w;
        const float* sl = SLOC + (size_t)((b * G_A + g) * S5NC) * 128 + lane;
        float psr[31], psi[31];
#pragma unroll
        for (int k = 0; k < 31; ++k) { const int kk = k < c ? k : 0; psr[k] = sl[kk * 128]; psi[k] = sl[kk * 128 + 64]; }
#pragma unroll
        for (int k = 0; k < 31; ++k) if (k < c) { const float t = qr * hr - qi * hi + psr[k]; hi = qr * hi + qi * hr + psi[k]; hr = t; }
    }
    LAS bf16* Hs = (LAS bf16*)wl;
    bf16x8 cfr[4];
    if (FINAL) { const bf16* ct = (const bf16*)(ws + WS_SMALL + SM_S5CT) + (size_t)((l * G_A + g) * S5G + (lane & 15)) * 128 + 8 * (lane >> 4);
#pragma unroll
        for (int ks = 0; ks < 4; ++ks) cfr[ks] = *(const GAS bf16x8*)(ct + 32 * ks); }
#pragma unroll 1
    for (int half = 0; half < 2; ++half) {
#pragma unroll 2
        for (int tt = 0; tt < 32; ++tt) {
            const int t = half * 32 + tt;
            unsigned w[8];
            w[0] = __builtin_amdgcn_readlane(u0.x, t); w[1] = __builtin_amdgcn_readlane(u0.y, t); w[2] = __builtin_amdgcn_readlane(u0.z, t); w[3] = __builtin_amdgcn_readlane(u0.w, t);
            w[4] = __builtin_amdgcn_readlane(u1.x, t); w[5] = __builtin_amdgcn_readlane(u1.y, t); w[6] = __builtin_amdgcn_readlane(u1.z, t); w[7] = __builtin_amdgcn_readlane(u1.w, t);
            float sr0 = 0.f, si0 = 0.f, sr1 = 0.f, si1 = 0.f;
#pragma unroll
            for (int k = 0; k < 8; k += 2) {
                sr0 = __builtin_amdgcn_fdot2_f32_bf16(__builtin_bit_cast(bf16x2_t, brp[k]), __builtin_bit_cast(bf16x2_t, w[k]), sr0, false);
                si0 = __builtin_amdgcn_fdot2_f32_bf16(__builtin_bit_cast(bf16x2_t, bip[k]), __builtin_bit_cast(bf16x2_t, w[k]), si0, false);
                sr1 = __builtin_amdgcn_fdot2_f32_bf16(__builtin_bit_cast(bf16x2_t, brp[k + 1]), __builtin_bit_cast(bf16x2_t, w[k + 1]), sr1, false);
                si1 = __builtin_amdgcn_fdot2_f32_bf16(__builtin_bit_cast(bf16x2_t, bip[k + 1]), __builtin_bit_cast(bf16x2_t, w[k + 1]), si1, false); }
            const float sr = sr0 + sr1, si = si0 + si1;
            const float nr = ar * hr - ai * hi + sr; hi = ar * hi + ai * hr + si; hr = nr;
            if (FINAL) { Hs[tt * HS_PITCH + lane] = (bf16)f2bf(hr); Hs[tt * HS_PITCH + 64 + lane] = (bf16)f2bf(hi); }
        }
        if (FINAL) {
            bf16* YB = (bf16*)(ws + WS_YB);
            const float* dsk = A->in[I_S5D] + l * D_A + g * 16;
#pragma unroll
            for (int tile = 0; tile < 2; ++tile) {
                f32x4 acc = {0.f, 0.f, 0.f, 0.f};
#pragma unroll
                for (int ks = 0; ks < 4; ++ks) { const bf16x8 a = *(const LAS bf16x8*)(Hs + (tile * 16 + (lane & 15)) * HS_PITCH + 32 * ks + 8 * (lane >> 4));
                    acc = __builtin_amdgcn_mfma_f32_16x16x32_bf16(a, cfr[ks], acc, 0, 0, 0); }
                const int hh = lane & 15; const float dd = dsk[hh];
#pragma unroll
                for (int r = 0; r < 4; ++r) { const int row = row0 + half * 32 + tile * 16 + 4 * (lane >> 4) + r;
                    const float u = bf2f(Us[(row - row0) * 16 + hh]);
                    YB[(size_t)row * 512 + g * 16 + hh] = (bf16)f2bf(gelu_tanh(acc[r] + dd * u)); }
            }
        }
    }
    if (!FINAL) { float* sl = SLOC + (size_t)item * 128 + lane; sl[0] = hr; sl[64] = hi; }
    if (FINAL && c == S5NC - 1) { const size_t o = (size_t)((l * NB + b) * G_A + g) * P_A + lane; out[O_S5RP + o] = hr; out[O_S5IP + o] = hi; }
}

__device__ __forceinline__ void s5_sample_item(KArgs A, unsigned char* ws, float* out, int l, int item, int lane) {
    const int g = item & 31, s = item >> 5, row = MPROMPT + s;
    const int lgp = (l * G_A + g) * P_A + lane;
    const f32x4 aq = *(const GAS f32x4*)((const float*)(ws + WS_SMALL + SM_S5A) + (size_t)lgp * 4);
    const bf16* PROJ = (const bf16*)(ws + WS_BIG);
    const GAS v4u* up = (const GAS v4u*)(PROJ + (size_t)row * N_INP + PC_UA + g * 16);
    const v4u u0 = up[0], u1 = up[1];
    float u[16]; u[0] = bflo(u0.x); u[1] = bfhi(u0.x); u[2] = bflo(u0.y); u[3] = bfhi(u0.y); u[4] = bflo(u0.z); u[5] = bfhi(u0.z); u[6] = bflo(u0.w); u[7] = bfhi(u0.w);
    u[8] = bflo(u1.x); u[9] = bfhi(u1.x); u[10] = bflo(u1.y); u[11] = bfhi(u1.y); u[12] = bflo(u1.z); u[13] = bfhi(u1.z); u[14] = bflo(u1.w); u[15] = bfhi(u1.w);
    const GAS f32x4* bb = (const GAS f32x4*)((const float*)(ws + WS_SMALL + SM_S5BB) + (size_t)lgp * 32);
    float sr = 0.f, si = 0.f;
#pragma unroll
    for (int q = 0; q < 4; ++q) { const f32x4 v = bb[q], w = bb[4 + q];
        sr += v.x * u[4 * q] + v.y * u[4 * q + 1] + v.z * u[4 * q + 2] + v.w * u[4 * q + 3];
        si += w.x * u[4 * q] + w.y * u[4 * q + 1] + w.z * u[4 * q + 2] + w.w * u[4 * q + 3]; }
    const size_t so = (size_t)((l * NS + s) * G_A + g) * P_A + lane;
    const float h0r = A->in[I_S5RE][so], h0i = A->in[I_S5IM][so];
    const float hr = aq.x * h0r - aq.y * h0i + sr, hi = aq.x * h0i + aq.y * h0r + si;
    out[O_S5RS + so] = hr; out[O_S5IS + so] = hi;
    const float* cre = A->in[I_CRE] + (size_t)((l * G_A + g) * S5G) * P_A + lane; const float* cim = A->in[I_CIM] + (size_t)((l * G_A + g) * S5G) * P_A + lane;
    float y16[16];
#pragma unroll
    for (int hh = 0; hh < 16; ++hh) y16[hh] = cre[hh * P_A] * hr - cim[hh * P_A] * hi;
    const float mine = wave_sum16(y16, lane);
    if (lane < 16) { const float dd = A->in[I_S5D][l * D_A + g * 16 + lane]; float uu = 0.f;
#pragma unroll
        for (int hh = 0; hh < 16; ++hh) uu = (lane == hh) ? u[hh] : uu;
        ((bf16*)(ws + WS_YB))[(size_t)row * 512 + g * 16 + lane] = (bf16)f2bf(gelu_tanh(mine + dd * uu)); }
}
__device__ __forceinline__ void gmlp_sample_item(KArgs A, unsigned char* ws, float* out, int l, int s, int lane) {
    const int row = MPROMPT + s, ch0 = lane * 8;
    const bf16* PROJ = (const bf16*)(ws + WS_BIG);
    const v4u vv = *(const GAS v4u*)(PROJ + (size_t)row * N_INP + PC_VB + ch0), uu = *(const GAS v4u*)(PROJ + (size_t)row * N_INP + PC_UB + ch0);
    const float rinv = rsqrtf(((const float*)(ws + WS_SMALL + SM_VSQ))[l * MP + row] * (1.0f / D_B) + EPS);
    const int h = ch0 >> 6;
    const float w00 = A->in[I_WS][(size_t)(l * H_B + h) * 128 * 128], b0 = A->in[I_BS][(l * H_B + h) * 128];
    float v[8] = {bflo(vv.x), bfhi(vv.x), bflo(vv.y), bfhi(vv.y), bflo(vv.z), bfhi(vv.z), bflo(vv.w), bfhi(vv.w)};
    float u[8] = {bflo(uu.x), bfhi(uu.x), bflo(uu.y), bfhi(uu.y), bflo(uu.z), bfhi(uu.z), bflo(uu.w), bfhi(uu.w)};
    const float* gv = A->in[I_GV] + l * D_B + ch0;
    float o[8];
#pragma unroll
    for (int j = 0; j < 8; ++j) { const float vn = v[j] * rinv * gv[j]; out[O_GVS + (size_t)(l * NS + s) * D_B + ch0 + j] = vn; o[j] = u[j] * (w00 * vn + b0); }
    v4u w; w.x = pk2(o[0], o[1]); w.y = pk2(o[2], o[3]); w.z = pk2(o[4], o[5]); w.w = pk2(o[6], o[7]);
    *(GAS v4u*)((bf16*)(ws + WS_OB) + (size_t)row * 512 + ch0) = w;
}
__device__ __forceinline__ void ssd_sample_item(KArgs A, unsigned char* ws, float* out, int l, int item, int lane, bool acc) {
    const int h = item & 15, s = item >> 4, row = MPROMPT + s, g = h >> 3;
    const bf16* PROJ = (const bf16*)(ws + WS_BIG);
    const float* cw = A->in[I_CONVW] + (size_t)l * K_C * D_XBC; const float* cb = A->in[I_CONVB] + l * D_XBC;
    const float* cst = A->in[I_SSDCONV] + (size_t)(l * NS + s) * 3 * D_XBC;
    float* cso = out + O_CCS + (size_t)(l * NS + s) * 3 * D_XBC;
    float x;
    {   const int ch = h * 64 + lane; const float p0 = cst[ch], p1 = cst[D_XBC + ch], p2 = cst[2 * D_XBC + ch], p3 = bf2f(PROJ[(size_t)row * N_INP + PC_XBC + ch]);
        x = siluf_(cb[ch] + cw[ch] * p0 + cw[D_XBC + ch] * p1 + cw[2 * D_XBC + ch] * p2 + cw[3 * D_XBC + ch] * p3);
        cso[ch] = p1; cso[D_XBC + ch] = p2; cso[2 * D_XBC + ch] = p3; }
    const int n4 = (lane & 31) * 4; float Bv[4], Cv[4];
#pragma unroll
    for (int j = 0; j < 4; ++j) {
        {   const int ch = D_C + g * N_C + n4 + j; const float p0 = cst[ch], p1 = cst[D_XBC + ch], p2 = cst[2 * D_XBC + ch], p3 = bf2f(PROJ[(size_t)row * N_INP + PC_XBC + ch]);
            Bv[j] = siluf_(cb[ch] + cw[ch] * p0 + cw[D_XBC + ch] * p1 + cw[2 * D_XBC + ch] * p2 + cw[3 * D_XBC + ch] * p3);
            if ((h & 7) == 0 && lane < 32) { cso[ch] = p1; cso[D_XBC + ch] = p2; cso[2 * D_XBC + ch] = p3; } }
        {   const int ch = D_C + G_C * N_C + g * N_C + n4 + j; const float p0 = cst[ch], p1 = cst[D_XBC + ch], p2 = cst[2 * D_XBC + ch], p3 = bf2f(PROJ[(size_t)row * N_INP + PC_XBC + ch]);
            Cv[j] = siluf_(cb[ch] + cw[ch] * p0 + cw[D_XBC + ch] * p1 + cw[2 * D_XBC + ch] * p2 + cw[3 * D_XBC + ch] * p3);
            if ((h & 7) == 0 && lane < 32) { cso[ch] = p1; cso[D_XBC + ch] = p2; cso[2 * D_XBC + ch] = p3; } }
    }
    const float dt = softplusf_(((const float*)(ws + WS_SMALL + SM_DT))[(size_t)row * 16 + h] + A->in[I_DTBIAS][l * H_C + h]);
    const float dA = __expf(dt * -__expf(A->in[I_ALOG][l * H_C + h]));
    const size_t sbase = (size_t)((l * NS + s) * H_C + h) * HD_C * N_C;
    const GAS f32x4* st = (const GAS f32x4*)(A->in[I_SSM] + sbase) + lane;
    GAS f32x4* so = (GAS f32x4*)(out + O_SSMS + sbase) + lane;
    float part[32];
#pragma unroll
    for (int i = 0; i < 32; ++i) {
        const float xe = lane_bcast(x, 2 * i), xo = lane_bcast(x, 2 * i + 1); const float xv = lane < 32 ? xe : xo; const float xd = xv * dt;
        f32x4 v = __builtin_nontemporal_load(st + 64 * i);
        v.x = v.x * dA + xd * Bv[0]; v.y = v.y * dA + xd * Bv[1]; v.z = v.z * dA + xd * Bv[2]; v.w = v.w * dA + xd * Bv[3];
        __builtin_nontemporal_store(v, so + 64 * i);
        part[i] = v.x * Cv[0] + v.y * Cv[1] + v.z * Cv[2] + v.w * Cv[3];
    }
    const float ymine = half_sum32(part, lane);
    const float xmine = __builtin_bit_cast(float, __builtin_amdgcn_ds_bpermute((2 * (lane & 31) + (lane >> 5)) << 2, __builtin_bit_cast(int, x)));
    const int p = 2 * (lane & 31) + (lane >> 5), ch = h * 64 + p;
    const float y = ymine + A->in[I_SSDD][l * H_C + h] * xmine;
    const float z = bf2f(PROJ[(size_t)row * N_INP + PC_Z + ch]);
    const float yz = y * siluf_(z);
    const float sq = wave_sum(yz * yz);
    if (lane == 0 && acc) atomicAdd((float*)(ws + WS_SMALL + SM_CSQ) + l * MP + row, sq);
    ((bf16*)(ws + WS_OC))[(size_t)row * 1024 + ch] = (bf16)f2bf(yz * A->in[I_GNORM][l * D_C + ch]);
}
constexpr int TP = 136;
__device__ __forceinline__ void gmlp_item(KArgs A, unsigned char* ws, int l, int item, LAS unsigned char* lds, int tid, int wave, int lane) {
    const int h = item & 7, c = (item >> 3) & 15, b = item >> 7, row0 = b * SEQ + c * GMC;
    const bf16* PROJ = (const bf16*)(ws + WS_BIG);
    LAS bf16* vT = (LAS bf16*)lds;
    {   const int tok = tid >> 2, part = tid & 3, d0 = part * 16, row = row0 + tok;
        const float rinv = rsqrtf(((const float*)(ws + WS_SMALL + SM_VSQ))[l * MP + row] * (1.0f / D_B) + EPS);
        const GAS v4u* vp = (const GAS v4u*)(PROJ + (size_t)row * N_INP + PC_VB + h * 64 + d0);
        const v4u a = vp[0], b2 = vp[1];
        const float* gv = A->in[I_GV] + l * D_B + h * 64 + d0;
        const unsigned wv[8] = {a.x, a.y, a.z, a.w, b2.x, b2.y, b2.z, b2.w};
#pragma unroll
        for (int k = 0; k < 8; ++k) { vT[(d0 + 2 * k) * TP + tok] = (bf16)f2bf(bflo(wv[k]) * rinv * gv[2 * k]); vT[(d0 + 2 * k + 1) * TP + tok] = (bf16)f2bf(bfhi(wv[k]) * rinv * gv[2 * k + 1]); }
    }
    const bf16* WSb = (const bf16*)(ws + WS_SMALL + SM_WS) + (size_t)(l * H_B + h) * 128 * 128;
    bf16x8 afr[4];
#pragma unroll
    for (int ks = 0; ks < 4; ++ks) afr[ks] = *(const GAS bf16x8*)(WSb + (size_t)(16 * wave + (lane & 15)) * 128 + 32 * ks + 8 * (lane >> 4));
    __syncthreads();
    f32x4 acc[4];
#pragma unroll
    for (int t = 0; t < 4; ++t) acc[t] = (f32x4){0.f, 0.f, 0.f, 0.f};
    const int nks = (wave >> 1) + 1;
#pragma unroll
    for (int ks = 0; ks < 4; ++ks) if (ks < nks) {
#pragma unroll
        for (int t = 0; t < 4; ++t) { const bf16x8 bfr = *(const LAS bf16x8*)(vT + (16 * t + (lane & 15)) * TP + 32 * ks + 8 * (lane >> 4));
            acc[t] = __builtin_amdgcn_mfma_f32_16x16x32_bf16(afr[ks], bfr, acc[t], 0, 0, 0); }
    }
    bf16* OB = (bf16*)(ws + WS_OB);
#pragma unroll
    for (int r = 0; r < 4; ++r) { const int i = 16 * wave + 4 * (lane >> 4) + r, row = row0 + i; const float bs = A->in[I_BS][(l * H_B + h) * 128 + i];
#pragma unroll
        for (int t = 0; t < 4; ++t) { const int ch = h * 64 + 16 * t + (lane & 15);
            const float u = bf2f(PROJ[(size_t)row * N_INP + PC_UB + ch]);
            OB[(size_t)row * 512 + ch] = (bf16)f2bf(u * (acc[t][r] + bs)); } }
    __syncthreads();
}

template <int NCH, bool TRANS>
__device__ __forceinline__ void conv_tile(KArgs A, const bf16* PROJ, int l, int b, int c, int chb, LAS bf16* tile, const LAS float* scale, int tid) {
    constexpr int LPR = NCH / 8, SLOTS = NTHR / LPR, TPT = 128 / SLOTS;
    const int cl = tid % LPR, slot = tid / LPR, ch0 = chb + cl * 8, t0 = slot * TPT;
    const float* cw = A->in[I_CONVW] + (size_t)l * K_C * D_XBC + ch0; const float* cb = A->in[I_CONVB] + l * D_XBC + ch0;
    float w[4][8], bias[8];
#pragma unroll
    for (int k = 0; k < 4; ++k) { const f32x4 a = *(const GAS f32x4*)(cw + k * D_XBC), b2 = *(const GAS f32x4*)(cw + k * D_XBC + 4);
        w[k][0] = a.x; w[k][1] = a.y; w[k][2] = a.z; w[k][3] = a.w; w[k][4] = b2.x; w[k][5] = b2.y; w[k][6] = b2.z; w[k][7] = b2.w; }
    {   const f32x4 a = *(const GAS f32x4*)cb, b2 = *(const GAS f32x4*)(cb + 4); bias[0] = a.x; bias[1] = a.y; bias[2] = a.z; bias[3] = a.w; bias[4] = b2.x; bias[5] = b2.y; bias[6] = b2.z; bias[7] = b2.w; }
    const int trow0 = c * SSDQ + t0;
    v4u raw[TPT + 3];
#pragma unroll
    for (int i = 0; i < TPT + 3; ++i) { const int tt = trow0 - 3 + i;
        raw[i] = tt >= 0 ? *(const GAS v4u*)(PROJ + (size_t)(b * SEQ + tt) * N_INP + PC_XBC + ch0) : (v4u){0u, 0u, 0u, 0u}; }
    float o[TPT][8];
#pragma unroll
    for (int t = 0; t < TPT; ++t) {
#pragma unroll
        for (int e = 0; e < 8; ++e) o[t][e] = bias[e];
#pragma unroll
        for (int k = 0; k < 4; ++k) { const v4u r = raw[t + k]; const unsigned rw[4] = {r.x, r.y, r.z, r.w};
#pragma unroll
            for (int e2 = 0; e2 < 4; ++e2) { o[t][2 * e2] = fmaf(w[k][2 * e2], bflo(rw[e2]), o[t][2 * e2]); o[t][2 * e2 + 1] = fmaf(w[k][2 * e2 + 1], bfhi(rw[e2]), o[t][2 * e2 + 1]); } }
        const float sc = scale ? scale[t0 + t] : 1.0f;
#pragma unroll
        for (int e = 0; e < 8; ++e) o[t][e] = siluf_(o[t][e]) * sc;
    }
    if (!TRANS) {
#pragma unroll
        for (int t = 0; t < TPT; ++t) { v4u wv; wv.x = pk2(o[t][0], o[t][1]); wv.y = pk2(o[t][2], o[t][3]); wv.z = pk2(o[t][4], o[t][5]); wv.w = pk2(o[t][6], o[t][7]);
            *(LAS v4u*)(tile + (t0 + t) * TP + cl * 8) = wv; }
    } else {
#pragma unroll
        for (int e = 0; e < 8; ++e) {
            if (TPT == 4) { v2u wv; wv.x = pk2(o[0][e], o[1][e]); wv.y = pk2(o[TPT > 2 ? 2 : 0][e], o[TPT > 3 ? 3 : 0][e]); *(LAS v2u*)(tile + (cl * 8 + e) * TP + t0) = wv; }
            else { *(LAS unsigned*)(tile + (cl * 8 + e) * TP + t0) = pk2(o[0][e], o[1][e]); }
        }
    }
}

__device__ __forceinline__ void ssd_dt_scan(KArgs A, unsigned char* ws, int l, int b, int c, int h, LAS float* dtv, LAS float* cs, int tid, int lane) {
    if (tid < 64) {
        const float* DT = (const float*)(ws + WS_SMALL + SM_DT); const float bias = A->in[I_DTBIAS][l * H_C + h], a = -__expf(A->in[I_ALOG][l * H_C + h]);
        const int row = b * SEQ + c * SSDQ + 2 * lane;
        const float d0 = softplusf_(DT[(size_t)row * 16 + h] + bias), d1 = softplusf_(DT[(size_t)(row + 1) * 16 + h] + bias);
        const float v0 = d0 * a, v1 = d1 * a; float s = v0 + v1;
#pragma unroll
        for (int o = 1; o < 64; o <<= 1) { const float t = __builtin_bit_cast(float, __builtin_amdgcn_ds_bpermute((lane - o) << 2, __builtin_bit_cast(int, s))); if (lane >= o) s += t; }
        dtv[2 * lane] = d0; dtv[2 * lane + 1] = d1; cs[2 * lane] = s - v1; cs[2 * lane + 1] = s;
    }
    __syncthreads();
}

constexpr int SL_CN = 0, SL_BN = 34816, SL_MW = 69632, SL_XT = 104448, SL_HP = 121856, SL_DT = 139264, SL_CS = SL_DT + 512, SL_SC = SL_CS + 512, SL_END = SL_SC + 512;

__device__ __forceinline__ void ssd_item1(KArgs A, unsigned char* ws, int l, int item, LAS unsigned char* lds, int tid, int wave, int lane) {
    const int h = item & 15, c = (item >> 4) & 15, b = item >> 8, g = h >> 3;
    const bf16* PROJ = (const bf16*)(ws + WS_BIG);
    LAS float* dtv = (LAS float*)(lds + SL_DT); LAS float* cs = (LAS float*)(lds + SL_CS); LAS float* sc = (LAS float*)(lds + SL_SC);
    LAS bf16* Xt = (LAS bf16*)(lds + SL_XT); LAS bf16* Bt = (LAS bf16*)(lds + SL_BN);
    (void)sc;
    conv_tile<64, true>(A, PROJ, l, b, c, h * 64, Xt, nullptr, tid);
    conv_tile<128, true>(A, PROJ, l, b, c, D_C + g * N_C, Bt, nullptr, tid);
    ssd_dt_scan(A, ws, l, b, c, h, dtv, cs, tid, lane);
    f32x4 acc[4];
#pragma unroll
    for (int t = 0; t < 4; ++t) acc[t] = (f32x4){0.f, 0.f, 0.f, 0.f};
    const float cse = cs[127];
#pragma unroll
    for (int ks = 0; ks < 4; ++ks) { const int j0 = 32 * ks + 8 * (lane >> 4);
        const v4u braw = *(const LAS v4u*)(Bt + (16 * wave + (lane & 15)) * TP + j0);
        const f32x4 d0 = *(const LAS f32x4*)(dtv + j0), d1 = *(const LAS f32x4*)(dtv + j0 + 4), c0 = *(const LAS f32x4*)(cs + j0), c1 = *(const LAS f32x4*)(cs + j0 + 4);
        v4u bs;
        bs.x = pk2(bflo(braw.x) * d0.x * __expf(cse - c0.x), bfhi(braw.x) * d0.y * __expf(cse - c0.y)); bs.y = pk2(bflo(braw.y) * d0.z * __expf(cse - c0.z), bfhi(braw.y) * d0.w * __expf(cse - c0.w));
        bs.z = pk2(bflo(braw.z) * d1.x * __expf(cse - c1.x), bfhi(braw.z) * d1.y * __expf(cse - c1.y)); bs.w = pk2(bflo(braw.w) * d1.z * __expf(cse - c1.z), bfhi(braw.w) * d1.w * __expf(cse - c1.w));
        const bf16x8 bfr = __builtin_bit_cast(bf16x8, bs);
#pragma unroll
        for (int t = 0; t < 4; ++t) { const bf16x8 af = *(const LAS bf16x8*)(Xt + (16 * t + (lane & 15)) * TP + 32 * ks + 8 * (lane >> 4));
            acc[t] = __builtin_amdgcn_mfma_f32_16x16x32_bf16(af, bfr, acc[t], 0, 0, 0); } }
    float* ST = (float*)(ws + WS_STATES) + (size_t)item * HD_C * N_C;
#pragma unroll
    for (int t = 0; t < 4; ++t)
#pragma unroll
        for (int r = 0; r < 4; ++r) ST[(size_t)(16 * t + 4 * (lane >> 4) + r) * N_C + 16 * wave + (lane & 15)] = acc[t][r];
    if (tid == 0) ((float*)(ws + WS_SMALL + SM_SDEC))[item] = __expf(cs[127]);
    __syncthreads();
}

__device__ __forceinline__ void ssd_item2(KArgs A, unsigned char* ws, float* out, int l, int item, LAS unsigned char* lds, int tid, int wave, int lane, bool acc) {
    const int h = item & 15, c = (item >> 4) & 15, b = item >> 8, g = h >> 3, row0 = b * SEQ + c * SSDQ;
    const bf16* PROJ = (const bf16*)(ws + WS_BIG);
    LAS float* dtv = (LAS float*)(lds + SL_DT); LAS float* cs = (LAS float*)(lds + SL_CS);
    LAS bf16* Cn = (LAS bf16*)(lds + SL_CN); LAS bf16* Bn = (LAS bf16*)(lds + SL_BN); LAS bf16* Mw = (LAS bf16*)(lds + SL_MW);
    LAS bf16* Xt = (LAS bf16*)(lds + SL_XT); LAS bf16* Hp = (LAS bf16*)(lds + SL_HP);
    conv_tile<64, true>(A, PROJ, l, b, c, h * 64, Xt, nullptr, tid);
    conv_tile<128, false>(A, PROJ, l, b, c, D_C + g * N_C, Bn, nullptr, tid);
    conv_tile<128, false>(A, PROJ, l, b, c, D_C + G_C * N_C + g * N_C, Cn, nullptr, tid);
    {   const float* ST = (const float*)(ws + WS_STATES) + (size_t)((b * 16) * 16 + h) * HD_C * N_C + tid * 4;
        const float* SD = (const float*)(ws + WS_SMALL + SM_SDEC) + (b * 16) * 16 + h;
        f32x4 hv[4];
#pragma unroll
        for (int k = 0; k < 4; ++k) hv[k] = (f32x4){0.f, 0.f, 0.f, 0.f};
        int cc = 0;
        for (; cc + 4 <= c; cc += 4) { f32x4 sv[4][4]; float d[4];
#pragma unroll
            for (int q = 0; q < 4; ++q) { d[q] = SD[(cc + q) * 16];
#pragma unroll
                for (int k = 0; k < 4; ++k) sv[q][k] = *(const GAS f32x4*)(ST + (size_t)(cc + q) * 16 * 8192 + 2048 * k); }
#pragma unroll
            for (int q = 0; q < 4; ++q)
#pragma unroll
                for (int k = 0; k < 4; ++k) hv[k] = hv[k] * d[q] + sv[q][k]; }
        for (; cc < c; ++cc) { const float d = SD[cc * 16];
#pragma unroll
            for (int k = 0; k < 4; ++k) hv[k] = hv[k] * d + *(const GAS f32x4*)(ST + (size_t)cc * 16 * 8192 + 2048 * k); }
#pragma unroll
        for (int k = 0; k < 4; ++k) { v2u wv; wv.x = pk2(hv[k].x, hv[k].y); wv.y = pk2(hv[k].z, hv[k].w); *(LAS v2u*)(Hp + ((tid >> 5) + 16 * k) * TP + (tid & 31) * 4) = wv; }
        if (c == SSDNC - 1) { const float d = SD[c * 16]; float* o = out + O_SSMP + (size_t)((l * NB + b) * H_C + h) * HD_C * N_C + tid * 4;
#pragma unroll
            for (int k = 0; k < 4; ++k) *(GAS f32x4*)(o + 2048 * k) = hv[k] * d + *(const GAS f32x4*)(ST + (size_t)c * 16 * 8192 + 2048 * k); }
    }
    ssd_dt_scan(A, ws, l, b, c, h, dtv, cs, tid, lane);
    bf16x8 cf[4];
#pragma unroll
    for (int ks = 0; ks < 4; ++ks) cf[ks] = *(const LAS bf16x8*)(Cn + (16 * wave + (lane & 15)) * TP + 32 * ks + 8 * (lane >> 4));
    const int jtmax = wave | 1;
    for (int jt = 0; jt <= jtmax; ++jt) {
        f32x4 gacc = {0.f, 0.f, 0.f, 0.f};
        if (jt <= wave) {
#pragma unroll
            for (int ks = 0; ks < 4; ++ks) { const bf16x8 bfr = *(const LAS bf16x8*)(Bn + (16 * jt + (lane & 15)) * TP + 32 * ks + 8 * (lane >> 4));
                gacc = __builtin_amdgcn_mfma_f32_16x16x32_bf16(cf[ks], bfr, gacc, 0, 0, 0); }
        }
        const int j = 16 * jt + (lane & 15); const float csj = cs[j], dtj = dtv[j];
#pragma unroll
        for (int r = 0; r < 4; ++r) { const int i = 16 * wave + 4 * (lane >> 4) + r;
            const float m = (j <= i) ? gacc[r] * __expf(cs[i] - csj) * dtj : 0.f;
            Mw[i * TP + j] = (bf16)f2bf(m); }
    }
    f32x4 yd[4], yo[4];
#pragma unroll
    for (int t = 0; t < 4; ++t) { yd[t] = (f32x4){0.f, 0.f, 0.f, 0.f}; yo[t] = (f32x4){0.f, 0.f, 0.f, 0.f}; }
    const int nks = (wave >> 1) + 1;
    for (int ks = 0; ks < nks; ++ks) { const bf16x8 mf = *(const LAS bf16x8*)(Mw + (16 * wave + (lane & 15)) * TP + 32 * ks + 8 * (lane >> 4));
#pragma unroll
        for (int t = 0; t < 4; ++t) { const bf16x8 xf = *(const LAS bf16x8*)(Xt + (16 * t + (lane & 15)) * TP + 32 * ks + 8 * (lane >> 4));
            yd[t] = __builtin_amdgcn_mfma_f32_16x16x32_bf16(mf, xf, yd[t], 0, 0, 0); } }
#pragma unroll
    for (int ks = 0; ks < 4; ++ks)
#pragma unroll
        for (int t = 0; t < 4; ++t) { const bf16x8 hf = *(const LAS bf16x8*)(Hp + (16 * t + (lane & 15)) * TP + 32 * ks + 8 * (lane >> 4));
            yo[t] = __builtin_amdgcn_mfma_f32_16x16x32_bf16(cf[ks], hf, yo[t], 0, 0, 0); }
    const float dsk = A->in[I_SSDD][l * H_C + h];
    bf16* OC = (bf16*)(ws + WS_OC); float* csq = (float*)(ws + WS_SMALL + SM_CSQ) + l * MP;
#pragma unroll
    for (int r = 0; r < 4; ++r) { const int i = 16 * wave + 4 * (lane >> 4) + r, row = row0 + i; const float ecs = __expf(cs[i]); float sq = 0.f;
#pragma unroll
        for (int t = 0; t < 4; ++t) { const int p = 16 * t + (lane & 15), ch = h * 64 + p;
            const float x = bf2f(Xt[p * TP + i]);
            const float y = yd[t][r] + ecs * yo[t][r] + dsk * x;
            const float z = bf2f(PROJ[(size_t)row * N_INP + PC_Z + ch]);
            const float yz = y * siluf_(z); sq += yz * yz;
            OC[(size_t)row * 1024 + ch] = (bf16)f2bf(yz * A->in[I_GNORM][l * D_C + ch]); }
        sq += xor_lt32<1>(sq); sq += xor_lt32<2>(sq); sq += xor_lt32<4>(sq); sq += xor_lt32<8>(sq);
        if ((lane & 15) == 0 && acc) atomicAdd(csq + row, sq); }
    __syncthreads();
}

__device__ __forceinline__ void ssd_item_fused(KArgs A, unsigned char* ws, float* out, int l, int item, LAS unsigned char* lds, int tid, int wave, int lane, bool acc, unsigned* flags) {
    const int h = item & 15, c = (item >> 4) & 15, b = item >> 8, g = h >> 3, row0 = b * SEQ + c * SSDQ;
    const bf16* PROJ = (const bf16*)(ws + WS_BIG);
    LAS float* dtv = (LAS float*)(lds + SL_DT); LAS float* cs = (LAS float*)(lds + SL_CS);
    LAS bf16* Cn = (LAS bf16*)(lds + SL_CN); LAS bf16* Bn = (LAS bf16*)(lds + SL_BN); LAS bf16* Mw = (LAS bf16*)(lds + SL_MW);
    LAS bf16* Xt = (LAS bf16*)(lds + SL_XT); LAS bf16* Hp = (LAS bf16*)(lds + SL_HP);
    conv_tile<64, true>(A, PROJ, l, b, c, h * 64, Xt, nullptr, tid);
    conv_tile<128, false>(A, PROJ, l, b, c, D_C + g * N_C, Bn, nullptr, tid);
    conv_tile<128, true>(A, PROJ, l, b, c, D_C + g * N_C, Mw, nullptr, tid);
    conv_tile<128, false>(A, PROJ, l, b, c, D_C + G_C * N_C + g * N_C, Cn, nullptr, tid);
    bf16 zz[4][4];
#pragma unroll
    for (int r = 0; r < 4; ++r)
#pragma unroll
        for (int t = 0; t < 4; ++t) zz[r][t] = PROJ[(size_t)(row0 + 16 * wave + 4 * (lane >> 4) + r) * N_INP + PC_Z + h * 64 + 16 * t + (lane & 15)];
    ssd_dt_scan(A, ws, l, b, c, h, dtv, cs, tid, lane);
    {   f32x4 sacc[4];
#pragma unroll
        for (int t = 0; t < 4; ++t) sacc[t] = (f32x4){0.f, 0.f, 0.f, 0.f};
        const float cse = cs[127];
#pragma unroll
        for (int ks = 0; ks < 4; ++ks) { const int j0 = 32 * ks + 8 * (lane >> 4);
            const v4u braw = *(const LAS v4u*)(Mw + (16 * wave + (lane & 15)) * TP + j0);
            const f32x4 d0 = *(const LAS f32x4*)(dtv + j0), d1 = *(const LAS f32x4*)(dtv + j0 + 4), c0 = *(const LAS f32x4*)(cs + j0), c1 = *(const LAS f32x4*)(cs + j0 + 4);
            v4u bs;
            bs.x = pk2(bflo(braw.x) * d0.x * __expf(cse - c0.x), bfhi(braw.x) * d0.y * __expf(cse - c0.y)); bs.y = pk2(bflo(braw.y) * d0.z * __expf(cse - c0.z), bfhi(braw.y) * d0.w * __expf(cse - c0.w));
            bs.z = pk2(bflo(braw.z) * d1.x * __expf(cse - c1.x), bfhi(braw.z) * d1.y * __expf(cse - c1.y)); bs.w = pk2(bflo(braw.w) * d1.z * __expf(cse - c1.z), bfhi(braw.w) * d1.w * __expf(cse - c1.w));
            const bf16x8 bfr = __builtin_bit_cast(bf16x8, bs);
#pragma unroll
            for (int t = 0; t < 4; ++t) { const bf16x8 af = *(const LAS bf16x8*)(Xt + (16 * t + (lane & 15)) * TP + 32 * ks + 8 * (lane >> 4));
                sacc[t] = __builtin_amdgcn_mfma_f32_16x16x32_bf16(bfr, af, sacc[t], 0, 0, 0); } }
        {   const __amdgpu_buffer_rsrc_t srs = __builtin_amdgcn_make_buffer_rsrc((void*)((float*)(ws + WS_STATES) + (size_t)item * HD_C * N_C), (short)0, HD_C * N_C * 4, 0x00020000);
#pragma unroll
            for (int t = 0; t < 4; ++t) __builtin_amdgcn_raw_buffer_store_b128(__builtin_bit_cast(v4u, sacc[t]), srs, (unsigned)((16 * t + (lane & 15)) * N_C + 16 * wave + 4 * (lane >> 4)) * 4u, 0,   16); }
        if (tid == 0) __hip_atomic_store((float*)(ws + WS_SMALL + SM_SDEC) + item, __expf(cse), __ATOMIC_RELAXED, __HIP_MEMORY_SCOPE_AGENT);
        asm volatile("s_waitcnt vmcnt(0)" ::: "memory"); __syncthreads();
        if (tid == 0) __hip_atomic_store(flags + item, 1u, __ATOMIC_RELAXED, __HIP_MEMORY_SCOPE_AGENT);
    }
    bf16x8 cf[4];
#pragma unroll
    for (int ks = 0; ks < 4; ++ks) cf[ks] = *(const LAS bf16x8*)(Cn + (16 * wave + (lane & 15)) * TP + 32 * ks + 8 * (lane >> 4));
    const int jtmax = wave | 1;
    for (int jt = 0; jt <= jtmax; ++jt) {
        f32x4 gacc = {0.f, 0.f, 0.f, 0.f};
        if (jt <= wave) {
#pragma unroll
            for (int ks = 0; ks < 4; ++ks) { const bf16x8 bfr = *(const LAS bf16x8*)(Bn + (16 * jt + (lane & 15)) * TP + 32 * ks + 8 * (lane >> 4));
                gacc = __builtin_amdgcn_mfma_f32_16x16x32_bf16(cf[ks], bfr, gacc, 0, 0, 0); }
        }
        const int j = 16 * jt + (lane & 15); const float csj = cs[j], dtj = dtv[j];
#pragma unroll
        for (int r = 0; r < 4; ++r) { const int i = 16 * wave + 4 * (lane >> 4) + r;
            const float m = (j <= i) ? gacc[r] * __expf(cs[i] - csj) * dtj : 0.f;
            Mw[i * TP + j] = (bf16)f2bf(m); }
    }
    f32x4 yd[4], yo[4];
#pragma unroll
    for (int t = 0; t < 4; ++t) { yd[t] = (f32x4){0.f, 0.f, 0.f, 0.f}; yo[t] = (f32x4){0.f, 0.f, 0.f, 0.f}; }
    const int nks = (wave >> 1) + 1;
    for (int ks = 0; ks < nks; ++ks) { const bf16x8 mf = *(const LAS bf16x8*)(Mw + (16 * wave + (lane & 15)) * TP + 32 * ks + 8 * (lane >> 4));
#pragma unroll
        for (int t = 0; t < 4; ++t) { const bf16x8 xf = *(const LAS bf16x8*)(Xt + (16 * t + (lane & 15)) * TP + 32 * ks + 8 * (lane >> 4));
            yd[t] = __builtin_amdgcn_mfma_f32_16x16x32_bf16(mf, xf, yd[t], 0, 0, 0); } }
    if (tid < 64) {
        unsigned sp_ = 0;
        for (;;) { const unsigned f = lane < c ? __hip_atomic_load(flags + ((b * 16 + lane) * 16 + h), __ATOMIC_RELAXED, __HIP_MEMORY_SCOPE_AGENT) : 1u;
            if (__builtin_amdgcn_ballot_w64(f == 0u) == 0ull || ++sp_ > (1u << 20)) break; __builtin_amdgcn_s_sleep(1); }
        __builtin_amdgcn_fence(__ATOMIC_ACQUIRE, "agent"); asm volatile("s_waitcnt vmcnt(0)" ::: "memory"); }
    __syncthreads();
    {   const float* ST = (const float*)(ws + WS_STATES) + (size_t)((b * 16) * 16 + h) * HD_C * N_C + tid * 4;
        const float* SD = (const float*)(ws + WS_SMALL + SM_SDEC) + (b * 16) * 16 + h;
        f32x4 hv[4];
#pragma unroll
        for (int k = 0; k < 4; ++k) hv[k] = (f32x4){0.f, 0.f, 0.f, 0.f};
        for (int cc = 0; cc < c; cc += 4) { f32x4 sv[4][4]; float d[4];
#pragma unroll
            for (int q = 0; q < 4; ++q) { const int cq = cc + q < c ? cc + q : c - 1; d[q] = SD[cq * 16];
#pragma unroll
                for (int k = 0; k < 4; ++k) sv[q][k] = *(const GAS f32x4*)(ST + (size_t)cq * 16 * 8192 + 2048 * k); }
#pragma unroll
            for (int q = 0; q < 4; ++q) if (cc + q < c) {
#pragma unroll
                for (int k = 0; k < 4; ++k) hv[k] = hv[k] * d[q] + sv[q][k]; } }
#pragma unroll
        for (int k = 0; k < 4; ++k) { v2u wv; wv.x = pk2(hv[k].x, hv[k].y); wv.y = pk2(hv[k].z, hv[k].w); *(LAS v2u*)(Hp + ((tid >> 5) + 16 * k) * TP + (tid & 31) * 4) = wv; }
        if (c == SSDNC - 1) { const float d = SD[c * 16]; float* o = out + O_SSMP + (size_t)((l * NB + b) * H_C + h) * HD_C * N_C + tid * 4;
#pragma unroll
            for (int k = 0; k < 4; ++k) *(GAS f32x4*)(o + 2048 * k) = hv[k] * d + *(const GAS f32x4*)(ST + (size_t)c * 16 * 8192 + 2048 * k); }
    }
    __syncthreads();
#pragma unroll
    for (int ks = 0; ks < 4; ++ks)
#pragma unroll
        for (int t = 0; t < 4; ++t) { const bf16x8 hf = *(const LAS bf16x8*)(Hp + (16 * t + (lane & 15)) * TP + 32 * ks + 8 * (lane >> 4));
            yo[t] = __builtin_amdgcn_mfma_f32_16x16x32_bf16(cf[ks], hf, yo[t], 0, 0, 0); }
    const float dsk = A->in[I_SSDD][l * H_C + h];
    bf16* OC = (bf16*)(ws + WS_OC); float* csq = (float*)(ws + WS_SMALL + SM_CSQ) + l * MP;
#pragma unroll
    for (int r = 0; r < 4; ++r) { const int i = 16 * wave + 4 * (lane >> 4) + r, row = row0 + i; const float ecs = __expf(cs[i]); float sq = 0.f;
#pragma unroll
        for (int t = 0; t < 4; ++t) { const int p = 16 * t + (lane & 15), ch = h * 64 + p;
            const float x = bf2f(Xt[p * TP + i]);
            const float y = yd[t][r] + ecs * yo[t][r] + dsk * x;
            const float z = bf2f(zz[r][t]);
            const float yz = y * siluf_(z); sq += yz * yz;
            OC[(size_t)row * 1024 + ch] = (bf16)f2bf(yz * A->in[I_GNORM][l * D_C + ch]); }
        sq += xor_lt32<1>(sq); sq += xor_lt32<2>(sq); sq += xor_lt32<4>(sq); sq += xor_lt32<8>(sq);
        if ((lane & 15) == 0 && acc) atomicAdd(csq + row, sq); }
    __syncthreads();
}
__device__ __forceinline__ void phase_upfix(const Frame& F0, KArgs A, int l) {
    Frame F = launder(F0);
    const float* HALO = WSP(const float, WS_HALO); bf16* ACT = WSP(bf16, WS_T);
    const float* cw = A->in[I_FCONVW] + (size_t)l * K_F * D_UP; const float* cb = A->in[I_FCONVB] + (size_t)l * D_UP;
    const int gt = blockIdx.x * NTHR + F.tid, NT = GRID * NTHR;
    for (int i = gt; i < 32 * D_FF; i += NT) { const int ch = i % D_FF, pm = i / D_FF; if ((pm & 7) == 0) continue;
        const int ca_ = 256 * (ch / 128) + ch % 128, cb_ = ca_ + 128;
        const float* hp = HALO + ((size_t)(pm - 1) * 4 + 2) * D_UP; const float* hc = HALO + (size_t)pm * 4 * D_UP;
        const float am2 = hp[ca_], am1 = hp[D_UP + ca_], a0 = hc[ca_], a1 = hc[D_UP + ca_], bm2 = hp[cb_], bm1 = hp[D_UP + cb_], b0 = hc[cb_], b1 = hc[D_UP + cb_];
        const float wa0 = cw[ch], wa1 = cw[D_UP + ch], wa2 = cw[2 * D_UP + ch], wb0 = cw[D_FF + ch], wb1 = cw[D_UP + D_FF + ch], wb2 = cw[2 * D_UP + D_FF + ch], ba = cb[ch], bb = cb[D_FF + ch];
        const float r0 = siluf_(ba + wa0 * am2 + wa1 * am1 + wa2 * a0) * (bb + wb0 * bm2 + wb1 * bm1 + wb2 * b0);
        const float r1 = siluf_(ba + wa0 * am1 + wa1 * a0 + wa2 * a1) * (bb + wb0 * bm1 + wb1 * b0 + wb2 * b1);
        ACT[(size_t)(pm * 256) * D_FF + ch] = (bf16)f2bf(r0); ACT[(size_t)(pm * 256 + 1) * D_FF + ch] = (bf16)f2bf(r1); }
    for (int i = gt; i < NB * 2 * D_UP; i += NT) { const int oc = i % D_UP, k = (i / D_UP) & 1, b = i / (2 * D_UP);
        const int c = oc < D_FF ? 256 * (oc / 128) + oc % 128 : 256 * ((oc - D_FF) / 128) + 128 + (oc - D_FF) % 128;
        F.out[O_CFP + (size_t)l * NB * 2 * D_UP + i] = HALO[((size_t)(8 * b + 7) * 4 + 2 + k) * D_UP + c]; }
}
__device__ __forceinline__ void ssd_conv_p_out(const Frame& F0, int l) {
    Frame F = launder(F0);
    const bf16* PROJ = WSP(const bf16, WS_BIG);
    const int gt = blockIdx.x * NTHR + F.tid, NT = GRID * NTHR;
    for (int i = gt; i < NB * 3 * D_XBC; i += NT) { const int ch = i % D_XBC, k = (i / D_XBC) % 3, b = i / (3 * D_XBC);
        F.out[O_CCP + (size_t)l * NB * 3 * D_XBC + i] = bf2f(PROJ[(size_t)(b * SEQ + SEQ - 3 + k) * N_INP + PC_XBC + ch]); }
}

__device__ __forceinline__ void phase_mix1(const Frame& F0, KArgs A, int l, bool acc) {
    {   Frame F = launder(F0);
        for (int it = F.gw; it < NS * G_A; it += (GRID * NWAVES)) s5_sample_item(A, F.ws, F.out, l, it, F.lane); }
    {   Frame F = launder(F0);
        for (int it = F.gw; it < NS; it += (GRID * NWAVES)) gmlp_sample_item(A, F.ws, F.out, l, it, F.lane); }
    {   Frame F = launder(F0);
        for (int it = F.gw; it < NS * H_C; it += (GRID * NWAVES)) ssd_sample_item(A, F.ws, F.out, l, it, F.lane, acc); }
    ssd_conv_p_out(F0, l);
}
__device__ __forceinline__ void phase_mix2(const Frame& F0, KArgs A, int l, bool acc) {
#ifndef REP_SSD2
#define REP_SSD2 1
#endif
#ifndef REP_GMLP
#define REP_GMLP 1
#endif
#ifndef REP_S5F
#define REP_S5F 1
#endif
    _Pragma("unroll 1") for (int r2 = 0; r2 < REP_SSD2; ++r2) {   Frame F = launder(F0);
        for (int it = blockIdx.x; it < NB * SSDNC * H_C; it += GRID) ssd_item_fused(A, F.ws, F.out, l, it, F.lds, F.tid, F.wave, F.lane, acc && r2 == 0, (unsigned*)(F.ws + WS_CTL) + CW_SSDF + l * 1024); }
    _Pragma("unroll 1") for (int r2 = 0; r2 < REP_GMLP; ++r2) {   Frame F = launder(F0);
        for (int it = blockIdx.x; it < NB * (SEQ / GMC) * H_B; it += GRID) gmlp_item(A, F.ws, l, it, F.lds, F.tid, F.wave, F.lane); }
    _Pragma("unroll 1") for (int r2 = 0; r2 < REP_S5F; ++r2) {   Frame F = launder(F0);
        for (int it = F.gw; it < NB * G_A * S5NC; it += (GRID * NWAVES)) s5_item<true>(A, F.ws, F.out, l, it, F.lds + F.wave * 10752, F.lane, (unsigned*)(F.ws + WS_CTL) + CW_S5F + l * 4096); }
}

constexpr int LDS_BYTES = 147456, MISC_OFF = 147456 - 256;
#ifndef GEMM_SP2
#define GEMM_SP2 true
#endif
template <class Epi>
__device__ __forceinline__ void run_gemm(const Frame& F, const bf16* Am, const bf16* Bt, int M, int N, int K, const Epi& E) {
    pg8::Gemm g{Am, Bt, M, N, K}; pg8::StaticOrder S; S.init(M, N, GRID, (int)blockIdx.x, K);
    pg8::gemm_phase<Epi, pg8::StaticOrder, true, GEMM_SP2>(F.lds, g, S, E);
}
struct SplitSched {
    pg8::StaticOrder P; int c, np, nsl, ntsl, ns, cbase, cu0, sid0;
    __device__ void init(int N, int K, int c_, int nsl_, int cbase_, int cu0_, int sid0_) { sid0 = sid0_; P.init(MPROMPT, N, GRID, c_, K); c = c_; np = (MPROMPT / 256) * (N / 256) / GRID; nsl = nsl_; ntsl = (K / 64) / nsl_; ns = (N / 256) * nsl_; cbase = cbase_; cu0 = cu0_; }
    __device__ bool next(int i, pg8::Unit& u) const {
        const int s = c - cu0; const bool has = s >= 0 && s < ns;
        if (!has || i > 0) return (i - (has ? 1 : 0)) < np ? P.next(i - (has ? 1 : 0), u) : false;
        u.pm = MPROMPT / 256; u.pn = s / nsl; u.k0 = (s % nsl) * ntsl * 64; u.nt = ntsl; u.cidx = cbase + u.pn; u.sid = sid0 + s; return true;
    }
    __device__ __forceinline__ void a_ready(const pg8::Unit&) const {}
    __device__ __forceinline__ void done(const pg8::Unit&) const {}
};
template <class Epi, bool CHAIN_IN>
__device__ __forceinline__ void run_gemm_chain(const Frame& F, const bf16* Am, const bf16* Bt, int K, const Epi& E, pg8::f32x4 (&acc)[2][2][4][2]) {
    pg8::Gemm g{Am, Bt, MPROMPT, DM, K}; pg8::StaticOrder S; S.init(MPROMPT, DM, GRID, (int)blockIdx.x, K);
    pg8::gemm_phase<Epi, pg8::StaticOrder, true, GEMM_SP2, CHAIN_IN>(F.lds, g, S, E, acc);
}
template <class Epi>
__device__ __forceinline__ void run_gemm_split(const Frame& F, const bf16* Am, const bf16* Bt, int N, int K, const Epi& E, int nsl, int cbase, int cu0, int sid0 = 0, bool slices_only = false) {
    pg8::Gemm g{Am, Bt, MP, N, K}; SplitSched S; S.init(N, K, (int)blockIdx.x, nsl, cbase, cu0, sid0); if (slices_only) S.np = 0;
    pg8::gemm_phase<Epi, SplitSched, true, GEMM_SP2>(F.lds, g, S, E);
}

#ifndef REP_PROLOGUE
#define REP_PROLOGUE 1
#endif
#ifndef REP_MOD
#define REP_MOD 1
#endif
#ifndef REP_PREP
#define REP_PREP 1
#endif
#ifndef REP_WIN
#define REP_WIN 1
#endif
#ifndef REP_MIX1
#define REP_MIX1 1
#endif
#ifndef REP_MIX2
#define REP_MIX2 1
#endif
#ifndef REP_GLU
#define REP_GLU 1
#endif
#ifndef REP_MERGE
#define REP_MERGE 1
#endif
#ifndef REP_OUT
#define REP_OUT 1
#endif
#ifndef REP_UP
#define REP_UP 1
#endif
#ifndef REP_CONV
#define REP_CONV 1
#endif
#ifndef REP_DOWN
#define REP_DOWN 1
#endif
#ifndef REP_BAR
#define REP_BAR 1
#endif
#define REP(n) _Pragma("unroll 1") for (int rep_ = 0; rep_ < (n); ++rep_)
__device__ __forceinline__ void grid_bar(const Frame& F0) {
    unsigned long long w = (unsigned long long)F0.ws; unsigned x = xb_xcc_id(); asm volatile("" : "+s"(w), "+s"(x));
    XcdBarrier b; b.bar = (unsigned*)((unsigned char*)w + WS_CTL) + CW_BAR; b.x = x; b.st = (volatile LAS unsigned*)(F0.lds + MISC_OFF) + 8;
    xcd_barrier(b);
}
__global__ void __launch_bounds__(NTHR, 2) mega_fwd(Args Aarg) {
    const KArgs A0 = (KArgs)__builtin_amdgcn_kernarg_segment_ptr(); (void)Aarg;
#define A launder_args(A0)
    extern __shared__ __attribute__((aligned(16))) unsigned char lds_raw[];
    Frame F;
    F.lds = (LAS unsigned char*)lds_raw;
    F.tid = threadIdx.x; F.lane = F.tid & 63; F.wave = __builtin_amdgcn_readfirstlane(F.tid >> 6);
    F.gw = blockIdx.x * NWAVES + F.wave;
    F.out = A0->out; F.ws = A0->ws;
    volatile LAS unsigned* MISC = (volatile LAS unsigned*)(F.lds + MISC_OFF);
    if (F.tid < 64) MISC[F.tid] = 0u;
    __syncthreads();
    (void)xcd_barrier_post((unsigned*)(F.ws + WS_CTL) + CW_BAR, MISC + 8);
#define GRID_BAR() do { REP(REP_BAR) grid_bar(F); } while (0)

#ifndef REP_MODS
#define REP_MODS 1
#endif
    REP(REP_PROLOGUE) { _Pragma("unroll 1") for (int rm = 0; rm < REP_MODS; ++rm) phase_mod(F, A); phase_prologue(F, A);
    GRID_BAR(); }
#pragma unroll 1
    for (int l = 0; l < DEPTH; ++l) {
#define PH_FRAME() const Frame Fq = launder(F); unsigned char* const wsq = Fq.ws; unsigned char* const wl = wsq + WS_W + (size_t)l * WL_END; \
        const float* const modl = (const float*)(wsq + WS_MOD) + (size_t)l * N_MOD; pg8::f32x4* const slab = (pg8::f32x4*)(wsq + WS_SLAB); \
        unsigned* const cnt = (unsigned*)(wsq + WS_CTL) + CW_CNT; (void)wl; (void)modl; (void)slab; (void)cnt
#define WSQ(T, off) ((T*)(wsq + (off)))
        if (l == 0) REP(REP_PREP) { { PH_FRAME(); phase_prep<true>(Fq, A->in[I_XP], A->in[I_XS], A->in[I_GMIX] + l * DM, modl, 0, 1, A->in[I_WIN] + (size_t)l * DM * N_IN, WSQ(float, WS_SMALL + SM_DT)); }
        GRID_BAR(); }
        REP(REP_WIN) { { PH_FRAME(); epi::EpiIn E{WSQ(bf16, WS_BIG), rep_ == 0 ? WSQ(float, WS_SMALL + SM_VSQ) + l * MP : nullptr, epi::SplitCtl{slab, cnt, 4u}};
            run_gemm_split(Fq, WSQ(const bf16, WS_H), (const bf16*)(wl + WL_IN), N_INP, DM, E, 4, (l * 4 + 0) * 64, 0); }
        GRID_BAR(); }
        REP(REP_MIX2) { phase_mix2(F, A, l, rep_ == 0); phase_mix1(F, A, l, rep_ == 0);
        GRID_BAR(); }
        REP(REP_GLU) { { PH_FRAME(); epi::EpiGlu E{WSQ(const bf16, WS_YB), WSQ(bf16, WS_OA)};
            run_gemm(Fq, WSQ(const bf16, WS_YB), (const bf16*)(wl + WL_GLU), MP, 512, 512, E); }
        GRID_BAR(); }
        REP(REP_MERGE) {
            {   PH_FRAME(); bf16* BIG = WSQ(bf16, WS_BIG);
                epi::EpiMerge<0> Ea{BIG + PC_GA, WSQ(float, WS_T), WSQ(bf16, WS_MERGED), WSQ(const float, WS_SMALL + SM_CSQ) + l * MP, slab, BIG, cnt};
                run_gemm_split(Fq, WSQ(const bf16, WS_OA), (const bf16*)(wl + WL_PA), DM, 512, Ea, 2, (l * 4 + 1) * 64, 0, 0); }
            {   PH_FRAME(); bf16* BIG = WSQ(bf16, WS_BIG);
                epi::EpiMerge<1> Eb{BIG + PC_GB, WSQ(float, WS_T), WSQ(bf16, WS_MERGED), WSQ(const float, WS_SMALL + SM_CSQ) + l * MP, slab, BIG, cnt};
                run_gemm_split(Fq, WSQ(const bf16, WS_OB), (const bf16*)(wl + WL_PB), DM, 512, Eb, 2, (l * 4 + 1) * 64, 16, 16); }
            {   PH_FRAME(); bf16* BIG = WSQ(bf16, WS_BIG);
                epi::EpiMerge<2> Ec{BIG + PC_GC, WSQ(float, WS_T), WSQ(bf16, WS_MERGED), WSQ(const float, WS_SMALL + SM_CSQ) + l * MP, slab, BIG, cnt};
                run_gemm_split(Fq, WSQ(const bf16, WS_OC), (const bf16*)(wl + WL_PC), DM, 1024, Ec, 4, (l * 4 + 1) * 64, 32, 32); }
        GRID_BAR(); }
        REP(REP_OUT) { { PH_FRAME(); epi::EpiResidPrep<0> E{epi::EpiResid{WSQ(const bf16, WS_X0), WSQ(const bf16, WS_X0) + (size_t)MPROMPT * DM, WSQ(bf16, WS_X1), modl + 2 * DM, epi::SplitCtl{slab, cnt, 4u}},
                WSQ(bf16, WS_H), nullptr, nullptr, A->in[I_GFFN] + l * DM, modl, 3, 4, nullptr, WSQ(float, WS_SMALL + SM_DT), (unsigned*)(wsq + WS_CTL) + CW_PC + (l * 2 + 0) * 64};
            run_gemm_split(Fq, WSQ(const bf16, WS_MERGED), (const bf16*)(wl + WL_OUT), DM, DM, E, 4, (l * 4 + 2) * 64, 0); }
        GRID_BAR(); }
        REP(REP_UP) { { PH_FRAME(); epi::EpiUpConv E{WSQ(bf16, WS_T), WSQ(float, WS_HALO), A->in[I_FCONVW] + (size_t)l * K_F * D_UP, A->in[I_FCONVB] + (size_t)l * D_UP,
                A->in[I_FFNCONV] + (size_t)l * NS * 2 * D_UP, Fq.out + O_CFS + (size_t)l * NS * 2 * D_UP, (LAS float*)(Fq.lds + 131072), rep_ < REP_UP - 1 ? 1 : 0};
            run_gemm(Fq, WSQ(const bf16, WS_H), (const bf16*)(wl + WL_UP), MP, D_UP, DM, E); }
        GRID_BAR(); }
        REP(REP_CONV) { phase_upfix(F, A, l);
        GRID_BAR(); }
        REP(REP_DOWN) {
            if (l + 1 < DEPTH) { PH_FRAME(); const float* mod2 = (const float*)(wsq + WS_MOD) + (size_t)(l + 1) * N_MOD;
                epi::EpiResidPrep<1> E{epi::EpiResid{WSQ(const bf16, WS_X1), WSQ(const bf16, WS_X1) + (size_t)MPROMPT * DM, WSQ(bf16, WS_X0), modl + 5 * DM, epi::SplitCtl{slab, cnt, 4u}},
                    WSQ(bf16, WS_H), nullptr, nullptr, A->in[I_GMIX] + (l + 1) * DM, mod2, 0, 1, WSQ(const float, WS_SMALL + SM_WDT) + (size_t)(l + 1) * 16 * DM, WSQ(float, WS_SMALL + SM_DT), (unsigned*)(wsq + WS_CTL) + CW_PC + (l * 2 + 1) * 64};
                run_gemm_split(Fq, WSQ(const bf16, WS_T), (const bf16*)(wl + WL_DOWN), DM, D_FF, E, 4, (l * 4 + 3) * 64, 0);
            } else { PH_FRAME();
                epi::EpiResidPrep<2> E{epi::EpiResid{WSQ(const bf16, WS_X1), WSQ(const bf16, WS_X1) + (size_t)MPROMPT * DM, WSQ(bf16, WS_X0), modl + 5 * DM, epi::SplitCtl{slab, cnt, 4u}},
                    nullptr, Fq.out + O_YP, Fq.out + O_YS, A->in[I_GFINAL], modl, 0, 1, nullptr, WSQ(float, WS_SMALL + SM_DT), (unsigned*)(wsq + WS_CTL) + CW_PC + (l * 2 + 1) * 64};
                run_gemm_split(Fq, WSQ(const bf16, WS_T), (const bf16*)(wl + WL_DOWN), DM, D_FF, E, 4, (l * 4 + 3) * 64, 0); }
        if (l + 1 < DEPTH) GRID_BAR(); }
    }
#undef A
}

extern "C" void kernel_launch(void* const* d_in, const int* in_sizes, int n_in, void* d_out, int out_size, void* d_ws, size_t ws_size, hipStream_t stream) {
    static int grid = 0;
    if (grid == 0) {
        if (n_in != N_INPUTS || (size_t)out_size != O_END || ws_size < WS_END) { fprintf(stderr, "kernel_launch: unexpected shapes (n_in %d, out %d, ws %zu, need %zu)\n", n_in, out_size, ws_size, (size_t)WS_END); grid = -1; return; }
        int dev = 0, cus = 0, per_cu = 0;
        if (hipGetDevice(&dev) != hipSuccess || hipDeviceGetAttribute(&cus, hipDeviceAttributeMultiprocessorCount, dev) != hipSuccess) { grid = -1; return; }
        if (hipFuncSetAttribute((const void*)mega_fwd, hipFuncAttributeMaxDynamicSharedMemorySize, LDS_BYTES) != hipSuccess) { fprintf(stderr, "kernel_launch: hipFuncSetAttribute failed\n"); grid = -1; return; }
        if (hipOccupancyMaxActiveBlocksPerMultiprocessor(&per_cu, (const void*)mega_fwd, NTHR, LDS_BYTES) != hipSuccess || per_cu < 1) { fprintf(stderr, "kernel_launch: occupancy query reports %d blocks per CU\n", per_cu); (void)hipGetLastError(); grid = -1; return; }
        if (cus * per_cu < GRID) { fprintf(stderr, "kernel_launch: %d CUs x %d blocks cannot hold the %d-workgroup grid\n", cus, per_cu, GRID); grid = -1; return; }
        grid = GRID;
    }
    if (grid < 0) return;
    if (hipMemsetAsync((char*)d_ws + WS_CTL, 0, CTL_ZERO_BYTES, stream) != hipSuccess) return;
    Args a{};
    for (int i = 0; i < N_INPUTS; ++i) a.in[i] = (const float*)d_in[i];
    a.out = (float*)d_out; a.ws = (unsigned char*)d_ws;
    void* params[] = {&a};
    hipError_t e = hipLaunchCooperativeKernel((const void*)mega_fwd, dim3(grid), dim3(NTHR), params, LDS_BYTES, stream);
    if (e != hipSuccess) fprintf(stderr, "kernel_launch: cooperative launch failed: %s (grid %d)\n", hipGetErrorString(e), grid);
}
```

```cpp
#include <hip/hip_runtime.h>
#include <cstdio>
#include <cstdint>
namespace pg8 {
#define PG8_LAS __attribute__((address_space(3)))
typedef unsigned short bf16_t;
typedef short bf16x8 __attribute__((ext_vector_type(8)));
typedef float f32x4 __attribute__((ext_vector_type(4)));
typedef unsigned u32x4 __attribute__((ext_vector_type(4)));
constexpr int BM = 256, BK = 64, HALF = 128, HTB = HALF * BK * 2  , STAGE_BYTES = 8 * HTB, NXCD = 8, WGM = 8;

__host__ __device__ __forceinline__ int lds_byte(int r, int c) { const int st = (r >> 4) * 2 + (c >> 5), rr = r & 15, cc = c & 31, ob = rr * 64 + cc * 2; return st * 1024 + (ob ^ (((ob >> 9) & 1) << 5)); }
__host__ __device__ __forceinline__ void stage_rc(int b, int& R, int& C) { const int st = b / 1024, sb = b % 1024, swz = sb ^ (((sb >> 9) & 1) << 5); R = (st >> 1) * 16 + swz / 64; C = (st & 1) * 32 + (swz % 64) / 2; }
__host__ __device__ __forceinline__ int perm32(int rho) { const int n = rho >> 4, i = rho & 15; return 8 * (i >> 2) + 4 * n + (i & 3); }

struct Unit { int pm, pn, k0, nt, cidx, sid; };
struct Gemm { const bf16_t* A; const bf16_t* Bt; int M, N, K; };

struct StaticOrder {
    int nM, nN, nwg, G, c, ntk;
    __host__ __device__ void init(int M, int N, int G_, int c_, int K_) { nM = M / BM; nN = N / BM; nwg = nM * nN; G = G_; c = c_; ntk = K_ / BK; }
    __host__ __device__ bool next(int i, Unit& u) const {
        const long L = (long)i * G + c; if (L >= nwg) return false;
        int wgid = (int)L; { const int q = nwg / NXCD, r = nwg % NXCD, xcd = wgid % NXCD, off = wgid / NXCD; wgid = (xcd < r ? xcd * (q + 1) : r * (q + 1) + (xcd - r) * q) + off; }
        const int nig = WGM * nN, gid = wgid / nig, fm = gid * WGM, gsz = (nM - fm) < WGM ? (nM - fm) : WGM;
        u.pm = fm + ((wgid % nig) % gsz); u.pn = (wgid % nig) / gsz; u.k0 = 0; u.nt = ntk; u.cidx = -1; u.sid = 0; return true;
    }
    __device__ __forceinline__ void a_ready(const Unit&) const {}
    __device__ __forceinline__ void done(const Unit&) const {}
};
__device__ __forceinline__ unsigned cvt_pk_bf16(float lo, float hi) { unsigned r; asm volatile("s_nop 0\n\tv_cvt_pk_bf16_f32 %0, %1, %2" : "=v"(r) : "v"(lo), "v"(hi)); return r; }
template <class Epi, class Sched, bool ALIGN_EPI = false, bool SP2 = false, bool CHAIN_IN = false>
__device__ __forceinline__ void gemm_phase(PG8_LAS unsigned char* lds, const Gemm g, const Sched& S, const Epi& E, f32x4 (&acc)[2][2][4][2]) {
    int tid_ = threadIdx.x; asm volatile("" : "+v"(tid_));
    const int tid = tid_, wid = __builtin_amdgcn_readfirstlane(tid >> 6), lane = tid & 63, wr = wid >> 2, wc = wid & 3, fr = lane & 15, fq = lane >> 4;
    const int K = g.K;
    unsigned voffA[2], voffB[2];
#pragma unroll
    for (int i = 0; i < 2; ++i) { int R, C; stage_rc(tid * 16 + i * 8192, R, C); const int Rb = Epi::PERM ? ((R & ~31) + perm32(R & 31)) : R;
        voffA[i] = (unsigned)(R * K + C) * 2u; voffB[i] = (unsigned)(Rb * K + C) * 2u; }
    const size_t kstep = (size_t)(BK * 2);
    const size_t hstep = (size_t)HALF * K * 2;
    const size_t tstep = 2 * hstep;
    const unsigned ldsw = (unsigned)wid * 1024u;
    const int aoff = lds_byte(wr * 64 + fr, fq * 8), boff = lds_byte(wc * 32 + fr, fq * 8);
#define PG8_SA(b, h) (((b) * 2 + (h)) * HTB)
#define PG8_SB(b, h) ((4 + (b) * 2 + (h)) * HTB)
#define PG8_STAGE(bufoff, gbase, voff) do { _Pragma("unroll") for (int _i = 0; _i < 2; ++_i) \
        __builtin_amdgcn_global_load_lds((const unsigned*)((const char*)(gbase) + (voff)[_i]), (PG8_LAS unsigned*)(lds + (bufoff) + ldsw + _i * 8192), 16, 0, 0); } while (0)
#define PG8_LDA(dst, b, h) do { _Pragma("unroll") for (int m = 0; m < 4; ++m) _Pragma("unroll") for (int k = 0; k < 2; ++k) dst[m][k] = *(const PG8_LAS bf16x8*)(lds + PG8_SA(b, h) + aoff + m * 2048 + k * 1024); } while (0)
#define PG8_LDB(dst, b, h) do { _Pragma("unroll") for (int n = 0; n < 2; ++n) _Pragma("unroll") for (int k = 0; k < 2; ++k) dst[n][k] = *(const PG8_LAS bf16x8*)(lds + PG8_SB(b, h) + boff + n * 2048 + k * 1024); } while (0)
#define PG8_MMA(ai, bj, At, Bt) do { __builtin_amdgcn_s_setprio(1); _Pragma("unroll") for (int m = 0; m < 4; ++m) _Pragma("unroll") for (int n = 0; n < 2; ++n) _Pragma("unroll") for (int k = 0; k < 2; ++k) \
        acc[ai][bj][m][n] = __builtin_amdgcn_mfma_f32_16x16x32_bf16(Bt[n][k], At[m][k], acc[ai][bj][m][n], 0, 0, 0); __builtin_amdgcn_s_setprio(0); } while (0)
#define PG8_WAIT_V(n) asm volatile("s_waitcnt vmcnt(" #n ")" ::: "memory")
#define PG8_WAIT_L(n) asm volatile("s_waitcnt lgkmcnt(" #n ")" ::: "memory")
#define PG8_BAR __builtin_amdgcn_s_barrier()
#define PG8_SCHED __builtin_amdgcn_sched_barrier(0)
    Unit cur, nxt; int ui = 0;
    if (!S.next(0, cur)) return;
    if constexpr (!CHAIN_IN) {
#pragma unroll
    for (int a = 0; a < 2; ++a)
#pragma unroll
        for (int b = 0; b < 2; ++b)
#pragma unroll
            for (int m = 0; m < 4; ++m)
#pragma unroll
                for (int n = 0; n < 2; ++n) acc[a][b][m][n] = (f32x4){0.f, 0.f, 0.f, 0.f};
    }
    bf16x8 At[4][2], B0[2][2], B1[2][2];
    const char* cA = (const char*)g.A + (size_t)cur.pm * tstep + (size_t)cur.k0 * 2; const char* cB = (const char*)g.Bt + (size_t)cur.pn * tstep + (size_t)cur.k0 * 2;
    S.a_ready(cur);
    if constexpr (SP2) {
        PG8_STAGE(PG8_SB(0, 0), cB, voffB); PG8_STAGE(PG8_SB(0, 1), cB + hstep, voffB); PG8_STAGE(PG8_SA(0, 0), cA, voffA); PG8_STAGE(PG8_SA(0, 1), cA + hstep, voffA);
        if (wr == 1) PG8_BAR;
        PG8_WAIT_V(2); PG8_BAR;
        PG8_STAGE(PG8_SB(1, 0), cB + kstep, voffB); PG8_STAGE(PG8_SA(1, 0), cA + kstep, voffA); PG8_STAGE(PG8_SB(1, 1), cB + hstep + kstep, voffB);
        PG8_WAIT_V(6); PG8_BAR;
    } else {
        PG8_STAGE(PG8_SB(0, 0), cB, voffB); PG8_STAGE(PG8_SA(0, 0), cA, voffA); PG8_STAGE(PG8_SB(0, 1), cB + hstep, voffB); PG8_STAGE(PG8_SA(0, 1), cA + hstep, voffA);
        if (wr == 1) PG8_BAR;
        PG8_WAIT_V(4); PG8_BAR;
        PG8_STAGE(PG8_SB(1, 0), cB + kstep, voffB); PG8_STAGE(PG8_SA(1, 0), cA + kstep, voffA); PG8_STAGE(PG8_SB(1, 1), cB + hstep + kstep, voffB);
        PG8_WAIT_V(6); PG8_BAR;
    }
    for (;;) {
        const bool has_next = S.next(ui + 1, nxt);
        const char* nA = has_next ? (const char*)g.A + (size_t)nxt.pm * tstep + (size_t)nxt.k0 * 2 : cA; const char* nB = has_next ? (const char*)g.Bt + (size_t)nxt.pn * tstep + (size_t)nxt.k0 * 2 : cB;
        const int nt = cur.nt; const bool halfu = cur.cidx >= 0;
        for (int t = 0; t < nt; t += 2) {
            const bool last = (t == nt - 2);
            const char* a1 = cA + (size_t)(t + 1) * kstep;
            const char* a2 = last ? nA : cA + (size_t)(t + 2) * kstep; const char* b2 = last ? nB : cB + (size_t)(t + 2) * kstep;
            const char* a3 = a2 + kstep; const char* b3 = b2 + kstep;
            if (last && has_next) S.a_ready(nxt);
            if constexpr (SP2) {
            PG8_LDB(B0, 0, 0); PG8_LDB(B1, 0, 1); PG8_SCHED; PG8_LDA(At, 0, 0); PG8_STAGE(PG8_SA(1, 1), a1 + hstep, voffA);
            PG8_WAIT_V(8); PG8_WAIT_L(0); PG8_BAR; PG8_MMA(0, 0, At, B0); PG8_MMA(0, 1, At, B1); PG8_BAR; PG8_SCHED;
            PG8_LDA(At, 0, 1); PG8_STAGE(PG8_SB(0, 0), b2, voffB); PG8_STAGE(PG8_SB(0, 1), b2 + hstep, voffB); PG8_STAGE(PG8_SA(0, 0), a2, voffA);
            PG8_WAIT_V(8); PG8_WAIT_L(0); PG8_BAR; if (!halfu) { PG8_MMA(1, 0, At, B0); PG8_MMA(1, 1, At, B1); } PG8_BAR; PG8_SCHED;
            PG8_LDB(B0, 1, 0); PG8_LDB(B1, 1, 1); PG8_SCHED; PG8_LDA(At, 1, 0); PG8_STAGE(PG8_SA(0, 1), a2 + hstep, voffA);
            PG8_WAIT_V(8); PG8_WAIT_L(0); PG8_BAR; PG8_MMA(0, 0, At, B0); PG8_MMA(0, 1, At, B1); PG8_BAR; PG8_SCHED;
            PG8_LDA(At, 1, 1); PG8_STAGE(PG8_SB(1, 0), b3, voffB); PG8_STAGE(PG8_SB(1, 1), b3 + hstep, voffB); PG8_STAGE(PG8_SA(1, 0), a3, voffA);
            PG8_WAIT_V(8); PG8_WAIT_L(0); PG8_BAR; if (!halfu) { PG8_MMA(1, 0, At, B0); PG8_MMA(1, 1, At, B1); } PG8_BAR; PG8_SCHED;
            } else {
            PG8_LDB(B0, 0, 0); PG8_SCHED; PG8_LDA(At, 0, 0); PG8_STAGE(PG8_SA(1, 1), a1 + hstep, voffA);
            PG8_WAIT_L(8); PG8_BAR; PG8_WAIT_L(0); PG8_MMA(0, 0, At, B0); PG8_BAR; PG8_SCHED;
            PG8_LDB(B1, 0, 1); PG8_STAGE(PG8_SB(0, 0), b2, voffB);
            PG8_BAR; PG8_WAIT_L(0); PG8_MMA(0, 1, At, B1); PG8_BAR;
            PG8_LDA(At, 0, 1); PG8_STAGE(PG8_SA(0, 0), a2, voffA);
            PG8_BAR; PG8_WAIT_L(0); PG8_MMA(1, 0, At, B0); PG8_BAR; PG8_SCHED;
            PG8_STAGE(PG8_SB(0, 1), b2 + hstep, voffB);
            PG8_WAIT_V(6); PG8_BAR; PG8_MMA(1, 1, At, B1); PG8_BAR;
            PG8_LDB(B0, 1, 0); PG8_SCHED; PG8_LDA(At, 1, 0); PG8_STAGE(PG8_SA(0, 1), a2 + hstep, voffA);
            PG8_WAIT_L(8); PG8_BAR; PG8_WAIT_L(0); PG8_MMA(0, 0, At, B0); PG8_BAR; PG8_SCHED;
            PG8_LDB(B1, 1, 1); PG8_STAGE(PG8_SB(1, 0), b3, voffB);
            PG8_BAR; PG8_WAIT_L(0); PG8_MMA(0, 1, At, B1); PG8_BAR;
            PG8_LDA(At, 1, 1); PG8_STAGE(PG8_SA(1, 0), a3, voffA);
            PG8_BAR; PG8_WAIT_L(0); PG8_MMA(1, 0, At, B0); PG8_BAR; PG8_SCHED;
            PG8_STAGE(PG8_SB(1, 1), b3 + hstep, voffB);
            PG8_WAIT_V(6); PG8_BAR; PG8_MMA(1, 1, At, B1); PG8_BAR;
            }
        }
        if constexpr (ALIGN_EPI) { if (wr == 0) PG8_BAR; }
        if constexpr (!Epi::AFTER_DRAIN) { int t2 = threadIdx.x; asm volatile("" : "+v"(t2)); const int lane2 = t2 & 63, fr2 = lane2 & 15, fq2 = lane2 >> 4;
            if (cur.cidx < 0) E(acc, cur, wr, wc, fr2, fq2); else E.partial(acc, cur, wr, wc, fr2, fq2, wid, lane2); S.done(cur); }
        else { if (cur.cidx >= 0) { int t2 = threadIdx.x; asm volatile("" : "+v"(t2)); const int lane2 = t2 & 63; E.partial(acc, cur, wr, wc, lane2 & 15, lane2 >> 4, wid, lane2); } }
        if (!has_next) break;
#pragma unroll
        for (int a = 0; a < 2; ++a)
#pragma unroll
            for (int b = 0; b < 2; ++b)
#pragma unroll
                for (int m = 0; m < 4; ++m)
#pragma unroll
                    for (int n = 0; n < 2; ++n) acc[a][b][m][n] = (f32x4){0.f, 0.f, 0.f, 0.f};
        cur = nxt; cA = nA; cB = nB; ++ui;
        if constexpr (ALIGN_EPI) { if (wr == 1) PG8_BAR; }
    }
    PG8_WAIT_V(0);
    if constexpr (!ALIGN_EPI) { if (wr == 0) PG8_BAR; }
    PG8_BAR;
    if constexpr (Epi::AFTER_DRAIN) { E.fused(acc, cur, wr, wc, fr, fq, lds, wid, lane); S.done(cur); }
#undef PG8_SA
#undef PG8_SB
#undef PG8_STAGE
#undef PG8_LDA
#undef PG8_LDB
#undef PG8_MMA
#undef PG8_WAIT_V
#undef PG8_WAIT_L
#undef PG8_BAR
#undef PG8_SCHED
}
template <class Epi, class Sched, bool ALIGN_EPI = false, bool SP2 = false>
__device__ __forceinline__ void gemm_phase(PG8_LAS unsigned char* lds, const Gemm g, const Sched& S, const Epi& E) {
    f32x4 acc[2][2][4][2];
    gemm_phase<Epi, Sched, ALIGN_EPI, SP2, false>(lds, g, S, E, acc);
}

}
constexpr int DM = 2048, NB = 4, SEQ = 2048, NS = 128, DEPTH = 2;
constexpr int MPROMPT = NB * SEQ;
constexpr int MREAL = MPROMPT + NS;
constexpr int MP = 8448;
constexpr int D_A = 512, G_A = 32, P_A = 64, S5G = 16;
constexpr int D_B = 512, H_B = 8, GMC = 128;
constexpr int D_C = 1024, HD_C = 64, H_C = 16, N_C = 128, G_C = 2, K_C = 4, D_XBC = 1536;
constexpr int D_FF = 5632, K_F = 3, D_UP = 2 * D_FF;
constexpr int N_IN = 10256, N_INP = 10240;
constexpr int N_MOD = 6 * DM, MOD_PITCH = 2 * N_MOD;
constexpr float EPS = 1e-6f;
constexpr int PC_UA = 0, PC_UB = 512, PC_VB = 1024, PC_Z = 1536, PC_XBC = 2560, PC_GA = 4096, PC_GB = 6144, PC_GC = 8192;
constexpr int S5Q = 64, S5NC = SEQ / S5Q;
constexpr int SSDQ = 128, SSDNC = SEQ / SSDQ;

enum { I_XP = 0, I_XS, I_CP, I_CS, I_S5RE, I_S5IM, I_SSM, I_SSDCONV, I_FFNCONV, I_WMOD, I_BMOD, I_GMIX, I_WIN, I_LAMRE, I_LAMIM, I_LOGDT,
       I_BRE, I_BIM, I_CRE, I_CIM, I_S5D, I_WGLU, I_GV, I_WS, I_BS, I_CONVW, I_CONVB, I_DTBIAS, I_ALOG, I_SSDD, I_GNORM, I_WPA, I_WPB, I_WPC,
       I_WOUT, I_GFFN, I_WUP, I_FCONVW, I_FCONVB, I_WDOWN, I_GFINAL, N_INPUTS };
constexpr size_t O_YP = 0, O_YS = 16777216, O_S5RP = 17039360, O_S5IP = 17055744, O_SSMP = 17072128, O_CCP = 18120704, O_CFP = 18157568,
                 O_S5RS = 18337792, O_S5IS = 18862080, O_SSMS = 19386368, O_CCS = 52940800, O_CFS = 54120448, O_GVS = 59887616, O_END = 60018688;

constexpr size_t MiB = 1u << 20;
constexpr size_t WS_CTL = 0, CTL_ZERO_BYTES = 1 * MiB;
constexpr size_t SZ_WIN = (size_t)N_INP * DM * 2, SZ_WGLU = 512 * 512 * 2, SZ_WPA = (size_t)DM * 512 * 2, SZ_WPC = (size_t)DM * 1024 * 2,
                 SZ_WOUT = (size_t)DM * DM * 2, SZ_WUP = (size_t)D_UP * DM * 2, SZ_WDOWN = (size_t)DM * D_FF * 2;
constexpr size_t WL_IN = 0, WL_GLU = WL_IN + SZ_WIN, WL_PA = WL_GLU + SZ_WGLU, WL_PB = WL_PA + SZ_WPA, WL_PC = WL_PB + SZ_WPA, WL_OUT = WL_PC + SZ_WPC,
                 WL_UP = WL_OUT + SZ_WOUT, WL_DOWN = WL_UP + SZ_WUP, WL_END = WL_DOWN + SZ_WDOWN;
constexpr size_t WS_W = 2 * MiB;
constexpr size_t WS_SMALL = WS_W + 2 * WL_END;
constexpr size_t SM_WS = 0;
constexpr size_t SM_S5BB = SM_WS + 2 * 8 * 128 * 128 * 2;
constexpr size_t SM_S5CT = SM_S5BB + 2 * 32 * 64 * 32 * 4;
constexpr size_t SM_S5A = SM_S5CT + 2 * 32 * 16 * 128 * 2;
constexpr size_t SM_DT = SM_S5A + 2 * 32 * 64 * 4 * 4;
constexpr size_t SM_VSQ = SM_DT + (size_t)MP * 16 * 4;
constexpr size_t SM_CSQ = SM_VSQ + (size_t)2 * MP * 4;
constexpr size_t SM_SLOC = SM_CSQ + (size_t)2 * MP * 4;
constexpr size_t SM_SDEC = SM_SLOC + (size_t)NB * G_A * S5NC * 128 * 4;
constexpr size_t SM_CSILU = SM_SDEC + 4096;
constexpr size_t SM_WDT = SM_CSILU + 256 * 2048 * 2;
constexpr size_t SM_END = SM_WDT + (size_t)2 * 16 * DM * 4;
constexpr size_t WS_MOD = (WS_SMALL + SM_END + 4095) / 4096 * 4096;
constexpr size_t WS_X0 = WS_MOD + (size_t)2 * 256 * N_MOD * 4;
constexpr size_t WS_X1 = WS_X0 + (size_t)MP * DM * 4;
constexpr size_t WS_H = WS_X1 + (size_t)MP * DM * 4;
constexpr size_t WS_BIG = WS_H + (size_t)MP * DM * 2;
constexpr size_t WS_T = WS_BIG + (size_t)MP * D_UP * 2;
constexpr size_t WS_MERGED = WS_T + (size_t)MP * DM * 4;
constexpr size_t WS_OA = WS_MERGED + (size_t)MP * DM * 2;
constexpr size_t WS_OB = WS_OA + (size_t)MP * 512 * 2;
constexpr size_t WS_YB = WS_OB + (size_t)MP * 512 * 2;
constexpr size_t WS_OC = WS_YB + (size_t)MP * 512 * 2;
constexpr size_t WS_STATES = WS_OC + (size_t)MP * 1024 * 2;
constexpr size_t WS_SLAB = WS_STATES + (size_t)NB * SSDNC * H_C * HD_C * N_C * 4;
constexpr size_t WS_HALO = WS_SLAB + (size_t)176 * 131072;
constexpr size_t WS_END = WS_HALO + (size_t)33 * 4 * D_UP * 4;
static_assert((size_t)MP * D_FF * 2 <= (size_t)MP * DM * 6, "ACT overlays T+MERGED");
constexpr int CW_PC = 12288;
constexpr int CW_S5F = 20480;
constexpr int CW_SSDF = 16384;
constexpr int CW_BAR = 4096, CW_CNT = 8192;
struct Args { const float* in[N_INPUTS]; float* out; unsigned char* ws; };
typedef const __attribute__((address_space(4))) Args* KArgs;
__device__ __forceinline__ KArgs launder_args(KArgs a) { unsigned long long t = (unsigned long long)a; asm volatile("" : "+s"(t)); return (KArgs)t; }
#define GAS __attribute__((address_space(1)))
#define LAS __attribute__((address_space(3)))
typedef unsigned short bf16;
typedef unsigned v4u __attribute__((ext_vector_type(4)));
typedef unsigned v2u __attribute__((ext_vector_type(2)));
typedef float f32x4 __attribute__((ext_vector_type(4)));
typedef float f32x2 __attribute__((ext_vector_type(2)));
typedef short bf16x8 __attribute__((ext_vector_type(8)));
typedef short bf16x4 __attribute__((ext_vector_type(4)));
typedef GAS unsigned gu32;
#define RLX_AGENT __ATOMIC_RELAXED, __HIP_MEMORY_SCOPE_AGENT
#define LDS_WAIT() asm volatile("s_waitcnt lgkmcnt(0)" ::: "memory")
#define VM_WAIT() asm volatile("s_waitcnt vmcnt(0)" ::: "memory")
constexpr int NWAVES = 8, NTHR = 512, GRID = 256;
__device__ __forceinline__ unsigned f2bf(float f) { unsigned u = __builtin_bit_cast(unsigned, f); return (u + 0x7fffu + ((u >> 16) & 1u)) >> 16; }
__device__ __forceinline__ unsigned pk2(float lo, float hi) { return f2bf(lo) | (f2bf(hi) << 16); }
__device__ __forceinline__ float bf2f(unsigned short b) { return __builtin_bit_cast(float, (unsigned)b << 16); }
__device__ __forceinline__ float bflo(unsigned w) { return __builtin_bit_cast(float, w << 16); }
__device__ __forceinline__ float bfhi(unsigned w) { return __builtin_bit_cast(float, w & 0xffff0000u); }
__device__ __forceinline__ float sigmoidf_(float x) { return __builtin_amdgcn_rcpf(1.0f + __expf(-x)); }
__device__ __forceinline__ float siluf_(float x) { return x * __builtin_amdgcn_rcpf(1.0f + __expf(-x)); }
__device__ __forceinline__ float gelu_tanh(float x) {
    const float u = 0.7978845608028654f * (x + 0.044715f * x * x * x);
    const float e = __expf(2.0f * u);
    const float t = 1.0f - 2.0f * __builtin_amdgcn_rcpf(e + 1.0f);
    return 0.5f * x * (1.0f + t);
}
__device__ __forceinline__ float softplusf_(float x) { return fmaxf(x, 0.f) + __logf(1.0f + __expf(-fabsf(x))); }
template <int M> __device__ __forceinline__ float xor_lt32(float x) {
    return __builtin_bit_cast(float, __builtin_amdgcn_ds_swizzle(__builtin_bit_cast(int, x), (M << 10) | 0x1f)); }
__device__ __forceinline__ float add_xor32(float x) {
    const unsigned b = __builtin_bit_cast(unsigned, x); const auto r = __builtin_amdgcn_permlane32_swap(b, b, false, false);
    return __builtin_bit_cast(float, (unsigned)r[0]) + __builtin_bit_cast(float, (unsigned)r[1]); }
__device__ __forceinline__ float wave_sum(float v) {
    v += xor_lt32<1>(v); v += xor_lt32<2>(v); v += xor_lt32<4>(v); v += xor_lt32<8>(v); v += xor_lt32<16>(v);
    return add_xor32(v);
}
__device__ __forceinline__ float wave_sum16(const float (&a)[16], int lane) {
    float b[8], c[4], d[2];
    const bool o1 = lane & 1, o2 = lane & 2, o4 = lane & 4, o8 = lane & 8;
#pragma unroll
    for (int i = 0; i < 8; ++i) { const float keep = o1 ? a[2 * i + 1] : a[2 * i], send = o1 ? a[2 * i] : a[2 * i + 1]; b[i] = keep + xor_lt32<1>(send); }
#pragma unroll
    for (int i = 0; i < 4; ++i) { const float keep = o2 ? b[2 * i + 1] : b[2 * i], send = o2 ? b[2 * i] : b[2 * i + 1]; c[i] = keep + xor_lt32<2>(send); }
#pragma unroll
    for (int i = 0; i < 2; ++i) { const float keep = o4 ? c[2 * i + 1] : c[2 * i], send = o4 ? c[2 * i] : c[2 * i + 1]; d[i] = keep + xor_lt32<4>(send); }
    const float keep = o8 ? d[1] : d[0], send = o8 ? d[0] : d[1];
    float e = keep + xor_lt32<8>(send);
    e += xor_lt32<16>(e);
    return add_xor32(e);
}
__device__ __forceinline__ float half_sum32(const float (&a)[32], int lane) {
    float b[16], c[8], d[4], e[2];
    const bool o1 = lane & 1, o2 = lane & 2, o4 = lane & 4, o8 = lane & 8, o16 = lane & 16;
#pragma unroll
    for (int i = 0; i < 16; ++i) { const float keep = o1 ? a[2 * i + 1] : a[2 * i], send = o1 ? a[2 * i] : a[2 * i + 1]; b[i] = keep + xor_lt32<1>(send); }
#pragma unroll
    for (int i = 0; i < 8; ++i) { const float keep = o2 ? b[2 * i + 1] : b[2 * i], send = o2 ? b[2 * i] : b[2 * i + 1]; c[i] = keep + xor_lt32<2>(send); }
#pragma unroll
    for (int i = 0; i < 4; ++i) { const float keep = o4 ? c[2 * i + 1] : c[2 * i], send = o4 ? c[2 * i] : c[2 * i + 1]; d[i] = keep + xor_lt32<4>(send); }
#pragma unroll
    for (int i = 0; i < 2; ++i) { const float keep = o8 ? d[2 * i + 1] : d[2 * i], send = o8 ? d[2 * i] : d[2 * i + 1]; e[i] = keep + xor_lt32<8>(send); }
    const float keep = o16 ? e[1] : e[0], send = o16 ? e[0] : e[1];
    return keep + xor_lt32<16>(send);
}
__device__ __forceinline__ float lane_bcast(float x, int src) {
    return __builtin_bit_cast(float, __builtin_amdgcn_readlane(__builtin_bit_cast(int, x), src)); }
__device__ __forceinline__ int mod_row(int r) { return r < MPROMPT ? (r >> 11) : (r < MREAL ? 4 + (r - MPROMPT) : 4 + NS - 1); }

template <int MODE>
__device__ __forceinline__ void prep_row(const bf16* xrow, const float* g, const float* mr, int sh_idx, int sc_idx, bf16* hrow, float* yrow, float* dtrow, const LAS float* wT, int lane) {
    const GAS v2u* xr = (const GAS v2u*)xrow + lane;
    f32x4 v[8]; float s = 0.f;
#pragma unroll
    for (int j = 0; j < 8; ++j) { const v2u w = xr[64 * j]; v[j] = (f32x4){bflo(w.x), bfhi(w.x), bflo(w.y), bfhi(w.y)}; s += (v[j].x * v[j].x + v[j].y * v[j].y) + (v[j].z * v[j].z + v[j].w * v[j].w); }
    const float rinv = rsqrtf(wave_sum(s) * (1.0f / DM) + EPS);
    const GAS f32x4* gp = (const GAS f32x4*)g + lane;
    if (MODE == 2) { GAS f32x4* o = (GAS f32x4*)yrow + lane;
#pragma unroll
        for (int j = 0; j < 8; ++j) o[64 * j] = v[j] * rinv * gp[64 * j];
        return; }
    const GAS f32x4* shp = (const GAS f32x4*)(mr + sh_idx * DM) + lane; const GAS f32x4* scp = (const GAS f32x4*)(mr + sc_idx * DM) + lane;
    GAS v2u* o = (GAS v2u*)hrow + lane;
#pragma unroll
    for (int j = 0; j < 8; ++j) { const f32x4 gg = gp[64 * j], sh = shp[64 * j], sc = scp[64 * j];
        v[j] = v[j] * rinv * gg * (sc + 1.0f) + sh;
        v2u w; w.x = pk2(v[j].x, v[j].y); w.y = pk2(v[j].z, v[j].w); o[64 * j] = w; }
    if (MODE == 1) {
        float a16[16];
#pragma unroll
        for (int hh = 0; hh < 16; ++hh) { float a = 0.f;
#pragma unroll
            for (int j = 0; j < 8; ++j) { const f32x4 w = *(const LAS f32x4*)(wT + hh * DM + 4 * lane + 256 * j); a += (v[j].x * w.x + v[j].y * w.y) + (v[j].z * w.z + v[j].w * w.w); }
            a16[hh] = a; }
        const float mine = wave_sum16(a16, lane);
        if (lane < 16) dtrow[lane] = mine;
    }
}

template <int MODE>
__device__ __forceinline__ void prep_rows4(const bf16* x0, const float* g, const float* mr, int sh_idx, int sc_idx, bf16* h0, float* y0, float* dt0, const LAS float* wT, int lane) {
    f32x4 v[4][8];
#pragma unroll
    for (int q = 0; q < 4; ++q) { const GAS v2u* xr = (const GAS v2u*)(x0 + (size_t)q * DM) + lane;
#pragma unroll
        for (int j = 0; j < 8; ++j) { const v2u w = xr[64 * j]; v[q][j] = (f32x4){bflo(w.x), bfhi(w.x), bflo(w.y), bfhi(w.y)}; } }
    f32x4 gm[8], sh[8];
    {   const GAS f32x4* gp = (const GAS f32x4*)g + lane;
        if (MODE == 2) {
#pragma unroll
            for (int j = 0; j < 8; ++j) gm[j] = gp[64 * j];
        } else { const GAS f32x4* shp = (const GAS f32x4*)(mr + sh_idx * DM) + lane; const GAS f32x4* scp = (const GAS f32x4*)(mr + sc_idx * DM) + lane;
#pragma unroll
            for (int j = 0; j < 8; ++j) { gm[j] = gp[64 * j] * (scp[64 * j] + 1.0f); sh[j] = shp[64 * j]; } } }
#pragma unroll
    for (int q = 0; q < 4; ++q) { float s = 0.f;
#pragma unroll
        for (int j = 0; j < 8; ++j) s += (v[q][j].x * v[q][j].x + v[q][j].y * v[q][j].y) + (v[q][j].z * v[q][j].z + v[q][j].w * v[q][j].w);
        const float rinv = rsqrtf(wave_sum(s) * (1.0f / DM) + EPS);
        if (MODE == 2) { GAS f32x4* o = (GAS f32x4*)(y0 + (size_t)q * DM) + lane;
#pragma unroll
            for (int j = 0; j < 8; ++j) o[64 * j] = v[q][j] * rinv * gm[j];
        } else { GAS v2u* o = (GAS v2u*)(h0 + (size_t)q * DM) + lane;
#pragma unroll
            for (int j = 0; j < 8; ++j) { v[q][j] = v[q][j] * rinv * gm[j] + sh[j]; v2u w; w.x = pk2(v[q][j].x, v[q][j].y); w.y = pk2(v[q][j].z, v[q][j].w); o[64 * j] = w; }
        }
    }
    if (MODE == 1) {
#pragma unroll
        for (int pr = 0; pr < 2; ++pr) { float a16[2][16];
#pragma unroll
            for (int hh = 0; hh < 16; ++hh) { float a0 = 0.f, a1 = 0.f;
#pragma unroll
                for (int j = 0; j < 8; ++j) { const f32x4 w = *(const LAS f32x4*)(wT + hh * DM + 4 * lane + 256 * j);
                    a0 += (v[2 * pr][j].x * w.x + v[2 * pr][j].y * w.y) + (v[2 * pr][j].z * w.z + v[2 * pr][j].w * w.w);
                    a1 += (v[2 * pr + 1][j].x * w.x + v[2 * pr + 1][j].y * w.y) + (v[2 * pr + 1][j].z * w.z + v[2 * pr + 1][j].w * w.w); }
                a16[0][hh] = a0; a16[1][hh] = a1; }
            { const float m0 = wave_sum16(a16[0], lane), m1 = wave_sum16(a16[1], lane); if (lane < 16) { dt0[(2 * pr) * 16 + lane] = m0; dt0[(2 * pr + 1) * 16 + lane] = m1; } } }
    }
}
#define XB_TMO      128
#define XB_XCNT(j)  (256  + 64 * (j))
#define XB_XSUB(j)  (1280 + 64 * (j))
#define XB_XGEN(j)  (2304 + 64 * (j))
#define XB_TOP      3328
#define XB_TOPGEN   3392
#define XCD_BAR_WORDS 3456
#define XB_SPIN_CAP (1u << 18)

__device__ __forceinline__ unsigned xb_ld(unsigned* p)              { return __hip_atomic_load(p, __ATOMIC_RELAXED, __HIP_MEMORY_SCOPE_AGENT); }
__device__ __forceinline__ unsigned xb_add(unsigned* p, unsigned v) { return __hip_atomic_fetch_add(p, v, __ATOMIC_RELAXED, __HIP_MEMORY_SCOPE_AGENT); }
__device__ __forceinline__ unsigned xb_xcc_id() { return (unsigned)__builtin_amdgcn_s_getreg((3 << 11) | 20) & 0xFu; }
#define XB_SPIN(cond, bar) do { unsigned _sp = 0; while (cond) { __builtin_amdgcn_s_sleep(1); \
    if ((++_sp & 255u) == 0u) { if (xb_ld(&(bar)[XB_TMO])) break; if (_sp > XB_SPIN_CAP) { atomicAdd(&(bar)[XB_TMO], 1u); break; } } } } while (0)

struct XcdBarrier {
    unsigned* bar; unsigned x;
    volatile LAS unsigned* st;
};

__device__ __forceinline__ XcdBarrier xcd_barrier_post(unsigned* bar, volatile LAS unsigned* st) {
    XcdBarrier b; b.bar = bar; b.x = xb_xcc_id(); b.st = st;
    if (threadIdx.x == 0) (void)xb_add(&bar[XB_XCNT(b.x)], 1u);
    return b;
}
__device__ __forceinline__ void xcd_barrier_complete(unsigned* bar, unsigned x, unsigned& nloc, unsigned& nx) {
    const unsigned G = gridDim.x * gridDim.y * gridDim.z;
    unsigned sum, cnt, mine, sp = 0u;
    for (;;) {
        sum = 0u; cnt = 0u; mine = 0u;
#pragma unroll
        for (unsigned j = 0; j < 16; ++j) { const unsigned c = xb_ld(&bar[XB_XCNT(j)]); sum += c; cnt += (c > 0u) ? 1u : 0u; mine = (j == x) ? c : mine; }
        if (sum == G) break;
        __builtin_amdgcn_s_sleep(1);
        if ((++sp & 255u) == 0u) { if (xb_ld(&bar[XB_TMO])) break; if (sp > XB_SPIN_CAP) { atomicAdd(&bar[XB_TMO], 1u); break; } }
    }
    nloc = mine > 0u ? mine : 1u; nx = cnt > 0u ? cnt : 1u;
}

__device__ __forceinline__ void xcd_barrier(const XcdBarrier& b) {
    asm volatile("s_waitcnt vmcnt(0)" ::: "memory");
    __syncthreads();
    if (threadIdx.x == 0) {
        unsigned* bar = b.bar;
        __builtin_amdgcn_s_waitcnt(0);
        unsigned nloc = b.st[0], nx = b.st[1];
        if (nloc == 0u) { xcd_barrier_complete(bar, b.x, nloc, nx); b.st[0] = nloc; b.st[1] = nx; }
        const unsigned old = xb_add(&bar[XB_XSUB(b.x)], 1u);
        const unsigned gen = old / nloc;
        if (old + 1u == (gen + 1u) * nloc) {
            __builtin_amdgcn_fence(__ATOMIC_RELEASE, "agent");
            asm volatile("s_waitcnt vmcnt(0)" ::: "memory");
            const unsigned og = xb_add(&bar[XB_TOP], 1u);
            const unsigned tg = og / nx;
            if (og + 1u == (tg + 1u) * nx) xb_add(&bar[XB_TOPGEN], 1u);
            else XB_SPIN(xb_ld(&bar[XB_TOPGEN]) == tg, bar);
            __builtin_amdgcn_fence(__ATOMIC_ACQUIRE, "agent");
            xb_add(&bar[XB_XGEN(b.x)], 1u);
            asm volatile("s_waitcnt vmcnt(0)" ::: "memory");
        } else {
            XB_SPIN(xb_ld(&bar[XB_XGEN(b.x)]) == gen, bar);
            __builtin_amdgcn_fence(__ATOMIC_ACQUIRE, "agent");
            asm volatile("s_waitcnt vmcnt(0)" ::: "memory");
        }
    }
    __syncthreads();
}

namespace epi {
using pg8::Unit; using pg8::f32x4; using pg8::u32x4; using pg8::cvt_pk_bf16;
typedef unsigned u32x2 __attribute__((ext_vector_type(2)));
constexpr int BM = 256, HALF = 128;

constexpr int SLAB_F4 = 8 * 16 * 64;
constexpr int SLAB_BYTES_ALL = 176 * 131072;
typedef unsigned v4u_ __attribute__((ext_vector_type(4)));
template <bool PERM> __device__ __forceinline__ int split_col(const Unit& u, int wc, int fq, int bj, int n) { return u.pn * BM + bj * HALF + wc * 32 + (PERM ? 8 * fq + 4 * n : 16 * n + 4 * fq); }
__device__ __forceinline__ __amdgpu_buffer_rsrc_t slab_rsrc(const f32x4* SLAB) { return __builtin_amdgcn_make_buffer_rsrc((void*)SLAB, (short)0, SLAB_BYTES_ALL, 0x00020000); }
__device__ __forceinline__ void split_store(const f32x4 (&acc)[2][2][4][2], f32x4* SLAB, int sid, int wid, int lane) {
    asm volatile("" : "+v"(lane));
    const __amdgpu_buffer_rsrc_t rs = slab_rsrc(SLAB);
    const unsigned vo = (unsigned)(wid * 16 * 64 + lane) * 16u, so = (unsigned)sid * (unsigned)(SLAB_F4 * 16);
#pragma unroll
    for (int m = 0; m < 4; ++m)
#pragma unroll
        for (int bj = 0; bj < 2; ++bj)
#pragma unroll
            for (int n = 0; n < 2; ++n) __builtin_amdgcn_raw_buffer_store_b128(__builtin_bit_cast(v4u_, acc[0][bj][m][n]), rs, vo + (unsigned)(((m * 2 + bj) * 2 + n) * 64 * 16), so,   16);
}
__device__ __forceinline__ bool split_arrive(unsigned* cnt, unsigned target, int lane) {
    asm volatile("s_waitcnt vmcnt(0)" ::: "memory");
    unsigned old = 0u;
    if (lane == 0) old = __hip_atomic_fetch_add(cnt, 1u, __ATOMIC_RELAXED, __HIP_MEMORY_SCOPE_AGENT);
    old = __builtin_amdgcn_readlane(old, 0);
    asm volatile("" ::: "memory");
    if (old != target - 1u) return false;
    __builtin_amdgcn_fence(__ATOMIC_ACQUIRE, "agent"); asm volatile("s_waitcnt vmcnt(0)" ::: "memory");
    return true;
}
__device__ __forceinline__ f32x4 slab_ld(const __amdgpu_buffer_rsrc_t rs, unsigned vo, unsigned so) { return __builtin_bit_cast(f32x4, __builtin_amdgcn_raw_buffer_load_b128(rs, vo, so,   16)); }
__device__ __forceinline__ f32x4 split_sum1(const f32x4* SLAB, int sid0, int ns, int wid, int lane, int reg) {
    const __amdgpu_buffer_rsrc_t rs = slab_rsrc(SLAB);
    const unsigned vo = (unsigned)((wid * 16 + reg) * 64 + lane) * 16u;
    f32x4 s = slab_ld(rs, vo, (unsigned)sid0 * (unsigned)(SLAB_F4 * 16));
    for (int j = 1; j < ns; ++j) s = s + slab_ld(rs, vo, (unsigned)(sid0 + j) * (unsigned)(SLAB_F4 * 16));
    return s;
}
__device__ __forceinline__ void split_sum(f32x4 (&acc)[2][2][4][2], const f32x4* SLAB, int sid0, int ns, int wid, int lane) {
    asm volatile("" : "+v"(lane));
    const __amdgpu_buffer_rsrc_t rs = slab_rsrc(SLAB);
    const unsigned vo = (unsigned)(wid * 16 * 64 + lane) * 16u;
#pragma unroll
    for (int m = 0; m < 4; ++m)
#pragma unroll
        for (int bj = 0; bj < 2; ++bj) {
            const unsigned vr = vo + (unsigned)((m * 2 + bj) * 2) * 1024u;
            unsigned so = (unsigned)sid0 * (unsigned)(SLAB_F4 * 16);
            f32x4 s0 = {0.f, 0.f, 0.f, 0.f}, s1 = s0;
            int j = 0;
#pragma unroll 1
            for (; j + 4 <= ns; j += 4) {
                f32x4 t[4][2];
#pragma unroll
                for (int q = 0; q < 4; ++q) { const unsigned sq = so + (unsigned)q * (unsigned)(SLAB_F4 * 16); t[q][0] = slab_ld(rs, vr, sq); t[q][1] = slab_ld(rs, vr + 1024u, sq); }
#pragma unroll
                for (int q = 0; q < 4; ++q) { s0 = s0 + t[q][0]; s1 = s1 + t[q][1]; }
                so += 4u * (unsigned)(SLAB_F4 * 16); }
#pragma unroll 1
            for (; j < ns; ++j) { s0 = s0 + slab_ld(rs, vr, so); s1 = s1 + slab_ld(rs, vr + 1024u, so); so += (unsigned)(SLAB_F4 * 16); }
            acc[0][bj][m][0] = s0; acc[0][bj][m][1] = s1;
            asm volatile("" ::: "memory");
        }
}
__device__ __forceinline__ void split_zero_pad(f32x4 (&acc)[2][2][4][2]) {
#pragma unroll
    for (int bj = 0; bj < 2; ++bj)
#pragma unroll
        for (int m = 0; m < 4; ++m)
#pragma unroll
            for (int n = 0; n < 2; ++n) acc[1][bj][m][n] = (f32x4){0.f, 0.f, 0.f, 0.f};
}
struct SplitCtl { f32x4* SLAB; unsigned* cnt; unsigned nsl; };

struct EpiIn {
    static constexpr bool PERM = true, AFTER_DRAIN = false;
    bf16* O; float* vsq; SplitCtl sp;
    template <int ACT> __device__ __forceinline__ void run(const f32x4 (&acc)[2][2][4][2], const Unit& u, int wr, int wc, int fr, int fq, bool dosq) const {
        const int row0 = u.pm * BM + wr * 64 + fr, col0 = u.pn * BM + wc * 32 + 8 * fq;
#pragma unroll
        for (int ai = 0; ai < 2; ++ai)
#pragma unroll
            for (int m = 0; m < 4; ++m) { const int row = row0 + ai * HALF + m * 16; bf16* rowp = O + (size_t)row * N_INP + col0; float sq = 0.f;
#pragma unroll
                for (int bj = 0; bj < 2; ++bj) { f32x4 v0 = acc[ai][bj][m][0], v1 = acc[ai][bj][m][1];
#pragma unroll
                    for (int j = 0; j < 4; ++j) {
                        if (ACT == 1) { v0[j] = gelu_tanh(v0[j]); v1[j] = gelu_tanh(v1[j]); }
                        if (ACT == 2) { v0[j] = sigmoidf_(v0[j]); v1[j] = sigmoidf_(v1[j]); }
                        sq += v0[j] * v0[j] + v1[j] * v1[j]; }
                    u32x4 w; w.x = cvt_pk_bf16(v0[0], v0[1]); w.y = cvt_pk_bf16(v0[2], v0[3]); w.z = cvt_pk_bf16(v1[0], v1[1]); w.w = cvt_pk_bf16(v1[2], v1[3]);
                    *(GAS u32x4*)(rowp + bj * HALF) = w; }
                if (ACT == 1) { if (dosq && vsq) { sq += xor_lt32<16>(sq); sq = add_xor32(sq); if (fq == 0) atomicAdd(vsq + row, sq); } }
            }
    }
    __device__ __forceinline__ void operator()(const f32x4 (&acc)[2][2][4][2], const Unit& u, int wr, int wc, int fr, int fq) const {
        const int pn = u.pn;
        if (pn >= 16) run<2>(acc, u, wr, wc, fr, fq, false);
        else if (pn >= 2 && pn < 6) run<1>(acc, u, wr, wc, fr, fq, pn >= 4);
        else run<0>(acc, u, wr, wc, fr, fq, false);
    }
    __device__ __forceinline__ void partial(f32x4 (&acc)[2][2][4][2], const Unit& u, int wr, int wc, int fr, int fq, int wid, int lane) const {
        split_store(acc, sp.SLAB, u.sid, wid, lane);
        if (split_arrive(sp.cnt + u.cidx * 8 + wid, sp.nsl, lane)) { split_zero_pad(acc); split_sum(acc, sp.SLAB, u.pn * (int)sp.nsl, (int)sp.nsl, wid, lane); (*this)(acc, u, wr, wc, fr, fq); }
    }
};
struct EpiBf16Plain {
    static constexpr bool PERM = true, AFTER_DRAIN = false;
    bf16* O; int ldc;
    __device__ __forceinline__ void partial(f32x4 (&)[2][2][4][2], const Unit&, int, int, int, int, int, int) const {}
    __device__ __forceinline__ void operator()(const f32x4 (&acc)[2][2][4][2], const Unit& u, int wr, int wc, int fr, int fq) const {
        const int row0 = u.pm * BM + wr * 64 + fr, col0 = u.pn * BM + wc * 32 + 8 * fq;
#pragma unroll
        for (int ai = 0; ai < 2; ++ai)
#pragma unroll
            for (int m = 0; m < 4; ++m) { bf16* rowp = O + (size_t)(row0 + ai * HALF + m * 16) * ldc + col0;
#pragma unroll
                for (int bj = 0; bj < 2; ++bj) { const f32x4 v0 = acc[ai][bj][m][0], v1 = acc[ai][bj][m][1];
                    u32x4 w; w.x = cvt_pk_bf16(v0[0], v0[1]); w.y = cvt_pk_bf16(v0[2], v0[3]); w.z = cvt_pk_bf16(v1[0], v1[1]); w.w = cvt_pk_bf16(v1[2], v1[3]);
                    *(GAS u32x4*)(rowp + bj * HALF) = w; } }
    }
};
__device__ __forceinline__ float dpp_ror1(float x) { return __builtin_bit_cast(float, __builtin_amdgcn_update_dpp(0, __builtin_bit_cast(int, x), 0x121, 0xf, 0xf, false)); }
__device__ __forceinline__ float dpp_ror2(float x) { return __builtin_bit_cast(float, __builtin_amdgcn_update_dpp(0, __builtin_bit_cast(int, x), 0x122, 0xf, 0xf, false)); }
__device__ __forceinline__ float dpp_shr1(float old, float x) { return __builtin_bit_cast(float, __builtin_amdgcn_update_dpp(__builtin_bit_cast(int, old), __builtin_bit_cast(int, x), 0x111, 0xf, 0xf, false)); }
__device__ __forceinline__ float dpp_shr2(float old, float x) { return __builtin_bit_cast(float, __builtin_amdgcn_update_dpp(__builtin_bit_cast(int, old), __builtin_bit_cast(int, x), 0x112, 0xf, 0xf, false)); }
struct EpiUpConv {
    static constexpr bool PERM = true, AFTER_DRAIN = false;
    bf16* ACT; float* HALO; const float* cw; const float* cb; const float* st; float* cfs; LAS float* EX; int dry;
    __device__ __forceinline__ void partial(f32x4 (&)[2][2][4][2], const Unit&, int, int, int, int, int, int) const {}
    __device__ __forceinline__ void operator()(const f32x4 (&acc)[2][2][4][2], const Unit& u, int wr, int wc, int fr, int fq) const {
        asm volatile("" : "+v"(fr), "+v"(fq));
        if (dry) {
#pragma unroll
            for (int ai = 0; ai < 2; ++ai)
#pragma unroll
                for (int bj = 0; bj < 2; ++bj)
#pragma unroll
                    for (int m = 0; m < 4; ++m)
#pragma unroll
                        for (int n = 0; n < 2; ++n) asm volatile("" :: "v"(acc[ai][bj][m][n]));
            return; }
        const int cl = wc * 32 + 8 * fq;
        if (u.pm == MPROMPT / 256) {
#pragma unroll
            for (int n = 0; n < 2; ++n) { const int c = u.pn * 128 + cl + 4 * n;
                f32x4 wa0, wa1, wa2, wb0, wb1, wb2, ba, bb;
                wa0 = *(const GAS f32x4*)(cw + c); wa1 = *(const GAS f32x4*)(cw + D_UP + c); wa2 = *(const GAS f32x4*)(cw + 2 * D_UP + c); wb0 = *(const GAS f32x4*)(cw + D_FF + c); wb1 = *(const GAS f32x4*)(cw + D_UP + D_FF + c); wb2 = *(const GAS f32x4*)(cw + 2 * D_UP + D_FF + c);
                ba = *(const GAS f32x4*)(cb + c); bb = *(const GAS f32x4*)(cb + D_FF + c);
#pragma unroll
                for (int m = 0; m < 4; ++m) { const int s = wr * 64 + m * 16 + fr; const float* sp = st + (size_t)s * 2 * D_UP; float* op = cfs + (size_t)s * 2 * D_UP;
                    const f32x4 a2 = *(const GAS f32x4*)(sp + c), a1 = *(const GAS f32x4*)(sp + D_UP + c), b2 = *(const GAS f32x4*)(sp + D_FF + c), b1 = *(const GAS f32x4*)(sp + D_UP + D_FF + c);
                    const f32x4 ua = acc[0][0][m][n], ub = acc[0][1][m][n];
                    *(GAS f32x4*)(op + c) = a1; *(GAS f32x4*)(op + D_FF + c) = b1; *(GAS f32x4*)(op + D_UP + c) = ua; *(GAS f32x4*)(op + D_UP + D_FF + c) = ub;
                    const f32x4 ca = ba + wa0 * a2 + wa1 * a1 + wa2 * ua, cbv = bb + wb0 * b2 + wb1 * b1 + wb2 * ub;
                    u32x2 w; w.x = cvt_pk_bf16(siluf_(ca[0]) * cbv[0], siluf_(ca[1]) * cbv[1]); w.y = cvt_pk_bf16(siluf_(ca[2]) * cbv[2], siluf_(ca[3]) * cbv[3]);
                    *(GAS u32x2*)(ACT + (size_t)(MPROMPT + s) * D_FF + c) = w; }
                asm volatile("" ::: "memory"); }
            return;
        }
        f32x4 wts[2][8];
#pragma unroll
        for (int n = 0; n < 2; ++n) { const int c = u.pn * 128 + cl + 4 * n;
            wts[n][0] = *(const GAS f32x4*)(cw + c); wts[n][1] = *(const GAS f32x4*)(cw + D_UP + c); wts[n][2] = *(const GAS f32x4*)(cw + 2 * D_UP + c);
            wts[n][3] = *(const GAS f32x4*)(cw + D_FF + c); wts[n][4] = *(const GAS f32x4*)(cw + D_UP + D_FF + c); wts[n][5] = *(const GAS f32x4*)(cw + 2 * D_UP + D_FF + c);
            wts[n][6] = *(const GAS f32x4*)(cb + c); wts[n][7] = *(const GAS f32x4*)(cb + D_FF + c); }
        if (fr >= 14) {
#pragma unroll
            for (int ai = 0; ai < 2; ++ai)
#pragma unroll
                for (int bj = 0; bj < 2; ++bj)
#pragma unroll
                    for (int n = 0; n < 2; ++n) *(LAS f32x4*)(EX + ((ai * 2 + wr) * 2 + (fr - 14)) * 256 + bj * 128 + cl + 4 * n) = acc[ai][bj][3][n];
            if (wr == 1) {
#pragma unroll
                for (int bj = 0; bj < 2; ++bj)
#pragma unroll
                    for (int n = 0; n < 2; ++n) *(GAS f32x4*)(HALO + ((size_t)u.pm * 4 + 2 + (fr - 14)) * D_UP + u.pn * 256 + bj * 128 + cl + 4 * n) = acc[1][bj][3][n]; }
        }
        if (fr < 2 && wr == 0) {
#pragma unroll
            for (int bj = 0; bj < 2; ++bj)
#pragma unroll
                for (int n = 0; n < 2; ++n) *(GAS f32x4*)(HALO + ((size_t)u.pm * 4 + fr) * D_UP + u.pn * 256 + bj * 128 + cl + 4 * n) = acc[0][bj][0][n]; }
        asm volatile("s_waitcnt lgkmcnt(0)" ::: "memory"); __builtin_amdgcn_s_barrier(); asm volatile("" ::: "memory");
#pragma unroll
        for (int n = 0; n < 2; ++n) { const int c = u.pn * 128 + cl + 4 * n;
            const f32x4 wa0 = wts[n][0], wa1 = wts[n][1], wa2 = wts[n][2], wb0 = wts[n][3], wb1 = wts[n][4], wb2 = wts[n][5], ba = wts[n][6], bb = wts[n][7];
#pragma unroll
            for (int ai = 0; ai < 2; ++ai)
#pragma unroll
                for (int m = 0; m < 4; ++m) {
                    f32x4 cv[2];
#pragma unroll
                    for (int bj = 0; bj < 2; ++bj) { const f32x4 cur = acc[ai][bj][m][n]; f32x4 pb;
                        if (m > 0) pb = acc[ai][bj][m - 1][n];
                        else { pb = (f32x4){0.f, 0.f, 0.f, 0.f};
                            const int sa = wr == 1 ? ai : 0, sw = wr == 1 ? 0 : 1; const bool have = (wr == 1) || (ai == 1);
                            if (have && fr >= 14) pb = *(const LAS f32x4*)(EX + ((sa * 2 + sw) * 2 + (fr - 14)) * 256 + bj * 128 + cl + 4 * n); }
                        f32x4 x1, x2;
#pragma unroll
                        for (int j = 0; j < 4; ++j) { x1[j] = dpp_shr1(dpp_ror1(pb[j]), cur[j]); x2[j] = dpp_shr2(dpp_ror2(pb[j]), cur[j]); }
                        cv[bj] = bj == 0 ? ba + wa0 * x2 + wa1 * x1 + wa2 * cur : bb + wb0 * x2 + wb1 * x1 + wb2 * cur; }
                    u32x2 w; w.x = cvt_pk_bf16(siluf_(cv[0][0]) * cv[1][0], siluf_(cv[0][1]) * cv[1][1]); w.y = cvt_pk_bf16(siluf_(cv[0][2]) * cv[1][2], siluf_(cv[0][3]) * cv[1][3]);
                    *(GAS u32x2*)(ACT + (size_t)(u.pm * BM + ai * HALF + wr * 64 + m * 16 + fr) * D_FF + c) = w; }
            asm volatile("" ::: "memory"); }
    }
};
struct EpiGlu {
    static constexpr bool PERM = true, AFTER_DRAIN = false;
    const bf16* Y; bf16* O;
    __device__ __forceinline__ void partial(f32x4 (&)[2][2][4][2], const Unit&, int, int, int, int, int, int) const {}
    __device__ __forceinline__ void operator()(const f32x4 (&acc)[2][2][4][2], const Unit& u, int wr, int wc, int fr, int fq) const {
        const int row0 = u.pm * BM + wr * 64 + fr, col0 = u.pn * BM + wc * 32 + 8 * fq;
#pragma unroll
        for (int ai = 0; ai < 2; ++ai)
#pragma unroll
            for (int m = 0; m < 4; ++m) { const size_t off = (size_t)(row0 + ai * HALF + m * 16) * 512 + col0;
#pragma unroll
                for (int bj = 0; bj < 2; ++bj) { const f32x4 v0 = acc[ai][bj][m][0], v1 = acc[ai][bj][m][1];
                    const u32x4 y = *(const GAS u32x4*)(Y + off + bj * HALF);
                    u32x4 w;
                    w.x = cvt_pk_bf16(bflo(y.x) * sigmoidf_(v0[0]), bfhi(y.x) * sigmoidf_(v0[1]));
                    w.y = cvt_pk_bf16(bflo(y.y) * sigmoidf_(v0[2]), bfhi(y.y) * sigmoidf_(v0[3]));
                    w.z = cvt_pk_bf16(bflo(y.z) * sigmoidf_(v1[0]), bfhi(y.z) * sigmoidf_(v1[1]));
                    w.w = cvt_pk_bf16(bflo(y.w) * sigmoidf_(v1[2]), bfhi(y.w) * sigmoidf_(v1[3]));
                    *(GAS u32x4*)(O + off + bj * HALF) = w; } }
    }
};
template <int MODE> struct EpiMerge {
    static constexpr bool PERM = false, AFTER_DRAIN = false;
    const bf16* G;
    float* T; bf16* MG; const float* csq;
    f32x4* SLAB; const bf16* PRJ; unsigned* cnt;
    __device__ __forceinline__ void partial(f32x4 (&acc)[2][2][4][2], const Unit& u, int wr, int wc, int fr, int fq, int wid, int lane) const {
        split_store(acc, SLAB, u.sid, wid, lane);
        if (!split_arrive(cnt + u.cidx * 8 + wid, 8u, lane)) return;
        asm volatile("" : "+v"(fr), "+v"(fq), "+v"(lane));
#pragma unroll
        for (int m = 0; m < 4; ++m) { const int r = wr * 64 + m * 16 + fr, row = MPROMPT + r; const float rs = rsqrtf(csq[row] * (1.0f / 1024.0f) + EPS);
            const __amdgpu_buffer_rsrc_t rs_ = slab_rsrc(SLAB);
#pragma unroll
            for (int bj = 0; bj < 2; ++bj) {
                f32x4 sa[2], sb[2], sc[2];
                {   f32x4 la[2][2], lb[2][2], lc[2][4];
#pragma unroll
                    for (int n = 0; n < 2; ++n) { const unsigned vo = (unsigned)((wid * 16 + (m * 2 + bj) * 2 + n) * 64 + lane) * 16u;
#pragma unroll
                        for (int j = 0; j < 2; ++j) { la[n][j] = slab_ld(rs_, vo, (unsigned)(u.pn * 2 + j) * (unsigned)(SLAB_F4 * 16)); lb[n][j] = slab_ld(rs_, vo, (unsigned)(16 + u.pn * 2 + j) * (unsigned)(SLAB_F4 * 16)); }
#pragma unroll
                        for (int j = 0; j < 4; ++j) lc[n][j] = slab_ld(rs_, vo, (unsigned)(32 + u.pn * 4 + j) * (unsigned)(SLAB_F4 * 16)); }
#pragma unroll
                    for (int n = 0; n < 2; ++n) { sa[n] = la[n][0] + la[n][1]; sb[n] = lb[n][0] + lb[n][1]; sc[n] = (lc[n][0] + lc[n][1]) + (lc[n][2] + lc[n][3]); } }
#pragma unroll
                for (int n = 0; n < 2; ++n) { const int col = split_col<PERM>(u, wc, fq, bj, n); const bf16* gp = PRJ + ((unsigned)row * N_INP + col);
                    const f32x4 a = sa[n], b = sb[n], c = sc[n];
                    const u32x2 ga = *(const GAS u32x2*)(gp + PC_GA), gb = *(const GAS u32x2*)(gp + PC_GB), gc = *(const GAS u32x2*)(gp + PC_GC);
                    f32x4 t; t[0] = bflo(ga.x) * a[0] + bflo(gb.x) * b[0] + bflo(gc.x) * rs * c[0]; t[1] = bfhi(ga.x) * a[1] + bfhi(gb.x) * b[1] + bfhi(gc.x) * rs * c[1];
                    t[2] = bflo(ga.y) * a[2] + bflo(gb.y) * b[2] + bflo(gc.y) * rs * c[2]; t[3] = bfhi(ga.y) * a[3] + bfhi(gb.y) * b[3] + bfhi(gc.y) * rs * c[3];
                    u32x2 w; w.x = cvt_pk_bf16(t[0], t[1]); w.y = cvt_pk_bf16(t[2], t[3]); *(GAS u32x2*)(MG + ((unsigned)row * DM + col)) = w; } }
            asm volatile("" ::: "memory"); }
    }
    __device__ __forceinline__ void operator()(const f32x4 (&acc)[2][2][4][2], const Unit& u, int wr, int wc, int fr, int fq) const {
        const int row0 = u.pm * BM + wr * 64 + fr, col0 = u.pn * BM + wc * 32 + 4 * fq;
        bf16* Tb = (bf16*)T;
#pragma unroll
        for (int ai = 0; ai < 2; ++ai) {
#pragma unroll
          for (int mh = 0; mh < 4; mh += 2) {
            u32x2 gq[4][2][2], tq[4][2][2]; float rsq[4];
#pragma unroll
            for (int m = mh; m < mh + 2; ++m) { const int row = row0 + ai * HALF + m * 16; const size_t off = (size_t)row * DM + col0; const bf16* gp = G + (size_t)row * N_INP + col0;
                rsq[m] = MODE == 2 ? csq[row] : 0.f;
#pragma unroll
                for (int bj = 0; bj < 2; ++bj)
#pragma unroll
                    for (int n = 0; n < 2; ++n) { const int co = bj * HALF + n * 16; gq[m][bj][n] = *(const GAS u32x2*)(gp + co); if (MODE != 0) tq[m][bj][n] = *(const GAS u32x2*)(Tb + off + co); } }
#pragma unroll
            for (int m = mh; m < mh + 2; ++m) { const int row = row0 + ai * HALF + m * 16; const size_t off = (size_t)row * DM + col0;
                const float rs = MODE == 2 ? rsqrtf(rsq[m] * (1.0f / 1024.0f) + EPS) : 1.f;
#pragma unroll
                for (int bj = 0; bj < 2; ++bj)
#pragma unroll
                    for (int n = 0; n < 2; ++n) { const int co = bj * HALF + n * 16; const u32x2 g = gq[m][bj][n]; f32x4 v = acc[ai][bj][m][n];
                        v[0] *= bflo(g.x); v[1] *= bfhi(g.x); v[2] *= bflo(g.y); v[3] *= bfhi(g.y);
                        if (MODE == 0) { u32x2 w; w.x = cvt_pk_bf16(v[0], v[1]); w.y = cvt_pk_bf16(v[2], v[3]); *(GAS u32x2*)(Tb + off + co) = w; }
                        if (MODE == 1) { const u32x2 tb = tq[m][bj][n]; u32x2 w; w.x = cvt_pk_bf16(bflo(tb.x) + v[0], bfhi(tb.x) + v[1]); w.y = cvt_pk_bf16(bflo(tb.y) + v[2], bfhi(tb.y) + v[3]); *(GAS u32x2*)(Tb + off + co) = w; }
                        if (MODE == 2) { const u32x2 tb = tq[m][bj][n]; f32x4 t = {bflo(tb.x), bfhi(tb.x), bflo(tb.y), bfhi(tb.y)}; t = t + v * rs; u32x2 w; w.x = cvt_pk_bf16(t[0], t[1]); w.y = cvt_pk_bf16(t[2], t[3]); *(GAS u32x2*)(MG + off + co) = w; } } } } }
    }
};
template <int SEG> struct EpiChain {
    static constexpr bool PERM = false, AFTER_DRAIN = false;
    const bf16* PRJ; bf16* MG; const float* csq;
    __device__ __forceinline__ void partial(f32x4 (&)[2][2][4][2], const Unit&, int, int, int, int, int, int) const {}
    __device__ __forceinline__ void operator()(f32x4 (&acc)[2][2][4][2], const Unit& u, int wr, int wc, int fr, int fq) const {
        const int row0 = u.pm * BM + wr * 64 + fr, col0 = u.pn * BM + wc * 32 + 4 * fq;
#pragma unroll
        for (int ai = 0; ai < 2; ++ai)
#pragma unroll
            for (int m = 0; m < 4; ++m) { const int row = row0 + ai * HALF + m * 16; const bf16* gp = PRJ + ((unsigned)row * N_INP + col0);
                float rs = 1.f; if (SEG >= 1) rs = rsqrtf(csq[row] * (1.0f / 1024.0f) + EPS);
#pragma unroll
                for (int bj = 0; bj < 2; ++bj)
#pragma unroll
                    for (int n = 0; n < 2; ++n) { const int co = bj * HALF + n * 16; f32x4 v = acc[ai][bj][m][n];
                        if (SEG == 0) { const u32x2 ga = *(const GAS u32x2*)(gp + PC_GA + co), gb = *(const GAS u32x2*)(gp + PC_GB + co);
                            v[0] *= bflo(ga.x) * __builtin_amdgcn_rcpf(fmaxf(bflo(gb.x), 1e-20f)); v[1] *= bfhi(ga.x) * __builtin_amdgcn_rcpf(fmaxf(bfhi(gb.x), 1e-20f));
                            v[2] *= bflo(ga.y) * __builtin_amdgcn_rcpf(fmaxf(bflo(gb.y), 1e-20f)); v[3] *= bfhi(ga.y) * __builtin_amdgcn_rcpf(fmaxf(bfhi(gb.y), 1e-20f)); acc[ai][bj][m][n] = v; }
                        if (SEG == 1) { const u32x2 gb = *(const GAS u32x2*)(gp + PC_GB + co), gc = *(const GAS u32x2*)(gp + PC_GC + co);
                            v[0] *= fmaxf(bflo(gb.x), 1e-20f) * __builtin_amdgcn_rcpf(fmaxf(bflo(gc.x) * rs, 1e-20f)); v[1] *= fmaxf(bfhi(gb.x), 1e-20f) * __builtin_amdgcn_rcpf(fmaxf(bfhi(gc.x) * rs, 1e-20f));
                            v[2] *= fmaxf(bflo(gb.y), 1e-20f) * __builtin_amdgcn_rcpf(fmaxf(bflo(gc.y) * rs, 1e-20f)); v[3] *= fmaxf(bfhi(gb.y), 1e-20f) * __builtin_amdgcn_rcpf(fmaxf(bfhi(gc.y) * rs, 1e-20f)); acc[ai][bj][m][n] = v; }
                        if (SEG == 2) { const u32x2 gc = *(const GAS u32x2*)(gp + PC_GC + co);
                            v[0] *= fmaxf(bflo(gc.x) * rs, 1e-20f); v[1] *= fmaxf(bfhi(gc.x) * rs, 1e-20f); v[2] *= fmaxf(bflo(gc.y) * rs, 1e-20f); v[3] *= fmaxf(bfhi(gc.y) * rs, 1e-20f);
                            u32x2 w; w.x = cvt_pk_bf16(v[0], v[1]); w.y = cvt_pk_bf16(v[2], v[3]); *(GAS u32x2*)(MG + ((unsigned)row * DM + col0 + co)) = w; } }
                asm volatile("" ::: "memory"); }
    }
};
struct EpiResid {
    static constexpr bool PERM = false, AFTER_DRAIN = false;
    const bf16* XI; const bf16* XIS; bf16* XO; const float* gate; SplitCtl sp;
    __device__ __forceinline__ void partial(f32x4 (&acc)[2][2][4][2], const Unit& u, int wr, int wc, int fr, int fq, int wid, int lane) const {
        split_store(acc, sp.SLAB, u.sid, wid, lane);
        if (split_arrive(sp.cnt + u.cidx * 8 + wid, sp.nsl, lane)) { split_zero_pad(acc); split_sum(acc, sp.SLAB, u.pn * (int)sp.nsl, (int)sp.nsl, wid, lane); (*this)(acc, u, wr, wc, fr, fq); }
    }
    __device__ __forceinline__ void operator()(const f32x4 (&acc)[2][2][4][2], const Unit& u, int wr, int wc, int fr, int fq) const {
        const int row0 = u.pm * BM + wr * 64 + fr, col0 = u.pn * BM + wc * 32 + 4 * fq;
        const __amdgpu_buffer_rsrc_t xr = __builtin_amdgcn_make_buffer_rsrc((void*)XO, (short)0, (int)((size_t)MP * DM * 2), 0x00020000);
        const bool samp = u.pm == MPROMPT / 256;
        const bf16* xs16 = samp ? XIS - (size_t)MPROMPT * DM : XI;
#pragma unroll
        for (int ai = 0; ai < 2; ++ai) { if (ai == 1 && samp) break;
            u32x2 xw[4][2][2]; f32x4 gg[4][2][2];
#pragma unroll
            for (int m = 0; m < 4; ++m) { const int row = row0 + ai * HALF + m * 16; const size_t off = (size_t)row * DM + col0; const float* gp = gate + (size_t)mod_row(row) * MOD_PITCH + col0;
#pragma unroll
                for (int bj = 0; bj < 2; ++bj)
#pragma unroll
                    for (int n = 0; n < 2; ++n) { const int co = bj * HALF + n * 16; xw[m][bj][n] = *(const GAS u32x2*)(xs16 + off + co); gg[m][bj][n] = *(const GAS f32x4*)(gp + co); } }
#pragma unroll
            for (int m = 0; m < 4; ++m) { const int row = row0 + ai * HALF + m * 16; const size_t off = (size_t)row * DM + col0;
#pragma unroll
                for (int bj = 0; bj < 2; ++bj)
#pragma unroll
                    for (int n = 0; n < 2; ++n) { const int co = bj * HALF + n * 16; const u32x2 w = xw[m][bj][n]; const f32x4 xi = {bflo(w.x), bfhi(w.x), bflo(w.y), bfhi(w.y)};
                        const f32x4 xo = xi + gg[m][bj][n] * acc[ai][bj][m][n]; u32x2 wo; wo.x = cvt_pk_bf16(xo[0], xo[1]); wo.y = cvt_pk_bf16(xo[2], xo[3]);
                        __builtin_amdgcn_raw_buffer_store_b64(wo, xr, (unsigned)(off + co) * 2u, 0,   16); } } }
    }
};
template <int MODE> struct EpiResidPrep {
    static constexpr bool PERM = false, AFTER_DRAIN = true;
    EpiResid R; bf16* H; float* yp; float* ys; const float* g; const float* mod2; int sh_idx, sc_idx; const float* wdt; float* DT; unsigned* pc;
    __device__ __forceinline__ void partial(f32x4 (&acc)[2][2][4][2], const Unit& u, int wr, int wc, int fr, int fq, int wid, int lane) const {
        split_store(acc, R.sp.SLAB, u.sid, wid, lane);
        if (split_arrive(R.sp.cnt + u.cidx * 8 + wid, R.sp.nsl, lane)) { split_zero_pad(acc); split_sum(acc, R.sp.SLAB, u.pn * (int)R.sp.nsl, (int)R.sp.nsl, wid, lane); R(acc, u, wr, wc, fr, fq);
            asm volatile("s_waitcnt vmcnt(0)" ::: "memory");
            if (lane == 0) __hip_atomic_fetch_add(pc + 32, 1u, __ATOMIC_RELAXED, __HIP_MEMORY_SCOPE_AGENT); }
    }
    __device__ __forceinline__ void operator()(const f32x4 (&acc)[2][2][4][2], const Unit& u, int wr, int wc, int fr, int fq) const { R(acc, u, wr, wc, fr, fq); }
    __device__ __forceinline__ void fused(f32x4 (&acc)[2][2][4][2], const Unit& u, int wr, int wc, int fr, int fq, LAS unsigned char* lds, int wid, int lane) const {
        R(acc, u, wr, wc, fr, fq);
        asm volatile("s_waitcnt vmcnt(0)" ::: "memory"); __syncthreads();
        if (wid == 0 && lane == 0) {
            __hip_atomic_fetch_add(pc + u.pm, 1u, __ATOMIC_RELAXED, __HIP_MEMORY_SCOPE_AGENT);
            unsigned sp_ = 0; while (__hip_atomic_load(pc + u.pm, __ATOMIC_RELAXED, __HIP_MEMORY_SCOPE_AGENT) < 8u && ++sp_ < (1u << 22)) __builtin_amdgcn_s_sleep(2);
            if (u.pn == 0) { sp_ = 0; while (__hip_atomic_load(pc + 32, __ATOMIC_RELAXED, __HIP_MEMORY_SCOPE_AGENT) < 64u && ++sp_ < (1u << 22)) __builtin_amdgcn_s_sleep(2); }
            __builtin_amdgcn_fence(__ATOMIC_ACQUIRE, "agent"); asm volatile("s_waitcnt vmcnt(0)" ::: "memory");
        }
        __syncthreads();
        LAS float* wT = (LAS float*)lds;
        if (MODE == 1) { f32x4 tw[16];
#pragma unroll
            for (int i = 0; i < 16; ++i) tw[i] = ((const f32x4*)wdt)[wid * 64 + lane + i * NTHR];
#pragma unroll
            for (int i = 0; i < 16; ++i) ((LAS f32x4*)wT)[wid * 64 + lane + i * NTHR] = tw[i];
            __syncthreads(); }
        const bf16* X = R.XO;
        {   const int row = u.pm * BM + u.pn * 32 + wid * 4;
            prep_rows4<MODE>(X + (size_t)row * DM, g, mod2 + (size_t)mod_row(row) * MOD_PITCH, sh_idx, sc_idx, H + (size_t)row * DM, yp + (size_t)row * DM, DT + (size_t)row * 16, wT, lane); }
        if (u.pn == 0 && wid < 4) { const int s = u.pm * 4 + wid, row = MPROMPT + s;
            prep_row<MODE>(X + (size_t)row * DM, g, mod2 + (size_t)mod_row(row) * MOD_PITCH, sh_idx, sc_idx, H + (size_t)row * DM, ys + (size_t)s * DM, DT + (size_t)row * 16, wT, lane); }
        if (MODE == 1) __syncthreads();
    }
};
struct EpiMod {
    static constexpr bool PERM = false, AFTER_DRAIN = false;
    float* MOD; const float* bmod;
    __device__ __forceinline__ void partial(f32x4 (&)[2][2][4][2], const Unit&, int, int, int, int, int, int) const {}
    __device__ __forceinline__ void operator()(const f32x4 (&acc)[2][2][4][2], const Unit& u, int wr, int wc, int fr, int fq) const {
        const int row0 = wr * 64 + fr, col0 = u.pn * BM + wc * 32 + 4 * fq;
        f32x4 bv[2][2];
#pragma unroll
        for (int bj = 0; bj < 2; ++bj)
#pragma unroll
            for (int n = 0; n < 2; ++n) bv[bj][n] = *(const GAS f32x4*)(bmod + col0 + bj * HALF + n * 16);
#pragma unroll
        for (int ai = 0; ai < 2; ++ai)
#pragma unroll
            for (int m = 0; m < 4; ++m) { float* rowp = MOD + (size_t)(row0 + ai * HALF + m * 16) * MOD_PITCH + col0;
#pragma unroll
                for (int bj = 0; bj < 2; ++bj)
#pragma unroll
                    for (int n = 0; n < 2; ++n) *(GAS f32x4*)(rowp + bj * HALF + n * 16) = acc[ai][bj][m][n] + bv[bj][n]; }
    }
};
}
struct Frame {
    LAS unsigned char* lds;
    int tid, lane, wave, gw;
    float* out; unsigned char* ws;
};
#define WSP(T, off) ((T*)(F.ws + (off)))
__device__ __forceinline__ Frame launder(const Frame& F0) {
    Frame F = F0; int t = F0.tid; asm volatile("" : "+v"(t)); F.tid = t; F.lane = t & 63; F.wave = __builtin_amdgcn_readfirstlane(t >> 6);
    unsigned long long w = (unsigned long long)F0.ws, o = (unsigned long long)F0.out; asm volatile("" : "+s"(w), "+s"(o)); F.ws = (unsigned char*)w; F.out = (float*)o;
    F.gw = blockIdx.x * NWAVES + F.wave; return F;
}

__device__ __forceinline__ void transpose_item(const float* W, int ld, int K, int ncols, int c0, bf16* WT, int row_off, LAS float* scr, int item, int lane) {
    const int nblk = ncols / 32, kb = item / nblk, nb = item % nblk, k0 = 64 * kb, n0 = 32 * nb;
    const int rbase = row_off >= 0 ? row_off + n0 : (n0 < D_FF ? 256 * (n0 / 128) + n0 % 128 : 256 * ((n0 - D_FF) / 128) + 128 + (n0 - D_FF) % 128);
    float tv[32];
#pragma unroll
    for (int i = 0; i < 32; ++i) { const int kk = 2 * i + (lane >> 5); tv[i] = __builtin_nontemporal_load(W + (size_t)(k0 + kk) * ld + c0 + n0 + (lane & 31)); }
#pragma unroll
    for (int i = 0; i < 32; ++i) { const int kk = 2 * i + (lane >> 5); scr[kk * 33 + (lane & 31)] = tv[i]; }
    if (false) for (int i = 0; i < 32; ++i) { const int kk = 2 * i + (lane >> 5); scr[kk * 33 + (lane & 31)] = __builtin_nontemporal_load(W + (size_t)(k0 + kk) * ld + c0 + n0 + (lane & 31)); }
    LDS_WAIT(); asm volatile("" ::: "memory");
    const int c = lane & 7;
#pragma unroll
    for (int j = 0; j < 4; ++j) { const int n = (lane >> 3) + 8 * j; const LAS float* s = scr + (8 * c) * 33 + n;
        v4u o; o.x = pk2(s[0 * 33], s[1 * 33]); o.y = pk2(s[2 * 33], s[3 * 33]); o.z = pk2(s[4 * 33], s[5 * 33]); o.w = pk2(s[6 * 33], s[7 * 33]);
        *(GAS v4u*)(WT + (size_t)(rbase + n) * K + k0 + 8 * c) = o; }
    LDS_WAIT(); asm volatile("" ::: "memory");
}
constexpr int MODC = 96, MODK = 128, MODP = 136;
__device__ __forceinline__ void phase_mod(const Frame& F0, KArgs A) {
    Frame F = launder(F0);
    const int n0 = blockIdx.x * MODC, l = n0 / N_MOD, cl = n0 - l * N_MOD;
    const float* W = A->in[I_WMOD] + (size_t)l * DM * N_MOD + cl;
    LAS bf16* Bt = (LAS bf16*)F.lds;
    LAS bf16* As = (LAS bf16*)(F.lds + 2 * MODC * MODP * 2);
    for (int i = F.tid; i < 2 * 12 * MODP; i += NTHR) { const int b = i / (12 * MODP), r = i % (12 * MODP); As[(b * 144 + 132) * MODP + r] = (bf16)0; }
    f32x4 wa[6], wb[6], creg[9];
    auto load_w = [&](f32x4 (&wr)[6], int kc) {
#pragma unroll
        for (int j = 0; j < 6; ++j) { const int idx = F.tid + NTHR * j, n = idx % MODC, k = 4 * (idx / MODC); const float* p = W + (size_t)(kc * MODK + k) * N_MOD + n;
            wr[j].x = __builtin_nontemporal_load(p); wr[j].y = __builtin_nontemporal_load(p + N_MOD); wr[j].z = __builtin_nontemporal_load(p + 2 * N_MOD); wr[j].w = __builtin_nontemporal_load(p + 3 * (size_t)N_MOD); }
    };
    auto load_c = [&](int kc) {
#pragma unroll
        for (int j = 0; j < 9; ++j) { const int idx = F.tid + NTHR * j, r = idx >> 5, k4 = (idx & 31) * 4;
            const float* src = r < NB ? A->in[I_CP] + (size_t)r * DM : A->in[I_CS] + (size_t)(r - NB) * DM;
            creg[j] = r < NB + NS ? *(const GAS f32x4*)(src + kc * MODK + k4) : (f32x4){0.f, 0.f, 0.f, 0.f}; }
    };
    auto store_w = [&](const f32x4 (&wr)[6], int buf) {
#pragma unroll
        for (int j = 0; j < 6; ++j) { const int idx = F.tid + NTHR * j, n = idx % MODC, k = 4 * (idx / MODC);
            v2u w; w.x = pk2(wr[j].x, wr[j].y); w.y = pk2(wr[j].z, wr[j].w); *(LAS v2u*)(Bt + (buf * MODC + n) * MODP + k) = w; }
    };
    auto store_c = [&](int buf) {
#pragma unroll
        for (int j = 0; j < 9; ++j) { const int idx = F.tid + NTHR * j, r = idx >> 5, k4 = (idx & 31) * 4;
            if (r < NB + NS) { v2u w; w.x = pk2(siluf_(creg[j].x), siluf_(creg[j].y)); w.y = pk2(siluf_(creg[j].z), siluf_(creg[j].w)); *(LAS v2u*)(As + (buf * 144 + r) * MODP + k4) = w; } }
    };
    f32x4 acc[9];
#pragma unroll
    for (int m = 0; m < 9; ++m) acc[m] = (f32x4){0.f, 0.f, 0.f, 0.f};
    auto compute = [&](int buf) {
        if (F.wave < 6) {
#pragma unroll
            for (int ks = 0; ks < MODK / 32; ++ks) { const bf16x8 bfr = *(const LAS bf16x8*)(Bt + (buf * MODC + 16 * F.wave + (F.lane & 15)) * MODP + 32 * ks + 8 * (F.lane >> 4));
#pragma unroll
                for (int m = 0; m < 9; ++m) { const bf16x8 af = *(const LAS bf16x8*)(As + (buf * 144 + 16 * m + (F.lane & 15)) * MODP + 32 * ks + 8 * (F.lane >> 4));
                    acc[m] = __builtin_amdgcn_mfma_f32_16x16x32_bf16(af, bfr, acc[m], 0, 0, 0); } }
        }
    };
    const int kst = blockIdx.x & 15;
    load_w(wa, kst); load_c(kst); load_w(wb, (1 + kst) & 15);
    store_w(wa, 0); store_c(0); __syncthreads();
#pragma unroll 1
    for (int kc = 0; kc < DM / MODK; kc += 2) {
        load_c((kc + 1 + kst) & 15); if (kc + 2 < DM / MODK) load_w(wa, (kc + 2 + kst) & 15);
        compute(0);
        store_w(wb, 1); store_c(1); __syncthreads();
        if (kc + 2 < DM / MODK) { load_c((kc + 2 + kst) & 15); if (kc + 3 < DM / MODK) load_w(wb, (kc + 3 + kst) & 15); }
        compute(1);
        if (kc + 2 < DM / MODK) { store_w(wa, 0); store_c(0); }
        __syncthreads();
    }
    if (F.wave < 6) { float* MOD = WSP(float, WS_MOD); const int col = n0 + 16 * F.wave + (F.lane & 15); const float bias = A->in[I_BMOD][col];
#pragma unroll
        for (int m = 0; m < 9; ++m)
#pragma unroll
            for (int r = 0; r < 4; ++r) { const int row = 16 * m + 4 * (F.lane >> 4) + r; if (row < NB + NS) MOD[(size_t)row * MOD_PITCH + col] = acc[m][r] + bias; } }
    __syncthreads();
}
__device__ __forceinline__ void tjob(Frame& F, LAS float* scr, const float* W, int ld, int K, int ncols, int c0, bf16* WT, int row_off) {
    const int nit = (K / 64) * (ncols / 32);
    for (int it = F.gw; it < nit; it += (GRID * NWAVES)) transpose_item(W, ld, K, ncols, c0, WT, row_off, scr, it, F.lane);
}
__device__ __forceinline__ void phase_prologue(const Frame& F0, KArgs A) {
    Frame F = launder(F0);
    LAS float* scr = (LAS float*)(F.lds + F.wave * 16384);
#pragma unroll 1
    for (int l = 0; l < DEPTH; ++l) {
        unsigned char* wl = F.ws + WS_W + (size_t)l * WL_END;
        tjob(F, scr, A->in[I_WIN] + (size_t)l * DM * N_IN, N_IN, DM, 4096, 0, (bf16*)(wl + WL_IN), 0);
        tjob(F, scr, A->in[I_WIN] + (size_t)l * DM * N_IN, N_IN, DM, 6144, 4112, (bf16*)(wl + WL_IN), 4096);
        tjob(F, scr, A->in[I_WGLU] + (size_t)l * 512 * 512, 512, 512, 512, 0, (bf16*)(wl + WL_GLU), 0);
        tjob(F, scr, A->in[I_WPA] + (size_t)l * 512 * DM, DM, 512, DM, 0, (bf16*)(wl + WL_PA), 0);
        tjob(F, scr, A->in[I_WPB] + (size_t)l * 512 * DM, DM, 512, DM, 0, (bf16*)(wl + WL_PB), 0);
        tjob(F, scr, A->in[I_WPC] + (size_t)l * 1024 * DM, DM, 1024, DM, 0, (bf16*)(wl + WL_PC), 0);
        tjob(F, scr, A->in[I_WOUT] + (size_t)l * DM * DM, DM, DM, DM, 0, (bf16*)(wl + WL_OUT), 0);
        tjob(F, scr, A->in[I_WUP] + (size_t)l * DM * D_UP, D_UP, DM, D_UP, 0, (bf16*)(wl + WL_UP), -1);
        tjob(F, scr, A->in[I_WDOWN] + (size_t)l * D_FF * DM, DM, D_FF, DM, 0, (bf16*)(wl + WL_DOWN), 0);
    }
    {   bf16* X0 = WSP(bf16, WS_X0);
        for (int r = F.gw; r < MREAL; r += (GRID * NWAVES)) {
            const float* src = r < MPROMPT ? A->in[I_XP] + (size_t)r * DM : A->in[I_XS] + (size_t)(r - MPROMPT) * DM;
            GAS v2u* o = (GAS v2u*)(X0 + (size_t)r * DM) + F.lane;
#pragma unroll
            for (int j = 0; j < 8; ++j) { const f32x4 v = __builtin_nontemporal_load((const f32x4*)src + F.lane + 64 * j); v2u w; w.x = pk2(v.x, v.y); w.y = pk2(v.z, v.w); o[64 * j] = w; }
        }
    }
    {   float* z = WSP(float, WS_SMALL + SM_VSQ);
        const int gt = blockIdx.x * NTHR + F.tid;
        for (int i = gt; i < 4 * MP; i += GRID * NTHR) z[i] = 0.f;
    }
    {   const int gt = blockIdx.x * NTHR + F.tid, NT = GRID * NTHR;
        bf16* WSb = WSP(bf16, WS_SMALL + SM_WS);
        for (int i = gt; i < DEPTH * H_B * 128 * 128; i += NT) { const int jj = i & 127, ii = (i >> 7) & 127; WSb[i] = (bf16)(jj <= ii ? f2bf(A->in[I_WS][i]) : 0u); }
        float* AA = WSP(float, WS_SMALL + SM_S5A); float* BB = WSP(float, WS_SMALL + SM_S5BB); bf16* CT = WSP(bf16, WS_SMALL + SM_S5CT);
        for (int i = gt; i < DEPTH * G_A * P_A; i += NT) {
            const int l = i / (G_A * P_A), g = (i / P_A) % G_A;
            const float dt = expf(A->in[I_LOGDT][l * G_A + g]), lr = A->in[I_LAMRE][i], li = A->in[I_LAMIM][i];
            const float mag = expf(lr * dt); float sn, cs; sincosf(li * dt, &sn, &cs);
            const float ar = mag * cs, ai = mag * sn, den = lr * lr + li * li, nr = ar - 1.0f;
            const float kr = (nr * lr + ai * li) / den, ki = (ai * lr - nr * li) / den;
            float qr = ar, qi = ai;
#pragma unroll
            for (int s = 0; s < 6; ++s) { const float t = qr * qr - qi * qi; qi = 2.0f * qr * qi; qr = t; }
            AA[i * 4 + 0] = ar; AA[i * 4 + 1] = ai; AA[i * 4 + 2] = qr; AA[i * 4 + 3] = qi;
#pragma unroll
            for (int h = 0; h < S5G; ++h) { const float bre = A->in[I_BRE][(size_t)i * S5G + h], bim = A->in[I_BIM][(size_t)i * S5G + h];
                BB[(size_t)i * 32 + h] = kr * bre - ki * bim; BB[(size_t)i * 32 + 16 + h] = kr * bim + ki * bre; }
        }
        {   float* WDT = WSP(float, WS_SMALL + SM_WDT);
            for (int i = gt; i < DEPTH * 16 * DM; i += NT) { const int k = i % DM, hh = (i / DM) & 15, l = i / (16 * DM); WDT[i] = A->in[I_WIN][((size_t)l * DM + k) * N_IN + 4096 + hh]; } }
        for (int i = gt; i < DEPTH * G_A * S5G * 128; i += NT) { const int k = i & 127, lgh = i >> 7;
            const float v = k < 64 ? A->in[I_CRE][(size_t)lgh * 64 + k] : -A->in[I_CIM][(size_t)lgh * 64 + (k - 64)]; CT[i] = (bf16)f2bf(v); }
    }
}

template <bool WITH_DT>
__device__ __forceinline__ void phase_prep(const Frame& F0, const float* X, const float* XS, const float* g, const float* modl, int sh_idx, int sc_idx, const float* win_l, float* DT) {
    Frame F = launder(F0);
    bf16* H = WSP(bf16, WS_H);
    LAS float* wT = (LAS float*)F.lds;
    if (WITH_DT) {
        {   const GAS f32x4* wd = (const GAS f32x4*)WSP(const float, WS_SMALL + SM_WDT);
            f32x4 tw[16];
#pragma unroll
            for (int i = 0; i < 16; ++i) tw[i] = wd[F.tid + i * NTHR];
#pragma unroll
            for (int i = 0; i < 16; ++i) ((LAS f32x4*)wT)[F.tid + i * NTHR] = tw[i]; }
        (void)win_l;
        __syncthreads();
    }
    if (WITH_DT) {
        const bf16* X0 = WSP(const bf16, WS_X0); float* DTo = DT; const int gwv = blockIdx.x * NWAVES + F.wave;
        {   const int row = 4 * gwv; prep_rows4<1>(X0 + (size_t)row * DM, g, modl + (size_t)mod_row(row) * MOD_PITCH, sh_idx, sc_idx, H + (size_t)row * DM, nullptr, DTo + (size_t)row * 16, wT, F.lane); }
        if (gwv < NS) { const int row = MPROMPT + gwv; prep_row<1>(X0 + (size_t)row * DM, g, modl + (size_t)mod_row(row) * MOD_PITCH, sh_idx, sc_idx, H + (size_t)row * DM, nullptr, DTo + (size_t)row * 16, wT, F.lane); }
    } else {
    f32x4 vn[8];
    {   const int r0 = blockIdx.x * NWAVES + F.wave; const int rr0 = r0 < MREAL ? r0 : 0; const GAS f32x4* xr = (const GAS f32x4*)(rr0 < MPROMPT ? X + (size_t)rr0 * DM : XS + (size_t)(rr0 - MPROMPT) * DM) + F.lane;
#pragma unroll
        for (int j = 0; j < 8; ++j) vn[j] = xr[64 * j]; }
    for (int r = blockIdx.x * NWAVES + F.wave; r < MREAL; r += GRID * NWAVES) {
        f32x4 v[8]; float s = 0.f;
#pragma unroll
        for (int j = 0; j < 8; ++j) { v[j] = vn[j]; s += (v[j].x * v[j].x + v[j].y * v[j].y) + (v[j].z * v[j].z + v[j].w * v[j].w); }
        {   const int rn = r + GRID * NWAVES; const int rr1 = rn < MREAL ? rn : r; const GAS f32x4* xr = (const GAS f32x4*)(rr1 < MPROMPT ? X + (size_t)rr1 * DM : XS + (size_t)(rr1 - MPROMPT) * DM) + F.lane;
#pragma unroll
            for (int j = 0; j < 8; ++j) vn[j] = xr[64 * j]; }
        const float rinv = rsqrtf(wave_sum(s) * (1.0f / DM) + EPS);
        const float* mr = modl + (size_t)mod_row(r) * MOD_PITCH;
        const GAS f32x4* gp = (const GAS f32x4*)g + F.lane; const GAS f32x4* shp = (const GAS f32x4*)(mr + sh_idx * DM) + F.lane; const GAS f32x4* scp = (const GAS f32x4*)(mr + sc_idx * DM) + F.lane;
        GAS v2u* o = (GAS v2u*)(H + (size_t)r * DM) + F.lane;
#pragma unroll
        for (int j = 0; j < 8; ++j) { const f32x4 gg = gp[64 * j], sh = shp[64 * j], sc = scp[64 * j];
            v[j] = v[j] * rinv * gg * (sc + 1.0f) + sh;
            v2u w; w.x = pk2(v[j].x, v[j].y); w.y = pk2(v[j].z, v[j].w); o[64 * j] = w; }
        if (WITH_DT) {
            float a16[16];
#pragma unroll
            for (int hh = 0; hh < 16; ++hh) { float a = 0.f;
#pragma unroll
                for (int j = 0; j < 8; ++j) { const f32x4 w = *(const LAS f32x4*)(wT + hh * DM + 4 * F.lane + 256 * j); a += (v[j].x * w.x + v[j].y * w.y) + (v[j].z * w.z + v[j].w * w.w); }
                a16[hh] = a; }
            const float mine = wave_sum16(a16, F.lane);
            if (F.lane < 16) DT[(size_t)r * 16 + F.lane] = mine;
        }
    }
    }
    if (WITH_DT) __syncthreads();
}

__device__ __forceinline__ void phase_final(const Frame& F0, KArgs A, const float* X) {
    Frame F = launder(F0);
    const float* g = A->in[I_GFINAL];
    for (int r = blockIdx.x * NWAVES + F.wave; r < MREAL; r += GRID * NWAVES) {
        const GAS f32x4* xr = (const GAS f32x4*)(X + (size_t)r * DM) + F.lane;
        f32x4 v[8]; float s = 0.f;
#pragma unroll
        for (int j = 0; j < 8; ++j) { v[j] = xr[64 * j]; s += (v[j].x * v[j].x + v[j].y * v[j].y) + (v[j].z * v[j].z + v[j].w * v[j].w); }
        const float rinv = rsqrtf(wave_sum(s) * (1.0f / DM) + EPS);
        GAS f32x4* o = (GAS f32x4*)(F.out + (r < MPROMPT ? O_YP + (size_t)r * DM : O_YS + (size_t)(r - MPROMPT) * DM)) + F.lane;
        const GAS f32x4* gp = (const GAS f32x4*)g + F.lane;
#pragma unroll
        for (int j = 0; j < 8; ++j) o[64 * j] = v[j] * rinv * gp[64 * j];
    }
}
typedef __bf16 bf16x2_t __attribute__((ext_vector_type(2)));
constexpr int HS_PITCH = 136;
template <bool FINAL>
__device__ __forceinline__ void s5_item(KArgs A, unsigned char* ws, float* out, int l, int item, LAS unsigned char* wl, int lane, unsigned* flags = nullptr) {
    const int c = item & 31, g = (item >> 5) & 31, b = item >> 10;
    const int lgp = (l * G_A + g) * P_A + lane;
    const f32x4 aq = *(const GAS f32x4*)((const float*)(ws + WS_SMALL + SM_S5A) + (size_t)lgp * 4);
    const float ar = aq.x, ai = aq.y;
    float br[16], bi[16];
    {   const GAS f32x4* bb = (const GAS f32x4*)((const float*)(ws + WS_SMALL + SM_S5BB) + (size_t)lgp * 32);
#pragma unroll
        for (int q = 0; q < 4; ++q) { const f32x4 v = bb[q]; br[4 * q] = v.x; br[4 * q + 1] = v.y; br[4 * q + 2] = v.z; br[4 * q + 3] = v.w;
                                      const f32x4 w = bb[4 + q]; bi[4 * q] = w.x; bi[4 * q + 1] = w.y; bi[4 * q + 2] = w.z; bi[4 * q + 3] = w.w; } }
    unsigned brp[8], bip[8];
#pragma unroll
    for (int k = 0; k < 8; ++k) { brp[k] = pk2(br[2 * k], br[2 * k + 1]); bip[k] = pk2(bi[2 * k], bi[2 * k + 1]); }
    const int row0 = b * SEQ + c * S5Q;
    const bf16* PROJ = (const bf16*)(ws + WS_BIG);
    const GAS v4u* up = (const GAS v4u*)(PROJ + (size_t)(row0 + lane) * N_INP + PC_UA + g * 16);
    const v4u u0 = up[0], u1 = up[1];
    LAS bf16* Us = (LAS bf16*)(wl + 8704);
    if (FINAL) { *(LAS v4u*)(Us + lane * 16) = u0; *(LAS v4u*)(Us + lane * 16 + 8) = u1; }
    float hr = 0.f, hi = 0.f;
    float* SLOC = (float*)(ws + WS_SMALL + SM_SLOC);
    if (FINAL && flags) {
        float lr = 0.f, li = 0.f;
#pragma unroll 2
        for (int t = 0; t < 64; ++t) {
            unsigned w[8];
            w[0] = __builtin_amdgcn_readlane(u0.x, t); w[1] = __builtin_amdgcn_readlane(u0.y, t); w[2] = __builtin_amdgcn_readlane(u0.z, t); w[3] = __builtin_amdgcn_readlane(u0.w, t);
            w[4] = __builtin_amdgcn_readlane(u1.x, t); w[5] = __builtin_amdgcn_readlane(u1.y, t); w[6] = __builtin_amdgcn_readlane(u1.z, t); w[7] = __builtin_amdgcn_readlane(u1.w, t);
            float sr0 = 0.f, si0 = 0.f, sr1 = 0.f, si1 = 0.f;
#pragma unroll
            for (int k = 0; k < 8; k += 2) {
                sr0 = __builtin_amdgcn_fdot2_f32_bf16(__builtin_bit_cast(bf16x2_t, brp[k]), __builtin_bit_cast(bf16x2_t, w[k]), sr0, false);
                si0 = __builtin_amdgcn_fdot2_f32_bf16(__builtin_bit_cast(bf16x2_t, bip[k]), __builtin_bit_cast(bf16x2_t, w[k]), si0, false);
                sr1 = __builtin_amdgcn_fdot2_f32_bf16(__builtin_bit_cast(bf16x2_t, brp[k + 1]), __builtin_bit_cast(bf16x2_t, w[k + 1]), sr1, false);
                si1 = __builtin_amdgcn_fdot2_f32_bf16(__builtin_bit_cast(bf16x2_t, bip[k + 1]), __builtin_bit_cast(bf16x2_t, w[k + 1]), si1, false); }
            const float nr = ar * lr - ai * li + (sr0 + sr1); li = ar * li + ai * lr + (si0 + si1); lr = nr;
        }
        float* sl = SLOC + (size_t)item * 128 + lane;
        __hip_atomic_store(sl, lr, __ATOMIC_RELAXED, __HIP_MEMORY_SCOPE_AGENT); __hip_atomic_store(sl + 64, li, __ATOMIC_RELAXED, __HIP_MEMORY_SCOPE_AGENT);
        asm volatile("s_waitcnt vmcnt(0)" ::: "memory");
        if (lane == 0) __hip_atomic_store(flags + item, 1u, __ATOMIC_RELAXED, __HIP_MEMORY_SCOPE_AGENT);
        {
            unsigned sp_ = 0;
            for (;;) { const unsigned f = lane < c ? __hip_atomic_load(flags + (item - c + lane), __ATOMIC_RELAXED, __HIP_MEMORY_SCOPE_AGENT) : 1u;
                if (__builtin_amdgcn_ballot_w64(f == 0u) == 0ull || ++sp_ > (1u << 20)) break; __builtin_amdgcn_s_sleep(1); }
            __builtin_amdgcn_fence(__ATOMIC_ACQUIRE, "agent"); }
        asm volatile("s_waitcnt vmcnt(0)" ::: "memory");
    }
    if (FINAL) {
        const float qr = aq.z, qi = aq.w;
        const float* sl = SLOC + (size_t)((b * G_A + g) * S5NC) * 128 + lane;
        float psr[31], psi[31];
#pragma unroll
        for (int k = 0; k < 31; ++k) { const int kk = k < c ? k : 0; psr[k] = sl[kk * 128]; psi[k] = sl[kk * 128 + 64]; }
#pragma unroll
        for (int k = 0; k < 31; ++k) if (k < c) { const float t = qr * hr - qi * hi + psr[k]; hi = qr * hi + qi * hr + psi[k]; hr = t; }
    }
    LAS bf16* Hs = (LAS bf16*)wl;
    bf16x8 cfr[4];
    if (FINAL) { const bf16* ct = (const bf16*)(ws + WS_SMALL + SM_S5CT) + (size_t)((l * G_A + g) * S5G + (lane & 15)) * 128 + 8 * (lane >> 4);
#pragma unroll
        for (int ks = 0; ks < 4; ++ks) cfr[ks] = *(const GAS bf16x8*)(ct + 32 * ks); }
#pragma unroll 1
    for (int half = 0; half < 2; ++half) {
#pragma unroll 2
        for (int tt = 0; tt < 32; ++tt) {
            const int t = half * 32 + tt;
            unsigned w[8];
            w[0] = __builtin_amdgcn_readlane(u0.x, t); w[1] = __builtin_amdgcn_readlane(u0.y, t); w[2] = __builtin_amdgcn_readlane(u0.z, t); w[3] = __builtin_amdgcn_readlane(u0.w, t);
            w[4] = __builtin_amdgcn_readlane(u1.x, t); w[5] = __builtin_amdgcn_readlane(u1.y, t); w[6] = __builtin_amdgcn_readlane(u1.z, t); w[7] = __builtin_amdgcn_readlane(u1.w, t);
            float sr0 = 0.f, si0 = 0.f, sr1 = 0.f, si1 = 0.f;
#pragma unroll
            for (int k = 0; k < 8; k += 2) {
                sr0 = __builtin_amdgcn_fdot2_f32_bf16(__builtin_bit_cast(bf16x2_t, brp[k]), __builtin_bit_cast(bf16x2_t, w[k]), sr0, false);
                si0 = __builtin_amdgcn_fdot2_f32_bf16(__builtin_bit_cast(bf16x2_t, bip[k]), __builtin_bit_cast(bf16x2_t, w[k]), si0, false);
                sr1 = __builtin_amdgcn_fdot2_f32_bf16(__builtin_bit_cast(bf16x2_t, brp[k + 1]), __builtin_bit_cast(bf16x2_t, w[k + 1]), sr1, false);
                si1 = __builtin_amdgcn_fdot2_f32_bf16(__builtin_bit_cast(bf16x2_t, bip[k + 1]), __builtin_bit_cast(bf16x2_t, w[k + 1]), si1, false); }
            const float sr = sr0 + sr1, si = si0 + si1;
            const float nr = ar * hr - ai * hi + sr; hi = ar * hi + ai * hr + si; hr = nr;
            if (FINAL) { Hs[tt * HS_PITCH + lane] = (bf16)f2bf(hr); Hs[tt * HS_PITCH + 64 + lane] = (bf16)f2bf(hi); }
        }
        if (FINAL) {
            bf16* YB = (bf16*)(ws + WS_YB);
            const float* dsk = A->in[I_S5D] + l * D_A + g * 16;
#pragma unroll
            for (int tile = 0; tile < 2; ++tile) {
                f32x4 acc = {0.f, 0.f, 0.f, 0.f};
#pragma unroll
                for (int ks = 0; ks < 4; ++ks) { const bf16x8 a = *(const LAS bf16x8*)(Hs + (tile * 16 + (lane & 15)) * HS_PITCH + 32 * ks + 8 * (lane >> 4));
                    acc = __builtin_amdgcn_mfma_f32_16x16x32_bf16(a, cfr[ks], acc, 0, 0, 0); }
                const int hh = lane & 15; const float dd = dsk[hh];
#pragma unroll
                for (int r = 0; r < 4; ++r) { const int row = row0 + half * 32 + tile * 16 + 4 * (lane >> 4) + r;
                    const float u = bf2f(Us[(row - row0) * 16 + hh]);
                    YB[(size_t)row * 512 + g * 16 + hh] = (bf16)f2bf(gelu_tanh(acc[r] + dd * u)); }
            }
        }
    }
    if (!FINAL) { float* sl = SLOC + (size_t)item * 128 + lane; sl[0] = hr; sl[64] = hi; }
    if (FINAL && c == S5NC - 1) { const size_t o = (size_t)((l * NB + b) * G_A + g) * P_A + lane; out[O_S5RP + o] = hr; out[O_S5IP + o] = hi; }
}

__device__ __forceinline__ void s5_sample_item(KArgs A, unsigned char* ws, float* out, int l, int item, int lane) {
    const int g = item & 31, s = item >> 5, row = MPROMPT + s;
    const int lgp = (l * G_A + g) * P_A + lane;
    const f32x4 aq = *(const GAS f32x4*)((const float*)(ws + WS_SMALL + SM_S5A) + (size_t)lgp * 4);
    const bf16* PROJ = (const bf16*)(ws + WS_BIG);
    const GAS v4u* up = (const GAS v4u*)(PROJ + (size_t)row * N_INP + PC_UA + g * 16);
    const v4u u0 = up[0], u1 = up[1];
    float u[16]; u[0] = bflo(u0.x); u[1] = bfhi(u0.x); u[2] = bflo(u0.y); u[3] = bfhi(u0.y); u[4] = bflo(u0.z); u[5] = bfhi(u0.z); u[6] = bflo(u0.w); u[7] = bfhi(u0.w);
    u[8] = bflo(u1.x); u[9] = bfhi(u1.x); u[10] = bflo(u1.y); u[11] = bfhi(u1.y); u[12] = bflo(u1.z); u[13] = bfhi(u1.z); u[14] = bflo(u1.w); u[15] = bfhi(u1.w);
    const GAS f32x4* bb = (const GAS f32x4*)((const float*)(ws + WS_SMALL + SM_S5BB) + (size_t)lgp * 32);
    float sr = 0.f, si = 0.f;
#pragma unroll
    for (int q = 0; q < 4; ++q) { const f32x4 v = bb[q], w = bb[4 + q];
        sr += v.x * u[4 * q] + v.y * u[4 * q + 1] + v.z * u[4 * q + 2] + v.w * u[4 * q + 3];
        si += w.x * u[4 * q] + w.y * u[4 * q + 1] + w.z * u[4 * q + 2] + w.w * u[4 * q + 3]; }
    const size_t so = (size_t)((l * NS + s) * G_A + g) * P_A + lane;
    const float h0r = A->in[I_S5RE][so], h0i = A->in[I_S5IM][so];
    const float hr = aq.x * h0r - aq.y * h0i + sr, hi = aq.x * h0i + aq.y * h0r + si;
    out[O_S5RS + so] = hr; out[O_S5IS + so] = hi;
    const float* cre = A->in[I_CRE] + (size_t)((l * G_A + g) * S5G) * P_A + lane; const float* cim = A->in[I_CIM] + (size_t)((l * G_A + g) * S5G) * P_A + lane;
    float y16[16];
#pragma unroll
    for (int hh = 0; hh < 16; ++hh) y16[hh] = cre[hh * P_A] * hr - cim[hh * P_A] * hi;
    const float mine = wave_sum16(y16, lane);
    if (lane < 16) { const float dd = A->in[I_S5D][l * D_A + g * 16 + lane]; float uu = 0.f;
#pragma unroll
        for (int hh = 0; hh < 16; ++hh) uu = (lane == hh) ? u[hh] : uu;
        ((bf16*)(ws + WS_YB))[(size_t)row * 512 + g * 16 + lane] = (bf16)f2bf(gelu_tanh(mine + dd * uu)); }
}
__device__ __forceinline__ void gmlp_sample_item(KArgs A, unsigned char* ws, float* out, int l, int s, int lane) {
    const int row = MPROMPT + s, ch0 = lane * 8;
    const bf16* PROJ = (const bf16*)(ws + WS_BIG);
    const v4u vv = *(const GAS v4u*)(PROJ + (size_t)row * N_INP + PC_VB + ch0), uu = *(const GAS v4u*)(PROJ + (size_t)row * N_INP + PC_UB + ch0);
    const float rinv = rsqrtf(((const float*)(ws + WS_SMALL + SM_VSQ))[l * MP + row] * (1.0f / D_B) + EPS);
    const int h = ch0 >> 6;
    const float w00 = A->in[I_WS][(size_t)(l * H_B + h) * 128 * 128], b0 = A->in[I_BS][(l * H_B + h) * 128];
    float v[8] = {bflo(vv.x), bfhi(vv.x), bflo(vv.y), bfhi(vv.y), bflo(vv.z), bfhi(vv.z), bflo(vv.w), bfhi(vv.w)};
    float u[8] = {bflo(uu.x), bfhi(uu.x), bflo(uu.y), bfhi(uu.y), bflo(uu.z), bfhi(uu.z), bflo(uu.w), bfhi(uu.w)};
    const float* gv = A->in[I_GV] + l * D_B + ch0;
    float o[8];
#pragma unroll
    for (int j = 0; j < 8; ++j) { const float vn = v[j] * rinv * gv[j]; out[O_GVS + (size_t)(l * NS + s) * D_B + ch0 + j] = vn; o[j] = u[j] * (w00 * vn + b0); }
    v4u w; w.x = pk2(o[0], o[1]); w.y = pk2(o[2], o[3]); w.z = pk2(o[4], o[5]); w.w = pk2(o[6], o[7]);
    *(GAS v4u*)((bf16*)(ws + WS_OB) + (size_t)row * 512 + ch0) = w;
}
__device__ __forceinline__ void ssd_sample_item(KArgs A, unsigned char* ws, float* out, int l, int item, int lane, bool acc) {
    const int h = item & 15, s = item >> 4, row = MPROMPT + s, g = h >> 3;
    const bf16* PROJ = (const bf16*)(ws + WS_BIG);
    const float* cw = A->in[I_CONVW] + (size_t)l * K_C * D_XBC; const float* cb = A->in[I_CONVB] + l * D_XBC;
    const float* cst = A->in[I_SSDCONV] + (size_t)(l * NS + s) * 3 * D_XBC;
    float* cso = out + O_CCS + (size_t)(l * NS + s) * 3 * D_XBC;
    float x;
    {   const int ch = h * 64 + lane; const float p0 = cst[ch], p1 = cst[D_XBC + ch], p2 = cst[2 * D_XBC + ch], p3 = bf2f(PROJ[(size_t)row * N_INP + PC_XBC + ch]);
        x = siluf_(cb[ch] + cw[ch] * p0 + cw[D_XBC + ch] * p1 + cw[2 * D_XBC + ch] * p2 + cw[3 * D_XBC + ch] * p3);
        cso[ch] = p1; cso[D_XBC + ch] = p2; cso[2 * D_XBC + ch] = p3; }
    const int n4 = (lane & 31) * 4; float Bv[4], Cv[4];
#pragma unroll
    for (int j = 0; j < 4; ++j) {
        {   const int ch = D_C + g * N_C + n4 + j; const float p0 = cst[ch], p1 = cst[D_XBC + ch], p2 = cst[2 * D_XBC + ch], p3 = bf2f(PROJ[(size_t)row * N_INP + PC_XBC + ch]);
            Bv[j] = siluf_(cb[ch] + cw[ch] * p0 + cw[D_XBC + ch] * p1 + cw[2 * D_XBC + ch] * p2 + cw[3 * D_XBC + ch] * p3);
            if ((h & 7) == 0 && lane < 32) { cso[ch] = p1; cso[D_XBC + ch] = p2; cso[2 * D_XBC + ch] = p3; } }
        {   const int ch = D_C + G_C * N_C + g * N_C + n4 + j; const float p0 = cst[ch], p1 = cst[D_XBC + ch], p2 = cst[2 * D_XBC + ch], p3 = bf2f(PROJ[(size_t)row * N_INP + PC_XBC + ch]);
            Cv[j] = siluf_(cb[ch] + cw[ch] * p0 + cw[D_XBC + ch] * p1 + cw[2 * D_XBC + ch] * p2 + cw[3 * D_XBC + ch] * p3);
            if ((h & 7) == 0 && lane < 32) { cso[ch] = p1; cso[D_XBC + ch] = p2; cso[2 * D_XBC + ch] = p3; } }
    }
    const float dt = softplusf_(((const float*)(ws + WS_SMALL + SM_DT))[(size_t)row * 16 + h] + A->in[I_DTBIAS][l * H_C + h]);
    const float dA = __expf(dt * -__expf(A->in[I_ALOG][l * H_C + h]));
    const size_t sbase = (size_t)((l * NS + s) * H_C + h) * HD_C * N_C;
    const GAS f32x4* st = (const GAS f32x4*)(A->in[I_SSM] + sbase) + lane;
    GAS f32x4* so = (GAS f32x4*)(out + O_SSMS + sbase) + lane;
    float part[32];
#pragma unroll
    for (int i = 0; i < 32; ++i) {
        const float xe = lane_bcast(x, 2 * i), xo = lane_bcast(x, 2 * i + 1); const float xv = lane < 32 ? xe : xo; const float xd = xv * dt;
        f32x4 v = __builtin_nontemporal_load(st + 64 * i);
        v.x = v.x * dA + xd * Bv[0]; v.y = v.y * dA + xd * Bv[1]; v.z = v.z * dA + xd * Bv[2]; v.w = v.w * dA + xd * Bv[3];
        __builtin_nontemporal_store(v, so + 64 * i);
        part[i] = v.x * Cv[0] + v.y * Cv[1] + v.z * Cv[2] + v.w * Cv[3];
    }
    const float ymine = half_sum32(part, lane);
    const float xmine = __builtin_bit_cast(float, __builtin_amdgcn_ds_bpermute((2 * (lane & 31) + (lane >> 5)) << 2, __builtin_bit_cast(int, x)));
    const int p = 2 * (lane & 31) + (lane >> 5), ch = h * 64 + p;
    const float y = ymine + A->in[I_SSDD][l * H_C + h] * xmine;
    const float z = bf2f(PROJ[(size_t)row * N_INP + PC_Z + ch]);
    const float yz = y * siluf_(z);
    const float sq = wave_sum(yz * yz);
    if (lane == 0 && acc) atomicAdd((float*)(ws + WS_SMALL + SM_CSQ) + l * MP + row, sq);
    ((bf16*)(ws + WS_OC))[(size_t)row * 1024 + ch] = (bf16)f2bf(yz * A->in[I_GNORM][l * D_C + ch]);
}
constexpr int TP = 136;
__device__ __forceinline__ void gmlp_item(KArgs A, unsigned char* ws, int l, int item, LAS unsigned char* lds, int tid, int wave, int lane) {
    const int h = item & 7, c = (item >> 3) & 15, b = item >> 7, row0 = b * SEQ + c * GMC;
    const bf16* PROJ = (const bf16*)(ws + WS_BIG);
    LAS bf16* vT = (LAS bf16*)lds;
    {   const int tok = tid >> 2, part = tid & 3, d0 = part * 16, row = row0 + tok;
        const float rinv = rsqrtf(((const float*)(ws + WS_SMALL + SM_VSQ))[l * MP + row] * (1.0f / D_B) + EPS);
        const GAS v4u* vp = (const GAS v4u*)(PROJ + (size_t)row * N_INP + PC_VB + h * 64 + d0);
        const v4u a = vp[0], b2 = vp[1];
        const float* gv = A->in[I_GV] + l * D_B + h * 64 + d0;
        const unsigned wv[8] = {a.x, a.y, a.z, a.w, b2.x, b2.y, b2.z, b2.w};
#pragma unroll
        for (int k = 0; k < 8; ++k) { vT[(d0 + 2 * k) * TP + tok] = (bf16)f2bf(bflo(wv[k]) * rinv * gv[2 * k]); vT[(d0 + 2 * k + 1) * TP + tok] = (bf16)f2bf(bfhi(wv[k]) * rinv * gv[2 * k + 1]); }
    }
    const bf16* WSb = (const bf16*)(ws + WS_SMALL + SM_WS) + (size_t)(l * H_B + h) * 128 * 128;
    bf16x8 afr[4];
#pragma unroll
    for (int ks = 0; ks < 4; ++ks) afr[ks] = *(const GAS bf16x8*)(WSb + (size_t)(16 * wave + (lane & 15)) * 128 + 32 * ks + 8 * (lane >> 4));
    __syncthreads();
    f32x4 acc[4];
#pragma unroll
    for (int t = 0; t < 4; ++t) acc[t] = (f32x4){0.f, 0.f, 0.f, 0.f};
    const int nks = (wave >> 1) + 1;
#pragma unroll
    for (int ks = 0; ks < 4; ++ks) if (ks < nks) {
#pragma unroll
        for (int t = 0; t < 4; ++t) { const bf16x8 bfr = *(const LAS bf16x8*)(vT + (16 * t + (lane & 15)) * TP + 32 * ks + 8 * (lane >> 4));
            acc[t] = __builtin_amdgcn_mfma_f32_16x16x32_bf16(afr[ks], bfr, acc[t], 0, 0, 0); }
    }
    bf16* OB = (bf16*)(ws + WS_OB);
#pragma unroll
    for (int r = 0; r < 4; ++r) { const int i = 16 * wave + 4 * (lane >> 4) + r, row = row0 + i; const float bs = A->in[I_BS][(l * H_B + h) * 128 + i];
#pragma unroll
        for (int t = 0; t < 4; ++t) { const int ch = h * 64 + 16 * t + (lane & 15);
            const float u = bf2f(PROJ[(size_t)row * N_INP + PC_UB + ch]);
            OB[(size_t)row * 512 + ch] = (bf16)f2bf(u * (acc[t][r] + bs)); } }
    __syncthreads();
}

template <int NCH, bool TRANS>
__device__ __forceinline__ void conv_tile(KArgs A, const bf16* PROJ, int l, int b, int c, int chb, LAS bf16* tile, const LAS float* scale, int tid) {
    constexpr int LPR = NCH / 8, SLOTS = NTHR / LPR, TPT = 128 / SLOTS;
    const int cl = tid % LPR, slot = tid / LPR, ch0 = chb + cl * 8, t0 = slot * TPT;
    const float* cw = A->in[I_CONVW] + (size_t)l * K_C * D_XBC + ch0; const float* cb = A->in[I_CONVB] + l * D_XBC + ch0;
    float w[4][8], bias[8];
#pragma unroll
    for (int k = 0; k < 4; ++k) { const f32x4 a = *(const GAS f32x4*)(cw + k * D_XBC), b2 = *(const GAS f32x4*)(cw + k * D_XBC + 4);
        w[k][0] = a.x; w[k][1] = a.y; w[k][2] = a.z; w[k][3] = a.w; w[k][4] = b2.x; w[k][5] = b2.y; w[k][6] = b2.z; w[k][7] = b2.w; }
    {   const f32x4 a = *(const GAS f32x4*)cb, b2 = *(const GAS f32x4*)(cb + 4); bias[0] = a.x; bias[1] = a.y; bias[2] = a.z; bias[3] = a.w; bias[4] = b2.x; bias[5] = b2.y; bias[6] = b2.z; bias[7] = b2.w; }
    const int trow0 = c * SSDQ + t0;
    v4u raw[TPT + 3];
#pragma unroll
    for (int i = 0; i < TPT + 3; ++i) { const int tt = trow0 - 3 + i;
        raw[i] = tt >= 0 ? *(const GAS v4u*)(PROJ + (size_t)(b * SEQ + tt) * N_INP + PC_XBC + ch0) : (v4u){0u, 0u, 0u, 0u}; }
    float o[TPT][8];
#pragma unroll
    for (int t = 0; t < TPT; ++t) {
#pragma unroll
        for (int e = 0; e < 8; ++e) o[t][e] = bias[e];
#pragma unroll
        for (int k = 0; k < 4; ++k) { const v4u r = raw[t + k]; const unsigned rw[4] = {r.x, r.y, r.z, r.w};
#pragma unroll
            for (int e2 = 0; e2 < 4; ++e2) { o[t][2 * e2] = fmaf(w[k][2 * e2], bflo(rw[e2]), o[t][2 * e2]); o[t][2 * e2 + 1] = fmaf(w[k][2 * e2 + 1], bfhi(rw[e2]), o[t][2 * e2 + 1]); } }
        const float sc = scale ? scale[t0 + t] : 1.0f;
#pragma unroll
        for (int e = 0; e < 8; ++e) o[t][e] = siluf_(o[t][e]) * sc;
    }
    if (!TRANS) {
#pragma unroll
        for (int t = 0; t < TPT; ++t) { v4u wv; wv.x = pk2(o[t][0], o[t][1]); wv.y = pk2(o[t][2], o[t][3]); wv.z = pk2(o[t][4], o[t][5]); wv.w = pk2(o[t][6], o[t][7]);
            *(LAS v4u*)(tile + (t0 + t) * TP + cl * 8) = wv; }
    } else {
#pragma unroll
        for (int e = 0; e < 8; ++e) {
            if (TPT == 4) { v2u wv; wv.x = pk2(o[0][e], o[1][e]); wv.y = pk2(o[TPT > 2 ? 2 : 0][e], o[TPT > 3 ? 3 : 0][e]); *(LAS v2u*)(tile + (cl * 8 + e) * TP + t0) = wv; }
            else { *(LAS unsigned*)(tile + (cl * 8 + e) * TP + t0) = pk2(o[0][e], o[1][e]); }
        }
    }
}

__device__ __forceinline__ void ssd_dt_scan(KArgs A, unsigned char* ws, int l, int b, int c, int h, LAS float* dtv, LAS float* cs, int tid, int lane) {
    if (tid < 64) {
        const float* DT = (const float*)(ws + WS_SMALL + SM_DT); const float bias = A->in[I_DTBIAS][l * H_C + h], a = -__expf(A->in[I_ALOG][l * H_C + h]);
        const int row = b * SEQ + c * SSDQ + 2 * lane;
        const float d0 = softplusf_(DT[(size_t)row * 16 + h] + bias), d1 = softplusf_(DT[(size_t)(row + 1) * 16 + h] + bias);
        const float v0 = d0 * a, v1 = d1 * a; float s = v0 + v1;
#pragma unroll
        for (int o = 1; o < 64; o <<= 1) { const float t = __builtin_bit_cast(float, __builtin_amdgcn_ds_bpermute((lane - o) << 2, __builtin_bit_cast(int, s))); if (lane >= o) s += t; }
        dtv[2 * lane] = d0; dtv[2 * lane + 1] = d1; cs[2 * lane] = s - v1; cs[2 * lane + 1] = s;
    }
    __syncthreads();
}

constexpr int SL_CN = 0, SL_BN = 34816, SL_MW = 69632, SL_XT = 104448, SL_HP = 121856, SL_DT = 139264, SL_CS = SL_DT + 512, SL_SC = SL_CS + 512, SL_END = SL_SC + 512;

__device__ __forceinline__ void ssd_item1(KArgs A, unsigned char* ws, int l, int item, LAS unsigned char* lds, int tid, int wave, int lane) {
    const int h = item & 15, c = (item >> 4) & 15, b = item >> 8, g = h >> 3;
    const bf16* PROJ = (const bf16*)(ws + WS_BIG);
    LAS float* dtv = (LAS float*)(lds + SL_DT); LAS float* cs = (LAS float*)(lds + SL_CS); LAS float* sc = (LAS float*)(lds + SL_SC);
    LAS bf16* Xt = (LAS bf16*)(lds + SL_XT); LAS bf16* Bt = (LAS bf16*)(lds + SL_BN);
    (void)sc;
    conv_tile<64, true>(A, PROJ, l, b, c, h * 64, Xt, nullptr, tid);
    conv_tile<128, true>(A, PROJ, l, b, c, D_C + g * N_C, Bt, nullptr, tid);
    ssd_dt_scan(A, ws, l, b, c, h, dtv, cs, tid, lane);
    f32x4 acc[4];
#pragma unroll
    for (int t = 0; t < 4; ++t) acc[t] = (f32x4){0.f, 0.f, 0.f, 0.f};
    const float cse = cs[127];
#pragma unroll
    for (int ks = 0; ks < 4; ++ks) { const int j0 = 32 * ks + 8 * (lane >> 4);
        const v4u braw = *(const LAS v4u*)(Bt + (16 * wave + (lane & 15)) * TP + j0);
        const f32x4 d0 = *(const LAS f32x4*)(dtv + j0), d1 = *(const LAS f32x4*)(dtv + j0 + 4), c0 = *(const LAS f32x4*)(cs + j0), c1 = *(const LAS f32x4*)(cs + j0 + 4);
        v4u bs;
        bs.x = pk2(bflo(braw.x) * d0.x * __expf(cse - c0.x), bfhi(braw.x) * d0.y * __expf(cse - c0.y)); bs.y = pk2(bflo(braw.y) * d0.z * __expf(cse - c0.z), bfhi(braw.y) * d0.w * __expf(cse - c0.w));
        bs.z = pk2(bflo(braw.z) * d1.x * __expf(cse - c1.x), bfhi(braw.z) * d1.y * __expf(cse - c1.y)); bs.w = pk2(bflo(braw.w) * d1.z * __expf(cse - c1.z), bfhi(braw.w) * d1.w * __expf(cse - c1.w));
        const bf16x8 bfr = __builtin_bit_cast(bf16x8, bs);
#pragma unroll
        for (int t = 0; t < 4; ++t) { const bf16x8 af = *(const LAS bf16x8*)(Xt + (16 * t + (lane & 15)) * TP + 32 * ks + 8 * (lane >> 4));
            acc[t] = __builtin_amdgcn_mfma_f32_16x16x32_bf16(af, bfr, acc[t], 0, 0, 0); } }
    float* ST = (float*)(ws + WS_STATES) + (size_t)item * HD_C * N_C;
#pragma unroll
    for (int t = 0; t < 4; ++t)
#pragma unroll
        for (int r = 0; r < 4; ++r) ST[(size_t)(16 * t + 4 * (lane >> 4) + r) * N_C + 16 * wave + (lane & 15)] = acc[t][r];
    if (tid == 0) ((float*)(ws + WS_SMALL + SM_SDEC))[item] = __expf(cs[127]);
    __syncthreads();
}

__device__ __forceinline__ void ssd_item2(KArgs A, unsigned char* ws, float* out, int l, int item, LAS unsigned char* lds, int tid, int wave, int lane, bool acc) {
    const int h = item & 15, c = (item >> 4) & 15, b = item >> 8, g = h >> 3, row0 = b * SEQ + c * SSDQ;
    const bf16* PROJ = (const bf16*)(ws + WS_BIG);
    LAS float* dtv = (LAS float*)(lds + SL_DT); LAS float* cs = (LAS float*)(lds + SL_CS);
    LAS bf16* Cn = (LAS bf16*)(lds + SL_CN); LAS bf16* Bn = (LAS bf16*)(lds + SL_BN); LAS bf16* Mw = (LAS bf16*)(lds + SL_MW);
    LAS bf16* Xt = (LAS bf16*)(lds + SL_XT); LAS bf16* Hp = (LAS bf16*)(lds + SL_HP);
    conv_tile<64, true>(A, PROJ, l, b, c, h * 64, Xt, nullptr, tid);
    conv_tile<128, false>(A, PROJ, l, b, c, D_C + g * N_C, Bn, nullptr, tid);
    conv_tile<128, false>(A, PROJ, l, b, c, D_C + G_C * N_C + g * N_C, Cn, nullptr, tid);
    {   const float* ST = (const float*)(ws + WS_STATES) + (size_t)((b * 16) * 16 + h) * HD_C * N_C + tid * 4;
        const float* SD = (const float*)(ws + WS_SMALL + SM_SDEC) + (b * 16) * 16 + h;
        f32x4 hv[4];
#pragma unroll
        for (int k = 0; k < 4; ++k) hv[k] = (f32x4){0.f, 0.f, 0.f, 0.f};
        int cc = 0;
        for (; cc + 4 <= c; cc += 4) { f32x4 sv[4][4]; float d[4];
#pragma unroll
            for (int q = 0; q < 4; ++q) { d[q] = SD[(cc + q) * 16];
#pragma unroll
                for (int k = 0; k < 4; ++k) sv[q][k] = *(const GAS f32x4*)(ST + (size_t)(cc + q) * 16 * 8192 + 2048 * k); }
#pragma unroll
            for (int q = 0; q < 4; ++q)
#pragma unroll
                for (int k = 0; k < 4; ++k) hv[k] = hv[k] * d[q] + sv[q][k]; }
        for (; cc < c; ++cc) { const float d = SD[cc * 16];
#pragma unroll
            for (int k = 0; k < 4; ++k) hv[k] = hv[k] * d + *(const GAS f32x4*)(ST + (size_t)cc * 16 * 8192 + 2048 * k); }
#pragma unroll
        for (int k = 0; k < 4; ++k) { v2u wv; wv.x = pk2(hv[k].x, hv[k].y); wv.y = pk2(hv[k].z, hv[k].w); *(LAS v2u*)(Hp + ((tid >> 5) + 16 * k) * TP + (tid & 31) * 4) = wv; }
        if (c == SSDNC - 1) { const float d = SD[c * 16]; float* o = out + O_SSMP + (size_t)((l * NB + b) * H_C + h) * HD_C * N_C + tid * 4;
#pragma unroll
            for (int k = 0; k < 4; ++k) *(GAS f32x4*)(o + 2048 * k) = hv[k] * d + *(const GAS f32x4*)(ST + (size_t)c * 16 * 8192 + 2048 * k); }
    }
    ssd_dt_scan(A, ws, l, b, c, h, dtv, cs, tid, lane);
    bf16x8 cf[4];
#pragma unroll
    for (int ks = 0; ks < 4; ++ks) cf[ks] = *(const LAS bf16x8*)(Cn + (16 * wave + (lane & 15)) * TP + 32 * ks + 8 * (lane >> 4));
    const int jtmax = wave | 1;
    for (int jt = 0; jt <= jtmax; ++jt) {
        f32x4 gacc = {0.f, 0.f, 0.f, 0.f};
        if (jt <= wave) {
#pragma unroll
            for (int ks = 0; ks < 4; ++ks) { const bf16x8 bfr = *(const LAS bf16x8*)(Bn + (16 * jt + (lane & 15)) * TP + 32 * ks + 8 * (lane >> 4));
                gacc = __builtin_amdgcn_mfma_f32_16x16x32_bf16(cf[ks], bfr, gacc, 0, 0, 0); }
        }
        const int j = 16 * jt + (lane & 15); const float csj = cs[j], dtj = dtv[j];
#pragma unroll
        for (int r = 0; r < 4; ++r) { const int i = 16 * wave + 4 * (lane >> 4) + r;
            const float m = (j <= i) ? gacc[r] * __expf(cs[i] - csj) * dtj : 0.f;
            Mw[i * TP + j] = (bf16)f2bf(m); }
    }
    f32x4 yd[4], yo[4];
#pragma unroll
    for (int t = 0; t < 4; ++t) { yd[t] = (f32x4){0.f, 0.f, 0.f, 0.f}; yo[t] = (f32x4){0.f, 0.f, 0.f, 0.f}; }
    const int nks = (wave >> 1) + 1;
    for (int ks = 0; ks < nks; ++ks) { const bf16x8 mf = *(const LAS bf16x8*)(Mw + (16 * wave + (lane & 15)) * TP + 32 * ks + 8 * (lane >> 4));
#pragma unroll
        for (int t = 0; t < 4; ++t) { const bf16x8 xf = *(const LAS bf16x8*)(Xt + (16 * t + (lane & 15)) * TP + 32 * ks + 8 * (lane >> 4));
            yd[t] = __builtin_amdgcn_mfma_f32_16x16x32_bf16(mf, xf, yd[t], 0, 0, 0); } }
#pragma unroll
    for (int ks = 0; ks < 4; ++ks)
#pragma unroll
        for (int t = 0; t < 4; ++t) { const bf16x8 hf = *(const LAS bf16x8*)(Hp + (16 * t + (lane & 15)) * TP + 32 * ks + 8 * (lane >> 4));
            yo[t] = __builtin_amdgcn_mfma_f32_16x16x32_bf16(cf[ks], hf, yo[t], 0, 0, 0); }
    const float dsk = A->in[I_SSDD][l * H_C + h];
    bf16* OC = (bf16*)(ws + WS_OC); float* csq = (float*)(ws + WS_SMALL + SM_CSQ) + l * MP;
#pragma unroll
    for (int r = 0; r < 4; ++r) { const int i = 16 * wave + 4 * (lane >> 4) + r, row = row0 + i; const float ecs = __expf(cs[i]); float sq = 0.f;
#pragma unroll
        for (int t = 0; t < 4; ++t) { const int p = 16 * t + (lane & 15), ch = h * 64 + p;
            const float x = bf2f(Xt[p * TP + i]);
            const float y = yd[t][r] + ecs * yo[t][r] + dsk * x;
            const float z = bf2f(PROJ[(size_t)row * N_INP + PC_Z + ch]);
            const float yz = y * siluf_(z); sq += yz * yz;
            OC[(size_t)row * 1024 + ch] = (bf16)f2bf(yz * A->in[I_GNORM][l * D_C + ch]); }
        sq += xor_lt32<1>(sq); sq += xor_lt32<2>(sq); sq += xor_lt32<4>(sq); sq += xor_lt32<8>(sq);
        if ((lane & 15) == 0 && acc) atomicAdd(csq + row, sq); }
    __syncthreads();
}

__device__ __forceinline__ void ssd_item_fused(KArgs A, unsigned char* ws, float* out, int l, int item, LAS unsigned char* lds, int tid, int wave, int lane, bool acc, unsigned* flags) {
    const int h = item & 15, c = (item >> 4) & 15, b = item >> 8, g = h >> 3, row0 = b * SEQ + c * SSDQ;
    const bf16* PROJ = (const bf16*)(ws + WS_BIG);
    LAS float* dtv = (LAS float*)(lds + SL_DT); LAS float* cs = (LAS float*)(lds + SL_CS);
    LAS bf16* Cn = (LAS bf16*)(lds + SL_CN); LAS bf16* Bn = (LAS bf16*)(lds + SL_BN); LAS bf16* Mw = (LAS bf16*)(lds + SL_MW);
    LAS bf16* Xt = (LAS bf16*)(lds + SL_XT); LAS bf16* Hp = (LAS bf16*)(lds + SL_HP);
    conv_tile<64, true>(A, PROJ, l, b, c, h * 64, Xt, nullptr, tid);
    conv_tile<128, false>(A, PROJ, l, b, c, D_C + g * N_C, Bn, nullptr, tid);
    conv_tile<128, true>(A, PROJ, l, b, c, D_C + g * N_C, Mw, nullptr, tid);
    conv_tile<128, false>(A, PROJ, l, b, c, D_C + G_C * N_C + g * N_C, Cn, nullptr, tid);
    bf16 zz[4][4];
#pragma unroll
    for (int r = 0; r < 4; ++r)
#pragma unroll
        for (int t = 0; t < 4; ++t) zz[r][t] = PROJ[(size_t)(row0 + 16 * wave + 4 * (lane >> 4) + r) * N_INP + PC_Z + h * 64 + 16 * t + (lane & 15)];
    ssd_dt_scan(A, ws, l, b, c, h, dtv, cs, tid, lane);
    {   f32x4 sacc[4];
#pragma unroll
        for (int t = 0; t < 4; ++t) sacc[t] = (f32x4){0.f, 0.f, 0.f, 0.f};
        const float cse = cs[127];
#pragma unroll
        for (int ks = 0; ks < 4; ++ks) { const int j0 = 32 * ks + 8 * (lane >> 4);
            const v4u braw = *(const LAS v4u*)(Mw + (16 * wave + (lane & 15)) * TP + j0);
            const f32x4 d0 = *(const LAS f32x4*)(dtv + j0), d1 = *(const LAS f32x4*)(dtv + j0 + 4), c0 = *(const LAS f32x4*)(cs + j0), c1 = *(const LAS f32x4*)(cs + j0 + 4);
            v4u bs;
            bs.x = pk2(bflo(braw.x) * d0.x * __expf(cse - c0.x), bfhi(braw.x) * d0.y * __expf(cse - c0.y)); bs.y = pk2(bflo(braw.y) * d0.z * __expf(cse - c0.z), bfhi(braw.y) * d0.w * __expf(cse - c0.w));
            bs.z = pk2(bflo(braw.z) * d1.x * __expf(cse - c1.x), bfhi(braw.z) * d1.y * __expf(cse - c1.y)); bs.w = pk2(bflo(braw.w) * d1.z * __expf(cse - c1.z), bfhi(braw.w) * d1.w * __expf(cse - c1.w));
            const bf16x8 bfr = __builtin_bit_cast(bf16x8, bs);
#pragma unroll
            for (int t = 0; t < 4; ++t) { const bf16x8 af = *(const LAS bf16x8*)(Xt + (16 * t + (lane & 15)) * TP + 32 * ks + 8 * (lane >> 4));
                sacc[t] = __builtin_amdgcn_mfma_f32_16x16x32_bf16(bfr, af, sacc[t], 0, 0, 0); } }
        {   const __amdgpu_buffer_rsrc_t srs = __builtin_amdgcn_make_buffer_rsrc((void*)((float*)(ws + WS_STATES) + (size_t)item * HD_C * N_C), (short)0, HD_C * N_C * 4, 0x00020000);
#pragma unroll
            for (int t = 0; t < 4; ++t) __builtin_amdgcn_raw_buffer_store_b128(__builtin_bit_cast(v4u, sacc[t]), srs, (unsigned)((16 * t + (lane & 15)) * N_C + 16 * wave + 4 * (lane >> 4)) * 4u, 0,   16); }
        if (tid == 0) __hip_atomic_store((float*)(ws + WS_SMALL + SM_SDEC) + item, __expf(cse), __ATOMIC_RELAXED, __HIP_MEMORY_SCOPE_AGENT);
        asm volatile("s_waitcnt vmcnt(0)" ::: "memory"); __syncthreads();
        if (tid == 0) __hip_atomic_store(flags + item, 1u, __ATOMIC_RELAXED, __HIP_MEMORY_SCOPE_AGENT);
    }
    bf16x8 cf[4];
#pragma unroll
    for (int ks = 0; ks < 4; ++ks) cf[ks] = *(const LAS bf16x8*)(Cn + (16 * wave + (lane & 15)) * TP + 32 * ks + 8 * (lane >> 4));
    const int jtmax = wave | 1;
    for (int jt = 0; jt <= jtmax; ++jt) {
        f32x4 gacc = {0.f, 0.f, 0.f, 0.f};
        if (jt <= wave) {
#pragma unroll
            for (int ks = 0; ks < 4; ++ks) { const bf16x8 bfr = *(const LAS bf16x8*)(Bn + (16 * jt + (lane & 15)) * TP + 32 * ks + 8 * (lane >> 4));
                gacc = __builtin_amdgcn_mfma_f32_16x16x32_bf16(cf[ks], bfr, gacc, 0, 0, 0); }
        }
        const int j = 16 * jt + (lane & 15); const float csj = cs[j], dtj = dtv[j];
#pragma unroll
        for (int r = 0; r < 4; ++r) { const int i = 16 * wave + 4 * (lane >> 4) + r;
            const float m = (j <= i) ? gacc[r] * __expf(cs[i] - csj) * dtj : 0.f;
            Mw[i * TP + j] = (bf16)f2bf(m); }
    }
    f32x4 yd[4], yo[4];
#pragma unroll
    for (int t = 0; t < 4; ++t) { yd[t] = (f32x4){0.f, 0.f, 0.f, 0.f}; yo[t] = (f32x4){0.f, 0.f, 0.f, 0.f}; }
    const int nks = (wave >> 1) + 1;
    for (int ks = 0; ks < nks; ++ks) { const bf16x8 mf = *(const LAS bf16x8*)(Mw + (16 * wave + (lane & 15)) * TP + 32 * ks + 8 * (lane >> 4));
#pragma unroll
        for (int t = 0; t < 4; ++t) { const bf16x8 xf = *(const LAS bf16x8*)(Xt + (16 * t + (lane & 15)) * TP + 32 * ks + 8 * (lane >> 4));
            yd[t] = __builtin_amdgcn_mfma_f32_16x16x32_bf16(mf, xf, yd[t], 0, 0, 0); } }
    if (tid < 64) {
        unsigned sp_ = 0;
        for (;;) { const unsigned f = lane < c ? __hip_atomic_load(flags + ((b * 16 + lane) * 16 + h), __ATOMIC_RELAXED, __HIP_MEMORY_SCOPE_AGENT) : 1u;
            if (__builtin_amdgcn_ballot_w64(f == 0u) == 0ull || ++sp_ > (1u << 20)) break; __builtin_amdgcn_s_sleep(1); }
        __builtin_amdgcn_fence(__ATOMIC_ACQUIRE, "agent"); asm volatile("s_waitcnt vmcnt(0)" ::: "memory"); }
    __syncthreads();
    {   const float* ST = (const float*)(ws + WS_STATES) + (size_t)((b * 16) * 16 + h) * HD_C * N_C + tid * 4;
        const float* SD = (const float*)(ws + WS_SMALL + SM_SDEC) + (b * 16) * 16 + h;
        f32x4 hv[4];
#pragma unroll
        for (int k = 0; k < 4; ++k) hv[k] = (f32x4){0.f, 0.f, 0.f, 0.f};
        for (int cc = 0; cc < c; cc += 4) { f32x4 sv[4][4]; float d[4];
#pragma unroll
            for (int q = 0; q < 4; ++q) { const int cq = cc + q < c ? cc + q : c - 1; d[q] = SD[cq * 16];
#pragma unroll
                for (int k = 0; k < 4; ++k) sv[q][k] = *(const GAS f32x4*)(ST + (size_t)cq * 16 * 8192 + 2048 * k); }
#pragma unroll
            for (int q = 0; q < 4; ++q) if (cc + q < c) {
#pragma unroll
                for (int k = 0; k < 4; ++k) hv[k] = hv[k] * d[q] + sv[q][k]; } }
#pragma unroll
        for (int k = 0; k < 4; ++k) { v2u wv; wv.x = pk2(hv[k].x, hv[k].y); wv.y = pk2(hv[k].z, hv[k].w); *(LAS v2u*)(Hp + ((tid >> 5) + 16 * k) * TP + (tid & 31) * 4) = wv; }
        if (c == SSDNC - 1) { const float d = SD[c * 16]; float* o = out + O_SSMP + (size_t)((l * NB + b) * H_C + h) * HD_C * N_C + tid * 4;
#pragma unroll
            for (int k = 0; k < 4; ++k) *(GAS f32x4*)(o + 2048 * k) = hv[k] * d + *(const GAS f32x4*)(ST + (size_t)c * 16 * 8192 + 2048 * k); }
    }
    __syncthreads();
#pragma unroll
    for (int ks = 0; ks < 4; ++ks)
#pragma unroll
        for (int t = 0; t < 4; ++t) { const bf16x8 hf = *(const LAS bf16x8*)(Hp + (16 * t + (lane & 15)) * TP + 32 * ks + 8 * (lane >> 4));
            yo[t] = __builtin_amdgcn_mfma_f32_16x16x32_bf16(cf[ks], hf, yo[t], 0, 0, 0); }
    const float dsk = A->in[I_SSDD][l * H_C + h];
    bf16* OC = (bf16*)(ws + WS_OC); float* csq = (float*)(ws + WS_SMALL + SM_CSQ) + l * MP;
#pragma unroll
    for (int r = 0; r < 4; ++r) { const int i = 16 * wave + 4 * (lane >> 4) + r, row = row0 + i; const float ecs = __expf(cs[i]); float sq = 0.f;
#pragma unroll
        for (int t = 0; t < 4; ++t) { const int p = 16 * t + (lane & 15), ch = h * 64 + p;
            const float x = bf2f(Xt[p * TP + i]);
            const float y = yd[t][r] + ecs * yo[t][r] + dsk * x;
            const float z = bf2f(zz[r][t]);
            const float yz = y * siluf_(z); sq += yz * yz;
            OC[(size_t)row * 1024 + ch] = (bf16)f2bf(yz * A->in[I_GNORM][l * D_C + ch]); }
        sq += xor_lt32<1>(sq); sq += xor_lt32<2>(sq); sq += xor_lt32<4>(sq); sq += xor_lt32<8>(sq);
        if ((lane & 15) == 0 && acc) atomicAdd(csq + row, sq); }
    __syncthreads();
}
__device__ __forceinline__ void phase_upfix(const Frame& F0, KArgs A, int l) {
    Frame F = launder(F0);
    const float* HALO = WSP(const float, WS_HALO); bf16* ACT = WSP(bf16, WS_T);
    const float* cw = A->in[I_FCONVW] + (size_t)l * K_F * D_UP; const float* cb = A->in[I_FCONVB] + (size_t)l * D_UP;
    const int gt = blockIdx.x * NTHR + F.tid, NT = GRID * NTHR;
    for (int i = gt; i < 32 * D_FF; i += NT) { const int ch = i % D_FF, pm = i / D_FF; if ((pm & 7) == 0) continue;
        const int ca_ = 256 * (ch / 128) + ch % 128, cb_ = ca_ + 128;
        const float* hp = HALO + ((size_t)(pm - 1) * 4 + 2) * D_UP; const float* hc = HALO + (size_t)pm * 4 * D_UP;
        const float am2 = hp[ca_], am1 = hp[D_UP + ca_], a0 = hc[ca_], a1 = hc[D_UP + ca_], bm2 = hp[cb_], bm1 = hp[D_UP + cb_], b0 = hc[cb_], b1 = hc[D_UP + cb_];
        const float wa0 = cw[ch], wa1 = cw[D_UP + ch], wa2 = cw[2 * D_UP + ch], wb0 = cw[D_FF + ch], wb1 = cw[D_UP + D_FF + ch], wb2 = cw[2 * D_UP + D_FF + ch], ba = cb[ch], bb = cb[D_FF + ch];
        const float r0 = siluf_(ba + wa0 * am2 + wa1 * am1 + wa2 * a0) * (bb + wb0 * bm2 + wb1 * bm1 + wb2 * b0);
        const float r1 = siluf_(ba + wa0 * am1 + wa1 * a0 + wa2 * a1) * (bb + wb0 * bm1 + wb1 * b0 + wb2 * b1);
        ACT[(size_t)(pm * 256) * D_FF + ch] = (bf16)f2bf(r0); ACT[(size_t)(pm * 256 + 1) * D_FF + ch] = (bf16)f2bf(r1); }
    for (int i = gt; i < NB * 2 * D_UP; i += NT) { const int oc = i % D_UP, k = (i / D_UP) & 1, b = i / (2 * D_UP);
        const int c = oc < D_FF ? 256 * (oc / 128) + oc % 128 : 256 * ((oc - D_FF) / 128) + 128 + (oc - D_FF) % 128;
        F.out[O_CFP + (size_t)l * NB * 2 * D_UP + i] = HALO[((size_t)(8 * b + 7) * 4 + 2 + k) * D_UP + c]; }
}
__device__ __forceinline__ void ssd_conv_p_out(const Frame& F0, int l) {
    Frame F = launder(F0);
    const bf16* PROJ = WSP(const bf16, WS_BIG);
    const int gt = blockIdx.x * NTHR + F.tid, NT = GRID * NTHR;
    for (int i = gt; i < NB * 3 * D_XBC; i += NT) { const int ch = i % D_XBC, k = (i / D_XBC) % 3, b = i / (3 * D_XBC);
        F.out[O_CCP + (size_t)l * NB * 3 * D_XBC + i] = bf2f(PROJ[(size_t)(b * SEQ + SEQ - 3 + k) * N_INP + PC_XBC + ch]); }
}

__device__ __forceinline__ void phase_mix1(const Frame& F0, KArgs A, int l, bool acc) {
    {   Frame F = launder(F0);
        for (int it = F.gw; it < NS * G_A; it += (GRID * NWAVES)) s5_sample_item(A, F.ws, F.out, l, it, F.lane); }
    {   Frame F = launder(F0);
        for (int it = F.gw; it < NS; it += (GRID * NWAVES)) gmlp_sample_item(A, F.ws, F.out, l, it, F.lane); }
    {   Frame F = launder(F0);
        for (int it = F.gw; it < NS * H_C; it += (GRID * NWAVES)) ssd_sample_item(A, F.ws, F.out, l, it, F.lane, acc); }
    ssd_conv_p_out(F0, l);
}
__device__ __forceinline__ void phase_mix2(const Frame& F0, KArgs A, int l, bool acc) {
#ifndef REP_SSD2
#define REP_SSD2 1
#endif
#ifndef REP_GMLP
#define REP_GMLP 1
#endif
#ifndef REP_S5F
#define REP_S5F 1
#endif
    _Pragma("unroll 1") for (int r2 = 0; r2 < REP_SSD2; ++r2) {   Frame F = launder(F0);
        for (int it = blockIdx.x; it < NB * SSDNC * H_C; it += GRID) ssd_item_fused(A, F.ws, F.out, l, it, F.lds, F.tid, F.wave, F.lane, acc && r2 == 0, (unsigned*)(F.ws + WS_CTL) + CW_SSDF + l * 1024); }
    _Pragma("unroll 1") for (int r2 = 0; r2 < REP_GMLP; ++r2) {   Frame F = launder(F0);
        for (int it = blockIdx.x; it < NB * (SEQ / GMC) * H_B; it += GRID) gmlp_item(A, F.ws, l, it, F.lds, F.tid, F.wave, F.lane); }
    _Pragma("unroll 1") for (int r2 = 0; r2 < REP_S5F; ++r2) {   Frame F = launder(F0);
        for (int it = F.gw; it < NB * G_A * S5NC; it += (GRID * NWAVES)) s5_item<true>(A, F.ws, F.out, l, it, F.lds + F.wave * 10752, F.lane, (unsigned*)(F.ws + WS_CTL) + CW_S5F + l * 4096); }
}

constexpr int LDS_BYTES = 147456, MISC_OFF = 147456 - 256;
#ifndef GEMM_SP2
#define GEMM_SP2 true
#endif
template <class Epi>
__device__ __forceinline__ void run_gemm(const Frame& F, const bf16* Am, const bf16* Bt, int M, int N, int K, const Epi& E) {
    pg8::Gemm g{Am, Bt, M, N, K}; pg8::StaticOrder S; S.init(M, N, GRID, (int)blockIdx.x, K);
    pg8::gemm_phase<Epi, pg8::StaticOrder, true, GEMM_SP2>(F.lds, g, S, E);
}
struct SplitSched {
    pg8::StaticOrder P; int c, np, nsl, ntsl, ns, cbase, cu0, sid0;
    __device__ void init(int N, int K, int c_, int nsl_, int cbase_, int cu0_, int sid0_) { sid0 = sid0_; P.init(MPROMPT, N, GRID, c_, K); c = c_; np = (MPROMPT / 256) * (N / 256) / GRID; nsl = nsl_; ntsl = (K / 64) / nsl_; ns = (N / 256) * nsl_; cbase = cbase_; cu0 = cu0_; }
    __device__ bool next(int i, pg8::Unit& u) const {
        const int s = c - cu0; const bool has = s >= 0 && s < ns;
        if (!has || i > 0) return (i - (has ? 1 : 0)) < np ? P.next(i - (has ? 1 : 0), u) : false;
        u.pm = MPROMPT / 256; u.pn = s / nsl; u.k0 = (s % nsl) * ntsl * 64; u.nt = ntsl; u.cidx = cbase + u.pn; u.sid = sid0 + s; return true;
    }
    __device__ __forceinline__ void a_ready(const pg8::Unit&) const {}
    __device__ __forceinline__ void done(const pg8::Unit&) const {}
};
template <class Epi, bool CHAIN_IN>
__device__ __forceinline__ void run_gemm_chain(const Frame& F, const bf16* Am, const bf16* Bt, int K, const Epi& E, pg8::f32x4 (&acc)[2][2][4][2]) {
    pg8::Gemm g{Am, Bt, MPROMPT, DM, K}; pg8::StaticOrder S; S.init(MPROMPT, DM, GRID, (int)blockIdx.x, K);
    pg8::gemm_phase<Epi, pg8::StaticOrder, true, GEMM_SP2, CHAIN_IN>(F.lds, g, S, E, acc);
}
template <class Epi>
__device__ __forceinline__ void run_gemm_split(const Frame& F, const bf16* Am, const bf16* Bt, int N, int K, const Epi& E, int nsl, int cbase, int cu0, int sid0 = 0, bool slices_only = false) {
    pg8::Gemm g{Am, Bt, MP, N, K}; SplitSched S; S.init(N, K, (int)blockIdx.x, nsl, cbase, cu0, sid0); if (slices_only) S.np = 0;
    pg8::gemm_phase<Epi, SplitSched, true, GEMM_SP2>(F.lds, g, S, E);
}

#ifndef REP_PROLOGUE
#define REP_PROLOGUE 1
#endif
#ifndef REP_MOD
#define REP_MOD 1
#endif
#ifndef REP_PREP
#define REP_PREP 1
#endif
#ifndef REP_WIN
#define REP_WIN 1
#endif
#ifndef REP_MIX1
#define REP_MIX1 1
#endif
#ifndef REP_MIX2
#define REP_MIX2 1
#endif
#ifndef REP_GLU
#define REP_GLU 1
#endif
#ifndef REP_MERGE
#define REP_MERGE 1
#endif
#ifndef REP_OUT
#define REP_OUT 1
#endif
#ifndef REP_UP
#define REP_UP 1
#endif
#ifndef REP_CONV
#define REP_CONV 1
#endif
#ifndef REP_DOWN
#define REP_DOWN 1
#endif
#ifndef REP_BAR
#define REP_BAR 1
#endif
#define REP(n) _Pragma("unroll 1") for (int rep_ = 0; rep_ < (n); ++rep_)
__device__ __forceinline__ void grid_bar(const Frame& F0) {
    unsigned long long w = (unsigned long long)F0.ws; unsigned x = xb_xcc_id(); asm volatile("" : "+s"(w), "+s"(x));
    XcdBarrier b; b.bar = (unsigned*)((unsigned char*)w + WS_CTL) + CW_BAR; b.x = x; b.st = (volatile LAS unsigned*)(F0.lds + MISC_OFF) + 8;
    xcd_barrier(b);
}
__global__ void __launch_bounds__(NTHR, 2) mega_fwd(Args Aarg) {
    const KArgs A0 = (KArgs)__builtin_amdgcn_kernarg_segment_ptr(); (void)Aarg;
#define A launder_args(A0)
    extern __shared__ __attribute__((aligned(16))) unsigned char lds_raw[];
    Frame F;
    F.lds = (LAS unsigned char*)lds_raw;
    F.tid = threadIdx.x; F.lane = F.tid & 63; F.wave = __builtin_amdgcn_readfirstlane(F.tid >> 6);
    F.gw = blockIdx.x * NWAVES + F.wave;
    F.out = A0->out; F.ws = A0->ws;
    volatile LAS unsigned* MISC = (volatile LAS unsigned*)(F.lds + MISC_OFF);
    if (F.tid < 64) MISC[F.tid] = 0u;
    __syncthreads();
    (void)xcd_barrier_post((unsigned*)(F.ws + WS_CTL) + CW_BAR, MISC + 8);
#define GRID_BAR() do { REP(REP_BAR) grid_bar(F); } while (0)
#ifndef TIME_PHASE
#define TIME_PHASE -1
#endif
    unsigned long long tacc_ = 0ull, tbeg_ = 0ull;
#define TBEG(k) do { if (TIME_PHASE == (k)) tbeg_ = __builtin_amdgcn_s_memrealtime(); } while (0)
#define TEND(k) do { if (TIME_PHASE == (k)) tacc_ += __builtin_amdgcn_s_memrealtime() - tbeg_; } while (0)

#ifndef REP_MODS
#define REP_MODS 1
#endif
    REP(REP_PROLOGUE) { _Pragma("unroll 1") for (int rm = 0; rm < REP_MODS; ++rm) phase_mod(F, A); phase_prologue(F, A);
    GRID_BAR(); }
#pragma unroll 1
    for (int l = 0; l < DEPTH; ++l) {
#define PH_FRAME() const Frame Fq = launder(F); unsigned char* const wsq = Fq.ws; unsigned char* const wl = wsq + WS_W + (size_t)l * WL_END; \
        const float* const modl = (const float*)(wsq + WS_MOD) + (size_t)l * N_MOD; pg8::f32x4* const slab = (pg8::f32x4*)(wsq + WS_SLAB); \
        unsigned* const cnt = (unsigned*)(wsq + WS_CTL) + CW_CNT; (void)wl; (void)modl; (void)slab; (void)cnt
#define WSQ(T, off) ((T*)(wsq + (off)))
        if (l == 0) REP(REP_PREP) { { PH_FRAME(); phase_prep<true>(Fq, A->in[I_XP], A->in[I_XS], A->in[I_GMIX] + l * DM, modl, 0, 1, A->in[I_WIN] + (size_t)l * DM * N_IN, WSQ(float, WS_SMALL + SM_DT)); }
        GRID_BAR(); }
        REP(REP_WIN) { { PH_FRAME(); epi::EpiIn E{WSQ(bf16, WS_BIG), rep_ == 0 ? WSQ(float, WS_SMALL + SM_VSQ) + l * MP : nullptr, epi::SplitCtl{slab, cnt, 4u}};
            run_gemm_split(Fq, WSQ(const bf16, WS_H), (const bf16*)(wl + WL_IN), N_INP, DM, E, 4, (l * 4 + 0) * 64, 0); }
        GRID_BAR(); }
        REP(REP_MIX2) { phase_mix2(F, A, l, rep_ == 0); phase_mix1(F, A, l, rep_ == 0);
        GRID_BAR(); }
        REP(REP_GLU) { { PH_FRAME(); epi::EpiGlu E{WSQ(const bf16, WS_YB), WSQ(bf16, WS_OA)};
            run_gemm(Fq, WSQ(const bf16, WS_YB), (const bf16*)(wl + WL_GLU), MP, 512, 512, E); }
        GRID_BAR(); }
        TBEG(5);
        REP(REP_MERGE) {
            TBEG(10);
            {   PH_FRAME(); bf16* BIG = WSQ(bf16, WS_BIG);
                epi::EpiMerge<0> Ea{BIG + PC_GA, WSQ(float, WS_T), WSQ(bf16, WS_MERGED), WSQ(const float, WS_SMALL + SM_CSQ) + l * MP, slab, BIG, cnt};
                run_gemm_split(Fq, WSQ(const bf16, WS_OA), (const bf16*)(wl + WL_PA), DM, 512, Ea, 2, (l * 4 + 1) * 64, 0, 0); }
            TEND(10); TBEG(11);
            {   PH_FRAME(); bf16* BIG = WSQ(bf16, WS_BIG);
                epi::EpiMerge<1> Eb{BIG + PC_GB, WSQ(float, WS_T), WSQ(bf16, WS_MERGED), WSQ(const float, WS_SMALL + SM_CSQ) + l * MP, slab, BIG, cnt};
                run_gemm_split(Fq, WSQ(const bf16, WS_OB), (const bf16*)(wl + WL_PB), DM, 512, Eb, 2, (l * 4 + 1) * 64, 16, 16); }
            TEND(11); TBEG(12);
            {   PH_FRAME(); bf16* BIG = WSQ(bf16, WS_BIG);
                epi::EpiMerge<2> Ec{BIG + PC_GC, WSQ(float, WS_T), WSQ(bf16, WS_MERGED), WSQ(const float, WS_SMALL + SM_CSQ) + l * MP, slab, BIG, cnt};
                run_gemm_split(Fq, WSQ(const bf16, WS_OC), (const bf16*)(wl + WL_PC), DM, 1024, Ec, 4, (l * 4 + 1) * 64, 32, 32); }
            TEND(12); TBEG(13);
        GRID_BAR(); TEND(13); }
        TEND(5);
        TBEG(6);
        REP(REP_OUT) { { PH_FRAME(); epi::EpiResidPrep<0> E{epi::EpiResid{WSQ(const bf16, WS_X0), WSQ(const bf16, WS_X0) + (size_t)MPROMPT * DM, WSQ(bf16, WS_X1), modl + 2 * DM, epi::SplitCtl{slab, cnt, 4u}},
                WSQ(bf16, WS_H), nullptr, nullptr, A->in[I_GFFN] + l * DM, modl, 3, 4, nullptr, WSQ(float, WS_SMALL + SM_DT), (unsigned*)(wsq + WS_CTL) + CW_PC + (l * 2 + 0) * 64};
            run_gemm_split(Fq, WSQ(const bf16, WS_MERGED), (const bf16*)(wl + WL_OUT), DM, DM, E, 4, (l * 4 + 2) * 64, 0); }
        GRID_BAR(); }
        TEND(6);
        REP(REP_UP) { { PH_FRAME(); epi::EpiUpConv E{WSQ(bf16, WS_T), WSQ(float, WS_HALO), A->in[I_FCONVW] + (size_t)l * K_F * D_UP, A->in[I_FCONVB] + (size_t)l * D_UP,
                A->in[I_FFNCONV] + (size_t)l * NS * 2 * D_UP, Fq.out + O_CFS + (size_t)l * NS * 2 * D_UP, (LAS float*)(Fq.lds + 131072), rep_ < REP_UP - 1 ? 1 : 0};
            run_gemm(Fq, WSQ(const bf16, WS_H), (const bf16*)(wl + WL_UP), MP, D_UP, DM, E); }
        GRID_BAR(); }
        REP(REP_CONV) { phase_upfix(F, A, l);
        GRID_BAR(); }
        REP(REP_DOWN) {
            if (l + 1 < DEPTH) { PH_FRAME(); const float* mod2 = (const float*)(wsq + WS_MOD) + (size_t)(l + 1) * N_MOD;
                epi::EpiResidPrep<1> E{epi::EpiResid{WSQ(const bf16, WS_X1), WSQ(const bf16, WS_X1) + (size_t)MPROMPT * DM, WSQ(bf16, WS_X0), modl + 5 * DM, epi::SplitCtl{slab, cnt, 4u}},
                    WSQ(bf16, WS_H), nullptr, nullptr, A->in[I_GMIX] + (l + 1) * DM, mod2, 0, 1, WSQ(const float, WS_SMALL + SM_WDT) + (size_t)(l + 1) * 16 * DM, WSQ(float, WS_SMALL + SM_DT), (unsigned*)(wsq + WS_CTL) + CW_PC + (l * 2 + 1) * 64};
                run_gemm_split(Fq, WSQ(const bf16, WS_T), (const bf16*)(wl + WL_DOWN), DM, D_FF, E, 4, (l * 4 + 3) * 64, 0);
            } else { PH_FRAME();
                epi::EpiResidPrep<2> E{epi::EpiResid{WSQ(const bf16, WS_X1), WSQ(const bf16, WS_X1) + (size_t)MPROMPT * DM, WSQ(bf16, WS_X0), modl + 5 * DM, epi::SplitCtl{slab, cnt, 4u}},
                    nullptr, Fq.out + O_YP, Fq.out + O_YS, A->in[I_GFINAL], modl, 0, 1, nullptr, WSQ(float, WS_SMALL + SM_DT), (unsigned*)(wsq + WS_CTL) + CW_PC + (l * 2 + 1) * 64};
                run_gemm_split(Fq, WSQ(const bf16, WS_T), (const bf16*)(wl + WL_DOWN), DM, D_FF, E, 4, (l * 4 + 3) * 64, 0); }
        if (l + 1 < DEPTH) GRID_BAR(); }
    }
    if (TIME_PHASE >= 0) {
        GRID_BAR();
        const float eps_ = sqrtf(5e-5f + 1e-6f * (float)tacc_ * 0.01f);
        for (int i = blockIdx.x * NTHR + F.tid; i < DEPTH * NS * D_B; i += GRID * NTHR) F.out[O_GVS + i] *= (1.0f + eps_);
    }
#undef A
}

extern "C" void kernel_launch(void* const* d_in, const int* in_sizes, int n_in, void* d_out, int out_size, void* d_ws, size_t ws_size, hipStream_t stream) {
    static int grid = 0;
    if (grid == 0) {
        if (n_in != N_INPUTS || (size_t)out_size != O_END || ws_size < WS_END) { fprintf(stderr, "kernel_launch: unexpected shapes (n_in %d, out %d, ws %zu, need %zu)\n", n_in, out_size, ws_size, (size_t)WS_END); grid = -1; return; }
        int dev = 0, cus = 0, per_cu = 0;
        if (hipGetDevice(&dev) != hipSuccess || hipDeviceGetAttribute(&cus, hipDeviceAttributeMultiprocessorCount, dev) != hipSuccess) { grid = -1; return; }
        if (hipFuncSetAttribute((const void*)mega_fwd, hipFuncAttributeMaxDynamicSharedMemorySize, LDS_BYTES) != hipSuccess) { fprintf(stderr, "kernel_launch: hipFuncSetAttribute failed\n"); grid = -1; return; }
        if (hipOccupancyMaxActiveBlocksPerMultiprocessor(&per_cu, (const void*)mega_fwd, NTHR, LDS_BYTES) != hipSuccess || per_cu < 1) { fprintf(stderr, "kernel_launch: occupancy query reports %d blocks per CU\n", per_cu); (void)hipGetLastError(); grid = -1; return; }
        if (cus * per_cu < GRID) { fprintf(stderr, "kernel_launch: %d CUs x %d blocks cannot hold the %d-workgroup grid\n", cus, per_cu, GRID); grid = -1; return; }
        grid = GRID;
    }
    if (grid < 0) return;
    if (hipMemsetAsync((char*)d_ws + WS_CTL, 0, CTL_ZERO_BYTES, stream) != hipSuccess) return;
    Args a{};
    for (int i = 0; i < N_INPUTS; ++i) a.in[i] = (const float*)d_in[i];
    a.out = (float*)d_out; a.ws = (unsigned char*)d_ws;
    void* params[] = {&a};
    hipError_t e = hipLaunchCooperativeKernel((const void*)mega_fwd, dim3(grid), dim3(NTHR), params, LDS_BYTES, stream);
    if (e != hipSuccess) fprintf(stderr, "kernel_launch: cooperative launch failed: %s (grid %d)\n", hipGetErrorString(e), grid);
}
```

```cpp
#include <hip/hip_runtime.h>
#include <cstdio>
#include <cstdint>
namespace pg8 {
#define PG8_LAS __attribute__((address_space(3)))
typedef unsigned short bf16_t;
typedef short bf16x8 __attribute__((ext_vector_type(8)));
typedef float f32x4 __attribute__((ext_vector_type(4)));
typedef unsigned u32x4 __attribute__((ext_vector_type(4)));
constexpr int BM = 256, BK = 64, HALF = 128, HTB = HALF * BK * 2  , STAGE_BYTES = 8 * HTB, NXCD = 8, WGM = 8;

__host__ __device__ __forceinline__ int lds_byte(int r, int c) { const int st = (r >> 4) * 2 + (c >> 5), rr = r & 15, cc = c & 31, ob = rr * 64 + cc * 2; return st * 1024 + (ob ^ (((ob >> 9) & 1) << 5)); }
__host__ __device__ __forceinline__ void stage_rc(int b, int& R, int& C) { const int st = b / 1024, sb = b % 1024, swz = sb ^ (((sb >> 9) & 1) << 5); R = (st >> 1) * 16 + swz / 64; C = (st & 1) * 32 + (swz % 64) / 2; }
__host__ __device__ __forceinline__ int perm32(int rho) { const int n = rho >> 4, i = rho & 15; return 8 * (i >> 2) + 4 * n + (i & 3); }

struct Unit { int pm, pn, k0, nt, cidx, sid; };
struct Gemm { const bf16_t* A; const bf16_t* Bt; int M, N, K; };

struct StaticOrder {
    int nM, nN, nwg, G, c, ntk;
    __host__ __device__ void init(int M, int N, int G_, int c_, int K_) { nM = M / BM; nN = N / BM; nwg = nM * nN; G = G_; c = c_; ntk = K_ / BK; }
    __host__ __device__ bool next(int i, Unit& u) const {
        const long L = (long)i * G + c; if (L >= nwg) return false;
        int wgid = (int)L; { const int q = nwg / NXCD, r = nwg % NXCD, xcd = wgid % NXCD, off = wgid / NXCD; wgid = (xcd < r ? xcd * (q + 1) : r * (q + 1) + (xcd - r) * q) + off; }
        const int nig = WGM * nN, gid = wgid / nig, fm = gid * WGM, gsz = (nM - fm) < WGM ? (nM - fm) : WGM;
        u.pm = fm + ((wgid % nig) % gsz); u.pn = (wgid % nig) / gsz; u.k0 = 0; u.nt = ntk; u.cidx = -1; u.sid = 0; return true;
    }
    __device__ __forceinline__ void a_ready(const Unit&) const {}
    __device__ __forceinline__ void done(const Unit&) const {}
};
__device__ __forceinline__ unsigned cvt_pk_bf16(float lo, float hi) { unsigned r; asm volatile("s_nop 0\n\tv_cvt_pk_bf16_f32 %0, %1, %2" : "=v"(r) : "v"(lo), "v"(hi)); return r; }
template <class Epi, class Sched, bool ALIGN_EPI = false, bool SP2 = false, bool CHAIN_IN = false>
__device__ __forceinline__ void gemm_phase(PG8_LAS unsigned char* lds, const Gemm g, const Sched& S, const Epi& E, f32x4 (&acc)[2][2][4][2]) {
    int tid_ = threadIdx.x; asm volatile("" : "+v"(tid_));
    const int tid = tid_, wid = __builtin_amdgcn_readfirstlane(tid >> 6), lane = tid & 63, wr = wid >> 2, wc = wid & 3, fr = lane & 15, fq = lane >> 4;
    const int K = g.K;
    unsigned voffA[2], voffB[2];
#pragma unroll
    for (int i = 0; i < 2; ++i) { int R, C; stage_rc(tid * 16 + i * 8192, R, C); const int Rb = Epi::PERM ? ((R & ~31) + perm32(R & 31)) : R;
        voffA[i] = (unsigned)(R * K + C) * 2u; voffB[i] = (unsigned)(Rb * K + C) * 2u; }
    const size_t kstep = (size_t)(BK * 2);
    const size_t hstep = (size_t)HALF * K * 2;
    const size_t tstep = 2 * hstep;
    const unsigned ldsw = (unsigned)wid * 1024u;
    const int aoff = lds_byte(wr * 64 + fr, fq * 8), boff = lds_byte(wc * 32 + fr, fq * 8);
#define PG8_SA(b, h) (((b) * 2 + (h)) * HTB)
#define PG8_SB(b, h) ((4 + (b) * 2 + (h)) * HTB)
#define PG8_STAGE(bufoff, gbase, voff) do { _Pragma("unroll") for (int _i = 0; _i < 2; ++_i) \
        __builtin_amdgcn_global_load_lds((const unsigned*)((const char*)(gbase) + (voff)[_i]), (PG8_LAS unsigned*)(lds + (bufoff) + ldsw + _i * 8192), 16, 0, 0); } while (0)
#define PG8_LDA(dst, b, h) do { _Pragma("unroll") for (int m = 0; m < 4; ++m) _Pragma("unroll") for (int k = 0; k < 2; ++k) dst[m][k] = *(const PG8_LAS bf16x8*)(lds + PG8_SA(b, h) + aoff + m * 2048 + k * 1024); } while (0)
#define PG8_LDB(dst, b, h) do { _Pragma("unroll") for (int n = 0; n < 2; ++n) _Pragma("unroll") for (int k = 0; k < 2; ++k) dst[n][k] = *(const PG8_LAS bf16x8*)(lds + PG8_SB(b, h) + boff + n * 2048 + k * 1024); } while (0)
#define PG8_MMA(ai, bj, At, Bt) do { __builtin_amdgcn_s_setprio(1); _Pragma("unroll") for (int m = 0; m < 4; ++m) _Pragma("unroll") for (int n = 0; n < 2; ++n) _Pragma("unroll") for (int k = 0; k < 2; ++k) \
        acc[ai][bj][m][n] = __builtin_amdgcn_mfma_f32_16x16x32_bf16(Bt[n][k], At[m][k], acc[ai][bj][m][n], 0, 0, 0); __builtin_amdgcn_s_setprio(0); } while (0)
#define PG8_WAIT_V(n) asm volatile("s_waitcnt vmcnt(" #n ")" ::: "memory")
#define PG8_WAIT_L(n) asm volatile("s_waitcnt lgkmcnt(" #n ")" ::: "memory")
#define PG8_BAR __builtin_amdgcn_s_barrier()
#define PG8_SCHED __builtin_amdgcn_sched_barrier(0)
    Unit cur, nxt; int ui = 0;
    if (!S.next(0, cur)) return;
    if constexpr (!CHAIN_IN) {
#pragma unroll
    for (int a = 0; a < 2; ++a)
#pragma unroll
        for (int b = 0; b < 2; ++b)
#pragma unroll
            for (int m = 0; m < 4; ++m)
#pragma unroll
                for (int n = 0; n < 2; ++n) acc[a][b][m][n] = (f32x4){0.f, 0.f, 0.f, 0.f};
    }
    bf16x8 At[4][2], B0[2][2], B1[2][2];
    const char* cA = (const char*)g.A + (size_t)cur.pm * tstep + (size_t)cur.k0 * 2; const char* cB = (const char*)g.Bt + (size_t)cur.pn * tstep + (size_t)cur.k0 * 2;
    S.a_ready(cur);
    if constexpr (SP2) {
        PG8_STAGE(PG8_SB(0, 0), cB, voffB); PG8_STAGE(PG8_SB(0, 1), cB + hstep, voffB); PG8_STAGE(PG8_SA(0, 0), cA, voffA); PG8_STAGE(PG8_SA(0, 1), cA + hstep, voffA);
        if (wr == 1) PG8_BAR;
        PG8_WAIT_V(2); PG8_BAR;
        PG8_STAGE(PG8_SB(1, 0), cB + kstep, voffB); PG8_STAGE(PG8_SA(1, 0), cA + kstep, voffA); PG8_STAGE(PG8_SB(1, 1), cB + hstep + kstep, voffB);
        PG8_WAIT_V(6); PG8_BAR;
    } else {
        PG8_STAGE(PG8_SB(0, 0), cB, voffB); PG8_STAGE(PG8_SA(0, 0), cA, voffA); PG8_STAGE(PG8_SB(0, 1), cB + hstep, voffB); PG8_STAGE(PG8_SA(0, 1), cA + hstep, voffA);
        if (wr == 1) PG8_BAR;
        PG8_WAIT_V(4); PG8_BAR;
        PG8_STAGE(PG8_SB(1, 0), cB + kstep, voffB); PG8_STAGE(PG8_SA(1, 0), cA + kstep, voffA); PG8_STAGE(PG8_SB(1, 1), cB + hstep + kstep, voffB);
        PG8_WAIT_V(6); PG8_BAR;
    }
    for (;;) {
        const bool has_next = S.next(ui + 1, nxt);
        const char* nA = has_next ? (const char*)g.A + (size_t)nxt.pm * tstep + (size_t)nxt.k0 * 2 : cA; const char* nB = has_next ? (const char*)g.Bt + (size_t)nxt.pn * tstep + (size_t)nxt.k0 * 2 : cB;
        const int nt = cur.nt; const bool halfu = cur.cidx >= 0;
        for (int t = 0; t < nt; t += 2) {
            const bool last = (t == nt - 2);
            const char* a1 = cA + (size_t)(t + 1) * kstep;
            const char* a2 = last ? nA : cA + (size_t)(t + 2) * kstep; const char* b2 = last ? nB : cB + (size_t)(t + 2) * kstep;
            const char* a3 = a2 + kstep; const char* b3 = b2 + kstep;
            if (last && has_next) S.a_ready(nxt);
            if constexpr (SP2) {
            PG8_LDB(B0, 0, 0); PG8_LDB(B1, 0, 1); PG8_SCHED; PG8_LDA(At, 0, 0); PG8_STAGE(PG8_SA(1, 1), a1 + hstep, voffA);
            PG8_WAIT_V(8); PG8_WAIT_L(0); PG8_BAR; PG8_MMA(0, 0, At, B0); PG8_MMA(0, 1, At, B1); PG8_BAR; PG8_SCHED;
            PG8_LDA(At, 0, 1); PG8_STAGE(PG8_SB(0, 0), b2, voffB); PG8_STAGE(PG8_SB(0, 1), b2 + hstep, voffB); PG8_STAGE(PG8_SA(0, 0), a2, voffA);
            PG8_WAIT_V(8); PG8_WAIT_L(0); PG8_BAR; if (!halfu) { PG8_MMA(1, 0, At, B0); PG8_MMA(1, 1, At, B1); } PG8_BAR; PG8_SCHED;
            PG8_LDB(B0, 1, 0); PG8_LDB(B1, 1, 1); PG8_SCHED; PG8_LDA(At, 1, 0); PG8_STAGE(PG8_SA(0, 1), a2 + hstep, voffA);
            PG8_WAIT_V(8); PG8_WAIT_L(0); PG8_BAR; PG8_MMA(0, 0, At, B0); PG8_MMA(0, 1, At, B1); PG8_BAR; PG8_SCHED;
            PG8_LDA(At, 1, 1); PG8_STAGE(PG8_SB(1, 0), b3, voffB); PG8_STAGE(PG8_SB(1, 1), b3 + hstep, voffB); PG8_STAGE(PG8_SA(1, 0), a3, voffA);
            PG8_WAIT_V(8); PG8_WAIT_L(0); PG8_BAR; if (!halfu) { PG8_MMA(1, 0, At, B0); PG8_MMA(1, 1, At, B1); } PG8_BAR; PG8_SCHED;
            } else {
            PG8_LDB(B0, 0, 0); PG8_SCHED; PG8_LDA(At, 0, 0); PG8_STAGE(PG8_SA(1, 1), a1 + hstep, voffA);
            PG8_WAIT_L(8); PG8_BAR; PG8_WAIT_L(0); PG8_MMA(0, 0, At, B0); PG8_BAR; PG8_SCHED;
            PG8_LDB(B1, 0, 1); PG8_STAGE(PG8_SB(0, 0), b2, voffB);
            PG8_BAR; PG8_WAIT_L(0); PG8_MMA(0, 1, At, B1); PG8_BAR;
            PG8_LDA(At, 0, 1); PG8_STAGE(PG8_SA(0, 0), a2, voffA);
            PG8_BAR; PG8_WAIT_L(0); PG8_MMA(1, 0, At, B0); PG8_BAR; PG8_SCHED;
            PG8_STAGE(PG8_SB(0, 1), b2 + hstep, voffB);
            PG8_WAIT_V(6); PG8_BAR; PG8_MMA(1, 1, At, B1); PG8_BAR;
            PG8_LDB(B0, 1, 0); PG8_SCHED; PG8_LDA(At, 1, 0); PG8_STAGE(PG8_SA(0, 1), a2 + hstep, voffA);
            PG8_WAIT_L(8); PG8_BAR; PG8_WAIT_L(0); PG8_MMA(0, 0, At, B0); PG8_BAR; PG8_SCHED;
            PG8_LDB(B1, 1, 1); PG8_STAGE(PG8_SB(1, 0), b3, voffB);
            PG8_BAR; PG8_WAIT_L(0); PG8_MMA(0, 1, At, B1); PG8_BAR;
            PG8_LDA(At, 1, 1); PG8_STAGE(PG8_SA(1, 0), a3, voffA);
            PG8_BAR; PG8_WAIT_L(0); PG8_MMA(1, 0, At, B0); PG8_BAR; PG8_SCHED;
            PG8_STAGE(PG8_SB(1, 1), b3 + hstep, voffB);
            PG8_WAIT_V(6); PG8_BAR; PG8_MMA(1, 1, At, B1); PG8_BAR;
            }
        }
        if constexpr (ALIGN_EPI) { if (wr == 0) PG8_BAR; }
        if constexpr (!Epi::AFTER_DRAIN) { int t2 = threadIdx.x; asm volatile("" : "+v"(t2)); const int lane2 = t2 & 63, fr2 = lane2 & 15, fq2 = lane2 >> 4;
            if (cur.cidx < 0) E(acc, cur, wr, wc, fr2, fq2); else E.partial(acc, cur, wr, wc, fr2, fq2, wid, lane2); S.done(cur); }
        else { if (cur.cidx >= 0) { int t2 = threadIdx.x; asm volatile("" : "+v"(t2)); const int lane2 = t2 & 63; E.partial(acc, cur, wr, wc, lane2 & 15, lane2 >> 4, wid, lane2); } }
        if (!has_next) break;
#pragma unroll
        for (int a = 0; a < 2; ++a)
#pragma unroll
            for (int b = 0; b < 2; ++b)
#pragma unroll
                for (int m = 0; m < 4; ++m)
#pragma unroll
                    for (int n = 0; n < 2; ++n) acc[a][b][m][n] = (f32x4){0.f, 0.f, 0.f, 0.f};
        cur = nxt; cA = nA; cB = nB; ++ui;
        if constexpr (ALIGN_EPI) { if (wr == 1) PG8_BAR; }
    }
    PG8_WAIT_V(0);
    if constexpr (!ALIGN_EPI) { if (wr == 0) PG8_BAR; }
    PG8_BAR;
    if constexpr (Epi::AFTER_DRAIN) { E.fused(acc, cur, wr, wc, fr, fq, lds, wid, lane); S.done(cur); }
#undef PG8_SA
#undef PG8_SB
#undef PG8_STAGE
#undef PG8_LDA
#undef PG8_LDB
#undef PG8_MMA
#undef PG8_WAIT_V
#undef PG8_WAIT_L
#undef PG8_BAR
#undef PG8_SCHED
}
template <class Epi, class Sched, bool ALIGN_EPI = false, bool SP2 = false>
__device__ __forceinline__ void gemm_phase(PG8_LAS unsigned char* lds, const Gemm g, const Sched& S, const Epi& E) {
    f32x4 acc[2][2][4][2];
    gemm_phase<Epi, Sched, ALIGN_EPI, SP2, false>(lds, g, S, E, acc);
}

}
constexpr int DM = 2048, NB = 4, SEQ = 2048, NS = 128, DEPTH = 2;
constexpr int MPROMPT = NB * SEQ;
constexpr int MREAL = MPROMPT + NS;
constexpr int MP = 8448;
constexpr int D_A = 512, G_A = 32, P_A = 64, S5G = 16;
constexpr int D_B = 512, H_B = 8, GMC = 128;
constexpr int D_C = 1024, HD_C = 64, H_C = 16, N_C = 128, G_C = 2, K_C = 4, D_XBC = 1536;
constexpr int D_FF = 5632, K_F = 3, D_UP = 2 * D_FF;
constexpr int N_IN = 10256, N_INP = 10240;
constexpr int N_MOD = 6 * DM, MOD_PITCH = 2 * N_MOD;
constexpr float EPS = 1e-6f;
constexpr int PC_UA = 0, PC_UB = 512, PC_VB = 1024, PC_Z = 1536, PC_XBC = 2560, PC_GA = 4096, PC_GB = 6144, PC_GC = 8192;
constexpr int S5Q = 64, S5NC = SEQ / S5Q;
constexpr int SSDQ = 128, SSDNC = SEQ / SSDQ;

enum { I_XP = 0, I_XS, I_CP, I_CS, I_S5RE, I_S5IM, I_SSM, I_SSDCONV, I_FFNCONV, I_WMOD, I_BMOD, I_GMIX, I_WIN, I_LAMRE, I_LAMIM, I_LOGDT,
       I_BRE, I_BIM, I_CRE, I_CIM, I_S5D, I_WGLU, I_GV, I_WS, I_BS, I_CONVW, I_CONVB, I_DTBIAS, I_ALOG, I_SSDD, I_GNORM, I_WPA, I_WPB, I_WPC,
       I_WOUT, I_GFFN, I_WUP, I_FCONVW, I_FCONVB, I_WDOWN, I_GFINAL, N_INPUTS };
constexpr size_t O_YP = 0, O_YS = 16777216, O_S5RP = 17039360, O_S5IP = 17055744, O_SSMP = 17072128, O_CCP = 18120704, O_CFP = 18157568,
                 O_S5RS = 18337792, O_S5IS = 18862080, O_SSMS = 19386368, O_CCS = 52940800, O_CFS = 54120448, O_GVS = 59887616, O_END = 60018688;

constexpr size_t MiB = 1u << 20;
constexpr size_t WS_CTL = 0, CTL_ZERO_BYTES = 1 * MiB;
constexpr size_t SZ_WIN = (size_t)N_INP * DM * 2, SZ_WGLU = 512 * 512 * 2, SZ_WPA = (size_t)DM * 512 * 2, SZ_WPC = (size_t)DM * 1024 * 2,
                 SZ_WOUT = (size_t)DM * DM * 2, SZ_WUP = (size_t)D_UP * DM * 2, SZ_WDOWN = (size_t)DM * D_FF * 2;
constexpr size_t WL_IN = 0, WL_GLU = WL_IN + SZ_WIN, WL_PA = WL_GLU + SZ_WGLU, WL_PB = WL_PA + SZ_WPA, WL_PC = WL_PB + SZ_WPA, WL_OUT = WL_PC + SZ_WPC,
                 WL_UP = WL_OUT + SZ_WOUT, WL_DOWN = WL_UP + SZ_WUP, WL_END = WL_DOWN + SZ_WDOWN;
constexpr size_t WS_W = 2 * MiB;
constexpr size_t WS_SMALL = WS_W + 2 * WL_END;
constexpr size_t SM_WS = 0;
constexpr size_t SM_S5BB = SM_WS + 2 * 8 * 128 * 128 * 2;
constexpr size_t SM_S5CT = SM_S5BB + 2 * 32 * 64 * 32 * 4;
constexpr size_t SM_S5A = SM_S5CT + 2 * 32 * 16 * 128 * 2;
constexpr size_t SM_DT = SM_S5A + 2 * 32 * 64 * 4 * 4;
constexpr size_t SM_VSQ = SM_DT + (size_t)MP * 16 * 4;
constexpr size_t SM_CSQ = SM_VSQ + (size_t)2 * MP * 4;
constexpr size_t SM_SLOC = SM_CSQ + (size_t)2 * MP * 4;
constexpr size_t SM_SDEC = SM_SLOC + (size_t)NB * G_A * S5NC * 128 * 4;
constexpr size_t SM_CSILU = SM_SDEC + 4096;
constexpr size_t SM_WDT = SM_CSILU + 256 * 2048 * 2;
constexpr size_t SM_END = SM_WDT + (size_t)2 * 16 * DM * 4;
constexpr size_t WS_MOD = (WS_SMALL + SM_END + 4095) / 4096 * 4096;
constexpr size_t WS_X0 = WS_MOD + (size_t)2 * 256 * N_MOD * 4;
constexpr size_t WS_X1 = WS_X0 + (size_t)MP * DM * 4;
constexpr size_t WS_H = WS_X1 + (size_t)MP * DM * 4;
constexpr size_t WS_BIG = WS_H + (size_t)MP * DM * 2;
constexpr size_t WS_T = WS_BIG + (size_t)MP * D_UP * 2;
constexpr size_t WS_MERGED = WS_T + (size_t)MP * DM * 4;
constexpr size_t WS_OA = WS_MERGED + (size_t)MP * DM * 2;
constexpr size_t WS_OB = WS_OA + (size_t)MP * 512 * 2;
constexpr size_t WS_YB = WS_OB + (size_t)MP * 512 * 2;
constexpr size_t WS_OC = WS_YB + (size_t)MP * 512 * 2;
constexpr size_t WS_STATES = WS_OC + (size_t)MP * 1024 * 2;
constexpr size_t WS_SLAB = WS_STATES + (size_t)NB * SSDNC * H_C * HD_C * N_C * 4;
constexpr size_t WS_HALO = WS_SLAB + (size_t)176 * 131072;
constexpr size_t WS_END = WS_HALO + (size_t)33 * 4 * D_UP * 4;
static_assert((size_t)MP * D_FF * 2 <= (size_t)MP * DM * 6, "ACT overlays T+MERGED");
constexpr int CW_PC = 12288;
constexpr int CW_S5F = 20480;
constexpr int CW_SSDF = 16384;
constexpr int CW_BAR = 4096, CW_CNT = 8192;
struct Args { const float* in[N_INPUTS]; float* out; unsigned char* ws; };
typedef const __attribute__((address_space(4))) Args* KArgs;
__device__ __forceinline__ KArgs launder_args(KArgs a) { unsigned long long t = (unsigned long long)a; asm volatile("" : "+s"(t)); return (KArgs)t; }
#define GAS __attribute__((address_space(1)))
#define LAS __attribute__((address_space(3)))
typedef unsigned short bf16;
typedef unsigned v4u __attribute__((ext_vector_type(4)));
typedef unsigned v2u __attribute__((ext_vector_type(2)));
typedef float f32x4 __attribute__((ext_vector_type(4)));
typedef float f32x2 __attribute__((ext_vector_type(2)));
typedef short bf16x8 __attribute__((ext_vector_type(8)));
typedef short bf16x4 __attribute__((ext_vector_type(4)));
typedef GAS unsigned gu32;
#define RLX_AGENT __ATOMIC_RELAXED, __HIP_MEMORY_SCOPE_AGENT
#define LDS_WAIT() asm volatile("s_waitcnt lgkmcnt(0)" ::: "memory")
#define VM_WAIT() asm volatile("s_waitcnt vmcnt(0)" ::: "memory")
constexpr int NWAVES = 8, NTHR = 512, GRID = 256;
__device__ __forceinline__ unsigned f2bf(float f) { unsigned u = __builtin_bit_cast(unsigned, f); return (u + 0x7fffu + ((u >> 16) & 1u)) >> 16; }
__device__ __forceinline__ unsigned pk2(float lo, float hi) { return f2bf(lo) | (f2bf(hi) << 16); }
__device__ __forceinline__ float bf2f(unsigned short b) { return __builtin_bit_cast(float, (unsigned)b << 16); }
__device__ __forceinline__ float bflo(unsigned w) { return __builtin_bit_cast(float, w << 16); }
__device__ __forceinline__ float bfhi(unsigned w) { return __builtin_bit_cast(float, w & 0xffff0000u); }
__device__ __forceinline__ float sigmoidf_(float x) { return __builtin_amdgcn_rcpf(1.0f + __expf(-x)); }
__device__ __forceinline__ float siluf_(float x) { return x * __builtin_amdgcn_rcpf(1.0f + __expf(-x)); }
__device__ __forceinline__ float gelu_tanh(float x) {
    const float u = 0.7978845608028654f * (x + 0.044715f * x * x * x);
    const float e = __expf(2.0f * u);
    const float t = 1.0f - 2.0f * __builtin_amdgcn_rcpf(e + 1.0f);
    return 0.5f * x * (1.0f + t);
}
__device__ __forceinline__ float softplusf_(float x) { return fmaxf(x, 0.f) + __logf(1.0f + __expf(-fabsf(x))); }
template <int M> __device__ __forceinline__ float xor_lt32(float x) {
    return __builtin_bit_cast(float, __builtin_amdgcn_ds_swizzle(__builtin_bit_cast(int, x), (M << 10) | 0x1f)); }
__device__ __forceinline__ float add_xor32(float x) {
    const unsigned b = __builtin_bit_cast(unsigned, x); const auto r = __builtin_amdgcn_permlane32_swap(b, b, false, false);
    return __builtin_bit_cast(float, (unsigned)r[0]) + __builtin_bit_cast(float, (unsigned)r[1]); }
__device__ __forceinline__ float wave_sum(float v) {
    v += xor_lt32<1>(v); v += xor_lt32<2>(v); v += xor_lt32<4>(v); v += xor_lt32<8>(v); v += xor_lt32<16>(v);
    return add_xor32(v);
}
__device__ __forceinline__ float wave_sum16(const float (&a)[16], int lane) {
    float b[8], c[4], d[2];
    const bool o1 = lane & 1, o2 = lane & 2, o4 = lane & 4, o8 = lane & 8;
#pragma unroll
    for (int i = 0; i < 8; ++i) { const float keep = o1 ? a[2 * i + 1] : a[2 * i], send = o1 ? a[2 * i] : a[2 * i + 1]; b[i] = keep + xor_lt32<1>(send); }
#pragma unroll
    for (int i = 0; i < 4; ++i) { const float keep = o2 ? b[2 * i + 1] : b[2 * i], send = o2 ? b[2 * i] : b[2 * i + 1]; c[i] = keep + xor_lt32<2>(send); }
#pragma unroll
    for (int i = 0; i < 2; ++i) { const float keep = o4 ? c[2 * i + 1] : c[2 * i], send = o4 ? c[2 * i] : c[2 * i + 1]; d[i] = keep + xor_lt32<4>(send); }
    const float keep = o8 ? d[1] : d[0], send = o8 ? d[0] : d[1];
    float e = keep + xor_lt32<8>(send);
    e += xor_lt32<16>(e);
    return add_xor32(e);
}
__device__ __forceinline__ float half_sum32(const float (&a)[32], int lane) {
    float b[16], c[8], d[4], e[2];
    const bool o1 = lane & 1, o2 = lane & 2, o4 = lane & 4, o8 = lane & 8, o16 = lane & 16;
#pragma unroll
    for (int i = 0; i < 16; ++i) { const float keep = o1 ? a[2 * i + 1] : a[2 * i], send = o1 ? a[2 * i] : a[2 * i + 1]; b[i] = keep + xor_lt32<1>(send); }
#pragma unroll
    for (int i = 0; i < 8; ++i) { const float keep = o2 ? b[2 * i + 1] : b[2 * i], send = o2 ? b[2 * i] : b[2 * i + 1]; c[i] = keep + xor_lt32<2>(send); }
#pragma unroll
    for (int i = 0; i < 4; ++i) { const float keep = o4 ? c[2 * i + 1] : c[2 * i], send = o4 ? c[2 * i] : c[2 * i + 1]; d[i] = keep + xor_lt32<4>(send); }
#pragma unroll
    for (int i = 0; i < 2; ++i) { const float keep = o8 ? d[2 * i + 1] : d[2 * i], send = o8 ? d[2 * i] : d[2 * i + 1]; e[i] = keep + xor_lt32<8>(send); }
    const float keep = o16 ? e[1] : e[0], send = o16 ? e[0] : e[1];
    return keep + xor_lt32<16>(send);
}
__device__ __forceinline__ float lane_bcast(float x, int src) {
    return __builtin_bit_cast(float, __builtin_amdgcn_readlane(__builtin_bit_cast(int, x), src)); }
__device__ __forceinline__ int mod_row(int r) { return r < MPROMPT ? (r >> 11) : (r < MREAL ? 4 + (r - MPROMPT) : 4 + NS - 1); }

template <int MODE>
__device__ __forceinline__ void prep_row(const bf16* xrow, const float* g, const float* mr, int sh_idx, int sc_idx, bf16* hrow, float* yrow, float* dtrow, const LAS float* wT, int lane) {
    const GAS v2u* xr = (const GAS v2u*)xrow + lane;
    f32x4 v[8]; float s = 0.f;
#pragma unroll
    for (int j = 0; j < 8; ++j) { const v2u w = xr[64 * j]; v[j] = (f32x4){bflo(w.x), bfhi(w.x), bflo(w.y), bfhi(w.y)}; s += (v[j].x * v[j].x + v[j].y * v[j].y) + (v[j].z * v[j].z + v[j].w * v[j].w); }
    const float rinv = rsqrtf(wave_sum(s) * (1.0f / DM) + EPS);
    const GAS f32x4* gp = (const GAS f32x4*)g + lane;
    if (MODE == 2) { GAS f32x4* o = (GAS f32x4*)yrow + lane;
#pragma unroll
        for (int j = 0; j < 8; ++j) o[64 * j] = v[j] * rinv * gp[64 * j];
        return; }
    const GAS f32x4* shp = (const GAS f32x4*)(mr + sh_idx * DM) + lane; const GAS f32x4* scp = (const GAS f32x4*)(mr + sc_idx * DM) + lane;
    GAS v2u* o = (GAS v2u*)hrow + lane;
#pragma unroll
    for (int j = 0; j < 8; ++j) { const f32x4 gg = gp[64 * j], sh = shp[64 * j], sc = scp[64 * j];
        v[j] = v[j] * rinv * gg * (sc + 1.0f) + sh;
        v2u w; w.x = pk2(v[j].x, v[j].y); w.y = pk2(v[j].z, v[j].w); o[64 * j] = w; }
    if (MODE == 1) {
        float a16[16];
#pragma unroll
        for (int hh = 0; hh < 16; ++hh) { float a = 0.f;
#pragma unroll
            for (int j = 0; j < 8; ++j) { const f32x4 w = *(const LAS f32x4*)(wT + hh * DM + 4 * lane + 256 * j); a += (v[j].x * w.x + v[j].y * w.y) + (v[j].z * w.z + v[j].w * w.w); }
            a16[hh] = a; }
        const float mine = wave_sum16(a16, lane);
        if (lane < 16) dtrow[lane] = mine;
    }
}

template <int MODE>
__device__ __forceinline__ void prep_rows4(const bf16* x0, const float* g, const float* mr, int sh_idx, int sc_idx, bf16* h0, float* y0, float* dt0, const LAS float* wT, int lane) {
    f32x4 v[4][8];
#pragma unroll
    for (int q = 0; q < 4; ++q) { const GAS v2u* xr = (const GAS v2u*)(x0 + (size_t)q * DM) + lane;
#pragma unroll
        for (int j = 0; j < 8; ++j) { const v2u w = xr[64 * j]; v[q][j] = (f32x4){bflo(w.x), bfhi(w.x), bflo(w.y), bfhi(w.y)}; } }
    f32x4 gm[8], sh[8];
    {   const GAS f32x4* gp = (const GAS f32x4*)g + lane;
        if (MODE == 2) {
#pragma unroll
            for (int j = 0; j < 8; ++j) gm[j] = gp[64 * j];
        } else { const GAS f32x4* shp = (const GAS f32x4*)(mr + sh_idx * DM) + lane; const GAS f32x4* scp = (const GAS f32x4*)(mr + sc_idx * DM) + lane;
#pragma unroll
            for (int j = 0; j < 8; ++j) { gm[j] = gp[64 * j] * (scp[64 * j] + 1.0f); sh[j] = shp[64 * j]; } } }
#pragma unroll
    for (int q = 0; q < 4; ++q) { float s = 0.f;
#pragma unroll
        for (int j = 0; j < 8; ++j) s += (v[q][j].x * v[q][j].x + v[q][j].y * v[q][j].y) + (v[q][j].z * v[q][j].z + v[q][j].w * v[q][j].w);
        const float rinv = rsqrtf(wave_sum(s) * (1.0f / DM) + EPS);
        if (MODE == 2) { GAS f32x4* o = (GAS f32x4*)(y0 + (size_t)q * DM) + lane;
#pragma unroll
            for (int j = 0; j < 8; ++j) o[64 * j] = v[q][j] * rinv * gm[j];
        } else { GAS v2u* o = (GAS v2u*)(h0 + (size_t)q * DM) + lane;
#pragma unroll
            for (int j = 0; j < 8; ++j) { v[q][j] = v[q][j] * rinv * gm[j] + sh[j]; v2u w; w.x = pk2(v[q][j].x, v[q][j].y); w.y = pk2(v[q][j].z, v[q][j].w); o[64 * j] = w; }
        }
    }
    if (MODE == 1) {
#pragma unroll
        for (int pr = 0; pr < 2; ++pr) { float a16[2][16];
#pragma unroll
            for (int hh = 0; hh < 16; ++hh) { float a0 = 0.f, a1 = 0.f;
#pragma unroll
                for (int j = 0; j < 8; ++j) { const f32x4 w = *(const LAS f32x4*)(wT + hh * DM + 4 * lane + 256 * j);
                    a0 += (v[2 * pr][j].x * w.x + v[2 * pr][j].y * w.y) + (v[2 * pr][j].z * w.z + v[2 * pr][j].w * w.w);
                    a1 += (v[2 * pr + 1][j].x * w.x + v[2 * pr + 1][j].y * w.y) + (v[2 * pr + 1][j].z * w.z + v[2 * pr + 1][j].w * w.w); }
                a16[0][hh] = a0; a16[1][hh] = a1; }
            { const float m0 = wave_sum16(a16[0], lane), m1 = wave_sum16(a16[1], lane); if (lane < 16) { dt0[(2 * pr) * 16 + lane] = m0; dt0[(2 * pr + 1) * 16 + lane] = m1; } } }
    }
}
#define XB_TMO      128
#define XB_XCNT(j)  (256  + 64 * (j))
#define XB_XSUB(j)  (1280 + 64 * (j))
#define XB_XGEN(j)  (2304 + 64 * (j))
#define XB_TOP      3328
#define XB_TOPGEN   3392
#define XCD_BAR_WORDS 3456
#define XB_SPIN_CAP (1u << 18)

__device__ __forceinline__ unsigned xb_ld(unsigned* p)              { return __hip_atomic_load(p, __ATOMIC_RELAXED, __HIP_MEMORY_SCOPE_AGENT); }
__device__ __forceinline__ unsigned xb_add(unsigned* p, unsigned v) { return __hip_atomic_fetch_add(p, v, __ATOMIC_RELAXED, __HIP_MEMORY_SCOPE_AGENT); }
__device__ __forceinline__ unsigned xb_xcc_id() { return (unsigned)__builtin_amdgcn_s_getreg((3 << 11) | 20) & 0xFu; }
#define XB_SPIN(cond, bar) do { unsigned _sp = 0; while (cond) { __builtin_amdgcn_s_sleep(1); \
    if ((++_sp & 255u) == 0u) { if (xb_ld(&(bar)[XB_TMO])) break; if (_sp > XB_SPIN_CAP) { atomicAdd(&(bar)[XB_TMO], 1u); break; } } } } while (0)

struct XcdBarrier {
    unsigned* bar; unsigned x;
    volatile LAS unsigned* st;
};

__device__ __forceinline__ XcdBarrier xcd_barrier_post(unsigned* bar, volatile LAS unsigned* st) {
    XcdBarrier b; b.bar = bar; b.x = xb_xcc_id(); b.st = st;
    if (threadIdx.x == 0) (void)xb_add(&bar[XB_XCNT(b.x)], 1u);
    return b;
}
__device__ __forceinline__ void xcd_barrier_complete(unsigned* bar, unsigned x, unsigned& nloc, unsigned& nx) {
    const unsigned G = gridDim.x * gridDim.y * gridDim.z;
    unsigned sum, cnt, mine, sp = 0u;
    for (;;) {
        sum = 0u; cnt = 0u; mine = 0u;
#pragma unroll
        for (unsigned j = 0; j < 16; ++j) { const unsigned c = xb_ld(&bar[XB_XCNT(j)]); sum += c; cnt += (c > 0u) ? 1u : 0u; mine = (j == x) ? c : mine; }
        if (sum == G) break;
        __builtin_amdgcn_s_sleep(1);
        if ((++sp & 255u) == 0u) { if (xb_ld(&bar[XB_TMO])) break; if (sp > XB_SPIN_CAP) { atomicAdd(&bar[XB_TMO], 1u); break; } }
    }
    nloc = mine > 0u ? mine : 1u; nx = cnt > 0u ? cnt : 1u;
}

__device__ __forceinline__ void xcd_barrier(const XcdBarrier& b) {
    asm volatile("s_waitcnt vmcnt(0)" ::: "memory");
    __syncthreads();
    if (threadIdx.x == 0) {
        unsigned* bar = b.bar;
        __builtin_amdgcn_s_waitcnt(0);
        unsigned nloc = b.st[0], nx = b.st[1];
        if (nloc == 0u) { xcd_barrier_complete(bar, b.x, nloc, nx); b.st[0] = nloc; b.st[1] = nx; }
        const unsigned old = xb_add(&bar[XB_XSUB(b.x)], 1u);
        const unsigned gen = old / nloc;
        if (old + 1u == (gen + 1u) * nloc) {
            __builtin_amdgcn_fence(__ATOMIC_RELEASE, "agent");
            asm volatile("s_waitcnt vmcnt(0)" ::: "memory");
            const unsigned og = xb_add(&bar[XB_TOP], 1u);
            const unsigned tg = og / nx;
            if (og + 1u == (tg + 1u) * nx) xb_add(&bar[XB_TOPGEN], 1u);
            else XB_SPIN(xb_ld(&bar[XB_TOPGEN]) == tg, bar);
            __builtin_amdgcn_fence(__ATOMIC_ACQUIRE, "agent");
            xb_add(&bar[XB_XGEN(b.x)], 1u);
            asm volatile("s_waitcnt vmcnt(0)" ::: "memory");
        } else {
            XB_SPIN(xb_ld(&bar[XB_XGEN(b.x)]) == gen, bar);
            __builtin_amdgcn_fence(__ATOMIC_ACQUIRE, "agent");
            asm volatile("s_waitcnt vmcnt(0)" ::: "memory");
        }
    }
    __syncthreads();
}

namespace epi {
using pg8::Unit; using pg8::f32x4; using pg8::u32x4; using pg8::cvt_pk_bf16;
typedef unsigned u32x2 __attribute__((ext_vector_type(2)));
constexpr int BM = 256, HALF = 128;

constexpr int SLAB_F4 = 8 * 16 * 64;
constexpr int SLAB_BYTES_ALL = 176 * 131072;
typedef unsigned v4u_ __attribute__((ext_vector_type(4)));
template <bool PERM> __device__ __forceinline__ int split_col(const Unit& u, int wc, int fq, int bj, int n) { return u.pn * BM + bj * HALF + wc * 32 + (PERM ? 8 * fq + 4 * n : 16 * n + 4 * fq); }
__device__ __forceinline__ __amdgpu_buffer_rsrc_t slab_rsrc(const f32x4* SLAB) { return __builtin_amdgcn_make_buffer_rsrc((void*)SLAB, (short)0, SLAB_BYTES_ALL, 0x00020000); }
__device__ __forceinline__ void split_store(const f32x4 (&acc)[2][2][4][2], f32x4* SLAB, int sid, int wid, int lane) {
    asm volatile("" : "+v"(lane));
    const __amdgpu_buffer_rsrc_t rs = slab_rsrc(SLAB);
    const unsigned vo = (unsigned)(wid * 16 * 64 + lane) * 16u, so = (unsigned)sid * (unsigned)(SLAB_F4 * 16);
#pragma unroll
    for (int m = 0; m < 4; ++m)
#pragma unroll
        for (int bj = 0; bj < 2; ++bj)
#pragma unroll
            for (int n = 0; n < 2; ++n) __builtin_amdgcn_raw_buffer_store_b128(__builtin_bit_cast(v4u_, acc[0][bj][m][n]), rs, vo + (unsigned)(((m * 2 + bj) * 2 + n) * 64 * 16), so,   16);
}
__device__ __forceinline__ bool split_arrive(unsigned* cnt, unsigned target, int lane) {
    asm volatile("s_waitcnt vmcnt(0)" ::: "memory");
    unsigned old = 0u;
    if (lane == 0) old = __hip_atomic_fetch_add(cnt, 1u, __ATOMIC_RELAXED, __HIP_MEMORY_SCOPE_AGENT);
    old = __builtin_amdgcn_readlane(old, 0);
    asm volatile("" ::: "memory");
    if (old != target - 1u) return false;
    __builtin_amdgcn_fence(__ATOMIC_ACQUIRE, "agent"); asm volatile("s_waitcnt vmcnt(0)" ::: "memory");
    return true;
}
__device__ __forceinline__ f32x4 slab_ld(const __amdgpu_buffer_rsrc_t rs, unsigned vo, unsigned so) { return __builtin_bit_cast(f32x4, __builtin_amdgcn_raw_buffer_load_b128(rs, vo, so,   16)); }
__device__ __forceinline__ f32x4 split_sum1(const f32x4* SLAB, int sid0, int ns, int wid, int lane, int reg) {
    const __amdgpu_buffer_rsrc_t rs = slab_rsrc(SLAB);
    const unsigned vo = (unsigned)((wid * 16 + reg) * 64 + lane) * 16u;
    f32x4 s = slab_ld(rs, vo, (unsigned)sid0 * (unsigned)(SLAB_F4 * 16));
    for (int j = 1; j < ns; ++j) s = s + slab_ld(rs, vo, (unsigned)(sid0 + j) * (unsigned)(SLAB_F4 * 16));
    return s;
}
__device__ __forceinline__ void split_sum(f32x4 (&acc)[2][2][4][2], const f32x4* SLAB, int sid0, int ns, int wid, int lane) {
    asm volatile("" : "+v"(lane));
    const __amdgpu_buffer_rsrc_t rs = slab_rsrc(SLAB);
    const unsigned vo = (unsigned)(wid * 16 * 64 + lane) * 16u;
#pragma unroll
    for (int m = 0; m < 4; ++m)
#pragma unroll
        for (int bj = 0; bj < 2; ++bj) {
            const unsigned vr = vo + (unsigned)((m * 2 + bj) * 2) * 1024u;
            unsigned so = (unsigned)sid0 * (unsigned)(SLAB_F4 * 16);
            f32x4 s0 = {0.f, 0.f, 0.f, 0.f}, s1 = s0;
            int j = 0;
#pragma unroll 1
            for (; j + 4 <= ns; j += 4) {
                f32x4 t[4][2];
#pragma unroll
                for (int q = 0; q < 4; ++q) { const unsigned sq = so + (unsigned)q * (unsigned)(SLAB_F4 * 16); t[q][0] = slab_ld(rs, vr, sq); t[q][1] = slab_ld(rs, vr + 1024u, sq); }
#pragma unroll
                for (int q = 0; q < 4; ++q) { s0 = s0 + t[q][0]; s1 = s1 + t[q][1]; }
                so += 4u * (unsigned)(SLAB_F4 * 16); }
#pragma unroll 1
            for (; j < ns; ++j) { s0 = s0 + slab_ld(rs, vr, so); s1 = s1 + slab_ld(rs, vr + 1024u, so); so += (unsigned)(SLAB_F4 * 16); }
            acc[0][bj][m][0] = s0; acc[0][bj][m][1] = s1;
            asm volatile("" ::: "memory");
        }
}
__device__ __forceinline__ void split_zero_pad(f32x4 (&acc)[2][2][4][2]) {
#pragma unroll
    for (int bj = 0; bj < 2; ++bj)
#pragma unroll
        for (int m = 0; m < 4; ++m)
#pragma unroll
            for (int n = 0; n < 2; ++n) acc[1][bj][m][n] = (f32x4){0.f, 0.f, 0.f, 0.f};
}
struct SplitCtl { f32x4* SLAB; unsigned* cnt; unsigned nsl; int fin0, cbase; };
__device__ __forceinline__ void split_post(unsigned* cnt, int lane) {
    asm volatile("s_waitcnt vmcnt(0)" ::: "memory");
    if (lane == 0) __hip_atomic_fetch_add(cnt, 1u, __ATOMIC_RELAXED, __HIP_MEMORY_SCOPE_AGENT);
}
__device__ __forceinline__ void split_wait(unsigned* cnt, unsigned target, int lane) {
    if (lane == 0) { unsigned sp_ = 0; while (__hip_atomic_load(cnt, __ATOMIC_RELAXED, __HIP_MEMORY_SCOPE_AGENT) < target && ++sp_ < (1u << 22)) __builtin_amdgcn_s_sleep(2); }
    asm volatile("" ::: "memory");
    __builtin_amdgcn_fence(__ATOMIC_ACQUIRE, "agent"); asm volatile("s_waitcnt vmcnt(0)" ::: "memory");
}
__device__ __forceinline__ int opaque_bx() { int b = (int)blockIdx.x; asm volatile("" : "+s"(b)); return b; }
__device__ __forceinline__ Unit final_unit(int f, int cbase) { Unit u; u.pm = MPROMPT / 256; u.pn = f; u.k0 = 0; u.nt = 0; u.cidx = cbase + f; u.sid = 0; return u; }

struct EpiIn {
    static constexpr bool PERM = true, AFTER_DRAIN = false;
    bf16* O; float* vsq; SplitCtl sp;
    template <int ACT> __device__ __forceinline__ void run(const f32x4 (&acc)[2][2][4][2], const Unit& u, int wr, int wc, int fr, int fq, bool dosq) const {
        const int row0 = u.pm * BM + wr * 64 + fr, col0 = u.pn * BM + wc * 32 + 8 * fq;
#pragma unroll
        for (int ai = 0; ai < 2; ++ai)
#pragma unroll
            for (int m = 0; m < 4; ++m) { const int row = row0 + ai * HALF + m * 16; bf16* rowp = O + (size_t)row * N_INP + col0; float sq = 0.f;
#pragma unroll
                for (int bj = 0; bj < 2; ++bj) { f32x4 v0 = acc[ai][bj][m][0], v1 = acc[ai][bj][m][1];
#pragma unroll
                    for (int j = 0; j < 4; ++j) {
                        if (ACT == 1) { v0[j] = gelu_tanh(v0[j]); v1[j] = gelu_tanh(v1[j]); }
                        if (ACT == 2) { v0[j] = sigmoidf_(v0[j]); v1[j] = sigmoidf_(v1[j]); }
                        sq += v0[j] * v0[j] + v1[j] * v1[j]; }
                    u32x4 w; w.x = cvt_pk_bf16(v0[0], v0[1]); w.y = cvt_pk_bf16(v0[2], v0[3]); w.z = cvt_pk_bf16(v1[0], v1[1]); w.w = cvt_pk_bf16(v1[2], v1[3]);
                    *(GAS u32x4*)(rowp + bj * HALF) = w; }
                if (ACT == 1) { if (dosq && vsq) { sq += xor_lt32<16>(sq); sq = add_xor32(sq); if (fq == 0) atomicAdd(vsq + row, sq); } }
            }
    }
    __device__ __forceinline__ void operator()(const f32x4 (&acc)[2][2][4][2], const Unit& u, int wr, int wc, int fr, int fq) const {
        const int pn = u.pn;
        if (pn >= 16) run<2>(acc, u, wr, wc, fr, fq, false);
        else if (pn >= 2 && pn < 6) run<1>(acc, u, wr, wc, fr, fq, pn >= 4);
        else run<0>(acc, u, wr, wc, fr, fq, false);
    }
    __device__ __forceinline__ void partial(f32x4 (&acc)[2][2][4][2], const Unit& u, int wr, int wc, int fr, int fq, int wid, int lane) const {
        split_store(acc, sp.SLAB, u.sid, wid, lane); split_post(sp.cnt + u.cidx * 8 + wid, lane);
    }
    __device__ __forceinline__ void final(const Unit& u, int wr, int wc, int fr, int fq, int wid, int lane) const {
        f32x4 acc[2][2][4][2];
        split_wait(sp.cnt + u.cidx * 8 + wid, sp.nsl, lane);
        split_sum(acc, sp.SLAB, u.pn * (int)sp.nsl, (int)sp.nsl, wid, lane); split_zero_pad(acc); (*this)(acc, u, wr, wc, fr, fq);
    }
};
struct EpiBf16Plain {
    static constexpr bool PERM = true, AFTER_DRAIN = false;
    bf16* O; int ldc;
    __device__ __forceinline__ void partial(f32x4 (&)[2][2][4][2], const Unit&, int, int, int, int, int, int) const {}
    __device__ __forceinline__ void operator()(const f32x4 (&acc)[2][2][4][2], const Unit& u, int wr, int wc, int fr, int fq) const {
        const int row0 = u.pm * BM + wr * 64 + fr, col0 = u.pn * BM + wc * 32 + 8 * fq;
#pragma unroll
        for (int ai = 0; ai < 2; ++ai)
#pragma unroll
            for (int m = 0; m < 4; ++m) { bf16* rowp = O + (size_t)(row0 + ai * HALF + m * 16) * ldc + col0;
#pragma unroll
                for (int bj = 0; bj < 2; ++bj) { const f32x4 v0 = acc[ai][bj][m][0], v1 = acc[ai][bj][m][1];
                    u32x4 w; w.x = cvt_pk_bf16(v0[0], v0[1]); w.y = cvt_pk_bf16(v0[2], v0[3]); w.z = cvt_pk_bf16(v1[0], v1[1]); w.w = cvt_pk_bf16(v1[2], v1[3]);
                    *(GAS u32x4*)(rowp + bj * HALF) = w; } }
    }
};
__device__ __forceinline__ float dpp_ror1(float x) { return __builtin_bit_cast(float, __builtin_amdgcn_update_dpp(0, __builtin_bit_cast(int, x), 0x121, 0xf, 0xf, false)); }
__device__ __forceinline__ float dpp_ror2(float x) { return __builtin_bit_cast(float, __builtin_amdgcn_update_dpp(0, __builtin_bit_cast(int, x), 0x122, 0xf, 0xf, false)); }
__device__ __forceinline__ float dpp_shr1(float old, float x) { return __builtin_bit_cast(float, __builtin_amdgcn_update_dpp(__builtin_bit_cast(int, old), __builtin_bit_cast(int, x), 0x111, 0xf, 0xf, false)); }
__device__ __forceinline__ float dpp_shr2(float old, float x) { return __builtin_bit_cast(float, __builtin_amdgcn_update_dpp(__builtin_bit_cast(int, old), __builtin_bit_cast(int, x), 0x112, 0xf, 0xf, false)); }
struct EpiUpConv {
    static constexpr bool PERM = true, AFTER_DRAIN = false;
    bf16* ACT; float* HALO; const float* cw; const float* cb; const float* st; float* cfs; LAS float* EX; int dry;
    __device__ __forceinline__ void partial(f32x4 (&)[2][2][4][2], const Unit&, int, int, int, int, int, int) const {}
    __device__ __forceinline__ void operator()(const f32x4 (&acc)[2][2][4][2], const Unit& u, int wr, int wc, int fr, int fq) const {
        asm volatile("" : "+v"(fr), "+v"(fq));
        if (dry) {
#pragma unroll
            for (int ai = 0; ai < 2; ++ai)
#pragma unroll
                for (int bj = 0; bj < 2; ++bj)
#pragma unroll
                    for (int m = 0; m < 4; ++m)
#pragma unroll
                        for (int n = 0; n < 2; ++n) asm volatile("" :: "v"(acc[ai][bj][m][n]));
            return; }
        const int cl = wc * 32 + 8 * fq;
        if (u.pm == MPROMPT / 256) {
#pragma unroll
            for (int n = 0; n < 2; ++n) { const int c = u.pn * 128 + cl + 4 * n;
                f32x4 wa0, wa1, wa2, wb0, wb1, wb2, ba, bb;
                wa0 = *(const GAS f32x4*)(cw + c); wa1 = *(const GAS f32x4*)(cw + D_UP + c); wa2 = *(const GAS f32x4*)(cw + 2 * D_UP + c); wb0 = *(const GAS f32x4*)(cw + D_FF + c); wb1 = *(const GAS f32x4*)(cw + D_UP + D_FF + c); wb2 = *(const GAS f32x4*)(cw + 2 * D_UP + D_FF + c);
                ba = *(const GAS f32x4*)(cb + c); bb = *(const GAS f32x4*)(cb + D_FF + c);
#pragma unroll
                for (int m = 0; m < 4; ++m) { const int s = wr * 64 + m * 16 + fr; const float* sp = st + (size_t)s * 2 * D_UP; float* op = cfs + (size_t)s * 2 * D_UP;
                    const f32x4 a2 = *(const GAS f32x4*)(sp + c), a1 = *(const GAS f32x4*)(sp + D_UP + c), b2 = *(const GAS f32x4*)(sp + D_FF + c), b1 = *(const GAS f32x4*)(sp + D_UP + D_FF + c);
                    const f32x4 ua = acc[0][0][m][n], ub = acc[0][1][m][n];
                    *(GAS f32x4*)(op + c) = a1; *(GAS f32x4*)(op + D_FF + c) = b1; *(GAS f32x4*)(op + D_UP + c) = ua; *(GAS f32x4*)(op + D_UP + D_FF + c) = ub;
                    const f32x4 ca = ba + wa0 * a2 + wa1 * a1 + wa2 * ua, cbv = bb + wb0 * b2 + wb1 * b1 + wb2 * ub;
                    u32x2 w; w.x = cvt_pk_bf16(siluf_(ca[0]) * cbv[0], siluf_(ca[1]) * cbv[1]); w.y = cvt_pk_bf16(siluf_(ca[2]) * cbv[2], siluf_(ca[3]) * cbv[3]);
                    *(GAS u32x2*)(ACT + (size_t)(MPROMPT + s) * D_FF + c) = w; }
                asm volatile("" ::: "memory"); }
            return;
        }
        f32x4 wts[2][8];
#pragma unroll
        for (int n = 0; n < 2; ++n) { const int c = u.pn * 128 + cl + 4 * n;
            wts[n][0] = *(const GAS f32x4*)(cw + c); wts[n][1] = *(const GAS f32x4*)(cw + D_UP + c); wts[n][2] = *(const GAS f32x4*)(cw + 2 * D_UP + c);
            wts[n][3] = *(const GAS f32x4*)(cw + D_FF + c); wts[n][4] = *(const GAS f32x4*)(cw + D_UP + D_FF + c); wts[n][5] = *(const GAS f32x4*)(cw + 2 * D_UP + D_FF + c);
            wts[n][6] = *(const GAS f32x4*)(cb + c); wts[n][7] = *(const GAS f32x4*)(cb + D_FF + c); }
        if (fr >= 14) {
#pragma unroll
            for (int ai = 0; ai < 2; ++ai)
#pragma unroll
                for (int bj = 0; bj < 2; ++bj)
#pragma unroll
                    for (int n = 0; n < 2; ++n) *(LAS f32x4*)(EX + ((ai * 2 + wr) * 2 + (fr - 14)) * 256 + bj * 128 + cl + 4 * n) = acc[ai][bj][3][n];
            if (wr == 1) {
#pragma unroll
                for (int bj = 0; bj < 2; ++bj)
#pragma unroll
                    for (int n = 0; n < 2; ++n) *(GAS f32x4*)(HALO + ((size_t)u.pm * 4 + 2 + (fr - 14)) * D_UP + u.pn * 256 + bj * 128 + cl + 4 * n) = acc[1][bj][3][n]; }
        }
        if (fr < 2 && wr == 0) {
#pragma unroll
            for (int bj = 0; bj < 2; ++bj)
#pragma unroll
                for (int n = 0; n < 2; ++n) *(GAS f32x4*)(HALO + ((size_t)u.pm * 4 + fr) * D_UP + u.pn * 256 + bj * 128 + cl + 4 * n) = acc[0][bj][0][n]; }
        asm volatile("s_waitcnt lgkmcnt(0)" ::: "memory"); __builtin_amdgcn_s_barrier(); asm volatile("" ::: "memory");
#pragma unroll
        for (int n = 0; n < 2; ++n) { const int c = u.pn * 128 + cl + 4 * n;
            const f32x4 wa0 = wts[n][0], wa1 = wts[n][1], wa2 = wts[n][2], wb0 = wts[n][3], wb1 = wts[n][4], wb2 = wts[n][5], ba = wts[n][6], bb = wts[n][7];
#pragma unroll
            for (int ai = 0; ai < 2; ++ai)
#pragma unroll
                for (int m = 0; m < 4; ++m) {
                    f32x4 cv[2];
#pragma unroll
                    for (int bj = 0; bj < 2; ++bj) { const f32x4 cur = acc[ai][bj][m][n]; f32x4 pb;
                        if (m > 0) pb = acc[ai][bj][m - 1][n];
                        else { pb = (f32x4){0.f, 0.f, 0.f, 0.f};
                            const int sa = wr == 1 ? ai : 0, sw = wr == 1 ? 0 : 1; const bool have = (wr == 1) || (ai == 1);
                            if (have && fr >= 14) pb = *(const LAS f32x4*)(EX + ((sa * 2 + sw) * 2 + (fr - 14)) * 256 + bj * 128 + cl + 4 * n); }
                        f32x4 x1, x2;
#pragma unroll
                        for (int j = 0; j < 4; ++j) { x1[j] = dpp_shr1(dpp_ror1(pb[j]), cur[j]); x2[j] = dpp_shr2(dpp_ror2(pb[j]), cur[j]); }
                        cv[bj] = bj == 0 ? ba + wa0 * x2 + wa1 * x1 + wa2 * cur : bb + wb0 * x2 + wb1 * x1 + wb2 * cur; }
                    u32x2 w; w.x = cvt_pk_bf16(siluf_(cv[0][0]) * cv[1][0], siluf_(cv[0][1]) * cv[1][1]); w.y = cvt_pk_bf16(siluf_(cv[0][2]) * cv[1][2], siluf_(cv[0][3]) * cv[1][3]);
                    *(GAS u32x2*)(ACT + (size_t)(u.pm * BM + ai * HALF + wr * 64 + m * 16 + fr) * D_FF + c) = w; }
            asm volatile("" ::: "memory"); }
    }
};
struct EpiGlu {
    static constexpr bool PERM = true, AFTER_DRAIN = false;
    const bf16* Y; bf16* O;
    __device__ __forceinline__ void partial(f32x4 (&)[2][2][4][2], const Unit&, int, int, int, int, int, int) const {}
    __device__ __forceinline__ void operator()(const f32x4 (&acc)[2][2][4][2], const Unit& u, int wr, int wc, int fr, int fq) const {
        const int row0 = u.pm * BM + wr * 64 + fr, col0 = u.pn * BM + wc * 32 + 8 * fq;
#pragma unroll
        for (int ai = 0; ai < 2; ++ai)
#pragma unroll
            for (int m = 0; m < 4; ++m) { const size_t off = (size_t)(row0 + ai * HALF + m * 16) * 512 + col0;
#pragma unroll
                for (int bj = 0; bj < 2; ++bj) { const f32x4 v0 = acc[ai][bj][m][0], v1 = acc[ai][bj][m][1];
                    const u32x4 y = *(const GAS u32x4*)(Y + off + bj * HALF);
                    u32x4 w;
                    w.x = cvt_pk_bf16(bflo(y.x) * sigmoidf_(v0[0]), bfhi(y.x) * sigmoidf_(v0[1]));
                    w.y = cvt_pk_bf16(bflo(y.y) * sigmoidf_(v0[2]), bfhi(y.y) * sigmoidf_(v0[3]));
                    w.z = cvt_pk_bf16(bflo(y.z) * sigmoidf_(v1[0]), bfhi(y.z) * sigmoidf_(v1[1]));
                    w.w = cvt_pk_bf16(bflo(y.w) * sigmoidf_(v1[2]), bfhi(y.w) * sigmoidf_(v1[3]));
                    *(GAS u32x4*)(O + off + bj * HALF) = w; } }
    }
};
template <int MODE> struct EpiMerge {
    static constexpr bool PERM = false, AFTER_DRAIN = false;
    const bf16* G;
    float* T; bf16* MG; const float* csq;
    f32x4* SLAB; const bf16* PRJ; unsigned* cnt;
    __device__ __forceinline__ void partial(f32x4 (&acc)[2][2][4][2], const Unit& u, int wr, int wc, int fr, int fq, int wid, int lane) const {
        split_store(acc, SLAB, u.sid, wid, lane); split_post(cnt + u.cidx * 8 + wid, lane);
    }
    __device__ __forceinline__ void final(const Unit& u, int wr, int wc, int fr, int fq, int wid, int lane) const {
        split_wait(cnt + u.cidx * 8 + wid, 8u, lane);
        asm volatile("" : "+v"(fr), "+v"(fq), "+v"(lane));
#pragma unroll
        for (int m = 0; m < 4; ++m) { const int r = wr * 64 + m * 16 + fr, row = MPROMPT + r; const float rs = rsqrtf(csq[row] * (1.0f / 1024.0f) + EPS);
            const __amdgpu_buffer_rsrc_t rs_ = slab_rsrc(SLAB);
#pragma unroll
            for (int bj = 0; bj < 2; ++bj) {
                f32x4 sa[2], sb[2], sc[2];
                {   f32x4 la[2][2], lb[2][2], lc[2][4];
#pragma unroll
                    for (int n = 0; n < 2; ++n) { const unsigned vo = (unsigned)((wid * 16 + (m * 2 + bj) * 2 + n) * 64 + lane) * 16u;
#pragma unroll
                        for (int j = 0; j < 2; ++j) { la[n][j] = slab_ld(rs_, vo, (unsigned)(u.pn * 2 + j) * (unsigned)(SLAB_F4 * 16)); lb[n][j] = slab_ld(rs_, vo, (unsigned)(16 + u.pn * 2 + j) * (unsigned)(SLAB_F4 * 16)); }
#pragma unroll
                        for (int j = 0; j < 4; ++j) lc[n][j] = slab_ld(rs_, vo, (unsigned)(32 + u.pn * 4 + j) * (unsigned)(SLAB_F4 * 16)); }
#pragma unroll
                    for (int n = 0; n < 2; ++n) { sa[n] = la[n][0] + la[n][1]; sb[n] = lb[n][0] + lb[n][1]; sc[n] = (lc[n][0] + lc[n][1]) + (lc[n][2] + lc[n][3]); } }
#pragma unroll
                for (int n = 0; n < 2; ++n) { const int col = split_col<PERM>(u, wc, fq, bj, n); const bf16* gp = PRJ + ((unsigned)row * N_INP + col);
                    const f32x4 a = sa[n], b = sb[n], c = sc[n];
                    const u32x2 ga = *(const GAS u32x2*)(gp + PC_GA), gb = *(const GAS u32x2*)(gp + PC_GB), gc = *(const GAS u32x2*)(gp + PC_GC);
                    f32x4 t; t[0] = bflo(ga.x) * a[0] + bflo(gb.x) * b[0] + bflo(gc.x) * rs * c[0]; t[1] = bfhi(ga.x) * a[1] + bfhi(gb.x) * b[1] + bfhi(gc.x) * rs * c[1];
                    t[2] = bflo(ga.y) * a[2] + bflo(gb.y) * b[2] + bflo(gc.y) * rs * c[2]; t[3] = bfhi(ga.y) * a[3] + bfhi(gb.y) * b[3] + bfhi(gc.y) * rs * c[3];
                    u32x2 w; w.x = cvt_pk_bf16(t[0], t[1]); w.y = cvt_pk_bf16(t[2], t[3]); *(GAS u32x2*)(MG + ((unsigned)row * DM + col)) = w; } }
            asm volatile("" ::: "memory"); }
    }
    __device__ __forceinline__ void operator()(const f32x4 (&acc)[2][2][4][2], const Unit& u, int wr, int wc, int fr, int fq) const {
        const int row0 = u.pm * BM + wr * 64 + fr, col0 = u.pn * BM + wc * 32 + 4 * fq;
        bf16* Tb = (bf16*)T;
#pragma unroll
        for (int ai = 0; ai < 2; ++ai) {
#pragma unroll
          for (int mh = 0; mh < 4; mh += 2) {
            u32x2 gq[4][2][2], tq[4][2][2]; float rsq[4];
#pragma unroll
            for (int m = mh; m < mh + 2; ++m) { const int row = row0 + ai * HALF + m * 16; const size_t off = (size_t)row * DM + col0; const bf16* gp = G + (size_t)row * N_INP + col0;
                rsq[m] = MODE == 2 ? csq[row] : 0.f;
#pragma unroll
                for (int bj = 0; bj < 2; ++bj)
#pragma unroll
                    for (int n = 0; n < 2; ++n) { const int co = bj * HALF + n * 16; gq[m][bj][n] = *(const GAS u32x2*)(gp + co); if (MODE != 0) tq[m][bj][n] = *(const GAS u32x2*)(Tb + off + co); } }
#pragma unroll
            for (int m = mh; m < mh + 2; ++m) { const int row = row0 + ai * HALF + m * 16; const size_t off = (size_t)row * DM + col0;
                const float rs = MODE == 2 ? rsqrtf(rsq[m] * (1.0f / 1024.0f) + EPS) : 1.f;
#pragma unroll
                for (int bj = 0; bj < 2; ++bj)
#pragma unroll
                    for (int n = 0; n < 2; ++n) { const int co = bj * HALF + n * 16; const u32x2 g = gq[m][bj][n]; f32x4 v = acc[ai][bj][m][n];
                        v[0] *= bflo(g.x); v[1] *= bfhi(g.x); v[2] *= bflo(g.y); v[3] *= bfhi(g.y);
                        if (MODE == 0) { u32x2 w; w.x = cvt_pk_bf16(v[0], v[1]); w.y = cvt_pk_bf16(v[2], v[3]); *(GAS u32x2*)(Tb + off + co) = w; }
                        if (MODE == 1) { const u32x2 tb = tq[m][bj][n]; u32x2 w; w.x = cvt_pk_bf16(bflo(tb.x) + v[0], bfhi(tb.x) + v[1]); w.y = cvt_pk_bf16(bflo(tb.y) + v[2], bfhi(tb.y) + v[3]); *(GAS u32x2*)(Tb + off + co) = w; }
                        if (MODE == 2) { const u32x2 tb = tq[m][bj][n]; f32x4 t = {bflo(tb.x), bfhi(tb.x), bflo(tb.y), bfhi(tb.y)}; t = t + v * rs; u32x2 w; w.x = cvt_pk_bf16(t[0], t[1]); w.y = cvt_pk_bf16(t[2], t[3]); *(GAS u32x2*)(MG + off + co) = w; } } } } }
    }
};
template <int SEG> struct EpiChain {
    static constexpr bool PERM = false, AFTER_DRAIN = false;
    const bf16* PRJ; bf16* MG; const float* csq;
    __device__ __forceinline__ void partial(f32x4 (&)[2][2][4][2], const Unit&, int, int, int, int, int, int) const {}
    __device__ __forceinline__ void operator()(f32x4 (&acc)[2][2][4][2], const Unit& u, int wr, int wc, int fr, int fq) const {
        const int row0 = u.pm * BM + wr * 64 + fr, col0 = u.pn * BM + wc * 32 + 4 * fq;
#pragma unroll
        for (int ai = 0; ai < 2; ++ai)
#pragma unroll
            for (int m = 0; m < 4; ++m) { const int row = row0 + ai * HALF + m * 16; const bf16* gp = PRJ + ((unsigned)row * N_INP + col0);
                float rs = 1.f; if (SEG >= 1) rs = rsqrtf(csq[row] * (1.0f / 1024.0f) + EPS);
#pragma unroll
                for (int bj = 0; bj < 2; ++bj)
#pragma unroll
                    for (int n = 0; n < 2; ++n) { const int co = bj * HALF + n * 16; f32x4 v = acc[ai][bj][m][n];
                        if (SEG == 0) { const u32x2 ga = *(const GAS u32x2*)(gp + PC_GA + co), gb = *(const GAS u32x2*)(gp + PC_GB + co);
                            v[0] *= bflo(ga.x) * __builtin_amdgcn_rcpf(fmaxf(bflo(gb.x), 1e-20f)); v[1] *= bfhi(ga.x) * __builtin_amdgcn_rcpf(fmaxf(bfhi(gb.x), 1e-20f));
                            v[2] *= bflo(ga.y) * __builtin_amdgcn_rcpf(fmaxf(bflo(gb.y), 1e-20f)); v[3] *= bfhi(ga.y) * __builtin_amdgcn_rcpf(fmaxf(bfhi(gb.y), 1e-20f)); acc[ai][bj][m][n] = v; }
                        if (SEG == 1) { const u32x2 gb = *(const GAS u32x2*)(gp + PC_GB + co), gc = *(const GAS u32x2*)(gp + PC_GC + co);
                            v[0] *= fmaxf(bflo(gb.x), 1e-20f) * __builtin_amdgcn_rcpf(fmaxf(bflo(gc.x) * rs, 1e-20f)); v[1] *= fmaxf(bfhi(gb.x), 1e-20f) * __builtin_amdgcn_rcpf(fmaxf(bfhi(gc.x) * rs, 1e-20f));
                            v[2] *= fmaxf(bflo(gb.y), 1e-20f) * __builtin_amdgcn_rcpf(fmaxf(bflo(gc.y) * rs, 1e-20f)); v[3] *= fmaxf(bfhi(gb.y), 1e-20f) * __builtin_amdgcn_rcpf(fmaxf(bfhi(gc.y) * rs, 1e-20f)); acc[ai][bj][m][n] = v; }
                        if (SEG == 2) { const u32x2 gc = *(const GAS u32x2*)(gp + PC_GC + co);
                            v[0] *= fmaxf(bflo(gc.x) * rs, 1e-20f); v[1] *= fmaxf(bfhi(gc.x) * rs, 1e-20f); v[2] *= fmaxf(bflo(gc.y) * rs, 1e-20f); v[3] *= fmaxf(bfhi(gc.y) * rs, 1e-20f);
                            u32x2 w; w.x = cvt_pk_bf16(v[0], v[1]); w.y = cvt_pk_bf16(v[2], v[3]); *(GAS u32x2*)(MG + ((unsigned)row * DM + col0 + co)) = w; } }
                asm volatile("" ::: "memory"); }
    }
};
struct EpiResid {
    static constexpr bool PERM = false, AFTER_DRAIN = false;
    const bf16* XI; const bf16* XIS; bf16* XO; const float* gate; SplitCtl sp;
    __device__ __forceinline__ void partial(f32x4 (&acc)[2][2][4][2], const Unit& u, int wr, int wc, int fr, int fq, int wid, int lane) const {
        split_store(acc, sp.SLAB, u.sid, wid, lane);
        if (split_arrive(sp.cnt + u.cidx * 8 + wid, sp.nsl, lane)) { split_zero_pad(acc); split_sum(acc, sp.SLAB, u.pn * (int)sp.nsl, (int)sp.nsl, wid, lane); (*this)(acc, u, wr, wc, fr, fq); }
    }
    __device__ __forceinline__ void operator()(const f32x4 (&acc)[2][2][4][2], const Unit& u, int wr, int wc, int fr, int fq) const {
        const int row0 = u.pm * BM + wr * 64 + fr, col0 = u.pn * BM + wc * 32 + 4 * fq;
        const __amdgpu_buffer_rsrc_t xr = __builtin_amdgcn_make_buffer_rsrc((void*)XO, (short)0, (int)((size_t)MP * DM * 2), 0x00020000);
        const bool samp = u.pm == MPROMPT / 256;
        const bf16* xs16 = samp ? XIS - (size_t)MPROMPT * DM : XI;
#pragma unroll
        for (int ai = 0; ai < 2; ++ai) { if (ai == 1 && samp) break;
            u32x2 xw[4][2][2]; f32x4 gg[4][2][2];
#pragma unroll
            for (int m = 0; m < 4; ++m) { const int row = row0 + ai * HALF + m * 16; const size_t off = (size_t)row * DM + col0; const float* gp = gate + (size_t)mod_row(row) * MOD_PITCH + col0;
#pragma unroll
                for (int bj = 0; bj < 2; ++bj)
#pragma unroll
                    for (int n = 0; n < 2; ++n) { const int co = bj * HALF + n * 16; xw[m][bj][n] = *(const GAS u32x2*)(xs16 + off + co); gg[m][bj][n] = *(const GAS f32x4*)(gp + co); } }
#pragma unroll
            for (int m = 0; m < 4; ++m) { const int row = row0 + ai * HALF + m * 16; const size_t off = (size_t)row * DM + col0;
#pragma unroll
                for (int bj = 0; bj < 2; ++bj)
#pragma unroll
                    for (int n = 0; n < 2; ++n) { const int co = bj * HALF + n * 16; const u32x2 w = xw[m][bj][n]; const f32x4 xi = {bflo(w.x), bfhi(w.x), bflo(w.y), bfhi(w.y)};
                        const f32x4 xo = xi + gg[m][bj][n] * acc[ai][bj][m][n]; u32x2 wo; wo.x = cvt_pk_bf16(xo[0], xo[1]); wo.y = cvt_pk_bf16(xo[2], xo[3]);
                        __builtin_amdgcn_raw_buffer_store_b64(wo, xr, (unsigned)(off + co) * 2u, 0,   16); } } }
    }
};
template <int MODE> struct EpiResidPrep {
    static constexpr bool PERM = false, AFTER_DRAIN = true;
    EpiResid R; bf16* H; float* yp; float* ys; const float* g; const float* mod2; int sh_idx, sc_idx; const float* wdt; float* DT; unsigned* pc;
    __device__ __forceinline__ void partial(f32x4 (&acc)[2][2][4][2], const Unit& u, int wr, int wc, int fr, int fq, int wid, int lane) const {
        split_store(acc, R.sp.SLAB, u.sid, wid, lane); split_post(R.sp.cnt + u.cidx * 8 + wid, lane);
    }
    __device__ __forceinline__ void operator()(const f32x4 (&acc)[2][2][4][2], const Unit& u, int wr, int wc, int fr, int fq) const { R(acc, u, wr, wc, fr, fq); }
    __device__ __forceinline__ void fused(f32x4 (&acc)[2][2][4][2], const Unit& u, int wr, int wc, int fr, int fq, LAS unsigned char* lds, int wid, int lane) const {
        R(acc, u, wr, wc, fr, fq);
        const int fin = opaque_bx() - R.sp.fin0; const bool isfin = fin >= 0 && fin < DM / 256;
        if (isfin) { const Unit uf = final_unit(fin, R.sp.cbase);
            split_wait(R.sp.cnt + uf.cidx * 8 + wid, R.sp.nsl, lane);
            split_sum(acc, R.sp.SLAB, uf.pn * (int)R.sp.nsl, (int)R.sp.nsl, wid, lane); split_zero_pad(acc); R(acc, uf, wr, wc, fr, fq); }
        asm volatile("s_waitcnt vmcnt(0)" ::: "memory"); __syncthreads();
        if (wid == 0 && lane == 0) {
            if (isfin) __hip_atomic_fetch_add(pc + 32, 8u, __ATOMIC_RELAXED, __HIP_MEMORY_SCOPE_AGENT);
            __hip_atomic_fetch_add(pc + u.pm, 1u, __ATOMIC_RELAXED, __HIP_MEMORY_SCOPE_AGENT);
            unsigned sp_ = 0; while (__hip_atomic_load(pc + u.pm, __ATOMIC_RELAXED, __HIP_MEMORY_SCOPE_AGENT) < 8u && ++sp_ < (1u << 22)) __builtin_amdgcn_s_sleep(2);
            if (u.pn == 0) { sp_ = 0; while (__hip_atomic_load(pc + 32, __ATOMIC_RELAXED, __HIP_MEMORY_SCOPE_AGENT) < 64u && ++sp_ < (1u << 22)) __builtin_amdgcn_s_sleep(2); }
            __builtin_amdgcn_fence(__ATOMIC_ACQUIRE, "agent"); asm volatile("s_waitcnt vmcnt(0)" ::: "memory");
        }
        __syncthreads();
        LAS float* wT = (LAS float*)lds;
        if (MODE == 1) { f32x4 tw[16];
#pragma unroll
            for (int i = 0; i < 16; ++i) tw[i] = ((const f32x4*)wdt)[wid * 64 + lane + i * NTHR];
#pragma unroll
            for (int i = 0; i < 16; ++i) ((LAS f32x4*)wT)[wid * 64 + lane + i * NTHR] = tw[i];
            __syncthreads(); }
        const bf16* X = R.XO;
        {   const int row = u.pm * BM + u.pn * 32 + wid * 4;
            prep_rows4<MODE>(X + (size_t)row * DM, g, mod2 + (size_t)mod_row(row) * MOD_PITCH, sh_idx, sc_idx, H + (size_t)row * DM, yp + (size_t)row * DM, DT + (size_t)row * 16, wT, lane); }
        if (u.pn == 0 && wid < 4) { const int s = u.pm * 4 + wid, row = MPROMPT + s;
            prep_row<MODE>(X + (size_t)row * DM, g, mod2 + (size_t)mod_row(row) * MOD_PITCH, sh_idx, sc_idx, H + (size_t)row * DM, ys + (size_t)s * DM, DT + (size_t)row * 16, wT, lane); }
        if (MODE == 1) __syncthreads();
    }
};
struct EpiMod {
    static constexpr bool PERM = false, AFTER_DRAIN = false;
    float* MOD; const float* bmod;
    __device__ __forceinline__ void partial(f32x4 (&)[2][2][4][2], const Unit&, int, int, int, int, int, int) const {}
    __device__ __forceinline__ void operator()(const f32x4 (&acc)[2][2][4][2], const Unit& u, int wr, int wc, int fr, int fq) const {
        const int row0 = wr * 64 + fr, col0 = u.pn * BM + wc * 32 + 4 * fq;
        f32x4 bv[2][2];
#pragma unroll
        for (int bj = 0; bj < 2; ++bj)
#pragma unroll
            for (int n = 0; n < 2; ++n) bv[bj][n] = *(const GAS f32x4*)(bmod + col0 + bj * HALF + n * 16);
#pragma unroll
        for (int ai = 0; ai < 2; ++ai)
#pragma unroll
            for (int m = 0; m < 4; ++m) { float* rowp = MOD + (size_t)(row0 + ai * HALF + m * 16) * MOD_PITCH + col0;
#pragma unroll
                for (int bj = 0; bj < 2; ++bj)
#pragma unroll
                    for (int n = 0; n < 2; ++n) *(GAS f32x4*)(rowp + bj * HALF + n * 16) = acc[ai][bj][m][n] + bv[bj][n]; }
    }
};
}
struct Frame {
    LAS unsigned char* lds;
    int tid, lane, wave, gw;
    float* out; unsigned char* ws;
};
#define WSP(T, off) ((T*)(F.ws + (off)))
__device__ __forceinline__ Frame launder(const Frame& F0) {
    Frame F = F0; int t = F0.tid; asm volatile("" : "+v"(t)); F.tid = t; F.lane = t & 63; F.wave = __builtin_amdgcn_readfirstlane(t >> 6);
    unsigned long long w = (unsigned long long)F0.ws, o = (unsigned long long)F0.out; asm volatile("" : "+s"(w), "+s"(o)); F.ws = (unsigned char*)w; F.out = (float*)o;
    F.gw = blockIdx.x * NWAVES + F.wave; return F;
}

__device__ __forceinline__ void transpose_item(const float* W, int ld, int K, int ncols, int c0, bf16* WT, int row_off, LAS float* scr, int item, int lane) {
    const int nblk = ncols / 32, kb = item / nblk, nb = item % nblk, k0 = 64 * kb, n0 = 32 * nb;
    const int rbase = row_off >= 0 ? row_off + n0 : (n0 < D_FF ? 256 * (n0 / 128) + n0 % 128 : 256 * ((n0 - D_FF) / 128) + 128 + (n0 - D_FF) % 128);
    float tv[32];
#pragma unroll
    for (int i = 0; i < 32; ++i) { const int kk = 2 * i + (lane >> 5); tv[i] = __builtin_nontemporal_load(W + (size_t)(k0 + kk) * ld + c0 + n0 + (lane & 31)); }
#pragma unroll
    for (int i = 0; i < 32; ++i) { const int kk = 2 * i + (lane >> 5); scr[kk * 33 + (lane & 31)] = tv[i]; }
    if (false) for (int i = 0; i < 32; ++i) { const int kk = 2 * i + (lane >> 5); scr[kk * 33 + (lane & 31)] = __builtin_nontemporal_load(W + (size_t)(k0 + kk) * ld + c0 + n0 + (lane & 31)); }
    LDS_WAIT(); asm volatile("" ::: "memory");
    const int c = lane & 7;
#pragma unroll
    for (int j = 0; j < 4; ++j) { const int n = (lane >> 3) + 8 * j; const LAS float* s = scr + (8 * c) * 33 + n;
        v4u o; o.x = pk2(s[0 * 33], s[1 * 33]); o.y = pk2(s[2 * 33], s[3 * 33]); o.z = pk2(s[4 * 33], s[5 * 33]); o.w = pk2(s[6 * 33], s[7 * 33]);
        *(GAS v4u*)(WT + (size_t)(rbase + n) * K + k0 + 8 * c) = o; }
    LDS_WAIT(); asm volatile("" ::: "memory");
}
constexpr int MODC = 96, MODK = 128, MODP = 136;
__device__ __forceinline__ void phase_mod(const Frame& F0, KArgs A) {
    Frame F = launder(F0);
    const int n0 = blockIdx.x * MODC, l = n0 / N_MOD, cl = n0 - l * N_MOD;
    const float* W = A->in[I_WMOD] + (size_t)l * DM * N_MOD + cl;
    LAS bf16* Bt = (LAS bf16*)F.lds;
    LAS bf16* As = (LAS bf16*)(F.lds + 2 * MODC * MODP * 2);
    for (int i = F.tid; i < 2 * 12 * MODP; i += NTHR) { const int b = i / (12 * MODP), r = i % (12 * MODP); As[(b * 144 + 132) * MODP + r] = (bf16)0; }
    f32x4 wa[6], wb[6], creg[9];
    auto load_w = [&](f32x4 (&wr)[6], int kc) {
#pragma unroll
        for (int j = 0; j < 6; ++j) { const int idx = F.tid + NTHR * j, n = idx % MODC, k = 4 * (idx / MODC); const float* p = W + (size_t)(kc * MODK + k) * N_MOD + n;
            wr[j].x = __builtin_nontemporal_load(p); wr[j].y = __builtin_nontemporal_load(p + N_MOD); wr[j].z = __builtin_nontemporal_load(p + 2 * N_MOD); wr[j].w = __builtin_nontemporal_load(p + 3 * (size_t)N_MOD); }
    };
    auto load_c = [&](int kc) {
#pragma unroll
        for (int j = 0; j < 9; ++j) { const int idx = F.tid + NTHR * j, r = idx >> 5, k4 = (idx & 31) * 4;
            const float* src = r < NB ? A->in[I_CP] + (size_t)r * DM : A->in[I_CS] + (size_t)(r - NB) * DM;
            creg[j] = r < NB + NS ? *(const GAS f32x4*)(src + kc * MODK + k4) : (f32x4){0.f, 0.f, 0.f, 0.f}; }
    };
    auto store_w = [&](const f32x4 (&wr)[6], int buf) {
#pragma unroll
        for (int j = 0; j < 6; ++j) { const int idx = F.tid + NTHR * j, n = idx % MODC, k = 4 * (idx / MODC);
            v2u w; w.x = pk2(wr[j].x, wr[j].y); w.y = pk2(wr[j].z, wr[j].w); *(LAS v2u*)(Bt + (buf * MODC + n) * MODP + k) = w; }
    };
    auto store_c = [&](int buf) {
#pragma unroll
        for (int j = 0; j < 9; ++j) { const int idx = F.tid + NTHR * j, r = idx >> 5, k4 = (idx & 31) * 4;
            if (r < NB + NS) { v2u w; w.x = pk2(siluf_(creg[j].x), siluf_(creg[j].y)); w.y = pk2(siluf_(creg[j].z), siluf_(creg[j].w)); *(LAS v2u*)(As + (buf * 144 + r) * MODP + k4) = w; } }
    };
    f32x4 acc[9];
#pragma unroll
    for (int m = 0; m < 9; ++m) acc[m] = (f32x4){0.f, 0.f, 0.f, 0.f};
    auto compute = [&](int buf) {
        if (F.wave < 6) {
#pragma unroll
            for (int ks = 0; ks < MODK / 32; ++ks) { const bf16x8 bfr = *(const LAS bf16x8*)(Bt + (buf * MODC + 16 * F.wave + (F.lane & 15)) * MODP + 32 * ks + 8 * (F.lane >> 4));
#pragma unroll
                for (int m = 0; m < 9; ++m) { const bf16x8 af = *(const LAS bf16x8*)(As + (buf * 144 + 16 * m + (F.lane & 15)) * MODP + 32 * ks + 8 * (F.lane >> 4));
                    acc[m] = __builtin_amdgcn_mfma_f32_16x16x32_bf16(af, bfr, acc[m], 0, 0, 0); } }
        }
    };
    const int kst = blockIdx.x & 15;
    load_w(wa, kst); load_c(kst); load_w(wb, (1 + kst) & 15);
    store_w(wa, 0); store_c(0); __syncthreads();
#pragma unroll 1
    for (int kc = 0; kc < DM / MODK; kc += 2) {
        load_c((kc + 1 + kst) & 15); if (kc + 2 < DM / MODK) load_w(wa, (kc + 2 + kst) & 15);
        compute(0);
        store_w(wb, 1); store_c(1); __syncthreads();
        if (kc + 2 < DM / MODK) { load_c((kc + 2 + kst) & 15); if (kc + 3 < DM / MODK) load_w(wb, (kc + 3 + kst) & 15); }
        compute(1);
        if (kc + 2 < DM / MODK) { store_w(wa, 0); store_c(0); }
        __syncthreads();
    }
    if (F.wave < 6) { float* MOD = WSP(float, WS_MOD); const int col = n0 + 16 * F.wave + (F.lane & 15); const float bias = A->in[I_BMOD][col];
#pragma unroll
        for (int m = 0; m < 9; ++m)
#pragma unroll
            for (int r = 0; r < 4; ++r) { const int row = 16 * m + 4 * (F.lane >> 4) + r; if (row < NB + NS) MOD[(size_t)row * MOD_PITCH + col] = acc[m][r] + bias; } }
    __syncthreads();
}
__device__ __forceinline__ void tjob(Frame& F, LAS float* scr, const float* W, int ld, int K, int ncols, int c0, bf16* WT, int row_off) {
    const int nit = (K / 64) * (ncols / 32);
    for (int it = F.gw; it < nit; it += (GRID * NWAVES)) transpose_item(W, ld, K, ncols, c0, WT, row_off, scr, it, F.lane);
}
__device__ __forceinline__ void phase_prologue(const Frame& F0, KArgs A) {
    Frame F = launder(F0);
    LAS float* scr = (LAS float*)(F.lds + F.wave * 16384);
#pragma unroll 1
    for (int l = 0; l < DEPTH; ++l) {
        unsigned char* wl = F.ws + WS_W + (size_t)l * WL_END;
        tjob(F, scr, A->in[I_WIN] + (size_t)l * DM * N_IN, N_IN, DM, 4096, 0, (bf16*)(wl + WL_IN), 0);
        tjob(F, scr, A->in[I_WIN] + (size_t)l * DM * N_IN, N_IN, DM, 6144, 4112, (bf16*)(wl + WL_IN), 4096);
        tjob(F, scr, A->in[I_WGLU] + (size_t)l * 512 * 512, 512, 512, 512, 0, (bf16*)(wl + WL_GLU), 0);
        tjob(F, scr, A->in[I_WPA] + (size_t)l * 512 * DM, DM, 512, DM, 0, (bf16*)(wl + WL_PA), 0);
        tjob(F, scr, A->in[I_WPB] + (size_t)l * 512 * DM, DM, 512, DM, 0, (bf16*)(wl + WL_PB), 0);
        tjob(F, scr, A->in[I_WPC] + (size_t)l * 1024 * DM, DM, 1024, DM, 0, (bf16*)(wl + WL_PC), 0);
        tjob(F, scr, A->in[I_WOUT] + (size_t)l * DM * DM, DM, DM, DM, 0, (bf16*)(wl + WL_OUT), 0);
        tjob(F, scr, A->in[I_WUP] + (size_t)l * DM * D_UP, D_UP, DM, D_UP, 0, (bf16*)(wl + WL_UP), -1);
        tjob(F, scr, A->in[I_WDOWN] + (size_t)l * D_FF * DM, DM, D_FF, DM, 0, (bf16*)(wl + WL_DOWN), 0);
    }
    {   bf16* X0 = WSP(bf16, WS_X0);
        for (int r = F.gw; r < MREAL; r += (GRID * NWAVES)) {
            const float* src = r < MPROMPT ? A->in[I_XP] + (size_t)r * DM : A->in[I_XS] + (size_t)(r - MPROMPT) * DM;
            GAS v2u* o = (GAS v2u*)(X0 + (size_t)r * DM) + F.lane;
#pragma unroll
            for (int j = 0; j < 8; ++j) { const f32x4 v = __builtin_nontemporal_load((const f32x4*)src + F.lane + 64 * j); v2u w; w.x = pk2(v.x, v.y); w.y = pk2(v.z, v.w); o[64 * j] = w; }
        }
    }
    {   float* z = WSP(float, WS_SMALL + SM_VSQ);
        const int gt = blockIdx.x * NTHR + F.tid;
        for (int i = gt; i < 4 * MP; i += GRID * NTHR) z[i] = 0.f;
    }
    {   const int gt = blockIdx.x * NTHR + F.tid, NT = GRID * NTHR;
        bf16* WSb = WSP(bf16, WS_SMALL + SM_WS);
        for (int i = gt; i < DEPTH * H_B * 128 * 128; i += NT) { const int jj = i & 127, ii = (i >> 7) & 127; WSb[i] = (bf16)(jj <= ii ? f2bf(A->in[I_WS][i]) : 0u); }
        float* AA = WSP(float, WS_SMALL + SM_S5A); float* BB = WSP(float, WS_SMALL + SM_S5BB); bf16* CT = WSP(bf16, WS_SMALL + SM_S5CT);
        for (int i = gt; i < DEPTH * G_A * P_A; i += NT) {
            const int l = i / (G_A * P_A), g = (i / P_A) % G_A;
            const float dt = expf(A->in[I_LOGDT][l * G_A + g]), lr = A->in[I_LAMRE][i], li = A->in[I_LAMIM][i];
            const float mag = expf(lr * dt); float sn, cs; sincosf(li * dt, &sn, &cs);
            const float ar = mag * cs, ai = mag * sn, den = lr * lr + li * li, nr = ar - 1.0f;
            const float kr = (nr * lr + ai * li) / den, ki = (ai * lr - nr * li) / den;
            float qr = ar, qi = ai;
#pragma unroll
            for (int s = 0; s < 6; ++s) { const float t = qr * qr - qi * qi; qi = 2.0f * qr * qi; qr = t; }
            AA[i * 4 + 0] = ar; AA[i * 4 + 1] = ai; AA[i * 4 + 2] = qr; AA[i * 4 + 3] = qi;
#pragma unroll
            for (int h = 0; h < S5G; ++h) { const float bre = A->in[I_BRE][(size_t)i * S5G + h], bim = A->in[I_BIM][(size_t)i * S5G + h];
                BB[(size_t)i * 32 + h] = kr * bre - ki * bim; BB[(size_t)i * 32 + 16 + h] = kr * bim + ki * bre; }
        }
        {   float* WDT = WSP(float, WS_SMALL + SM_WDT);
            for (int i = gt; i < DEPTH * 16 * DM; i += NT) { const int k = i % DM, hh = (i / DM) & 15, l = i / (16 * DM); WDT[i] = A->in[I_WIN][((size_t)l * DM + k) * N_IN + 4096 + hh]; } }
        for (int i = gt; i < DEPTH * G_A * S5G * 128; i += NT) { const int k = i & 127, lgh = i >> 7;
            const float v = k < 64 ? A->in[I_CRE][(size_t)lgh * 64 + k] : -A->in[I_CIM][(size_t)lgh * 64 + (k - 64)]; CT[i] = (bf16)f2bf(v); }
    }
}

template <bool WITH_DT>
__device__ __forceinline__ void phase_prep(const Frame& F0, const float* X, const float* XS, const float* g, const float* modl, int sh_idx, int sc_idx, const float* win_l, float* DT) {
    Frame F = launder(F0);
    bf16* H = WSP(bf16, WS_H);
    LAS float* wT = (LAS float*)F.lds;
    if (WITH_DT) {
        {   const GAS f32x4* wd = (const GAS f32x4*)WSP(const float, WS_SMALL + SM_WDT);
            f32x4 tw[16];
#pragma unroll
            for (int i = 0; i < 16; ++i) tw[i] = wd[F.tid + i * NTHR];
#pragma unroll
            for (int i = 0; i < 16; ++i) ((LAS f32x4*)wT)[F.tid + i * NTHR] = tw[i]; }
        (void)win_l;
        __syncthreads();
    }
    if (WITH_DT) {
        const bf16* X0 = WSP(const bf16, WS_X0); float* DTo = DT; const int gwv = blockIdx.x * NWAVES + F.wave;
        {   const int row = 4 * gwv; prep_rows4<1>(X0 + (size_t)row * DM, g, modl + (size_t)mod_row(row) * MOD_PITCH, sh_idx, sc_idx, H + (size_t)row * DM, nullptr, DTo + (size_t)row * 16, wT, F.lane); }
        if (gwv < NS) { const int row = MPROMPT + gwv; prep_row<1>(X0 + (size_t)row * DM, g, modl + (size_t)mod_row(row) * MOD_PITCH, sh_idx, sc_idx, H + (size_t)row * DM, nullptr, DTo + (size_t)row * 16, wT, F.lane); }
    } else {
    f32x4 vn[8];
    {   const int r0 = blockIdx.x * NWAVES + F.wave; const int rr0 = r0 < MREAL ? r0 : 0; const GAS f32x4* xr = (const GAS f32x4*)(rr0 < MPROMPT ? X + (size_t)rr0 * DM : XS + (size_t)(rr0 - MPROMPT) * DM) + F.lane;
#pragma unroll
        for (int j = 0; j < 8; ++j) vn[j] = xr[64 * j]; }
    for (int r = blockIdx.x * NWAVES + F.wave; r < MREAL; r += GRID * NWAVES) {
        f32x4 v[8]; float s = 0.f;
#pragma unroll
        for (int j = 0; j < 8; ++j) { v[j] = vn[j]; s += (v[j].x * v[j].x + v[j].y * v[j].y) + (v[j].z * v[j].z + v[j].w * v[j].w); }
        {   const int rn = r + GRID * NWAVES; const int rr1 = rn < MREAL ? rn : r; const GAS f32x4* xr = (const GAS f32x4*)(rr1 < MPROMPT ? X + (size_t)rr1 * DM : XS + (size_t)(rr1 - MPROMPT) * DM) + F.lane;
#pragma unroll
            for (int j = 0; j < 8; ++j) vn[j] = xr[64 * j]; }
        const float rinv = rsqrtf(wave_sum(s) * (1.0f / DM) + EPS);
        const float* mr = modl + (size_t)mod_row(r) * MOD_PITCH;
        const GAS f32x4* gp = (const GAS f32x4*)g + F.lane; const GAS f32x4* shp = (const GAS f32x4*)(mr + sh_idx * DM) + F.lane; const GAS f32x4* scp = (const GAS f32x4*)(mr + sc_idx * DM) + F.lane;
        GAS v2u* o = (GAS v2u*)(H + (size_t)r * DM) + F.lane;
#pragma unroll
        for (int j = 0; j < 8; ++j) { const f32x4 gg = gp[64 * j], sh = shp[64 * j], sc = scp[64 * j];
            v[j] = v[j] * rinv * gg * (sc + 1.0f) + sh;
            v2u w; w.x = pk2(v[j].x, v[j].y); w.y = pk2(v[j].z, v[j].w); o[64 * j] = w; }
        if (WITH_DT) {
            float a16[16];
#pragma unroll
            for (int hh = 0; hh < 16; ++hh) { float a = 0.f;
#pragma unroll
                for (int j = 0; j < 8; ++j) { const f32x4 w = *(const LAS f32x4*)(wT + hh * DM + 4 * F.lane + 256 * j); a += (v[j].x * w.x + v[j].y * w.y) + (v[j].z * w.z + v[j].w * w.w); }
                a16[hh] = a; }
            const float mine = wave_sum16(a16, F.lane);
            if (F.lane < 16) DT[(size_t)r * 16 + F.lane] = mine;
        }
    }
    }
    if (WITH_DT) __syncthreads();
}

__device__ __forceinline__ void phase_final(const Frame& F0, KArgs A, const float* X) {
    Frame F = launder(F0);
    const float* g = A->in[I_GFINAL];
    for (int r = blockIdx.x * NWAVES + F.wave; r < MREAL; r += GRID * NWAVES) {
        const GAS f32x4* xr = (const GAS f32x4*)(X + (size_t)r * DM) + F.lane;
        f32x4 v[8]; float s = 0.f;
#pragma unroll
        for (int j = 0; j < 8; ++j) { v[j] = xr[64 * j]; s += (v[j].x * v[j].x + v[j].y * v[j].y) + (v[j].z * v[j].z + v[j].w * v[j].w); }
        const float rinv = rsqrtf(wave_sum(s) * (1.0f / DM) + EPS);
        GAS f32x4* o = (GAS f32x4*)(F.out + (r < MPROMPT ? O_YP + (size_t)r * DM : O_YS + (size_t)(r - MPROMPT) * DM)) + F.lane;
        const GAS f32x4* gp = (const GAS f32x4*)g + F.lane;
#pragma unroll
        for (int j = 0; j < 8; ++j) o[64 * j] = v[j] * rinv * gp[64 * j];
    }
}
typedef __bf16 bf16x2_t __attribute__((ext_vector_type(2)));
constexpr int HS_PITCH = 136;
template <bool FINAL>
__device__ __forceinline__ void s5_item(KArgs A, unsigned char* ws, float* out, int l, int item, LAS unsigned char* wl, int lane, unsigned* flags = nullptr) {
    const int c = item & 31, g = (item >> 5) & 31, b = item >> 10;
    const int lgp = (l * G_A + g) * P_A + lane;
    const f32x4 aq = *(const GAS f32x4*)((const float*)(ws + WS_SMALL + SM_S5A) + (size_t)lgp * 4);
    const float ar = aq.x, ai = aq.y;
    float br[16], bi[16];
    {   const GAS f32x4* bb = (const GAS f32x4*)((const float*)(ws + WS_SMALL + SM_S5BB) + (size_t)lgp * 32);
#pragma unroll
        for (int q = 0; q < 4; ++q) { const f32x4 v = bb[q]; br[4 * q] = v.x; br[4 * q + 1] = v.y; br[4 * q + 2] = v.z; br[4 * q + 3] = v.w;
                                      const f32x4 w = bb[4 + q]; bi[4 * q] = w.x; bi[4 * q + 1] = w.y; bi[4 * q + 2] = w.z; bi[4 * q + 3] = w.w; } }
    unsigned brp[8], bip[8];
#pragma unroll
    for (int k = 0; k < 8; ++k) { brp[k] = pk2(br[2 * k], br[2 * k + 1]); bip[k] = pk2(bi[2 * k], bi[2 * k + 1]); }
    const int row0 = b * SEQ + c * S5Q;
    const bf16* PROJ = (const bf16*)(ws + WS_BIG);
    const GAS v4u* up = (const GAS v4u*)(PROJ + (size_t)(row0 + lane) * N_INP + PC_UA + g * 16);
    const v4u u0 = up[0], u1 = up[1];
    LAS bf16* Us = (LAS bf16*)(wl + 8704);
    if (FINAL) { *(LAS v4u*)(Us + lane * 16) = u0; *(LAS v4u*)(Us + lane * 16 + 8) = u1; }
    float hr = 0.f, hi = 0.f;
    float* SLOC = (float*)(ws + WS_SMALL + SM_SLOC);
    if (FINAL && flags) {
        float lr = 0.f, li = 0.f;
#pragma unroll 2
        for (int t = 0; t < 64; ++t) {
            unsigned w[8];
            w[0] = __builtin_amdgcn_readlane(u0.x, t); w[1] = __builtin_amdgcn_readlane(u0.y, t); w[2] = __builtin_amdgcn_readlane(u0.z, t); w[3] = __builtin_amdgcn_readlane(u0.w, t);
            w[4] = __builtin_amdgcn_readlane(u1.x, t); w[5] = __builtin_amdgcn_readlane(u1.y, t); w[6] = __builtin_amdgcn_readlane(u1.z, t); w[7] = __builtin_amdgcn_readlane(u1.w, t);
            float sr0 = 0.f, si0 = 0.f, sr1 = 0.f, si1 = 0.f;
#pragma unroll
            for (int k = 0; k < 8; k += 2) {
                sr0 = __builtin_amdgcn_fdot2_f32_bf16(__builtin_bit_cast(bf16x2_t, brp[k]), __builtin_bit_cast(bf16x2_t, w[k]), sr0, false);
                si0 = __builtin_amdgcn_fdot2_f32_bf16(__builtin_bit_cast(bf16x2_t, bip[k]), __builtin_bit_cast(bf16x2_t, w[k]), si0, false);
                sr1 = __builtin_amdgcn_fdot2_f32_bf16(__builtin_bit_cast(bf16x2_t, brp[k + 1]), __builtin_bit_cast(bf16x2_t, w[k + 1]), sr1, false);
                si1 = __builtin_amdgcn_fdot2_f32_bf16(__builtin_bit_cast(bf16x2_t, bip[k + 1]), __builtin_bit_cast(bf16x2_t, w[k + 1]), si1, false); }
            const float nr = ar * lr - ai * li + (sr0 + sr1); li = ar * li + ai * lr + (si0 + si1); lr = nr;
        }
        float* sl = SLOC + (size_t)item * 128 + lane;
        __hip_atomic_store(sl, lr, __ATOMIC_RELAXED, __HIP_MEMORY_SCOPE_AGENT); __hip_atomic_store(sl + 64, li, __ATOMIC_RELAXED, __HIP_MEMORY_SCOPE_AGENT);
        asm volatile("s_waitcnt vmcnt(0)" ::: "memory");
        if (lane == 0) __hip_atomic_store(flags + item, 1u, __ATOMIC_RELAXED, __HIP_MEMORY_SCOPE_AGENT);
        {
            unsigned sp_ = 0;
            for (;;) { const unsigned f = lane < c ? __hip_atomic_load(flags + (item - c + lane), __ATOMIC_RELAXED, __HIP_MEMORY_SCOPE_AGENT) : 1u;
                if (__builtin_amdgcn_ballot_w64(f == 0u) == 0ull || ++sp_ > (1u << 20)) break; __builtin_amdgcn_s_sleep(1); }
            __builtin_amdgcn_fence(__ATOMIC_ACQUIRE, "agent"); }
        asm volatile("s_waitcnt vmcnt(0)" ::: "memory");
    }
    if (FINAL) {
        const float qr = aq.z, qi = aq.w;
        const float* sl = SLOC + (size_t)((b * G_A + g) * S5NC) * 128 + lane;
        float psr[31], psi[31];
#pragma unroll
        for (int k = 0; k < 31; ++k) { const int kk = k < c ? k : 0; psr[k] = sl[kk * 128]; psi[k] = sl[kk * 128 + 64]; }
#pragma unroll
        for (int k = 0; k < 31; ++k) if (k < c) { const float t = qr * hr - qi * hi + psr[k]; hi = qr * hi + qi * hr + psi[k]; hr = t; }
    }
    LAS bf16* Hs = (LAS bf16*)wl;
    bf16x8 cfr[4];
    if (FINAL) { const bf16* ct = (const bf16*)(ws + WS_SMALL + SM_S5CT) + (size_t)((l * G_A + g) * S5G + (lane & 15)) * 128 + 8 * (lane >> 4);
#pragma unroll
        for (int ks = 0; ks < 4; ++ks) cfr[ks] = *(const GAS bf16x8*)(ct + 32 * ks); }
#pragma unroll 1
    for (int half = 0; half < 2; ++half) {
#pragma unroll 2
        for (int tt = 0; tt < 32; ++tt) {
            const int t = half * 32 + tt;
            unsigned w[8];
            w[0] = __builtin_amdgcn_readlane(u0.x, t); w[1] = __builtin_amdgcn_readlane(u0.y, t); w[2] = __builtin_amdgcn_readlane(u0.z, t); w[3] = __builtin_amdgcn_readlane(u0.w, t);
            w[4] = __builtin_amdgcn_readlane(u1.x, t); w[5] = __builtin_amdgcn_readlane(u1.y, t); w[6] = __builtin_amdgcn_readlane(u1.z, t); w[7] = __builtin_amdgcn_readlane(u1.w, t);
            float sr0 = 0.f, si0 = 0.f, sr1 = 0.f, si1 = 0.f;
#pragma unroll
            for (int k = 0; k < 8; k += 2) {
                sr0 = __builtin_amdgcn_fdot2_f32_bf16(__builtin_bit_cast(bf16x2_t, brp[k]), __builtin_bit_cast(bf16x2_t, w[k]), sr0, false);
                si0 = __builtin_amdgcn_fdot2_f32_bf16(__builtin_bit_cast(bf16x2_t, bip[k]), __builtin_bit_cast(bf16x2_t, w[k]), si0, false);
                sr1 = __builtin_amdgcn_fdot2_f32_bf16(__builtin_bit_cast(bf16x2_t, brp[k + 1]), __builtin_bit_cast(bf16x2_t, w[k + 1]), sr1, false);
                si1 = __builtin_amdgcn_fdot2_f32_bf16(__builtin_bit_cast(bf16x2_t, bip[k + 1]), __builtin_bit_cast(bf16x2_t, w[k + 1]), si1, false); }
            const float sr = sr0 + sr1, si = si0 + si1;
            const float nr = ar * hr - ai * hi + sr; hi = ar * hi + ai * hr + si; hr = nr;
            if (FINAL) { Hs[tt * HS_PITCH + lane] = (bf16)f2bf(hr); Hs[tt * HS_PITCH + 64 + lane] = (bf16)f2bf(hi); }
        }
        if (FINAL) {
            bf16* YB = (bf16*)(ws + WS_YB);
            const float* dsk = A->in[I_S5D] + l * D_A + g * 16;
#pragma unroll
            for (int tile = 0; tile < 2; ++tile) {
                f32x4 acc = {0.f, 0.f, 0.f, 0.f};
#pragma unroll
                for (int ks = 0; ks < 4; ++ks) { const bf16x8 a = *(const LAS bf16x8*)(Hs + (tile * 16 + (lane & 15)) * HS_PITCH + 32 * ks + 8 * (lane >> 4));
                    acc = __builtin_amdgcn_mfma_f32_16x16x32_bf16(a, cfr[ks], acc, 0, 0, 0); }
                const int hh = lane & 15; const float dd = dsk[hh];
#pragma unroll
                for (int r = 0; r < 4; ++r) { const int row = row0 + half * 32 + tile * 16 + 4 * (lane >> 4) + r;
                    const float u = bf2f(Us[(row - row0) * 16 + hh]);
                    YB[(size_t)row * 512 + g * 16 + hh] = (bf16)f2bf(gelu_tanh(acc[r] + dd * u)); }
            }
        }
    }
    if (!FINAL) { float* sl = SLOC + (size_t)item * 128 + lane; sl[0] = hr; sl[64] = hi; }
    if (FINAL && c == S5NC - 1) { const size_t o = (size_t)((l * NB + b) * G_A + g) * P_A + lane; out[O_S5RP + o] = hr; out[O_S5IP + o] = hi; }
}

__device__ __forceinline__ void s5_sample_item(KArgs A, unsigned char* ws, float* out, int l, int item, int lane) {
    const int g = item & 31, s = item >> 5, row = MPROMPT + s;
    const int lgp = (l * G_A + g) * P_A + lane;
    const f32x4 aq = *(const GAS f32x4*)((const float*)(ws + WS_SMALL + SM_S5A) + (size_t)lgp * 4);
    const bf16* PROJ = (const bf16*)(ws + WS_BIG);
    const GAS v4u* up = (const GAS v4u*)(PROJ + (size_t)row * N_INP + PC_UA + g * 16);
    const v4u u0 = up[0], u1 = up[1];
    float u[16]; u[0] = bflo(u0.x); u[1] = bfhi(u0.x); u[2] = bflo(u0.y); u[3] = bfhi(u0.y); u[4] = bflo(u0.z); u[5] = bfhi(u0.z); u[6] = bflo(u0.w); u[7] = bfhi(u0.w);
    u[8] = bflo(u1.x); u[9] = bfhi(u1.x); u[10] = bflo(u1.y); u[11] = bfhi(u1.y); u[12] = bflo(u1.z); u[13] = bfhi(u1.z); u[14] = bflo(u1.w); u[15] = bfhi(u1.w);
    const GAS f32x4* bb = (const GAS f32x4*)((const float*)(ws + WS_SMALL + SM_S5BB) + (size_t)lgp * 32);
    float sr = 0.f, si = 0.f;
#pragma unroll
    for (int q = 0; q < 4; ++q) { const f32x4 v = bb[q], w = bb[4 + q];
        sr += v.x * u[4 * q] + v.y * u[4 * q + 1] + v.z * u[4 * q + 2] + v.w * u[4 * q + 3];
        si += w.x * u[4 * q] + w.y * u[4 * q + 1] + w.z * u[4 * q + 2] + w.w * u[4 * q + 3]; }
    const size_t so = (size_t)((l * NS + s) * G_A + g) * P_A + lane;
    const float h0r = A->in[I_S5RE][so], h0i = A->in[I_S5IM][so];
    const float hr = aq.x * h0r - aq.y * h0i + sr, hi = aq.x * h0i + aq.y * h0r + si;
    out[O_S5RS + so] = hr; out[O_S5IS + so] = hi;
    const float* cre = A->in[I_CRE] + (size_t)((l * G_A + g) * S5G) * P_A + lane; const float* cim = A->in[I_CIM] + (size_t)((l * G_A + g) * S5G) * P_A + lane;
    float y16[16];
#pragma unroll
    for (int hh = 0; hh < 16; ++hh) y16[hh] = cre[hh * P_A] * hr - cim[hh * P_A] * hi;
    const float mine = wave_sum16(y16, lane);
    if (lane < 16) { const float dd = A->in[I_S5D][l * D_A + g * 16 + lane]; float uu = 0.f;
#pragma unroll
        for (int hh = 0; hh < 16; ++hh) uu = (lane == hh) ? u[hh] : uu;
        ((bf16*)(ws + WS_YB))[(size_t)row * 512 + g * 16 + lane] = (bf16)f2bf(gelu_tanh(mine + dd * uu)); }
}
__device__ __forceinline__ void gmlp_sample_item(KArgs A, unsigned char* ws, float* out, int l, int s, int lane) {
    const int row = MPROMPT + s, ch0 = lane * 8;
    const bf16* PROJ = (const bf16*)(ws + WS_BIG);
    const v4u vv = *(const GAS v4u*)(PROJ + (size_t)row * N_INP + PC_VB + ch0), uu = *(const GAS v4u*)(PROJ + (size_t)row * N_INP + PC_UB + ch0);
    const float rinv = rsqrtf(((const float*)(ws + WS_SMALL + SM_VSQ))[l * MP + row] * (1.0f / D_B) + EPS);
    const int h = ch0 >> 6;
    const float w00 = A->in[I_WS][(size_t)(l * H_B + h) * 128 * 128], b0 = A->in[I_BS][(l * H_B + h) * 128];
    float v[8] = {bflo(vv.x), bfhi(vv.x), bflo(vv.y), bfhi(vv.y), bflo(vv.z), bfhi(vv.z), bflo(vv.w), bfhi(vv.w)};
    float u[8] = {bflo(uu.x), bfhi(uu.x), bflo(uu.y), bfhi(uu.y), bflo(uu.z), bfhi(uu.z), bflo(uu.w), bfhi(uu.w)};
    const float* gv = A->in[I_GV] + l * D_B + ch0;
    float o[8];
#pragma unroll
    for (int j = 0; j < 8; ++j) { const float vn = v[j] * rinv * gv[j]; out[O_GVS + (size_t)(l * NS + s) * D_B + ch0 + j] = vn; o[j] = u[j] * (w00 * vn + b0); }
    v4u w; w.x = pk2(o[0], o[1]); w.y = pk2(o[2], o[3]); w.z = pk2(o[4], o[5]); w.w = pk2(o[6], o[7]);
    *(GAS v4u*)((bf16*)(ws + WS_OB) + (size_t)row * 512 + ch0) = w;
}
__device__ __forceinline__ void ssd_sample_item(KArgs A, unsigned char* ws, float* out, int l, int item, int lane, bool acc) {
    const int h = item & 15, s = item >> 4, row = MPROMPT + s, g = h >> 3;
    const bf16* PROJ = (const bf16*)(ws + WS_BIG);
    const float* cw = A->in[I_CONVW] + (size_t)l * K_C * D_XBC; const float* cb = A->in[I_CONVB] + l * D_XBC;
    const float* cst = A->in[I_SSDCONV] + (size_t)(l * NS + s) * 3 * D_XBC;
    float* cso = out + O_CCS + (size_t)(l * NS + s) * 3 * D_XBC;
    float x;
    {   const int ch = h * 64 + lane; const float p0 = cst[ch], p1 = cst[D_XBC + ch], p2 = cst[2 * D_XBC + ch], p3 = bf2f(PROJ[(size_t)row * N_INP + PC_XBC + ch]);
        x = siluf_(cb[ch] + cw[ch] * p0 + cw[D_XBC + ch] * p1 + cw[2 * D_XBC + ch] * p2 + cw[3 * D_XBC + ch] * p3);
        cso[ch] = p1; cso[D_XBC + ch] = p2; cso[2 * D_XBC + ch] = p3; }
    const int n4 = (lane & 31) * 4; float Bv[4], Cv[4];
#pragma unroll
    for (int j = 0; j < 4; ++j) {
        {   const int ch = D_C + g * N_C + n4 + j; const float p0 = cst[ch], p1 = cst[D_XBC + ch], p2 = cst[2 * D_XBC + ch], p3 = bf2f(PROJ[(size_t)row * N_INP + PC_XBC + ch]);
            Bv[j] = siluf_(cb[ch] + cw[ch] * p0 + cw[D_XBC + ch] * p1 + cw[2 * D_XBC + ch] * p2 + cw[3 * D_XBC + ch] * p3);
            if ((h & 7) == 0 && lane < 32) { cso[ch] = p1; cso[D_XBC + ch] = p2; cso[2 * D_XBC + ch] = p3; } }
        {   const int ch = D_C + G_C * N_C + g * N_C + n4 + j; const float p0 = cst[ch], p1 = cst[D_XBC + ch], p2 = cst[2 * D_XBC + ch], p3 = bf2f(PROJ[(size_t)row * N_INP + PC_XBC + ch]);
            Cv[j] = siluf_(cb[ch] + cw[ch] * p0 + cw[D_XBC + ch] * p1 + cw[2 * D_XBC + ch] * p2 + cw[3 * D_XBC + ch] * p3);
            if ((h & 7) == 0 && lane < 32) { cso[ch] = p1; cso[D_XBC + ch] = p2; cso[2 * D_XBC + ch] = p3; } }
    }
    const float dt = softplusf_(((const float*)(ws + WS_SMALL + SM_DT))[(size_t)row * 16 + h] + A->in[I_DTBIAS][l * H_C + h]);
    const float dA = __expf(dt * -__expf(A->in[I_ALOG][l * H_C + h]));
    const size_t sbase = (size_t)((l * NS + s) * H_C + h) * HD_C * N_C;
    const GAS f32x4* st = (const GAS f32x4*)(A->in[I_SSM] + sbase) + lane;
    GAS f32x4* so = (GAS f32x4*)(out + O_SSMS + sbase) + lane;
    float part[32];
#pragma unroll
    for (int i = 0; i < 32; ++i) {
        const float xe = lane_bcast(x, 2 * i), xo = lane_bcast(x, 2 * i + 1); const float xv = lane < 32 ? xe : xo; const float xd = xv * dt;
        f32x4 v = __builtin_nontemporal_load(st + 64 * i);
        v.x = v.x * dA + xd * Bv[0]; v.y = v.y * dA + xd * Bv[1]; v.z = v.z * dA + xd * Bv[2]; v.w = v.w * dA + xd * Bv[3];
        __builtin_nontemporal_store(v, so + 64 * i);
        part[i] = v.x * Cv[0] + v.y * Cv[1] + v.z * Cv[2] + v.w * Cv[3];
    }
    const float ymine = half_sum32(part, lane);
    const float xmine = __builtin_bit_cast(float, __builtin_amdgcn_ds_bpermute((2 * (lane & 31) + (lane >> 5)) << 2, __builtin_bit_cast(int, x)));
    const int p = 2 * (lane & 31) + (lane >> 5), ch = h * 64 + p;
    const float y = ymine + A->in[I_SSDD][l * H_C + h] * xmine;
    const float z = bf2f(PROJ[(size_t)row * N_INP + PC_Z + ch]);
    const float yz = y * siluf_(z);
    const float sq = wave_sum(yz * yz);
    if (lane == 0 && acc) atomicAdd((float*)(ws + WS_SMALL + SM_CSQ) + l * MP + row, sq);
    ((bf16*)(ws + WS_OC))[(size_t)row * 1024 + ch] = (bf16)f2bf(yz * A->in[I_GNORM][l * D_C + ch]);
}
constexpr int TP = 136;
__device__ __forceinline__ void gmlp_item(KArgs A, unsigned char* ws, int l, int item, LAS unsigned char* lds, int tid, int wave, int lane) {
    const int h = item & 7, c = (item >> 3) & 15, b = item >> 7, row0 = b * SEQ + c * GMC;
    const bf16* PROJ = (const bf16*)(ws + WS_BIG);
    LAS bf16* vT = (LAS bf16*)lds;
    {   const int tok = tid >> 2, part = tid & 3, d0 = part * 16, row = row0 + tok;
        const float rinv = rsqrtf(((const float*)(ws + WS_SMALL + SM_VSQ))[l * MP + row] * (1.0f / D_B) + EPS);
        const GAS v4u* vp = (const GAS v4u*)(PROJ + (size_t)row * N_INP + PC_VB + h * 64 + d0);
        const v4u a = vp[0], b2 = vp[1];
        const float* gv = A->in[I_GV] + l * D_B + h * 64 + d0;
        const unsigned wv[8] = {a.x, a.y, a.z, a.w, b2.x, b2.y, b2.z, b2.w};
#pragma unroll
        for (int k = 0; k < 8; ++k) { vT[(d0 + 2 * k) * TP + tok] = (bf16)f2bf(bflo(wv[k]) * rinv * gv[2 * k]); vT[(d0 + 2 * k + 1) * TP + tok] = (bf16)f2bf(bfhi(wv[k]) * rinv * gv[2 * k + 1]); }
    }
    const bf16* WSb = (const bf16*)(ws + WS_SMALL + SM_WS) + (size_t)(l * H_B + h) * 128 * 128;
    bf16x8 afr[4];
#pragma unroll
    for (int ks = 0; ks < 4; ++ks) afr[ks] = *(const GAS bf16x8*)(WSb + (size_t)(16 * wave + (lane & 15)) * 128 + 32 * ks + 8 * (lane >> 4));
    __syncthreads();
    f32x4 acc[4];
#pragma unroll
    for (int t = 0; t < 4; ++t) acc[t] = (f32x4){0.f, 0.f, 0.f, 0.f};
    const int nks = (wave >> 1) + 1;
#pragma unroll
    for (int ks = 0; ks < 4; ++ks) if (ks < nks) {
#pragma unroll
        for (int t = 0; t < 4; ++t) { const bf16x8 bfr = *(const LAS bf16x8*)(vT + (16 * t + (lane & 15)) * TP + 32 * ks + 8 * (lane >> 4));
            acc[t] = __builtin_amdgcn_mfma_f32_16x16x32_bf16(afr[ks], bfr, acc[t], 0, 0, 0); }
    }
    bf16* OB = (bf16*)(ws + WS_OB);
#pragma unroll
    for (int r = 0; r < 4; ++r) { const int i = 16 * wave + 4 * (lane >> 4) + r, row = row0 + i; const float bs = A->in[I_BS][(l * H_B + h) * 128 + i];
#pragma unroll
        for (int t = 0; t < 4; ++t) { const int ch = h * 64 + 16 * t + (lane & 15);
            const float u = bf2f(PROJ[(size_t)row * N_INP + PC_UB + ch]);
            OB[(size_t)row * 512 + ch] = (bf16)f2bf(u * (acc[t][r] + bs)); } }
    __syncthreads();
}

template <int NCH, bool TRANS>
__device__ __forceinline__ void conv_tile(KArgs A, const bf16* PROJ, int l, int b, int c, int chb, LAS bf16* tile, const LAS float* scale, int tid) {
    constexpr int LPR = NCH / 8, SLOTS = NTHR / LPR, TPT = 128 / SLOTS;
    const int cl = tid % LPR, slot = tid / LPR, ch0 = chb + cl * 8, t0 = slot * TPT;
    const float* cw = A->in[I_CONVW] + (size_t)l * K_C * D_XBC + ch0; const float* cb = A->in[I_CONVB] + l * D_XBC + ch0;
    float w[4][8], bias[8];
#pragma unroll
    for (int k = 0; k < 4; ++k) { const f32x4 a = *(const GAS f32x4*)(cw + k * D_XBC), b2 = *(const GAS f32x4*)(cw + k * D_XBC + 4);
        w[k][0] = a.x; w[k][1] = a.y; w[k][2] = a.z; w[k][3] = a.w; w[k][4] = b2.x; w[k][5] = b2.y; w[k][6] = b2.z; w[k][7] = b2.w; }
    {   const f32x4 a = *(const GAS f32x4*)cb, b2 = *(const GAS f32x4*)(cb + 4); bias[0] = a.x; bias[1] = a.y; bias[2] = a.z; bias[3] = a.w; bias[4] = b2.x; bias[5] = b2.y; bias[6] = b2.z; bias[7] = b2.w; }
    const int trow0 = c * SSDQ + t0;
    v4u raw[TPT + 3];
#pragma unroll
    for (int i = 0; i < TPT + 3; ++i) { const int tt = trow0 - 3 + i;
        raw[i] = tt >= 0 ? *(const GAS v4u*)(PROJ + (size_t)(b * SEQ + tt) * N_INP + PC_XBC + ch0) : (v4u){0u, 0u, 0u, 0u}; }
    float o[TPT][8];
#pragma unroll
    for (int t = 0; t < TPT; ++t) {
#pragma unroll
        for (int e = 0; e < 8; ++e) o[t][e] = bias[e];
#pragma unroll
        for (int k = 0; k < 4; ++k) { const v4u r = raw[t + k]; const unsigned rw[4] = {r.x, r.y, r.z, r.w};
#pragma unroll
            for (int e2 = 0; e2 < 4; ++e2) { o[t][2 * e2] = fmaf(w[k][2 * e2], bflo(rw[e2]), o[t][2 * e2]); o[t][2 * e2 + 1] = fmaf(w[k][2 * e2 + 1], bfhi(rw[e2]), o[t][2 * e2 + 1]); } }
        const float sc = scale ? scale[t0 + t] : 1.0f;
#pragma unroll
        for (int e = 0; e < 8; ++e) o[t][e] = siluf_(o[t][e]) * sc;
    }
    if (!TRANS) {
#pragma unroll
        for (int t = 0; t < TPT; ++t) { v4u wv; wv.x = pk2(o[t][0], o[t][1]); wv.y = pk2(o[t][2], o[t][3]); wv.z = pk2(o[t][4], o[t][5]); wv.w = pk2(o[t][6], o[t][7]);
            *(LAS v4u*)(tile + (t0 + t) * TP + cl * 8) = wv; }
    } else {
#pragma unroll
        for (int e = 0; e < 8; ++e) {
            if (TPT == 4) { v2u wv; wv.x = pk2(o[0][e], o[1][e]); wv.y = pk2(o[TPT > 2 ? 2 : 0][e], o[TPT > 3 ? 3 : 0][e]); *(LAS v2u*)(tile + (cl * 8 + e) * TP + t0) = wv; }
            else { *(LAS unsigned*)(tile + (cl * 8 + e) * TP + t0) = pk2(o[0][e], o[1][e]); }
        }
    }
}

__device__ __forceinline__ void ssd_dt_scan(KArgs A, unsigned char* ws, int l, int b, int c, int h, LAS float* dtv, LAS float* cs, int tid, int lane) {
    if (tid < 64) {
        const float* DT = (const float*)(ws + WS_SMALL + SM_DT); const float bias = A->in[I_DTBIAS][l * H_C + h], a = -__expf(A->in[I_ALOG][l * H_C + h]);
        const int row = b * SEQ + c * SSDQ + 2 * lane;
        const float d0 = softplusf_(DT[(size_t)row * 16 + h] + bias), d1 = softplusf_(DT[(size_t)(row + 1) * 16 + h] + bias);
        const float v0 = d0 * a, v1 = d1 * a; float s = v0 + v1;
#pragma unroll
        for (int o = 1; o < 64; o <<= 1) { const float t = __builtin_bit_cast(float, __builtin_amdgcn_ds_bpermute((lane - o) << 2, __builtin_bit_cast(int, s))); if (lane >= o) s += t; }
        dtv[2 * lane] = d0; dtv[2 * lane + 1] = d1; cs[2 * lane] = s - v1; cs[2 * lane + 1] = s;
    }
    __syncthreads();
}

constexpr int SL_CN = 0, SL_BN = 34816, SL_MW = 69632, SL_XT = 104448, SL_HP = 121856, SL_DT = 139264, SL_CS = SL_DT + 512, SL_SC = SL_CS + 512, SL_END = SL_SC + 512;

__device__ __forceinline__ void ssd_item1(KArgs A, unsigned char* ws, int l, int item, LAS unsigned char* lds, int tid, int wave, int lane) {
    const int h = item & 15, c = (item >> 4) & 15, b = item >> 8, g = h >> 3;
    const bf16* PROJ = (const bf16*)(ws + WS_BIG);
    LAS float* dtv = (LAS float*)(lds + SL_DT); LAS float* cs = (LAS float*)(lds + SL_CS); LAS float* sc = (LAS float*)(lds + SL_SC);
    LAS bf16* Xt = (LAS bf16*)(lds + SL_XT); LAS bf16* Bt = (LAS bf16*)(lds + SL_BN);
    (void)sc;
    conv_tile<64, true>(A, PROJ, l, b, c, h * 64, Xt, nullptr, tid);
    conv_tile<128, true>(A, PROJ, l, b, c, D_C + g * N_C, Bt, nullptr, tid);
    ssd_dt_scan(A, ws, l, b, c, h, dtv, cs, tid, lane);
    f32x4 acc[4];
#pragma unroll
    for (int t = 0; t < 4; ++t) acc[t] = (f32x4){0.f, 0.f, 0.f, 0.f};
    const float cse = cs[127];
#pragma unroll
    for (int ks = 0; ks < 4; ++ks) { const int j0 = 32 * ks + 8 * (lane >> 4);
        const v4u braw = *(const LAS v4u*)(Bt + (16 * wave + (lane & 15)) * TP + j0);
        const f32x4 d0 = *(const LAS f32x4*)(dtv + j0), d1 = *(const LAS f32x4*)(dtv + j0 + 4), c0 = *(const LAS f32x4*)(cs + j0), c1 = *(const LAS f32x4*)(cs + j0 + 4);
        v4u bs;
        bs.x = pk2(bflo(braw.x) * d0.x * __expf(cse - c0.x), bfhi(braw.x) * d0.y * __expf(cse - c0.y)); bs.y = pk2(bflo(braw.y) * d0.z * __expf(cse - c0.z), bfhi(braw.y) * d0.w * __expf(cse - c0.w));
        bs.z = pk2(bflo(braw.z) * d1.x * __expf(cse - c1.x), bfhi(braw.z) * d1.y * __expf(cse - c1.y)); bs.w = pk2(bflo(braw.w) * d1.z * __expf(cse - c1.z), bfhi(braw.w) * d1.w * __expf(cse - c1.w));
        const bf16x8 bfr = __builtin_bit_cast(bf16x8, bs);
#pragma unroll
        for (int t = 0; t < 4; ++t) { const bf16x8 af = *(const LAS bf16x8*)(Xt + (16 * t + (lane & 15)) * TP + 32 * ks + 8 * (lane >> 4));
            acc[t] = __builtin_amdgcn_mfma_f32_16x16x32_bf16(af, bfr, acc[t], 0, 0, 0); } }
    float* ST = (float*)(ws + WS_STATES) + (size_t)item * HD_C * N_C;
#pragma unroll
    for (int t = 0; t < 4; ++t)
#pragma unroll
        for (int r = 0; r < 4; ++r) ST[(size_t)(16 * t + 4 * (lane >> 4) + r) * N_C + 16 * wave + (lane & 15)] = acc[t][r];
    if (tid == 0) ((float*)(ws + WS_SMALL + SM_SDEC))[item] = __expf(cs[127]);
    __syncthreads();
}

__device__ __forceinline__ void ssd_item2(KArgs A, unsigned char* ws, float* out, int l, int item, LAS unsigned char* lds, int tid, int wave, int lane, bool acc) {
    const int h = item & 15, c = (item >> 4) & 15, b = item >> 8, g = h >> 3, row0 = b * SEQ + c * SSDQ;
    const bf16* PROJ = (const bf16*)(ws + WS_BIG);
    LAS float* dtv = (LAS float*)(lds + SL_DT); LAS float* cs = (LAS float*)(lds + SL_CS);
    LAS bf16* Cn = (LAS bf16*)(lds + SL_CN); LAS bf16* Bn = (LAS bf16*)(lds + SL_BN); LAS bf16* Mw = (LAS bf16*)(lds + SL_MW);
    LAS bf16* Xt = (LAS bf16*)(lds + SL_XT); LAS bf16* Hp = (LAS bf16*)(lds + SL_HP);
    conv_tile<64, true>(A, PROJ, l, b, c, h * 64, Xt, nullptr, tid);
    conv_tile<128, false>(A, PROJ, l, b, c, D_C + g * N_C, Bn, nullptr, tid);
    conv_tile<128, false>(A, PROJ, l, b, c, D_C + G_C * N_C + g * N_C, Cn, nullptr, tid);
    {   const float* ST = (const float*)(ws + WS_STATES) + (size_t)((b * 16) * 16 + h) * HD_C * N_C + tid * 4;
        const float* SD = (const float*)(ws + WS_SMALL + SM_SDEC) + (b * 16) * 16 + h;
        f32x4 hv[4];
#pragma unroll
        for (int k = 0; k < 4; ++k) hv[k] = (f32x4){0.f, 0.f, 0.f, 0.f};
        int cc = 0;
        for (; cc + 4 <= c; cc += 4) { f32x4 sv[4][4]; float d[4];
#pragma unroll
            for (int q = 0; q < 4; ++q) { d[q] = SD[(cc + q) * 16];
#pragma unroll
                for (int k = 0; k < 4; ++k) sv[q][k] = *(const GAS f32x4*)(ST + (size_t)(cc + q) * 16 * 8192 + 2048 * k); }
#pragma unroll
            for (int q = 0; q < 4; ++q)
#pragma unroll
                for (int k = 0; k < 4; ++k) hv[k] = hv[k] * d[q] + sv[q][k]; }
        for (; cc < c; ++cc) { const float d = SD[cc * 16];
#pragma unroll
            for (int k = 0; k < 4; ++k) hv[k] = hv[k] * d + *(const GAS f32x4*)(ST + (size_t)cc * 16 * 8192 + 2048 * k); }
#pragma unroll
        for (int k = 0; k < 4; ++k) { v2u wv; wv.x = pk2(hv[k].x, hv[k].y); wv.y = pk2(hv[k].z, hv[k].w); *(LAS v2u*)(Hp + ((tid >> 5) + 16 * k) * TP + (tid & 31) * 4) = wv; }
        if (c == SSDNC - 1) { const float d = SD[c * 16]; float* o = out + O_SSMP + (size_t)((l * NB + b) * H_C + h) * HD_C * N_C + tid * 4;
#pragma unroll
            for (int k = 0; k < 4; ++k) *(GAS f32x4*)(o + 2048 * k) = hv[k] * d + *(const GAS f32x4*)(ST + (size_t)c * 16 * 8192 + 2048 * k); }
    }
    ssd_dt_scan(A, ws, l, b, c, h, dtv, cs, tid, lane);
    bf16x8 cf[4];
#pragma unroll
    for (int ks = 0; ks < 4; ++ks) cf[ks] = *(const LAS bf16x8*)(Cn + (16 * wave + (lane & 15)) * TP + 32 * ks + 8 * (lane >> 4));
    const int jtmax = wave | 1;
    for (int jt = 0; jt <= jtmax; ++jt) {
        f32x4 gacc = {0.f, 0.f, 0.f, 0.f};
        if (jt <= wave) {
#pragma unroll
            for (int ks = 0; ks < 4; ++ks) { const bf16x8 bfr = *(const LAS bf16x8*)(Bn + (16 * jt + (lane & 15)) * TP + 32 * ks + 8 * (lane >> 4));
                gacc = __builtin_amdgcn_mfma_f32_16x16x32_bf16(cf[ks], bfr, gacc, 0, 0, 0); }
        }
        const int j = 16 * jt + (lane & 15); const float csj = cs[j], dtj = dtv[j];
#pragma unroll
        for (int r = 0; r < 4; ++r) { const int i = 16 * wave + 4 * (lane >> 4) + r;
            const float m = (j <= i) ? gacc[r] * __expf(cs[i] - csj) * dtj : 0.f;
            Mw[i * TP + j] = (bf16)f2bf(m); }
    }
    f32x4 yd[4], yo[4];
#pragma unroll
    for (int t = 0; t < 4; ++t) { yd[t] = (f32x4){0.f, 0.f, 0.f, 0.f}; yo[t] = (f32x4){0.f, 0.f, 0.f, 0.f}; }
    const int nks = (wave >> 1) + 1;
    for (int ks = 0; ks < nks; ++ks) { const bf16x8 mf = *(const LAS bf16x8*)(Mw + (16 * wave + (lane & 15)) * TP + 32 * ks + 8 * (lane >> 4));
#pragma unroll
        for (int t = 0; t < 4; ++t) { const bf16x8 xf = *(const LAS bf16x8*)(Xt + (16 * t + (lane & 15)) * TP + 32 * ks + 8 * (lane >> 4));
            yd[t] = __builtin_amdgcn_mfma_f32_16x16x32_bf16(mf, xf, yd[t], 0, 0, 0); } }
#pragma unroll
    for (int ks = 0; ks < 4; ++ks)
#pragma unroll
        for (int t = 0; t < 4; ++t) { const bf16x8 hf = *(const LAS bf16x8*)(Hp + (16 * t + (lane & 15)) * TP + 32 * ks + 8 * (lane >> 4));
            yo[t] = __builtin_amdgcn_mfma_f32_16x16x32_bf16(cf[ks], hf, yo[t], 0, 0, 0); }
    const float dsk = A->in[I_SSDD][l * H_C + h];
    bf16* OC = (bf16*)(ws + WS_OC); float* csq = (float*)(ws + WS_SMALL + SM_CSQ) + l * MP;
#pragma unroll
    for (int r = 0; r < 4; ++r) { const int i = 16 * wave + 4 * (lane >> 4) + r, row = row0 + i; const float ecs = __expf(cs[i]); float sq = 0.f;
#pragma unroll
        for (int t = 0; t < 4; ++t) { const int p = 16 * t + (lane & 15), ch = h * 64 + p;
            const float x = bf2f(Xt[p * TP + i]);
            const float y = yd[t][r] + ecs * yo[t][r] + dsk * x;
            const float z = bf2f(PROJ[(size_t)row * N_INP + PC_Z + ch]);
            const float yz = y * siluf_(z); sq += yz * yz;
            OC[(size_t)row * 1024 + ch] = (bf16)f2bf(yz * A->in[I_GNORM][l * D_C + ch]); }
        sq += xor_lt32<1>(sq); sq += xor_lt32<2>(sq); sq += xor_lt32<4>(sq); sq += xor_lt32<8>(sq);
        if ((lane & 15) == 0 && acc) atomicAdd(csq + row, sq); }
    __syncthreads();
}

__device__ __forceinline__ void ssd_item_fused(KArgs A, unsigned char* ws, float* out, int l, int item, LAS unsigned char* lds, int tid, int wave, int lane, bool acc, unsigned* flags) {
    const int h = item & 15, c = (item >> 4) & 15, b = item >> 8, g = h >> 3, row0 = b * SEQ + c * SSDQ;
    const bf16* PROJ = (const bf16*)(ws + WS_BIG);
    LAS float* dtv = (LAS float*)(lds + SL_DT); LAS float* cs = (LAS float*)(lds + SL_CS);
    LAS bf16* Cn = (LAS bf16*)(lds + SL_CN); LAS bf16* Bn = (LAS bf16*)(lds + SL_BN); LAS bf16* Mw = (LAS bf16*)(lds + SL_MW);
    LAS bf16* Xt = (LAS bf16*)(lds + SL_XT); LAS bf16* Hp = (LAS bf16*)(lds + SL_HP);
    conv_tile<64, true>(A, PROJ, l, b, c, h * 64, Xt, nullptr, tid);
    conv_tile<128, false>(A, PROJ, l, b, c, D_C + g * N_C, Bn, nullptr, tid);
    conv_tile<128, true>(A, PROJ, l, b, c, D_C + g * N_C, Mw, nullptr, tid);
    conv_tile<128, false>(A, PROJ, l, b, c, D_C + G_C * N_C + g * N_C, Cn, nullptr, tid);
    bf16 zz[4][4];
#pragma unroll
    for (int r = 0; r < 4; ++r)
#pragma unroll
        for (int t = 0; t < 4; ++t) zz[r][t] = PROJ[(size_t)(row0 + 16 * wave + 4 * (lane >> 4) + r) * N_INP + PC_Z + h * 64 + 16 * t + (lane & 15)];
    ssd_dt_scan(A, ws, l, b, c, h, dtv, cs, tid, lane);
    {   f32x4 sacc[4];
#pragma unroll
        for (int t = 0; t < 4; ++t) sacc[t] = (f32x4){0.f, 0.f, 0.f, 0.f};
        const float cse = cs[127];
#pragma unroll
        for (int ks = 0; ks < 4; ++ks) { const int j0 = 32 * ks + 8 * (lane >> 4);
            const v4u braw = *(const LAS v4u*)(Mw + (16 * wave + (lane & 15)) * TP + j0);
            const f32x4 d0 = *(const LAS f32x4*)(dtv + j0), d1 = *(const LAS f32x4*)(dtv + j0 + 4), c0 = *(const LAS f32x4*)(cs + j0), c1 = *(const LAS f32x4*)(cs + j0 + 4);
            v4u bs;
            bs.x = pk2(bflo(braw.x) * d0.x * __expf(cse - c0.x), bfhi(braw.x) * d0.y * __expf(cse - c0.y)); bs.y = pk2(bflo(braw.y) * d0.z * __expf(cse - c0.z), bfhi(braw.y) * d0.w * __expf(cse - c0.w));
            bs.z = pk2(bflo(braw.z) * d1.x * __expf(cse - c1.x), bfhi(braw.z) * d1.y * __expf(cse - c1.y)); bs.w = pk2(bflo(braw.w) * d1.z * __expf(cse - c1.z), bfhi(braw.w) * d1.w * __expf(cse - c1.w));
            const bf16x8 bfr = __builtin_bit_cast(bf16x8, bs);
#pragma unroll
            for (int t = 0; t < 4; ++t) { const bf16x8 af = *(const LAS bf16x8*)(Xt + (16 * t + (lane & 15)) * TP + 32 * ks + 8 * (lane >> 4));
                sacc[t] = __builtin_amdgcn_mfma_f32_16x16x32_bf16(bfr, af, sacc[t], 0, 0, 0); } }
        {   const __amdgpu_buffer_rsrc_t srs = __builtin_amdgcn_make_buffer_rsrc((void*)((float*)(ws + WS_STATES) + (size_t)item * HD_C * N_C), (short)0, HD_C * N_C * 4, 0x00020000);
#pragma unroll
            for (int t = 0; t < 4; ++t) __builtin_amdgcn_raw_buffer_store_b128(__builtin_bit_cast(v4u, sacc[t]), srs, (unsigned)((16 * t + (lane & 15)) * N_C + 16 * wave + 4 * (lane >> 4)) * 4u, 0,   16); }
        if (tid == 0) __hip_atomic_store((float*)(ws + WS_SMALL + SM_SDEC) + item, __expf(cse), __ATOMIC_RELAXED, __HIP_MEMORY_SCOPE_AGENT);
        asm volatile("s_waitcnt vmcnt(0)" ::: "memory"); __syncthreads();
        if (tid == 0) __hip_atomic_store(flags + item, 1u, __ATOMIC_RELAXED, __HIP_MEMORY_SCOPE_AGENT);
    }
    bf16x8 cf[4];
#pragma unroll
    for (int ks = 0; ks < 4; ++ks) cf[ks] = *(const LAS bf16x8*)(Cn + (16 * wave + (lane & 15)) * TP + 32 * ks + 8 * (lane >> 4));
    const int jtmax = wave | 1;
    for (int jt = 0; jt <= jtmax; ++jt) {
        f32x4 gacc = {0.f, 0.f, 0.f, 0.f};
        if (jt <= wave) {
#pragma unroll
            for (int ks = 0; ks < 4; ++ks) { const bf16x8 bfr = *(const LAS bf16x8*)(Bn + (16 * jt + (lane & 15)) * TP + 32 * ks + 8 * (lane >> 4));
                gacc = __builtin_amdgcn_mfma_f32_16x16x32_bf16(cf[ks], bfr, gacc, 0, 0, 0); }
        }
        const int j = 16 * jt + (lane & 15); const float csj = cs[j], dtj = dtv[j];
#pragma unroll
        for (int r = 0; r < 4; ++r) { const int i = 16 * wave + 4 * (lane >> 4) + r;
            const float m = (j <= i) ? gacc[r] * __expf(cs[i] - csj) * dtj : 0.f;
            Mw[i * TP + j] = (bf16)f2bf(m); }
    }
    f32x4 yd[4], yo[4];
#pragma unroll
    for (int t = 0; t < 4; ++t) { yd[t] = (f32x4){0.f, 0.f, 0.f, 0.f}; yo[t] = (f32x4){0.f, 0.f, 0.f, 0.f}; }
    const int nks = (wave >> 1) + 1;
    for (int ks = 0; ks < nks; ++ks) { const bf16x8 mf = *(const LAS bf16x8*)(Mw + (16 * wave + (lane & 15)) * TP + 32 * ks + 8 * (lane >> 4));
#pragma unroll
        for (int t = 0; t < 4; ++t) { const bf16x8 xf = *(const LAS bf16x8*)(Xt + (16 * t + (lane & 15)) * TP + 32 * ks + 8 * (lane >> 4));
            yd[t] = __builtin_amdgcn_mfma_f32_16x16x32_bf16(mf, xf, yd[t], 0, 0, 0); } }
    if (tid < 64) {
        unsigned sp_ = 0;
        for (;;) { const unsigned f = lane < c ? __hip_atomic_load(flags + ((b * 16 + lane) * 16 + h), __ATOMIC_RELAXED, __HIP_MEMORY_SCOPE_AGENT) : 1u;
            if (__builtin_amdgcn_ballot_w64(f == 0u) == 0ull || ++sp_ > (1u << 20)) break; __builtin_amdgcn_s_sleep(1); }
        __builtin_amdgcn_fence(__ATOMIC_ACQUIRE, "agent"); asm volatile("s_waitcnt vmcnt(0)" ::: "memory"); }
    __syncthreads();
    {   const float* ST = (const float*)(ws + WS_STATES) + (size_t)((b * 16) * 16 + h) * HD_C * N_C + tid * 4;
        const float* SD = (const float*)(ws + WS_SMALL + SM_SDEC) + (b * 16) * 16 + h;
        f32x4 hv[4];
#pragma unroll
        for (int k = 0; k < 4; ++k) hv[k] = (f32x4){0.f, 0.f, 0.f, 0.f};
        for (int cc = 0; cc < c; cc += 4) { f32x4 sv[4][4]; float d[4];
#pragma unroll
            for (int q = 0; q < 4; ++q) { const int cq = cc + q < c ? cc + q : c - 1; d[q] = SD[cq * 16];
#pragma unroll
                for (int k = 0; k < 4; ++k) sv[q][k] = *(const GAS f32x4*)(ST + (size_t)cq * 16 * 8192 + 2048 * k); }
#pragma unroll
            for (int q = 0; q < 4; ++q) if (cc + q < c) {
#pragma unroll
                for (int k = 0; k < 4; ++k) hv[k] = hv[k] * d[q] + sv[q][k]; } }
#pragma unroll
        for (int k = 0; k < 4; ++k) { v2u wv; wv.x = pk2(hv[k].x, hv[k].y); wv.y = pk2(hv[k].z, hv[k].w); *(LAS v2u*)(Hp + ((tid >> 5) + 16 * k) * TP + (tid & 31) * 4) = wv; }
        if (c == SSDNC - 1) { const float d = SD[c * 16]; float* o = out + O_SSMP + (size_t)((l * NB + b) * H_C + h) * HD_C * N_C + tid * 4;
#pragma unroll
            for (int k = 0; k < 4; ++k) *(GAS f32x4*)(o + 2048 * k) = hv[k] * d + *(const GAS f32x4*)(ST + (size_t)c * 16 * 8192 + 2048 * k); }
    }
    __syncthreads();
#pragma unroll
    for (int ks = 0; ks < 4; ++ks)
#pragma unroll
        for (int t = 0; t < 4; ++t) { const bf16x8 hf = *(const LAS bf16x8*)(Hp + (16 * t + (lane & 15)) * TP + 32 * ks + 8 * (lane >> 4));
            yo[t] = __builtin_amdgcn_mfma_f32_16x16x32_bf16(cf[ks], hf, yo[t], 0, 0, 0); }
    const float dsk = A->in[I_SSDD][l * H_C + h];
    bf16* OC = (bf16*)(ws + WS_OC); float* csq = (float*)(ws + WS_SMALL + SM_CSQ) + l * MP;
#pragma unroll
    for (int r = 0; r < 4; ++r) { const int i = 16 * wave + 4 * (lane >> 4) + r, row = row0 + i; const float ecs = __expf(cs[i]); float sq = 0.f;
#pragma unroll
        for (int t = 0; t < 4; ++t) { const int p = 16 * t + (lane & 15), ch = h * 64 + p;
            const float x = bf2f(Xt[p * TP + i]);
            const float y = yd[t][r] + ecs * yo[t][r] + dsk * x;
            const float z = bf2f(zz[r][t]);
            const float yz = y * siluf_(z); sq += yz * yz;
            OC[(size_t)row * 1024 + ch] = (bf16)f2bf(yz * A->in[I_GNORM][l * D_C + ch]); }
        sq += xor_lt32<1>(sq); sq += xor_lt32<2>(sq); sq += xor_lt32<4>(sq); sq += xor_lt32<8>(sq);
        if ((lane & 15) == 0 && acc) atomicAdd(csq + row, sq); }
    __syncthreads();
}
__device__ __forceinline__ void phase_upfix(const Frame& F0, KArgs A, int l) {
    Frame F = launder(F0);
    const float* HALO = WSP(const float, WS_HALO); bf16* ACT = WSP(bf16, WS_T);
    const float* cw = A->in[I_FCONVW] + (size_t)l * K_F * D_UP; const float* cb = A->in[I_FCONVB] + (size_t)l * D_UP;
    const int gt = blockIdx.x * NTHR + F.tid, NT = GRID * NTHR;
    for (int i = gt; i < 32 * D_FF; i += NT) { const int ch = i % D_FF, pm = i / D_FF; if ((pm & 7) == 0) continue;
        const int ca_ = 256 * (ch / 128) + ch % 128, cb_ = ca_ + 128;
        const float* hp = HALO + ((size_t)(pm - 1) * 4 + 2) * D_UP; const float* hc = HALO + (size_t)pm * 4 * D_UP;
        const float am2 = hp[ca_], am1 = hp[D_UP + ca_], a0 = hc[ca_], a1 = hc[D_UP + ca_], bm2 = hp[cb_], bm1 = hp[D_UP + cb_], b0 = hc[cb_], b1 = hc[D_UP + cb_];
        const float wa0 = cw[ch], wa1 = cw[D_UP + ch], wa2 = cw[2 * D_UP + ch], wb0 = cw[D_FF + ch], wb1 = cw[D_UP + D_FF + ch], wb2 = cw[2 * D_UP + D_FF + ch], ba = cb[ch], bb = cb[D_FF + ch];
        const float r0 = siluf_(ba + wa0 * am2 + wa1 * am1 + wa2 * a0) * (bb + wb0 * bm2 + wb1 * bm1 + wb2 * b0);
        const float r1 = siluf_(ba + wa0 * am1 + wa1 * a0 + wa2 * a1) * (bb + wb0 * bm1 + wb1 * b0 + wb2 * b1);
        ACT[(size_t)(pm * 256) * D_FF + ch] = (bf16)f2bf(r0); ACT[(size_t)(pm * 256 + 1) * D_FF + ch] = (bf16)f2bf(r1); }
    for (int i = gt; i < NB * 2 * D_UP; i += NT) { const int oc = i % D_UP, k = (i / D_UP) & 1, b = i / (2 * D_UP);
        const int c = oc < D_FF ? 256 * (oc / 128) + oc % 128 : 256 * ((oc - D_FF) / 128) + 128 + (oc - D_FF) % 128;
        F.out[O_CFP + (size_t)l * NB * 2 * D_UP + i] = HALO[((size_t)(8 * b + 7) * 4 + 2 + k) * D_UP + c]; }
}
__device__ __forceinline__ void ssd_conv_p_out(const Frame& F0, int l) {
    Frame F = launder(F0);
    const bf16* PROJ = WSP(const bf16, WS_BIG);
    const int gt = blockIdx.x * NTHR + F.tid, NT = GRID * NTHR;
    for (int i = gt; i < NB * 3 * D_XBC; i += NT) { const int ch = i % D_XBC, k = (i / D_XBC) % 3, b = i / (3 * D_XBC);
        F.out[O_CCP + (size_t)l * NB * 3 * D_XBC + i] = bf2f(PROJ[(size_t)(b * SEQ + SEQ - 3 + k) * N_INP + PC_XBC + ch]); }
}

__device__ __forceinline__ void phase_mix1(const Frame& F0, KArgs A, int l, bool acc) {
    {   Frame F = launder(F0);
        for (int it = F.gw; it < NS * G_A; it += (GRID * NWAVES)) s5_sample_item(A, F.ws, F.out, l, it, F.lane); }
    {   Frame F = launder(F0);
        for (int it = F.gw; it < NS; it += (GRID * NWAVES)) gmlp_sample_item(A, F.ws, F.out, l, it, F.lane); }
    {   Frame F = launder(F0);
        for (int it = F.gw; it < NS * H_C; it += (GRID * NWAVES)) ssd_sample_item(A, F.ws, F.out, l, it, F.lane, acc); }
    ssd_conv_p_out(F0, l);
}
__device__ __forceinline__ void phase_mix2(const Frame& F0, KArgs A, int l, bool acc) {
#ifndef REP_SSD2
#define REP_SSD2 1
#endif
#ifndef REP_GMLP
#define REP_GMLP 1
#endif
#ifndef REP_S5F
#define REP_S5F 1
#endif
    _Pragma("unroll 1") for (int r2 = 0; r2 < REP_SSD2; ++r2) {   Frame F = launder(F0);
        for (int it = blockIdx.x; it < NB * SSDNC * H_C; it += GRID) ssd_item_fused(A, F.ws, F.out, l, it, F.lds, F.tid, F.wave, F.lane, acc && r2 == 0, (unsigned*)(F.ws + WS_CTL) + CW_SSDF + l * 1024); }
    _Pragma("unroll 1") for (int r2 = 0; r2 < REP_GMLP; ++r2) {   Frame F = launder(F0);
        for (int it = blockIdx.x; it < NB * (SEQ / GMC) * H_B; it += GRID) gmlp_item(A, F.ws, l, it, F.lds, F.tid, F.wave, F.lane); }
    _Pragma("unroll 1") for (int r2 = 0; r2 < REP_S5F; ++r2) {   Frame F = launder(F0);
        for (int it = F.gw; it < NB * G_A * S5NC; it += (GRID * NWAVES)) s5_item<true>(A, F.ws, F.out, l, it, F.lds + F.wave * 10752, F.lane, (unsigned*)(F.ws + WS_CTL) + CW_S5F + l * 4096); }
}

constexpr int LDS_BYTES = 147456, MISC_OFF = 147456 - 256;
#ifndef GEMM_SP2
#define GEMM_SP2 true
#endif
template <class Epi>
__device__ __forceinline__ void run_gemm(const Frame& F, const bf16* Am, const bf16* Bt, int M, int N, int K, const Epi& E) {
    pg8::Gemm g{Am, Bt, M, N, K}; pg8::StaticOrder S; S.init(M, N, GRID, (int)blockIdx.x, K);
    pg8::gemm_phase<Epi, pg8::StaticOrder, true, GEMM_SP2>(F.lds, g, S, E);
}
struct SplitSched {
    pg8::StaticOrder P; int c, np, nsl, ntsl, ns, cbase, cu0, sid0;
    __device__ void init(int N, int K, int c_, int nsl_, int cbase_, int cu0_, int sid0_) { sid0 = sid0_; P.init(MPROMPT, N, GRID, c_, K); c = c_; np = (MPROMPT / 256) * (N / 256) / GRID; nsl = nsl_; ntsl = (K / 64) / nsl_; ns = (N / 256) * nsl_; cbase = cbase_; cu0 = cu0_; }
    __device__ bool next(int i, pg8::Unit& u) const {
        const int s = c - cu0; const bool has = s >= 0 && s < ns;
        if (!has || i > 0) return (i - (has ? 1 : 0)) < np ? P.next(i - (has ? 1 : 0), u) : false;
        u.pm = MPROMPT / 256; u.pn = s / nsl; u.k0 = (s % nsl) * ntsl * 64; u.nt = ntsl; u.cidx = cbase + u.pn; u.sid = sid0 + s; return true;
    }
    __device__ __forceinline__ void a_ready(const pg8::Unit&) const {}
    __device__ __forceinline__ void done(const pg8::Unit&) const {}
};
template <class Epi, bool CHAIN_IN>
__device__ __forceinline__ void run_gemm_chain(const Frame& F, const bf16* Am, const bf16* Bt, int K, const Epi& E, pg8::f32x4 (&acc)[2][2][4][2]) {
    pg8::Gemm g{Am, Bt, MPROMPT, DM, K}; pg8::StaticOrder S; S.init(MPROMPT, DM, GRID, (int)blockIdx.x, K);
    pg8::gemm_phase<Epi, pg8::StaticOrder, true, GEMM_SP2, CHAIN_IN>(F.lds, g, S, E, acc);
}
template <class Epi>
__device__ __forceinline__ void run_gemm_split(const Frame& F, const bf16* Am, const bf16* Bt, int N, int K, const Epi& E, int nsl, int cbase, int cu0, int sid0 = 0, int fin0 = -1) {
    pg8::Gemm g{Am, Bt, MP, N, K}; SplitSched S; S.init(N, K, (int)blockIdx.x, nsl, cbase, cu0, sid0);
    pg8::gemm_phase<Epi, SplitSched, true, GEMM_SP2>(F.lds, g, S, E);
    if constexpr (!Epi::AFTER_DRAIN) {
        const int f = epi::opaque_bx() - fin0;
        if (fin0 >= 0 && f >= 0 && f < N / 256) { int t2 = threadIdx.x; asm volatile("" : "+v"(t2)); const int lane = t2 & 63, wid = __builtin_amdgcn_readfirstlane(t2 >> 6);
            const pg8::Unit u = epi::final_unit(f, cbase); E.final(u, wid >> 2, wid & 3, lane & 15, lane >> 4, wid, lane); }
    }
}

#ifndef REP_PROLOGUE
#define REP_PROLOGUE 1
#endif
#ifndef REP_MOD
#define REP_MOD 1
#endif
#ifndef REP_PREP
#define REP_PREP 1
#endif
#ifndef REP_WIN
#define REP_WIN 1
#endif
#ifndef REP_MIX1
#define REP_MIX1 1
#endif
#ifndef REP_MIX2
#define REP_MIX2 1
#endif
#ifndef REP_GLU
#define REP_GLU 1
#endif
#ifndef REP_MERGE
#define REP_MERGE 1
#endif
#ifndef REP_OUT
#define REP_OUT 1
#endif
#ifndef REP_UP
#define REP_UP 1
#endif
#ifndef REP_CONV
#define REP_CONV 1
#endif
#ifndef REP_DOWN
#define REP_DOWN 1
#endif
#ifndef REP_BAR
#define REP_BAR 1
#endif
#define REP(n) _Pragma("unroll 1") for (int rep_ = 0; rep_ < (n); ++rep_)
__device__ __forceinline__ void grid_bar(const Frame& F0) {
    unsigned long long w = (unsigned long long)F0.ws; unsigned x = xb_xcc_id(); asm volatile("" : "+s"(w), "+s"(x));
    XcdBarrier b; b.bar = (unsigned*)((unsigned char*)w + WS_CTL) + CW_BAR; b.x = x; b.st = (volatile LAS unsigned*)(F0.lds + MISC_OFF) + 8;
    xcd_barrier(b);
}
__global__ void __launch_bounds__(NTHR, 2) mega_fwd(Args Aarg) {
    const KArgs A0 = (KArgs)__builtin_amdgcn_kernarg_segment_ptr(); (void)Aarg;
#define A launder_args(A0)
    extern __shared__ __attribute__((aligned(16))) unsigned char lds_raw[];
    Frame F;
    F.lds = (LAS unsigned char*)lds_raw;
    F.tid = threadIdx.x; F.lane = F.tid & 63; F.wave = __builtin_amdgcn_readfirstlane(F.tid >> 6);
    F.gw = blockIdx.x * NWAVES + F.wave;
    F.out = A0->out; F.ws = A0->ws;
    volatile LAS unsigned* MISC = (volatile LAS unsigned*)(F.lds + MISC_OFF);
    if (F.tid < 64) MISC[F.tid] = 0u;
    __syncthreads();
    (void)xcd_barrier_post((unsigned*)(F.ws + WS_CTL) + CW_BAR, MISC + 8);
#define GRID_BAR() do { REP(REP_BAR) grid_bar(F); } while (0)
#ifndef TIME_PHASE
#define TIME_PHASE -1
#endif
    unsigned long long tacc_ = 0ull, tbeg_ = 0ull;
#define TBEG(k) do { if (TIME_PHASE == (k)) tbeg_ = __builtin_amdgcn_s_memrealtime(); } while (0)
#define TEND(k) do { if (TIME_PHASE == (k)) tacc_ += __builtin_amdgcn_s_memrealtime() - tbeg_; } while (0)

#ifndef REP_MODS
#define REP_MODS 1
#endif
    REP(REP_PROLOGUE) { _Pragma("unroll 1") for (int rm = 0; rm < REP_MODS; ++rm) phase_mod(F, A); phase_prologue(F, A);
    GRID_BAR(); }
#pragma unroll 1
    for (int l = 0; l < DEPTH; ++l) {
#define PH_FRAME() const Frame Fq = launder(F); unsigned char* const wsq = Fq.ws; unsigned char* const wl = wsq + WS_W + (size_t)l * WL_END; \
        const float* const modl = (const float*)(wsq + WS_MOD) + (size_t)l * N_MOD; pg8::f32x4* const slab = (pg8::f32x4*)(wsq + WS_SLAB); \
        unsigned* const cnt = (unsigned*)(wsq + WS_CTL) + CW_CNT; (void)wl; (void)modl; (void)slab; (void)cnt
#define WSQ(T, off) ((T*)(wsq + (off)))
        if (l == 0) REP(REP_PREP) { { PH_FRAME(); phase_prep<true>(Fq, A->in[I_XP], A->in[I_XS], A->in[I_GMIX] + l * DM, modl, 0, 1, A->in[I_WIN] + (size_t)l * DM * N_IN, WSQ(float, WS_SMALL + SM_DT)); }
        GRID_BAR(); }
        REP(REP_WIN) { { PH_FRAME(); epi::EpiIn E{WSQ(bf16, WS_BIG), rep_ == 0 ? WSQ(float, WS_SMALL + SM_VSQ) + l * MP : nullptr, epi::SplitCtl{slab, cnt, 4u, 160, (l * 4 + 0) * 64}};
            run_gemm_split(Fq, WSQ(const bf16, WS_H), (const bf16*)(wl + WL_IN), N_INP, DM, E, 4, (l * 4 + 0) * 64, 0, 0, 160); }
        GRID_BAR(); }
        REP(REP_MIX2) { phase_mix2(F, A, l, rep_ == 0); phase_mix1(F, A, l, rep_ == 0);
        GRID_BAR(); }
        REP(REP_GLU) { { PH_FRAME(); epi::EpiGlu E{WSQ(const bf16, WS_YB), WSQ(bf16, WS_OA)};
            run_gemm(Fq, WSQ(const bf16, WS_YB), (const bf16*)(wl + WL_GLU), MP, 512, 512, E); }
        GRID_BAR(); }
        TBEG(5);
        REP(REP_MERGE) {
            TBEG(10);
            {   PH_FRAME(); bf16* BIG = WSQ(bf16, WS_BIG);
                epi::EpiMerge<0> Ea{BIG + PC_GA, WSQ(float, WS_T), WSQ(bf16, WS_MERGED), WSQ(const float, WS_SMALL + SM_CSQ) + l * MP, slab, BIG, cnt};
                run_gemm_split(Fq, WSQ(const bf16, WS_OA), (const bf16*)(wl + WL_PA), DM, 512, Ea, 2, (l * 4 + 1) * 64, 0, 0); }
            TEND(10); TBEG(11);
            {   PH_FRAME(); bf16* BIG = WSQ(bf16, WS_BIG);
                epi::EpiMerge<1> Eb{BIG + PC_GB, WSQ(float, WS_T), WSQ(bf16, WS_MERGED), WSQ(const float, WS_SMALL + SM_CSQ) + l * MP, slab, BIG, cnt};
                run_gemm_split(Fq, WSQ(const bf16, WS_OB), (const bf16*)(wl + WL_PB), DM, 512, Eb, 2, (l * 4 + 1) * 64, 16, 16); }
            TEND(11); TBEG(12);
            {   PH_FRAME(); bf16* BIG = WSQ(bf16, WS_BIG);
                epi::EpiMerge<2> Ec{BIG + PC_GC, WSQ(float, WS_T), WSQ(bf16, WS_MERGED), WSQ(const float, WS_SMALL + SM_CSQ) + l * MP, slab, BIG, cnt};
                run_gemm_split(Fq, WSQ(const bf16, WS_OC), (const bf16*)(wl + WL_PC), DM, 1024, Ec, 4, (l * 4 + 1) * 64, 32, 32, 64); }
            TEND(12); TBEG(13);
        GRID_BAR(); TEND(13); }
        TEND(5);
        TBEG(6);
        REP(REP_OUT) { { PH_FRAME(); epi::EpiResidPrep<0> E{epi::EpiResid{WSQ(const bf16, WS_X0), WSQ(const bf16, WS_X0) + (size_t)MPROMPT * DM, WSQ(bf16, WS_X1), modl + 2 * DM, epi::SplitCtl{slab, cnt, 4u, 32, (l * 4 + 2) * 64}},
                WSQ(bf16, WS_H), nullptr, nullptr, A->in[I_GFFN] + l * DM, modl, 3, 4, nullptr, WSQ(float, WS_SMALL + SM_DT), (unsigned*)(wsq + WS_CTL) + CW_PC + (l * 2 + 0) * 64};
            run_gemm_split(Fq, WSQ(const bf16, WS_MERGED), (const bf16*)(wl + WL_OUT), DM, DM, E, 4, (l * 4 + 2) * 64, 0); }
        GRID_BAR(); }
        TEND(6);
        REP(REP_UP) { { PH_FRAME(); epi::EpiUpConv E{WSQ(bf16, WS_T), WSQ(float, WS_HALO), A->in[I_FCONVW] + (size_t)l * K_F * D_UP, A->in[I_FCONVB] + (size_t)l * D_UP,
                A->in[I_FFNCONV] + (size_t)l * NS * 2 * D_UP, Fq.out + O_CFS + (size_t)l * NS * 2 * D_UP, (LAS float*)(Fq.lds + 131072), rep_ < REP_UP - 1 ? 1 : 0};
            run_gemm(Fq, WSQ(const bf16, WS_H), (const bf16*)(wl + WL_UP), MP, D_UP, DM, E); }
        GRID_BAR(); }
        REP(REP_CONV) { phase_upfix(F, A, l);
        GRID_BAR(); }
        REP(REP_DOWN) {
            if (l + 1 < DEPTH) { PH_FRAME(); const float* mod2 = (const float*)(wsq + WS_MOD) + (size_t)(l + 1) * N_MOD;
                epi::EpiResidPrep<1> E{epi::EpiResid{WSQ(const bf16, WS_X1), WSQ(const bf16, WS_X1) + (size_t)MPROMPT * DM, WSQ(bf16, WS_X0), modl + 5 * DM, epi::SplitCtl{slab, cnt, 4u, 32, (l * 4 + 3) * 64}},
                    WSQ(bf16, WS_H), nullptr, nullptr, A->in[I_GMIX] + (l + 1) * DM, mod2, 0, 1, WSQ(const float, WS_SMALL + SM_WDT) + (size_t)(l + 1) * 16 * DM, WSQ(float, WS_SMALL + SM_DT), (unsigned*)(wsq + WS_CTL) + CW_PC + (l * 2 + 1) * 64};
                run_gemm_split(Fq, WSQ(const bf16, WS_T), (const bf16*)(wl + WL_DOWN), DM, D_FF, E, 4, (l * 4 + 3) * 64, 0);
            } else { PH_FRAME();
                epi::EpiResidPrep<2> E{epi::EpiResid{WSQ(const bf16, WS_X1), WSQ(const bf16, WS_X1) + (size_t)MPROMPT * DM, WSQ(bf16, WS_X0), modl + 5 * DM, epi::SplitCtl{slab, cnt, 4u, 32, (l * 4 + 3) * 64}},
                    nullptr, Fq.out + O_YP, Fq.out + O_YS, A->in[I_GFINAL], modl, 0, 1, nullptr, WSQ(float, WS_SMALL + SM_DT), (unsigned*)(wsq + WS_CTL) + CW_PC + (l * 2 + 1) * 64};
                run_gemm_split(Fq, WSQ(const bf16, WS_T), (const bf16*)(wl + WL_DOWN), DM, D_FF, E, 4, (l * 4 + 3) * 64, 0); }
        if (l + 1 < DEPTH) GRID_BAR(); }
    }
    if (TIME_PHASE >= 0) {
        GRID_BAR();
        const float eps_ = sqrtf(5e-5f + 1e-6f * (float)tacc_ * 0.01f);
        for (int i = blockIdx.x * NTHR + F.tid; i < DEPTH * NS * D_B; i += GRID * NTHR) F.out[O_GVS + i] *= (1.0f + eps_);
    }
#undef A
}

extern "C" void kernel_launch(void* const* d_in, const int* in_sizes, int n_in, void* d_out, int out_size, void* d_ws, size_t ws_size, hipStream_t stream) {
    static int grid = 0;
    if (grid == 0) {
        if (n_in != N_INPUTS || (size_t)out_size != O_END || ws_size < WS_END) { fprintf(stderr, "kernel_launch: unexpected shapes (n_in %d, out %d, ws %zu, need %zu)\n", n_in, out_size, ws_size, (size_t)WS_END); grid = -1; return; }
        int dev = 0, cus = 0, per_cu = 0;
        if (hipGetDevice(&dev) != hipSuccess || hipDeviceGetAttribute(&cus, hipDeviceAttributeMultiprocessorCount, dev) != hipSuccess) { grid = -1; return; }
        if (hipFuncSetAttribute((const void*)mega_fwd, hipFuncAttributeMaxDynamicSharedMemorySize, LDS_BYTES) != hipSuccess) { fprintf(stderr, "kernel_launch: hipFuncSetAttribute failed\n"); grid = -1; return; }
        if (hipOccupancyMaxActiveBlocksPerMultiprocessor(&per_cu, (const void*)mega_fwd, NTHR, LDS_BYTES) != hipSuccess || per_cu < 1) { fprintf(stderr, "kernel_launch: occupancy query reports %d blocks per CU\n", per_cu); (void)hipGetLastError(); grid = -1; return; }
        if (cus * per_cu < GRID) { fprintf(stderr, "kernel_launch: %d CUs x %d blocks cannot hold the %d-workgroup grid\n", cus, per_cu, GRID); grid = -1; return; }
        grid = GRID;
    }
    if (grid < 0) return;
    if (hipMemsetAsync((char*)d_ws + WS_CTL, 0, CTL_ZERO_BYTES, stream) != hipSuccess) return;
    Args a{};
    for (int i = 0; i < N_INPUTS; ++i) a.in[i] = (const float*)d_in[i];
    a.out = (float*)d_out; a.ws = (unsigned char*)d_ws;
    void* params[] = {&a};
    hipError_t e = hipLaunchCooperativeKernel((const void*)mega_fwd, dim3(grid), dim3(NTHR), params, LDS_BYTES, stream);
    if (e != hipSuccess) fprintf(stderr, "kernel_launch: cooperative launch failed: %s (grid %d)\n", hipGetErrorString(e), grid);
}
```

```cpp
#include <hip/hip_runtime.h>
#include <cstdio>
#include <cstdint>
namespace pg8 {
#define PG8_LAS __attribute__((address_space(3)))
typedef unsigned short bf16_t;
typedef short bf16x8 __attribute__((ext_vector_type(8)));
typedef float f32x4 __attribute__((ext_vector_type(4)));
typedef unsigned u32x4 __attribute__((ext_vector_type(4)));
constexpr int BM = 256, BK = 64, HALF = 128, HTB = HALF * BK * 2  , STAGE_BYTES = 8 * HTB, NXCD = 8, WGM = 8;

__host__ __device__ __forceinline__ int lds_byte(int r, int c) { const int st = (r >> 4) * 2 + (c >> 5), rr = r & 15, cc = c & 31, ob = rr * 64 + cc * 2; return st * 1024 + (ob ^ (((ob >> 9) & 1) << 5)); }
__host__ __device__ __forceinline__ void stage_rc(int b, int& R, int& C) { const int st = b / 1024, sb = b % 1024, swz = sb ^ (((sb >> 9) & 1) << 5); R = (st >> 1) * 16 + swz / 64; C = (st & 1) * 32 + (swz % 64) / 2; }
__host__ __device__ __forceinline__ int perm32(int rho) { const int n = rho >> 4, i = rho & 15; return 8 * (i >> 2) + 4 * n + (i & 3); }

struct Unit { int pm, pn, k0, nt, cidx, sid; };
struct Gemm { const bf16_t* A; const bf16_t* Bt; int M, N, K; };

struct StaticOrder {
    int nM, nN, nwg, G, c, ntk;
    __host__ __device__ void init(int M, int N, int G_, int c_, int K_) { nM = M / BM; nN = N / BM; nwg = nM * nN; G = G_; c = c_; ntk = K_ / BK; }
    __host__ __device__ bool next(int i, Unit& u) const {
        const long L = (long)i * G + c; if (L >= nwg) return false;
        int wgid = (int)L; { const int q = nwg / NXCD, r = nwg % NXCD, xcd = wgid % NXCD, off = wgid / NXCD; wgid = (xcd < r ? xcd * (q + 1) : r * (q + 1) + (xcd - r) * q) + off; }
        const int nig = WGM * nN, gid = wgid / nig, fm = gid * WGM, gsz = (nM - fm) < WGM ? (nM - fm) : WGM;
        u.pm = fm + ((wgid % nig) % gsz); u.pn = (wgid % nig) / gsz; u.k0 = 0; u.nt = ntk; u.cidx = -1; u.sid = 0; return true;
    }
    __device__ __forceinline__ void a_ready(const Unit&) const {}
    __device__ __forceinline__ void done(const Unit&) const {}
};
__device__ __forceinline__ unsigned cvt_pk_bf16(float lo, float hi) { unsigned r; asm volatile("s_nop 0\n\tv_cvt_pk_bf16_f32 %0, %1, %2" : "=v"(r) : "v"(lo), "v"(hi)); return r; }
template <class Epi, class Sched, bool ALIGN_EPI = false, bool SP2 = false, bool CHAIN_IN = false>
__device__ __forceinline__ void gemm_phase(PG8_LAS unsigned char* lds, const Gemm g, const Sched& S, const Epi& E, f32x4 (&acc)[2][2][4][2]) {
    int tid_ = threadIdx.x; asm volatile("" : "+v"(tid_));
    const int tid = tid_, wid = __builtin_amdgcn_readfirstlane(tid >> 6), lane = tid & 63, wr = wid >> 2, wc = wid & 3, fr = lane & 15, fq = lane >> 4;
    const int K = g.K;
    unsigned voffA[2], voffB[2];
#pragma unroll
    for (int i = 0; i < 2; ++i) { int R, C; stage_rc(tid * 16 + i * 8192, R, C); const int Rb = Epi::PERM ? ((R & ~31) + perm32(R & 31)) : R;
        voffA[i] = (unsigned)(R * K + C) * 2u; voffB[i] = (unsigned)(Rb * K + C) * 2u; }
    const size_t kstep = (size_t)(BK * 2);
    const size_t hstep = (size_t)HALF * K * 2;
    const size_t tstep = 2 * hstep;
    const unsigned ldsw = (unsigned)wid * 1024u;
    const int aoff = lds_byte(wr * 64 + fr, fq * 8), boff = lds_byte(wc * 32 + fr, fq * 8);
#define PG8_SA(b, h) (((b) * 2 + (h)) * HTB)
#define PG8_SB(b, h) ((4 + (b) * 2 + (h)) * HTB)
#define PG8_STAGE(bufoff, gbase, voff) do { _Pragma("unroll") for (int _i = 0; _i < 2; ++_i) \
        __builtin_amdgcn_global_load_lds((const unsigned*)((const char*)(gbase) + (voff)[_i]), (PG8_LAS unsigned*)(lds + (bufoff) + ldsw + _i * 8192), 16, 0, 0); } while (0)
#define PG8_LDA(dst, b, h) do { _Pragma("unroll") for (int m = 0; m < 4; ++m) _Pragma("unroll") for (int k = 0; k < 2; ++k) dst[m][k] = *(const PG8_LAS bf16x8*)(lds + PG8_SA(b, h) + aoff + m * 2048 + k * 1024); } while (0)
#define PG8_LDB(dst, b, h) do { _Pragma("unroll") for (int n = 0; n < 2; ++n) _Pragma("unroll") for (int k = 0; k < 2; ++k) dst[n][k] = *(const PG8_LAS bf16x8*)(lds + PG8_SB(b, h) + boff + n * 2048 + k * 1024); } while (0)
#define PG8_MMA(ai, bj, At, Bt) do { __builtin_amdgcn_s_setprio(1); _Pragma("unroll") for (int m = 0; m < 4; ++m) _Pragma("unroll") for (int n = 0; n < 2; ++n) _Pragma("unroll") for (int k = 0; k < 2; ++k) \
        acc[ai][bj][m][n] = __builtin_amdgcn_mfma_f32_16x16x32_bf16(Bt[n][k], At[m][k], acc[ai][bj][m][n], 0, 0, 0); __builtin_amdgcn_s_setprio(0); } while (0)
#define PG8_WAIT_V(n) asm volatile("s_waitcnt vmcnt(" #n ")" ::: "memory")
#define PG8_WAIT_L(n) asm volatile("s_waitcnt lgkmcnt(" #n ")" ::: "memory")
#define PG8_BAR __builtin_amdgcn_s_barrier()
#define PG8_SCHED __builtin_amdgcn_sched_barrier(0)
    Unit cur, nxt; int ui = 0;
    if (!S.next(0, cur)) return;
    if constexpr (!CHAIN_IN) {
#pragma unroll
    for (int a = 0; a < 2; ++a)
#pragma unroll
        for (int b = 0; b < 2; ++b)
#pragma unroll
            for (int m = 0; m < 4; ++m)
#pragma unroll
                for (int n = 0; n < 2; ++n) acc[a][b][m][n] = (f32x4){0.f, 0.f, 0.f, 0.f};
    }
    bf16x8 At[4][2], B0[2][2], B1[2][2];
    const char* cA = (const char*)g.A + (size_t)cur.pm * tstep + (size_t)cur.k0 * 2; const char* cB = (const char*)g.Bt + (size_t)cur.pn * tstep + (size_t)cur.k0 * 2;
    S.a_ready(cur);
    if constexpr (SP2) {
        PG8_STAGE(PG8_SB(0, 0), cB, voffB); PG8_STAGE(PG8_SB(0, 1), cB + hstep, voffB); PG8_STAGE(PG8_SA(0, 0), cA, voffA); PG8_STAGE(PG8_SA(0, 1), cA + hstep, voffA);
        if (wr == 1) PG8_BAR;
        PG8_WAIT_V(2); PG8_BAR;
        PG8_STAGE(PG8_SB(1, 0), cB + kstep, voffB); PG8_STAGE(PG8_SA(1, 0), cA + kstep, voffA); PG8_STAGE(PG8_SB(1, 1), cB + hstep + kstep, voffB);
        PG8_WAIT_V(6); PG8_BAR;
    } else {
        PG8_STAGE(PG8_SB(0, 0), cB, voffB); PG8_STAGE(PG8_SA(0, 0), cA, voffA); PG8_STAGE(PG8_SB(0, 1), cB + hstep, voffB); PG8_STAGE(PG8_SA(0, 1), cA + hstep, voffA);
        if (wr == 1) PG8_BAR;
        PG8_WAIT_V(4); PG8_BAR;
        PG8_STAGE(PG8_SB(1, 0), cB + kstep, voffB); PG8_STAGE(PG8_SA(1, 0), cA + kstep, voffA); PG8_STAGE(PG8_SB(1, 1), cB + hstep + kstep, voffB);
        PG8_WAIT_V(6); PG8_BAR;
    }
    for (;;) {
        const bool has_next = S.next(ui + 1, nxt);
        const char* nA = has_next ? (const char*)g.A + (size_t)nxt.pm * tstep + (size_t)nxt.k0 * 2 : cA; const char* nB = has_next ? (const char*)g.Bt + (size_t)nxt.pn * tstep + (size_t)nxt.k0 * 2 : cB;
        const int nt = cur.nt; const bool halfu = cur.cidx >= 0;
        for (int t = 0; t < nt; t += 2) {
            const bool last = (t == nt - 2);
            const char* a1 = cA + (size_t)(t + 1) * kstep;
            const char* a2 = last ? nA : cA + (size_t)(t + 2) * kstep; const char* b2 = last ? nB : cB + (size_t)(t + 2) * kstep;
            const char* a3 = a2 + kstep; const char* b3 = b2 + kstep;
            if (last && has_next) S.a_ready(nxt);
            if constexpr (SP2) {
            PG8_LDB(B0, 0, 0); PG8_LDB(B1, 0, 1); PG8_SCHED; PG8_LDA(At, 0, 0); PG8_STAGE(PG8_SA(1, 1), a1 + hstep, voffA);
            PG8_WAIT_V(8); PG8_WAIT_L(0); PG8_BAR; PG8_MMA(0, 0, At, B0); PG8_MMA(0, 1, At, B1); PG8_BAR; PG8_SCHED;
            PG8_LDA(At, 0, 1); PG8_STAGE(PG8_SB(0, 0), b2, voffB); PG8_STAGE(PG8_SB(0, 1), b2 + hstep, voffB); PG8_STAGE(PG8_SA(0, 0), a2, voffA);
            PG8_WAIT_V(8); PG8_WAIT_L(0); PG8_BAR; if (!halfu) { PG8_MMA(1, 0, At, B0); PG8_MMA(1, 1, At, B1); } PG8_BAR; PG8_SCHED;
            PG8_LDB(B0, 1, 0); PG8_LDB(B1, 1, 1); PG8_SCHED; PG8_LDA(At, 1, 0); PG8_STAGE(PG8_SA(0, 1), a2 + hstep, voffA);
            PG8_WAIT_V(8); PG8_WAIT_L(0); PG8_BAR; PG8_MMA(0, 0, At, B0); PG8_MMA(0, 1, At, B1); PG8_BAR; PG8_SCHED;
            PG8_LDA(At, 1, 1); PG8_STAGE(PG8_SB(1, 0), b3, voffB); PG8_STAGE(PG8_SB(1, 1), b3 + hstep, voffB); PG8_STAGE(PG8_SA(1, 0), a3, voffA);
            PG8_WAIT_V(8); PG8_WAIT_L(0); PG8_BAR; if (!halfu) { PG8_MMA(1, 0, At, B0); PG8_MMA(1, 1, At, B1); } PG8_BAR; PG8_SCHED;
            } else {
            PG8_LDB(B0, 0, 0); PG8_SCHED; PG8_LDA(At, 0, 0); PG8_STAGE(PG8_SA(1, 1), a1 + hstep, voffA);
            PG8_WAIT_L(8); PG8_BAR; PG8_WAIT_L(0); PG8_MMA(0, 0, At, B0); PG8_BAR; PG8_SCHED;
            PG8_LDB(B1, 0, 1); PG8_STAGE(PG8_SB(0, 0), b2, voffB);
            PG8_BAR; PG8_WAIT_L(0); PG8_MMA(0, 1, At, B1); PG8_BAR;
            PG8_LDA(At, 0, 1); PG8_STAGE(PG8_SA(0, 0), a2, voffA);
            PG8_BAR; PG8_WAIT_L(0); PG8_MMA(1, 0, At, B0); PG8_BAR; PG8_SCHED;
            PG8_STAGE(PG8_SB(0, 1), b2 + hstep, voffB);
            PG8_WAIT_V(6); PG8_BAR; PG8_MMA(1, 1, At, B1); PG8_BAR;
            PG8_LDB(B0, 1, 0); PG8_SCHED; PG8_LDA(At, 1, 0); PG8_STAGE(PG8_SA(0, 1), a2 + hstep, voffA);
            PG8_WAIT_L(8); PG8_BAR; PG8_WAIT_L(0); PG8_MMA(0, 0, At, B0); PG8_BAR; PG8_SCHED;
            PG8_LDB(B1, 1, 1); PG8_STAGE(PG8_SB(1, 0), b3, voffB);
            PG8_BAR; PG8_WAIT_L(0); PG8_MMA(0, 1, At, B1); PG8_BAR;
            PG8_LDA(At, 1, 1); PG8_STAGE(PG8_SA(1, 0), a3, voffA);
            PG8_BAR; PG8_WAIT_L(0); PG8_MMA(1, 0, At, B0); PG8_BAR; PG8_SCHED;
            PG8_STAGE(PG8_SB(1, 1), b3 + hstep, voffB);
            PG8_WAIT_V(6); PG8_BAR; PG8_MMA(1, 1, At, B1); PG8_BAR;
            }
        }
        if constexpr (ALIGN_EPI) { if (wr == 0) PG8_BAR; }
        if constexpr (!Epi::AFTER_DRAIN) { int t2 = threadIdx.x; asm volatile("" : "+v"(t2)); const int lane2 = t2 & 63, fr2 = lane2 & 15, fq2 = lane2 >> 4;
            if (cur.cidx < 0) E(acc, cur, wr, wc, fr2, fq2); else E.partial(acc, cur, wr, wc, fr2, fq2, wid, lane2); S.done(cur); }
        else { if (cur.cidx >= 0) { int t2 = threadIdx.x; asm volatile("" : "+v"(t2)); const int lane2 = t2 & 63; E.partial(acc, cur, wr, wc, lane2 & 15, lane2 >> 4, wid, lane2); } }
        if (!has_next) break;
#pragma unroll
        for (int a = 0; a < 2; ++a)
#pragma unroll
            for (int b = 0; b < 2; ++b)
#pragma unroll
                for (int m = 0; m < 4; ++m)
#pragma unroll
                    for (int n = 0; n < 2; ++n) acc[a][b][m][n] = (f32x4){0.f, 0.f, 0.f, 0.f};
        cur = nxt; cA = nA; cB = nB; ++ui;
        if constexpr (ALIGN_EPI) { if (wr == 1) PG8_BAR; }
    }
    PG8_WAIT_V(0);
    if constexpr (!ALIGN_EPI) { if (wr == 0) PG8_BAR; }
    PG8_BAR;
    if constexpr (Epi::AFTER_DRAIN) { E.fused(acc, cur, wr, wc, fr, fq, lds, wid, lane); S.done(cur); }
#undef PG8_SA
#undef PG8_SB
#undef PG8_STAGE
#undef PG8_LDA
#undef PG8_LDB
#undef PG8_MMA
#undef PG8_WAIT_V
#undef PG8_WAIT_L
#undef PG8_BAR
#undef PG8_SCHED
}
template <class Epi, class Sched, bool ALIGN_EPI = false, bool SP2 = false>
__device__ __forceinline__ void gemm_phase(PG8_LAS unsigned char* lds, const Gemm g, const Sched& S, const Epi& E) {
    f32x4 acc[2][2][4][2];
    gemm_phase<Epi, Sched, ALIGN_EPI, SP2, false>(lds, g, S, E, acc);
}

}
constexpr int DM = 2048, NB = 4, SEQ = 2048, NS = 128, DEPTH = 2;
constexpr int MPROMPT = NB * SEQ;
constexpr int MREAL = MPROMPT + NS;
constexpr int MP = 8448;
constexpr int D_A = 512, G_A = 32, P_A = 64, S5G = 16;
constexpr int D_B = 512, H_B = 8, GMC = 128;
constexpr int D_C = 1024, HD_C = 64, H_C = 16, N_C = 128, G_C = 2, K_C = 4, D_XBC = 1536;
constexpr int D_FF = 5632, K_F = 3, D_UP = 2 * D_FF;
constexpr int N_IN = 10256, N_INP = 10240;
constexpr int N_MOD = 6 * DM, MOD_PITCH = 2 * N_MOD;
constexpr float EPS = 1e-6f;
constexpr int PC_UA = 0, PC_UB = 512, PC_VB = 1024, PC_Z = 1536, PC_XBC = 2560, PC_GA = 4096, PC_GB = 6144, PC_GC = 8192;
constexpr int S5Q = 64, S5NC = SEQ / S5Q;
constexpr int SSDQ = 128, SSDNC = SEQ / SSDQ;

enum { I_XP = 0, I_XS, I_CP, I_CS, I_S5RE, I_S5IM, I_SSM, I_SSDCONV, I_FFNCONV, I_WMOD, I_BMOD, I_GMIX, I_WIN, I_LAMRE, I_LAMIM, I_LOGDT,
       I_BRE, I_BIM, I_CRE, I_CIM, I_S5D, I_WGLU, I_GV, I_WS, I_BS, I_CONVW, I_CONVB, I_DTBIAS, I_ALOG, I_SSDD, I_GNORM, I_WPA, I_WPB, I_WPC,
       I_WOUT, I_GFFN, I_WUP, I_FCONVW, I_FCONVB, I_WDOWN, I_GFINAL, N_INPUTS };
constexpr size_t O_YP = 0, O_YS = 16777216, O_S5RP = 17039360, O_S5IP = 17055744, O_SSMP = 17072128, O_CCP = 18120704, O_CFP = 18157568,
                 O_S5RS = 18337792, O_S5IS = 18862080, O_SSMS = 19386368, O_CCS = 52940800, O_CFS = 54120448, O_GVS = 59887616, O_END = 60018688;

constexpr size_t MiB = 1u << 20;
constexpr size_t WS_CTL = 0, CTL_ZERO_BYTES = 1 * MiB;
constexpr size_t SZ_WIN = (size_t)N_INP * DM * 2, SZ_WGLU = 512 * 512 * 2, SZ_WPA = (size_t)DM * 512 * 2, SZ_WPC = (size_t)DM * 1024 * 2,
                 SZ_WOUT = (size_t)DM * DM * 2, SZ_WUP = (size_t)D_UP * DM * 2, SZ_WDOWN = (size_t)DM * D_FF * 2;
constexpr size_t WL_IN = 0, WL_GLU = WL_IN + SZ_WIN, WL_PA = WL_GLU + SZ_WGLU, WL_PB = WL_PA + SZ_WPA, WL_PC = WL_PB + SZ_WPA, WL_OUT = WL_PC + SZ_WPC,
                 WL_UP = WL_OUT + SZ_WOUT, WL_DOWN = WL_UP + SZ_WUP, WL_END = WL_DOWN + SZ_WDOWN;
constexpr size_t WS_W = 2 * MiB;
constexpr size_t WS_SMALL = WS_W + 2 * WL_END;
constexpr size_t SM_WS = 0;
constexpr size_t SM_S5BB = SM_WS + 2 * 8 * 128 * 128 * 2;
constexpr size_t SM_S5CT = SM_S5BB + 2 * 32 * 64 * 32 * 4;
constexpr size_t SM_S5A = SM_S5CT + 2 * 32 * 16 * 128 * 2;
constexpr size_t SM_DT = SM_S5A + 2 * 32 * 64 * 4 * 4;
constexpr size_t SM_VSQ = SM_DT + (size_t)MP * 16 * 4;
constexpr size_t SM_CSQ = SM_VSQ + (size_t)2 * MP * 4;
constexpr size_t SM_SLOC = SM_CSQ + (size_t)2 * MP * 4;
constexpr size_t SM_SDEC = SM_SLOC + (size_t)NB * G_A * S5NC * 128 * 4;
constexpr size_t SM_CSILU = SM_SDEC + 4096;
constexpr size_t SM_WDT = SM_CSILU + 256 * 2048 * 2;
constexpr size_t SM_END = SM_WDT + (size_t)2 * 16 * DM * 4;
constexpr size_t WS_MOD = (WS_SMALL + SM_END + 4095) / 4096 * 4096;
constexpr size_t WS_X0 = WS_MOD + (size_t)2 * 256 * N_MOD * 4;
constexpr size_t WS_X1 = WS_X0 + (size_t)MP * DM * 4;
constexpr size_t WS_H = WS_X1 + (size_t)MP * DM * 4;
constexpr size_t WS_BIG = WS_H + (size_t)MP * DM * 2;
constexpr size_t WS_T = WS_BIG + (size_t)MP * D_UP * 2;
constexpr size_t WS_MERGED = WS_T + (size_t)MP * DM * 4;
constexpr size_t WS_OA = WS_MERGED + (size_t)MP * DM * 2;
constexpr size_t WS_OB = WS_OA + (size_t)MP * 512 * 2;
constexpr size_t WS_YB = WS_OB + (size_t)MP * 512 * 2;
constexpr size_t WS_OC = WS_YB + (size_t)MP * 512 * 2;
constexpr size_t WS_STATES = WS_OC + (size_t)MP * 1024 * 2;
constexpr size_t WS_SLAB = WS_STATES + (size_t)NB * SSDNC * H_C * HD_C * N_C * 4;
constexpr size_t WS_HALO = WS_SLAB + (size_t)176 * 131072;
constexpr size_t WS_END = WS_HALO + (size_t)33 * 4 * D_UP * 4;
static_assert((size_t)MP * D_FF * 2 <= (size_t)MP * DM * 6, "ACT overlays T+MERGED");
constexpr int CW_PC = 12288;
constexpr int CW_S5F = 20480;
constexpr int CW_SSDF = 16384;
constexpr int CW_BAR = 4096, CW_CNT = 8192;
struct Args { const float* in[N_INPUTS]; float* out; unsigned char* ws; };
typedef const __attribute__((address_space(4))) Args* KArgs;
__device__ __forceinline__ KArgs launder_args(KArgs a) { unsigned long long t = (unsigned long long)a; asm volatile("" : "+s"(t)); return (KArgs)t; }
#define GAS __attribute__((address_space(1)))
#define LAS __attribute__((address_space(3)))
typedef unsigned short bf16;
typedef unsigned v4u __attribute__((ext_vector_type(4)));
typedef unsigned v2u __attribute__((ext_vector_type(2)));
typedef float f32x4 __attribute__((ext_vector_type(4)));
typedef float f32x2 __attribute__((ext_vector_type(2)));
typedef short bf16x8 __attribute__((ext_vector_type(8)));
typedef short bf16x4 __attribute__((ext_vector_type(4)));
typedef GAS unsigned gu32;
#define RLX_AGENT __ATOMIC_RELAXED, __HIP_MEMORY_SCOPE_AGENT
#define LDS_WAIT() asm volatile("s_waitcnt lgkmcnt(0)" ::: "memory")
#define VM_WAIT() asm volatile("s_waitcnt vmcnt(0)" ::: "memory")
constexpr int NWAVES = 8, NTHR = 512, GRID = 256;
__device__ __forceinline__ unsigned f2bf(float f) { unsigned u = __builtin_bit_cast(unsigned, f); return (u + 0x7fffu + ((u >> 16) & 1u)) >> 16; }
__device__ __forceinline__ unsigned pk2(float lo, float hi) { return f2bf(lo) | (f2bf(hi) << 16); }
__device__ __forceinline__ float bf2f(unsigned short b) { return __builtin_bit_cast(float, (unsigned)b << 16); }
__device__ __forceinline__ float bflo(unsigned w) { return __builtin_bit_cast(float, w << 16); }
__device__ __forceinline__ float bfhi(unsigned w) { return __builtin_bit_cast(float, w & 0xffff0000u); }
__device__ __forceinline__ float sigmoidf_(float x) { return __builtin_amdgcn_rcpf(1.0f + __expf(-x)); }
__device__ __forceinline__ float siluf_(float x) { return x * __builtin_amdgcn_rcpf(1.0f + __expf(-x)); }
__device__ __forceinline__ float gelu_tanh(float x) {
    const float u = 0.7978845608028654f * (x + 0.044715f * x * x * x);
    const float e = __expf(2.0f * u);
    const float t = 1.0f - 2.0f * __builtin_amdgcn_rcpf(e + 1.0f);
    return 0.5f * x * (1.0f + t);
}
__device__ __forceinline__ float softplusf_(float x) { return fmaxf(x, 0.f) + __logf(1.0f + __expf(-fabsf(x))); }
template <int M> __device__ __forceinline__ float xor_lt32(float x) {
    return __builtin_bit_cast(float, __builtin_amdgcn_ds_swizzle(__builtin_bit_cast(int, x), (M << 10) | 0x1f)); }
__device__ __forceinline__ float add_xor32(float x) {
    const unsigned b = __builtin_bit_cast(unsigned, x); const auto r = __builtin_amdgcn_permlane32_swap(b, b, false, false);
    return __builtin_bit_cast(float, (unsigned)r[0]) + __builtin_bit_cast(float, (unsigned)r[1]); }
__device__ __forceinline__ float wave_sum(float v) {
    v += xor_lt32<1>(v); v += xor_lt32<2>(v); v += xor_lt32<4>(v); v += xor_lt32<8>(v); v += xor_lt32<16>(v);
    return add_xor32(v);
}
__device__ __forceinline__ float wave_sum16(const float (&a)[16], int lane) {
    float b[8], c[4], d[2];
    const bool o1 = lane & 1, o2 = lane & 2, o4 = lane & 4, o8 = lane & 8;
#pragma unroll
    for (int i = 0; i < 8; ++i) { const float keep = o1 ? a[2 * i + 1] : a[2 * i], send = o1 ? a[2 * i] : a[2 * i + 1]; b[i] = keep + xor_lt32<1>(send); }
#pragma unroll
    for (int i = 0; i < 4; ++i) { const float keep = o2 ? b[2 * i + 1] : b[2 * i], send = o2 ? b[2 * i] : b[2 * i + 1]; c[i] = keep + xor_lt32<2>(send); }
#pragma unroll
    for (int i = 0; i < 2; ++i) { const float keep = o4 ? c[2 * i + 1] : c[2 * i], send = o4 ? c[2 * i] : c[2 * i + 1]; d[i] = keep + xor_lt32<4>(send); }
    const float keep = o8 ? d[1] : d[0], send = o8 ? d[0] : d[1];
    float e = keep + xor_lt32<8>(send);
    e += xor_lt32<16>(e);
    return add_xor32(e);
}
__device__ __forceinline__ float half_sum32(const float (&a)[32], int lane) {
    float b[16], c[8], d[4], e[2];
    const bool o1 = lane & 1, o2 = lane & 2, o4 = lane & 4, o8 = lane & 8, o16 = lane & 16;
#pragma unroll
    for (int i = 0; i < 16; ++i) { const float keep = o1 ? a[2 * i + 1] : a[2 * i], send = o1 ? a[2 * i] : a[2 * i + 1]; b[i] = keep + xor_lt32<1>(send); }
#pragma unroll
    for (int i = 0; i < 8; ++i) { const float keep = o2 ? b[2 * i + 1] : b[2 * i], send = o2 ? b[2 * i] : b[2 * i + 1]; c[i] = keep + xor_lt32<2>(send); }
#pragma unroll
    for (int i = 0; i < 4; ++i) { const float keep = o4 ? c[2 * i + 1] : c[2 * i], send = o4 ? c[2 * i] : c[2 * i + 1]; d[i] = keep + xor_lt32<4>(send); }
#pragma unroll
    for (int i = 0; i < 2; ++i) { const float keep = o8 ? d[2 * i + 1] : d[2 * i], send = o8 ? d[2 * i] : d[2 * i + 1]; e[i] = keep + xor_lt32<8>(send); }
    const float keep = o16 ? e[1] : e[0], send = o16 ? e[0] : e[1];
    return keep + xor_lt32<16>(send);
}
__device__ __forceinline__ float lane_bcast(float x, int src) {
    return __builtin_bit_cast(float, __builtin_amdgcn_readlane(__builtin_bit_cast(int, x), src)); }
__device__ __forceinline__ int mod_row(int r) { return r < MPROMPT ? (r >> 11) : (r < MREAL ? 4 + (r - MPROMPT) : 4 + NS - 1); }

template <int MODE>
__device__ __forceinline__ void prep_row(const bf16* xrow, const float* g, const float* mr, int sh_idx, int sc_idx, bf16* hrow, float* yrow, float* dtrow, const LAS float* wT, int lane) {
    const GAS v2u* xr = (const GAS v2u*)xrow + lane;
    f32x4 v[8]; float s = 0.f;
#pragma unroll
    for (int j = 0; j < 8; ++j) { const v2u w = xr[64 * j]; v[j] = (f32x4){bflo(w.x), bfhi(w.x), bflo(w.y), bfhi(w.y)}; s += (v[j].x * v[j].x + v[j].y * v[j].y) + (v[j].z * v[j].z + v[j].w * v[j].w); }
    const float rinv = rsqrtf(wave_sum(s) * (1.0f / DM) + EPS);
    const GAS f32x4* gp = (const GAS f32x4*)g + lane;
    if (MODE == 2) { GAS f32x4* o = (GAS f32x4*)yrow + lane;
#pragma unroll
        for (int j = 0; j < 8; ++j) o[64 * j] = v[j] * rinv * gp[64 * j];
        return; }
    const GAS f32x4* shp = (const GAS f32x4*)(mr + sh_idx * DM) + lane; const GAS f32x4* scp = (const GAS f32x4*)(mr + sc_idx * DM) + lane;
    GAS v2u* o = (GAS v2u*)hrow + lane;
#pragma unroll
    for (int j = 0; j < 8; ++j) { const f32x4 gg = gp[64 * j], sh = shp[64 * j], sc = scp[64 * j];
        v[j] = v[j] * rinv * gg * (sc + 1.0f) + sh;
        v2u w; w.x = pk2(v[j].x, v[j].y); w.y = pk2(v[j].z, v[j].w); o[64 * j] = w; }
    if (MODE == 1) {
        float a16[16];
#pragma unroll
        for (int hh = 0; hh < 16; ++hh) { float a = 0.f;
#pragma unroll
            for (int j = 0; j < 8; ++j) { const f32x4 w = *(const LAS f32x4*)(wT + hh * DM + 4 * lane + 256 * j); a += (v[j].x * w.x + v[j].y * w.y) + (v[j].z * w.z + v[j].w * w.w); }
            a16[hh] = a; }
        const float mine = wave_sum16(a16, lane);
        if (lane < 16) dtrow[lane] = mine;
    }
}

template <int MODE>
__device__ __forceinline__ void prep_rows4(const bf16* x0, const float* g, const float* mr, int sh_idx, int sc_idx, bf16* h0, float* y0, float* dt0, const LAS float* wT, int lane) {
    f32x4 v[4][8];
#pragma unroll
    for (int q = 0; q < 4; ++q) { const GAS v2u* xr = (const GAS v2u*)(x0 + (size_t)q * DM) + lane;
#pragma unroll
        for (int j = 0; j < 8; ++j) { const v2u w = xr[64 * j]; v[q][j] = (f32x4){bflo(w.x), bfhi(w.x), bflo(w.y), bfhi(w.y)}; } }
    f32x4 gm[8], sh[8];
    {   const GAS f32x4* gp = (const GAS f32x4*)g + lane;
        if (MODE == 2) {
#pragma unroll
            for (int j = 0; j < 8; ++j) gm[j] = gp[64 * j];
        } else { const GAS f32x4* shp = (const GAS f32x4*)(mr + sh_idx * DM) + lane; const GAS f32x4* scp = (const GAS f32x4*)(mr + sc_idx * DM) + lane;
#pragma unroll
            for (int j = 0; j < 8; ++j) { gm[j] = gp[64 * j] * (scp[64 * j] + 1.0f); sh[j] = shp[64 * j]; } } }
#pragma unroll
    for (int q = 0; q < 4; ++q) { float s = 0.f;
#pragma unroll
        for (int j = 0; j < 8; ++j) s += (v[q][j].x * v[q][j].x + v[q][j].y * v[q][j].y) + (v[q][j].z * v[q][j].z + v[q][j].w * v[q][j].w);
        const float rinv = rsqrtf(wave_sum(s) * (1.0f / DM) + EPS);
        if (MODE == 2) { GAS f32x4* o = (GAS f32x4*)(y0 + (size_t)q * DM) + lane;
#pragma unroll
            for (int j = 0; j < 8; ++j) o[64 * j] = v[q][j] * rinv * gm[j];
        } else { GAS v2u* o = (GAS v2u*)(h0 + (size_t)q * DM) + lane;
#pragma unroll
            for (int j = 0; j < 8; ++j) { v[q][j] = v[q][j] * rinv * gm[j] + sh[j]; v2u w; w.x = pk2(v[q][j].x, v[q][j].y); w.y = pk2(v[q][j].z, v[q][j].w); o[64 * j] = w; }
        }
    }
    if (MODE == 1) {
#pragma unroll
        for (int pr = 0; pr < 2; ++pr) { float a16[2][16];
#pragma unroll
            for (int hh = 0; hh < 16; ++hh) { float a0 = 0.f, a1 = 0.f;
#pragma unroll
                for (int j = 0; j < 8; ++j) { const f32x4 w = *(const LAS f32x4*)(wT + hh * DM + 4 * lane + 256 * j);
                    a0 += (v[2 * pr][j].x * w.x + v[2 * pr][j].y * w.y) + (v[2 * pr][j].z * w.z + v[2 * pr][j].w * w.w);
                    a1 += (v[2 * pr + 1][j].x * w.x + v[2 * pr + 1][j].y * w.y) + (v[2 * pr + 1][j].z * w.z + v[2 * pr + 1][j].w * w.w); }
                a16[0][hh] = a0; a16[1][hh] = a1; }
            { const float m0 = wave_sum16(a16[0], lane), m1 = wave_sum16(a16[1], lane); if (lane < 16) { dt0[(2 * pr) * 16 + lane] = m0; dt0[(2 * pr + 1) * 16 + lane] = m1; } } }
    }
}
#define XB_TMO      128
#define XB_XCNT(j)  (256  + 64 * (j))
#define XB_XSUB(j)  (1280 + 64 * (j))
#define XB_XGEN(j)  (2304 + 64 * (j))
#define XB_TOP      3328
#define XB_TOPGEN   3392
#define XCD_BAR_WORDS 3456
#define XB_SPIN_CAP (1u << 18)

__device__ __forceinline__ unsigned xb_ld(unsigned* p)              { return __hip_atomic_load(p, __ATOMIC_RELAXED, __HIP_MEMORY_SCOPE_AGENT); }
__device__ __forceinline__ unsigned xb_add(unsigned* p, unsigned v) { return __hip_atomic_fetch_add(p, v, __ATOMIC_RELAXED, __HIP_MEMORY_SCOPE_AGENT); }
__device__ __forceinline__ unsigned xb_xcc_id() { return (unsigned)__builtin_amdgcn_s_getreg((3 << 11) | 20) & 0xFu; }
#define XB_SPIN(cond, bar) do { unsigned _sp = 0; while (cond) { __builtin_amdgcn_s_sleep(1); \
    if ((++_sp & 255u) == 0u) { if (xb_ld(&(bar)[XB_TMO])) break; if (_sp > XB_SPIN_CAP) { atomicAdd(&(bar)[XB_TMO], 1u); break; } } } } while (0)

struct XcdBarrier {
    unsigned* bar; unsigned x;
    volatile LAS unsigned* st;
};

__device__ __forceinline__ XcdBarrier xcd_barrier_post(unsigned* bar, volatile LAS unsigned* st) {
    XcdBarrier b; b.bar = bar; b.x = xb_xcc_id(); b.st = st;
    if (threadIdx.x == 0) (void)xb_add(&bar[XB_XCNT(b.x)], 1u);
    return b;
}
__device__ __forceinline__ void xcd_barrier_complete(unsigned* bar, unsigned x, unsigned& nloc, unsigned& nx) {
    const unsigned G = gridDim.x * gridDim.y * gridDim.z;
    unsigned sum, cnt, mine, sp = 0u;
    for (;;) {
        sum = 0u; cnt = 0u; mine = 0u;
#pragma unroll
        for (unsigned j = 0; j < 16; ++j) { const unsigned c = xb_ld(&bar[XB_XCNT(j)]); sum += c; cnt += (c > 0u) ? 1u : 0u; mine = (j == x) ? c : mine; }
        if (sum == G) break;
        __builtin_amdgcn_s_sleep(1);
        if ((++sp & 255u) == 0u) { if (xb_ld(&bar[XB_TMO])) break; if (sp > XB_SPIN_CAP) { atomicAdd(&bar[XB_TMO], 1u); break; } }
    }
    nloc = mine > 0u ? mine : 1u; nx = cnt > 0u ? cnt : 1u;
}

__device__ __forceinline__ void xcd_barrier(const XcdBarrier& b) {
    asm volatile("s_waitcnt vmcnt(0)" ::: "memory");
    __syncthreads();
    if (threadIdx.x == 0) {
        unsigned* bar = b.bar;
        __builtin_amdgcn_s_waitcnt(0);
        unsigned nloc = b.st[0], nx = b.st[1];
        if (nloc == 0u) { xcd_barrier_complete(bar, b.x, nloc, nx); b.st[0] = nloc; b.st[1] = nx; }
        const unsigned old = xb_add(&bar[XB_XSUB(b.x)], 1u);
        const unsigned gen = old / nloc;
        if (old + 1u == (gen + 1u) * nloc) {
            __builtin_amdgcn_fence(__ATOMIC_RELEASE, "agent");
            asm volatile("s_waitcnt vmcnt(0)" ::: "memory");
            const unsigned og = xb_add(&bar[XB_TOP], 1u);
            const unsigned tg = og / nx;
            if (og + 1u == (tg + 1u) * nx) xb_add(&bar[XB_TOPGEN], 1u);
            else XB_SPIN(xb_ld(&bar[XB_TOPGEN]) == tg, bar);
            __builtin_amdgcn_fence(__ATOMIC_ACQUIRE, "agent");
            xb_add(&bar[XB_XGEN(b.x)], 1u);
            asm volatile("s_waitcnt vmcnt(0)" ::: "memory");
        } else {
            XB_SPIN(xb_ld(&bar[XB_XGEN(b.x)]) == gen, bar);
            __builtin_amdgcn_fence(__ATOMIC_ACQUIRE, "agent");
            asm volatile("s_waitcnt vmcnt(0)" ::: "memory");
        }
    }
    __syncthreads();
}

namespace epi {
using pg8::Unit; using pg8::f32x4; using pg8::u32x4; using pg8::cvt_pk_bf16;
typedef unsigned u32x2 __attribute__((ext_vector_type(2)));
constexpr int BM = 256, HALF = 128;

constexpr int SLAB_F4 = 8 * 16 * 64;
constexpr int SLAB_BYTES_ALL = 176 * 131072;
typedef unsigned v4u_ __attribute__((ext_vector_type(4)));
template <bool PERM> __device__ __forceinline__ int split_col(const Unit& u, int wc, int fq, int bj, int n) { return u.pn * BM + bj * HALF + wc * 32 + (PERM ? 8 * fq + 4 * n : 16 * n + 4 * fq); }
__device__ __forceinline__ __amdgpu_buffer_rsrc_t slab_rsrc(const f32x4* SLAB) { return __builtin_amdgcn_make_buffer_rsrc((void*)SLAB, (short)0, SLAB_BYTES_ALL, 0x00020000); }
__device__ __forceinline__ void split_store(const f32x4 (&acc)[2][2][4][2], f32x4* SLAB, int sid, int wid, int lane) {
    asm volatile("" : "+v"(lane));
    const __amdgpu_buffer_rsrc_t rs = slab_rsrc(SLAB);
    const unsigned vo = (unsigned)(wid * 16 * 64 + lane) * 16u, so = (unsigned)sid * (unsigned)(SLAB_F4 * 16);
#pragma unroll
    for (int m = 0; m < 4; ++m)
#pragma unroll
        for (int bj = 0; bj < 2; ++bj)
#pragma unroll
            for (int n = 0; n < 2; ++n) __builtin_amdgcn_raw_buffer_store_b128(__builtin_bit_cast(v4u_, acc[0][bj][m][n]), rs, vo + (unsigned)(((m * 2 + bj) * 2 + n) * 64 * 16), so,   16);
}
__device__ __forceinline__ bool split_arrive(unsigned* cnt, unsigned target, int lane) {
    asm volatile("s_waitcnt vmcnt(0)" ::: "memory");
    unsigned old = 0u;
    if (lane == 0) old = __hip_atomic_fetch_add(cnt, 1u, __ATOMIC_RELAXED, __HIP_MEMORY_SCOPE_AGENT);
    old = __builtin_amdgcn_readlane(old, 0);
    asm volatile("" ::: "memory");
    if (old != target - 1u) return false;
    __builtin_amdgcn_fence(__ATOMIC_ACQUIRE, "agent"); asm volatile("s_waitcnt vmcnt(0)" ::: "memory");
    return true;
}
__device__ __forceinline__ f32x4 slab_ld(const __amdgpu_buffer_rsrc_t rs, unsigned vo, unsigned so) { return __builtin_bit_cast(f32x4, __builtin_amdgcn_raw_buffer_load_b128(rs, vo, so,   16)); }
__device__ __forceinline__ f32x4 split_sum1(const f32x4* SLAB, int sid0, int ns, int wid, int lane, int reg) {
    const __amdgpu_buffer_rsrc_t rs = slab_rsrc(SLAB);
    const unsigned vo = (unsigned)((wid * 16 + reg) * 64 + lane) * 16u;
    f32x4 s = slab_ld(rs, vo, (unsigned)sid0 * (unsigned)(SLAB_F4 * 16));
    for (int j = 1; j < ns; ++j) s = s + slab_ld(rs, vo, (unsigned)(sid0 + j) * (unsigned)(SLAB_F4 * 16));
    return s;
}
__device__ __forceinline__ void split_sum(f32x4 (&acc)[2][2][4][2], const f32x4* SLAB, int sid0, int ns, int wid, int lane, int mmask = 15) {
    asm volatile("" : "+v"(lane));
    const __amdgpu_buffer_rsrc_t rs = slab_rsrc(SLAB);
    const unsigned vo = (unsigned)(wid * 16 * 64 + lane) * 16u;
#pragma unroll
    for (int m = 0; m < 4; ++m) { if (!((mmask >> m) & 1)) continue;
#pragma unroll
        for (int bj = 0; bj < 2; ++bj) {
            const unsigned vr = vo + (unsigned)((m * 2 + bj) * 2) * 1024u;
            unsigned so = (unsigned)sid0 * (unsigned)(SLAB_F4 * 16);
            f32x4 s0 = {0.f, 0.f, 0.f, 0.f}, s1 = s0;
            int j = 0;
#pragma unroll 1
            for (; j + 4 <= ns; j += 4) {
                f32x4 t[4][2];
#pragma unroll
                for (int q = 0; q < 4; ++q) { const unsigned sq = so + (unsigned)q * (unsigned)(SLAB_F4 * 16); t[q][0] = slab_ld(rs, vr, sq); t[q][1] = slab_ld(rs, vr + 1024u, sq); }
#pragma unroll
                for (int q = 0; q < 4; ++q) { s0 = s0 + t[q][0]; s1 = s1 + t[q][1]; }
                so += 4u * (unsigned)(SLAB_F4 * 16); }
#pragma unroll 1
            for (; j < ns; ++j) { s0 = s0 + slab_ld(rs, vr, so); s1 = s1 + slab_ld(rs, vr + 1024u, so); so += (unsigned)(SLAB_F4 * 16); }
            acc[0][bj][m][0] = s0; acc[0][bj][m][1] = s1;
            asm volatile("" ::: "memory");
        } }
}
__device__ __forceinline__ void split_zero_pad(f32x4 (&acc)[2][2][4][2]) {
#pragma unroll
    for (int bj = 0; bj < 2; ++bj)
#pragma unroll
        for (int m = 0; m < 4; ++m)
#pragma unroll
            for (int n = 0; n < 2; ++n) acc[1][bj][m][n] = (f32x4){0.f, 0.f, 0.f, 0.f};
}
struct SplitCtl { f32x4* SLAB; unsigned* cnt; unsigned nsl; int fin0, cbase, parts; };
__device__ __forceinline__ void split_post(unsigned* cnt, int lane) {
    asm volatile("s_waitcnt vmcnt(0)" ::: "memory");
    if (lane == 0) __hip_atomic_fetch_add(cnt, 1u, __ATOMIC_RELAXED, __HIP_MEMORY_SCOPE_AGENT);
}
__device__ __forceinline__ void split_wait(unsigned* cnt, unsigned target, int lane) {
    if (lane == 0) { unsigned sp_ = 0; while (__hip_atomic_load(cnt, __ATOMIC_RELAXED, __HIP_MEMORY_SCOPE_AGENT) < target && ++sp_ < (1u << 22)) __builtin_amdgcn_s_sleep(2); }
    asm volatile("" ::: "memory");
    __builtin_amdgcn_fence(__ATOMIC_ACQUIRE, "agent"); asm volatile("s_waitcnt vmcnt(0)" ::: "memory");
}
__device__ __forceinline__ int part_mask(int p, int parts) { const int w = 4 / parts; return ((1 << w) - 1) << (p * w); }
__device__ __forceinline__ int opaque_bx() { int b = (int)blockIdx.x; asm volatile("" : "+s"(b)); return b; }
__device__ __forceinline__ Unit final_unit(int f, int cbase) { Unit u; u.pm = MPROMPT / 256; u.pn = f; u.k0 = 0; u.nt = 0; u.cidx = cbase + f; u.sid = 0; return u; }

struct EpiIn {
    static constexpr bool PERM = true, AFTER_DRAIN = false;
    bf16* O; float* vsq; SplitCtl sp;
    template <int ACT> __device__ __forceinline__ void run(const f32x4 (&acc)[2][2][4][2], const Unit& u, int wr, int wc, int fr, int fq, bool dosq, int mmask, int nai) const {
        const int row0 = u.pm * BM + wr * 64 + fr, col0 = u.pn * BM + wc * 32 + 8 * fq;
#pragma unroll
        for (int ai = 0; ai < 2; ++ai) { if (ai >= nai) break;
#pragma unroll
            for (int m = 0; m < 4; ++m) { if (!((mmask >> m) & 1)) continue; const int row = row0 + ai * HALF + m * 16; bf16* rowp = O + (size_t)row * N_INP + col0; float sq = 0.f;
#pragma unroll
                for (int bj = 0; bj < 2; ++bj) { f32x4 v0 = acc[ai][bj][m][0], v1 = acc[ai][bj][m][1];
#pragma unroll
                    for (int j = 0; j < 4; ++j) {
                        if (ACT == 1) { v0[j] = gelu_tanh(v0[j]); v1[j] = gelu_tanh(v1[j]); }
                        if (ACT == 2) { v0[j] = sigmoidf_(v0[j]); v1[j] = sigmoidf_(v1[j]); }
                        sq += v0[j] * v0[j] + v1[j] * v1[j]; }
                    u32x4 w; w.x = cvt_pk_bf16(v0[0], v0[1]); w.y = cvt_pk_bf16(v0[2], v0[3]); w.z = cvt_pk_bf16(v1[0], v1[1]); w.w = cvt_pk_bf16(v1[2], v1[3]);
                    *(GAS u32x4*)(rowp + bj * HALF) = w; }
                if (ACT == 1) { if (dosq && vsq) { sq += xor_lt32<16>(sq); sq = add_xor32(sq); if (fq == 0) atomicAdd(vsq + row, sq); } }
            } }
    }
    __device__ __forceinline__ void apply(const f32x4 (&acc)[2][2][4][2], const Unit& u, int wr, int wc, int fr, int fq, int mmask, int nai) const {
        const int pn = u.pn;
        if (pn >= 16) run<2>(acc, u, wr, wc, fr, fq, false, mmask, nai);
        else if (pn >= 2 && pn < 6) run<1>(acc, u, wr, wc, fr, fq, pn >= 4, mmask, nai);
        else run<0>(acc, u, wr, wc, fr, fq, false, mmask, nai);
    }
    __device__ __forceinline__ void operator()(const f32x4 (&acc)[2][2][4][2], const Unit& u, int wr, int wc, int fr, int fq) const { apply(acc, u, wr, wc, fr, fq, 15, 2); }
    __device__ __forceinline__ void partial(f32x4 (&acc)[2][2][4][2], const Unit& u, int wr, int wc, int fr, int fq, int wid, int lane) const {
        split_store(acc, sp.SLAB, u.sid, wid, lane); split_post(sp.cnt + u.cidx * 8 + wid, lane);
    }
    __device__ __forceinline__ void final(const Unit& u, int wr, int wc, int fr, int fq, int wid, int lane, int mmask) const {
        f32x4 acc[2][2][4][2];
        split_wait(sp.cnt + u.cidx * 8 + wid, sp.nsl, lane);
        split_sum(acc, sp.SLAB, u.pn * (int)sp.nsl, (int)sp.nsl, wid, lane, mmask); apply(acc, u, wr, wc, fr, fq, mmask, 1);
    }
};
struct EpiBf16Plain {
    static constexpr bool PERM = true, AFTER_DRAIN = false;
    bf16* O; int ldc;
    __device__ __forceinline__ void partial(f32x4 (&)[2][2][4][2], const Unit&, int, int, int, int, int, int) const {}
    __device__ __forceinline__ void operator()(const f32x4 (&acc)[2][2][4][2], const Unit& u, int wr, int wc, int fr, int fq) const {
        const int row0 = u.pm * BM + wr * 64 + fr, col0 = u.pn * BM + wc * 32 + 8 * fq;
#pragma unroll
        for (int ai = 0; ai < 2; ++ai)
#pragma unroll
            for (int m = 0; m < 4; ++m) { bf16* rowp = O + (size_t)(row0 + ai * HALF + m * 16) * ldc + col0;
#pragma unroll
                for (int bj = 0; bj < 2; ++bj) { const f32x4 v0 = acc[ai][bj][m][0], v1 = acc[ai][bj][m][1];
                    u32x4 w; w.x = cvt_pk_bf16(v0[0], v0[1]); w.y = cvt_pk_bf16(v0[2], v0[3]); w.z = cvt_pk_bf16(v1[0], v1[1]); w.w = cvt_pk_bf16(v1[2], v1[3]);
                    *(GAS u32x4*)(rowp + bj * HALF) = w; } }
    }
};
__device__ __forceinline__ float dpp_ror1(float x) { return __builtin_bit_cast(float, __builtin_amdgcn_update_dpp(0, __builtin_bit_cast(int, x), 0x121, 0xf, 0xf, false)); }
__device__ __forceinline__ float dpp_ror2(float x) { return __builtin_bit_cast(float, __builtin_amdgcn_update_dpp(0, __builtin_bit_cast(int, x), 0x122, 0xf, 0xf, false)); }
__device__ __forceinline__ float dpp_shr1(float old, float x) { return __builtin_bit_cast(float, __builtin_amdgcn_update_dpp(__builtin_bit_cast(int, old), __builtin_bit_cast(int, x), 0x111, 0xf, 0xf, false)); }
__device__ __forceinline__ float dpp_shr2(float old, float x) { return __builtin_bit_cast(float, __builtin_amdgcn_update_dpp(__builtin_bit_cast(int, old), __builtin_bit_cast(int, x), 0x112, 0xf, 0xf, false)); }
struct EpiUpConv {
    static constexpr bool PERM = true, AFTER_DRAIN = false;
    bf16* ACT; float* HALO; const float* cw; const float* cb; const float* st; float* cfs; LAS float* EX; int dry;
    __device__ __forceinline__ void partial(f32x4 (&)[2][2][4][2], const Unit&, int, int, int, int, int, int) const {}
    __device__ __forceinline__ void operator()(const f32x4 (&acc)[2][2][4][2], const Unit& u, int wr, int wc, int fr, int fq) const {
        asm volatile("" : "+v"(fr), "+v"(fq));
        if (dry) {
#pragma unroll
            for (int ai = 0; ai < 2; ++ai)
#pragma unroll
                for (int bj = 0; bj < 2; ++bj)
#pragma unroll
                    for (int m = 0; m < 4; ++m)
#pragma unroll
                        for (int n = 0; n < 2; ++n) asm volatile("" :: "v"(acc[ai][bj][m][n]));
            return; }
        const int cl = wc * 32 + 8 * fq;
        if (u.pm == MPROMPT / 256) {
#pragma unroll
            for (int n = 0; n < 2; ++n) { const int c = u.pn * 128 + cl + 4 * n;
                f32x4 wa0, wa1, wa2, wb0, wb1, wb2, ba, bb;
                wa0 = *(const GAS f32x4*)(cw + c); wa1 = *(const GAS f32x4*)(cw + D_UP + c); wa2 = *(const GAS f32x4*)(cw + 2 * D_UP + c); wb0 = *(const GAS f32x4*)(cw + D_FF + c); wb1 = *(const GAS f32x4*)(cw + D_UP + D_FF + c); wb2 = *(const GAS f32x4*)(cw + 2 * D_UP + D_FF + c);
                ba = *(const GAS f32x4*)(cb + c); bb = *(const GAS f32x4*)(cb + D_FF + c);
#pragma unroll
                for (int m = 0; m < 4; ++m) { const int s = wr * 64 + m * 16 + fr; const float* sp = st + (size_t)s * 2 * D_UP; float* op = cfs + (size_t)s * 2 * D_UP;
                    const f32x4 a2 = *(const GAS f32x4*)(sp + c), a1 = *(const GAS f32x4*)(sp + D_UP + c), b2 = *(const GAS f32x4*)(sp + D_FF + c), b1 = *(const GAS f32x4*)(sp + D_UP + D_FF + c);
                    const f32x4 ua = acc[0][0][m][n], ub = acc[0][1][m][n];
                    *(GAS f32x4*)(op + c) = a1; *(GAS f32x4*)(op + D_FF + c) = b1; *(GAS f32x4*)(op + D_UP + c) = ua; *(GAS f32x4*)(op + D_UP + D_FF + c) = ub;
                    const f32x4 ca = ba + wa0 * a2 + wa1 * a1 + wa2 * ua, cbv = bb + wb0 * b2 + wb1 * b1 + wb2 * ub;
                    u32x2 w; w.x = cvt_pk_bf16(siluf_(ca[0]) * cbv[0], siluf_(ca[1]) * cbv[1]); w.y = cvt_pk_bf16(siluf_(ca[2]) * cbv[2], siluf_(ca[3]) * cbv[3]);
                    *(GAS u32x2*)(ACT + (size_t)(MPROMPT + s) * D_FF + c) = w; }
                asm volatile("" ::: "memory"); }
            return;
        }
        f32x4 wts[2][8];
#pragma unroll
        for (int n = 0; n < 2; ++n) { const int c = u.pn * 128 + cl + 4 * n;
            wts[n][0] = *(const GAS f32x4*)(cw + c); wts[n][1] = *(const GAS f32x4*)(cw + D_UP + c); wts[n][2] = *(const GAS f32x4*)(cw + 2 * D_UP + c);
            wts[n][3] = *(const GAS f32x4*)(cw + D_FF + c); wts[n][4] = *(const GAS f32x4*)(cw + D_UP + D_FF + c); wts[n][5] = *(const GAS f32x4*)(cw + 2 * D_UP + D_FF + c);
            wts[n][6] = *(const GAS f32x4*)(cb + c); wts[n][7] = *(const GAS f32x4*)(cb + D_FF + c); }
        if (fr >= 14) {
#pragma unroll
            for (int ai = 0; ai < 2; ++ai)
#pragma unroll
                for (int bj = 0; bj < 2; ++bj)
#pragma unroll
                    for (int n = 0; n < 2; ++n) *(LAS f32x4*)(EX + ((ai * 2 + wr) * 2 + (fr - 14)) * 256 + bj * 128 + cl + 4 * n) = acc[ai][bj][3][n];
            if (wr == 1) {
#pragma unroll
                for (int bj = 0; bj < 2; ++bj)
#pragma unroll
                    for (int n = 0; n < 2; ++n) *(GAS f32x4*)(HALO + ((size_t)u.pm * 4 + 2 + (fr - 14)) * D_UP + u.pn * 256 + bj * 128 + cl + 4 * n) = acc[1][bj][3][n]; }
        }
        if (fr < 2 && wr == 0) {
#pragma unroll
            for (int bj = 0; bj < 2; ++bj)
#pragma unroll
                for (int n = 0; n < 2; ++n) *(GAS f32x4*)(HALO + ((size_t)u.pm * 4 + fr) * D_UP + u.pn * 256 + bj * 128 + cl + 4 * n) = acc[0][bj][0][n]; }
        asm volatile("s_waitcnt lgkmcnt(0)" ::: "memory"); __builtin_amdgcn_s_barrier(); asm volatile("" ::: "memory");
#pragma unroll
        for (int n = 0; n < 2; ++n) { const int c = u.pn * 128 + cl + 4 * n;
            const f32x4 wa0 = wts[n][0], wa1 = wts[n][1], wa2 = wts[n][2], wb0 = wts[n][3], wb1 = wts[n][4], wb2 = wts[n][5], ba = wts[n][6], bb = wts[n][7];
#pragma unroll
            for (int ai = 0; ai < 2; ++ai)
#pragma unroll
                for (int m = 0; m < 4; ++m) {
                    f32x4 cv[2];
#pragma unroll
                    for (int bj = 0; bj < 2; ++bj) { const f32x4 cur = acc[ai][bj][m][n]; f32x4 pb;
                        if (m > 0) pb = acc[ai][bj][m - 1][n];
                        else { pb = (f32x4){0.f, 0.f, 0.f, 0.f};
                            const int sa = wr == 1 ? ai : 0, sw = wr == 1 ? 0 : 1; const bool have = (wr == 1) || (ai == 1);
                            if (have && fr >= 14) pb = *(const LAS f32x4*)(EX + ((sa * 2 + sw) * 2 + (fr - 14)) * 256 + bj * 128 + cl + 4 * n); }
                        f32x4 x1, x2;
#pragma unroll
                        for (int j = 0; j < 4; ++j) { x1[j] = dpp_shr1(dpp_ror1(pb[j]), cur[j]); x2[j] = dpp_shr2(dpp_ror2(pb[j]), cur[j]); }
                        cv[bj] = bj == 0 ? ba + wa0 * x2 + wa1 * x1 + wa2 * cur : bb + wb0 * x2 + wb1 * x1 + wb2 * cur; }
                    u32x2 w; w.x = cvt_pk_bf16(siluf_(cv[0][0]) * cv[1][0], siluf_(cv[0][1]) * cv[1][1]); w.y = cvt_pk_bf16(siluf_(cv[0][2]) * cv[1][2], siluf_(cv[0][3]) * cv[1][3]);
                    *(GAS u32x2*)(ACT + (size_t)(u.pm * BM + ai * HALF + wr * 64 + m * 16 + fr) * D_FF + c) = w; }
            asm volatile("" ::: "memory"); }
    }
};
struct EpiGlu {
    static constexpr bool PERM = true, AFTER_DRAIN = false;
    const bf16* Y; bf16* O;
    __device__ __forceinline__ void partial(f32x4 (&)[2][2][4][2], const Unit&, int, int, int, int, int, int) const {}
    __device__ __forceinline__ void operator()(const f32x4 (&acc)[2][2][4][2], const Unit& u, int wr, int wc, int fr, int fq) const {
        const int row0 = u.pm * BM + wr * 64 + fr, col0 = u.pn * BM + wc * 32 + 8 * fq;
#pragma unroll
        for (int ai = 0; ai < 2; ++ai)
#pragma unroll
            for (int m = 0; m < 4; ++m) { const size_t off = (size_t)(row0 + ai * HALF + m * 16) * 512 + col0;
#pragma unroll
                for (int bj = 0; bj < 2; ++bj) { const f32x4 v0 = acc[ai][bj][m][0], v1 = acc[ai][bj][m][1];
                    const u32x4 y = *(const GAS u32x4*)(Y + off + bj * HALF);
                    u32x4 w;
                    w.x = cvt_pk_bf16(bflo(y.x) * sigmoidf_(v0[0]), bfhi(y.x) * sigmoidf_(v0[1]));
                    w.y = cvt_pk_bf16(bflo(y.y) * sigmoidf_(v0[2]), bfhi(y.y) * sigmoidf_(v0[3]));
                    w.z = cvt_pk_bf16(bflo(y.z) * sigmoidf_(v1[0]), bfhi(y.z) * sigmoidf_(v1[1]));
                    w.w = cvt_pk_bf16(bflo(y.w) * sigmoidf_(v1[2]), bfhi(y.w) * sigmoidf_(v1[3]));
                    *(GAS u32x4*)(O + off + bj * HALF) = w; } }
    }
};
template <int MODE> struct EpiMerge {
    static constexpr bool PERM = false, AFTER_DRAIN = false;
    const bf16* G;
    float* T; bf16* MG; const float* csq;
    f32x4* SLAB; const bf16* PRJ; unsigned* cnt;
    __device__ __forceinline__ void partial(f32x4 (&acc)[2][2][4][2], const Unit& u, int wr, int wc, int fr, int fq, int wid, int lane) const {
        split_store(acc, SLAB, u.sid, wid, lane); split_post(cnt + u.cidx * 8 + wid, lane);
    }
    __device__ __forceinline__ void final(const Unit& u, int wr, int wc, int fr, int fq, int wid, int lane, int mmask) const {
        split_wait(cnt + u.cidx * 8 + wid, 8u, lane);
        asm volatile("" : "+v"(fr), "+v"(fq), "+v"(lane));
#pragma unroll
        for (int m = 0; m < 4; ++m) { if (!((mmask >> m) & 1)) continue; const int r = wr * 64 + m * 16 + fr, row = MPROMPT + r; const float rs = rsqrtf(csq[row] * (1.0f / 1024.0f) + EPS);
            const __amdgpu_buffer_rsrc_t rs_ = slab_rsrc(SLAB);
#pragma unroll
            for (int bj = 0; bj < 2; ++bj) {
                f32x4 sa[2], sb[2], sc[2];
                {   f32x4 la[2][2], lb[2][2], lc[2][4];
#pragma unroll
                    for (int n = 0; n < 2; ++n) { const unsigned vo = (unsigned)((wid * 16 + (m * 2 + bj) * 2 + n) * 64 + lane) * 16u;
#pragma unroll
                        for (int j = 0; j < 2; ++j) { la[n][j] = slab_ld(rs_, vo, (unsigned)(u.pn * 2 + j) * (unsigned)(SLAB_F4 * 16)); lb[n][j] = slab_ld(rs_, vo, (unsigned)(16 + u.pn * 2 + j) * (unsigned)(SLAB_F4 * 16)); }
#pragma unroll
                        for (int j = 0; j < 4; ++j) lc[n][j] = slab_ld(rs_, vo, (unsigned)(32 + u.pn * 4 + j) * (unsigned)(SLAB_F4 * 16)); }
#pragma unroll
                    for (int n = 0; n < 2; ++n) { sa[n] = la[n][0] + la[n][1]; sb[n] = lb[n][0] + lb[n][1]; sc[n] = (lc[n][0] + lc[n][1]) + (lc[n][2] + lc[n][3]); } }
#pragma unroll
                for (int n = 0; n < 2; ++n) { const int col = split_col<PERM>(u, wc, fq, bj, n); const bf16* gp = PRJ + ((unsigned)row * N_INP + col);
                    const f32x4 a = sa[n], b = sb[n], c = sc[n];
                    const u32x2 ga = *(const GAS u32x2*)(gp + PC_GA), gb = *(const GAS u32x2*)(gp + PC_GB), gc = *(const GAS u32x2*)(gp + PC_GC);
                    f32x4 t; t[0] = bflo(ga.x) * a[0] + bflo(gb.x) * b[0] + bflo(gc.x) * rs * c[0]; t[1] = bfhi(ga.x) * a[1] + bfhi(gb.x) * b[1] + bfhi(gc.x) * rs * c[1];
                    t[2] = bflo(ga.y) * a[2] + bflo(gb.y) * b[2] + bflo(gc.y) * rs * c[2]; t[3] = bfhi(ga.y) * a[3] + bfhi(gb.y) * b[3] + bfhi(gc.y) * rs * c[3];
                    u32x2 w; w.x = cvt_pk_bf16(t[0], t[1]); w.y = cvt_pk_bf16(t[2], t[3]); *(GAS u32x2*)(MG + ((unsigned)row * DM + col)) = w; } }
            asm volatile("" ::: "memory"); }
    }
    __device__ __forceinline__ void operator()(const f32x4 (&acc)[2][2][4][2], const Unit& u, int wr, int wc, int fr, int fq) const {
        const int row0 = u.pm * BM + wr * 64 + fr, col0 = u.pn * BM + wc * 32 + 4 * fq;
        bf16* Tb = (bf16*)T;
#pragma unroll
        for (int ai = 0; ai < 2; ++ai) {
#pragma unroll
          for (int mh = 0; mh < 4; mh += 2) {
            u32x2 gq[4][2][2], tq[4][2][2]; float rsq[4];
#pragma unroll
            for (int m = mh; m < mh + 2; ++m) { const int row = row0 + ai * HALF + m * 16; const size_t off = (size_t)row * DM + col0; const bf16* gp = G + (size_t)row * N_INP + col0;
                rsq[m] = MODE == 2 ? csq[row] : 0.f;
#pragma unroll
                for (int bj = 0; bj < 2; ++bj)
#pragma unroll
                    for (int n = 0; n < 2; ++n) { const int co = bj * HALF + n * 16; gq[m][bj][n] = *(const GAS u32x2*)(gp + co); if (MODE != 0) tq[m][bj][n] = *(const GAS u32x2*)(Tb + off + co); } }
#pragma unroll
            for (int m = mh; m < mh + 2; ++m) { const int row = row0 + ai * HALF + m * 16; const size_t off = (size_t)row * DM + col0;
                const float rs = MODE == 2 ? rsqrtf(rsq[m] * (1.0f / 1024.0f) + EPS) : 1.f;
#pragma unroll
                for (int bj = 0; bj < 2; ++bj)
#pragma unroll
                    for (int n = 0; n < 2; ++n) { const int co = bj * HALF + n * 16; const u32x2 g = gq[m][bj][n]; f32x4 v = acc[ai][bj][m][n];
                        v[0] *= bflo(g.x); v[1] *= bfhi(g.x); v[2] *= bflo(g.y); v[3] *= bfhi(g.y);
                        if (MODE == 0) { u32x2 w; w.x = cvt_pk_bf16(v[0], v[1]); w.y = cvt_pk_bf16(v[2], v[3]); *(GAS u32x2*)(Tb + off + co) = w; }
                        if (MODE == 1) { const u32x2 tb = tq[m][bj][n]; u32x2 w; w.x = cvt_pk_bf16(bflo(tb.x) + v[0], bfhi(tb.x) + v[1]); w.y = cvt_pk_bf16(bflo(tb.y) + v[2], bfhi(tb.y) + v[3]); *(GAS u32x2*)(Tb + off + co) = w; }
                        if (MODE == 2) { const u32x2 tb = tq[m][bj][n]; f32x4 t = {bflo(tb.x), bfhi(tb.x), bflo(tb.y), bfhi(tb.y)}; t = t + v * rs; u32x2 w; w.x = cvt_pk_bf16(t[0], t[1]); w.y = cvt_pk_bf16(t[2], t[3]); *(GAS u32x2*)(MG + off + co) = w; } } } } }
    }
};
template <int SEG> struct EpiChain {
    static constexpr bool PERM = false, AFTER_DRAIN = false;
    const bf16* PRJ; bf16* MG; const float* csq;
    __device__ __forceinline__ void partial(f32x4 (&)[2][2][4][2], const Unit&, int, int, int, int, int, int) const {}
    __device__ __forceinline__ void operator()(f32x4 (&acc)[2][2][4][2], const Unit& u, int wr, int wc, int fr, int fq) const {
        const int row0 = u.pm * BM + wr * 64 + fr, col0 = u.pn * BM + wc * 32 + 4 * fq;
#pragma unroll
        for (int ai = 0; ai < 2; ++ai)
#pragma unroll
            for (int m = 0; m < 4; ++m) { const int row = row0 + ai * HALF + m * 16; const bf16* gp = PRJ + ((unsigned)row * N_INP + col0);
                float rs = 1.f; if (SEG >= 1) rs = rsqrtf(csq[row] * (1.0f / 1024.0f) + EPS);
#pragma unroll
                for (int bj = 0; bj < 2; ++bj)
#pragma unroll
                    for (int n = 0; n < 2; ++n) { const int co = bj * HALF + n * 16; f32x4 v = acc[ai][bj][m][n];
                        if (SEG == 0) { const u32x2 ga = *(const GAS u32x2*)(gp + PC_GA + co), gb = *(const GAS u32x2*)(gp + PC_GB + co);
                            v[0] *= bflo(ga.x) * __builtin_amdgcn_rcpf(fmaxf(bflo(gb.x), 1e-20f)); v[1] *= bfhi(ga.x) * __builtin_amdgcn_rcpf(fmaxf(bfhi(gb.x), 1e-20f));
                            v[2] *= bflo(ga.y) * __builtin_amdgcn_rcpf(fmaxf(bflo(gb.y), 1e-20f)); v[3] *= bfhi(ga.y) * __builtin_amdgcn_rcpf(fmaxf(bfhi(gb.y), 1e-20f)); acc[ai][bj][m][n] = v; }
                        if (SEG == 1) { const u32x2 gb = *(const GAS u32x2*)(gp + PC_GB + co), gc = *(const GAS u32x2*)(gp + PC_GC + co);
                            v[0] *= fmaxf(bflo(gb.x), 1e-20f) * __builtin_amdgcn_rcpf(fmaxf(bflo(gc.x) * rs, 1e-20f)); v[1] *= fmaxf(bfhi(gb.x), 1e-20f) * __builtin_amdgcn_rcpf(fmaxf(bfhi(gc.x) * rs, 1e-20f));
                            v[2] *= fmaxf(bflo(gb.y), 1e-20f) * __builtin_amdgcn_rcpf(fmaxf(bflo(gc.y) * rs, 1e-20f)); v[3] *= fmaxf(bfhi(gb.y), 1e-20f) * __builtin_amdgcn_rcpf(fmaxf(bfhi(gc.y) * rs, 1e-20f)); acc[ai][bj][m][n] = v; }
                        if (SEG == 2) { const u32x2 gc = *(const GAS u32x2*)(gp + PC_GC + co);
                            v[0] *= fmaxf(bflo(gc.x) * rs, 1e-20f); v[1] *= fmaxf(bfhi(gc.x) * rs, 1e-20f); v[2] *= fmaxf(bflo(gc.y) * rs, 1e-20f); v[3] *= fmaxf(bfhi(gc.y) * rs, 1e-20f);
                            u32x2 w; w.x = cvt_pk_bf16(v[0], v[1]); w.y = cvt_pk_bf16(v[2], v[3]); *(GAS u32x2*)(MG + ((unsigned)row * DM + col0 + co)) = w; } }
                asm volatile("" ::: "memory"); }
    }
};
struct EpiResid {
    static constexpr bool PERM = false, AFTER_DRAIN = false;
    const bf16* XI; const bf16* XIS; bf16* XO; const float* gate; SplitCtl sp;
    __device__ __forceinline__ void partial(f32x4 (&acc)[2][2][4][2], const Unit& u, int wr, int wc, int fr, int fq, int wid, int lane) const {
        split_store(acc, sp.SLAB, u.sid, wid, lane);
        if (split_arrive(sp.cnt + u.cidx * 8 + wid, sp.nsl, lane)) { split_zero_pad(acc); split_sum(acc, sp.SLAB, u.pn * (int)sp.nsl, (int)sp.nsl, wid, lane); (*this)(acc, u, wr, wc, fr, fq); }
    }
    __device__ __forceinline__ void operator()(const f32x4 (&acc)[2][2][4][2], const Unit& u, int wr, int wc, int fr, int fq, int mmask = 15) const {
        const int row0 = u.pm * BM + wr * 64 + fr, col0 = u.pn * BM + wc * 32 + 4 * fq;
        const __amdgpu_buffer_rsrc_t xr = __builtin_amdgcn_make_buffer_rsrc((void*)XO, (short)0, (int)((size_t)MP * DM * 2), 0x00020000);
        const bool samp = u.pm == MPROMPT / 256;
        const bf16* xs16 = samp ? XIS - (size_t)MPROMPT * DM : XI;
#pragma unroll
        for (int ai = 0; ai < 2; ++ai) { if (ai == 1 && samp) break;
            u32x2 xw[4][2][2]; f32x4 gg[4][2][2];
#pragma unroll
            for (int m = 0; m < 4; ++m) { if (!((mmask >> m) & 1)) continue; const int row = row0 + ai * HALF + m * 16; const size_t off = (size_t)row * DM + col0; const float* gp = gate + (size_t)mod_row(row) * MOD_PITCH + col0;
#pragma unroll
                for (int bj = 0; bj < 2; ++bj)
#pragma unroll
                    for (int n = 0; n < 2; ++n) { const int co = bj * HALF + n * 16; xw[m][bj][n] = *(const GAS u32x2*)(xs16 + off + co); gg[m][bj][n] = *(const GAS f32x4*)(gp + co); } }
#pragma unroll
            for (int m = 0; m < 4; ++m) { if (!((mmask >> m) & 1)) continue; const int row = row0 + ai * HALF + m * 16; const size_t off = (size_t)row * DM + col0;
#pragma unroll
                for (int bj = 0; bj < 2; ++bj)
#pragma unroll
                    for (int n = 0; n < 2; ++n) { const int co = bj * HALF + n * 16; const u32x2 w = xw[m][bj][n]; const f32x4 xi = {bflo(w.x), bfhi(w.x), bflo(w.y), bfhi(w.y)};
                        const f32x4 xo = xi + gg[m][bj][n] * acc[ai][bj][m][n]; u32x2 wo; wo.x = cvt_pk_bf16(xo[0], xo[1]); wo.y = cvt_pk_bf16(xo[2], xo[3]);
                        __builtin_amdgcn_raw_buffer_store_b64(wo, xr, (unsigned)(off + co) * 2u, 0,   16); } } }
    }
};
template <int MODE> struct EpiResidPrep {
    static constexpr bool PERM = false, AFTER_DRAIN = true;
    EpiResid R; bf16* H; float* yp; float* ys; const float* g; const float* mod2; int sh_idx, sc_idx; const float* wdt; float* DT; unsigned* pc;
    __device__ __forceinline__ void partial(f32x4 (&acc)[2][2][4][2], const Unit& u, int wr, int wc, int fr, int fq, int wid, int lane) const {
        split_store(acc, R.sp.SLAB, u.sid, wid, lane); split_post(R.sp.cnt + u.cidx * 8 + wid, lane);
    }
    __device__ __forceinline__ void operator()(const f32x4 (&acc)[2][2][4][2], const Unit& u, int wr, int wc, int fr, int fq) const { R(acc, u, wr, wc, fr, fq); }
    __device__ __forceinline__ void fused(f32x4 (&acc)[2][2][4][2], const Unit& u, int wr, int wc, int fr, int fq, LAS unsigned char* lds, int wid, int lane) const {
        R(acc, u, wr, wc, fr, fq);
        const int fin = opaque_bx() - R.sp.fin0; const bool isfin = fin >= 0 && fin < (DM / 256) * R.sp.parts;
        if (isfin) { const Unit uf = final_unit(fin / R.sp.parts, R.sp.cbase); const int mmask = part_mask(fin % R.sp.parts, R.sp.parts);
            split_wait(R.sp.cnt + uf.cidx * 8 + wid, R.sp.nsl, lane);
            split_sum(acc, R.sp.SLAB, uf.pn * (int)R.sp.nsl, (int)R.sp.nsl, wid, lane, mmask); R(acc, uf, wr, wc, fr, fq, mmask); }
        asm volatile("s_waitcnt vmcnt(0)" ::: "memory"); __syncthreads();
        if (wid == 0 && lane == 0) {
            if (isfin) __hip_atomic_fetch_add(pc + 32, 8u / (unsigned)R.sp.parts, __ATOMIC_RELAXED, __HIP_MEMORY_SCOPE_AGENT);
            __hip_atomic_fetch_add(pc + u.pm, 1u, __ATOMIC_RELAXED, __HIP_MEMORY_SCOPE_AGENT);
            unsigned sp_ = 0; while (__hip_atomic_load(pc + u.pm, __ATOMIC_RELAXED, __HIP_MEMORY_SCOPE_AGENT) < 8u && ++sp_ < (1u << 22)) __builtin_amdgcn_s_sleep(2);
            if (u.pn == 0) { sp_ = 0; while (__hip_atomic_load(pc + 32, __ATOMIC_RELAXED, __HIP_MEMORY_SCOPE_AGENT) < 64u && ++sp_ < (1u << 22)) __builtin_amdgcn_s_sleep(2); }
            __builtin_amdgcn_fence(__ATOMIC_ACQUIRE, "agent"); asm volatile("s_waitcnt vmcnt(0)" ::: "memory");
        }
        __syncthreads();
        LAS float* wT = (LAS float*)lds;
        if (MODE == 1) { f32x4 tw[16];
#pragma unroll
            for (int i = 0; i < 16; ++i) tw[i] = ((const f32x4*)wdt)[wid * 64 + lane + i * NTHR];
#pragma unroll
            for (int i = 0; i < 16; ++i) ((LAS f32x4*)wT)[wid * 64 + lane + i * NTHR] = tw[i];
            __syncthreads(); }
        const bf16* X = R.XO;
        {   const int row = u.pm * BM + u.pn * 32 + wid * 4;
            prep_rows4<MODE>(X + (size_t)row * DM, g, mod2 + (size_t)mod_row(row) * MOD_PITCH, sh_idx, sc_idx, H + (size_t)row * DM, yp + (size_t)row * DM, DT + (size_t)row * 16, wT, lane); }
        if (u.pn == 0 && wid < 4) { const int s = u.pm * 4 + wid, row = MPROMPT + s;
            prep_row<MODE>(X + (size_t)row * DM, g, mod2 + (size_t)mod_row(row) * MOD_PITCH, sh_idx, sc_idx, H + (size_t)row * DM, ys + (size_t)s * DM, DT + (size_t)row * 16, wT, lane); }
        if (MODE == 1) __syncthreads();
    }
};
struct EpiMod {
    static constexpr bool PERM = false, AFTER_DRAIN = false;
    float* MOD; const float* bmod;
    __device__ __forceinline__ void partial(f32x4 (&)[2][2][4][2], const Unit&, int, int, int, int, int, int) const {}
    __device__ __forceinline__ void operator()(const f32x4 (&acc)[2][2][4][2], const Unit& u, int wr, int wc, int fr, int fq) const {
        const int row0 = wr * 64 + fr, col0 = u.pn * BM + wc * 32 + 4 * fq;
        f32x4 bv[2][2];
#pragma unroll
        for (int bj = 0; bj < 2; ++bj)
#pragma unroll
            for (int n = 0; n < 2; ++n) bv[bj][n] = *(const GAS f32x4*)(bmod + col0 + bj * HALF + n * 16);
#pragma unroll
        for (int ai = 0; ai < 2; ++ai)
#pragma unroll
            for (int m = 0; m < 4; ++m) { float* rowp = MOD + (size_t)(row0 + ai * HALF + m * 16) * MOD_PITCH + col0;
#pragma unroll
                for (int bj = 0; bj < 2; ++bj)
#pragma unroll
                    for (int n = 0; n < 2; ++n) *(GAS f32x4*)(rowp + bj * HALF + n * 16) = acc[ai][bj][m][n] + bv[bj][n]; }
    }
};
}
struct Frame {
    LAS unsigned char* lds;
    int tid, lane, wave, gw;
    float* out; unsigned char* ws;
};
#define WSP(T, off) ((T*)(F.ws + (off)))
__device__ __forceinline__ Frame launder(const Frame& F0) {
    Frame F = F0; int t = F0.tid; asm volatile("" : "+v"(t)); F.tid = t; F.lane = t & 63; F.wave = __builtin_amdgcn_readfirstlane(t >> 6);
    unsigned long long w = (unsigned long long)F0.ws, o = (unsigned long long)F0.out; asm volatile("" : "+s"(w), "+s"(o)); F.ws = (unsigned char*)w; F.out = (float*)o;
    F.gw = blockIdx.x * NWAVES + F.wave; return F;
}

__device__ __forceinline__ void transpose_item(const float* W, int ld, int K, int ncols, int c0, bf16* WT, int row_off, LAS float* scr, int item, int lane) {
    const int nblk = ncols / 32, kb = item / nblk, nb = item % nblk, k0 = 64 * kb, n0 = 32 * nb;
    const int rbase = row_off >= 0 ? row_off + n0 : (n0 < D_FF ? 256 * (n0 / 128) + n0 % 128 : 256 * ((n0 - D_FF) / 128) + 128 + (n0 - D_FF) % 128);
    float tv[32];
#pragma unroll
    for (int i = 0; i < 32; ++i) { const int kk = 2 * i + (lane >> 5); tv[i] = __builtin_nontemporal_load(W + (size_t)(k0 + kk) * ld + c0 + n0 + (lane & 31)); }
#pragma unroll
    for (int i = 0; i < 32; ++i) { const int kk = 2 * i + (lane >> 5); scr[kk * 33 + (lane & 31)] = tv[i]; }
    if (false) for (int i = 0; i < 32; ++i) { const int kk = 2 * i + (lane >> 5); scr[kk * 33 + (lane & 31)] = __builtin_nontemporal_load(W + (size_t)(k0 + kk) * ld + c0 + n0 + (lane & 31)); }
    LDS_WAIT(); asm volatile("" ::: "memory");
    const int c = lane & 7;
#pragma unroll
    for (int j = 0; j < 4; ++j) { const int n = (lane >> 3) + 8 * j; const LAS float* s = scr + (8 * c) * 33 + n;
        v4u o; o.x = pk2(s[0 * 33], s[1 * 33]); o.y = pk2(s[2 * 33], s[3 * 33]); o.z = pk2(s[4 * 33], s[5 * 33]); o.w = pk2(s[6 * 33], s[7 * 33]);
        *(GAS v4u*)(WT + (size_t)(rbase + n) * K + k0 + 8 * c) = o; }
    LDS_WAIT(); asm volatile("" ::: "memory");
}
constexpr int MODC = 96, MODK = 128, MODP = 136;
__device__ __forceinline__ void phase_mod(const Frame& F0, KArgs A) {
    Frame F = launder(F0);
    const int n0 = blockIdx.x * MODC, l = n0 / N_MOD, cl = n0 - l * N_MOD;
    const float* W = A->in[I_WMOD] + (size_t)l * DM * N_MOD + cl;
    LAS bf16* Bt = (LAS bf16*)F.lds;
    LAS bf16* As = (LAS bf16*)(F.lds + 2 * MODC * MODP * 2);
    for (int i = F.tid; i < 2 * 12 * MODP; i += NTHR) { const int b = i / (12 * MODP), r = i % (12 * MODP); As[(b * 144 + 132) * MODP + r] = (bf16)0; }
    f32x4 wa[6], wb[6], creg[9];
    auto load_w = [&](f32x4 (&wr)[6], int kc) {
#pragma unroll
        for (int j = 0; j < 6; ++j) { const int idx = F.tid + NTHR * j, n = idx % MODC, k = 4 * (idx / MODC); const float* p = W + (size_t)(kc * MODK + k) * N_MOD + n;
            wr[j].x = __builtin_nontemporal_load(p); wr[j].y = __builtin_nontemporal_load(p + N_MOD); wr[j].z = __builtin_nontemporal_load(p + 2 * N_MOD); wr[j].w = __builtin_nontemporal_load(p + 3 * (size_t)N_MOD); }
    };
    auto load_c = [&](int kc) {
#pragma unroll
        for (int j = 0; j < 9; ++j) { const int idx = F.tid + NTHR * j, r = idx >> 5, k4 = (idx & 31) * 4;
            const float* src = r < NB ? A->in[I_CP] + (size_t)r * DM : A->in[I_CS] + (size_t)(r - NB) * DM;
            creg[j] = r < NB + NS ? *(const GAS f32x4*)(src + kc * MODK + k4) : (f32x4){0.f, 0.f, 0.f, 0.f}; }
    };
    auto store_w = [&](const f32x4 (&wr)[6], int buf) {
#pragma unroll
        for (int j = 0; j < 6; ++j) { const int idx = F.tid + NTHR * j, n = idx % MODC, k = 4 * (idx / MODC);
            v2u w; w.x = pk2(wr[j].x, wr[j].y); w.y = pk2(wr[j].z, wr[j].w); *(LAS v2u*)(Bt + (buf * MODC + n) * MODP + k) = w; }
    };
    auto store_c = [&](int buf) {
#pragma unroll
        for (int j = 0; j < 9; ++j) { const int idx = F.tid + NTHR * j, r = idx >> 5, k4 = (idx & 31) * 4;
            if (r < NB + NS) { v2u w; w.x = pk2(siluf_(creg[j].x), siluf_(creg[j].y)); w.y = pk2(siluf_(creg[j].z), siluf_(creg[j].w)); *(LAS v2u*)(As + (buf * 144 + r) * MODP + k4) = w; } }
    };
    f32x4 acc[9];
#pragma unroll
    for (int m = 0; m < 9; ++m) acc[m] = (f32x4){0.f, 0.f, 0.f, 0.f};
    auto compute = [&](int buf) {
        if (F.wave < 6) {
#pragma unroll
            for (int ks = 0; ks < MODK / 32; ++ks) { const bf16x8 bfr = *(const LAS bf16x8*)(Bt + (buf * MODC + 16 * F.wave + (F.lane & 15)) * MODP + 32 * ks + 8 * (F.lane >> 4));
#pragma unroll
                for (int m = 0; m < 9; ++m) { const bf16x8 af = *(const LAS bf16x8*)(As + (buf * 144 + 16 * m + (F.lane & 15)) * MODP + 32 * ks + 8 * (F.lane >> 4));
                    acc[m] = __builtin_amdgcn_mfma_f32_16x16x32_bf16(af, bfr, acc[m], 0, 0, 0); } }
        }
    };
    const int kst = blockIdx.x & 15;
    load_w(wa, kst); load_c(kst); load_w(wb, (1 + kst) & 15);
    store_w(wa, 0); store_c(0); __syncthreads();
#pragma unroll 1
    for (int kc = 0; kc < DM / MODK; kc += 2) {
        load_c((kc + 1 + kst) & 15); if (kc + 2 < DM / MODK) load_w(wa, (kc + 2 + kst) & 15);
        compute(0);
        store_w(wb, 1); store_c(1); __syncthreads();
        if (kc + 2 < DM / MODK) { load_c((kc + 2 + kst) & 15); if (kc + 3 < DM / MODK) load_w(wb, (kc + 3 + kst) & 15); }
        compute(1);
        if (kc + 2 < DM / MODK) { store_w(wa, 0); store_c(0); }
        __syncthreads();
    }
    if (F.wave < 6) { float* MOD = WSP(float, WS_MOD); const int col = n0 + 16 * F.wave + (F.lane & 15); const float bias = A->in[I_BMOD][col];
#pragma unroll
        for (int m = 0; m < 9; ++m)
#pragma unroll
            for (int r = 0; r < 4; ++r) { const int row = 16 * m + 4 * (F.lane >> 4) + r; if (row < NB + NS) MOD[(size_t)row * MOD_PITCH + col] = acc[m][r] + bias; } }
    __syncthreads();
}
__device__ __forceinline__ void tjob(Frame& F, LAS float* scr, const float* W, int ld, int K, int ncols, int c0, bf16* WT, int row_off) {
    const int nit = (K / 64) * (ncols / 32);
    for (int it = F.gw; it < nit; it += (GRID * NWAVES)) transpose_item(W, ld, K, ncols, c0, WT, row_off, scr, it, F.lane);
}
__device__ __forceinline__ void phase_prologue(const Frame& F0, KArgs A) {
    Frame F = launder(F0);
    LAS float* scr = (LAS float*)(F.lds + F.wave * 16384);
#pragma unroll 1
    for (int l = 0; l < DEPTH; ++l) {
        unsigned char* wl = F.ws + WS_W + (size_t)l * WL_END;
        tjob(F, scr, A->in[I_WIN] + (size_t)l * DM * N_IN, N_IN, DM, 4096, 0, (bf16*)(wl + WL_IN), 0);
        tjob(F, scr, A->in[I_WIN] + (size_t)l * DM * N_IN, N_IN, DM, 6144, 4112, (bf16*)(wl + WL_IN), 4096);
        tjob(F, scr, A->in[I_WGLU] + (size_t)l * 512 * 512, 512, 512, 512, 0, (bf16*)(wl + WL_GLU), 0);
        tjob(F, scr, A->in[I_WPA] + (size_t)l * 512 * DM, DM, 512, DM, 0, (bf16*)(wl + WL_PA), 0);
        tjob(F, scr, A->in[I_WPB] + (size_t)l * 512 * DM, DM, 512, DM, 0, (bf16*)(wl + WL_PB), 0);
        tjob(F, scr, A->in[I_WPC] + (size_t)l * 1024 * DM, DM, 1024, DM, 0, (bf16*)(wl + WL_PC), 0);
        tjob(F, scr, A->in[I_WOUT] + (size_t)l * DM * DM, DM, DM, DM, 0, (bf16*)(wl + WL_OUT), 0);
        tjob(F, scr, A->in[I_WUP] + (size_t)l * DM * D_UP, D_UP, DM, D_UP, 0, (bf16*)(wl + WL_UP), -1);
        tjob(F, scr, A->in[I_WDOWN] + (size_t)l * D_FF * DM, DM, D_FF, DM, 0, (bf16*)(wl + WL_DOWN), 0);
    }
    {   bf16* X0 = WSP(bf16, WS_X0);
        for (int r = F.gw; r < MREAL; r += (GRID * NWAVES)) {
            const float* src = r < MPROMPT ? A->in[I_XP] + (size_t)r * DM : A->in[I_XS] + (size_t)(r - MPROMPT) * DM;
            GAS v2u* o = (GAS v2u*)(X0 + (size_t)r * DM) + F.lane;
#pragma unroll
            for (int j = 0; j < 8; ++j) { const f32x4 v = __builtin_nontemporal_load((const f32x4*)src + F.lane + 64 * j); v2u w; w.x = pk2(v.x, v.y); w.y = pk2(v.z, v.w); o[64 * j] = w; }
        }
    }
    {   float* z = WSP(float, WS_SMALL + SM_VSQ);
        const int gt = blockIdx.x * NTHR + F.tid;
        for (int i = gt; i < 4 * MP; i += GRID * NTHR) z[i] = 0.f;
    }
    {   const int gt = blockIdx.x * NTHR + F.tid, NT = GRID * NTHR;
        bf16* WSb = WSP(bf16, WS_SMALL + SM_WS);
        for (int i = gt; i < DEPTH * H_B * 128 * 128; i += NT) { const int jj = i & 127, ii = (i >> 7) & 127; WSb[i] = (bf16)(jj <= ii ? f2bf(A->in[I_WS][i]) : 0u); }
        float* AA = WSP(float, WS_SMALL + SM_S5A); float* BB = WSP(float, WS_SMALL + SM_S5BB); bf16* CT = WSP(bf16, WS_SMALL + SM_S5CT);
        for (int i = gt; i < DEPTH * G_A * P_A; i += NT) {
            const int l = i / (G_A * P_A), g = (i / P_A) % G_A;
            const float dt = expf(A->in[I_LOGDT][l * G_A + g]), lr = A->in[I_LAMRE][i], li = A->in[I_LAMIM][i];
            const float mag = expf(lr * dt); float sn, cs; sincosf(li * dt, &sn, &cs);
            const float ar = mag * cs, ai = mag * sn, den = lr * lr + li * li, nr = ar - 1.0f;
            const float kr = (nr * lr + ai * li) / den, ki = (ai * lr - nr * li) / den;
            float qr = ar, qi = ai;
#pragma unroll
            for (int s = 0; s < 6; ++s) { const float t = qr * qr - qi * qi; qi = 2.0f * qr * qi; qr = t; }
            AA[i * 4 + 0] = ar; AA[i * 4 + 1] = ai; AA[i * 4 + 2] = qr; AA[i * 4 + 3] = qi;
#pragma unroll
            for (int h = 0; h < S5G; ++h) { const float bre = A->in[I_BRE][(size_t)i * S5G + h], bim = A->in[I_BIM][(size_t)i * S5G + h];
                BB[(size_t)i * 32 + h] = kr * bre - ki * bim; BB[(size_t)i * 32 + 16 + h] = kr * bim + ki * bre; }
        }
        {   float* WDT = WSP(float, WS_SMALL + SM_WDT);
            for (int i = gt; i < DEPTH * 16 * DM; i += NT) { const int k = i % DM, hh = (i / DM) & 15, l = i / (16 * DM); WDT[i] = A->in[I_WIN][((size_t)l * DM + k) * N_IN + 4096 + hh]; } }
        for (int i = gt; i < DEPTH * G_A * S5G * 128; i += NT) { const int k = i & 127, lgh = i >> 7;
            const float v = k < 64 ? A->in[I_CRE][(size_t)lgh * 64 + k] : -A->in[I_CIM][(size_t)lgh * 64 + (k - 64)]; CT[i] = (bf16)f2bf(v); }
    }
}

template <bool WITH_DT>
__device__ __forceinline__ void phase_prep(const Frame& F0, const float* X, const float* XS, const float* g, const float* modl, int sh_idx, int sc_idx, const float* win_l, float* DT) {
    Frame F = launder(F0);
    bf16* H = WSP(bf16, WS_H);
    LAS float* wT = (LAS float*)F.lds;
    if (WITH_DT) {
        {   const GAS f32x4* wd = (const GAS f32x4*)WSP(const float, WS_SMALL + SM_WDT);
            f32x4 tw[16];
#pragma unroll
            for (int i = 0; i < 16; ++i) tw[i] = wd[F.tid + i * NTHR];
#pragma unroll
            for (int i = 0; i < 16; ++i) ((LAS f32x4*)wT)[F.tid + i * NTHR] = tw[i]; }
        (void)win_l;
        __syncthreads();
    }
    if (WITH_DT) {
        const bf16* X0 = WSP(const bf16, WS_X0); float* DTo = DT; const int gwv = blockIdx.x * NWAVES + F.wave;
        {   const int row = 4 * gwv; prep_rows4<1>(X0 + (size_t)row * DM, g, modl + (size_t)mod_row(row) * MOD_PITCH, sh_idx, sc_idx, H + (size_t)row * DM, nullptr, DTo + (size_t)row * 16, wT, F.lane); }
        if (gwv < NS) { const int row = MPROMPT + gwv; prep_row<1>(X0 + (size_t)row * DM, g, modl + (size_t)mod_row(row) * MOD_PITCH, sh_idx, sc_idx, H + (size_t)row * DM, nullptr, DTo + (size_t)row * 16, wT, F.lane); }
    } else {
    f32x4 vn[8];
    {   const int r0 = blockIdx.x * NWAVES + F.wave; const int rr0 = r0 < MREAL ? r0 : 0; const GAS f32x4* xr = (const GAS f32x4*)(rr0 < MPROMPT ? X + (size_t)rr0 * DM : XS + (size_t)(rr0 - MPROMPT) * DM) + F.lane;
#pragma unroll
        for (int j = 0; j < 8; ++j) vn[j] = xr[64 * j]; }
    for (int r = blockIdx.x * NWAVES + F.wave; r < MREAL; r += GRID * NWAVES) {
        f32x4 v[8]; float s = 0.f;
#pragma unroll
        for (int j = 0; j < 8; ++j) { v[j] = vn[j]; s += (v[j].x * v[j].x + v[j].y * v[j].y) + (v[j].z * v[j].z + v[j].w * v[j].w); }
        {   const int rn = r + GRID * NWAVES; const int rr1 = rn < MREAL ? rn : r; const GAS f32x4* xr = (const GAS f32x4*)(rr1 < MPROMPT ? X + (size_t)rr1 * DM : XS + (size_t)(rr1 - MPROMPT) * DM) + F.lane;
#pragma unroll
            for (int j = 0; j < 8; ++j) vn[j] = xr[64 * j]; }
        const float rinv = rsqrtf(wave_sum(s) * (1.0f / DM) + EPS);
        const float* mr = modl + (size_t)mod_row(r) * MOD_PITCH;
        const GAS f32x4* gp = (const GAS f32x4*)g + F.lane; const GAS f32x4* shp = (const GAS f32x4*)(mr + sh_idx * DM) + F.lane; const GAS f32x4* scp = (const GAS f32x4*)(mr + sc_idx * DM) + F.lane;
        GAS v2u* o = (GAS v2u*)(H + (size_t)r * DM) + F.lane;
#pragma unroll
        for (int j = 0; j < 8; ++j) { const f32x4 gg = gp[64 * j], sh = shp[64 * j], sc = scp[64 * j];
            v[j] = v[j] * rinv * gg * (sc + 1.0f) + sh;
            v2u w; w.x = pk2(v[j].x, v[j].y); w.y = pk2(v[j].z, v[j].w); o[64 * j] = w; }
        if (WITH_DT) {
            float a16[16];
#pragma unroll
            for (int hh = 0; hh < 16; ++hh) { float a = 0.f;
#pragma unroll
                for (int j = 0; j < 8; ++j) { const f32x4 w = *(const LAS f32x4*)(wT + hh * DM + 4 * F.lane + 256 * j); a += (v[j].x * w.x + v[j].y * w.y) + (v[j].z * w.z + v[j].w * w.w); }
                a16[hh] = a; }
            const float mine = wave_sum16(a16, F.lane);
            if (F.lane < 16) DT[(size_t)r * 16 + F.lane] = mine;
        }
    }
    }
    if (WITH_DT) __syncthreads();
}

__device__ __forceinline__ void phase_final(const Frame& F0, KArgs A, const float* X) {
    Frame F = launder(F0);
    const float* g = A->in[I_GFINAL];
    for (int r = blockIdx.x * NWAVES + F.wave; r < MREAL; r += GRID * NWAVES) {
        const GAS f32x4* xr = (const GAS f32x4*)(X + (size_t)r * DM) + F.lane;
        f32x4 v[8]; float s = 0.f;
#pragma unroll
        for (int j = 0; j < 8; ++j) { v[j] = xr[64 * j]; s += (v[j].x * v[j].x + v[j].y * v[j].y) + (v[j].z * v[j].z + v[j].w * v[j].w); }
        const float rinv = rsqrtf(wave_sum(s) * (1.0f / DM) + EPS);
        GAS f32x4* o = (GAS f32x4*)(F.out + (r < MPROMPT ? O_YP + (size_t)r * DM : O_YS + (size_t)(r - MPROMPT) * DM)) + F.lane;
        const GAS f32x4* gp = (const GAS f32x4*)g + F.lane;
#pragma unroll
        for (int j = 0; j < 8; ++j) o[64 * j] = v[j] * rinv * gp[64 * j];
    }
}
typedef __bf16 bf16x2_t __attribute__((ext_vector_type(2)));
constexpr int HS_PITCH = 136;
template <bool FINAL>
__device__ __forceinline__ void s5_item(KArgs A, unsigned char* ws, float* out, int l, int item, LAS unsigned char* wl, int lane, unsigned* flags = nullptr) {
    const int c = item & 31, g = (item >> 5) & 31, b = item >> 10;
    const int lgp = (l * G_A + g) * P_A + lane;
    const f32x4 aq = *(const GAS f32x4*)((const float*)(ws + WS_SMALL + SM_S5A) + (size_t)lgp * 4);
    const float ar = aq.x, ai = aq.y;
    float br[16], bi[16];
    {   const GAS f32x4* bb = (const GAS f32x4*)((const float*)(ws + WS_SMALL + SM_S5BB) + (size_t)lgp * 32);
#pragma unroll
        for (int q = 0; q < 4; ++q) { const f32x4 v = bb[q]; br[4 * q] = v.x; br[4 * q + 1] = v.y; br[4 * q + 2] = v.z; br[4 * q + 3] = v.w;
                                      const f32x4 w = bb[4 + q]; bi[4 * q] = w.x; bi[4 * q + 1] = w.y; bi[4 * q + 2] = w.z; bi[4 * q + 3] = w.w; } }
    unsigned brp[8], bip[8];
#pragma unroll
    for (int k = 0; k < 8; ++k) { brp[k] = pk2(br[2 * k], br[2 * k + 1]); bip[k] = pk2(bi[2 * k], bi[2 * k + 1]); }
    const int row0 = b * SEQ + c * S5Q;
    const bf16* PROJ = (const bf16*)(ws + WS_BIG);
    const GAS v4u* up = (const GAS v4u*)(PROJ + (size_t)(row0 + lane) * N_INP + PC_UA + g * 16);
    const v4u u0 = up[0], u1 = up[1];
    LAS bf16* Us = (LAS bf16*)(wl + 8704);
    if (FINAL) { *(LAS v4u*)(Us + lane * 16) = u0; *(LAS v4u*)(Us + lane * 16 + 8) = u1; }
    float hr = 0.f, hi = 0.f;
    float* SLOC = (float*)(ws + WS_SMALL + SM_SLOC);
    if (FINAL && flags) {
        float lr = 0.f, li = 0.f;
#pragma unroll 2
        for (int t = 0; t < 64; ++t) {
            unsigned w[8];
            w[0] = __builtin_amdgcn_readlane(u0.x, t); w[1] = __builtin_amdgcn_readlane(u0.y, t); w[2] = __builtin_amdgcn_readlane(u0.z, t); w[3] = __builtin_amdgcn_readlane(u0.w, t);
            w[4] = __builtin_amdgcn_readlane(u1.x, t); w[5] = __builtin_amdgcn_readlane(u1.y, t); w[6] = __builtin_amdgcn_readlane(u1.z, t); w[7] = __builtin_amdgcn_readlane(u1.w, t);
            float sr0 = 0.f, si0 = 0.f, sr1 = 0.f, si1 = 0.f;
#pragma unroll
            for (int k = 0; k < 8; k += 2) {
                sr0 = __builtin_amdgcn_fdot2_f32_bf16(__builtin_bit_cast(bf16x2_t, brp[k]), __builtin_bit_cast(bf16x2_t, w[k]), sr0, false);
                si0 = __builtin_amdgcn_fdot2_f32_bf16(__builtin_bit_cast(bf16x2_t, bip[k]), __builtin_bit_cast(bf16x2_t, w[k]), si0, false);
                sr1 = __builtin_amdgcn_fdot2_f32_bf16(__builtin_bit_cast(bf16x2_t, brp[k + 1]), __builtin_bit_cast(bf16x2_t, w[k + 1]), sr1, false);
                si1 = __builtin_amdgcn_fdot2_f32_bf16(__builtin_bit_cast(bf16x2_t, bip[k + 1]), __builtin_bit_cast(bf16x2_t, w[k + 1]), si1, false); }
            const float nr = ar * lr - ai * li + (sr0 + sr1); li = ar * li + ai * lr + (si0 + si1); lr = nr;
        }
        float* sl = SLOC + (size_t)item * 128 + lane;
        __hip_atomic_store(sl, lr, __ATOMIC_RELAXED, __HIP_MEMORY_SCOPE_AGENT); __hip_atomic_store(sl + 64, li, __ATOMIC_RELAXED, __HIP_MEMORY_SCOPE_AGENT);
        asm volatile("s_waitcnt vmcnt(0)" ::: "memory");
        if (lane == 0) __hip_atomic_store(flags + item, 1u, __ATOMIC_RELAXED, __HIP_MEMORY_SCOPE_AGENT);
        {
            unsigned sp_ = 0;
            for (;;) { const unsigned f = lane < c ? __hip_atomic_load(flags + (item - c + lane), __ATOMIC_RELAXED, __HIP_MEMORY_SCOPE_AGENT) : 1u;
                if (__builtin_amdgcn_ballot_w64(f == 0u) == 0ull || ++sp_ > (1u << 20)) break; __builtin_amdgcn_s_sleep(1); }
            __builtin_amdgcn_fence(__ATOMIC_ACQUIRE, "agent"); }
        asm volatile("s_waitcnt vmcnt(0)" ::: "memory");
    }
    if (FINAL) {
        const float qr = aq.z, qi = aq.w;
        const float* sl = SLOC + (size_t)((b * G_A + g) * S5NC) * 128 + lane;
        float psr[31], psi[31];
#pragma unroll
        for (int k = 0; k < 31; ++k) { const int kk = k < c ? k : 0; psr[k] = sl[kk * 128]; psi[k] = sl[kk * 128 + 64]; }
#pragma unroll
        for (int k = 0; k < 31; ++k) if (k < c) { const float t = qr * hr - qi * hi + psr[k]; hi = qr * hi + qi * hr + psi[k]; hr = t; }
    }
    LAS bf16* Hs = (LAS bf16*)wl;
    bf16x8 cfr[4];
    if (FINAL) { const bf16* ct = (const bf16*)(ws + WS_SMALL + SM_S5CT) + (size_t)((l * G_A + g) * S5G + (lane & 15)) * 128 + 8 * (lane >> 4);
#pragma unroll
        for (int ks = 0; ks < 4; ++ks) cfr[ks] = *(const GAS bf16x8*)(ct + 32 * ks); }
#pragma unroll 1
    for (int half = 0; half < 2; ++half) {
#pragma unroll 2
        for (int tt = 0; tt < 32; ++tt) {
            const int t = half * 32 + tt;
            unsigned w[8];
            w[0] = __builtin_amdgcn_readlane(u0.x, t); w[1] = __builtin_amdgcn_readlane(u0.y, t); w[2] = __builtin_amdgcn_readlane(u0.z, t); w[3] = __builtin_amdgcn_readlane(u0.w, t);
            w[4] = __builtin_amdgcn_readlane(u1.x, t); w[5] = __builtin_amdgcn_readlane(u1.y, t); w[6] = __builtin_amdgcn_readlane(u1.z, t); w[7] = __builtin_amdgcn_readlane(u1.w, t);
            float sr0 = 0.f, si0 = 0.f, sr1 = 0.f, si1 = 0.f;
#pragma unroll
            for (int k = 0; k < 8; k += 2) {
                sr0 = __builtin_amdgcn_fdot2_f32_bf16(__builtin_bit_cast(bf16x2_t, brp[k]), __builtin_bit_cast(bf16x2_t, w[k]), sr0, false);
                si0 = __builtin_amdgcn_fdot2_f32_bf16(__builtin_bit_cast(bf16x2_t, bip[k]), __builtin_bit_cast(bf16x2_t, w[k]), si0, false);
                sr1 = __builtin_amdgcn_fdot2_f32_bf16(__builtin_bit_cast(bf16x2_t, brp[k + 1]), __builtin_bit_cast(bf16x2_t, w[k + 1]), sr1, false);
                si1 = __builtin_amdgcn_fdot2_f32_bf16(__builtin_bit_cast(bf16x2_t, bip[k + 1]), __builtin_bit_cast(bf16x2_t, w[k + 1]), si1, false); }
            const float sr = sr0 + sr1, si = si0 + si1;
            const float nr = ar * hr - ai * hi + sr; hi = ar * hi + ai * hr + si; hr = nr;
            if (FINAL) { Hs[tt * HS_PITCH + lane] = (bf16)f2bf(hr); Hs[tt * HS_PITCH + 64 + lane] = (bf16)f2bf(hi); }
        }
        if (FINAL) {
            bf16* YB = (bf16*)(ws + WS_YB);
            const float* dsk = A->in[I_S5D] + l * D_A + g * 16;
#pragma unroll
            for (int tile = 0; tile < 2; ++tile) {
                f32x4 acc = {0.f, 0.f, 0.f, 0.f};
#pragma unroll
                for (int ks = 0; ks < 4; ++ks) { const bf16x8 a = *(const LAS bf16x8*)(Hs + (tile * 16 + (lane & 15)) * HS_PITCH + 32 * ks + 8 * (lane >> 4));
                    acc = __builtin_amdgcn_mfma_f32_16x16x32_bf16(a, cfr[ks], acc, 0, 0, 0); }
                const int hh = lane & 15; const float dd = dsk[hh];
#pragma unroll
                for (int r = 0; r < 4; ++r) { const int row = row0 + half * 32 + tile * 16 + 4 * (lane >> 4) + r;
                    const float u = bf2f(Us[(row - row0) * 16 + hh]);
                    YB[(size_t)row * 512 + g * 16 + hh] = (bf16)f2bf(gelu_tanh(acc[r] + dd * u)); }
            }
        }
    }
    if (!FINAL) { float* sl = SLOC + (size_t)item * 128 + lane; sl[0] = hr; sl[64] = hi; }
    if (FINAL && c == S5NC - 1) { const size_t o = (size_t)((l * NB + b) * G_A + g) * P_A + lane; out[O_S5RP + o] = hr; out[O_S5IP + o] = hi; }
}

__device__ __forceinline__ void s5_sample_item(KArgs A, unsigned char* ws, float* out, int l, int item, int lane) {
    const int g = item & 31, s = item >> 5, row = MPROMPT + s;
    const int lgp = (l * G_A + g) * P_A + lane;
    const f32x4 aq = *(const GAS f32x4*)((const float*)(ws + WS_SMALL + SM_S5A) + (size_t)lgp * 4);
    const bf16* PROJ = (const bf16*)(ws + WS_BIG);
    const GAS v4u* up = (const GAS v4u*)(PROJ + (size_t)row * N_INP + PC_UA + g * 16);
    const v4u u0 = up[0], u1 = up[1];
    float u[16]; u[0] = bflo(u0.x); u[1] = bfhi(u0.x); u[2] = bflo(u0.y); u[3] = bfhi(u0.y); u[4] = bflo(u0.z); u[5] = bfhi(u0.z); u[6] = bflo(u0.w); u[7] = bfhi(u0.w);
    u[8] = bflo(u1.x); u[9] = bfhi(u1.x); u[10] = bflo(u1.y); u[11] = bfhi(u1.y); u[12] = bflo(u1.z); u[13] = bfhi(u1.z); u[14] = bflo(u1.w); u[15] = bfhi(u1.w);
    const GAS f32x4* bb = (const GAS f32x4*)((const float*)(ws + WS_SMALL + SM_S5BB) + (size_t)lgp * 32);
    float sr = 0.f, si = 0.f;
#pragma unroll
    for (int q = 0; q < 4; ++q) { const f32x4 v = bb[q], w = bb[4 + q];
        sr += v.x * u[4 * q] + v.y * u[4 * q + 1] + v.z * u[4 * q + 2] + v.w * u[4 * q + 3];
        si += w.x * u[4 * q] + w.y * u[4 * q + 1] + w.z * u[4 * q + 2] + w.w * u[4 * q + 3]; }
    const size_t so = (size_t)((l * NS + s) * G_A + g) * P_A + lane;
    const float h0r = A->in[I_S5RE][so], h0i = A->in[I_S5IM][so];
    const float hr = aq.x * h0r - aq.y * h0i + sr, hi = aq.x * h0i + aq.y * h0r + si;
    out[O_S5RS + so] = hr; out[O_S5IS + so] = hi;
    const float* cre = A->in[I_CRE] + (size_t)((l * G_A + g) * S5G) * P_A + lane; const float* cim = A->in[I_CIM] + (size_t)((l * G_A + g) * S5G) * P_A + lane;
    float y16[16];
#pragma unroll
    for (int hh = 0; hh < 16; ++hh) y16[hh] = cre[hh * P_A] * hr - cim[hh * P_A] * hi;
    const float mine = wave_sum16(y16, lane);
    if (lane < 16) { const float dd = A->in[I_S5D][l * D_A + g * 16 + lane]; float uu = 0.f;
#pragma unroll
        for (int hh = 0; hh < 16; ++hh) uu = (lane == hh) ? u[hh] : uu;
        ((bf16*)(ws + WS_YB))[(size_t)row * 512 + g * 16 + lane] = (bf16)f2bf(gelu_tanh(mine + dd * uu)); }
}
__device__ __forceinline__ void gmlp_sample_item(KArgs A, unsigned char* ws, float* out, int l, int s, int lane) {
    const int row = MPROMPT + s, ch0 = lane * 8;
    const bf16* PROJ = (const bf16*)(ws + WS_BIG);
    const v4u vv = *(const GAS v4u*)(PROJ + (size_t)row * N_INP + PC_VB + ch0), uu = *(const GAS v4u*)(PROJ + (size_t)row * N_INP + PC_UB + ch0);
    const float rinv = rsqrtf(((const float*)(ws + WS_SMALL + SM_VSQ))[l * MP + row] * (1.0f / D_B) + EPS);
    const int h = ch0 >> 6;
    const float w00 = A->in[I_WS][(size_t)(l * H_B + h) * 128 * 128], b0 = A->in[I_BS][(l * H_B + h) * 128];
    float v[8] = {bflo(vv.x), bfhi(vv.x), bflo(vv.y), bfhi(vv.y), bflo(vv.z), bfhi(vv.z), bflo(vv.w), bfhi(vv.w)};
    float u[8] = {bflo(uu.x), bfhi(uu.x), bflo(uu.y), bfhi(uu.y), bflo(uu.z), bfhi(uu.z), bflo(uu.w), bfhi(uu.w)};
    const float* gv = A->in[I_GV] + l * D_B + ch0;
    float o[8];
#pragma unroll
    for (int j = 0; j < 8; ++j) { const float vn = v[j] * rinv * gv[j]; out[O_GVS + (size_t)(l * NS + s) * D_B + ch0 + j] = vn; o[j] = u[j] * (w00 * vn + b0); }
    v4u w; w.x = pk2(o[0], o[1]); w.y = pk2(o[2], o[3]); w.z = pk2(o[4], o[5]); w.w = pk2(o[6], o[7]);
    *(GAS v4u*)((bf16*)(ws + WS_OB) + (size_t)row * 512 + ch0) = w;
}
__device__ __forceinline__ void ssd_sample_item(KArgs A, unsigned char* ws, float* out, int l, int item, int lane, bool acc) {
    const int h = item & 15, s = item >> 4, row = MPROMPT + s, g = h >> 3;
    const bf16* PROJ = (const bf16*)(ws + WS_BIG);
    const float* cw = A->in[I_CONVW] + (size_t)l * K_C * D_XBC; const float* cb = A->in[I_CONVB] + l * D_XBC;
    const float* cst = A->in[I_SSDCONV] + (size_t)(l * NS + s) * 3 * D_XBC;
    float* cso = out + O_CCS + (size_t)(l * NS + s) * 3 * D_XBC;
    float x;
    {   const int ch = h * 64 + lane; const float p0 = cst[ch], p1 = cst[D_XBC + ch], p2 = cst[2 * D_XBC + ch], p3 = bf2f(PROJ[(size_t)row * N_INP + PC_XBC + ch]);
        x = siluf_(cb[ch] + cw[ch] * p0 + cw[D_XBC + ch] * p1 + cw[2 * D_XBC + ch] * p2 + cw[3 * D_XBC + ch] * p3);
        cso[ch] = p1; cso[D_XBC + ch] = p2; cso[2 * D_XBC + ch] = p3; }
    const int n4 = (lane & 31) * 4; float Bv[4], Cv[4];
#pragma unroll
    for (int j = 0; j < 4; ++j) {
        {   const int ch = D_C + g * N_C + n4 + j; const float p0 = cst[ch], p1 = cst[D_XBC + ch], p2 = cst[2 * D_XBC + ch], p3 = bf2f(PROJ[(size_t)row * N_INP + PC_XBC + ch]);
            Bv[j] = siluf_(cb[ch] + cw[ch] * p0 + cw[D_XBC + ch] * p1 + cw[2 * D_XBC + ch] * p2 + cw[3 * D_XBC + ch] * p3);
            if ((h & 7) == 0 && lane < 32) { cso[ch] = p1; cso[D_XBC + ch] = p2; cso[2 * D_XBC + ch] = p3; } }
        {   const int ch = D_C + G_C * N_C + g * N_C + n4 + j; const float p0 = cst[ch], p1 = cst[D_XBC + ch], p2 = cst[2 * D_XBC + ch], p3 = bf2f(PROJ[(size_t)row * N_INP + PC_XBC + ch]);
            Cv[j] = siluf_(cb[ch] + cw[ch] * p0 + cw[D_XBC + ch] * p1 + cw[2 * D_XBC + ch] * p2 + cw[3 * D_XBC + ch] * p3);
            if ((h & 7) == 0 && lane < 32) { cso[ch] = p1; cso[D_XBC + ch] = p2; cso[2 * D_XBC + ch] = p3; } }
    }
    const float dt = softplusf_(((const float*)(ws + WS_SMALL + SM_DT))[(size_t)row * 16 + h] + A->in[I_DTBIAS][l * H_C + h]);
    const float dA = __expf(dt * -__expf(A->in[I_ALOG][l * H_C + h]));
    const size_t sbase = (size_t)((l * NS + s) * H_C + h) * HD_C * N_C;
    const GAS f32x4* st = (const GAS f32x4*)(A->in[I_SSM] + sbase) + lane;
    GAS f32x4* so = (GAS f32x4*)(out + O_SSMS + sbase) + lane;
    float part[32];
#pragma unroll
    for (int i = 0; i < 32; ++i) {
        const float xe = lane_bcast(x, 2 * i), xo = lane_bcast(x, 2 * i + 1); const float xv = lane < 32 ? xe : xo; const float xd = xv * dt;
        f32x4 v = __builtin_nontemporal_load(st + 64 * i);
        v.x = v.x * dA + xd * Bv[0]; v.y = v.y * dA + xd * Bv[1]; v.z = v.z * dA + xd * Bv[2]; v.w = v.w * dA + xd * Bv[3];
        __builtin_nontemporal_store(v, so + 64 * i);
        part[i] = v.x * Cv[0] + v.y * Cv[1] + v.z * Cv[2] + v.w * Cv[3];
    }
    const float ymine = half_sum32(part, lane);
    const float xmine = __builtin_bit_cast(float, __builtin_amdgcn_ds_bpermute((2 * (lane & 31) + (lane >> 5)) << 2, __builtin_bit_cast(int, x)));
    const int p = 2 * (lane & 31) + (lane >> 5), ch = h * 64 + p;
    const float y = ymine + A->in[I_SSDD][l * H_C + h] * xmine;
    const float z = bf2f(PROJ[(size_t)row * N_INP + PC_Z + ch]);
    const float yz = y * siluf_(z);
    const float sq = wave_sum(yz * yz);
    if (lane == 0 && acc) atomicAdd((float*)(ws + WS_SMALL + SM_CSQ) + l * MP + row, sq);
    ((bf16*)(ws + WS_OC))[(size_t)row * 1024 + ch] = (bf16)f2bf(yz * A->in[I_GNORM][l * D_C + ch]);
}
constexpr int TP = 136;
__device__ __forceinline__ void gmlp_item(KArgs A, unsigned char* ws, int l, int item, LAS unsigned char* lds, int tid, int wave, int lane) {
    const int h = item & 7, c = (item >> 3) & 15, b = item >> 7, row0 = b * SEQ + c * GMC;
    const bf16* PROJ = (const bf16*)(ws + WS_BIG);
    LAS bf16* vT = (LAS bf16*)lds;
    {   const int tok = tid >> 2, part = tid & 3, d0 = part * 16, row = row0 + tok;
        const float rinv = rsqrtf(((const float*)(ws + WS_SMALL + SM_VSQ))[l * MP + row] * (1.0f / D_B) + EPS);
        const GAS v4u* vp = (const GAS v4u*)(PROJ + (size_t)row * N_INP + PC_VB + h * 64 + d0);
        const v4u a = vp[0], b2 = vp[1];
        const float* gv = A->in[I_GV] + l * D_B + h * 64 + d0;
        const unsigned wv[8] = {a.x, a.y, a.z, a.w, b2.x, b2.y, b2.z, b2.w};
#pragma unroll
        for (int k = 0; k < 8; ++k) { vT[(d0 + 2 * k) * TP + tok] = (bf16)f2bf(bflo(wv[k]) * rinv * gv[2 * k]); vT[(d0 + 2 * k + 1) * TP + tok] = (bf16)f2bf(bfhi(wv[k]) * rinv * gv[2 * k + 1]); }
    }
    const bf16* WSb = (const bf16*)(ws + WS_SMALL + SM_WS) + (size_t)(l * H_B + h) * 128 * 128;
    bf16x8 afr[4];
#pragma unroll
    for (int ks = 0; ks < 4; ++ks) afr[ks] = *(const GAS bf16x8*)(WSb + (size_t)(16 * wave + (lane & 15)) * 128 + 32 * ks + 8 * (lane >> 4));
    __syncthreads();
    f32x4 acc[4];
#pragma unroll
    for (int t = 0; t < 4; ++t) acc[t] = (f32x4){0.f, 0.f, 0.f, 0.f};
    const int nks = (wave >> 1) + 1;
#pragma unroll
    for (int ks = 0; ks < 4; ++ks) if (ks < nks) {
#pragma unroll
        for (int t = 0; t < 4; ++t) { const bf16x8 bfr = *(const LAS bf16x8*)(vT + (16 * t + (lane & 15)) * TP + 32 * ks + 8 * (lane >> 4));
            acc[t] = __builtin_amdgcn_mfma_f32_16x16x32_bf16(afr[ks], bfr, acc[t], 0, 0, 0); }
    }
    bf16* OB = (bf16*)(ws + WS_OB);
#pragma unroll
    for (int r = 0; r < 4; ++r) { const int i = 16 * wave + 4 * (lane >> 4) + r, row = row0 + i; const float bs = A->in[I_BS][(l * H_B + h) * 128 + i];
#pragma unroll
        for (int t = 0; t < 4; ++t) { const int ch = h * 64 + 16 * t + (lane & 15);
            const float u = bf2f(PROJ[(size_t)row * N_INP + PC_UB + ch]);
            OB[(size_t)row * 512 + ch] = (bf16)f2bf(u * (acc[t][r] + bs)); } }
    __syncthreads();
}

template <int NCH, bool TRANS>
__device__ __forceinline__ void conv_tile(KArgs A, const bf16* PROJ, int l, int b, int c, int chb, LAS bf16* tile, const LAS float* scale, int tid) {
    constexpr int LPR = NCH / 8, SLOTS = NTHR / LPR, TPT = 128 / SLOTS;
    const int cl = tid % LPR, slot = tid / LPR, ch0 = chb + cl * 8, t0 = slot * TPT;
    const float* cw = A->in[I_CONVW] + (size_t)l * K_C * D_XBC + ch0; const float* cb = A->in[I_CONVB] + l * D_XBC + ch0;
    float w[4][8], bias[8];
#pragma unroll
    for (int k = 0; k < 4; ++k) { const f32x4 a = *(const GAS f32x4*)(cw + k * D_XBC), b2 = *(const GAS f32x4*)(cw + k * D_XBC + 4);
        w[k][0] = a.x; w[k][1] = a.y; w[k][2] = a.z; w[k][3] = a.w; w[k][4] = b2.x; w[k][5] = b2.y; w[k][6] = b2.z; w[k][7] = b2.w; }
    {   const f32x4 a = *(const GAS f32x4*)cb, b2 = *(const GAS f32x4*)(cb + 4); bias[0] = a.x; bias[1] = a.y; bias[2] = a.z; bias[3] = a.w; bias[4] = b2.x; bias[5] = b2.y; bias[6] = b2.z; bias[7] = b2.w; }
    const int trow0 = c * SSDQ + t0;
    v4u raw[TPT + 3];
#pragma unroll
    for (int i = 0; i < TPT + 3; ++i) { const int tt = trow0 - 3 + i;
        raw[i] = tt >= 0 ? *(const GAS v4u*)(PROJ + (size_t)(b * SEQ + tt) * N_INP + PC_XBC + ch0) : (v4u){0u, 0u, 0u, 0u}; }
    float o[TPT][8];
#pragma unroll
    for (int t = 0; t < TPT; ++t) {
#pragma unroll
        for (int e = 0; e < 8; ++e) o[t][e] = bias[e];
#pragma unroll
        for (int k = 0; k < 4; ++k) { const v4u r = raw[t + k]; const unsigned rw[4] = {r.x, r.y, r.z, r.w};
#pragma unroll
            for (int e2 = 0; e2 < 4; ++e2) { o[t][2 * e2] = fmaf(w[k][2 * e2], bflo(rw[e2]), o[t][2 * e2]); o[t][2 * e2 + 1] = fmaf(w[k][2 * e2 + 1], bfhi(rw[e2]), o[t][2 * e2 + 1]); } }
        const float sc = scale ? scale[t0 + t] : 1.0f;
#pragma unroll
        for (int e = 0; e < 8; ++e) o[t][e] = siluf_(o[t][e]) * sc;
    }
    if (!TRANS) {
#pragma unroll
        for (int t = 0; t < TPT; ++t) { v4u wv; wv.x = pk2(o[t][0], o[t][1]); wv.y = pk2(o[t][2], o[t][3]); wv.z = pk2(o[t][4], o[t][5]); wv.w = pk2(o[t][6], o[t][7]);
            *(LAS v4u*)(tile + (t0 + t) * TP + cl * 8) = wv; }
    } else {
#pragma unroll
        for (int e = 0; e < 8; ++e) {
            if (TPT == 4) { v2u wv; wv.x = pk2(o[0][e], o[1][e]); wv.y = pk2(o[TPT > 2 ? 2 : 0][e], o[TPT > 3 ? 3 : 0][e]); *(LAS v2u*)(tile + (cl * 8 + e) * TP + t0) = wv; }
            else { *(LAS unsigned*)(tile + (cl * 8 + e) * TP + t0) = pk2(o[0][e], o[1][e]); }
        }
    }
}

__device__ __forceinline__ void ssd_dt_scan(KArgs A, unsigned char* ws, int l, int b, int c, int h, LAS float* dtv, LAS float* cs, int tid, int lane) {
    if (tid < 64) {
        const float* DT = (const float*)(ws + WS_SMALL + SM_DT); const float bias = A->in[I_DTBIAS][l * H_C + h], a = -__expf(A->in[I_ALOG][l * H_C + h]);
        const int row = b * SEQ + c * SSDQ + 2 * lane;
        const float d0 = softplusf_(DT[(size_t)row * 16 + h] + bias), d1 = softplusf_(DT[(size_t)(row + 1) * 16 + h] + bias);
        const float v0 = d0 * a, v1 = d1 * a; float s = v0 + v1;
#pragma unroll
        for (int o = 1; o < 64; o <<= 1) { const float t = __builtin_bit_cast(float, __builtin_amdgcn_ds_bpermute((lane - o) << 2, __builtin_bit_cast(int, s))); if (lane >= o) s += t; }
        dtv[2 * lane] = d0; dtv[2 * lane + 1] = d1; cs[2 * lane] = s - v1; cs[2 * lane + 1] = s;
    }
    __syncthreads();
}

constexpr int SL_CN = 0, SL_BN = 34816, SL_MW = 69632, SL_XT = 104448, SL_HP = 121856, SL_DT = 139264, SL_CS = SL_DT + 512, SL_SC = SL_CS + 512, SL_END = SL_SC + 512;

__device__ __forceinline__ void ssd_item1(KArgs A, unsigned char* ws, int l, int item, LAS unsigned char* lds, int tid, int wave, int lane) {
    const int h = item & 15, c = (item >> 4) & 15, b = item >> 8, g = h >> 3;
    const bf16* PROJ = (const bf16*)(ws + WS_BIG);
    LAS float* dtv = (LAS float*)(lds + SL_DT); LAS float* cs = (LAS float*)(lds + SL_CS); LAS float* sc = (LAS float*)(lds + SL_SC);
    LAS bf16* Xt = (LAS bf16*)(lds + SL_XT); LAS bf16* Bt = (LAS bf16*)(lds + SL_BN);
    (void)sc;
    conv_tile<64, true>(A, PROJ, l, b, c, h * 64, Xt, nullptr, tid);
    conv_tile<128, true>(A, PROJ, l, b, c, D_C + g * N_C, Bt, nullptr, tid);
    ssd_dt_scan(A, ws, l, b, c, h, dtv, cs, tid, lane);
    f32x4 acc[4];
#pragma unroll
    for (int t = 0; t < 4; ++t) acc[t] = (f32x4){0.f, 0.f, 0.f, 0.f};
    const float cse = cs[127];
#pragma unroll
    for (int ks = 0; ks < 4; ++ks) { const int j0 = 32 * ks + 8 * (lane >> 4);
        const v4u braw = *(const LAS v4u*)(Bt + (16 * wave + (lane & 15)) * TP + j0);
        const f32x4 d0 = *(const LAS f32x4*)(dtv + j0), d1 = *(const LAS f32x4*)(dtv + j0 + 4), c0 = *(const LAS f32x4*)(cs + j0), c1 = *(const LAS f32x4*)(cs + j0 + 4);
        v4u bs;
        bs.x = pk2(bflo(braw.x) * d0.x * __expf(cse - c0.x), bfhi(braw.x) * d0.y * __expf(cse - c0.y)); bs.y = pk2(bflo(braw.y) * d0.z * __expf(cse - c0.z), bfhi(braw.y) * d0.w * __expf(cse - c0.w));
        bs.z = pk2(bflo(braw.z) * d1.x * __expf(cse - c1.x), bfhi(braw.z) * d1.y * __expf(cse - c1.y)); bs.w = pk2(bflo(braw.w) * d1.z * __expf(cse - c1.z), bfhi(braw.w) * d1.w * __expf(cse - c1.w));
        const bf16x8 bfr = __builtin_bit_cast(bf16x8, bs);
#pragma unroll
        for (int t = 0; t < 4; ++t) { const bf16x8 af = *(const LAS bf16x8*)(Xt + (16 * t + (lane & 15)) * TP + 32 * ks + 8 * (lane >> 4));
            acc[t] = __builtin_amdgcn_mfma_f32_16x16x32_bf16(af, bfr, acc[t], 0, 0, 0); } }
    float* ST = (float*)(ws + WS_STATES) + (size_t)item * HD_C * N_C;
#pragma unroll
    for (int t = 0; t < 4; ++t)
#pragma unroll
        for (int r = 0; r < 4; ++r) ST[(size_t)(16 * t + 4 * (lane >> 4) + r) * N_C + 16 * wave + (lane & 15)] = acc[t][r];
    if (tid == 0) ((float*)(ws + WS_SMALL + SM_SDEC))[item] = __expf(cs[127]);
    __syncthreads();
}

__device__ __forceinline__ void ssd_item2(KArgs A, unsigned char* ws, float* out, int l, int item, LAS unsigned char* lds, int tid, int wave, int lane, bool acc) {
    const int h = item & 15, c = (item >> 4) & 15, b = item >> 8, g = h >> 3, row0 = b * SEQ + c * SSDQ;
    const bf16* PROJ = (const bf16*)(ws + WS_BIG);
    LAS float* dtv = (LAS float*)(lds + SL_DT); LAS float* cs = (LAS float*)(lds + SL_CS);
    LAS bf16* Cn = (LAS bf16*)(lds + SL_CN); LAS bf16* Bn = (LAS bf16*)(lds + SL_BN); LAS bf16* Mw = (LAS bf16*)(lds + SL_MW);
    LAS bf16* Xt = (LAS bf16*)(lds + SL_XT); LAS bf16* Hp = (LAS bf16*)(lds + SL_HP);
    conv_tile<64, true>(A, PROJ, l, b, c, h * 64, Xt, nullptr, tid);
    conv_tile<128, false>(A, PROJ, l, b, c, D_C + g * N_C, Bn, nullptr, tid);
    conv_tile<128, false>(A, PROJ, l, b, c, D_C + G_C * N_C + g * N_C, Cn, nullptr, tid);
    {   const float* ST = (const float*)(ws + WS_STATES) + (size_t)((b * 16) * 16 + h) * HD_C * N_C + tid * 4;
        const float* SD = (const float*)(ws + WS_SMALL + SM_SDEC) + (b * 16) * 16 + h;
        f32x4 hv[4];
#pragma unroll
        for (int k = 0; k < 4; ++k) hv[k] = (f32x4){0.f, 0.f, 0.f, 0.f};
        int cc = 0;
        for (; cc + 4 <= c; cc += 4) { f32x4 sv[4][4]; float d[4];
#pragma unroll
            for (int q = 0; q < 4; ++q) { d[q] = SD[(cc + q) * 16];
#pragma unroll
                for (int k = 0; k < 4; ++k) sv[q][k] = *(const GAS f32x4*)(ST + (size_t)(cc + q) * 16 * 8192 + 2048 * k); }
#pragma unroll
            for (int q = 0; q < 4; ++q)
#pragma unroll
                for (int k = 0; k < 4; ++k) hv[k] = hv[k] * d[q] + sv[q][k]; }
        for (; cc < c; ++cc) { const float d = SD[cc * 16];
#pragma unroll
            for (int k = 0; k < 4; ++k) hv[k] = hv[k] * d + *(const GAS f32x4*)(ST + (size_t)cc * 16 * 8192 + 2048 * k); }
#pragma unroll
        for (int k = 0; k < 4; ++k) { v2u wv; wv.x = pk2(hv[k].x, hv[k].y); wv.y = pk2(hv[k].z, hv[k].w); *(LAS v2u*)(Hp + ((tid >> 5) + 16 * k) * TP + (tid & 31) * 4) = wv; }
        if (c == SSDNC - 1) { const float d = SD[c * 16]; float* o = out + O_SSMP + (size_t)((l * NB + b) * H_C + h) * HD_C * N_C + tid * 4;
#pragma unroll
            for (int k = 0; k < 4; ++k) *(GAS f32x4*)(o + 2048 * k) = hv[k] * d + *(const GAS f32x4*)(ST + (size_t)c * 16 * 8192 + 2048 * k); }
    }
    ssd_dt_scan(A, ws, l, b, c, h, dtv, cs, tid, lane);
    bf16x8 cf[4];
#pragma unroll
    for (int ks = 0; ks < 4; ++ks) cf[ks] = *(const LAS bf16x8*)(Cn + (16 * wave + (lane & 15)) * TP + 32 * ks + 8 * (lane >> 4));
    const int jtmax = wave | 1;
    for (int jt = 0; jt <= jtmax; ++jt) {
        f32x4 gacc = {0.f, 0.f, 0.f, 0.f};
        if (jt <= wave) {
#pragma unroll
            for (int ks = 0; ks < 4; ++ks) { const bf16x8 bfr = *(const LAS bf16x8*)(Bn + (16 * jt + (lane & 15)) * TP + 32 * ks + 8 * (lane >> 4));
                gacc = __builtin_amdgcn_mfma_f32_16x16x32_bf16(cf[ks], bfr, gacc, 0, 0, 0); }
        }
        const int j = 16 * jt + (lane & 15); const float csj = cs[j], dtj = dtv[j];
#pragma unroll
        for (int r = 0; r < 4; ++r) { const int i = 16 * wave + 4 * (lane >> 4) + r;
            const float m = (j <= i) ? gacc[r] * __expf(cs[i] - csj) * dtj : 0.f;
            Mw[i * TP + j] = (bf16)f2bf(m); }
    }
    f32x4 yd[4], yo[4];
#pragma unroll
    for (int t = 0; t < 4; ++t) { yd[t] = (f32x4){0.f, 0.f, 0.f, 0.f}; yo[t] = (f32x4){0.f, 0.f, 0.f, 0.f}; }
    const int nks = (wave >> 1) + 1;
    for (int ks = 0; ks < nks; ++ks) { const bf16x8 mf = *(const LAS bf16x8*)(Mw + (16 * wave + (lane & 15)) * TP + 32 * ks + 8 * (lane >> 4));
#pragma unroll
        for (int t = 0; t < 4; ++t) { const bf16x8 xf = *(const LAS bf16x8*)(Xt + (16 * t + (lane & 15)) * TP + 32 * ks + 8 * (lane >> 4));
            yd[t] = __builtin_amdgcn_mfma_f32_16x16x32_bf16(mf, xf, yd[t], 0, 0, 0); } }
#pragma unroll
    for (int ks = 0; ks < 4; ++ks)
#pragma unroll
        for (int t = 0; t < 4; ++t) { const bf16x8 hf = *(const LAS bf16x8*)(Hp + (16 * t + (lane & 15)) * TP + 32 * ks + 8 * (lane >> 4));
            yo[t] = __builtin_amdgcn_mfma_f32_16x16x32_bf16(cf[ks], hf, yo[t], 0, 0, 0); }
    const float dsk = A->in[I_SSDD][l * H_C + h];
    bf16* OC = (bf16*)(ws + WS_OC); float* csq = (float*)(ws + WS_SMALL + SM_CSQ) + l * MP;
#pragma unroll
    for (int r = 0; r < 4; ++r) { const int i = 16 * wave + 4 * (lane >> 4) + r, row = row0 + i; const float ecs = __expf(cs[i]); float sq = 0.f;
#pragma unroll
        for (int t = 0; t < 4; ++t) { const int p = 16 * t + (lane & 15), ch = h * 64 + p;
            const float x = bf2f(Xt[p * TP + i]);
            const float y = yd[t][r] + ecs * yo[t][r] + dsk * x;
            const float z = bf2f(PROJ[(size_t)row * N_INP + PC_Z + ch]);
            const float yz = y * siluf_(z); sq += yz * yz;
            OC[(size_t)row * 1024 + ch] = (bf16)f2bf(yz * A->in[I_GNORM][l * D_C + ch]); }
        sq += xor_lt32<1>(sq); sq += xor_lt32<2>(sq); sq += xor_lt32<4>(sq); sq += xor_lt32<8>(sq);
        if ((lane & 15) == 0 && acc) atomicAdd(csq + row, sq); }
    __syncthreads();
}

__device__ __forceinline__ void ssd_item_fused(KArgs A, unsigned char* ws, float* out, int l, int item, LAS unsigned char* lds, int tid, int wave, int lane, bool acc, unsigned* flags) {
    const int h = item & 15, c = (item >> 4) & 15, b = item >> 8, g = h >> 3, row0 = b * SEQ + c * SSDQ;
    const bf16* PROJ = (const bf16*)(ws + WS_BIG);
    LAS float* dtv = (LAS float*)(lds + SL_DT); LAS float* cs = (LAS float*)(lds + SL_CS);
    LAS bf16* Cn = (LAS bf16*)(lds + SL_CN); LAS bf16* Bn = (LAS bf16*)(lds + SL_BN); LAS bf16* Mw = (LAS bf16*)(lds + SL_MW);
    LAS bf16* Xt = (LAS bf16*)(lds + SL_XT); LAS bf16* Hp = (LAS bf16*)(lds + SL_HP);
    conv_tile<64, true>(A, PROJ, l, b, c, h * 64, Xt, nullptr, tid);
    conv_tile<128, false>(A, PROJ, l, b, c, D_C + g * N_C, Bn, nullptr, tid);
    conv_tile<128, true>(A, PROJ, l, b, c, D_C + g * N_C, Mw, nullptr, tid);
    conv_tile<128, false>(A, PROJ, l, b, c, D_C + G_C * N_C + g * N_C, Cn, nullptr, tid);
    bf16 zz[4][4];
#pragma unroll
    for (int r = 0; r < 4; ++r)
#pragma unroll
        for (int t = 0; t < 4; ++t) zz[r][t] = PROJ[(size_t)(row0 + 16 * wave + 4 * (lane >> 4) + r) * N_INP + PC_Z + h * 64 + 16 * t + (lane & 15)];
    ssd_dt_scan(A, ws, l, b, c, h, dtv, cs, tid, lane);
    {   f32x4 sacc[4];
#pragma unroll
        for (int t = 0; t < 4; ++t) sacc[t] = (f32x4){0.f, 0.f, 0.f, 0.f};
        const float cse = cs[127];
#pragma unroll
        for (int ks = 0; ks < 4; ++ks) { const int j0 = 32 * ks + 8 * (lane >> 4);
            const v4u braw = *(const LAS v4u*)(Mw + (16 * wave + (lane & 15)) * TP + j0);
            const f32x4 d0 = *(const LAS f32x4*)(dtv + j0), d1 = *(const LAS f32x4*)(dtv + j0 + 4), c0 = *(const LAS f32x4*)(cs + j0), c1 = *(const LAS f32x4*)(cs + j0 + 4);
            v4u bs;
            bs.x = pk2(bflo(braw.x) * d0.x * __expf(cse - c0.x), bfhi(braw.x) * d0.y * __expf(cse - c0.y)); bs.y = pk2(bflo(braw.y) * d0.z * __expf(cse - c0.z), bfhi(braw.y) * d0.w * __expf(cse - c0.w));
            bs.z = pk2(bflo(braw.z) * d1.x * __expf(cse - c1.x), bfhi(braw.z) * d1.y * __expf(cse - c1.y)); bs.w = pk2(bflo(braw.w) * d1.z * __expf(cse - c1.z), bfhi(braw.w) * d1.w * __expf(cse - c1.w));
            const bf16x8 bfr = __builtin_bit_cast(bf16x8, bs);
#pragma unroll
            for (int t = 0; t < 4; ++t) { const bf16x8 af = *(const LAS bf16x8*)(Xt + (16 * t + (lane & 15)) * TP + 32 * ks + 8 * (lane >> 4));
                sacc[t] = __builtin_amdgcn_mfma_f32_16x16x32_bf16(bfr, af, sacc[t], 0, 0, 0); } }
        {   const __amdgpu_buffer_rsrc_t srs = __builtin_amdgcn_make_buffer_rsrc((void*)((float*)(ws + WS_STATES) + (size_t)item * HD_C * N_C), (short)0, HD_C * N_C * 4, 0x00020000);
#pragma unroll
            for (int t = 0; t < 4; ++t) __builtin_amdgcn_raw_buffer_store_b128(__builtin_bit_cast(v4u, sacc[t]), srs, (unsigned)((16 * t + (lane & 15)) * N_C + 16 * wave + 4 * (lane >> 4)) * 4u, 0,   16); }
        if (tid == 0) __hip_atomic_store((float*)(ws + WS_SMALL + SM_SDEC) + item, __expf(cse), __ATOMIC_RELAXED, __HIP_MEMORY_SCOPE_AGENT);
        asm volatile("s_waitcnt vmcnt(0)" ::: "memory"); __syncthreads();
        if (tid == 0) __hip_atomic_store(flags + item, 1u, __ATOMIC_RELAXED, __HIP_MEMORY_SCOPE_AGENT);
    }
    bf16x8 cf[4];
#pragma unroll
    for (int ks = 0; ks < 4; ++ks) cf[ks] = *(const LAS bf16x8*)(Cn + (16 * wave + (lane & 15)) * TP + 32 * ks + 8 * (lane >> 4));
    const int jtmax = wave | 1;
    for (int jt = 0; jt <= jtmax; ++jt) {
        f32x4 gacc = {0.f, 0.f, 0.f, 0.f};
        if (jt <= wave) {
#pragma unroll
            for (int ks = 0; ks < 4; ++ks) { const bf16x8 bfr = *(const LAS bf16x8*)(Bn + (16 * jt + (lane & 15)) * TP + 32 * ks + 8 * (lane >> 4));
                gacc = __builtin_amdgcn_mfma_f32_16x16x32_bf16(cf[ks], bfr, gacc, 0, 0, 0); }
        }
        const int j = 16 * jt + (lane & 15); const float csj = cs[j], dtj = dtv[j];
#pragma unroll
        for (int r = 0; r < 4; ++r) { const int i = 16 * wave + 4 * (lane >> 4) + r;
            const float m = (j <= i) ? gacc[r] * __expf(cs[i] - csj) * dtj : 0.f;
            Mw[i * TP + j] = (bf16)f2bf(m); }
    }
    f32x4 yd[4], yo[4];
#pragma unroll
    for (int t = 0; t < 4; ++t) { yd[t] = (f32x4){0.f, 0.f, 0.f, 0.f}; yo[t] = (f32x4){0.f, 0.f, 0.f, 0.f}; }
    const int nks = (wave >> 1) + 1;
    for (int ks = 0; ks < nks; ++ks) { const bf16x8 mf = *(const LAS bf16x8*)(Mw + (16 * wave + (lane & 15)) * TP + 32 * ks + 8 * (lane >> 4));
#pragma unroll
        for (int t = 0; t < 4; ++t) { const bf16x8 xf = *(const LAS bf16x8*)(Xt + (16 * t + (lane & 15)) * TP + 32 * ks + 8 * (lane >> 4));
            yd[t] = __builtin_amdgcn_mfma_f32_16x16x32_bf16(mf, xf, yd[t], 0, 0, 0); } }
    if (tid < 64) {
        unsigned sp_ = 0;
        for (;;) { const unsigned f = lane < c ? __hip_atomic_load(flags + ((b * 16 + lane) * 16 + h), __ATOMIC_RELAXED, __HIP_MEMORY_SCOPE_AGENT) : 1u;
            if (__builtin_amdgcn_ballot_w64(f == 0u) == 0ull || ++sp_ > (1u << 20)) break; __builtin_amdgcn_s_sleep(1); }
        __builtin_amdgcn_fence(__ATOMIC_ACQUIRE, "agent"); asm volatile("s_waitcnt vmcnt(0)" ::: "memory"); }
    __syncthreads();
    {   const float* ST = (const float*)(ws + WS_STATES) + (size_t)((b * 16) * 16 + h) * HD_C * N_C + tid * 4;
        const float* SD = (const float*)(ws + WS_SMALL + SM_SDEC) + (b * 16) * 16 + h;
        f32x4 hv[4];
#pragma unroll
        for (int k = 0; k < 4; ++k) hv[k] = (f32x4){0.f, 0.f, 0.f, 0.f};
        for (int cc = 0; cc < c; cc += 4) { f32x4 sv[4][4]; float d[4];
#pragma unroll
            for (int q = 0; q < 4; ++q) { const int cq = cc + q < c ? cc + q : c - 1; d[q] = SD[cq * 16];
#pragma unroll
                for (int k = 0; k < 4; ++k) sv[q][k] = *(const GAS f32x4*)(ST + (size_t)cq * 16 * 8192 + 2048 * k); }
#pragma unroll
            for (int q = 0; q < 4; ++q) if (cc + q < c) {
#pragma unroll
                for (int k = 0; k < 4; ++k) hv[k] = hv[k] * d[q] + sv[q][k]; } }
#pragma unroll
        for (int k = 0; k < 4; ++k) { v2u wv; wv.x = pk2(hv[k].x, hv[k].y); wv.y = pk2(hv[k].z, hv[k].w); *(LAS v2u*)(Hp + ((tid >> 5) + 16 * k) * TP + (tid & 31) * 4) = wv; }
        if (c == SSDNC - 1) { const float d = SD[c * 16]; float* o = out + O_SSMP + (size_t)((l * NB + b) * H_C + h) * HD_C * N_C + tid * 4;
#pragma unroll
            for (int k = 0; k < 4; ++k) *(GAS f32x4*)(o + 2048 * k) = hv[k] * d + *(const GAS f32x4*)(ST + (size_t)c * 16 * 8192 + 2048 * k); }
    }
    __syncthreads();
#pragma unroll
    for (int ks = 0; ks < 4; ++ks)
#pragma unroll
        for (int t = 0; t < 4; ++t) { const bf16x8 hf = *(const LAS bf16x8*)(Hp + (16 * t + (lane & 15)) * TP + 32 * ks + 8 * (lane >> 4));
            yo[t] = __builtin_amdgcn_mfma_f32_16x16x32_bf16(cf[ks], hf, yo[t], 0, 0, 0); }
    const float dsk = A->in[I_SSDD][l * H_C + h];
    bf16* OC = (bf16*)(ws + WS_OC); float* csq = (float*)(ws + WS_SMALL + SM_CSQ) + l * MP;
#pragma unroll
    for (int r = 0; r < 4; ++r) { const int i = 16 * wave + 4 * (lane >> 4) + r, row = row0 + i; const float ecs = __expf(cs[i]); float sq = 0.f;
#pragma unroll
        for (int t = 0; t < 4; ++t) { const int p = 16 * t + (lane & 15), ch = h * 64 + p;
            const float x = bf2f(Xt[p * TP + i]);
            const float y = yd[t][r] + ecs * yo[t][r] + dsk * x;
            const float z = bf2f(zz[r][t]);
            const float yz = y * siluf_(z); sq += yz * yz;
            OC[(size_t)row * 1024 + ch] = (bf16)f2bf(yz * A->in[I_GNORM][l * D_C + ch]); }
        sq += xor_lt32<1>(sq); sq += xor_lt32<2>(sq); sq += xor_lt32<4>(sq); sq += xor_lt32<8>(sq);
        if ((lane & 15) == 0 && acc) atomicAdd(csq + row, sq); }
    __syncthreads();
}
__device__ __forceinline__ void phase_upfix(const Frame& F0, KArgs A, int l) {
    Frame F = launder(F0);
    const float* HALO = WSP(const float, WS_HALO); bf16* ACT = WSP(bf16, WS_T);
    const float* cw = A->in[I_FCONVW] + (size_t)l * K_F * D_UP; const float* cb = A->in[I_FCONVB] + (size_t)l * D_UP;
    const int gt = blockIdx.x * NTHR + F.tid, NT = GRID * NTHR;
    for (int i = gt; i < 32 * D_FF; i += NT) { const int ch = i % D_FF, pm = i / D_FF; if ((pm & 7) == 0) continue;
        const int ca_ = 256 * (ch / 128) + ch % 128, cb_ = ca_ + 128;
        const float* hp = HALO + ((size_t)(pm - 1) * 4 + 2) * D_UP; const float* hc = HALO + (size_t)pm * 4 * D_UP;
        const float am2 = hp[ca_], am1 = hp[D_UP + ca_], a0 = hc[ca_], a1 = hc[D_UP + ca_], bm2 = hp[cb_], bm1 = hp[D_UP + cb_], b0 = hc[cb_], b1 = hc[D_UP + cb_];
        const float wa0 = cw[ch], wa1 = cw[D_UP + ch], wa2 = cw[2 * D_UP + ch], wb0 = cw[D_FF + ch], wb1 = cw[D_UP + D_FF + ch], wb2 = cw[2 * D_UP + D_FF + ch], ba = cb[ch], bb = cb[D_FF + ch];
        const float r0 = siluf_(ba + wa0 * am2 + wa1 * am1 + wa2 * a0) * (bb + wb0 * bm2 + wb1 * bm1 + wb2 * b0);
        const float r1 = siluf_(ba + wa0 * am1 + wa1 * a0 + wa2 * a1) * (bb + wb0 * bm1 + wb1 * b0 + wb2 * b1);
        ACT[(size_t)(pm * 256) * D_FF + ch] = (bf16)f2bf(r0); ACT[(size_t)(pm * 256 + 1) * D_FF + ch] = (bf16)f2bf(r1); }
    for (int i = gt; i < NB * 2 * D_UP; i += NT) { const int oc = i % D_UP, k = (i / D_UP) & 1, b = i / (2 * D_UP);
        const int c = oc < D_FF ? 256 * (oc / 128) + oc % 128 : 256 * ((oc - D_FF) / 128) + 128 + (oc - D_FF) % 128;
        F.out[O_CFP + (size_t)l * NB * 2 * D_UP + i] = HALO[((size_t)(8 * b + 7) * 4 + 2 + k) * D_UP + c]; }
}
__device__ __forceinline__ void ssd_conv_p_out(const Frame& F0, int l) {
    Frame F = launder(F0);
    const bf16* PROJ = WSP(const bf16, WS_BIG);
    const int gt = blockIdx.x * NTHR + F.tid, NT = GRID * NTHR;
    for (int i = gt; i < NB * 3 * D_XBC; i += NT) { const int ch = i % D_XBC, k = (i / D_XBC) % 3, b = i / (3 * D_XBC);
        F.out[O_CCP + (size_t)l * NB * 3 * D_XBC + i] = bf2f(PROJ[(size_t)(b * SEQ + SEQ - 3 + k) * N_INP + PC_XBC + ch]); }
}

__device__ __forceinline__ void phase_mix1(const Frame& F0, KArgs A, int l, bool acc) {
    {   Frame F = launder(F0);
        for (int it = F.gw; it < NS * G_A; it += (GRID * NWAVES)) s5_sample_item(A, F.ws, F.out, l, it, F.lane); }
    {   Frame F = launder(F0);
        for (int it = F.gw; it < NS; it += (GRID * NWAVES)) gmlp_sample_item(A, F.ws, F.out, l, it, F.lane); }
    {   Frame F = launder(F0);
        for (int it = F.gw; it < NS * H_C; it += (GRID * NWAVES)) ssd_sample_item(A, F.ws, F.out, l, it, F.lane, acc); }
    ssd_conv_p_out(F0, l);
}
__device__ __forceinline__ void phase_mix2(const Frame& F0, KArgs A, int l, bool acc) {
#ifndef REP_SSD2
#define REP_SSD2 1
#endif
#ifndef REP_GMLP
#define REP_GMLP 1
#endif
#ifndef REP_S5F
#define REP_S5F 1
#endif
    _Pragma("unroll 1") for (int r2 = 0; r2 < REP_SSD2; ++r2) {   Frame F = launder(F0);
        for (int it = blockIdx.x; it < NB * SSDNC * H_C; it += GRID) ssd_item_fused(A, F.ws, F.out, l, it, F.lds, F.tid, F.wave, F.lane, acc && r2 == 0, (unsigned*)(F.ws + WS_CTL) + CW_SSDF + l * 1024); }
    _Pragma("unroll 1") for (int r2 = 0; r2 < REP_GMLP; ++r2) {   Frame F = launder(F0);
        for (int it = blockIdx.x; it < NB * (SEQ / GMC) * H_B; it += GRID) gmlp_item(A, F.ws, l, it, F.lds, F.tid, F.wave, F.lane); }
    _Pragma("unroll 1") for (int r2 = 0; r2 < REP_S5F; ++r2) {   Frame F = launder(F0);
        for (int it = F.gw; it < NB * G_A * S5NC; it += (GRID * NWAVES)) s5_item<true>(A, F.ws, F.out, l, it, F.lds + F.wave * 10752, F.lane, (unsigned*)(F.ws + WS_CTL) + CW_S5F + l * 4096); }
}

constexpr int LDS_BYTES = 147456, MISC_OFF = 147456 - 256;
#ifndef GEMM_SP2
#define GEMM_SP2 true
#endif
template <class Epi>
__device__ __forceinline__ void run_gemm(const Frame& F, const bf16* Am, const bf16* Bt, int M, int N, int K, const Epi& E) {
    pg8::Gemm g{Am, Bt, M, N, K}; pg8::StaticOrder S; S.init(M, N, GRID, (int)blockIdx.x, K);
    pg8::gemm_phase<Epi, pg8::StaticOrder, true, GEMM_SP2>(F.lds, g, S, E);
}
struct SplitSched {
    pg8::StaticOrder P; int c, np, nsl, ntsl, ns, cbase, cu0, sid0;
    __device__ void init(int N, int K, int c_, int nsl_, int cbase_, int cu0_, int sid0_) { sid0 = sid0_; P.init(MPROMPT, N, GRID, c_, K); c = c_; np = (MPROMPT / 256) * (N / 256) / GRID; nsl = nsl_; ntsl = (K / 64) / nsl_; ns = (N / 256) * nsl_; cbase = cbase_; cu0 = cu0_; }
    __device__ bool next(int i, pg8::Unit& u) const {
        const int s = c - cu0; const bool has = s >= 0 && s < ns;
        if (!has || i > 0) return (i - (has ? 1 : 0)) < np ? P.next(i - (has ? 1 : 0), u) : false;
        u.pm = MPROMPT / 256; u.pn = s / nsl; u.k0 = (s % nsl) * ntsl * 64; u.nt = ntsl; u.cidx = cbase + u.pn; u.sid = sid0 + s; return true;
    }
    __device__ __forceinline__ void a_ready(const pg8::Unit&) const {}
    __device__ __forceinline__ void done(const pg8::Unit&) const {}
};
template <class Epi, bool CHAIN_IN>
__device__ __forceinline__ void run_gemm_chain(const Frame& F, const bf16* Am, const bf16* Bt, int K, const Epi& E, pg8::f32x4 (&acc)[2][2][4][2]) {
    pg8::Gemm g{Am, Bt, MPROMPT, DM, K}; pg8::StaticOrder S; S.init(MPROMPT, DM, GRID, (int)blockIdx.x, K);
    pg8::gemm_phase<Epi, pg8::StaticOrder, true, GEMM_SP2, CHAIN_IN>(F.lds, g, S, E, acc);
}
template <class Epi>
__device__ __forceinline__ void run_gemm_split(const Frame& F, const bf16* Am, const bf16* Bt, int N, int K, const Epi& E, int nsl, int cbase, int cu0, int sid0 = 0, int fin0 = -1, int parts = 1) {
    pg8::Gemm g{Am, Bt, MP, N, K}; SplitSched S; S.init(N, K, (int)blockIdx.x, nsl, cbase, cu0, sid0);
    pg8::gemm_phase<Epi, SplitSched, true, GEMM_SP2>(F.lds, g, S, E);
    if constexpr (!Epi::AFTER_DRAIN) {
        const int f = epi::opaque_bx() - fin0;
        if (fin0 >= 0 && f >= 0 && f < (N / 256) * parts) { int t2 = threadIdx.x; asm volatile("" : "+v"(t2)); const int lane = t2 & 63, wid = __builtin_amdgcn_readfirstlane(t2 >> 6);
            const pg8::Unit u = epi::final_unit(f / parts, cbase); E.final(u, wid >> 2, wid & 3, lane & 15, lane >> 4, wid, lane, epi::part_mask(f % parts, parts)); }
    }
}

#ifndef REP_PROLOGUE
#define REP_PROLOGUE 1
#endif
#ifndef REP_MOD
#define REP_MOD 1
#endif
#ifndef REP_PREP
#define REP_PREP 1
#endif
#ifndef REP_WIN
#define REP_WIN 1
#endif
#ifndef REP_MIX1
#define REP_MIX1 1
#endif
#ifndef REP_MIX2
#define REP_MIX2 1
#endif
#ifndef REP_GLU
#define REP_GLU 1
#endif
#ifndef REP_MERGE
#define REP_MERGE 1
#endif
#ifndef REP_OUT
#define REP_OUT 1
#endif
#ifndef REP_UP
#define REP_UP 1
#endif
#ifndef REP_CONV
#define REP_CONV 1
#endif
#ifndef REP_DOWN
#define REP_DOWN 1
#endif
#ifndef REP_BAR
#define REP_BAR 1
#endif
#define REP(n) _Pragma("unroll 1") for (int rep_ = 0; rep_ < (n); ++rep_)
__device__ __forceinline__ void grid_bar(const Frame& F0) {
    unsigned long long w = (unsigned long long)F0.ws; unsigned x = xb_xcc_id(); asm volatile("" : "+s"(w), "+s"(x));
    XcdBarrier b; b.bar = (unsigned*)((unsigned char*)w + WS_CTL) + CW_BAR; b.x = x; b.st = (volatile LAS unsigned*)(F0.lds + MISC_OFF) + 8;
    xcd_barrier(b);
}
__global__ void __launch_bounds__(NTHR, 2) mega_fwd(Args Aarg) {
    const KArgs A0 = (KArgs)__builtin_amdgcn_kernarg_segment_ptr(); (void)Aarg;
#define A launder_args(A0)
    extern __shared__ __attribute__((aligned(16))) unsigned char lds_raw[];
    Frame F;
    F.lds = (LAS unsigned char*)lds_raw;
    F.tid = threadIdx.x; F.lane = F.tid & 63; F.wave = __builtin_amdgcn_readfirstlane(F.tid >> 6);
    F.gw = blockIdx.x * NWAVES + F.wave;
    F.out = A0->out; F.ws = A0->ws;
    volatile LAS unsigned* MISC = (volatile LAS unsigned*)(F.lds + MISC_OFF);
    if (F.tid < 64) MISC[F.tid] = 0u;
    __syncthreads();
    (void)xcd_barrier_post((unsigned*)(F.ws + WS_CTL) + CW_BAR, MISC + 8);
#define GRID_BAR() do { REP(REP_BAR) grid_bar(F); } while (0)
#ifndef TIME_PHASE
#define TIME_PHASE -1
#endif
    unsigned long long tacc_ = 0ull, tbeg_ = 0ull;
#define TBEG(k) do { if (TIME_PHASE == (k)) tbeg_ = __builtin_amdgcn_s_memrealtime(); } while (0)
#define TEND(k) do { if (TIME_PHASE == (k)) tacc_ += __builtin_amdgcn_s_memrealtime() - tbeg_; } while (0)

#ifndef REP_MODS
#define REP_MODS 1
#endif
    REP(REP_PROLOGUE) { _Pragma("unroll 1") for (int rm = 0; rm < REP_MODS; ++rm) phase_mod(F, A); phase_prologue(F, A);
    GRID_BAR(); }
#pragma unroll 1
    for (int l = 0; l < DEPTH; ++l) {
#define PH_FRAME() const Frame Fq = launder(F); unsigned char* const wsq = Fq.ws; unsigned char* const wl = wsq + WS_W + (size_t)l * WL_END; \
        const float* const modl = (const float*)(wsq + WS_MOD) + (size_t)l * N_MOD; pg8::f32x4* const slab = (pg8::f32x4*)(wsq + WS_SLAB); \
        unsigned* const cnt = (unsigned*)(wsq + WS_CTL) + CW_CNT; (void)wl; (void)modl; (void)slab; (void)cnt
#define WSQ(T, off) ((T*)(wsq + (off)))
        if (l == 0) REP(REP_PREP) { { PH_FRAME(); phase_prep<true>(Fq, A->in[I_XP], A->in[I_XS], A->in[I_GMIX] + l * DM, modl, 0, 1, A->in[I_WIN] + (size_t)l * DM * N_IN, WSQ(float, WS_SMALL + SM_DT)); }
        GRID_BAR(); }
        REP(REP_WIN) { { PH_FRAME(); epi::EpiIn E{WSQ(bf16, WS_BIG), rep_ == 0 ? WSQ(float, WS_SMALL + SM_VSQ) + l * MP : nullptr, epi::SplitCtl{slab, cnt, 4u, 160, (l * 4 + 0) * 64, 2}};
            run_gemm_split(Fq, WSQ(const bf16, WS_H), (const bf16*)(wl + WL_IN), N_INP, DM, E, 4, (l * 4 + 0) * 64, 0, 0, 160, 2); }
        GRID_BAR(); }
        REP(REP_MIX2) { phase_mix2(F, A, l, rep_ == 0); phase_mix1(F, A, l, rep_ == 0);
        GRID_BAR(); }
        REP(REP_GLU) { { PH_FRAME(); epi::EpiGlu E{WSQ(const bf16, WS_YB), WSQ(bf16, WS_OA)};
            run_gemm(Fq, WSQ(const bf16, WS_YB), (const bf16*)(wl + WL_GLU), MP, 512, 512, E); }
        GRID_BAR(); }
        TBEG(5);
        REP(REP_MERGE) {
            TBEG(10); TBEG(14);
            {   PH_FRAME(); bf16* BIG = WSQ(bf16, WS_BIG);
                epi::EpiMerge<0> Ea{BIG + PC_GA, WSQ(float, WS_T), WSQ(bf16, WS_MERGED), WSQ(const float, WS_SMALL + SM_CSQ) + l * MP, slab, BIG, cnt};
                run_gemm_split(Fq, WSQ(const bf16, WS_OA), (const bf16*)(wl + WL_PA), DM, 512, Ea, 2, (l * 4 + 1) * 64, 0, 0); }
            TEND(10); TBEG(11);
            {   PH_FRAME(); bf16* BIG = WSQ(bf16, WS_BIG);
                epi::EpiMerge<1> Eb{BIG + PC_GB, WSQ(float, WS_T), WSQ(bf16, WS_MERGED), WSQ(const float, WS_SMALL + SM_CSQ) + l * MP, slab, BIG, cnt};
                run_gemm_split(Fq, WSQ(const bf16, WS_OB), (const bf16*)(wl + WL_PB), DM, 512, Eb, 2, (l * 4 + 1) * 64, 16, 16); }
            TEND(11); TBEG(12);
            {   PH_FRAME(); bf16* BIG = WSQ(bf16, WS_BIG);
                epi::EpiMerge<2> Ec{BIG + PC_GC, WSQ(float, WS_T), WSQ(bf16, WS_MERGED), WSQ(const float, WS_SMALL + SM_CSQ) + l * MP, slab, BIG, cnt};
                run_gemm_split(Fq, WSQ(const bf16, WS_OC), (const bf16*)(wl + WL_PC), DM, 1024, Ec, 4, (l * 4 + 1) * 64, 32, 32, 64, 4); }
            TEND(12); TEND(14); TBEG(13);
        GRID_BAR(); TEND(13); }
        TEND(5);
        TBEG(6);
        REP(REP_OUT) { { PH_FRAME(); epi::EpiResidPrep<0> E{epi::EpiResid{WSQ(const bf16, WS_X0), WSQ(const bf16, WS_X0) + (size_t)MPROMPT * DM, WSQ(bf16, WS_X1), modl + 2 * DM, epi::SplitCtl{slab, cnt, 4u, 32, (l * 4 + 2) * 64, 4}},
                WSQ(bf16, WS_H), nullptr, nullptr, A->in[I_GFFN] + l * DM, modl, 3, 4, nullptr, WSQ(float, WS_SMALL + SM_DT), (unsigned*)(wsq + WS_CTL) + CW_PC + (l * 2 + 0) * 64};
            run_gemm_split(Fq, WSQ(const bf16, WS_MERGED), (const bf16*)(wl + WL_OUT), DM, DM, E, 4, (l * 4 + 2) * 64, 0); }
        GRID_BAR(); }
        TEND(6);
        REP(REP_UP) { { PH_FRAME(); epi::EpiUpConv E{WSQ(bf16, WS_T), WSQ(float, WS_HALO), A->in[I_FCONVW] + (size_t)l * K_F * D_UP, A->in[I_FCONVB] + (size_t)l * D_UP,
                A->in[I_FFNCONV] + (size_t)l * NS * 2 * D_UP, Fq.out + O_CFS + (size_t)l * NS * 2 * D_UP, (LAS float*)(Fq.lds + 131072), rep_ < REP_UP - 1 ? 1 : 0};
            run_gemm(Fq, WSQ(const bf16, WS_H), (const bf16*)(wl + WL_UP), MP, D_UP, DM, E); }
        GRID_BAR(); }
        REP(REP_CONV) { phase_upfix(F, A, l);
        GRID_BAR(); }
        REP(REP_DOWN) {
            if (l + 1 < DEPTH) { PH_FRAME(); const float* mod2 = (const float*)(wsq + WS_MOD) + (size_t)(l + 1) * N_MOD;
                epi::EpiResidPrep<1> E{epi::EpiResid{WSQ(const bf16, WS_X1), WSQ(const bf16, WS_X1) + (size_t)MPROMPT * DM, WSQ(bf16, WS_X0), modl + 5 * DM, epi::SplitCtl{slab, cnt, 4u, 32, (l * 4 + 3) * 64, 4}},
                    WSQ(bf16, WS_H), nullptr, nullptr, A->in[I_GMIX] + (l + 1) * DM, mod2, 0, 1, WSQ(const float, WS_SMALL + SM_WDT) + (size_t)(l + 1) * 16 * DM, WSQ(float, WS_SMALL + SM_DT), (unsigned*)(wsq + WS_CTL) + CW_PC + (l * 2 + 1) * 64};
                run_gemm_split(Fq, WSQ(const bf16, WS_T), (const bf16*)(wl + WL_DOWN), DM, D_FF, E, 4, (l * 4 + 3) * 64, 0);
            } else { PH_FRAME();
                epi::EpiResidPrep<2> E{epi::EpiResid{WSQ(const bf16, WS_X1), WSQ(const bf16, WS_X1) + (size_t)MPROMPT * DM, WSQ(bf16, WS_X0), modl + 5 * DM, epi::SplitCtl{slab, cnt, 4u, 32, (l * 4 + 3) * 64, 4}},
                    nullptr, Fq.out + O_YP, Fq.out + O_YS, A->in[I_GFINAL], modl, 0, 1, nullptr, WSQ(float, WS_SMALL + SM_DT), (unsigned*)(wsq + WS_CTL) + CW_PC + (l * 2 + 1) * 64};
                run_gemm_split(Fq, WSQ(const bf16, WS_T), (const bf16*)(wl + WL_DOWN), DM, D_FF, E, 4, (l * 4 + 3) * 64, 0); }
        if (l + 1 < DEPTH) GRID_BAR(); }
    }
    if (TIME_PHASE >= 0) {
        GRID_BAR();
#ifdef TIME_WG_LO
        if ((int)blockIdx.x < TIME_WG_LO || (int)blockIdx.x > TIME_WG_HI) tacc_ = 0ull; else tacc_ *= (unsigned long long)(256 / (TIME_WG_HI - TIME_WG_LO + 1));
#endif
        const float eps_ = sqrtf(5e-5f + 1e-6f * (float)tacc_ * 0.01f);
        for (int i = blockIdx.x * NTHR + F.tid; i < DEPTH * NS * D_B; i += GRID * NTHR) F.out[O_GVS + i] *= (1.0f + eps_);
    }
#undef A
}

extern "C" void kernel_launch(void* const* d_in, const int* in_sizes, int n_in, void* d_out, int out_size, void* d_ws, size_t ws_size, hipStream_t stream) {
    static int grid = 0;
    if (grid == 0) {
        if (n_in != N_INPUTS || (size_t)out_size != O_END || ws_size < WS_END) { fprintf(stderr, "kernel_launch: unexpected shapes (n_in %d, out %d, ws %zu, need %zu)\n", n_in, out_size, ws_size, (size_t)WS_END); grid = -1; return; }
        int dev = 0, cus = 0, per_cu = 0;
        if (hipGetDevice(&dev) != hipSuccess || hipDeviceGetAttribute(&cus, hipDeviceAttributeMultiprocessorCount, dev) != hipSuccess) { grid = -1; return; }
        if (hipFuncSetAttribute((const void*)mega_fwd, hipFuncAttributeMaxDynamicSharedMemorySize, LDS_BYTES) != hipSuccess) { fprintf(stderr, "kernel_launch: hipFuncSetAttribute failed\n"); grid = -1; return; }
        if (hipOccupancyMaxActiveBlocksPerMultiprocessor(&per_cu, (const void*)mega_fwd, NTHR, LDS_BYTES) != hipSuccess || per_cu < 1) { fprintf(stderr, "kernel_launch: occupancy query reports %d blocks per CU\n", per_cu); (void)hipGetLastError(); grid = -1; return; }
        if (cus * per_cu < GRID) { fprintf(stderr, "kernel_launch: %d CUs x %d blocks cannot hold the %d-workgroup grid\n", cus, per_cu, GRID); grid = -1; return; }
        grid = GRID;
    }
    if (grid < 0) return;
    if (hipMemsetAsync((char*)d_ws + WS_CTL, 0, CTL_ZERO_BYTES, stream) != hipSuccess) return;
    Args a{};
    for (int i = 0; i < N_INPUTS; ++i) a.in[i] = (const float*)d_in[i];
    a.out = (float*)d_out; a.ws = (unsigned char*)d_ws;
    void* params[] = {&a};
    hipError_t e = hipLaunchCooperativeKernel((const void*)mega_fwd, dim3(grid), dim3(NTHR), params, LDS_BYTES, stream);
    if (e != hipSuccess) fprintf(stderr, "kernel_launch: cooperative launch failed: %s (grid %d)\n", hipGetErrorString(e), grid);
}
```

```cpp
#include <hip/hip_runtime.h>
#include <cstdio>
#include <cstdint>
namespace pg8 {
#define PG8_LAS __attribute__((address_space(3)))
typedef unsigned short bf16_t;
typedef short bf16x8 __attribute__((ext_vector_type(8)));
typedef float f32x4 __attribute__((ext_vector_type(4)));
typedef unsigned u32x4 __attribute__((ext_vector_type(4)));
constexpr int BM = 256, BK = 64, HALF = 128, HTB = HALF * BK * 2  , STAGE_BYTES = 8 * HTB, NXCD = 8, WGM = 8;

__host__ __device__ __forceinline__ int lds_byte(int r, int c) { const int st = (r >> 4) * 2 + (c >> 5), rr = r & 15, cc = c & 31, ob = rr * 64 + cc * 2; return st * 1024 + (ob ^ (((ob >> 9) & 1) << 5)); }
__host__ __device__ __forceinline__ void stage_rc(int b, int& R, int& C) { const int st = b / 1024, sb = b % 1024, swz = sb ^ (((sb >> 9) & 1) << 5); R = (st >> 1) * 16 + swz / 64; C = (st & 1) * 32 + (swz % 64) / 2; }
__host__ __device__ __forceinline__ int perm32(int rho) { const int n = rho >> 4, i = rho & 15; return 8 * (i >> 2) + 4 * n + (i & 3); }

struct Unit { int pm, pn, k0, nt, cidx, sid; };
struct Gemm { const bf16_t* A; const bf16_t* Bt; int M, N, K; };

struct StaticOrder {
    int nM, nN, nwg, G, c, ntk;
    __host__ __device__ void init(int M, int N, int G_, int c_, int K_) { nM = M / BM; nN = N / BM; nwg = nM * nN; G = G_; c = c_; ntk = K_ / BK; }
    __host__ __device__ bool next(int i, Unit& u) const {
        const long L = (long)i * G + c; if (L >= nwg) return false;
        int wgid = (int)L; { const int q = nwg / NXCD, r = nwg % NXCD, xcd = wgid % NXCD, off = wgid / NXCD; wgid = (xcd < r ? xcd * (q + 1) : r * (q + 1) + (xcd - r) * q) + off; }
        const int nig = WGM * nN, gid = wgid / nig, fm = gid * WGM, gsz = (nM - fm) < WGM ? (nM - fm) : WGM;
        u.pm = fm + ((wgid % nig) % gsz); u.pn = (wgid % nig) / gsz; u.k0 = 0; u.nt = ntk; u.cidx = -1; u.sid = 0; return true;
    }
    __device__ __forceinline__ void a_ready(const Unit&) const {}
    __device__ __forceinline__ void done(const Unit&) const {}
};
__device__ __forceinline__ unsigned cvt_pk_bf16(float lo, float hi) { unsigned r; asm volatile("s_nop 0\n\tv_cvt_pk_bf16_f32 %0, %1, %2" : "=v"(r) : "v"(lo), "v"(hi)); return r; }
template <class Epi, class Sched, bool ALIGN_EPI = false, bool SP2 = false, bool CHAIN_IN = false>
__device__ __forceinline__ void gemm_phase(PG8_LAS unsigned char* lds, const Gemm g, const Sched& S, const Epi& E, f32x4 (&acc)[2][2][4][2]) {
    int tid_ = threadIdx.x; asm volatile("" : "+v"(tid_));
    const int tid = tid_, wid = __builtin_amdgcn_readfirstlane(tid >> 6), lane = tid & 63, wr = wid >> 2, wc = wid & 3, fr = lane & 15, fq = lane >> 4;
    const int K = g.K;
    unsigned voffA[2], voffB[2];
#pragma unroll
    for (int i = 0; i < 2; ++i) { int R, C; stage_rc(tid * 16 + i * 8192, R, C); const int Rb = Epi::PERM ? ((R & ~31) + perm32(R & 31)) : R;
        voffA[i] = (unsigned)(R * K + C) * 2u; voffB[i] = (unsigned)(Rb * K + C) * 2u; }
    const size_t kstep = (size_t)(BK * 2);
    const size_t hstep = (size_t)HALF * K * 2;
    const size_t tstep = 2 * hstep;
    const unsigned ldsw = (unsigned)wid * 1024u;
    const int aoff = lds_byte(wr * 64 + fr, fq * 8), boff = lds_byte(wc * 32 + fr, fq * 8);
#define PG8_SA(b, h) (((b) * 2 + (h)) * HTB)
#define PG8_SB(b, h) ((4 + (b) * 2 + (h)) * HTB)
#define PG8_STAGE(bufoff, gbase, voff) do { _Pragma("unroll") for (int _i = 0; _i < 2; ++_i) \
        __builtin_amdgcn_global_load_lds((const unsigned*)((const char*)(gbase) + (voff)[_i]), (PG8_LAS unsigned*)(lds + (bufoff) + ldsw + _i * 8192), 16, 0, 0); } while (0)
#define PG8_LDA(dst, b, h) do { _Pragma("unroll") for (int m = 0; m < 4; ++m) _Pragma("unroll") for (int k = 0; k < 2; ++k) dst[m][k] = *(const PG8_LAS bf16x8*)(lds + PG8_SA(b, h) + aoff + m * 2048 + k * 1024); } while (0)
#define PG8_LDB(dst, b, h) do { _Pragma("unroll") for (int n = 0; n < 2; ++n) _Pragma("unroll") for (int k = 0; k < 2; ++k) dst[n][k] = *(const PG8_LAS bf16x8*)(lds + PG8_SB(b, h) + boff + n * 2048 + k * 1024); } while (0)
#define PG8_MMA(ai, bj, At, Bt) do { __builtin_amdgcn_s_setprio(1); _Pragma("unroll") for (int m = 0; m < 4; ++m) _Pragma("unroll") for (int n = 0; n < 2; ++n) _Pragma("unroll") for (int k = 0; k < 2; ++k) \
        acc[ai][bj][m][n] = __builtin_amdgcn_mfma_f32_16x16x32_bf16(Bt[n][k], At[m][k], acc[ai][bj][m][n], 0, 0, 0); __builtin_amdgcn_s_setprio(0); } while (0)
#define PG8_WAIT_V(n) asm volatile("s_waitcnt vmcnt(" #n ")" ::: "memory")
#define PG8_WAIT_L(n) asm volatile("s_waitcnt lgkmcnt(" #n ")" ::: "memory")
#define PG8_BAR __builtin_amdgcn_s_barrier()
#define PG8_SCHED __builtin_amdgcn_sched_barrier(0)
    Unit cur, nxt; int ui = 0;
    if (!S.next(0, cur)) return;
    if constexpr (!CHAIN_IN) {
#pragma unroll
    for (int a = 0; a < 2; ++a)
#pragma unroll
        for (int b = 0; b < 2; ++b)
#pragma unroll
            for (int m = 0; m < 4; ++m)
#pragma unroll
                for (int n = 0; n < 2; ++n) acc[a][b][m][n] = (f32x4){0.f, 0.f, 0.f, 0.f};
    }
    bf16x8 At[4][2], B0[2][2], B1[2][2];
    const char* cA = (const char*)g.A + (size_t)cur.pm * tstep + (size_t)cur.k0 * 2; const char* cB = (const char*)g.Bt + (size_t)cur.pn * tstep + (size_t)cur.k0 * 2;
    S.a_ready(cur);
    if constexpr (SP2) {
        PG8_STAGE(PG8_SB(0, 0), cB, voffB); PG8_STAGE(PG8_SB(0, 1), cB + hstep, voffB); PG8_STAGE(PG8_SA(0, 0), cA, voffA); PG8_STAGE(PG8_SA(0, 1), cA + hstep, voffA);
        if (wr == 1) PG8_BAR;
        PG8_WAIT_V(2); PG8_BAR;
        PG8_STAGE(PG8_SB(1, 0), cB + kstep, voffB); PG8_STAGE(PG8_SA(1, 0), cA + kstep, voffA); PG8_STAGE(PG8_SB(1, 1), cB + hstep + kstep, voffB);
        PG8_WAIT_V(6); PG8_BAR;
    } else {
        PG8_STAGE(PG8_SB(0, 0), cB, voffB); PG8_STAGE(PG8_SA(0, 0), cA, voffA); PG8_STAGE(PG8_SB(0, 1), cB + hstep, voffB); PG8_STAGE(PG8_SA(0, 1), cA + hstep, voffA);
        if (wr == 1) PG8_BAR;
        PG8_WAIT_V(4); PG8_BAR;
        PG8_STAGE(PG8_SB(1, 0), cB + kstep, voffB); PG8_STAGE(PG8_SA(1, 0), cA + kstep, voffA); PG8_STAGE(PG8_SB(1, 1), cB + hstep + kstep, voffB);
        PG8_WAIT_V(6); PG8_BAR;
    }
    for (;;) {
        const bool has_next = S.next(ui + 1, nxt);
        const char* nA = has_next ? (const char*)g.A + (size_t)nxt.pm * tstep + (size_t)nxt.k0 * 2 : cA; const char* nB = has_next ? (const char*)g.Bt + (size_t)nxt.pn * tstep + (size_t)nxt.k0 * 2 : cB;
        const int nt = cur.nt; const bool halfu = cur.cidx >= 0;
        for (int t = 0; t < nt; t += 2) {
            const bool last = (t == nt - 2);
            const char* a1 = cA + (size_t)(t + 1) * kstep;
            const char* a2 = last ? nA : cA + (size_t)(t + 2) * kstep; const char* b2 = last ? nB : cB + (size_t)(t + 2) * kstep;
            const char* a3 = a2 + kstep; const char* b3 = b2 + kstep;
            if (last && has_next) S.a_ready(nxt);
            if constexpr (SP2) {
            PG8_LDB(B0, 0, 0); PG8_LDB(B1, 0, 1); PG8_SCHED; PG8_LDA(At, 0, 0); PG8_STAGE(PG8_SA(1, 1), a1 + hstep, voffA);
            PG8_WAIT_V(8); PG8_WAIT_L(0); PG8_BAR; PG8_MMA(0, 0, At, B0); PG8_MMA(0, 1, At, B1); PG8_BAR; PG8_SCHED;
            PG8_LDA(At, 0, 1); PG8_STAGE(PG8_SB(0, 0), b2, voffB); PG8_STAGE(PG8_SB(0, 1), b2 + hstep, voffB); PG8_STAGE(PG8_SA(0, 0), a2, voffA);
            PG8_WAIT_V(8); PG8_WAIT_L(0); PG8_BAR; if (!halfu) { PG8_MMA(1, 0, At, B0); PG8_MMA(1, 1, At, B1); } PG8_BAR; PG8_SCHED;
            PG8_LDB(B0, 1, 0); PG8_LDB(B1, 1, 1); PG8_SCHED; PG8_LDA(At, 1, 0); PG8_STAGE(PG8_SA(0, 1), a2 + hstep, voffA);
            PG8_WAIT_V(8); PG8_WAIT_L(0); PG8_BAR; PG8_MMA(0, 0, At, B0); PG8_MMA(0, 1, At, B1); PG8_BAR; PG8_SCHED;
            PG8_LDA(At, 1, 1); PG8_STAGE(PG8_SB(1, 0), b3, voffB); PG8_STAGE(PG8_SB(1, 1), b3 + hstep, voffB); PG8_STAGE(PG8_SA(1, 0), a3, voffA);
            PG8_WAIT_V(8); PG8_WAIT_L(0); PG8_BAR; if (!halfu) { PG8_MMA(1, 0, At, B0); PG8_MMA(1, 1, At, B1); } PG8_BAR; PG8_SCHED;
            } else {
            PG8_LDB(B0, 0, 0); PG8_SCHED; PG8_LDA(At, 0, 0); PG8_STAGE(PG8_SA(1, 1), a1 + hstep, voffA);
            PG8_WAIT_L(8); PG8_BAR; PG8_WAIT_L(0); PG8_MMA(0, 0, At, B0); PG8_BAR; PG8_SCHED;
            PG8_LDB(B1, 0, 1); PG8_STAGE(PG8_SB(0, 0), b2, voffB);
            PG8_BAR; PG8_WAIT_L(0); PG8_MMA(0, 1, At, B1); PG8_BAR;
            PG8_LDA(At, 0, 1); PG8_STAGE(PG8_SA(0, 0), a2, voffA);
            PG8_BAR; PG8_WAIT_L(0); PG8_MMA(1, 0, At, B0); PG8_BAR; PG8_SCHED;
            PG8_STAGE(PG8_SB(0, 1), b2 + hstep, voffB);
            PG8_WAIT_V(6); PG8_BAR; PG8_MMA(1, 1, At, B1); PG8_BAR;
            PG8_LDB(B0, 1, 0); PG8_SCHED; PG8_LDA(At, 1, 0); PG8_STAGE(PG8_SA(0, 1), a2 + hstep, voffA);
            PG8_WAIT_L(8); PG8_BAR; PG8_WAIT_L(0); PG8_MMA(0, 0, At, B0); PG8_BAR; PG8_SCHED;
            PG8_LDB(B1, 1, 1); PG8_STAGE(PG8_SB(1, 0), b3, voffB);
            PG8_BAR; PG8_WAIT_L(0); PG8_MMA(0, 1, At, B1); PG8_BAR;
            PG8_LDA(At, 1, 1); PG8_STAGE(PG8_SA(1, 0), a3, voffA);
            PG8_BAR; PG8_WAIT_L(0); PG8_MMA(1, 0, At, B0); PG8_BAR; PG8_SCHED;
            PG8_STAGE(PG8_SB(1, 1), b3 + hstep, voffB);
            PG8_WAIT_V(6); PG8_BAR; PG8_MMA(1, 1, At, B1); PG8_BAR;
            }
        }
        if constexpr (ALIGN_EPI) { if (wr == 0) PG8_BAR; }
        if constexpr (!Epi::AFTER_DRAIN) { int t2 = threadIdx.x; asm volatile("" : "+v"(t2)); const int lane2 = t2 & 63, fr2 = lane2 & 15, fq2 = lane2 >> 4;
            if (cur.cidx < 0) E(acc, cur, wr, wc, fr2, fq2); else E.partial(acc, cur, wr, wc, fr2, fq2, wid, lane2); S.done(cur); }
        else { if (cur.cidx >= 0) { int t2 = threadIdx.x; asm volatile("" : "+v"(t2)); const int lane2 = t2 & 63; E.partial(acc, cur, wr, wc, lane2 & 15, lane2 >> 4, wid, lane2); } }
        if (!has_next) break;
#pragma unroll
        for (int a = 0; a < 2; ++a)
#pragma unroll
            for (int b = 0; b < 2; ++b)
#pragma unroll
                for (int m = 0; m < 4; ++m)
#pragma unroll
                    for (int n = 0; n < 2; ++n) acc[a][b][m][n] = (f32x4){0.f, 0.f, 0.f, 0.f};
        cur = nxt; cA = nA; cB = nB; ++ui;
        if constexpr (ALIGN_EPI) { if (wr == 1) PG8_BAR; }
    }
    PG8_WAIT_V(0);
    if constexpr (!ALIGN_EPI) { if (wr == 0) PG8_BAR; }
    PG8_BAR;
    if constexpr (Epi::AFTER_DRAIN) { E.fused(acc, cur, wr, wc, fr, fq, lds, wid, lane); S.done(cur); }
#undef PG8_SA
#undef PG8_SB
#undef PG8_STAGE
#undef PG8_LDA
#undef PG8_LDB
#undef PG8_MMA
#undef PG8_WAIT_V
#undef PG8_WAIT_L
#undef PG8_BAR
#undef PG8_SCHED
}
template <class Epi, class Sched, bool ALIGN_EPI = false, bool SP2 = false>
__device__ __forceinline__ void gemm_phase(PG8_LAS unsigned char* lds, const Gemm g, const Sched& S, const Epi& E) {
    f32x4 acc[2][2][4][2];
    gemm_phase<Epi, Sched, ALIGN_EPI, SP2, false>(lds, g, S, E, acc);
}

}
constexpr int DM = 2048, NB = 4, SEQ = 2048, NS = 128, DEPTH = 2;
constexpr int MPROMPT = NB * SEQ;
constexpr int MREAL = MPROMPT + NS;
constexpr int MP = 8448;
constexpr int D_A = 512, G_A = 32, P_A = 64, S5G = 16;
constexpr int D_B = 512, H_B = 8, GMC = 128;
constexpr int D_C = 1024, HD_C = 64, H_C = 16, N_C = 128, G_C = 2, K_C = 4, D_XBC = 1536;
constexpr int D_FF = 5632, K_F = 3, D_UP = 2 * D_FF;
constexpr int N_IN = 10256, N_INP = 10240;
constexpr int N_MOD = 6 * DM, MOD_PITCH = 2 * N_MOD;
constexpr float EPS = 1e-6f;
constexpr int PC_UA = 0, PC_UB = 512, PC_VB = 1024, PC_Z = 1536, PC_XBC = 2560, PC_GA = 4096, PC_GB = 6144, PC_GC = 8192;
constexpr int S5Q = 64, S5NC = SEQ / S5Q;
constexpr int SSDQ = 128, SSDNC = SEQ / SSDQ;

enum { I_XP = 0, I_XS, I_CP, I_CS, I_S5RE, I_S5IM, I_SSM, I_SSDCONV, I_FFNCONV, I_WMOD, I_BMOD, I_GMIX, I_WIN, I_LAMRE, I_LAMIM, I_LOGDT,
       I_BRE, I_BIM, I_CRE, I_CIM, I_S5D, I_WGLU, I_GV, I_WS, I_BS, I_CONVW, I_CONVB, I_DTBIAS, I_ALOG, I_SSDD, I_GNORM, I_WPA, I_WPB, I_WPC,
       I_WOUT, I_GFFN, I_WUP, I_FCONVW, I_FCONVB, I_WDOWN, I_GFINAL, N_INPUTS };
constexpr size_t O_YP = 0, O_YS = 16777216, O_S5RP = 17039360, O_S5IP = 17055744, O_SSMP = 17072128, O_CCP = 18120704, O_CFP = 18157568,
                 O_S5RS = 18337792, O_S5IS = 18862080, O_SSMS = 19386368, O_CCS = 52940800, O_CFS = 54120448, O_GVS = 59887616, O_END = 60018688;

constexpr size_t MiB = 1u << 20;
constexpr size_t WS_CTL = 0, CTL_ZERO_BYTES = 1 * MiB;
constexpr size_t SZ_WIN = (size_t)N_INP * DM * 2, SZ_WGLU = 512 * 512 * 2, SZ_WPA = (size_t)DM * 512 * 2, SZ_WPC = (size_t)DM * 1024 * 2,
                 SZ_WOUT = (size_t)DM * DM * 2, SZ_WUP = (size_t)D_UP * DM * 2, SZ_WDOWN = (size_t)DM * D_FF * 2;
constexpr size_t WL_IN = 0, WL_GLU = WL_IN + SZ_WIN, WL_PA = WL_GLU + SZ_WGLU, WL_PB = WL_PA + SZ_WPA, WL_PC = WL_PB + SZ_WPA, WL_OUT = WL_PC + SZ_WPC,
                 WL_UP = WL_OUT + SZ_WOUT, WL_DOWN = WL_UP + SZ_WUP, WL_END = WL_DOWN + SZ_WDOWN;
constexpr size_t WS_W = 2 * MiB;
constexpr size_t WS_SMALL = WS_W + 2 * WL_END;
constexpr size_t SM_WS = 0;
constexpr size_t SM_S5BB = SM_WS + 2 * 8 * 128 * 128 * 2;
constexpr size_t SM_S5CT = SM_S5BB + 2 * 32 * 64 * 32 * 4;
constexpr size_t SM_S5A = SM_S5CT + 2 * 32 * 16 * 128 * 2;
constexpr size_t SM_DT = SM_S5A + 2 * 32 * 64 * 4 * 4;
constexpr size_t SM_VSQ = SM_DT + (size_t)MP * 16 * 4;
constexpr size_t SM_CSQ = SM_VSQ + (size_t)2 * MP * 4;
constexpr size_t SM_SLOC = SM_CSQ + (size_t)2 * MP * 4;
constexpr size_t SM_SDEC = SM_SLOC + (size_t)NB * G_A * S5NC * 128 * 4;
constexpr size_t SM_CSILU = SM_SDEC + 4096;
constexpr size_t SM_WDT = SM_CSILU + 256 * 2048 * 2;
constexpr size_t SM_END = SM_WDT + (size_t)2 * 16 * DM * 4;
constexpr size_t WS_MOD = (WS_SMALL + SM_END + 4095) / 4096 * 4096;
constexpr size_t WS_X0 = WS_MOD + (size_t)2 * 256 * N_MOD * 4;
constexpr size_t WS_X1 = WS_X0 + (size_t)MP * DM * 4;
constexpr size_t WS_H = WS_X1 + (size_t)MP * DM * 4;
constexpr size_t WS_BIG = WS_H + (size_t)MP * DM * 2;
constexpr size_t WS_T = WS_BIG + (size_t)MP * D_UP * 2;
constexpr size_t WS_MERGED = WS_T + (size_t)MP * DM * 4;
constexpr size_t WS_OA = WS_MERGED + (size_t)MP * DM * 2;
constexpr size_t WS_OB = WS_OA + (size_t)MP * 512 * 2;
constexpr size_t WS_YB = WS_OB + (size_t)MP * 512 * 2;
constexpr size_t WS_OC = WS_YB + (size_t)MP * 512 * 2;
constexpr size_t WS_STATES = WS_OC + (size_t)MP * 1024 * 2;
constexpr size_t WS_SLAB = WS_STATES + (size_t)NB * SSDNC * H_C * HD_C * N_C * 4;
constexpr size_t WS_HALO = WS_SLAB + (size_t)176 * 131072;
constexpr size_t WS_END = WS_HALO + (size_t)33 * 4 * D_UP * 4;
static_assert((size_t)MP * D_FF * 2 <= (size_t)MP * DM * 6, "ACT overlays T+MERGED");
constexpr int CW_PC = 12288;
constexpr int CW_S5F = 20480;
constexpr int CW_SSDF = 16384;
constexpr int CW_BAR = 4096, CW_CNT = 8192;
struct Args { const float* in[N_INPUTS]; float* out; unsigned char* ws; };
typedef const __attribute__((address_space(4))) Args* KArgs;
__device__ __forceinline__ KArgs launder_args(KArgs a) { unsigned long long t = (unsigned long long)a; asm volatile("" : "+s"(t)); return (KArgs)t; }
#define GAS __attribute__((address_space(1)))
#define LAS __attribute__((address_space(3)))
typedef unsigned short bf16;
typedef unsigned v4u __attribute__((ext_vector_type(4)));
typedef unsigned v2u __attribute__((ext_vector_type(2)));
typedef float f32x4 __attribute__((ext_vector_type(4)));
typedef float f32x2 __attribute__((ext_vector_type(2)));
typedef short bf16x8 __attribute__((ext_vector_type(8)));
typedef short bf16x4 __attribute__((ext_vector_type(4)));
typedef GAS unsigned gu32;
#define RLX_AGENT __ATOMIC_RELAXED, __HIP_MEMORY_SCOPE_AGENT
#define LDS_WAIT() asm volatile("s_waitcnt lgkmcnt(0)" ::: "memory")
#define VM_WAIT() asm volatile("s_waitcnt vmcnt(0)" ::: "memory")
constexpr int NWAVES = 8, NTHR = 512, GRID = 256;
__device__ __forceinline__ unsigned f2bf(float f) { unsigned u = __builtin_bit_cast(unsigned, f); return (u + 0x7fffu + ((u >> 16) & 1u)) >> 16; }
__device__ __forceinline__ unsigned pk2(float lo, float hi) { return f2bf(lo) | (f2bf(hi) << 16); }
__device__ __forceinline__ float bf2f(unsigned short b) { return __builtin_bit_cast(float, (unsigned)b << 16); }
__device__ __forceinline__ float bflo(unsigned w) { return __builtin_bit_cast(float, w << 16); }
__device__ __forceinline__ float bfhi(unsigned w) { return __builtin_bit_cast(float, w & 0xffff0000u); }
__device__ __forceinline__ float sigmoidf_(float x) { return __builtin_amdgcn_rcpf(1.0f + __expf(-x)); }
__device__ __forceinline__ float siluf_(float x) { return x * __builtin_amdgcn_rcpf(1.0f + __expf(-x)); }
__device__ __forceinline__ float gelu_tanh(float x) {
    const float u = 0.7978845608028654f * (x + 0.044715f * x * x * x);
    const float e = __expf(2.0f * u);
    const float t = 1.0f - 2.0f * __builtin_amdgcn_rcpf(e + 1.0f);
    return 0.5f * x * (1.0f + t);
}
__device__ __forceinline__ float softplusf_(float x) { return fmaxf(x, 0.f) + __logf(1.0f + __expf(-fabsf(x))); }
template <int M> __device__ __forceinline__ float xor_lt32(float x) {
    return __builtin_bit_cast(float, __builtin_amdgcn_ds_swizzle(__builtin_bit_cast(int, x), (M << 10) | 0x1f)); }
__device__ __forceinline__ float add_xor32(float x) {
    const unsigned b = __builtin_bit_cast(unsigned, x); const auto r = __builtin_amdgcn_permlane32_swap(b, b, false, false);
    return __builtin_bit_cast(float, (unsigned)r[0]) + __builtin_bit_cast(float, (unsigned)r[1]); }
__device__ __forceinline__ float wave_sum(float v) {
    v += xor_lt32<1>(v); v += xor_lt32<2>(v); v += xor_lt32<4>(v); v += xor_lt32<8>(v); v += xor_lt32<16>(v);
    return add_xor32(v);
}
__device__ __forceinline__ float wave_sum16(const float (&a)[16], int lane) {
    float b[8], c[4], d[2];
    const bool o1 = lane & 1, o2 = lane & 2, o4 = lane & 4, o8 = lane & 8;
#pragma unroll
    for (int i = 0; i < 8; ++i) { const float keep = o1 ? a[2 * i + 1] : a[2 * i], send = o1 ? a[2 * i] : a[2 * i + 1]; b[i] = keep + xor_lt32<1>(send); }
#pragma unroll
    for (int i = 0; i < 4; ++i) { const float keep = o2 ? b[2 * i + 1] : b[2 * i], send = o2 ? b[2 * i] : b[2 * i + 1]; c[i] = keep + xor_lt32<2>(send); }
#pragma unroll
    for (int i = 0; i < 2; ++i) { const float keep = o4 ? c[2 * i + 1] : c[2 * i], send = o4 ? c[2 * i] : c[2 * i + 1]; d[i] = keep + xor_lt32<4>(send); }
    const float keep = o8 ? d[1] : d[0], send = o8 ? d[0] : d[1];
    float e = keep + xor_lt32<8>(send);
    e += xor_lt32<16>(e);
    return add_xor32(e);
}
__device__ __forceinline__ float half_sum32(const float (&a)[32], int lane) {
    float b[16], c[8], d[4], e[2];
    const bool o1 = lane & 1, o2 = lane & 2, o4 = lane & 4, o8 = lane & 8, o16 = lane & 16;
#pragma unroll
    for (int i = 0; i < 16; ++i) { const float keep = o1 ? a[2 * i + 1] : a[2 * i], send = o1 ? a[2 * i] : a[2 * i + 1]; b[i] = keep + xor_lt32<1>(send); }
#pragma unroll
    for (int i = 0; i < 8; ++i) { const float keep = o2 ? b[2 * i + 1] : b[2 * i], send = o2 ? b[2 * i] : b[2 * i + 1]; c[i] = keep + xor_lt32<2>(send); }
#pragma unroll
    for (int i = 0; i < 4; ++i) { const float keep = o4 ? c[2 * i + 1] : c[2 * i], send = o4 ? c[2 * i] : c[2 * i + 1]; d[i] = keep + xor_lt32<4>(send); }
#pragma unroll
    for (int i = 0; i < 2; ++i) { const float keep = o8 ? d[2 * i + 1] : d[2 * i], send = o8 ? d[2 * i] : d[2 * i + 1]; e[i] = keep + xor_lt32<8>(send); }
    const float keep = o16 ? e[1] : e[0], send = o16 ? e[0] : e[1];
    return keep + xor_lt32<16>(send);
}
__device__ __forceinline__ float lane_bcast(float x, int src) {
    return __builtin_bit_cast(float, __builtin_amdgcn_readlane(__builtin_bit_cast(int, x), src)); }
__device__ __forceinline__ int mod_row(int r) { return r < MPROMPT ? (r >> 11) : (r < MREAL ? 4 + (r - MPROMPT) : 4 + NS - 1); }

template <int MODE>
__device__ __forceinline__ void prep_row(const bf16* xrow, const float* g, const float* mr, int sh_idx, int sc_idx, bf16* hrow, float* yrow, float* dtrow, const LAS float* wT, int lane) {
    const GAS v2u* xr = (const GAS v2u*)xrow + lane;
    f32x4 v[8]; float s = 0.f;
#pragma unroll
    for (int j = 0; j < 8; ++j) { const v2u w = xr[64 * j]; v[j] = (f32x4){bflo(w.x), bfhi(w.x), bflo(w.y), bfhi(w.y)}; s += (v[j].x * v[j].x + v[j].y * v[j].y) + (v[j].z * v[j].z + v[j].w * v[j].w); }
    const float rinv = rsqrtf(wave_sum(s) * (1.0f / DM) + EPS);
    const GAS f32x4* gp = (const GAS f32x4*)g + lane;
    if (MODE == 2) { GAS f32x4* o = (GAS f32x4*)yrow + lane;
#pragma unroll
        for (int j = 0; j < 8; ++j) o[64 * j] = v[j] * rinv * gp[64 * j];
        return; }
    const GAS f32x4* shp = (const GAS f32x4*)(mr + sh_idx * DM) + lane; const GAS f32x4* scp = (const GAS f32x4*)(mr + sc_idx * DM) + lane;
    GAS v2u* o = (GAS v2u*)hrow + lane;
#pragma unroll
    for (int j = 0; j < 8; ++j) { const f32x4 gg = gp[64 * j], sh = shp[64 * j], sc = scp[64 * j];
        v[j] = v[j] * rinv * gg * (sc + 1.0f) + sh;
        v2u w; w.x = pk2(v[j].x, v[j].y); w.y = pk2(v[j].z, v[j].w); o[64 * j] = w; }
    if (MODE == 1) {
        float a16[16];
#pragma unroll
        for (int hh = 0; hh < 16; ++hh) { float a = 0.f;
#pragma unroll
            for (int j = 0; j < 8; ++j) { const f32x4 w = *(const LAS f32x4*)(wT + hh * DM + 4 * lane + 256 * j); a += (v[j].x * w.x + v[j].y * w.y) + (v[j].z * w.z + v[j].w * w.w); }
            a16[hh] = a; }
        const float mine = wave_sum16(a16, lane);
        if (lane < 16) dtrow[lane] = mine;
    }
}

template <int MODE>
__device__ __forceinline__ void prep_rows4(const bf16* x0, const float* g, const float* mr, int sh_idx, int sc_idx, bf16* h0, float* y0, float* dt0, const LAS float* wT, int lane) {
    f32x4 v[4][8];
#pragma unroll
    for (int q = 0; q < 4; ++q) { const GAS v2u* xr = (const GAS v2u*)(x0 + (size_t)q * DM) + lane;
#pragma unroll
        for (int j = 0; j < 8; ++j) { const v2u w = xr[64 * j]; v[q][j] = (f32x4){bflo(w.x), bfhi(w.x), bflo(w.y), bfhi(w.y)}; } }
    f32x4 gm[8], sh[8];
    {   const GAS f32x4* gp = (const GAS f32x4*)g + lane;
        if (MODE == 2) {
#pragma unroll
            for (int j = 0; j < 8; ++j) gm[j] = gp[64 * j];
        } else { const GAS f32x4* shp = (const GAS f32x4*)(mr + sh_idx * DM) + lane; const GAS f32x4* scp = (const GAS f32x4*)(mr + sc_idx * DM) + lane;
#pragma unroll
            for (int j = 0; j < 8; ++j) { gm[j] = gp[64 * j] * (scp[64 * j] + 1.0f); sh[j] = shp[64 * j]; } } }
#pragma unroll
    for (int q = 0; q < 4; ++q) { float s = 0.f;
#pragma unroll
        for (int j = 0; j < 8; ++j) s += (v[q][j].x * v[q][j].x + v[q][j].y * v[q][j].y) + (v[q][j].z * v[q][j].z + v[q][j].w * v[q][j].w);
        const float rinv = rsqrtf(wave_sum(s) * (1.0f / DM) + EPS);
        if (MODE == 2) { GAS f32x4* o = (GAS f32x4*)(y0 + (size_t)q * DM) + lane;
#pragma unroll
            for (int j = 0; j < 8; ++j) o[64 * j] = v[q][j] * rinv * gm[j];
        } else { GAS v2u* o = (GAS v2u*)(h0 + (size_t)q * DM) + lane;
#pragma unroll
            for (int j = 0; j < 8; ++j) { v[q][j] = v[q][j] * rinv * gm[j] + sh[j]; v2u w; w.x = pk2(v[q][j].x, v[q][j].y); w.y = pk2(v[q][j].z, v[q][j].w); o[64 * j] = w; }
        }
    }
    if (MODE == 1) {
#pragma unroll
        for (int pr = 0; pr < 2; ++pr) { float a16[2][16];
#pragma unroll
            for (int hh = 0; hh < 16; ++hh) { float a0 = 0.f, a1 = 0.f;
#pragma unroll
                for (int j = 0; j < 8; ++j) { const f32x4 w = *(const LAS f32x4*)(wT + hh * DM + 4 * lane + 256 * j);
                    a0 += (v[2 * pr][j].x * w.x + v[2 * pr][j].y * w.y) + (v[2 * pr][j].z * w.z + v[2 * pr][j].w * w.w);
                    a1 += (v[2 * pr + 1][j].x * w.x + v[2 * pr + 1][j].y * w.y) + (v[2 * pr + 1][j].z * w.z + v[2 * pr + 1][j].w * w.w); }
                a16[0][hh] = a0; a16[1][hh] = a1; }
            { const float m0 = wave_sum16(a16[0], lane), m1 = wave_sum16(a16[1], lane); if (lane < 16) { dt0[(2 * pr) * 16 + lane] = m0; dt0[(2 * pr + 1) * 16 + lane] = m1; } } }
    }
}
#define XB_TMO      128
#define XB_XCNT(j)  (256  + 64 * (j))
#define XB_XSUB(j)  (1280 + 64 * (j))
#define XB_XGEN(j)  (2304 + 64 * (j))
#define XB_TOP      3328
#define XB_TOPGEN   3392
#define XCD_BAR_WORDS 3456
#define XB_SPIN_CAP (1u << 18)

__device__ __forceinline__ unsigned xb_ld(unsigned* p)              { return __hip_atomic_load(p, __ATOMIC_RELAXED, __HIP_MEMORY_SCOPE_AGENT); }
__device__ __forceinline__ unsigned xb_add(unsigned* p, unsigned v) { return __hip_atomic_fetch_add(p, v, __ATOMIC_RELAXED, __HIP_MEMORY_SCOPE_AGENT); }
__device__ __forceinline__ unsigned xb_xcc_id() { return (unsigned)__builtin_amdgcn_s_getreg((3 << 11) | 20) & 0xFu; }
#define XB_SPIN(cond, bar) do { unsigned _sp = 0; while (cond) { __builtin_amdgcn_s_sleep(1); \
    if ((++_sp & 255u) == 0u) { if (xb_ld(&(bar)[XB_TMO])) break; if (_sp > XB_SPIN_CAP) { atomicAdd(&(bar)[XB_TMO], 1u); break; } } } } while (0)

struct XcdBarrier {
    unsigned* bar; unsigned x;
    volatile LAS unsigned* st;
};

__device__ __forceinline__ XcdBarrier xcd_barrier_post(unsigned* bar, volatile LAS unsigned* st) {
    XcdBarrier b; b.bar = bar; b.x = xb_xcc_id(); b.st = st;
    if (threadIdx.x == 0) (void)xb_add(&bar[XB_XCNT(b.x)], 1u);
    return b;
}
__device__ __forceinline__ void xcd_barrier_complete(unsigned* bar, unsigned x, unsigned& nloc, unsigned& nx) {
    const unsigned G = gridDim.x * gridDim.y * gridDim.z;
    unsigned sum, cnt, mine, sp = 0u;
    for (;;) {
        sum = 0u; cnt = 0u; mine = 0u;
#pragma unroll
        for (unsigned j = 0; j < 16; ++j) { const unsigned c = xb_ld(&bar[XB_XCNT(j)]); sum += c; cnt += (c > 0u) ? 1u : 0u; mine = (j == x) ? c : mine; }
        if (sum == G) break;
        __builtin_amdgcn_s_sleep(1);
        if ((++sp & 255u) == 0u) { if (xb_ld(&bar[XB_TMO])) break; if (sp > XB_SPIN_CAP) { atomicAdd(&bar[XB_TMO], 1u); break; } }
    }
    nloc = mine > 0u ? mine : 1u; nx = cnt > 0u ? cnt : 1u;
}

__device__ __forceinline__ void xcd_barrier(const XcdBarrier& b) {
    asm volatile("s_waitcnt vmcnt(0)" ::: "memory");
    __syncthreads();
    if (threadIdx.x == 0) {
        unsigned* bar = b.bar;
        __builtin_amdgcn_s_waitcnt(0);
        unsigned nloc = b.st[0], nx = b.st[1];
        if (nloc == 0u) { xcd_barrier_complete(bar, b.x, nloc, nx); b.st[0] = nloc; b.st[1] = nx; }
        const unsigned old = xb_add(&bar[XB_XSUB(b.x)], 1u);
        const unsigned gen = old / nloc;
        if (old + 1u == (gen + 1u) * nloc) {
            __builtin_amdgcn_fence(__ATOMIC_RELEASE, "agent");
            asm volatile("s_waitcnt vmcnt(0)" ::: "memory");
            const unsigned og = xb_add(&bar[XB_TOP], 1u);
            const unsigned tg = og / nx;
            if (og + 1u == (tg + 1u) * nx) xb_add(&bar[XB_TOPGEN], 1u);
            else XB_SPIN(xb_ld(&bar[XB_TOPGEN]) == tg, bar);
            __builtin_amdgcn_fence(__ATOMIC_ACQUIRE, "agent");
            xb_add(&bar[XB_XGEN(b.x)], 1u);
            asm volatile("s_waitcnt vmcnt(0)" ::: "memory");
        } else {
            XB_SPIN(xb_ld(&bar[XB_XGEN(b.x)]) == gen, bar);
            __builtin_amdgcn_fence(__ATOMIC_ACQUIRE, "agent");
            asm volatile("s_waitcnt vmcnt(0)" ::: "memory");
        }
    }
    __syncthreads();
}

namespace epi {
using pg8::Unit; using pg8::f32x4; using pg8::u32x4; using pg8::cvt_pk_bf16;
typedef unsigned u32x2 __attribute__((ext_vector_type(2)));
constexpr int BM = 256, HALF = 128;

constexpr int SLAB_F4 = 8 * 16 * 64;
constexpr int SLAB_BYTES_ALL = 176 * 131072;
typedef unsigned v4u_ __attribute__((ext_vector_type(4)));
template <bool PERM> __device__ __forceinline__ int split_col(const Unit& u, int wc, int fq, int bj, int n) { return u.pn * BM + bj * HALF + wc * 32 + (PERM ? 8 * fq + 4 * n : 16 * n + 4 * fq); }
__device__ __forceinline__ __amdgpu_buffer_rsrc_t slab_rsrc(const f32x4* SLAB) { return __builtin_amdgcn_make_buffer_rsrc((void*)SLAB, (short)0, SLAB_BYTES_ALL, 0x00020000); }
__device__ __forceinline__ void split_store(const f32x4 (&acc)[2][2][4][2], f32x4* SLAB, int sid, int wid, int lane) {
    asm volatile("" : "+v"(lane));
    const __amdgpu_buffer_rsrc_t rs = slab_rsrc(SLAB);
    const unsigned vo = (unsigned)(wid * 16 * 64 + lane) * 16u, so = (unsigned)sid * (unsigned)(SLAB_F4 * 16);
#pragma unroll
    for (int m = 0; m < 4; ++m)
#pragma unroll
        for (int bj = 0; bj < 2; ++bj)
#pragma unroll
            for (int n = 0; n < 2; ++n) __builtin_amdgcn_raw_buffer_store_b128(__builtin_bit_cast(v4u_, acc[0][bj][m][n]), rs, vo + (unsigned)(((m * 2 + bj) * 2 + n) * 64 * 16), so,   16);
}
__device__ __forceinline__ bool split_arrive(unsigned* cnt, unsigned target, int lane) {
    asm volatile("s_waitcnt vmcnt(0)" ::: "memory");
    unsigned old = 0u;
    if (lane == 0) old = __hip_atomic_fetch_add(cnt, 1u, __ATOMIC_RELAXED, __HIP_MEMORY_SCOPE_AGENT);
    old = __builtin_amdgcn_readlane(old, 0);
    asm volatile("" ::: "memory");
    if (old != target - 1u) return false;
    __builtin_amdgcn_fence(__ATOMIC_ACQUIRE, "agent"); asm volatile("s_waitcnt vmcnt(0)" ::: "memory");
    return true;
}
__device__ __forceinline__ f32x4 slab_ld(const __amdgpu_buffer_rsrc_t rs, unsigned vo, unsigned so) { return __builtin_bit_cast(f32x4, __builtin_amdgcn_raw_buffer_load_b128(rs, vo, so,   16)); }
__device__ __forceinline__ f32x4 split_sum1(const f32x4* SLAB, int sid0, int ns, int wid, int lane, int reg) {
    const __amdgpu_buffer_rsrc_t rs = slab_rsrc(SLAB);
    const unsigned vo = (unsigned)((wid * 16 + reg) * 64 + lane) * 16u;
    f32x4 s = slab_ld(rs, vo, (unsigned)sid0 * (unsigned)(SLAB_F4 * 16));
    for (int j = 1; j < ns; ++j) s = s + slab_ld(rs, vo, (unsigned)(sid0 + j) * (unsigned)(SLAB_F4 * 16));
    return s;
}
__device__ __forceinline__ void split_sum(f32x4 (&acc)[2][2][4][2], const f32x4* SLAB, int sid0, int ns, int wid, int lane, int mmask = 15) {
    asm volatile("" : "+v"(lane));
    const __amdgpu_buffer_rsrc_t rs = slab_rsrc(SLAB);
    const unsigned vo = (unsigned)(wid * 16 * 64 + lane) * 16u;
#pragma unroll
    for (int m = 0; m < 4; ++m) { if (!((mmask >> m) & 1)) continue;
#pragma unroll
        for (int bj = 0; bj < 2; ++bj) {
            const unsigned vr = vo + (unsigned)((m * 2 + bj) * 2) * 1024u;
            unsigned so = (unsigned)sid0 * (unsigned)(SLAB_F4 * 16);
            f32x4 s0 = {0.f, 0.f, 0.f, 0.f}, s1 = s0;
            int j = 0;
#pragma unroll 1
            for (; j + 4 <= ns; j += 4) {
                f32x4 t[4][2];
#pragma unroll
                for (int q = 0; q < 4; ++q) { const unsigned sq = so + (unsigned)q * (unsigned)(SLAB_F4 * 16); t[q][0] = slab_ld(rs, vr, sq); t[q][1] = slab_ld(rs, vr + 1024u, sq); }
#pragma unroll
                for (int q = 0; q < 4; ++q) { s0 = s0 + t[q][0]; s1 = s1 + t[q][1]; }
                so += 4u * (unsigned)(SLAB_F4 * 16); }
            if (j < ns) {
                f32x4 t[3][2];
#pragma unroll
                for (int q = 0; q < 3; ++q) { const unsigned sq = so + (unsigned)q * (unsigned)(SLAB_F4 * 16);
                    if (j + q < ns) { t[q][0] = slab_ld(rs, vr, sq); t[q][1] = slab_ld(rs, vr + 1024u, sq); } else { t[q][0] = (f32x4){0.f, 0.f, 0.f, 0.f}; t[q][1] = t[q][0]; } }
#pragma unroll
                for (int q = 0; q < 3; ++q) { s0 = s0 + t[q][0]; s1 = s1 + t[q][1]; } }
            acc[0][bj][m][0] = s0; acc[0][bj][m][1] = s1;
            asm volatile("" ::: "memory");
        } }
}
__device__ __forceinline__ void split_zero_pad(f32x4 (&acc)[2][2][4][2]) {
#pragma unroll
    for (int bj = 0; bj < 2; ++bj)
#pragma unroll
        for (int m = 0; m < 4; ++m)
#pragma unroll
            for (int n = 0; n < 2; ++n) acc[1][bj][m][n] = (f32x4){0.f, 0.f, 0.f, 0.f};
}
struct SplitCtl { f32x4* SLAB; unsigned* cnt; unsigned nsl; int fin0, cbase, parts; };
__device__ __forceinline__ void split_post(unsigned* cnt, int lane) {
    asm volatile("s_waitcnt vmcnt(0)" ::: "memory");
    if (lane == 0) __hip_atomic_fetch_add(cnt, 1u, __ATOMIC_RELAXED, __HIP_MEMORY_SCOPE_AGENT);
}
__device__ __forceinline__ void split_wait(unsigned* cnt, unsigned target, int lane) {
    if (lane == 0) { unsigned sp_ = 0; while (__hip_atomic_load(cnt, __ATOMIC_RELAXED, __HIP_MEMORY_SCOPE_AGENT) < target && ++sp_ < (1u << 22)) __builtin_amdgcn_s_sleep(2); }
    asm volatile("" ::: "memory");
    __builtin_amdgcn_fence(__ATOMIC_ACQUIRE, "agent"); asm volatile("s_waitcnt vmcnt(0)" ::: "memory");
}
__device__ __forceinline__ int part_mask(int p, int parts) { const int w = 4 / parts; return ((1 << w) - 1) << (p * w); }
__device__ __forceinline__ int opaque_bx() { int b = (int)blockIdx.x; asm volatile("" : "+s"(b)); return b; }
__device__ __forceinline__ Unit final_unit(int f, int cbase) { Unit u; u.pm = MPROMPT / 256; u.pn = f; u.k0 = 0; u.nt = 0; u.cidx = cbase + f; u.sid = 0; return u; }

struct EpiIn {
    static constexpr bool PERM = true, AFTER_DRAIN = false;
    bf16* O; float* vsq; SplitCtl sp;
    template <int ACT> __device__ __forceinline__ void run(const f32x4 (&acc)[2][2][4][2], const Unit& u, int wr, int wc, int fr, int fq, bool dosq, int mmask, int nai) const {
        const int row0 = u.pm * BM + wr * 64 + fr, col0 = u.pn * BM + wc * 32 + 8 * fq;
#pragma unroll
        for (int ai = 0; ai < 2; ++ai) { if (ai >= nai) break;
#pragma unroll
            for (int m = 0; m < 4; ++m) { if (!((mmask >> m) & 1)) continue; const int row = row0 + ai * HALF + m * 16; bf16* rowp = O + (size_t)row * N_INP + col0; float sq = 0.f;
#pragma unroll
                for (int bj = 0; bj < 2; ++bj) { f32x4 v0 = acc[ai][bj][m][0], v1 = acc[ai][bj][m][1];
#pragma unroll
                    for (int j = 0; j < 4; ++j) {
                        if (ACT == 1) { v0[j] = gelu_tanh(v0[j]); v1[j] = gelu_tanh(v1[j]); }
                        if (ACT == 2) { v0[j] = sigmoidf_(v0[j]); v1[j] = sigmoidf_(v1[j]); }
                        sq += v0[j] * v0[j] + v1[j] * v1[j]; }
                    u32x4 w; w.x = cvt_pk_bf16(v0[0], v0[1]); w.y = cvt_pk_bf16(v0[2], v0[3]); w.z = cvt_pk_bf16(v1[0], v1[1]); w.w = cvt_pk_bf16(v1[2], v1[3]);
                    *(GAS u32x4*)(rowp + bj * HALF) = w; }
                if (ACT == 1) { if (dosq && vsq) { sq += xor_lt32<16>(sq); sq = add_xor32(sq); if (fq == 0) atomicAdd(vsq + row, sq); } }
            } }
    }
    __device__ __forceinline__ void apply(const f32x4 (&acc)[2][2][4][2], const Unit& u, int wr, int wc, int fr, int fq, int mmask, int nai) const {
        const int pn = u.pn;
        if (pn >= 16) run<2>(acc, u, wr, wc, fr, fq, false, mmask, nai);
        else if (pn >= 2 && pn < 6) run<1>(acc, u, wr, wc, fr, fq, pn >= 4, mmask, nai);
        else run<0>(acc, u, wr, wc, fr, fq, false, mmask, nai);
    }
    __device__ __forceinline__ void operator()(const f32x4 (&acc)[2][2][4][2], const Unit& u, int wr, int wc, int fr, int fq) const { apply(acc, u, wr, wc, fr, fq, 15, 2); }
    __device__ __forceinline__ void partial(f32x4 (&acc)[2][2][4][2], const Unit& u, int wr, int wc, int fr, int fq, int wid, int lane) const {
        split_store(acc, sp.SLAB, u.sid, wid, lane); split_post(sp.cnt + u.cidx * 8 + wid, lane);
    }
    __device__ __forceinline__ void final(const Unit& u, int wr, int wc, int fr, int fq, int wid, int lane, int mmask) const {
        f32x4 acc[2][2][4][2];
        split_wait(sp.cnt + u.cidx * 8 + wid, sp.nsl, lane);
        split_sum(acc, sp.SLAB, u.pn * (int)sp.nsl, (int)sp.nsl, wid, lane, mmask); apply(acc, u, wr, wc, fr, fq, mmask, 1);
    }
};
struct EpiBf16Plain {
    static constexpr bool PERM = true, AFTER_DRAIN = false;
    bf16* O; int ldc;
    __device__ __forceinline__ void partial(f32x4 (&)[2][2][4][2], const Unit&, int, int, int, int, int, int) const {}
    __device__ __forceinline__ void operator()(const f32x4 (&acc)[2][2][4][2], const Unit& u, int wr, int wc, int fr, int fq) const {
        const int row0 = u.pm * BM + wr * 64 + fr, col0 = u.pn * BM + wc * 32 + 8 * fq;
#pragma unroll
        for (int ai = 0; ai < 2; ++ai)
#pragma unroll
            for (int m = 0; m < 4; ++m) { bf16* rowp = O + (size_t)(row0 + ai * HALF + m * 16) * ldc + col0;
#pragma unroll
                for (int bj = 0; bj < 2; ++bj) { const f32x4 v0 = acc[ai][bj][m][0], v1 = acc[ai][bj][m][1];
                    u32x4 w; w.x = cvt_pk_bf16(v0[0], v0[1]); w.y = cvt_pk_bf16(v0[2], v0[3]); w.z = cvt_pk_bf16(v1[0], v1[1]); w.w = cvt_pk_bf16(v1[2], v1[3]);
                    *(GAS u32x4*)(rowp + bj * HALF) = w; } }
    }
};
__device__ __forceinline__ float dpp_ror1(float x) { return __builtin_bit_cast(float, __builtin_amdgcn_update_dpp(0, __builtin_bit_cast(int, x), 0x121, 0xf, 0xf, false)); }
__device__ __forceinline__ float dpp_ror2(float x) { return __builtin_bit_cast(float, __builtin_amdgcn_update_dpp(0, __builtin_bit_cast(int, x), 0x122, 0xf, 0xf, false)); }
__device__ __forceinline__ float dpp_shr1(float old, float x) { return __builtin_bit_cast(float, __builtin_amdgcn_update_dpp(__builtin_bit_cast(int, old), __builtin_bit_cast(int, x), 0x111, 0xf, 0xf, false)); }
__device__ __forceinline__ float dpp_shr2(float old, float x) { return __builtin_bit_cast(float, __builtin_amdgcn_update_dpp(__builtin_bit_cast(int, old), __builtin_bit_cast(int, x), 0x112, 0xf, 0xf, false)); }
struct EpiUpConv {
    static constexpr bool PERM = true, AFTER_DRAIN = false;
    bf16* ACT; float* HALO; const float* cw; const float* cb; const float* st; float* cfs; LAS float* EX; int dry;
    __device__ __forceinline__ void partial(f32x4 (&)[2][2][4][2], const Unit&, int, int, int, int, int, int) const {}
    __device__ __forceinline__ void operator()(const f32x4 (&acc)[2][2][4][2], const Unit& u, int wr, int wc, int fr, int fq) const {
        asm volatile("" : "+v"(fr), "+v"(fq));
        if (dry) {
#pragma unroll
            for (int ai = 0; ai < 2; ++ai)
#pragma unroll
                for (int bj = 0; bj < 2; ++bj)
#pragma unroll
                    for (int m = 0; m < 4; ++m)
#pragma unroll
                        for (int n = 0; n < 2; ++n) asm volatile("" :: "v"(acc[ai][bj][m][n]));
            return; }
        const int cl = wc * 32 + 8 * fq;
        if (u.pm == MPROMPT / 256) {
#pragma unroll
            for (int n = 0; n < 2; ++n) { const int c = u.pn * 128 + cl + 4 * n;
                f32x4 wa0, wa1, wa2, wb0, wb1, wb2, ba, bb;
                wa0 = *(const GAS f32x4*)(cw + c); wa1 = *(const GAS f32x4*)(cw + D_UP + c); wa2 = *(const GAS f32x4*)(cw + 2 * D_UP + c); wb0 = *(const GAS f32x4*)(cw + D_FF + c); wb1 = *(const GAS f32x4*)(cw + D_UP + D_FF + c); wb2 = *(const GAS f32x4*)(cw + 2 * D_UP + D_FF + c);
                ba = *(const GAS f32x4*)(cb + c); bb = *(const GAS f32x4*)(cb + D_FF + c);
#pragma unroll
                for (int m = 0; m < 4; ++m) { const int s = wr * 64 + m * 16 + fr; const float* sp = st + (size_t)s * 2 * D_UP; float* op = cfs + (size_t)s * 2 * D_UP;
                    const f32x4 a2 = *(const GAS f32x4*)(sp + c), a1 = *(const GAS f32x4*)(sp + D_UP + c), b2 = *(const GAS f32x4*)(sp + D_FF + c), b1 = *(const GAS f32x4*)(sp + D_UP + D_FF + c);
                    const f32x4 ua = acc[0][0][m][n], ub = acc[0][1][m][n];
                    *(GAS f32x4*)(op + c) = a1; *(GAS f32x4*)(op + D_FF + c) = b1; *(GAS f32x4*)(op + D_UP + c) = ua; *(GAS f32x4*)(op + D_UP + D_FF + c) = ub;
                    const f32x4 ca = ba + wa0 * a2 + wa1 * a1 + wa2 * ua, cbv = bb + wb0 * b2 + wb1 * b1 + wb2 * ub;
                    u32x2 w; w.x = cvt_pk_bf16(siluf_(ca[0]) * cbv[0], siluf_(ca[1]) * cbv[1]); w.y = cvt_pk_bf16(siluf_(ca[2]) * cbv[2], siluf_(ca[3]) * cbv[3]);
                    *(GAS u32x2*)(ACT + (size_t)(MPROMPT + s) * D_FF + c) = w; }
                asm volatile("" ::: "memory"); }
            return;
        }
        f32x4 wts[2][8];
#pragma unroll
        for (int n = 0; n < 2; ++n) { const int c = u.pn * 128 + cl + 4 * n;
            wts[n][0] = *(const GAS f32x4*)(cw + c); wts[n][1] = *(const GAS f32x4*)(cw + D_UP + c); wts[n][2] = *(const GAS f32x4*)(cw + 2 * D_UP + c);
            wts[n][3] = *(const GAS f32x4*)(cw + D_FF + c); wts[n][4] = *(const GAS f32x4*)(cw + D_UP + D_FF + c); wts[n][5] = *(const GAS f32x4*)(cw + 2 * D_UP + D_FF + c);
            wts[n][6] = *(const GAS f32x4*)(cb + c); wts[n][7] = *(const GAS f32x4*)(cb + D_FF + c); }
        if (fr >= 14) {
#pragma unroll
            for (int ai = 0; ai < 2; ++ai)
#pragma unroll
                for (int bj = 0; bj < 2; ++bj)
#pragma unroll
                    for (int n = 0; n < 2; ++n) *(LAS f32x4*)(EX + ((ai * 2 + wr) * 2 + (fr - 14)) * 256 + bj * 128 + cl + 4 * n) = acc[ai][bj][3][n];
            if (wr == 1) {
#pragma unroll
                for (int bj = 0; bj < 2; ++bj)
#pragma unroll
                    for (int n = 0; n < 2; ++n) *(GAS f32x4*)(HALO + ((size_t)u.pm * 4 + 2 + (fr - 14)) * D_UP + u.pn * 256 + bj * 128 + cl + 4 * n) = acc[1][bj][3][n]; }
        }
        if (fr < 2 && wr == 0) {
#pragma unroll
            for (int bj = 0; bj < 2; ++bj)
#pragma unroll
                for (int n = 0; n < 2; ++n) *(GAS f32x4*)(HALO + ((size_t)u.pm * 4 + fr) * D_UP + u.pn * 256 + bj * 128 + cl + 4 * n) = acc[0][bj][0][n]; }
        asm volatile("s_waitcnt lgkmcnt(0)" ::: "memory"); __builtin_amdgcn_s_barrier(); asm volatile("" ::: "memory");
#pragma unroll
        for (int n = 0; n < 2; ++n) { const int c = u.pn * 128 + cl + 4 * n;
            const f32x4 wa0 = wts[n][0], wa1 = wts[n][1], wa2 = wts[n][2], wb0 = wts[n][3], wb1 = wts[n][4], wb2 = wts[n][5], ba = wts[n][6], bb = wts[n][7];
#pragma unroll
            for (int ai = 0; ai < 2; ++ai)
#pragma unroll
                for (int m = 0; m < 4; ++m) {
                    f32x4 cv[2];
#pragma unroll
                    for (int bj = 0; bj < 2; ++bj) { const f32x4 cur = acc[ai][bj][m][n]; f32x4 pb;
                        if (m > 0) pb = acc[ai][bj][m - 1][n];
                        else { pb = (f32x4){0.f, 0.f, 0.f, 0.f};
                            const int sa = wr == 1 ? ai : 0, sw = wr == 1 ? 0 : 1; const bool have = (wr == 1) || (ai == 1);
                            if (have && fr >= 14) pb = *(const LAS f32x4*)(EX + ((sa * 2 + sw) * 2 + (fr - 14)) * 256 + bj * 128 + cl + 4 * n); }
                        f32x4 x1, x2;
#pragma unroll
                        for (int j = 0; j < 4; ++j) { x1[j] = dpp_shr1(dpp_ror1(pb[j]), cur[j]); x2[j] = dpp_shr2(dpp_ror2(pb[j]), cur[j]); }
                        cv[bj] = bj == 0 ? ba + wa0 * x2 + wa1 * x1 + wa2 * cur : bb + wb0 * x2 + wb1 * x1 + wb2 * cur; }
                    u32x2 w; w.x = cvt_pk_bf16(siluf_(cv[0][0]) * cv[1][0], siluf_(cv[0][1]) * cv[1][1]); w.y = cvt_pk_bf16(siluf_(cv[0][2]) * cv[1][2], siluf_(cv[0][3]) * cv[1][3]);
                    *(GAS u32x2*)(ACT + (size_t)(u.pm * BM + ai * HALF + wr * 64 + m * 16 + fr) * D_FF + c) = w; }
            asm volatile("" ::: "memory"); }
    }
};
struct EpiGlu {
    static constexpr bool PERM = true, AFTER_DRAIN = false;
    const bf16* Y; bf16* O;
    __device__ __forceinline__ void partial(f32x4 (&)[2][2][4][2], const Unit&, int, int, int, int, int, int) const {}
    __device__ __forceinline__ void operator()(const f32x4 (&acc)[2][2][4][2], const Unit& u, int wr, int wc, int fr, int fq) const {
        const int row0 = u.pm * BM + wr * 64 + fr, col0 = u.pn * BM + wc * 32 + 8 * fq;
#pragma unroll
        for (int ai = 0; ai < 2; ++ai)
#pragma unroll
            for (int m = 0; m < 4; ++m) { const size_t off = (size_t)(row0 + ai * HALF + m * 16) * 512 + col0;
#pragma unroll
                for (int bj = 0; bj < 2; ++bj) { const f32x4 v0 = acc[ai][bj][m][0], v1 = acc[ai][bj][m][1];
                    const u32x4 y = *(const GAS u32x4*)(Y + off + bj * HALF);
                    u32x4 w;
                    w.x = cvt_pk_bf16(bflo(y.x) * sigmoidf_(v0[0]), bfhi(y.x) * sigmoidf_(v0[1]));
                    w.y = cvt_pk_bf16(bflo(y.y) * sigmoidf_(v0[2]), bfhi(y.y) * sigmoidf_(v0[3]));
                    w.z = cvt_pk_bf16(bflo(y.z) * sigmoidf_(v1[0]), bfhi(y.z) * sigmoidf_(v1[1]));
                    w.w = cvt_pk_bf16(bflo(y.w) * sigmoidf_(v1[2]), bfhi(y.w) * sigmoidf_(v1[3]));
                    *(GAS u32x4*)(O + off + bj * HALF) = w; } }
    }
};
template <int MODE> struct EpiMerge {
    static constexpr bool PERM = false, AFTER_DRAIN = false;
    const bf16* G;
    float* T; bf16* MG; const float* csq;
    f32x4* SLAB; const bf16* PRJ; unsigned* cnt;
    __device__ __forceinline__ void partial(f32x4 (&acc)[2][2][4][2], const Unit& u, int wr, int wc, int fr, int fq, int wid, int lane) const {
        split_store(acc, SLAB, u.sid, wid, lane); split_post(cnt + u.cidx * 8 + wid, lane);
    }
    __device__ __forceinline__ void final(const Unit& u, int wr, int wc, int fr, int fq, int wid, int lane, int mmask) const {
        split_wait(cnt + u.cidx * 8 + wid, 8u, lane);
        asm volatile("" : "+v"(fr), "+v"(fq), "+v"(lane));
#pragma unroll
        for (int m = 0; m < 4; ++m) { if (!((mmask >> m) & 1)) continue; const int r = wr * 64 + m * 16 + fr, row = MPROMPT + r; const float rs = rsqrtf(csq[row] * (1.0f / 1024.0f) + EPS);
            const __amdgpu_buffer_rsrc_t rs_ = slab_rsrc(SLAB);
#pragma unroll
            for (int bj = 0; bj < 2; ++bj) {
                f32x4 sa[2], sb[2], sc[2];
                {   f32x4 la[2][2], lb[2][2], lc[2][4];
#pragma unroll
                    for (int n = 0; n < 2; ++n) { const unsigned vo = (unsigned)((wid * 16 + (m * 2 + bj) * 2 + n) * 64 + lane) * 16u;
#pragma unroll
                        for (int j = 0; j < 2; ++j) { la[n][j] = slab_ld(rs_, vo, (unsigned)(u.pn * 2 + j) * (unsigned)(SLAB_F4 * 16)); lb[n][j] = slab_ld(rs_, vo, (unsigned)(16 + u.pn * 2 + j) * (unsigned)(SLAB_F4 * 16)); }
#pragma unroll
                        for (int j = 0; j < 4; ++j) lc[n][j] = slab_ld(rs_, vo, (unsigned)(32 + u.pn * 4 + j) * (unsigned)(SLAB_F4 * 16)); }
#pragma unroll
                    for (int n = 0; n < 2; ++n) { sa[n] = la[n][0] + la[n][1]; sb[n] = lb[n][0] + lb[n][1]; sc[n] = (lc[n][0] + lc[n][1]) + (lc[n][2] + lc[n][3]); } }
#pragma unroll
                for (int n = 0; n < 2; ++n) { const int col = split_col<PERM>(u, wc, fq, bj, n); const bf16* gp = PRJ + ((unsigned)row * N_INP + col);
                    const f32x4 a = sa[n], b = sb[n], c = sc[n];
                    const u32x2 ga = *(const GAS u32x2*)(gp + PC_GA), gb = *(const GAS u32x2*)(gp + PC_GB), gc = *(const GAS u32x2*)(gp + PC_GC);
                    f32x4 t; t[0] = bflo(ga.x) * a[0] + bflo(gb.x) * b[0] + bflo(gc.x) * rs * c[0]; t[1] = bfhi(ga.x) * a[1] + bfhi(gb.x) * b[1] + bfhi(gc.x) * rs * c[1];
                    t[2] = bflo(ga.y) * a[2] + bflo(gb.y) * b[2] + bflo(gc.y) * rs * c[2]; t[3] = bfhi(ga.y) * a[3] + bfhi(gb.y) * b[3] + bfhi(gc.y) * rs * c[3];
                    u32x2 w; w.x = cvt_pk_bf16(t[0], t[1]); w.y = cvt_pk_bf16(t[2], t[3]); *(GAS u32x2*)(MG + ((unsigned)row * DM + col)) = w; } }
            asm volatile("" ::: "memory"); }
    }
    __device__ __forceinline__ void operator()(const f32x4 (&acc)[2][2][4][2], const Unit& u, int wr, int wc, int fr, int fq) const {
        const int row0 = u.pm * BM + wr * 64 + fr, col0 = u.pn * BM + wc * 32 + 4 * fq;
        bf16* Tb = (bf16*)T;
#pragma unroll
        for (int ai = 0; ai < 2; ++ai) {
#pragma unroll
          for (int mh = 0; mh < 4; mh += 2) {
            u32x2 gq[4][2][2], tq[4][2][2]; float rsq[4];
#pragma unroll
            for (int m = mh; m < mh + 2; ++m) { const int row = row0 + ai * HALF + m * 16; const size_t off = (size_t)row * DM + col0; const bf16* gp = G + (size_t)row * N_INP + col0;
                rsq[m] = MODE == 2 ? csq[row] : 0.f;
#pragma unroll
                for (int bj = 0; bj < 2; ++bj)
#pragma unroll
                    for (int n = 0; n < 2; ++n) { const int co = bj * HALF + n * 16; gq[m][bj][n] = *(const GAS u32x2*)(gp + co); if (MODE != 0) tq[m][bj][n] = *(const GAS u32x2*)(Tb + off + co); } }
#pragma unroll
            for (int m = mh; m < mh + 2; ++m) { const int row = row0 + ai * HALF + m * 16; const size_t off = (size_t)row * DM + col0;
                const float rs = MODE == 2 ? rsqrtf(rsq[m] * (1.0f / 1024.0f) + EPS) : 1.f;
#pragma unroll
                for (int bj = 0; bj < 2; ++bj)
#pragma unroll
                    for (int n = 0; n < 2; ++n) { const int co = bj * HALF + n * 16; const u32x2 g = gq[m][bj][n]; f32x4 v = acc[ai][bj][m][n];
                        v[0] *= bflo(g.x); v[1] *= bfhi(g.x); v[2] *= bflo(g.y); v[3] *= bfhi(g.y);
                        if (MODE == 0) { u32x2 w; w.x = cvt_pk_bf16(v[0], v[1]); w.y = cvt_pk_bf16(v[2], v[3]); *(GAS u32x2*)(Tb + off + co) = w; }
                        if (MODE == 1) { const u32x2 tb = tq[m][bj][n]; u32x2 w; w.x = cvt_pk_bf16(bflo(tb.x) + v[0], bfhi(tb.x) + v[1]); w.y = cvt_pk_bf16(bflo(tb.y) + v[2], bfhi(tb.y) + v[3]); *(GAS u32x2*)(Tb + off + co) = w; }
                        if (MODE == 2) { const u32x2 tb = tq[m][bj][n]; f32x4 t = {bflo(tb.x), bfhi(tb.x), bflo(tb.y), bfhi(tb.y)}; t = t + v * rs; u32x2 w; w.x = cvt_pk_bf16(t[0], t[1]); w.y = cvt_pk_bf16(t[2], t[3]); *(GAS u32x2*)(MG + off + co) = w; } } } } }
    }
};
template <int SEG> struct EpiChain {
    static constexpr bool PERM = false, AFTER_DRAIN = false;
    const bf16* PRJ; bf16* MG; const float* csq;
    __device__ __forceinline__ void partial(f32x4 (&)[2][2][4][2], const Unit&, int, int, int, int, int, int) const {}
    __device__ __forceinline__ void operator()(f32x4 (&acc)[2][2][4][2], const Unit& u, int wr, int wc, int fr, int fq) const {
        const int row0 = u.pm * BM + wr * 64 + fr, col0 = u.pn * BM + wc * 32 + 4 * fq;
#pragma unroll
        for (int ai = 0; ai < 2; ++ai)
#pragma unroll
            for (int m = 0; m < 4; ++m) { const int row = row0 + ai * HALF + m * 16; const bf16* gp = PRJ + ((unsigned)row * N_INP + col0);
                float rs = 1.f; if (SEG >= 1) rs = rsqrtf(csq[row] * (1.0f / 1024.0f) + EPS);
#pragma unroll
                for (int bj = 0; bj < 2; ++bj)
#pragma unroll
                    for (int n = 0; n < 2; ++n) { const int co = bj * HALF + n * 16; f32x4 v = acc[ai][bj][m][n];
                        if (SEG == 0) { const u32x2 ga = *(const GAS u32x2*)(gp + PC_GA + co), gb = *(const GAS u32x2*)(gp + PC_GB + co);
                            v[0] *= bflo(ga.x) * __builtin_amdgcn_rcpf(fmaxf(bflo(gb.x), 1e-20f)); v[1] *= bfhi(ga.x) * __builtin_amdgcn_rcpf(fmaxf(bfhi(gb.x), 1e-20f));
                            v[2] *= bflo(ga.y) * __builtin_amdgcn_rcpf(fmaxf(bflo(gb.y), 1e-20f)); v[3] *= bfhi(ga.y) * __builtin_amdgcn_rcpf(fmaxf(bfhi(gb.y), 1e-20f)); acc[ai][bj][m][n] = v; }
                        if (SEG == 1) { const u32x2 gb = *(const GAS u32x2*)(gp + PC_GB + co), gc = *(const GAS u32x2*)(gp + PC_GC + co);
                            v[0] *= fmaxf(bflo(gb.x), 1e-20f) * __builtin_amdgcn_rcpf(fmaxf(bflo(gc.x) * rs, 1e-20f)); v[1] *= fmaxf(bfhi(gb.x), 1e-20f) * __builtin_amdgcn_rcpf(fmaxf(bfhi(gc.x) * rs, 1e-20f));
                            v[2] *= fmaxf(bflo(gb.y), 1e-20f) * __builtin_amdgcn_rcpf(fmaxf(bflo(gc.y) * rs, 1e-20f)); v[3] *= fmaxf(bfhi(gb.y), 1e-20f) * __builtin_amdgcn_rcpf(fmaxf(bfhi(gc.y) * rs, 1e-20f)); acc[ai][bj][m][n] = v; }
                        if (SEG == 2) { const u32x2 gc = *(const GAS u32x2*)(gp + PC_GC + co);
                            v[0] *= fmaxf(bflo(gc.x) * rs, 1e-20f); v[1] *= fmaxf(bfhi(gc.x) * rs, 1e-20f); v[2] *= fmaxf(bflo(gc.y) * rs, 1e-20f); v[3] *= fmaxf(bfhi(gc.y) * rs, 1e-20f);
                            u32x2 w; w.x = cvt_pk_bf16(v[0], v[1]); w.y = cvt_pk_bf16(v[2], v[3]); *(GAS u32x2*)(MG + ((unsigned)row * DM + col0 + co)) = w; } }
                asm volatile("" ::: "memory"); }
    }
};
struct EpiResid {
    static constexpr bool PERM = false, AFTER_DRAIN = false;
    const bf16* XI; const bf16* XIS; bf16* XO; const float* gate; SplitCtl sp;
    __device__ __forceinline__ void partial(f32x4 (&acc)[2][2][4][2], const Unit& u, int wr, int wc, int fr, int fq, int wid, int lane) const {
        split_store(acc, sp.SLAB, u.sid, wid, lane);
        if (split_arrive(sp.cnt + u.cidx * 8 + wid, sp.nsl, lane)) { split_zero_pad(acc); split_sum(acc, sp.SLAB, u.pn * (int)sp.nsl, (int)sp.nsl, wid, lane); (*this)(acc, u, wr, wc, fr, fq); }
    }
    __device__ __forceinline__ void operator()(const f32x4 (&acc)[2][2][4][2], const Unit& u, int wr, int wc, int fr, int fq, int mmask = 15) const {
        const int row0 = u.pm * BM + wr * 64 + fr, col0 = u.pn * BM + wc * 32 + 4 * fq;
        const __amdgpu_buffer_rsrc_t xr = __builtin_amdgcn_make_buffer_rsrc((void*)XO, (short)0, (int)((size_t)MP * DM * 2), 0x00020000);
        const bool samp = u.pm == MPROMPT / 256;
        const bf16* xs16 = samp ? XIS - (size_t)MPROMPT * DM : XI;
#pragma unroll
        for (int ai = 0; ai < 2; ++ai) { if (ai == 1 && samp) break;
            u32x2 xw[4][2][2]; f32x4 gg[4][2][2];
#pragma unroll
            for (int m = 0; m < 4; ++m) { if (!((mmask >> m) & 1)) continue; const int row = row0 + ai * HALF + m * 16; const size_t off = (size_t)row * DM + col0; const float* gp = gate + (size_t)mod_row(row) * MOD_PITCH + col0;
#pragma unroll
                for (int bj = 0; bj < 2; ++bj)
#pragma unroll
                    for (int n = 0; n < 2; ++n) { const int co = bj * HALF + n * 16; xw[m][bj][n] = *(const GAS u32x2*)(xs16 + off + co); gg[m][bj][n] = *(const GAS f32x4*)(gp + co); } }
#pragma unroll
            for (int m = 0; m < 4; ++m) { if (!((mmask >> m) & 1)) continue; const int row = row0 + ai * HALF + m * 16; const size_t off = (size_t)row * DM + col0;
#pragma unroll
                for (int bj = 0; bj < 2; ++bj)
#pragma unroll
                    for (int n = 0; n < 2; ++n) { const int co = bj * HALF + n * 16; const u32x2 w = xw[m][bj][n]; const f32x4 xi = {bflo(w.x), bfhi(w.x), bflo(w.y), bfhi(w.y)};
                        const f32x4 xo = xi + gg[m][bj][n] * acc[ai][bj][m][n]; u32x2 wo; wo.x = cvt_pk_bf16(xo[0], xo[1]); wo.y = cvt_pk_bf16(xo[2], xo[3]);
                        __builtin_amdgcn_raw_buffer_store_b64(wo, xr, (unsigned)(off + co) * 2u, 0,   16); } } }
    }
};
template <int MODE> struct EpiResidPrep {
    static constexpr bool PERM = false, AFTER_DRAIN = true;
    EpiResid R; bf16* H; float* yp; float* ys; const float* g; const float* mod2; int sh_idx, sc_idx; const float* wdt; float* DT; unsigned* pc;
    __device__ __forceinline__ void partial(f32x4 (&acc)[2][2][4][2], const Unit& u, int wr, int wc, int fr, int fq, int wid, int lane) const {
        split_store(acc, R.sp.SLAB, u.sid, wid, lane); split_post(R.sp.cnt + u.cidx * 8 + wid, lane);
    }
    __device__ __forceinline__ void operator()(const f32x4 (&acc)[2][2][4][2], const Unit& u, int wr, int wc, int fr, int fq) const { R(acc, u, wr, wc, fr, fq); }
    __device__ __forceinline__ void fused(f32x4 (&acc)[2][2][4][2], const Unit& u, int wr, int wc, int fr, int fq, LAS unsigned char* lds, int wid, int lane) const {
        R(acc, u, wr, wc, fr, fq);
        const int fin = opaque_bx() - R.sp.fin0; const bool isfin = fin >= 0 && fin < (DM / 256) * R.sp.parts;
        if (isfin) { const Unit uf = final_unit(fin / R.sp.parts, R.sp.cbase); const int mmask = part_mask(fin % R.sp.parts, R.sp.parts);
            split_wait(R.sp.cnt + uf.cidx * 8 + wid, R.sp.nsl, lane);
            split_sum(acc, R.sp.SLAB, uf.pn * (int)R.sp.nsl, (int)R.sp.nsl, wid, lane, mmask); R(acc, uf, wr, wc, fr, fq, mmask); }
        asm volatile("s_waitcnt vmcnt(0)" ::: "memory"); __syncthreads();
        if (wid == 0 && lane == 0) {
            if (isfin) __hip_atomic_fetch_add(pc + 32, 8u / (unsigned)R.sp.parts, __ATOMIC_RELAXED, __HIP_MEMORY_SCOPE_AGENT);
            __hip_atomic_fetch_add(pc + u.pm, 1u, __ATOMIC_RELAXED, __HIP_MEMORY_SCOPE_AGENT);
            unsigned sp_ = 0; while (__hip_atomic_load(pc + u.pm, __ATOMIC_RELAXED, __HIP_MEMORY_SCOPE_AGENT) < 8u && ++sp_ < (1u << 22)) __builtin_amdgcn_s_sleep(2);
            if (u.pn == 0) { sp_ = 0; while (__hip_atomic_load(pc + 32, __ATOMIC_RELAXED, __HIP_MEMORY_SCOPE_AGENT) < 64u && ++sp_ < (1u << 22)) __builtin_amdgcn_s_sleep(2); }
            __builtin_amdgcn_fence(__ATOMIC_ACQUIRE, "agent"); asm volatile("s_waitcnt vmcnt(0)" ::: "memory");
        }
        __syncthreads();
        LAS float* wT = (LAS float*)lds;
        if (MODE == 1) { f32x4 tw[16];
#pragma unroll
            for (int i = 0; i < 16; ++i) tw[i] = ((const f32x4*)wdt)[wid * 64 + lane + i * NTHR];
#pragma unroll
            for (int i = 0; i < 16; ++i) ((LAS f32x4*)wT)[wid * 64 + lane + i * NTHR] = tw[i];
            __syncthreads(); }
        const bf16* X = R.XO;
        {   const int row = u.pm * BM + u.pn * 32 + wid * 4;
            prep_rows4<MODE>(X + (size_t)row * DM, g, mod2 + (size_t)mod_row(row) * MOD_PITCH, sh_idx, sc_idx, H + (size_t)row * DM, yp + (size_t)row * DM, DT + (size_t)row * 16, wT, lane); }
        if (u.pn == 0 && wid < 4) { const int s = u.pm * 4 + wid, row = MPROMPT + s;
            prep_row<MODE>(X + (size_t)row * DM, g, mod2 + (size_t)mod_row(row) * MOD_PITCH, sh_idx, sc_idx, H + (size_t)row * DM, ys + (size_t)s * DM, DT + (size_t)row * 16, wT, lane); }
        if (MODE == 1) __syncthreads();
    }
};
struct EpiMod {
    static constexpr bool PERM = false, AFTER_DRAIN = false;
    float* MOD; const float* bmod;
    __device__ __forceinline__ void partial(f32x4 (&)[2][2][4][2], const Unit&, int, int, int, int, int, int) const {}
    __device__ __forceinline__ void operator()(const f32x4 (&acc)[2][2][4][2], const Unit& u, int wr, int wc, int fr, int fq) const {
        const int row0 = wr * 64 + fr, col0 = u.pn * BM + wc * 32 + 4 * fq;
        f32x4 bv[2][2];
#pragma unroll
        for (int bj = 0; bj < 2; ++bj)
#pragma unroll
            for (int n = 0; n < 2; ++n) bv[bj][n] = *(const GAS f32x4*)(bmod + col0 + bj * HALF + n * 16);
#pragma unroll
        for (int ai = 0; ai < 2; ++ai)
#pragma unroll
            for (int m = 0; m < 4; ++m) { float* rowp = MOD + (size_t)(row0 + ai * HALF + m * 16) * MOD_PITCH + col0;
#pragma unroll
                for (int bj = 0; bj < 2; ++bj)
#pragma unroll
                    for (int n = 0; n < 2; ++n) *(GAS f32x4*)(rowp + bj * HALF + n * 16) = acc[ai][bj][m][n] + bv[bj][n]; }
    }
};
}
struct Frame {
    LAS unsigned char* lds;
    int tid, lane, wave, gw;
    float* out; unsigned char* ws;
};
#define WSP(T, off) ((T*)(F.ws + (off)))
__device__ __forceinline__ Frame launder(const Frame& F0) {
    Frame F = F0; int t = F0.tid; asm volatile("" : "+v"(t)); F.tid = t; F.lane = t & 63; F.wave = __builtin_amdgcn_readfirstlane(t >> 6);
    unsigned long long w = (unsigned long long)F0.ws, o = (unsigned long long)F0.out; asm volatile("" : "+s"(w), "+s"(o)); F.ws = (unsigned char*)w; F.out = (float*)o;
    F.gw = blockIdx.x * NWAVES + F.wave; return F;
}

__device__ __forceinline__ void transpose_item(const float* W, int ld, int K, int ncols, int c0, bf16* WT, int row_off, LAS float* scr, int item, int lane) {
    const int nblk = ncols / 32, kb = item / nblk, nb = item % nblk, k0 = 64 * kb, n0 = 32 * nb;
    const int rbase = row_off >= 0 ? row_off + n0 : (n0 < D_FF ? 256 * (n0 / 128) + n0 % 128 : 256 * ((n0 - D_FF) / 128) + 128 + (n0 - D_FF) % 128);
    float tv[32];
#pragma unroll
    for (int i = 0; i < 32; ++i) { const int kk = 2 * i + (lane >> 5); tv[i] = __builtin_nontemporal_load(W + (size_t)(k0 + kk) * ld + c0 + n0 + (lane & 31)); }
#pragma unroll
    for (int i = 0; i < 32; ++i) { const int kk = 2 * i + (lane >> 5); scr[kk * 33 + (lane & 31)] = tv[i]; }
    if (false) for (int i = 0; i < 32; ++i) { const int kk = 2 * i + (lane >> 5); scr[kk * 33 + (lane & 31)] = __builtin_nontemporal_load(W + (size_t)(k0 + kk) * ld + c0 + n0 + (lane & 31)); }
    LDS_WAIT(); asm volatile("" ::: "memory");
    const int c = lane & 7;
#pragma unroll
    for (int j = 0; j < 4; ++j) { const int n = (lane >> 3) + 8 * j; const LAS float* s = scr + (8 * c) * 33 + n;
        v4u o; o.x = pk2(s[0 * 33], s[1 * 33]); o.y = pk2(s[2 * 33], s[3 * 33]); o.z = pk2(s[4 * 33], s[5 * 33]); o.w = pk2(s[6 * 33], s[7 * 33]);
        *(GAS v4u*)(WT + (size_t)(rbase + n) * K + k0 + 8 * c) = o; }
    LDS_WAIT(); asm volatile("" ::: "memory");
}
constexpr int MODC = 96, MODK = 128, MODP = 136;
__device__ __forceinline__ void phase_mod(const Frame& F0, KArgs A) {
    Frame F = launder(F0);
    const int n0 = blockIdx.x * MODC, l = n0 / N_MOD, cl = n0 - l * N_MOD;
    const float* W = A->in[I_WMOD] + (size_t)l * DM * N_MOD + cl;
    LAS bf16* Bt = (LAS bf16*)F.lds;
    LAS bf16* As = (LAS bf16*)(F.lds + 2 * MODC * MODP * 2);
    for (int i = F.tid; i < 2 * 12 * MODP; i += NTHR) { const int b = i / (12 * MODP), r = i % (12 * MODP); As[(b * 144 + 132) * MODP + r] = (bf16)0; }
    f32x4 wa[6], wb[6], creg[9];
    auto load_w = [&](f32x4 (&wr)[6], int kc) {
#pragma unroll
        for (int j = 0; j < 6; ++j) { const int idx = F.tid + NTHR * j, n = idx % MODC, k = 4 * (idx / MODC); const float* p = W + (size_t)(kc * MODK + k) * N_MOD + n;
            wr[j].x = __builtin_nontemporal_load(p); wr[j].y = __builtin_nontemporal_load(p + N_MOD); wr[j].z = __builtin_nontemporal_load(p + 2 * N_MOD); wr[j].w = __builtin_nontemporal_load(p + 3 * (size_t)N_MOD); }
    };
    auto load_c = [&](int kc) {
#pragma unroll
        for (int j = 0; j < 9; ++j) { const int idx = F.tid + NTHR * j, r = idx >> 5, k4 = (idx & 31) * 4;
            const float* src = r < NB ? A->in[I_CP] + (size_t)r * DM : A->in[I_CS] + (size_t)(r - NB) * DM;
            creg[j] = r < NB + NS ? *(const GAS f32x4*)(src + kc * MODK + k4) : (f32x4){0.f, 0.f, 0.f, 0.f}; }
    };
    auto store_w = [&](const f32x4 (&wr)[6], int buf) {
#pragma unroll
        for (int j = 0; j < 6; ++j) { const int idx = F.tid + NTHR * j, n = idx % MODC, k = 4 * (idx / MODC);
            v2u w; w.x = pk2(wr[j].x, wr[j].y); w.y = pk2(wr[j].z, wr[j].w); *(LAS v2u*)(Bt + (buf * MODC + n) * MODP + k) = w; }
    };
    auto store_c = [&](int buf) {
#pragma unroll
        for (int j = 0; j < 9; ++j) { const int idx = F.tid + NTHR * j, r = idx >> 5, k4 = (idx & 31) * 4;
            if (r < NB + NS) { v2u w; w.x = pk2(siluf_(creg[j].x), siluf_(creg[j].y)); w.y = pk2(siluf_(creg[j].z), siluf_(creg[j].w)); *(LAS v2u*)(As + (buf * 144 + r) * MODP + k4) = w; } }
    };
    f32x4 acc[9];
#pragma unroll
    for (int m = 0; m < 9; ++m) acc[m] = (f32x4){0.f, 0.f, 0.f, 0.f};
    auto compute = [&](int buf) {
        if (F.wave < 6) {
#pragma unroll
            for (int ks = 0; ks < MODK / 32; ++ks) { const bf16x8 bfr = *(const LAS bf16x8*)(Bt + (buf * MODC + 16 * F.wave + (F.lane & 15)) * MODP + 32 * ks + 8 * (F.lane >> 4));
#pragma unroll
                for (int m = 0; m < 9; ++m) { const bf16x8 af = *(const LAS bf16x8*)(As + (buf * 144 + 16 * m + (F.lane & 15)) * MODP + 32 * ks + 8 * (F.lane >> 4));
                    acc[m] = __builtin_amdgcn_mfma_f32_16x16x32_bf16(af, bfr, acc[m], 0, 0, 0); } }
        }
    };
    const int kst = blockIdx.x & 15;
    load_w(wa, kst); load_c(kst); load_w(wb, (1 + kst) & 15);
    store_w(wa, 0); store_c(0); __syncthreads();
#pragma unroll 1
    for (int kc = 0; kc < DM / MODK; kc += 2) {
        load_c((kc + 1 + kst) & 15); if (kc + 2 < DM / MODK) load_w(wa, (kc + 2 + kst) & 15);
        compute(0);
        store_w(wb, 1); store_c(1); __syncthreads();
        if (kc + 2 < DM / MODK) { load_c((kc + 2 + kst) & 15); if (kc + 3 < DM / MODK) load_w(wb, (kc + 3 + kst) & 15); }
        compute(1);
        if (kc + 2 < DM / MODK) { store_w(wa, 0); store_c(0); }
        __syncthreads();
    }
    if (F.wave < 6) { float* MOD = WSP(float, WS_MOD); const int col = n0 + 16 * F.wave + (F.lane & 15); const float bias = A->in[I_BMOD][col];
#pragma unroll
        for (int m = 0; m < 9; ++m)
#pragma unroll
            for (int r = 0; r < 4; ++r) { const int row = 16 * m + 4 * (F.lane >> 4) + r; if (row < NB + NS) MOD[(size_t)row * MOD_PITCH + col] = acc[m][r] + bias; } }
    __syncthreads();
}
__device__ __forceinline__ void tjob(Frame& F, LAS float* scr, const float* W, int ld, int K, int ncols, int c0, bf16* WT, int row_off) {
    const int nit = (K / 64) * (ncols / 32);
    for (int it = F.gw; it < nit; it += (GRID * NWAVES)) transpose_item(W, ld, K, ncols, c0, WT, row_off, scr, it, F.lane);
}
__device__ __forceinline__ void phase_prologue(const Frame& F0, KArgs A) {
    Frame F = launder(F0);
    LAS float* scr = (LAS float*)(F.lds + F.wave * 16384);
#pragma unroll 1
    for (int l = 0; l < DEPTH; ++l) {
        unsigned char* wl = F.ws + WS_W + (size_t)l * WL_END;
        tjob(F, scr, A->in[I_WIN] + (size_t)l * DM * N_IN, N_IN, DM, 4096, 0, (bf16*)(wl + WL_IN), 0);
        tjob(F, scr, A->in[I_WIN] + (size_t)l * DM * N_IN, N_IN, DM, 6144, 4112, (bf16*)(wl + WL_IN), 4096);
        tjob(F, scr, A->in[I_WGLU] + (size_t)l * 512 * 512, 512, 512, 512, 0, (bf16*)(wl + WL_GLU), 0);
        tjob(F, scr, A->in[I_WPA] + (size_t)l * 512 * DM, DM, 512, DM, 0, (bf16*)(wl + WL_PA), 0);
        tjob(F, scr, A->in[I_WPB] + (size_t)l * 512 * DM, DM, 512, DM, 0, (bf16*)(wl + WL_PB), 0);
        tjob(F, scr, A->in[I_WPC] + (size_t)l * 1024 * DM, DM, 1024, DM, 0, (bf16*)(wl + WL_PC), 0);
        tjob(F, scr, A->in[I_WOUT] + (size_t)l * DM * DM, DM, DM, DM, 0, (bf16*)(wl + WL_OUT), 0);
        tjob(F, scr, A->in[I_WUP] + (size_t)l * DM * D_UP, D_UP, DM, D_UP, 0, (bf16*)(wl + WL_UP), -1);
        tjob(F, scr, A->in[I_WDOWN] + (size_t)l * D_FF * DM, DM, D_FF, DM, 0, (bf16*)(wl + WL_DOWN), 0);
    }
    {   bf16* X0 = WSP(bf16, WS_X0);
        for (int r = F.gw; r < MREAL; r += (GRID * NWAVES)) {
            const float* src = r < MPROMPT ? A->in[I_XP] + (size_t)r * DM : A->in[I_XS] + (size_t)(r - MPROMPT) * DM;
            GAS v2u* o = (GAS v2u*)(X0 + (size_t)r * DM) + F.lane;
#pragma unroll
            for (int j = 0; j < 8; ++j) { const f32x4 v = __builtin_nontemporal_load((const f32x4*)src + F.lane + 64 * j); v2u w; w.x = pk2(v.x, v.y); w.y = pk2(v.z, v.w); o[64 * j] = w; }
        }
    }
    {   float* z = WSP(float, WS_SMALL + SM_VSQ);
        const int gt = blockIdx.x * NTHR + F.tid;
        for (int i = gt; i < 4 * MP; i += GRID * NTHR) z[i] = 0.f;
    }
    {   const int gt = blockIdx.x * NTHR + F.tid, NT = GRID * NTHR;
        bf16* WSb = WSP(bf16, WS_SMALL + SM_WS);
        for (int i = gt; i < DEPTH * H_B * 128 * 128; i += NT) { const int jj = i & 127, ii = (i >> 7) & 127; WSb[i] = (bf16)(jj <= ii ? f2bf(A->in[I_WS][i]) : 0u); }
        float* AA = WSP(float, WS_SMALL + SM_S5A); float* BB = WSP(float, WS_SMALL + SM_S5BB); bf16* CT = WSP(bf16, WS_SMALL + SM_S5CT);
        for (int i = gt; i < DEPTH * G_A * P_A; i += NT) {
            const int l = i / (G_A * P_A), g = (i / P_A) % G_A;
            const float dt = expf(A->in[I_LOGDT][l * G_A + g]), lr = A->in[I_LAMRE][i], li = A->in[I_LAMIM][i];
            const float mag = expf(lr * dt); float sn, cs; sincosf(li * dt, &sn, &cs);
            const float ar = mag * cs, ai = mag * sn, den = lr * lr + li * li, nr = ar - 1.0f;
            const float kr = (nr * lr + ai * li) / den, ki = (ai * lr - nr * li) / den;
            float qr = ar, qi = ai;
#pragma unroll
            for (int s = 0; s < 6; ++s) { const float t = qr * qr - qi * qi; qi = 2.0f * qr * qi; qr = t; }
            AA[i * 4 + 0] = ar; AA[i * 4 + 1] = ai; AA[i * 4 + 2] = qr; AA[i * 4 + 3] = qi;
#pragma unroll
            for (int h = 0; h < S5G; ++h) { const float bre = A->in[I_BRE][(size_t)i * S5G + h], bim = A->in[I_BIM][(size_t)i * S5G + h];
                BB[(size_t)i * 32 + h] = kr * bre - ki * bim; BB[(size_t)i * 32 + 16 + h] = kr * bim + ki * bre; }
        }
        {   float* WDT = WSP(float, WS_SMALL + SM_WDT);
            for (int i = gt; i < DEPTH * 16 * DM; i += NT) { const int k = i % DM, hh = (i / DM) & 15, l = i / (16 * DM); WDT[i] = A->in[I_WIN][((size_t)l * DM + k) * N_IN + 4096 + hh]; } }
        for (int i = gt; i < DEPTH * G_A * S5G * 128; i += NT) { const int k = i & 127, lgh = i >> 7;
            const float v = k < 64 ? A->in[I_CRE][(size_t)lgh * 64 + k] : -A->in[I_CIM][(size_t)lgh * 64 + (k - 64)]; CT[i] = (bf16)f2bf(v); }
    }
}

template <bool WITH_DT>
__device__ __forceinline__ void phase_prep(const Frame& F0, const float* X, const float* XS, const float* g, const float* modl, int sh_idx, int sc_idx, const float* win_l, float* DT) {
    Frame F = launder(F0);
    bf16* H = WSP(bf16, WS_H);
    LAS float* wT = (LAS float*)F.lds;
    if (WITH_DT) {
        {   const GAS f32x4* wd = (const GAS f32x4*)WSP(const float, WS_SMALL + SM_WDT);
            f32x4 tw[16];
#pragma unroll
            for (int i = 0; i < 16; ++i) tw[i] = wd[F.tid + i * NTHR];
#pragma unroll
            for (int i = 0; i < 16; ++i) ((LAS f32x4*)wT)[F.tid + i * NTHR] = tw[i]; }
        (void)win_l;
        __syncthreads();
    }
    if (WITH_DT) {
        const bf16* X0 = WSP(const bf16, WS_X0); float* DTo = DT; const int gwv = blockIdx.x * NWAVES + F.wave;
        {   const int row = 4 * gwv; prep_rows4<1>(X0 + (size_t)row * DM, g, modl + (size_t)mod_row(row) * MOD_PITCH, sh_idx, sc_idx, H + (size_t)row * DM, nullptr, DTo + (size_t)row * 16, wT, F.lane); }
        if (gwv < NS) { const int row = MPROMPT + gwv; prep_row<1>(X0 + (size_t)row * DM, g, modl + (size_t)mod_row(row) * MOD_PITCH, sh_idx, sc_idx, H + (size_t)row * DM, nullptr, DTo + (size_t)row * 16, wT, F.lane); }
    } else {
    f32x4 vn[8];
    {   const int r0 = blockIdx.x * NWAVES + F.wave; const int rr0 = r0 < MREAL ? r0 : 0; const GAS f32x4* xr = (const GAS f32x4*)(rr0 < MPROMPT ? X + (size_t)rr0 * DM : XS + (size_t)(rr0 - MPROMPT) * DM) + F.lane;
#pragma unroll
        for (int j = 0; j < 8; ++j) vn[j] = xr[64 * j]; }
    for (int r = blockIdx.x * NWAVES + F.wave; r < MREAL; r += GRID * NWAVES) {
        f32x4 v[8]; float s = 0.f;
#pragma unroll
        for (int j = 0; j < 8; ++j) { v[j] = vn[j]; s += (v[j].x * v[j].x + v[j].y * v[j].y) + (v[j].z * v[j].z + v[j].w * v[j].w); }
        {   const int rn = r + GRID * NWAVES; const int rr1 = rn < MREAL ? rn : r; const GAS f32x4* xr = (const GAS f32x4*)(rr1 < MPROMPT ? X + (size_t)rr1 * DM : XS + (size_t)(rr1 - MPROMPT) * DM) + F.lane;
#pragma unroll
            for (int j = 0; j < 8; ++j) vn[j] = xr[64 * j]; }
        const float rinv = rsqrtf(wave_sum(s) * (1.0f / DM) + EPS);
        const float* mr = modl + (size_t)mod_row(r) * MOD_PITCH;
        const GAS f32x4* gp = (const GAS f32x4*)g + F.lane; const GAS f32x4* shp = (const GAS f32x4*)(mr + sh_idx * DM) + F.lane; const GAS f32x4* scp = (const GAS f32x4*)(mr + sc_idx * DM) + F.lane;
        GAS v2u* o = (GAS v2u*)(H + (size_t)r * DM) + F.lane;
#pragma unroll
        for (int j = 0; j < 8; ++j) { const f32x4 gg = gp[64 * j], sh = shp[64 * j], sc = scp[64 * j];
            v[j] = v[j] * rinv * gg * (sc + 1.0f) + sh;
            v2u w; w.x = pk2(v[j].x, v[j].y); w.y = pk2(v[j].z, v[j].w); o[64 * j] = w; }
        if (WITH_DT) {
            float a16[16];
#pragma unroll
            for (int hh = 0; hh < 16; ++hh) { float a = 0.f;
#pragma unroll
                for (int j = 0; j < 8; ++j) { const f32x4 w = *(const LAS f32x4*)(wT + hh * DM + 4 * F.lane + 256 * j); a += (v[j].x * w.x + v[j].y * w.y) + (v[j].z * w.z + v[j].w * w.w); }
                a16[hh] = a; }
            const float mine = wave_sum16(a16, F.lane);
            if (F.lane < 16) DT[(size_t)r * 16 + F.lane] = mine;
        }
    }
    }
    if (WITH_DT) __syncthreads();
}

__device__ __forceinline__ void phase_final(const Frame& F0, KArgs A, const float* X) {
    Frame F = launder(F0);
    const float* g = A->in[I_GFINAL];
    for (int r = blockIdx.x * NWAVES + F.wave; r < MREAL; r += GRID * NWAVES) {
        const GAS f32x4* xr = (const GAS f32x4*)(X + (size_t)r * DM) + F.lane;
        f32x4 v[8]; float s = 0.f;
#pragma unroll
        for (int j = 0; j < 8; ++j) { v[j] = xr[64 * j]; s += (v[j].x * v[j].x + v[j].y * v[j].y) + (v[j].z * v[j].z + v[j].w * v[j].w); }
        const float rinv = rsqrtf(wave_sum(s) * (1.0f / DM) + EPS);
        GAS f32x4* o = (GAS f32x4*)(F.out + (r < MPROMPT ? O_YP + (size_t)r * DM : O_YS + (size_t)(r - MPROMPT) * DM)) + F.lane;
        const GAS f32x4* gp = (const GAS f32x4*)g + F.lane;
#pragma unroll
        for (int j = 0; j < 8; ++j) o[64 * j] = v[j] * rinv * gp[64 * j];
    }
}
typedef __bf16 bf16x2_t __attribute__((ext_vector_type(2)));
constexpr int HS_PITCH = 136;
template <bool FINAL>
__device__ __forceinline__ void s5_item(KArgs A, unsigned char* ws, float* out, int l, int item, LAS unsigned char* wl, int lane, unsigned* flags = nullptr) {
    const int c = item & 31, g = (item >> 5) & 31, b = item >> 10;
    const int lgp = (l * G_A + g) * P_A + lane;
    const f32x4 aq = *(const GAS f32x4*)((const float*)(ws + WS_SMALL + SM_S5A) + (size_t)lgp * 4);
    const float ar = aq.x, ai = aq.y;
    float br[16], bi[16];
    {   const GAS f32x4* bb = (const GAS f32x4*)((const float*)(ws + WS_SMALL + SM_S5BB) + (size_t)lgp * 32);
#pragma unroll
        for (int q = 0; q < 4; ++q) { const f32x4 v = bb[q]; br[4 * q] = v.x; br[4 * q + 1] = v.y; br[4 * q + 2] = v.z; br[4 * q + 3] = v.w;
                                      const f32x4 w = bb[4 + q]; bi[4 * q] = w.x; bi[4 * q + 1] = w.y; bi[4 * q + 2] = w.z; bi[4 * q + 3] = w.w; } }
    unsigned brp[8], bip[8];
#pragma unroll
    for (int k = 0; k < 8; ++k) { brp[k] = pk2(br[2 * k], br[2 * k + 1]); bip[k] = pk2(bi[2 * k], bi[2 * k + 1]); }
    const int row0 = b * SEQ + c * S5Q;
    const bf16* PROJ = (const bf16*)(ws + WS_BIG);
    const GAS v4u* up = (const GAS v4u*)(PROJ + (size_t)(row0 + lane) * N_INP + PC_UA + g * 16);
    const v4u u0 = up[0], u1 = up[1];
    LAS bf16* Us = (LAS bf16*)(wl + 8704);
    if (FINAL) { *(LAS v4u*)(Us + lane * 16) = u0; *(LAS v4u*)(Us + lane * 16 + 8) = u1; }
    float hr = 0.f, hi = 0.f;
    float* SLOC = (float*)(ws + WS_SMALL + SM_SLOC);
    if (FINAL && flags) {
        float lr = 0.f, li = 0.f;
#pragma unroll 2
        for (int t = 0; t < 64; ++t) {
            unsigned w[8];
            w[0] = __builtin_amdgcn_readlane(u0.x, t); w[1] = __builtin_amdgcn_readlane(u0.y, t); w[2] = __builtin_amdgcn_readlane(u0.z, t); w[3] = __builtin_amdgcn_readlane(u0.w, t);
            w[4] = __builtin_amdgcn_readlane(u1.x, t); w[5] = __builtin_amdgcn_readlane(u1.y, t); w[6] = __builtin_amdgcn_readlane(u1.z, t); w[7] = __builtin_amdgcn_readlane(u1.w, t);
            float sr0 = 0.f, si0 = 0.f, sr1 = 0.f, si1 = 0.f;
#pragma unroll
            for (int k = 0; k < 8; k += 2) {
                sr0 = __builtin_amdgcn_fdot2_f32_bf16(__builtin_bit_cast(bf16x2_t, brp[k]), __builtin_bit_cast(bf16x2_t, w[k]), sr0, false);
                si0 = __builtin_amdgcn_fdot2_f32_bf16(__builtin_bit_cast(bf16x2_t, bip[k]), __builtin_bit_cast(bf16x2_t, w[k]), si0, false);
                sr1 = __builtin_amdgcn_fdot2_f32_bf16(__builtin_bit_cast(bf16x2_t, brp[k + 1]), __builtin_bit_cast(bf16x2_t, w[k + 1]), sr1, false);
                si1 = __builtin_amdgcn_fdot2_f32_bf16(__builtin_bit_cast(bf16x2_t, bip[k + 1]), __builtin_bit_cast(bf16x2_t, w[k + 1]), si1, false); }
            const float nr = ar * lr - ai * li + (sr0 + sr1); li = ar * li + ai * lr + (si0 + si1); lr = nr;
        }
        float* sl = SLOC + (size_t)item * 128 + lane;
        __hip_atomic_store(sl, lr, __ATOMIC_RELAXED, __HIP_MEMORY_SCOPE_AGENT); __hip_atomic_store(sl + 64, li, __ATOMIC_RELAXED, __HIP_MEMORY_SCOPE_AGENT);
        asm volatile("s_waitcnt vmcnt(0)" ::: "memory");
        if (lane == 0) __hip_atomic_store(flags + item, 1u, __ATOMIC_RELAXED, __HIP_MEMORY_SCOPE_AGENT);
        {
            unsigned sp_ = 0;
            for (;;) { const unsigned f = lane < c ? __hip_atomic_load(flags + (item - c + lane), __ATOMIC_RELAXED, __HIP_MEMORY_SCOPE_AGENT) : 1u;
                if (__builtin_amdgcn_ballot_w64(f == 0u) == 0ull || ++sp_ > (1u << 20)) break; __builtin_amdgcn_s_sleep(1); }
            __builtin_amdgcn_fence(__ATOMIC_ACQUIRE, "agent"); }
        asm volatile("s_waitcnt vmcnt(0)" ::: "memory");
    }
    if (FINAL) {
        const float qr = aq.z, qi = aq.w;
        const float* sl = SLOC + (size_t)((b * G_A + g) * S5NC) * 128 + lane;
        float psr[31], psi[31];
#pragma unroll
        for (int k = 0; k < 31; ++k) { const int kk = k < c ? k : 0; psr[k] = sl[kk * 128]; psi[k] = sl[kk * 128 + 64]; }
#pragma unroll
        for (int k = 0; k < 31; ++k) if (k < c) { const float t = qr * hr - qi * hi + psr[k]; hi = qr * hi + qi * hr + psi[k]; hr = t; }
    }
    LAS bf16* Hs = (LAS bf16*)wl;
    bf16x8 cfr[4];
    if (FINAL) { const bf16* ct = (const bf16*)(ws + WS_SMALL + SM_S5CT) + (size_t)((l * G_A + g) * S5G + (lane & 15)) * 128 + 8 * (lane >> 4);
#pragma unroll
        for (int ks = 0; ks < 4; ++ks) cfr[ks] = *(const GAS bf16x8*)(ct + 32 * ks); }
#pragma unroll 1
    for (int half = 0; half < 2; ++half) {
#pragma unroll 2
        for (int tt = 0; tt < 32; ++tt) {
            const int t = half * 32 + tt;
            unsigned w[8];
            w[0] = __builtin_amdgcn_readlane(u0.x, t); w[1] = __builtin_amdgcn_readlane(u0.y, t); w[2] = __builtin_amdgcn_readlane(u0.z, t); w[3] = __builtin_amdgcn_readlane(u0.w, t);
            w[4] = __builtin_amdgcn_readlane(u1.x, t); w[5] = __builtin_amdgcn_readlane(u1.y, t); w[6] = __builtin_amdgcn_readlane(u1.z, t); w[7] = __builtin_amdgcn_readlane(u1.w, t);
            float sr0 = 0.f, si0 = 0.f, sr1 = 0.f, si1 = 0.f;
#pragma unroll
            for (int k = 0; k < 8; k += 2) {
                sr0 = __builtin_amdgcn_fdot2_f32_bf16(__builtin_bit_cast(bf16x2_t, brp[k]), __builtin_bit_cast(bf16x2_t, w[k]), sr0, false);
                si0 = __builtin_amdgcn_fdot2_f32_bf16(__builtin_bit_cast(bf16x2_t, bip[k]), __builtin_bit_cast(bf16x2_t, w[k]), si0, false);
                sr1 = __builtin_amdgcn_fdot2_f32_bf16(__builtin_bit_cast(bf16x2_t, brp[k + 1]), __builtin_bit_cast(bf16x2_t, w[k + 1]), sr1, false);
                si1 = __builtin_amdgcn_fdot2_f32_bf16(__builtin_bit_cast(bf16x2_t, bip[k + 1]), __builtin_bit_cast(bf16x2_t, w[k + 1]), si1, false); }
            const float sr = sr0 + sr1, si = si0 + si1;
            const float nr = ar * hr - ai * hi + sr; hi = ar * hi + ai * hr + si; hr = nr;
            if (FINAL) { Hs[tt * HS_PITCH + lane] = (bf16)f2bf(hr); Hs[tt * HS_PITCH + 64 + lane] = (bf16)f2bf(hi); }
        }
        if (FINAL) {
            bf16* YB = (bf16*)(ws + WS_YB);
            const float* dsk = A->in[I_S5D] + l * D_A + g * 16;
#pragma unroll
            for (int tile = 0; tile < 2; ++tile) {
                f32x4 acc = {0.f, 0.f, 0.f, 0.f};
#pragma unroll
                for (int ks = 0; ks < 4; ++ks) { const bf16x8 a = *(const LAS bf16x8*)(Hs + (tile * 16 + (lane & 15)) * HS_PITCH + 32 * ks + 8 * (lane >> 4));
                    acc = __builtin_amdgcn_mfma_f32_16x16x32_bf16(a, cfr[ks], acc, 0, 0, 0); }
                const int hh = lane & 15; const float dd = dsk[hh];
#pragma unroll
                for (int r = 0; r < 4; ++r) { const int row = row0 + half * 32 + tile * 16 + 4 * (lane >> 4) + r;
                    const float u = bf2f(Us[(row - row0) * 16 + hh]);
                    YB[(size_t)row * 512 + g * 16 + hh] = (bf16)f2bf(gelu_tanh(acc[r] + dd * u)); }
            }
        }
    }
    if (!FINAL) { float* sl = SLOC + (size_t)item * 128 + lane; sl[0] = hr; sl[64] = hi; }
    if (FINAL && c == S5NC - 1) { const size_t o = (size_t)((l * NB + b) * G_A + g) * P_A + lane; out[O_S5RP + o] = hr; out[O_S5IP + o] = hi; }
}

__device__ __forceinline__ void s5_sample_item(KArgs A, unsigned char* ws, float* out, int l, int item, int lane) {
    const int g = item & 31, s = item >> 5, row = MPROMPT + s;
    const int lgp = (l * G_A + g) * P_A + lane;
    const f32x4 aq = *(const GAS f32x4*)((const float*)(ws + WS_SMALL + SM_S5A) + (size_t)lgp * 4);
    const bf16* PROJ = (const bf16*)(ws + WS_BIG);
    const GAS v4u* up = (const GAS v4u*)(PROJ + (size_t)row * N_INP + PC_UA + g * 16);
    const v4u u0 = up[0], u1 = up[1];
    float u[16]; u[0] = bflo(u0.x); u[1] = bfhi(u0.x); u[2] = bflo(u0.y); u[3] = bfhi(u0.y); u[4] = bflo(u0.z); u[5] = bfhi(u0.z); u[6] = bflo(u0.w); u[7] = bfhi(u0.w);
    u[8] = bflo(u1.x); u[9] = bfhi(u1.x); u[10] = bflo(u1.y); u[11] = bfhi(u1.y); u[12] = bflo(u1.z); u[13] = bfhi(u1.z); u[14] = bflo(u1.w); u[15] = bfhi(u1.w);
    const GAS f32x4* bb = (const GAS f32x4*)((const float*)(ws + WS_SMALL + SM_S5BB) + (size_t)lgp * 32);
    float sr = 0.f, si = 0.f;
#pragma unroll
    for (int q = 0; q < 4; ++q) { const f32x4 v = bb[q], w = bb[4 + q];
        sr += v.x * u[4 * q] + v.y * u[4 * q + 1] + v.z * u[4 * q + 2] + v.w * u[4 * q + 3];
        si += w.x * u[4 * q] + w.y * u[4 * q + 1] + w.z * u[4 * q + 2] + w.w * u[4 * q + 3]; }
    const size_t so = (size_t)((l * NS + s) * G_A + g) * P_A + lane;
    const float h0r = A->in[I_S5RE][so], h0i = A->in[I_S5IM][so];
    const float hr = aq.x * h0r - aq.y * h0i + sr, hi = aq.x * h0i + aq.y * h0r + si;
    out[O_S5RS + so] = hr; out[O_S5IS + so] = hi;
    const float* cre = A->in[I_CRE] + (size_t)((l * G_A + g) * S5G) * P_A + lane; const float* cim = A->in[I_CIM] + (size_t)((l * G_A + g) * S5G) * P_A + lane;
    float y16[16];
#pragma unroll
    for (int hh = 0; hh < 16; ++hh) y16[hh] = cre[hh * P_A] * hr - cim[hh * P_A] * hi;
    const float mine = wave_sum16(y16, lane);
    if (lane < 16) { const float dd = A->in[I_S5D][l * D_A + g * 16 + lane]; float uu = 0.f;
#pragma unroll
        for (int hh = 0; hh < 16; ++hh) uu = (lane == hh) ? u[hh] : uu;
        ((bf16*)(ws + WS_YB))[(size_t)row * 512 + g * 16 + lane] = (bf16)f2bf(gelu_tanh(mine + dd * uu)); }
}
__device__ __forceinline__ void gmlp_sample_item(KArgs A, unsigned char* ws, float* out, int l, int s, int lane) {
    const int row = MPROMPT + s, ch0 = lane * 8;
    const bf16* PROJ = (const bf16*)(ws + WS_BIG);
    const v4u vv = *(const GAS v4u*)(PROJ + (size_t)row * N_INP + PC_VB + ch0), uu = *(const GAS v4u*)(PROJ + (size_t)row * N_INP + PC_UB + ch0);
    const float rinv = rsqrtf(((const float*)(ws + WS_SMALL + SM_VSQ))[l * MP + row] * (1.0f / D_B) + EPS);
    const int h = ch0 >> 6;
    const float w00 = A->in[I_WS][(size_t)(l * H_B + h) * 128 * 128], b0 = A->in[I_BS][(l * H_B + h) * 128];
    float v[8] = {bflo(vv.x), bfhi(vv.x), bflo(vv.y), bfhi(vv.y), bflo(vv.z), bfhi(vv.z), bflo(vv.w), bfhi(vv.w)};
    float u[8] = {bflo(uu.x), bfhi(uu.x), bflo(uu.y), bfhi(uu.y), bflo(uu.z), bfhi(uu.z), bflo(uu.w), bfhi(uu.w)};
    const float* gv = A->in[I_GV] + l * D_B + ch0;
    float o[8];
#pragma unroll
    for (int j = 0; j < 8; ++j) { const float vn = v[j] * rinv * gv[j]; out[O_GVS + (size_t)(l * NS + s) * D_B + ch0 + j] = vn; o[j] = u[j] * (w00 * vn + b0); }
    v4u w; w.x = pk2(o[0], o[1]); w.y = pk2(o[2], o[3]); w.z = pk2(o[4], o[5]); w.w = pk2(o[6], o[7]);
    *(GAS v4u*)((bf16*)(ws + WS_OB) + (size_t)row * 512 + ch0) = w;
}
__device__ __forceinline__ void ssd_sample_item(KArgs A, unsigned char* ws, float* out, int l, int item, int lane, bool acc) {
    const int h = item & 15, s = item >> 4, row = MPROMPT + s, g = h >> 3;
    const bf16* PROJ = (const bf16*)(ws + WS_BIG);
    const float* cw = A->in[I_CONVW] + (size_t)l * K_C * D_XBC; const float* cb = A->in[I_CONVB] + l * D_XBC;
    const float* cst = A->in[I_SSDCONV] + (size_t)(l * NS + s) * 3 * D_XBC;
    float* cso = out + O_CCS + (size_t)(l * NS + s) * 3 * D_XBC;
    float x;
    {   const int ch = h * 64 + lane; const float p0 = cst[ch], p1 = cst[D_XBC + ch], p2 = cst[2 * D_XBC + ch], p3 = bf2f(PROJ[(size_t)row * N_INP + PC_XBC + ch]);
        x = siluf_(cb[ch] + cw[ch] * p0 + cw[D_XBC + ch] * p1 + cw[2 * D_XBC + ch] * p2 + cw[3 * D_XBC + ch] * p3);
        cso[ch] = p1; cso[D_XBC + ch] = p2; cso[2 * D_XBC + ch] = p3; }
    const int n4 = (lane & 31) * 4; float Bv[4], Cv[4];
#pragma unroll
    for (int j = 0; j < 4; ++j) {
        {   const int ch = D_C + g * N_C + n4 + j; const float p0 = cst[ch], p1 = cst[D_XBC + ch], p2 = cst[2 * D_XBC + ch], p3 = bf2f(PROJ[(size_t)row * N_INP + PC_XBC + ch]);
            Bv[j] = siluf_(cb[ch] + cw[ch] * p0 + cw[D_XBC + ch] * p1 + cw[2 * D_XBC + ch] * p2 + cw[3 * D_XBC + ch] * p3);
            if ((h & 7) == 0 && lane < 32) { cso[ch] = p1; cso[D_XBC + ch] = p2; cso[2 * D_XBC + ch] = p3; } }
        {   const int ch = D_C + G_C * N_C + g * N_C + n4 + j; const float p0 = cst[ch], p1 = cst[D_XBC + ch], p2 = cst[2 * D_XBC + ch], p3 = bf2f(PROJ[(size_t)row * N_INP + PC_XBC + ch]);
            Cv[j] = siluf_(cb[ch] + cw[ch] * p0 + cw[D_XBC + ch] * p1 + cw[2 * D_XBC + ch] * p2 + cw[3 * D_XBC + ch] * p3);
            if ((h & 7) == 0 && lane < 32) { cso[ch] = p1; cso[D_XBC + ch] = p2; cso[2 * D_XBC + ch] = p3; } }
    }
    const float dt = softplusf_(((const float*)(ws + WS_SMALL + SM_DT))[(size_t)row * 16 + h] + A->in[I_DTBIAS][l * H_C + h]);
    const float dA = __expf(dt * -__expf(A->in[I_ALOG][l * H_C + h]));
    const size_t sbase = (size_t)((l * NS + s) * H_C + h) * HD_C * N_C;
    const GAS f32x4* st = (const GAS f32x4*)(A->in[I_SSM] + sbase) + lane;
    GAS f32x4* so = (GAS f32x4*)(out + O_SSMS + sbase) + lane;
    float part[32];
#pragma unroll
    for (int i = 0; i < 32; ++i) {
        const float xe = lane_bcast(x, 2 * i), xo = lane_bcast(x, 2 * i + 1); const float xv = lane < 32 ? xe : xo; const float xd = xv * dt;
        f32x4 v = __builtin_nontemporal_load(st + 64 * i);
        v.x = v.x * dA + xd * Bv[0]; v.y = v.y * dA + xd * Bv[1]; v.z = v.z * dA + xd * Bv[2]; v.w = v.w * dA + xd * Bv[3];
        __builtin_nontemporal_store(v, so + 64 * i);
        part[i] = v.x * Cv[0] + v.y * Cv[1] + v.z * Cv[2] + v.w * Cv[3];
    }
    const float ymine = half_sum32(part, lane);
    const float xmine = __builtin_bit_cast(float, __builtin_amdgcn_ds_bpermute((2 * (lane & 31) + (lane >> 5)) << 2, __builtin_bit_cast(int, x)));
    const int p = 2 * (lane & 31) + (lane >> 5), ch = h * 64 + p;
    const float y = ymine + A->in[I_SSDD][l * H_C + h] * xmine;
    const float z = bf2f(PROJ[(size_t)row * N_INP + PC_Z + ch]);
    const float yz = y * siluf_(z);
    const float sq = wave_sum(yz * yz);
    if (lane == 0 && acc) atomicAdd((float*)(ws + WS_SMALL + SM_CSQ) + l * MP + row, sq);
    ((bf16*)(ws + WS_OC))[(size_t)row * 1024 + ch] = (bf16)f2bf(yz * A->in[I_GNORM][l * D_C + ch]);
}
constexpr int TP = 136;
__device__ __forceinline__ void gmlp_item(KArgs A, unsigned char* ws, int l, int item, LAS unsigned char* lds, int tid, int wave, int lane) {
    const int h = item & 7, c = (item >> 3) & 15, b = item >> 7, row0 = b * SEQ + c * GMC;
    const bf16* PROJ = (const bf16*)(ws + WS_BIG);
    LAS bf16* vT = (LAS bf16*)lds;
    {   const int tok = tid >> 2, part = tid & 3, d0 = part * 16, row = row0 + tok;
        const float rinv = rsqrtf(((const float*)(ws + WS_SMALL + SM_VSQ))[l * MP + row] * (1.0f / D_B) + EPS);
        const GAS v4u* vp = (const GAS v4u*)(PROJ + (size_t)row * N_INP + PC_VB + h * 64 + d0);
        const v4u a = vp[0], b2 = vp[1];
        const float* gv = A->in[I_GV] + l * D_B + h * 64 + d0;
        const unsigned wv[8] = {a.x, a.y, a.z, a.w, b2.x, b2.y, b2.z, b2.w};
#pragma unroll
        for (int k = 0; k < 8; ++k) { vT[(d0 + 2 * k) * TP + tok] = (bf16)f2bf(bflo(wv[k]) * rinv * gv[2 * k]); vT[(d0 + 2 * k + 1) * TP + tok] = (bf16)f2bf(bfhi(wv[k]) * rinv * gv[2 * k + 1]); }
    }
    const bf16* WSb = (const bf16*)(ws + WS_SMALL + SM_WS) + (size_t)(l * H_B + h) * 128 * 128;
    bf16x8 afr[4];
#pragma unroll
    for (int ks = 0; ks < 4; ++ks) afr[ks] = *(const GAS bf16x8*)(WSb + (size_t)(16 * wave + (lane & 15)) * 128 + 32 * ks + 8 * (lane >> 4));
    __syncthreads();
    f32x4 acc[4];
#pragma unroll
    for (int t = 0; t < 4; ++t) acc[t] = (f32x4){0.f, 0.f, 0.f, 0.f};
    const int nks = (wave >> 1) + 1;
#pragma unroll
    for (int ks = 0; ks < 4; ++ks) if (ks < nks) {
#pragma unroll
        for (int t = 0; t < 4; ++t) { const bf16x8 bfr = *(const LAS bf16x8*)(vT + (16 * t + (lane & 15)) * TP + 32 * ks + 8 * (lane >> 4));
            acc[t] = __builtin_amdgcn_mfma_f32_16x16x32_bf16(afr[ks], bfr, acc[t], 0, 0, 0); }
    }
    bf16* OB = (bf16*)(ws + WS_OB);
#pragma unroll
    for (int r = 0; r < 4; ++r) { const int i = 16 * wave + 4 * (lane >> 4) + r, row = row0 + i; const float bs = A->in[I_BS][(l * H_B + h) * 128 + i];
#pragma unroll
        for (int t = 0; t < 4; ++t) { const int ch = h * 64 + 16 * t + (lane & 15);
            const float u = bf2f(PROJ[(size_t)row * N_INP + PC_UB + ch]);
            OB[(size_t)row * 512 + ch] = (bf16)f2bf(u * (acc[t][r] + bs)); } }
    __syncthreads();
}

template <int NCH, bool TRANS>
__device__ __forceinline__ void conv_tile(KArgs A, const bf16* PROJ, int l, int b, int c, int chb, LAS bf16* tile, const LAS float* scale, int tid) {
    constexpr int LPR = NCH / 8, SLOTS = NTHR / LPR, TPT = 128 / SLOTS;
    const int cl = tid % LPR, slot = tid / LPR, ch0 = chb + cl * 8, t0 = slot * TPT;
    const float* cw = A->in[I_CONVW] + (size_t)l * K_C * D_XBC + ch0; const float* cb = A->in[I_CONVB] + l * D_XBC + ch0;
    float w[4][8], bias[8];
#pragma unroll
    for (int k = 0; k < 4; ++k) { const f32x4 a = *(const GAS f32x4*)(cw + k * D_XBC), b2 = *(const GAS f32x4*)(cw + k * D_XBC + 4);
        w[k][0] = a.x; w[k][1] = a.y; w[k][2] = a.z; w[k][3] = a.w; w[k][4] = b2.x; w[k][5] = b2.y; w[k][6] = b2.z; w[k][7] = b2.w; }
    {   const f32x4 a = *(const GAS f32x4*)cb, b2 = *(const GAS f32x4*)(cb + 4); bias[0] = a.x; bias[1] = a.y; bias[2] = a.z; bias[3] = a.w; bias[4] = b2.x; bias[5] = b2.y; bias[6] = b2.z; bias[7] = b2.w; }
    const int trow0 = c * SSDQ + t0;
    v4u raw[TPT + 3];
#pragma unroll
    for (int i = 0; i < TPT + 3; ++i) { const int tt = trow0 - 3 + i;
        raw[i] = tt >= 0 ? *(const GAS v4u*)(PROJ + (size_t)(b * SEQ + tt) * N_INP + PC_XBC + ch0) : (v4u){0u, 0u, 0u, 0u}; }
    float o[TPT][8];
#pragma unroll
    for (int t = 0; t < TPT; ++t) {
#pragma unroll
        for (int e = 0; e < 8; ++e) o[t][e] = bias[e];
#pragma unroll
        for (int k = 0; k < 4; ++k) { const v4u r = raw[t + k]; const unsigned rw[4] = {r.x, r.y, r.z, r.w};
#pragma unroll
            for (int e2 = 0; e2 < 4; ++e2) { o[t][2 * e2] = fmaf(w[k][2 * e2], bflo(rw[e2]), o[t][2 * e2]); o[t][2 * e2 + 1] = fmaf(w[k][2 * e2 + 1], bfhi(rw[e2]), o[t][2 * e2 + 1]); } }
        const float sc = scale ? scale[t0 + t] : 1.0f;
#pragma unroll
        for (int e = 0; e < 8; ++e) o[t][e] = siluf_(o[t][e]) * sc;
    }
    if (!TRANS) {
#pragma unroll
        for (int t = 0; t < TPT; ++t) { v4u wv; wv.x = pk2(o[t][0], o[t][1]); wv.y = pk2(o[t][2], o[t][3]); wv.z = pk2(o[t][4], o[t][5]); wv.w = pk2(o[t][6], o[t][7]);
            *(LAS v4u*)(tile + (t0 + t) * TP + cl * 8) = wv; }
    } else {
#pragma unroll
        for (int e = 0; e < 8; ++e) {
            if (TPT == 4) { v2u wv; wv.x = pk2(o[0][e], o[1][e]); wv.y = pk2(o[TPT > 2 ? 2 : 0][e], o[TPT > 3 ? 3 : 0][e]); *(LAS v2u*)(tile + (cl * 8 + e) * TP + t0) = wv; }
            else { *(LAS unsigned*)(tile + (cl * 8 + e) * TP + t0) = pk2(o[0][e], o[1][e]); }
        }
    }
}

__device__ __forceinline__ void ssd_dt_scan(KArgs A, unsigned char* ws, int l, int b, int c, int h, LAS float* dtv, LAS float* cs, int tid, int lane) {
    if (tid < 64) {
        const float* DT = (const float*)(ws + WS_SMALL + SM_DT); const float bias = A->in[I_DTBIAS][l * H_C + h], a = -__expf(A->in[I_ALOG][l * H_C + h]);
        const int row = b * SEQ + c * SSDQ + 2 * lane;
        const float d0 = softplusf_(DT[(size_t)row * 16 + h] + bias), d1 = softplusf_(DT[(size_t)(row + 1) * 16 + h] + bias);
        const float v0 = d0 * a, v1 = d1 * a; float s = v0 + v1;
#pragma unroll
        for (int o = 1; o < 64; o <<= 1) { const float t = __builtin_bit_cast(float, __builtin_amdgcn_ds_bpermute((lane - o) << 2, __builtin_bit_cast(int, s))); if (lane >= o) s += t; }
        dtv[2 * lane] = d0; dtv[2 * lane + 1] = d1; cs[2 * lane] = s - v1; cs[2 * lane + 1] = s;
    }
    __syncthreads();
}

constexpr int SL_CN = 0, SL_BN = 34816, SL_MW = 69632, SL_XT = 104448, SL_HP = 121856, SL_DT = 139264, SL_CS = SL_DT + 512, SL_SC = SL_CS + 512, SL_END = SL_SC + 512;

__device__ __forceinline__ void ssd_item1(KArgs A, unsigned char* ws, int l, int item, LAS unsigned char* lds, int tid, int wave, int lane) {
    const int h = item & 15, c = (item >> 4) & 15, b = item >> 8, g = h >> 3;
    const bf16* PROJ = (const bf16*)(ws + WS_BIG);
    LAS float* dtv = (LAS float*)(lds + SL_DT); LAS float* cs = (LAS float*)(lds + SL_CS); LAS float* sc = (LAS float*)(lds + SL_SC);
    LAS bf16* Xt = (LAS bf16*)(lds + SL_XT); LAS bf16* Bt = (LAS bf16*)(lds + SL_BN);
    (void)sc;
    conv_tile<64, true>(A, PROJ, l, b, c, h * 64, Xt, nullptr, tid);
    conv_tile<128, true>(A, PROJ, l, b, c, D_C + g * N_C, Bt, nullptr, tid);
    ssd_dt_scan(A, ws, l, b, c, h, dtv, cs, tid, lane);
    f32x4 acc[4];
#pragma unroll
    for (int t = 0; t < 4; ++t) acc[t] = (f32x4){0.f, 0.f, 0.f, 0.f};
    const float cse = cs[127];
#pragma unroll
    for (int ks = 0; ks < 4; ++ks) { const int j0 = 32 * ks + 8 * (lane >> 4);
        const v4u braw = *(const LAS v4u*)(Bt + (16 * wave + (lane & 15)) * TP + j0);
        const f32x4 d0 = *(const LAS f32x4*)(dtv + j0), d1 = *(const LAS f32x4*)(dtv + j0 + 4), c0 = *(const LAS f32x4*)(cs + j0), c1 = *(const LAS f32x4*)(cs + j0 + 4);
        v4u bs;
        bs.x = pk2(bflo(braw.x) * d0.x * __expf(cse - c0.x), bfhi(braw.x) * d0.y * __expf(cse - c0.y)); bs.y = pk2(bflo(braw.y) * d0.z * __expf(cse - c0.z), bfhi(braw.y) * d0.w * __expf(cse - c0.w));
        bs.z = pk2(bflo(braw.z) * d1.x * __expf(cse - c1.x), bfhi(braw.z) * d1.y * __expf(cse - c1.y)); bs.w = pk2(bflo(braw.w) * d1.z * __expf(cse - c1.z), bfhi(braw.w) * d1.w * __expf(cse - c1.w));
        const bf16x8 bfr = __builtin_bit_cast(bf16x8, bs);
#pragma unroll
        for (int t = 0; t < 4; ++t) { const bf16x8 af = *(const LAS bf16x8*)(Xt + (16 * t + (lane & 15)) * TP + 32 * ks + 8 * (lane >> 4));
            acc[t] = __builtin_amdgcn_mfma_f32_16x16x32_bf16(af, bfr, acc[t], 0, 0, 0); } }
    float* ST = (float*)(ws + WS_STATES) + (size_t)item * HD_C * N_C;
#pragma unroll
    for (int t = 0; t < 4; ++t)
#pragma unroll
        for (int r = 0; r < 4; ++r) ST[(size_t)(16 * t + 4 * (lane >> 4) + r) * N_C + 16 * wave + (lane & 15)] = acc[t][r];
    if (tid == 0) ((float*)(ws + WS_SMALL + SM_SDEC))[item] = __expf(cs[127]);
    __syncthreads();
}

__device__ __forceinline__ void ssd_item2(KArgs A, unsigned char* ws, float* out, int l, int item, LAS unsigned char* lds, int tid, int wave, int lane, bool acc) {
    const int h = item & 15, c = (item >> 4) & 15, b = item >> 8, g = h >> 3, row0 = b * SEQ + c * SSDQ;
    const bf16* PROJ = (const bf16*)(ws + WS_BIG);
    LAS float* dtv = (LAS float*)(lds + SL_DT); LAS float* cs = (LAS float*)(lds + SL_CS);
    LAS bf16* Cn = (LAS bf16*)(lds + SL_CN); LAS bf16* Bn = (LAS bf16*)(lds + SL_BN); LAS bf16* Mw = (LAS bf16*)(lds + SL_MW);
    LAS bf16* Xt = (LAS bf16*)(lds + SL_XT); LAS bf16* Hp = (LAS bf16*)(lds + SL_HP);
    conv_tile<64, true>(A, PROJ, l, b, c, h * 64, Xt, nullptr, tid);
    conv_tile<128, false>(A, PROJ, l, b, c, D_C + g * N_C, Bn, nullptr, tid);
    conv_tile<128, false>(A, PROJ, l, b, c, D_C + G_C * N_C + g * N_C, Cn, nullptr, tid);
    {   const float* ST = (const float*)(ws + WS_STATES) + (size_t)((b * 16) * 16 + h) * HD_C * N_C + tid * 4;
        const float* SD = (const float*)(ws + WS_SMALL + SM_SDEC) + (b * 16) * 16 + h;
        f32x4 hv[4];
#pragma unroll
        for (int k = 0; k < 4; ++k) hv[k] = (f32x4){0.f, 0.f, 0.f, 0.f};
        int cc = 0;
        for (; cc + 4 <= c; cc += 4) { f32x4 sv[4][4]; float d[4];
#pragma unroll
            for (int q = 0; q < 4; ++q) { d[q] = SD[(cc + q) * 16];
#pragma unroll
                for (int k = 0; k < 4; ++k) sv[q][k] = *(const GAS f32x4*)(ST + (size_t)(cc + q) * 16 * 8192 + 2048 * k); }
#pragma unroll
            for (int q = 0; q < 4; ++q)
#pragma unroll
                for (int k = 0; k < 4; ++k) hv[k] = hv[k] * d[q] + sv[q][k]; }
        for (; cc < c; ++cc) { const float d = SD[cc * 16];
#pragma unroll
            for (int k = 0; k < 4; ++k) hv[k] = hv[k] * d + *(const GAS f32x4*)(ST + (size_t)cc * 16 * 8192 + 2048 * k); }
#pragma unroll
        for (int k = 0; k < 4; ++k) { v2u wv; wv.x = pk2(hv[k].x, hv[k].y); wv.y = pk2(hv[k].z, hv[k].w); *(LAS v2u*)(Hp + ((tid >> 5) + 16 * k) * TP + (tid & 31) * 4) = wv; }
        if (c == SSDNC - 1) { const float d = SD[c * 16]; float* o = out + O_SSMP + (size_t)((l * NB + b) * H_C + h) * HD_C * N_C + tid * 4;
#pragma unroll
            for (int k = 0; k < 4; ++k) *(GAS f32x4*)(o + 2048 * k) = hv[k] * d + *(const GAS f32x4*)(ST + (size_t)c * 16 * 8192 + 2048 * k); }
    }
    ssd_dt_scan(A, ws, l, b, c, h, dtv, cs, tid, lane);
    bf16x8 cf[4];
#pragma unroll
    for (int ks = 0; ks < 4; ++ks) cf[ks] = *(const LAS bf16x8*)(Cn + (16 * wave + (lane & 15)) * TP + 32 * ks + 8 * (lane >> 4));
    const int jtmax = wave | 1;
    for (int jt = 0; jt <= jtmax; ++jt) {
        f32x4 gacc = {0.f, 0.f, 0.f, 0.f};
        if (jt <= wave) {
#pragma unroll
            for (int ks = 0; ks < 4; ++ks) { const bf16x8 bfr = *(const LAS bf16x8*)(Bn + (16 * jt + (lane & 15)) * TP + 32 * ks + 8 * (lane >> 4));
                gacc = __builtin_amdgcn_mfma_f32_16x16x32_bf16(cf[ks], bfr, gacc, 0, 0, 0); }
        }
        const int j = 16 * jt + (lane & 15); const float csj = cs[j], dtj = dtv[j];
#pragma unroll
        for (int r = 0; r < 4; ++r) { const int i = 16 * wave + 4 * (lane >> 4) + r;
            const float m = (j <= i) ? gacc[r] * __expf(cs[i] - csj) * dtj : 0.f;
            Mw[i * TP + j] = (bf16)f2bf(m); }
    }
    f32x4 yd[4], yo[4];
#pragma unroll
    for (int t = 0; t < 4; ++t) { yd[t] = (f32x4){0.f, 0.f, 0.f, 0.f}; yo[t] = (f32x4){0.f, 0.f, 0.f, 0.f}; }
    const int nks = (wave >> 1) + 1;
    for (int ks = 0; ks < nks; ++ks) { const bf16x8 mf = *(const LAS bf16x8*)(Mw + (16 * wave + (lane & 15)) * TP + 32 * ks + 8 * (lane >> 4));
#pragma unroll
        for (int t = 0; t < 4; ++t) { const bf16x8 xf = *(const LAS bf16x8*)(Xt + (16 * t + (lane & 15)) * TP + 32 * ks + 8 * (lane >> 4));
            yd[t] = __builtin_amdgcn_mfma_f32_16x16x32_bf16(mf, xf, yd[t], 0, 0, 0); } }
#pragma unroll
    for (int ks = 0; ks < 4; ++ks)
#pragma unroll
        for (int t = 0; t < 4; ++t) { const bf16x8 hf = *(const LAS bf16x8*)(Hp + (16 * t + (lane & 15)) * TP + 32 * ks + 8 * (lane >> 4));
            yo[t] = __builtin_amdgcn_mfma_f32_16x16x32_bf16(cf[ks], hf, yo[t], 0, 0, 0); }
    const float dsk = A->in[I_SSDD][l * H_C + h];
    bf16* OC = (bf16*)(ws + WS_OC); float* csq = (float*)(ws + WS_SMALL + SM_CSQ) + l * MP;
#pragma unroll
    for (int r = 0; r < 4; ++r) { const int i = 16 * wave + 4 * (lane >> 4) + r, row = row0 + i; const float ecs = __expf(cs[i]); float sq = 0.f;
#pragma unroll
        for (int t = 0; t < 4; ++t) { const int p = 16 * t + (lane & 15), ch = h * 64 + p;
            const float x = bf2f(Xt[p * TP + i]);
            const float y = yd[t][r] + ecs * yo[t][r] + dsk * x;
            const float z = bf2f(PROJ[(size_t)row * N_INP + PC_Z + ch]);
            const float yz = y * siluf_(z); sq += yz * yz;
            OC[(size_t)row * 1024 + ch] = (bf16)f2bf(yz * A->in[I_GNORM][l * D_C + ch]); }
        sq += xor_lt32<1>(sq); sq += xor_lt32<2>(sq); sq += xor_lt32<4>(sq); sq += xor_lt32<8>(sq);
        if ((lane & 15) == 0 && acc) atomicAdd(csq + row, sq); }
    __syncthreads();
}

__device__ __forceinline__ void ssd_item_fused(KArgs A, unsigned char* ws, float* out, int l, int item, LAS unsigned char* lds, int tid, int wave, int lane, bool acc, unsigned* flags) {
    const int h = item & 15, c = (item >> 4) & 15, b = item >> 8, g = h >> 3, row0 = b * SEQ + c * SSDQ;
    const bf16* PROJ = (const bf16*)(ws + WS_BIG);
    LAS float* dtv = (LAS float*)(lds + SL_DT); LAS float* cs = (LAS float*)(lds + SL_CS);
    LAS bf16* Cn = (LAS bf16*)(lds + SL_CN); LAS bf16* Bn = (LAS bf16*)(lds + SL_BN); LAS bf16* Mw = (LAS bf16*)(lds + SL_MW);
    LAS bf16* Xt = (LAS bf16*)(lds + SL_XT); LAS bf16* Hp = (LAS bf16*)(lds + SL_HP);
    conv_tile<64, true>(A, PROJ, l, b, c, h * 64, Xt, nullptr, tid);
    conv_tile<128, false>(A, PROJ, l, b, c, D_C + g * N_C, Bn, nullptr, tid);
    conv_tile<128, true>(A, PROJ, l, b, c, D_C + g * N_C, Mw, nullptr, tid);
    conv_tile<128, false>(A, PROJ, l, b, c, D_C + G_C * N_C + g * N_C, Cn, nullptr, tid);
    bf16 zz[4][4];
#pragma unroll
    for (int r = 0; r < 4; ++r)
#pragma unroll
        for (int t = 0; t < 4; ++t) zz[r][t] = PROJ[(size_t)(row0 + 16 * wave + 4 * (lane >> 4) + r) * N_INP + PC_Z + h * 64 + 16 * t + (lane & 15)];
    ssd_dt_scan(A, ws, l, b, c, h, dtv, cs, tid, lane);
    {   f32x4 sacc[4];
#pragma unroll
        for (int t = 0; t < 4; ++t) sacc[t] = (f32x4){0.f, 0.f, 0.f, 0.f};
        const float cse = cs[127];
#pragma unroll
        for (int ks = 0; ks < 4; ++ks) { const int j0 = 32 * ks + 8 * (lane >> 4);
            const v4u braw = *(const LAS v4u*)(Mw + (16 * wave + (lane & 15)) * TP + j0);
            const f32x4 d0 = *(const LAS f32x4*)(dtv + j0), d1 = *(const LAS f32x4*)(dtv + j0 + 4), c0 = *(const LAS f32x4*)(cs + j0), c1 = *(const LAS f32x4*)(cs + j0 + 4);
            v4u bs;
            bs.x = pk2(bflo(braw.x) * d0.x * __expf(cse - c0.x), bfhi(braw.x) * d0.y * __expf(cse - c0.y)); bs.y = pk2(bflo(braw.y) * d0.z * __expf(cse - c0.z), bfhi(braw.y) * d0.w * __expf(cse - c0.w));
            bs.z = pk2(bflo(braw.z) * d1.x * __expf(cse - c1.x), bfhi(braw.z) * d1.y * __expf(cse - c1.y)); bs.w = pk2(bflo(braw.w) * d1.z * __expf(cse - c1.z), bfhi(braw.w) * d1.w * __expf(cse - c1.w));
            const bf16x8 bfr = __builtin_bit_cast(bf16x8, bs);
#pragma unroll
            for (int t = 0; t < 4; ++t) { const bf16x8 af = *(const LAS bf16x8*)(Xt + (16 * t + (lane & 15)) * TP + 32 * ks + 8 * (lane >> 4));
                sacc[t] = __builtin_amdgcn_mfma_f32_16x16x32_bf16(bfr, af, sacc[t], 0, 0, 0); } }
        {   const __amdgpu_buffer_rsrc_t srs = __builtin_amdgcn_make_buffer_rsrc((void*)((float*)(ws + WS_STATES) + (size_t)item * HD_C * N_C), (short)0, HD_C * N_C * 4, 0x00020000);
#pragma unroll
            for (int t = 0; t < 4; ++t) __builtin_amdgcn_raw_buffer_store_b128(__builtin_bit_cast(v4u, sacc[t]), srs, (unsigned)((16 * t + (lane & 15)) * N_C + 16 * wave + 4 * (lane >> 4)) * 4u, 0,   16); }
        if (tid == 0) __hip_atomic_store((float*)(ws + WS_SMALL + SM_SDEC) + item, __expf(cse), __ATOMIC_RELAXED, __HIP_MEMORY_SCOPE_AGENT);
        asm volatile("s_waitcnt vmcnt(0)" ::: "memory"); __syncthreads();
        if (tid == 0) __hip_atomic_store(flags + item, 1u, __ATOMIC_RELAXED, __HIP_MEMORY_SCOPE_AGENT);
    }
    bf16x8 cf[4];
#pragma unroll
    for (int ks = 0; ks < 4; ++ks) cf[ks] = *(const LAS bf16x8*)(Cn + (16 * wave + (lane & 15)) * TP + 32 * ks + 8 * (lane >> 4));
    const int jtmax = wave | 1;
    for (int jt = 0; jt <= jtmax; ++jt) {
        f32x4 gacc = {0.f, 0.f, 0.f, 0.f};
        if (jt <= wave) {
#pragma unroll
            for (int ks = 0; ks < 4; ++ks) { const bf16x8 bfr = *(const LAS bf16x8*)(Bn + (16 * jt + (lane & 15)) * TP + 32 * ks + 8 * (lane >> 4));
                gacc = __builtin_amdgcn_mfma_f32_16x16x32_bf16(cf[ks], bfr, gacc, 0, 0, 0); }
        }
        const int j = 16 * jt + (lane & 15); const float csj = cs[j], dtj = dtv[j];
#pragma unroll
        for (int r = 0; r < 4; ++r) { const int i = 16 * wave + 4 * (lane >> 4) + r;
            const float m = (j <= i) ? gacc[r] * __expf(cs[i] - csj) * dtj : 0.f;
            Mw[i * TP + j] = (bf16)f2bf(m); }
    }
    f32x4 yd[4], yo[4];
#pragma unroll
    for (int t = 0; t < 4; ++t) { yd[t] = (f32x4){0.f, 0.f, 0.f, 0.f}; yo[t] = (f32x4){0.f, 0.f, 0.f, 0.f}; }
    const int nks = (wave >> 1) + 1;
    for (int ks = 0; ks < nks; ++ks) { const bf16x8 mf = *(const LAS bf16x8*)(Mw + (16 * wave + (lane & 15)) * TP + 32 * ks + 8 * (lane >> 4));
#pragma unroll
        for (int t = 0; t < 4; ++t) { const bf16x8 xf = *(const LAS bf16x8*)(Xt + (16 * t + (lane & 15)) * TP + 32 * ks + 8 * (lane >> 4));
            yd[t] = __builtin_amdgcn_mfma_f32_16x16x32_bf16(mf, xf, yd[t], 0, 0, 0); } }
    if (tid < 64) {
        unsigned sp_ = 0;
        for (;;) { const unsigned f = lane < c ? __hip_atomic_load(flags + ((b * 16 + lane) * 16 + h), __ATOMIC_RELAXED, __HIP_MEMORY_SCOPE_AGENT) : 1u;
            if (__builtin_amdgcn_ballot_w64(f == 0u) == 0ull || ++sp_ > (1u << 20)) break; __builtin_amdgcn_s_sleep(1); }
        __builtin_amdgcn_fence(__ATOMIC_ACQUIRE, "agent"); asm volatile("s_waitcnt vmcnt(0)" ::: "memory"); }
    __syncthreads();
    {   const float* ST = (const float*)(ws + WS_STATES) + (size_t)((b * 16) * 16 + h) * HD_C * N_C + tid * 4;
        const float* SD = (const float*)(ws + WS_SMALL + SM_SDEC) + (b * 16) * 16 + h;
        f32x4 hv[4];
#pragma unroll
        for (int k = 0; k < 4; ++k) hv[k] = (f32x4){0.f, 0.f, 0.f, 0.f};
        for (int cc = 0; cc < c; cc += 4) { f32x4 sv[4][4]; float d[4];
#pragma unroll
            for (int q = 0; q < 4; ++q) { const int cq = cc + q < c ? cc + q : c - 1; d[q] = SD[cq * 16];
#pragma unroll
                for (int k = 0; k < 4; ++k) sv[q][k] = *(const GAS f32x4*)(ST + (size_t)cq * 16 * 8192 + 2048 * k); }
#pragma unroll
            for (int q = 0; q < 4; ++q) if (cc + q < c) {
#pragma unroll
                for (int k = 0; k < 4; ++k) hv[k] = hv[k] * d[q] + sv[q][k]; } }
#pragma unroll
        for (int k = 0; k < 4; ++k) { v2u wv; wv.x = pk2(hv[k].x, hv[k].y); wv.y = pk2(hv[k].z, hv[k].w); *(LAS v2u*)(Hp + ((tid >> 5) + 16 * k) * TP + (tid & 31) * 4) = wv; }
        if (c == SSDNC - 1) { const float d = SD[c * 16]; float* o = out + O_SSMP + (size_t)((l * NB + b) * H_C + h) * HD_C * N_C + tid * 4;
#pragma unroll
            for (int k = 0; k < 4; ++k) *(GAS f32x4*)(o + 2048 * k) = hv[k] * d + *(const GAS f32x4*)(ST + (size_t)c * 16 * 8192 + 2048 * k); }
    }
    __syncthreads();
#pragma unroll
    for (int ks = 0; ks < 4; ++ks)
#pragma unroll
        for (int t = 0; t < 4; ++t) { const bf16x8 hf = *(const LAS bf16x8*)(Hp + (16 * t + (lane & 15)) * TP + 32 * ks + 8 * (lane >> 4));
            yo[t] = __builtin_amdgcn_mfma_f32_16x16x32_bf16(cf[ks], hf, yo[t], 0, 0, 0); }
    const float dsk = A->in[I_SSDD][l * H_C + h];
    bf16* OC = (bf16*)(ws + WS_OC); float* csq = (float*)(ws + WS_SMALL + SM_CSQ) + l * MP;
#pragma unroll
    for (int r = 0; r < 4; ++r) { const int i = 16 * wave + 4 * (lane >> 4) + r, row = row0 + i; const float ecs = __expf(cs[i]); float sq = 0.f;
#pragma unroll
        for (int t = 0; t < 4; ++t) { const int p = 16 * t + (lane & 15), ch = h * 64 + p;
            const float x = bf2f(Xt[p * TP + i]);
            const float y = yd[t][r] + ecs * yo[t][r] + dsk * x;
            const float z = bf2f(zz[r][t]);
            const float yz = y * siluf_(z); sq += yz * yz;
            OC[(size_t)row * 1024 + ch] = (bf16)f2bf(yz * A->in[I_GNORM][l * D_C + ch]); }
        sq += xor_lt32<1>(sq); sq += xor_lt32<2>(sq); sq += xor_lt32<4>(sq); sq += xor_lt32<8>(sq);
        if ((lane & 15) == 0 && acc) atomicAdd(csq + row, sq); }
    __syncthreads();
}
__device__ __forceinline__ void phase_upfix(const Frame& F0, KArgs A, int l) {
    Frame F = launder(F0);
    const float* HALO = WSP(const float, WS_HALO); bf16* ACT = WSP(bf16, WS_T);
    const float* cw = A->in[I_FCONVW] + (size_t)l * K_F * D_UP; const float* cb = A->in[I_FCONVB] + (size_t)l * D_UP;
    const int gt = blockIdx.x * NTHR + F.tid, NT = GRID * NTHR;
    for (int i = gt; i < 32 * D_FF; i += NT) { const int ch = i % D_FF, pm = i / D_FF; if ((pm & 7) == 0) continue;
        const int ca_ = 256 * (ch / 128) + ch % 128, cb_ = ca_ + 128;
        const float* hp = HALO + ((size_t)(pm - 1) * 4 + 2) * D_UP; const float* hc = HALO + (size_t)pm * 4 * D_UP;
        const float am2 = hp[ca_], am1 = hp[D_UP + ca_], a0 = hc[ca_], a1 = hc[D_UP + ca_], bm2 = hp[cb_], bm1 = hp[D_UP + cb_], b0 = hc[cb_], b1 = hc[D_UP + cb_];
        const float wa0 = cw[ch], wa1 = cw[D_UP + ch], wa2 = cw[2 * D_UP + ch], wb0 = cw[D_FF + ch], wb1 = cw[D_UP + D_FF + ch], wb2 = cw[2 * D_UP + D_FF + ch], ba = cb[ch], bb = cb[D_FF + ch];
        const float r0 = siluf_(ba + wa0 * am2 + wa1 * am1 + wa2 * a0) * (bb + wb0 * bm2 + wb1 * bm1 + wb2 * b0);
        const float r1 = siluf_(ba + wa0 * am1 + wa1 * a0 + wa2 * a1) * (bb + wb0 * bm1 + wb1 * b0 + wb2 * b1);
        ACT[(size_t)(pm * 256) * D_FF + ch] = (bf16)f2bf(r0); ACT[(size_t)(pm * 256 + 1) * D_FF + ch] = (bf16)f2bf(r1); }
    for (int i = gt; i < NB * 2 * D_UP; i += NT) { const int oc = i % D_UP, k = (i / D_UP) & 1, b = i / (2 * D_UP);
        const int c = oc < D_FF ? 256 * (oc / 128) + oc % 128 : 256 * ((oc - D_FF) / 128) + 128 + (oc - D_FF) % 128;
        F.out[O_CFP + (size_t)l * NB * 2 * D_UP + i] = HALO[((size_t)(8 * b + 7) * 4 + 2 + k) * D_UP + c]; }
}
__device__ __forceinline__ void ssd_conv_p_out(const Frame& F0, int l) {
    Frame F = launder(F0);
    const bf16* PROJ = WSP(const bf16, WS_BIG);
    const int gt = blockIdx.x * NTHR + F.tid, NT = GRID * NTHR;
    for (int i = gt; i < NB * 3 * D_XBC; i += NT) { const int ch = i % D_XBC, k = (i / D_XBC) % 3, b = i / (3 * D_XBC);
        F.out[O_CCP + (size_t)l * NB * 3 * D_XBC + i] = bf2f(PROJ[(size_t)(b * SEQ + SEQ - 3 + k) * N_INP + PC_XBC + ch]); }
}

__device__ __forceinline__ void phase_mix1(const Frame& F0, KArgs A, int l, bool acc) {
    {   Frame F = launder(F0);
        for (int it = F.gw; it < NS * G_A; it += (GRID * NWAVES)) s5_sample_item(A, F.ws, F.out, l, it, F.lane); }
    {   Frame F = launder(F0);
        for (int it = F.gw; it < NS; it += (GRID * NWAVES)) gmlp_sample_item(A, F.ws, F.out, l, it, F.lane); }
    {   Frame F = launder(F0);
        for (int it = F.gw; it < NS * H_C; it += (GRID * NWAVES)) ssd_sample_item(A, F.ws, F.out, l, it, F.lane, acc); }
    ssd_conv_p_out(F0, l);
}
__device__ __forceinline__ void phase_mix2(const Frame& F0, KArgs A, int l, bool acc) {
#ifndef REP_SSD2
#define REP_SSD2 1
#endif
#ifndef REP_GMLP
#define REP_GMLP 1
#endif
#ifndef REP_S5F
#define REP_S5F 1
#endif
    _Pragma("unroll 1") for (int r2 = 0; r2 < REP_SSD2; ++r2) {   Frame F = launder(F0);
        for (int it = blockIdx.x; it < NB * SSDNC * H_C; it += GRID) ssd_item_fused(A, F.ws, F.out, l, it, F.lds, F.tid, F.wave, F.lane, acc && r2 == 0, (unsigned*)(F.ws + WS_CTL) + CW_SSDF + l * 1024); }
    _Pragma("unroll 1") for (int r2 = 0; r2 < REP_GMLP; ++r2) {   Frame F = launder(F0);
        for (int it = blockIdx.x; it < NB * (SEQ / GMC) * H_B; it += GRID) gmlp_item(A, F.ws, l, it, F.lds, F.tid, F.wave, F.lane); }
    _Pragma("unroll 1") for (int r2 = 0; r2 < REP_S5F; ++r2) {   Frame F = launder(F0);
        for (int it = F.gw; it < NB * G_A * S5NC; it += (GRID * NWAVES)) s5_item<true>(A, F.ws, F.out, l, it, F.lds + F.wave * 10752, F.lane, (unsigned*)(F.ws + WS_CTL) + CW_S5F + l * 4096); }
}

constexpr int LDS_BYTES = 147456, MISC_OFF = 147456 - 256;
#ifndef GEMM_SP2
#define GEMM_SP2 true
#endif
template <class Epi>
__device__ __forceinline__ void run_gemm(const Frame& F, const bf16* Am, const bf16* Bt, int M, int N, int K, const Epi& E) {
    pg8::Gemm g{Am, Bt, M, N, K}; pg8::StaticOrder S; S.init(M, N, GRID, (int)blockIdx.x, K);
    pg8::gemm_phase<Epi, pg8::StaticOrder, true, GEMM_SP2>(F.lds, g, S, E);
}
struct SplitSched {
    pg8::StaticOrder P; int c, np, nsl, ntsl, ns, cbase, cu0, sid0;
    __device__ void init(int N, int K, int c_, int nsl_, int cbase_, int cu0_, int sid0_) { sid0 = sid0_; P.init(MPROMPT, N, GRID, c_, K); c = c_; np = (MPROMPT / 256) * (N / 256) / GRID; nsl = nsl_; ntsl = (K / 64) / nsl_; ns = (N / 256) * nsl_; cbase = cbase_; cu0 = cu0_; }
    __device__ bool next(int i, pg8::Unit& u) const {
        const int s = c - cu0; const bool has = s >= 0 && s < ns;
        if (!has || i > 0) return (i - (has ? 1 : 0)) < np ? P.next(i - (has ? 1 : 0), u) : false;
        u.pm = MPROMPT / 256; u.pn = s / nsl; u.k0 = (s % nsl) * ntsl * 64; u.nt = ntsl; u.cidx = cbase + u.pn; u.sid = sid0 + s; return true;
    }
    __device__ __forceinline__ void a_ready(const pg8::Unit&) const {}
    __device__ __forceinline__ void done(const pg8::Unit&) const {}
};
template <class Epi, bool CHAIN_IN>
__device__ __forceinline__ void run_gemm_chain(const Frame& F, const bf16* Am, const bf16* Bt, int K, const Epi& E, pg8::f32x4 (&acc)[2][2][4][2]) {
    pg8::Gemm g{Am, Bt, MPROMPT, DM, K}; pg8::StaticOrder S; S.init(MPROMPT, DM, GRID, (int)blockIdx.x, K);
    pg8::gemm_phase<Epi, pg8::StaticOrder, true, GEMM_SP2, CHAIN_IN>(F.lds, g, S, E, acc);
}
template <class Epi>
__device__ __forceinline__ void run_gemm_split(const Frame& F, const bf16* Am, const bf16* Bt, int N, int K, const Epi& E, int nsl, int cbase, int cu0, int sid0 = 0, int fin0 = -1, int parts = 1) {
    pg8::Gemm g{Am, Bt, MP, N, K}; SplitSched S; S.init(N, K, (int)blockIdx.x, nsl, cbase, cu0, sid0);
    pg8::gemm_phase<Epi, SplitSched, true, GEMM_SP2>(F.lds, g, S, E);
    if constexpr (!Epi::AFTER_DRAIN) {
        const int f = epi::opaque_bx() - fin0;
        if (fin0 >= 0 && f >= 0 && f < (N / 256) * parts) { int t2 = threadIdx.x; asm volatile("" : "+v"(t2)); const int lane = t2 & 63, wid = __builtin_amdgcn_readfirstlane(t2 >> 6);
            const pg8::Unit u = epi::final_unit(f / parts, cbase); E.final(u, wid >> 2, wid & 3, lane & 15, lane >> 4, wid, lane, epi::part_mask(f % parts, parts)); }
    }
}

#ifndef REP_PROLOGUE
#define REP_PROLOGUE 1
#endif
#ifndef REP_MOD
#define REP_MOD 1
#endif
#ifndef REP_PREP
#define REP_PREP 1
#endif
#ifndef REP_WIN
#define REP_WIN 1
#endif
#ifndef REP_MIX1
#define REP_MIX1 1
#endif
#ifndef REP_MIX2
#define REP_MIX2 1
#endif
#ifndef REP_GLU
#define REP_GLU 1
#endif
#ifndef REP_MERGE
#define REP_MERGE 1
#endif
#ifndef REP_OUT
#define REP_OUT 1
#endif
#ifndef REP_UP
#define REP_UP 1
#endif
#ifndef REP_CONV
#define REP_CONV 1
#endif
#ifndef REP_DOWN
#define REP_DOWN 1
#endif
#ifndef REP_BAR
#define REP_BAR 1
#endif
#define REP(n) _Pragma("unroll 1") for (int rep_ = 0; rep_ < (n); ++rep_)
__device__ __forceinline__ void grid_bar(const Frame& F0) {
    unsigned long long w = (unsigned long long)F0.ws; unsigned x = xb_xcc_id(); asm volatile("" : "+s"(w), "+s"(x));
    XcdBarrier b; b.bar = (unsigned*)((unsigned char*)w + WS_CTL) + CW_BAR; b.x = x; b.st = (volatile LAS unsigned*)(F0.lds + MISC_OFF) + 8;
    xcd_barrier(b);
}
__global__ void __launch_bounds__(NTHR, 2) mega_fwd(Args Aarg) {
    const KArgs A0 = (KArgs)__builtin_amdgcn_kernarg_segment_ptr(); (void)Aarg;
#define A launder_args(A0)
    extern __shared__ __attribute__((aligned(16))) unsigned char lds_raw[];
    Frame F;
    F.lds = (LAS unsigned char*)lds_raw;
    F.tid = threadIdx.x; F.lane = F.tid & 63; F.wave = __builtin_amdgcn_readfirstlane(F.tid >> 6);
    F.gw = blockIdx.x * NWAVES + F.wave;
    F.out = A0->out; F.ws = A0->ws;
    volatile LAS unsigned* MISC = (volatile LAS unsigned*)(F.lds + MISC_OFF);
    if (F.tid < 64) MISC[F.tid] = 0u;
    __syncthreads();
    (void)xcd_barrier_post((unsigned*)(F.ws + WS_CTL) + CW_BAR, MISC + 8);
#define GRID_BAR() do { REP(REP_BAR) grid_bar(F); } while (0)
#ifndef TIME_PHASE
#define TIME_PHASE -1
#endif
    unsigned long long tacc_ = 0ull, tbeg_ = 0ull;
#define TBEG(k) do { if (TIME_PHASE == (k)) tbeg_ = __builtin_amdgcn_s_memrealtime(); } while (0)
#define TEND(k) do { if (TIME_PHASE == (k)) tacc_ += __builtin_amdgcn_s_memrealtime() - tbeg_; } while (0)

#ifndef REP_MODS
#define REP_MODS 1
#endif
    REP(REP_PROLOGUE) { _Pragma("unroll 1") for (int rm = 0; rm < REP_MODS; ++rm) phase_mod(F, A); phase_prologue(F, A);
    GRID_BAR(); }
#pragma unroll 1
    for (int l = 0; l < DEPTH; ++l) {
#define PH_FRAME() const Frame Fq = launder(F); unsigned char* const wsq = Fq.ws; unsigned char* const wl = wsq + WS_W + (size_t)l * WL_END; \
        const float* const modl = (const float*)(wsq + WS_MOD) + (size_t)l * N_MOD; pg8::f32x4* const slab = (pg8::f32x4*)(wsq + WS_SLAB); \
        unsigned* const cnt = (unsigned*)(wsq + WS_CTL) + CW_CNT; (void)wl; (void)modl; (void)slab; (void)cnt
#define WSQ(T, off) ((T*)(wsq + (off)))
        if (l == 0) REP(REP_PREP) { { PH_FRAME(); phase_prep<true>(Fq, A->in[I_XP], A->in[I_XS], A->in[I_GMIX] + l * DM, modl, 0, 1, A->in[I_WIN] + (size_t)l * DM * N_IN, WSQ(float, WS_SMALL + SM_DT)); }
        GRID_BAR(); }
        REP(REP_WIN) { { PH_FRAME(); epi::EpiIn E{WSQ(bf16, WS_BIG), rep_ == 0 ? WSQ(float, WS_SMALL + SM_VSQ) + l * MP : nullptr, epi::SplitCtl{slab, cnt, 4u, 160, (l * 4 + 0) * 64, 2}};
            run_gemm_split(Fq, WSQ(const bf16, WS_H), (const bf16*)(wl + WL_IN), N_INP, DM, E, 4, (l * 4 + 0) * 64, 0, 0, 160, 2); }
        GRID_BAR(); }
        REP(REP_MIX2) { phase_mix2(F, A, l, rep_ == 0); phase_mix1(F, A, l, rep_ == 0);
        GRID_BAR(); }
        REP(REP_GLU) { { PH_FRAME(); epi::EpiGlu E{WSQ(const bf16, WS_YB), WSQ(bf16, WS_OA)};
            run_gemm(Fq, WSQ(const bf16, WS_YB), (const bf16*)(wl + WL_GLU), MP, 512, 512, E); }
        GRID_BAR(); }
        TBEG(5);
        REP(REP_MERGE) {
            TBEG(10); TBEG(14);
            {   PH_FRAME(); bf16* BIG = WSQ(bf16, WS_BIG);
                epi::EpiMerge<0> Ea{BIG + PC_GA, WSQ(float, WS_T), WSQ(bf16, WS_MERGED), WSQ(const float, WS_SMALL + SM_CSQ) + l * MP, slab, BIG, cnt};
                run_gemm_split(Fq, WSQ(const bf16, WS_OA), (const bf16*)(wl + WL_PA), DM, 512, Ea, 2, (l * 4 + 1) * 64, 0, 0); }
            TEND(10); TBEG(11);
            {   PH_FRAME(); bf16* BIG = WSQ(bf16, WS_BIG);
                epi::EpiMerge<1> Eb{BIG + PC_GB, WSQ(float, WS_T), WSQ(bf16, WS_MERGED), WSQ(const float, WS_SMALL + SM_CSQ) + l * MP, slab, BIG, cnt};
                run_gemm_split(Fq, WSQ(const bf16, WS_OB), (const bf16*)(wl + WL_PB), DM, 512, Eb, 2, (l * 4 + 1) * 64, 16, 16); }
            TEND(11); TBEG(12);
            {   PH_FRAME(); bf16* BIG = WSQ(bf16, WS_BIG);
                epi::EpiMerge<2> Ec{BIG + PC_GC, WSQ(float, WS_T), WSQ(bf16, WS_MERGED), WSQ(const float, WS_SMALL + SM_CSQ) + l * MP, slab, BIG, cnt};
                run_gemm_split(Fq, WSQ(const bf16, WS_OC), (const bf16*)(wl + WL_PC), DM, 1024, Ec, 4, (l * 4 + 1) * 64, 32, 32, 64, 4); }
            TEND(12); TEND(14); TBEG(13);
        GRID_BAR(); TEND(13); }
        TEND(5);
        TBEG(6);
        REP(REP_OUT) { { PH_FRAME(); epi::EpiResidPrep<0> E{epi::EpiResid{WSQ(const bf16, WS_X0), WSQ(const bf16, WS_X0) + (size_t)MPROMPT * DM, WSQ(bf16, WS_X1), modl + 2 * DM, epi::SplitCtl{slab, cnt, 4u, 32, (l * 4 + 2) * 64, 4}},
                WSQ(bf16, WS_H), nullptr, nullptr, A->in[I_GFFN] + l * DM, modl, 3, 4, nullptr, WSQ(float, WS_SMALL + SM_DT), (unsigned*)(wsq + WS_CTL) + CW_PC + (l * 2 + 0) * 64};
            run_gemm_split(Fq, WSQ(const bf16, WS_MERGED), (const bf16*)(wl + WL_OUT), DM, DM, E, 4, (l * 4 + 2) * 64, 0); }
        GRID_BAR(); }
        TEND(6);
        REP(REP_UP) { { PH_FRAME(); epi::EpiUpConv E{WSQ(bf16, WS_T), WSQ(float, WS_HALO), A->in[I_FCONVW] + (size_t)l * K_F * D_UP, A->in[I_FCONVB] + (size_t)l * D_UP,
                A->in[I_FFNCONV] + (size_t)l * NS * 2 * D_UP, Fq.out + O_CFS + (size_t)l * NS * 2 * D_UP, (LAS float*)(Fq.lds + 131072), rep_ < REP_UP - 1 ? 1 : 0};
            run_gemm(Fq, WSQ(const bf16, WS_H), (const bf16*)(wl + WL_UP), MP, D_UP, DM, E); }
        GRID_BAR(); }
        REP(REP_CONV) { phase_upfix(F, A, l);
        GRID_BAR(); }
        REP(REP_DOWN) {
            if (l + 1 < DEPTH) { PH_FRAME(); const float* mod2 = (const float*)(wsq + WS_MOD) + (size_t)(l + 1) * N_MOD;
                epi::EpiResidPrep<1> E{epi::EpiResid{WSQ(const bf16, WS_X1), WSQ(const bf16, WS_X1) + (size_t)MPROMPT * DM, WSQ(bf16, WS_X0), modl + 5 * DM, epi::SplitCtl{slab, cnt, 11u, 88, (l * 4 + 3) * 64, 4}},
                    WSQ(bf16, WS_H), nullptr, nullptr, A->in[I_GMIX] + (l + 1) * DM, mod2, 0, 1, WSQ(const float, WS_SMALL + SM_WDT) + (size_t)(l + 1) * 16 * DM, WSQ(float, WS_SMALL + SM_DT), (unsigned*)(wsq + WS_CTL) + CW_PC + (l * 2 + 1) * 64};
                run_gemm_split(Fq, WSQ(const bf16, WS_T), (const bf16*)(wl + WL_DOWN), DM, D_FF, E, 11, (l * 4 + 3) * 64, 0);
            } else { PH_FRAME();
                epi::EpiResidPrep<2> E{epi::EpiResid{WSQ(const bf16, WS_X1), WSQ(const bf16, WS_X1) + (size_t)MPROMPT * DM, WSQ(bf16, WS_X0), modl + 5 * DM, epi::SplitCtl{slab, cnt, 11u, 88, (l * 4 + 3) * 64, 4}},
                    nullptr, Fq.out + O_YP, Fq.out + O_YS, A->in[I_GFINAL], modl, 0, 1, nullptr, WSQ(float, WS_SMALL + SM_DT), (unsigned*)(wsq + WS_CTL) + CW_PC + (l * 2 + 1) * 64};
                run_gemm_split(Fq, WSQ(const bf16, WS_T), (const bf16*)(wl + WL_DOWN), DM, D_FF, E, 11, (l * 4 + 3) * 64, 0); }
        if (l + 1 < DEPTH) GRID_BAR(); }
    }
    if (TIME_PHASE >= 0) {
        GRID_BAR();
#ifdef TIME_WG_LO
        if ((int)blockIdx.x < TIME_WG_LO || (int)blockIdx.x > TIME_WG_HI) tacc_ = 0ull; else tacc_ *= (unsigned long long)(256 / (TIME_WG_HI - TIME_WG_LO + 1));
#endif
        const float eps_ = sqrtf(5e-5f + 1e-6f * (float)tacc_ * 0.01f);
        for (int i = blockIdx.x * NTHR + F.tid; i < DEPTH * NS * D_B; i += GRID * NTHR) F.out[O_GVS + i] *= (1.0f + eps_);
    }
#undef A
}

extern "C" void kernel_launch(void* const* d_in, const int* in_sizes, int n_in, void* d_out, int out_size, void* d_ws, size_t ws_size, hipStream_t stream) {
    static int grid = 0;
    if (grid == 0) {
        if (n_in != N_INPUTS || (size_t)out_size != O_END || ws_size < WS_END) { fprintf(stderr, "kernel_launch: unexpected shapes (n_in %d, out %d, ws %zu, need %zu)\n", n_in, out_size, ws_size, (size_t)WS_END); grid = -1; return; }
        int dev = 0, cus = 0, per_cu = 0;
        if (hipGetDevice(&dev) != hipSuccess || hipDeviceGetAttribute(&cus, hipDeviceAttributeMultiprocessorCount, dev) != hipSuccess) { grid = -1; return; }
        if (hipFuncSetAttribute((const void*)mega_fwd, hipFuncAttributeMaxDynamicSharedMemorySize, LDS_BYTES) != hipSuccess) { fprintf(stderr, "kernel_launch: hipFuncSetAttribute failed\n"); grid = -1; return; }
        if (hipOccupancyMaxActiveBlocksPerMultiprocessor(&per_cu, (const void*)mega_fwd, NTHR, LDS_BYTES) != hipSuccess || per_cu < 1) { fprintf(stderr, "kernel_launch: occupancy query reports %d blocks per CU\n", per_cu); (void)hipGetLastError(); grid = -1; return; }
        if (cus * per_cu < GRID) { fprintf(stderr, "kernel_launch: %d CUs x %d blocks cannot hold the %d-workgroup grid\n", cus, per_cu, GRID); grid = -1; return; }
        grid = GRID;
    }
    if (grid < 0) return;
    if (hipMemsetAsync((char*)d_ws + WS_CTL, 0, CTL_ZERO_BYTES, stream) != hipSuccess) return;
    Args a{};
    for (int i = 0; i < N_INPUTS; ++i) a.in[i] = (const float*)d_in[i];
    a.out = (float*)d_out; a.ws = (unsigned char*)d_ws;
    void* params[] = {&a};
    hipError_t e = hipLaunchCooperativeKernel((const void*)mega_fwd, dim3(grid), dim3(NTHR), params, LDS_BYTES, stream);
    if (e != hipSuccess) fprintf(stderr, "kernel_launch: cooperative launch failed: %s (grid %d)\n", hipGetErrorString(e), grid);
}
```

```cpp
#include <hip/hip_runtime.h>
#include <cstdio>
#include <cstdint>
namespace pg8 {
#define PG8_LAS __attribute__((address_space(3)))
typedef unsigned short bf16_t;
typedef short bf16x8 __attribute__((ext_vector_type(8)));
typedef float f32x4 __attribute__((ext_vector_type(4)));
typedef unsigned u32x4 __attribute__((ext_vector_type(4)));
constexpr int BM = 256, BK = 64, HALF = 128, HTB = HALF * BK * 2  , STAGE_BYTES = 8 * HTB, NXCD = 8, WGM = 8;

__host__ __device__ __forceinline__ int lds_byte(int r, int c) { const int st = (r >> 4) * 2 + (c >> 5), rr = r & 15, cc = c & 31, ob = rr * 64 + cc * 2; return st * 1024 + (ob ^ (((ob >> 9) & 1) << 5)); }
__host__ __device__ __forceinline__ void stage_rc(int b, int& R, int& C) { const int st = b / 1024, sb = b % 1024, swz = sb ^ (((sb >> 9) & 1) << 5); R = (st >> 1) * 16 + swz / 64; C = (st & 1) * 32 + (swz % 64) / 2; }
__host__ __device__ __forceinline__ int perm32(int rho) { const int n = rho >> 4, i = rho & 15; return 8 * (i >> 2) + 4 * n + (i & 3); }

struct Unit { int pm, pn, k0, nt, cidx, sid; };
struct Gemm { const bf16_t* A; const bf16_t* Bt; int M, N, K; };

struct StaticOrder {
    int nM, nN, nwg, G, c, ntk;
    __host__ __device__ void init(int M, int N, int G_, int c_, int K_) { nM = M / BM; nN = N / BM; nwg = nM * nN; G = G_; c = c_; ntk = K_ / BK; }
    __host__ __device__ bool next(int i, Unit& u) const {
        const long L = (long)i * G + c; if (L >= nwg) return false;
        int wgid = (int)L; { const int q = nwg / NXCD, r = nwg % NXCD, xcd = wgid % NXCD, off = wgid / NXCD; wgid = (xcd < r ? xcd * (q + 1) : r * (q + 1) + (xcd - r) * q) + off; }
        const int nig = WGM * nN, gid = wgid / nig, fm = gid * WGM, gsz = (nM - fm) < WGM ? (nM - fm) : WGM;
        u.pm = fm + ((wgid % nig) % gsz); u.pn = (wgid % nig) / gsz; u.k0 = 0; u.nt = ntk; u.cidx = -1; u.sid = 0; return true;
    }
    __device__ __forceinline__ void a_ready(const Unit&) const {}
    __device__ __forceinline__ void done(const Unit&) const {}
};
__device__ __forceinline__ unsigned cvt_pk_bf16(float lo, float hi) { unsigned r; asm volatile("s_nop 0\n\tv_cvt_pk_bf16_f32 %0, %1, %2" : "=v"(r) : "v"(lo), "v"(hi)); return r; }
template <class Epi, class Sched, bool ALIGN_EPI = false, bool SP2 = false, bool CHAIN_IN = false>
__device__ __forceinline__ void gemm_phase(PG8_LAS unsigned char* lds, const Gemm g, const Sched& S, const Epi& E, f32x4 (&acc)[2][2][4][2]) {
    int tid_ = threadIdx.x; asm volatile("" : "+v"(tid_));
    const int tid = tid_, wid = __builtin_amdgcn_readfirstlane(tid >> 6), lane = tid & 63, wr = wid >> 2, wc = wid & 3, fr = lane & 15, fq = lane >> 4;
    const int K = g.K;
    unsigned voffA[2], voffB[2];
#pragma unroll
    for (int i = 0; i < 2; ++i) { int R, C; stage_rc(tid * 16 + i * 8192, R, C); const int Rb = Epi::PERM ? ((R & ~31) + perm32(R & 31)) : R;
        voffA[i] = (unsigned)(R * K + C) * 2u; voffB[i] = (unsigned)(Rb * K + C) * 2u; }
    const size_t kstep = (size_t)(BK * 2);
    const size_t hstep = (size_t)HALF * K * 2;
    const size_t tstep = 2 * hstep;
    const unsigned ldsw = (unsigned)wid * 1024u;
    const int aoff = lds_byte(wr * 64 + fr, fq * 8), boff = lds_byte(wc * 32 + fr, fq * 8);
#define PG8_SA(b, h) (((b) * 2 + (h)) * HTB)
#define PG8_SB(b, h) ((4 + (b) * 2 + (h)) * HTB)
#define PG8_STAGE(bufoff, gbase, voff) do { _Pragma("unroll") for (int _i = 0; _i < 2; ++_i) \
        __builtin_amdgcn_global_load_lds((const unsigned*)((const char*)(gbase) + (voff)[_i]), (PG8_LAS unsigned*)(lds + (bufoff) + ldsw + _i * 8192), 16, 0, 0); } while (0)
#define PG8_LDA(dst, b, h) do { _Pragma("unroll") for (int m = 0; m < 4; ++m) _Pragma("unroll") for (int k = 0; k < 2; ++k) dst[m][k] = *(const PG8_LAS bf16x8*)(lds + PG8_SA(b, h) + aoff + m * 2048 + k * 1024); } while (0)
#define PG8_LDB(dst, b, h) do { _Pragma("unroll") for (int n = 0; n < 2; ++n) _Pragma("unroll") for (int k = 0; k < 2; ++k) dst[n][k] = *(const PG8_LAS bf16x8*)(lds + PG8_SB(b, h) + boff + n * 2048 + k * 1024); } while (0)
#define PG8_MMA(ai, bj, At, Bt) do { __builtin_amdgcn_s_setprio(1); _Pragma("unroll") for (int m = 0; m < 4; ++m) _Pragma("unroll") for (int n = 0; n < 2; ++n) _Pragma("unroll") for (int k = 0; k < 2; ++k) \
        acc[ai][bj][m][n] = __builtin_amdgcn_mfma_f32_16x16x32_bf16(Bt[n][k], At[m][k], acc[ai][bj][m][n], 0, 0, 0); __builtin_amdgcn_s_setprio(0); } while (0)
#define PG8_WAIT_V(n) asm volatile("s_waitcnt vmcnt(" #n ")" ::: "memory")
#define PG8_WAIT_L(n) asm volatile("s_waitcnt lgkmcnt(" #n ")" ::: "memory")
#define PG8_BAR __builtin_amdgcn_s_barrier()
#define PG8_SCHED __builtin_amdgcn_sched_barrier(0)
    Unit cur, nxt; int ui = 0;
    if (!S.next(0, cur)) return;
    if constexpr (!CHAIN_IN) {
#pragma unroll
    for (int a = 0; a < 2; ++a)
#pragma unroll
        for (int b = 0; b < 2; ++b)
#pragma unroll
            for (int m = 0; m < 4; ++m)
#pragma unroll
                for (int n = 0; n < 2; ++n) acc[a][b][m][n] = (f32x4){0.f, 0.f, 0.f, 0.f};
    }
    bf16x8 At[4][2], B0[2][2], B1[2][2];
    const char* cA = (const char*)g.A + (size_t)cur.pm * tstep + (size_t)cur.k0 * 2; const char* cB = (const char*)g.Bt + (size_t)cur.pn * tstep + (size_t)cur.k0 * 2;
    S.a_ready(cur);
    if constexpr (SP2) {
        PG8_STAGE(PG8_SB(0, 0), cB, voffB); PG8_STAGE(PG8_SB(0, 1), cB + hstep, voffB); PG8_STAGE(PG8_SA(0, 0), cA, voffA); PG8_STAGE(PG8_SA(0, 1), cA + hstep, voffA);
        if (wr == 1) PG8_BAR;
        PG8_WAIT_V(2); PG8_BAR;
        PG8_STAGE(PG8_SB(1, 0), cB + kstep, voffB); PG8_STAGE(PG8_SA(1, 0), cA + kstep, voffA); PG8_STAGE(PG8_SB(1, 1), cB + hstep + kstep, voffB);
        PG8_WAIT_V(6); PG8_BAR;
    } else {
        PG8_STAGE(PG8_SB(0, 0), cB, voffB); PG8_STAGE(PG8_SA(0, 0), cA, voffA); PG8_STAGE(PG8_SB(0, 1), cB + hstep, voffB); PG8_STAGE(PG8_SA(0, 1), cA + hstep, voffA);
        if (wr == 1) PG8_BAR;
        PG8_WAIT_V(4); PG8_BAR;
        PG8_STAGE(PG8_SB(1, 0), cB + kstep, voffB); PG8_STAGE(PG8_SA(1, 0), cA + kstep, voffA); PG8_STAGE(PG8_SB(1, 1), cB + hstep + kstep, voffB);
        PG8_WAIT_V(6); PG8_BAR;
    }
    for (;;) {
        const bool has_next = S.next(ui + 1, nxt);
        const char* nA = has_next ? (const char*)g.A + (size_t)nxt.pm * tstep + (size_t)nxt.k0 * 2 : cA; const char* nB = has_next ? (const char*)g.Bt + (size_t)nxt.pn * tstep + (size_t)nxt.k0 * 2 : cB;
        const int nt = cur.nt; const bool halfu = cur.cidx >= 0;
        for (int t = 0; t < nt; t += 2) {
            if constexpr (Epi::HOOK) { if (!halfu && (t == 8 || t == 16)) E.hook(acc, cur, t, wr, wc); }
            const bool last = (t == nt - 2);
            const char* a1 = cA + (size_t)(t + 1) * kstep;
            const char* a2 = last ? nA : cA + (size_t)(t + 2) * kstep; const char* b2 = last ? nB : cB + (size_t)(t + 2) * kstep;
            const char* a3 = a2 + kstep; const char* b3 = b2 + kstep;
            if (last && has_next) S.a_ready(nxt);
            if constexpr (SP2) {
            PG8_LDB(B0, 0, 0); PG8_LDB(B1, 0, 1); PG8_SCHED; PG8_LDA(At, 0, 0); PG8_STAGE(PG8_SA(1, 1), a1 + hstep, voffA);
            PG8_WAIT_V(8); PG8_WAIT_L(0); PG8_BAR; PG8_MMA(0, 0, At, B0); PG8_MMA(0, 1, At, B1); PG8_BAR; PG8_SCHED;
            PG8_LDA(At, 0, 1); PG8_STAGE(PG8_SB(0, 0), b2, voffB); PG8_STAGE(PG8_SB(0, 1), b2 + hstep, voffB); PG8_STAGE(PG8_SA(0, 0), a2, voffA);
            PG8_WAIT_V(8); PG8_WAIT_L(0); PG8_BAR; if (!halfu) { PG8_MMA(1, 0, At, B0); PG8_MMA(1, 1, At, B1); } PG8_BAR; PG8_SCHED;
            PG8_LDB(B0, 1, 0); PG8_LDB(B1, 1, 1); PG8_SCHED; PG8_LDA(At, 1, 0); PG8_STAGE(PG8_SA(0, 1), a2 + hstep, voffA);
            PG8_WAIT_V(8); PG8_WAIT_L(0); PG8_BAR; PG8_MMA(0, 0, At, B0); PG8_MMA(0, 1, At, B1); PG8_BAR; PG8_SCHED;
            PG8_LDA(At, 1, 1); PG8_STAGE(PG8_SB(1, 0), b3, voffB); PG8_STAGE(PG8_SB(1, 1), b3 + hstep, voffB); PG8_STAGE(PG8_SA(1, 0), a3, voffA);
            PG8_WAIT_V(8); PG8_WAIT_L(0); PG8_BAR; if (!halfu) { PG8_MMA(1, 0, At, B0); PG8_MMA(1, 1, At, B1); } PG8_BAR; PG8_SCHED;
            } else {
            PG8_LDB(B0, 0, 0); PG8_SCHED; PG8_LDA(At, 0, 0); PG8_STAGE(PG8_SA(1, 1), a1 + hstep, voffA);
            PG8_WAIT_L(8); PG8_BAR; PG8_WAIT_L(0); PG8_MMA(0, 0, At, B0); PG8_BAR; PG8_SCHED;
            PG8_LDB(B1, 0, 1); PG8_STAGE(PG8_SB(0, 0), b2, voffB);
            PG8_BAR; PG8_WAIT_L(0); PG8_MMA(0, 1, At, B1); PG8_BAR;
            PG8_LDA(At, 0, 1); PG8_STAGE(PG8_SA(0, 0), a2, voffA);
            PG8_BAR; PG8_WAIT_L(0); PG8_MMA(1, 0, At, B0); PG8_BAR; PG8_SCHED;
            PG8_STAGE(PG8_SB(0, 1), b2 + hstep, voffB);
            PG8_WAIT_V(6); PG8_BAR; PG8_MMA(1, 1, At, B1); PG8_BAR;
            PG8_LDB(B0, 1, 0); PG8_SCHED; PG8_LDA(At, 1, 0); PG8_STAGE(PG8_SA(0, 1), a2 + hstep, voffA);
            PG8_WAIT_L(8); PG8_BAR; PG8_WAIT_L(0); PG8_MMA(0, 0, At, B0); PG8_BAR; PG8_SCHED;
            PG8_LDB(B1, 1, 1); PG8_STAGE(PG8_SB(1, 0), b3, voffB);
            PG8_BAR; PG8_WAIT_L(0); PG8_MMA(0, 1, At, B1); PG8_BAR;
            PG8_LDA(At, 1, 1); PG8_STAGE(PG8_SA(1, 0), a3, voffA);
            PG8_BAR; PG8_WAIT_L(0); PG8_MMA(1, 0, At, B0); PG8_BAR; PG8_SCHED;
            PG8_STAGE(PG8_SB(1, 1), b3 + hstep, voffB);
            PG8_WAIT_V(6); PG8_BAR; PG8_MMA(1, 1, At, B1); PG8_BAR;
            }
        }
        if constexpr (ALIGN_EPI) { if (wr == 0) PG8_BAR; }
        if constexpr (!Epi::AFTER_DRAIN) { int t2 = threadIdx.x; asm volatile("" : "+v"(t2)); const int lane2 = t2 & 63, fr2 = lane2 & 15, fq2 = lane2 >> 4;
            if (cur.cidx < 0) E(acc, cur, wr, wc, fr2, fq2); else E.partial(acc, cur, wr, wc, fr2, fq2, wid, lane2); S.done(cur); }
        else { if (cur.cidx >= 0) { int t2 = threadIdx.x; asm volatile("" : "+v"(t2)); const int lane2 = t2 & 63; E.partial(acc, cur, wr, wc, lane2 & 15, lane2 >> 4, wid, lane2); } }
        if (!has_next) break;
#pragma unroll
        for (int a = 0; a < 2; ++a)
#pragma unroll
            for (int b = 0; b < 2; ++b)
#pragma unroll
                for (int m = 0; m < 4; ++m)
#pragma unroll
                    for (int n = 0; n < 2; ++n) acc[a][b][m][n] = (f32x4){0.f, 0.f, 0.f, 0.f};
        cur = nxt; cA = nA; cB = nB; ++ui;
        if constexpr (ALIGN_EPI) { if (wr == 1) PG8_BAR; }
    }
    PG8_WAIT_V(0);
    if constexpr (!ALIGN_EPI) { if (wr == 0) PG8_BAR; }
    PG8_BAR;
    if constexpr (Epi::AFTER_DRAIN) { E.fused(acc, cur, wr, wc, fr, fq, lds, wid, lane); S.done(cur); }
#undef PG8_SA
#undef PG8_SB
#undef PG8_STAGE
#undef PG8_LDA
#undef PG8_LDB
#undef PG8_MMA
#undef PG8_WAIT_V
#undef PG8_WAIT_L
#undef PG8_BAR
#undef PG8_SCHED
}
template <class Epi, class Sched, bool ALIGN_EPI = false, bool SP2 = false>
__device__ __forceinline__ void gemm_phase(PG8_LAS unsigned char* lds, const Gemm g, const Sched& S, const Epi& E) {
    f32x4 acc[2][2][4][2];
    gemm_phase<Epi, Sched, ALIGN_EPI, SP2, false>(lds, g, S, E, acc);
}

}
constexpr int DM = 2048, NB = 4, SEQ = 2048, NS = 128, DEPTH = 2;
constexpr int MPROMPT = NB * SEQ;
constexpr int MREAL = MPROMPT + NS;
constexpr int MP = 8448;
constexpr int D_A = 512, G_A = 32, P_A = 64, S5G = 16;
constexpr int D_B = 512, H_B = 8, GMC = 128;
constexpr int D_C = 1024, HD_C = 64, H_C = 16, N_C = 128, G_C = 2, K_C = 4, D_XBC = 1536;
constexpr int D_FF = 5632, K_F = 3, D_UP = 2 * D_FF;
constexpr int N_IN = 10256, N_INP = 10240;
constexpr int N_MOD = 6 * DM, MOD_PITCH = 2 * N_MOD;
constexpr float EPS = 1e-6f;
constexpr int PC_UA = 0, PC_UB = 512, PC_VB = 1024, PC_Z = 1536, PC_XBC = 2560, PC_GA = 4096, PC_GB = 6144, PC_GC = 8192;
constexpr int S5Q = 64, S5NC = SEQ / S5Q;
constexpr int SSDQ = 128, SSDNC = SEQ / SSDQ;

enum { I_XP = 0, I_XS, I_CP, I_CS, I_S5RE, I_S5IM, I_SSM, I_SSDCONV, I_FFNCONV, I_WMOD, I_BMOD, I_GMIX, I_WIN, I_LAMRE, I_LAMIM, I_LOGDT,
       I_BRE, I_BIM, I_CRE, I_CIM, I_S5D, I_WGLU, I_GV, I_WS, I_BS, I_CONVW, I_CONVB, I_DTBIAS, I_ALOG, I_SSDD, I_GNORM, I_WPA, I_WPB, I_WPC,
       I_WOUT, I_GFFN, I_WUP, I_FCONVW, I_FCONVB, I_WDOWN, I_GFINAL, N_INPUTS };
constexpr size_t O_YP = 0, O_YS = 16777216, O_S5RP = 17039360, O_S5IP = 17055744, O_SSMP = 17072128, O_CCP = 18120704, O_CFP = 18157568,
                 O_S5RS = 18337792, O_S5IS = 18862080, O_SSMS = 19386368, O_CCS = 52940800, O_CFS = 54120448, O_GVS = 59887616, O_END = 60018688;

constexpr size_t MiB = 1u << 20;
constexpr size_t WS_CTL = 0, CTL_ZERO_BYTES = 1 * MiB;
constexpr size_t SZ_WIN = (size_t)N_INP * DM * 2, SZ_WGLU = 512 * 512 * 2, SZ_WPA = (size_t)DM * 512 * 2, SZ_WPC = (size_t)DM * 1024 * 2,
                 SZ_WOUT = (size_t)DM * DM * 2, SZ_WUP = (size_t)D_UP * DM * 2, SZ_WDOWN = (size_t)DM * D_FF * 2;
constexpr size_t WL_IN = 0, WL_GLU = WL_IN + SZ_WIN, WL_PA = WL_GLU + SZ_WGLU, WL_PB = WL_PA + SZ_WPA, WL_PC = WL_PB + SZ_WPA, WL_OUT = WL_PC + SZ_WPC,
                 WL_UP = WL_OUT + SZ_WOUT, WL_DOWN = WL_UP + SZ_WUP, WL_END = WL_DOWN + SZ_WDOWN;
constexpr size_t WS_W = 2 * MiB;
constexpr size_t WS_SMALL = WS_W + 2 * WL_END;
constexpr size_t SM_WS = 0;
constexpr size_t SM_S5BB = SM_WS + 2 * 8 * 128 * 128 * 2;
constexpr size_t SM_S5CT = SM_S5BB + 2 * 32 * 64 * 32 * 4;
constexpr size_t SM_S5A = SM_S5CT + 2 * 32 * 16 * 128 * 2;
constexpr size_t SM_DT = SM_S5A + 2 * 32 * 64 * 4 * 4;
constexpr size_t SM_VSQ = SM_DT + (size_t)MP * 16 * 4;
constexpr size_t SM_CSQ = SM_VSQ + (size_t)2 * MP * 4;
constexpr size_t SM_SLOC = SM_CSQ + (size_t)2 * MP * 4;
constexpr size_t SM_SDEC = SM_SLOC + (size_t)NB * G_A * S5NC * 128 * 4;
constexpr size_t SM_CSILU = SM_SDEC + 4096;
constexpr size_t SM_WDT = SM_CSILU + 256 * 2048 * 2;
constexpr size_t SM_END = SM_WDT + (size_t)2 * 16 * DM * 4;
constexpr size_t WS_MOD = (WS_SMALL + SM_END + 4095) / 4096 * 4096;
constexpr size_t WS_X0 = WS_MOD + (size_t)2 * 256 * N_MOD * 4;
constexpr size_t WS_X1 = WS_X0 + (size_t)MP * DM * 4;
constexpr size_t WS_H = WS_X1 + (size_t)MP * DM * 4;
constexpr size_t WS_BIG = WS_H + (size_t)MP * DM * 2;
constexpr size_t WS_T = WS_BIG + (size_t)MP * D_UP * 2;
constexpr size_t WS_MERGED = WS_T + (size_t)MP * DM * 4;
constexpr size_t WS_OCAT = WS_MERGED + (size_t)MP * DM * 2;
constexpr int OCP = 2048, OC_A = 0, OC_B = 512, OC_C = 1024;
constexpr size_t WS_YB = WS_OCAT + (size_t)MP * OCP * 2;
constexpr size_t WS_STATES = WS_YB + (size_t)MP * 512 * 2;
constexpr size_t WS_SLAB = WS_STATES + (size_t)NB * SSDNC * H_C * HD_C * N_C * 4;
constexpr size_t WS_HALO = WS_SLAB + (size_t)176 * 131072;
constexpr size_t WS_END = WS_HALO + (size_t)33 * 4 * D_UP * 4;
static_assert((size_t)MP * D_FF * 2 <= (size_t)MP * DM * 6, "ACT overlays T+MERGED");
constexpr int CW_PC = 12288;
constexpr int CW_S5F = 20480;
constexpr int CW_SSDF = 16384;
constexpr int CW_BAR = 4096, CW_CNT = 8192;
struct Args { const float* in[N_INPUTS]; float* out; unsigned char* ws; };
typedef const __attribute__((address_space(4))) Args* KArgs;
__device__ __forceinline__ KArgs launder_args(KArgs a) { unsigned long long t = (unsigned long long)a; asm volatile("" : "+s"(t)); return (KArgs)t; }
#define GAS __attribute__((address_space(1)))
#define LAS __attribute__((address_space(3)))
typedef unsigned short bf16;
typedef unsigned v4u __attribute__((ext_vector_type(4)));
typedef unsigned v2u __attribute__((ext_vector_type(2)));
typedef float f32x4 __attribute__((ext_vector_type(4)));
typedef float f32x2 __attribute__((ext_vector_type(2)));
typedef short bf16x8 __attribute__((ext_vector_type(8)));
typedef short bf16x4 __attribute__((ext_vector_type(4)));
typedef GAS unsigned gu32;
#define RLX_AGENT __ATOMIC_RELAXED, __HIP_MEMORY_SCOPE_AGENT
#define LDS_WAIT() asm volatile("s_waitcnt lgkmcnt(0)" ::: "memory")
#define VM_WAIT() asm volatile("s_waitcnt vmcnt(0)" ::: "memory")
constexpr int NWAVES = 8, NTHR = 512, GRID = 256;
__device__ __forceinline__ unsigned f2bf(float f) { unsigned u = __builtin_bit_cast(unsigned, f); return (u + 0x7fffu + ((u >> 16) & 1u)) >> 16; }
__device__ __forceinline__ unsigned pk2(float lo, float hi) { return f2bf(lo) | (f2bf(hi) << 16); }
__device__ __forceinline__ float bf2f(unsigned short b) { return __builtin_bit_cast(float, (unsigned)b << 16); }
__device__ __forceinline__ float bflo(unsigned w) { return __builtin_bit_cast(float, w << 16); }
__device__ __forceinline__ float bfhi(unsigned w) { return __builtin_bit_cast(float, w & 0xffff0000u); }
__device__ __forceinline__ float sigmoidf_(float x) { return __builtin_amdgcn_rcpf(1.0f + __expf(-x)); }
__device__ __forceinline__ float siluf_(float x) { return x * __builtin_amdgcn_rcpf(1.0f + __expf(-x)); }
__device__ __forceinline__ float gelu_tanh(float x) {
    const float u = 0.7978845608028654f * (x + 0.044715f * x * x * x);
    const float e = __expf(2.0f * u);
    const float t = 1.0f - 2.0f * __builtin_amdgcn_rcpf(e + 1.0f);
    return 0.5f * x * (1.0f + t);
}
__device__ __forceinline__ float softplusf_(float x) { return fmaxf(x, 0.f) + __logf(1.0f + __expf(-fabsf(x))); }
template <int M> __device__ __forceinline__ float xor_lt32(float x) {
    return __builtin_bit_cast(float, __builtin_amdgcn_ds_swizzle(__builtin_bit_cast(int, x), (M << 10) | 0x1f)); }
__device__ __forceinline__ float add_xor32(float x) {
    const unsigned b = __builtin_bit_cast(unsigned, x); const auto r = __builtin_amdgcn_permlane32_swap(b, b, false, false);
    return __builtin_bit_cast(float, (unsigned)r[0]) + __builtin_bit_cast(float, (unsigned)r[1]); }
__device__ __forceinline__ float wave_sum(float v) {
    v += xor_lt32<1>(v); v += xor_lt32<2>(v); v += xor_lt32<4>(v); v += xor_lt32<8>(v); v += xor_lt32<16>(v);
    return add_xor32(v);
}
__device__ __forceinline__ float wave_sum16(const float (&a)[16], int lane) {
    float b[8], c[4], d[2];
    const bool o1 = lane & 1, o2 = lane & 2, o4 = lane & 4, o8 = lane & 8;
#pragma unroll
    for (int i = 0; i < 8; ++i) { const float keep = o1 ? a[2 * i + 1] : a[2 * i], send = o1 ? a[2 * i] : a[2 * i + 1]; b[i] = keep + xor_lt32<1>(send); }
#pragma unroll
    for (int i = 0; i < 4; ++i) { const float keep = o2 ? b[2 * i + 1] : b[2 * i], send = o2 ? b[2 * i] : b[2 * i + 1]; c[i] = keep + xor_lt32<2>(send); }
#pragma unroll
    for (int i = 0; i < 2; ++i) { const float keep = o4 ? c[2 * i + 1] : c[2 * i], send = o4 ? c[2 * i] : c[2 * i + 1]; d[i] = keep + xor_lt32<4>(send); }
    const float keep = o8 ? d[1] : d[0], send = o8 ? d[0] : d[1];
    float e = keep + xor_lt32<8>(send);
    e += xor_lt32<16>(e);
    return add_xor32(e);
}
__device__ __forceinline__ float half_sum32(const float (&a)[32], int lane) {
    float b[16], c[8], d[4], e[2];
    const bool o1 = lane & 1, o2 = lane & 2, o4 = lane & 4, o8 = lane & 8, o16 = lane & 16;
#pragma unroll
    for (int i = 0; i < 16; ++i) { const float keep = o1 ? a[2 * i + 1] : a[2 * i], send = o1 ? a[2 * i] : a[2 * i + 1]; b[i] = keep + xor_lt32<1>(send); }
#pragma unroll
    for (int i = 0; i < 8; ++i) { const float keep = o2 ? b[2 * i + 1] : b[2 * i], send = o2 ? b[2 * i] : b[2 * i + 1]; c[i] = keep + xor_lt32<2>(send); }
#pragma unroll
    for (int i = 0; i < 4; ++i) { const float keep = o4 ? c[2 * i + 1] : c[2 * i], send = o4 ? c[2 * i] : c[2 * i + 1]; d[i] = keep + xor_lt32<4>(send); }
#pragma unroll
    for (int i = 0; i < 2; ++i) { const float keep = o8 ? d[2 * i + 1] : d[2 * i], send = o8 ? d[2 * i] : d[2 * i + 1]; e[i] = keep + xor_lt32<8>(send); }
    const float keep = o16 ? e[1] : e[0], send = o16 ? e[0] : e[1];
    return keep + xor_lt32<16>(send);
}
__device__ __forceinline__ float lane_bcast(float x, int src) {
    return __builtin_bit_cast(float, __builtin_amdgcn_readlane(__builtin_bit_cast(int, x), src)); }
__device__ __forceinline__ int mod_row(int r) { return r < MPROMPT ? (r >> 11) : (r < MREAL ? 4 + (r - MPROMPT) : 4 + NS - 1); }

template <int MODE>
__device__ __forceinline__ void prep_row(const bf16* xrow, const float* g, const float* mr, int sh_idx, int sc_idx, bf16* hrow, float* yrow, float* dtrow, const LAS float* wT, int lane) {
    const GAS v2u* xr = (const GAS v2u*)xrow + lane;
    f32x4 v[8]; float s = 0.f;
#pragma unroll
    for (int j = 0; j < 8; ++j) { const v2u w = xr[64 * j]; v[j] = (f32x4){bflo(w.x), bfhi(w.x), bflo(w.y), bfhi(w.y)}; s += (v[j].x * v[j].x + v[j].y * v[j].y) + (v[j].z * v[j].z + v[j].w * v[j].w); }
    const float rinv = rsqrtf(wave_sum(s) * (1.0f / DM) + EPS);
    const GAS f32x4* gp = (const GAS f32x4*)g + lane;
    if (MODE == 2) { GAS f32x4* o = (GAS f32x4*)yrow + lane;
#pragma unroll
        for (int j = 0; j < 8; ++j) o[64 * j] = v[j] * rinv * gp[64 * j];
        return; }
    const GAS f32x4* shp = (const GAS f32x4*)(mr + sh_idx * DM) + lane; const GAS f32x4* scp = (const GAS f32x4*)(mr + sc_idx * DM) + lane;
    GAS v2u* o = (GAS v2u*)hrow + lane;
#pragma unroll
    for (int j = 0; j < 8; ++j) { const f32x4 gg = gp[64 * j], sh = shp[64 * j], sc = scp[64 * j];
        v[j] = v[j] * rinv * gg * (sc + 1.0f) + sh;
        v2u w; w.x = pk2(v[j].x, v[j].y); w.y = pk2(v[j].z, v[j].w); o[64 * j] = w; }
    if (MODE == 1) {
        float a16[16];
#pragma unroll
        for (int hh = 0; hh < 16; ++hh) { float a = 0.f;
#pragma unroll
            for (int j = 0; j < 8; ++j) { const f32x4 w = *(const LAS f32x4*)(wT + hh * DM + 4 * lane + 256 * j); a += (v[j].x * w.x + v[j].y * w.y) + (v[j].z * w.z + v[j].w * w.w); }
            a16[hh] = a; }
        const float mine = wave_sum16(a16, lane);
        if (lane < 16) dtrow[lane] = mine;
    }
}

template <int MODE>
__device__ __forceinline__ void prep_rows4(const bf16* x0, const float* g, const float* mr, int sh_idx, int sc_idx, bf16* h0, float* y0, float* dt0, const LAS float* wT, int lane) {
    f32x4 v[4][8];
#pragma unroll
    for (int q = 0; q < 4; ++q) { const GAS v2u* xr = (const GAS v2u*)(x0 + (size_t)q * DM) + lane;
#pragma unroll
        for (int j = 0; j < 8; ++j) { const v2u w = xr[64 * j]; v[q][j] = (f32x4){bflo(w.x), bfhi(w.x), bflo(w.y), bfhi(w.y)}; } }
    f32x4 gm[8], sh[8];
    {   const GAS f32x4* gp = (const GAS f32x4*)g + lane;
        if (MODE == 2) {
#pragma unroll
            for (int j = 0; j < 8; ++j) gm[j] = gp[64 * j];
        } else { const GAS f32x4* shp = (const GAS f32x4*)(mr + sh_idx * DM) + lane; const GAS f32x4* scp = (const GAS f32x4*)(mr + sc_idx * DM) + lane;
#pragma unroll
            for (int j = 0; j < 8; ++j) { gm[j] = gp[64 * j] * (scp[64 * j] + 1.0f); sh[j] = shp[64 * j]; } } }
#pragma unroll
    for (int q = 0; q < 4; ++q) { float s = 0.f;
#pragma unroll
        for (int j = 0; j < 8; ++j) s += (v[q][j].x * v[q][j].x + v[q][j].y * v[q][j].y) + (v[q][j].z * v[q][j].z + v[q][j].w * v[q][j].w);
        const float rinv = rsqrtf(wave_sum(s) * (1.0f / DM) + EPS);
        if (MODE == 2) { GAS f32x4* o = (GAS f32x4*)(y0 + (size_t)q * DM) + lane;
#pragma unroll
            for (int j = 0; j < 8; ++j) o[64 * j] = v[q][j] * rinv * gm[j];
        } else { GAS v2u* o = (GAS v2u*)(h0 + (size_t)q * DM) + lane;
#pragma unroll
            for (int j = 0; j < 8; ++j) { v[q][j] = v[q][j] * rinv * gm[j] + sh[j]; v2u w; w.x = pk2(v[q][j].x, v[q][j].y); w.y = pk2(v[q][j].z, v[q][j].w); o[64 * j] = w; }
        }
    }
    if (MODE == 1) {
#pragma unroll
        for (int pr = 0; pr < 2; ++pr) { float a16[2][16];
#pragma unroll
            for (int hh = 0; hh < 16; ++hh) { float a0 = 0.f, a1 = 0.f;
#pragma unroll
                for (int j = 0; j < 8; ++j) { const f32x4 w = *(const LAS f32x4*)(wT + hh * DM + 4 * lane + 256 * j);
                    a0 += (v[2 * pr][j].x * w.x + v[2 * pr][j].y * w.y) + (v[2 * pr][j].z * w.z + v[2 * pr][j].w * w.w);
                    a1 += (v[2 * pr + 1][j].x * w.x + v[2 * pr + 1][j].y * w.y) + (v[2 * pr + 1][j].z * w.z + v[2 * pr + 1][j].w * w.w); }
                a16[0][hh] = a0; a16[1][hh] = a1; }
            { const float m0 = wave_sum16(a16[0], lane), m1 = wave_sum16(a16[1], lane); if (lane < 16) { dt0[(2 * pr) * 16 + lane] = m0; dt0[(2 * pr + 1) * 16 + lane] = m1; } } }
    }
}
#define XB_TMO      128
#define XB_XCNT(j)  (256  + 64 * (j))
#define XB_XSUB(j)  (1280 + 64 * (j))
#define XB_XGEN(j)  (2304 + 64 * (j))
#define XB_TOP      3328
#define XB_TOPGEN   3392
#define XCD_BAR_WORDS 3456
#define XB_SPIN_CAP (1u << 18)

__device__ __forceinline__ unsigned xb_ld(unsigned* p)              { return __hip_atomic_load(p, __ATOMIC_RELAXED, __HIP_MEMORY_SCOPE_AGENT); }
__device__ __forceinline__ unsigned xb_add(unsigned* p, unsigned v) { return __hip_atomic_fetch_add(p, v, __ATOMIC_RELAXED, __HIP_MEMORY_SCOPE_AGENT); }
__device__ __forceinline__ unsigned xb_xcc_id() { return (unsigned)__builtin_amdgcn_s_getreg((3 << 11) | 20) & 0xFu; }
#define XB_SPIN(cond, bar) do { unsigned _sp = 0; while (cond) { __builtin_amdgcn_s_sleep(1); \
    if ((++_sp & 255u) == 0u) { if (xb_ld(&(bar)[XB_TMO])) break; if (_sp > XB_SPIN_CAP) { atomicAdd(&(bar)[XB_TMO], 1u); break; } } } } while (0)

struct XcdBarrier {
    unsigned* bar; unsigned x;
    volatile LAS unsigned* st;
};

__device__ __forceinline__ XcdBarrier xcd_barrier_post(unsigned* bar, volatile LAS unsigned* st) {
    XcdBarrier b; b.bar = bar; b.x = xb_xcc_id(); b.st = st;
    if (threadIdx.x == 0) (void)xb_add(&bar[XB_XCNT(b.x)], 1u);
    return b;
}
__device__ __forceinline__ void xcd_barrier_complete(unsigned* bar, unsigned x, unsigned& nloc, unsigned& nx) {
    const unsigned G = gridDim.x * gridDim.y * gridDim.z;
    unsigned sum, cnt, mine, sp = 0u;
    for (;;) {
        sum = 0u; cnt = 0u; mine = 0u;
#pragma unroll
        for (unsigned j = 0; j < 16; ++j) { const unsigned c = xb_ld(&bar[XB_XCNT(j)]); sum += c; cnt += (c > 0u) ? 1u : 0u; mine = (j == x) ? c : mine; }
        if (sum == G) break;
        __builtin_amdgcn_s_sleep(1);
        if ((++sp & 255u) == 0u) { if (xb_ld(&bar[XB_TMO])) break; if (sp > XB_SPIN_CAP) { atomicAdd(&bar[XB_TMO], 1u); break; } }
    }
    nloc = mine > 0u ? mine : 1u; nx = cnt > 0u ? cnt : 1u;
}

__device__ __forceinline__ void xcd_barrier(const XcdBarrier& b) {
    asm volatile("s_waitcnt vmcnt(0)" ::: "memory");
    __syncthreads();
    if (threadIdx.x == 0) {
        unsigned* bar = b.bar;
        __builtin_amdgcn_s_waitcnt(0);
        unsigned nloc = b.st[0], nx = b.st[1];
        if (nloc == 0u) { xcd_barrier_complete(bar, b.x, nloc, nx); b.st[0] = nloc; b.st[1] = nx; }
        const unsigned old = xb_add(&bar[XB_XSUB(b.x)], 1u);
        const unsigned gen = old / nloc;
        if (old + 1u == (gen + 1u) * nloc) {
            __builtin_amdgcn_fence(__ATOMIC_RELEASE, "agent");
            asm volatile("s_waitcnt vmcnt(0)" ::: "memory");
            const unsigned og = xb_add(&bar[XB_TOP], 1u);
            const unsigned tg = og / nx;
            if (og + 1u == (tg + 1u) * nx) xb_add(&bar[XB_TOPGEN], 1u);
            else XB_SPIN(xb_ld(&bar[XB_TOPGEN]) == tg, bar);
            __builtin_amdgcn_fence(__ATOMIC_ACQUIRE, "agent");
            xb_add(&bar[XB_XGEN(b.x)], 1u);
            asm volatile("s_waitcnt vmcnt(0)" ::: "memory");
        } else {
            XB_SPIN(xb_ld(&bar[XB_XGEN(b.x)]) == gen, bar);
            __builtin_amdgcn_fence(__ATOMIC_ACQUIRE, "agent");
            asm volatile("s_waitcnt vmcnt(0)" ::: "memory");
        }
    }
    __syncthreads();
}

namespace epi {
using pg8::Unit; using pg8::f32x4; using pg8::u32x4; using pg8::cvt_pk_bf16;
typedef unsigned u32x2 __attribute__((ext_vector_type(2)));
constexpr int BM = 256, HALF = 128;

constexpr int SLAB_F4 = 8 * 16 * 64;
constexpr int SLAB_BYTES_ALL = 176 * 131072;
typedef unsigned v4u_ __attribute__((ext_vector_type(4)));
template <bool PERM> __device__ __forceinline__ int split_col(const Unit& u, int wc, int fq, int bj, int n) { return u.pn * BM + bj * HALF + wc * 32 + (PERM ? 8 * fq + 4 * n : 16 * n + 4 * fq); }
__device__ __forceinline__ __amdgpu_buffer_rsrc_t slab_rsrc(const f32x4* SLAB) { return __builtin_amdgcn_make_buffer_rsrc((void*)SLAB, (short)0, SLAB_BYTES_ALL, 0x00020000); }
__device__ __forceinline__ void split_store(const f32x4 (&acc)[2][2][4][2], f32x4* SLAB, int sid, int wid, int lane) {
    asm volatile("" : "+v"(lane));
    const __amdgpu_buffer_rsrc_t rs = slab_rsrc(SLAB);
    const unsigned vo = (unsigned)(wid * 16 * 64 + lane) * 16u, so = (unsigned)sid * (unsigned)(SLAB_F4 * 16);
#pragma unroll
    for (int m = 0; m < 4; ++m)
#pragma unroll
        for (int bj = 0; bj < 2; ++bj)
#pragma unroll
            for (int n = 0; n < 2; ++n) __builtin_amdgcn_raw_buffer_store_b128(__builtin_bit_cast(v4u_, acc[0][bj][m][n]), rs, vo + (unsigned)(((m * 2 + bj) * 2 + n) * 64 * 16), so,   16);
}
__device__ __forceinline__ bool split_arrive(unsigned* cnt, unsigned target, int lane) {
    asm volatile("s_waitcnt vmcnt(0)" ::: "memory");
    unsigned old = 0u;
    if (lane == 0) old = __hip_atomic_fetch_add(cnt, 1u, __ATOMIC_RELAXED, __HIP_MEMORY_SCOPE_AGENT);
    old = __builtin_amdgcn_readlane(old, 0);
    asm volatile("" ::: "memory");
    if (old != target - 1u) return false;
    __builtin_amdgcn_fence(__ATOMIC_ACQUIRE, "agent"); asm volatile("s_waitcnt vmcnt(0)" ::: "memory");
    return true;
}
__device__ __forceinline__ f32x4 slab_ld(const __amdgpu_buffer_rsrc_t rs, unsigned vo, unsigned so) { return __builtin_bit_cast(f32x4, __builtin_amdgcn_raw_buffer_load_b128(rs, vo, so,   16)); }
__device__ __forceinline__ f32x4 split_sum1(const f32x4* SLAB, int sid0, int ns, int wid, int lane, int reg) {
    const __amdgpu_buffer_rsrc_t rs = slab_rsrc(SLAB);
    const unsigned vo = (unsigned)((wid * 16 + reg) * 64 + lane) * 16u;
    f32x4 s = slab_ld(rs, vo, (unsigned)sid0 * (unsigned)(SLAB_F4 * 16));
    for (int j = 1; j < ns; ++j) s = s + slab_ld(rs, vo, (unsigned)(sid0 + j) * (unsigned)(SLAB_F4 * 16));
    return s;
}
__device__ __forceinline__ void split_sum(f32x4 (&acc)[2][2][4][2], const f32x4* SLAB, int sid0, int ns, int wid, int lane, int mmask = 15) {
    asm volatile("" : "+v"(lane));
    const __amdgpu_buffer_rsrc_t rs = slab_rsrc(SLAB);
    const unsigned vo = (unsigned)(wid * 16 * 64 + lane) * 16u;
#pragma unroll
    for (int m = 0; m < 4; ++m) { if (!((mmask >> m) & 1)) continue;
#pragma unroll
        for (int bj = 0; bj < 2; ++bj) {
            const unsigned vr = vo + (unsigned)((m * 2 + bj) * 2) * 1024u;
            unsigned so = (unsigned)sid0 * (unsigned)(SLAB_F4 * 16);
            f32x4 s0 = {0.f, 0.f, 0.f, 0.f}, s1 = s0;
            int j = 0;
#pragma unroll 1
            for (; j + 4 <= ns; j += 4) {
                f32x4 t[4][2];
#pragma unroll
                for (int q = 0; q < 4; ++q) { const unsigned sq = so + (unsigned)q * (unsigned)(SLAB_F4 * 16); t[q][0] = slab_ld(rs, vr, sq); t[q][1] = slab_ld(rs, vr + 1024u, sq); }
#pragma unroll
                for (int q = 0; q < 4; ++q) { s0 = s0 + t[q][0]; s1 = s1 + t[q][1]; }
                so += 4u * (unsigned)(SLAB_F4 * 16); }
            if (j < ns) {
                f32x4 t[3][2];
#pragma unroll
                for (int q = 0; q < 3; ++q) { const unsigned sq = so + (unsigned)q * (unsigned)(SLAB_F4 * 16);
                    if (j + q < ns) { t[q][0] = slab_ld(rs, vr, sq); t[q][1] = slab_ld(rs, vr + 1024u, sq); } else { t[q][0] = (f32x4){0.f, 0.f, 0.f, 0.f}; t[q][1] = t[q][0]; } }
#pragma unroll
                for (int q = 0; q < 3; ++q) { s0 = s0 + t[q][0]; s1 = s1 + t[q][1]; } }
            acc[0][bj][m][0] = s0; acc[0][bj][m][1] = s1;
            asm volatile("" ::: "memory");
        } }
}
__device__ __forceinline__ void split_zero_pad(f32x4 (&acc)[2][2][4][2]) {
#pragma unroll
    for (int bj = 0; bj < 2; ++bj)
#pragma unroll
        for (int m = 0; m < 4; ++m)
#pragma unroll
            for (int n = 0; n < 2; ++n) acc[1][bj][m][n] = (f32x4){0.f, 0.f, 0.f, 0.f};
}
struct SplitCtl { f32x4* SLAB; unsigned* cnt; unsigned nsl; int fin0, cbase, parts; };
__device__ __forceinline__ void split_post(unsigned* cnt, int lane) {
    asm volatile("s_waitcnt vmcnt(0)" ::: "memory");
    if (lane == 0) __hip_atomic_fetch_add(cnt, 1u, __ATOMIC_RELAXED, __HIP_MEMORY_SCOPE_AGENT);
}
__device__ __forceinline__ void split_wait(unsigned* cnt, unsigned target, int lane) {
    if (lane == 0) { unsigned sp_ = 0; while (__hip_atomic_load(cnt, __ATOMIC_RELAXED, __HIP_MEMORY_SCOPE_AGENT) < target && ++sp_ < (1u << 22)) __builtin_amdgcn_s_sleep(2); }
    asm volatile("" ::: "memory");
    __builtin_amdgcn_fence(__ATOMIC_ACQUIRE, "agent"); asm volatile("s_waitcnt vmcnt(0)" ::: "memory");
}
__device__ __forceinline__ int part_mask(int p, int parts) { const int w = 4 / parts; return ((1 << w) - 1) << (p * w); }
__device__ __forceinline__ int opaque_bx() { int b = (int)blockIdx.x; asm volatile("" : "+s"(b)); return b; }
__device__ __forceinline__ Unit final_unit(int f, int cbase) { Unit u; u.pm = MPROMPT / 256; u.pn = f; u.k0 = 0; u.nt = 0; u.cidx = cbase + f; u.sid = 0; return u; }

struct EpiIn {
    static constexpr bool PERM = true, AFTER_DRAIN = false, HOOK = false;
    bf16* O; float* vsq; SplitCtl sp;
    template <int ACT> __device__ __forceinline__ void run(const f32x4 (&acc)[2][2][4][2], const Unit& u, int wr, int wc, int fr, int fq, bool dosq, int mmask, int nai) const {
        const int row0 = u.pm * BM + wr * 64 + fr, col0 = u.pn * BM + wc * 32 + 8 * fq;
#pragma unroll
        for (int ai = 0; ai < 2; ++ai) { if (ai >= nai) break;
#pragma unroll
            for (int m = 0; m < 4; ++m) { if (!((mmask >> m) & 1)) continue; const int row = row0 + ai * HALF + m * 16; bf16* rowp = O + (size_t)row * N_INP + col0; float sq = 0.f;
#pragma unroll
                for (int bj = 0; bj < 2; ++bj) { f32x4 v0 = acc[ai][bj][m][0], v1 = acc[ai][bj][m][1];
#pragma unroll
                    for (int j = 0; j < 4; ++j) {
                        if (ACT == 1) { v0[j] = gelu_tanh(v0[j]); v1[j] = gelu_tanh(v1[j]); }
                        if (ACT == 2) { v0[j] = sigmoidf_(v0[j]); v1[j] = sigmoidf_(v1[j]); }
                        sq += v0[j] * v0[j] + v1[j] * v1[j]; }
                    u32x4 w; w.x = cvt_pk_bf16(v0[0], v0[1]); w.y = cvt_pk_bf16(v0[2], v0[3]); w.z = cvt_pk_bf16(v1[0], v1[1]); w.w = cvt_pk_bf16(v1[2], v1[3]);
                    *(GAS u32x4*)(rowp + bj * HALF) = w; }
                if (ACT == 1) { if (dosq && vsq) { sq += xor_lt32<16>(sq); sq = add_xor32(sq); if (fq == 0) atomicAdd(vsq + row, sq); } }
            } }
    }
    __device__ __forceinline__ void apply(const f32x4 (&acc)[2][2][4][2], const Unit& u, int wr, int wc, int fr, int fq, int mmask, int nai) const {
        const int pn = u.pn;
        if (pn >= 16) run<2>(acc, u, wr, wc, fr, fq, false, mmask, nai);
        else if (pn >= 2 && pn < 6) run<1>(acc, u, wr, wc, fr, fq, pn >= 4, mmask, nai);
        else run<0>(acc, u, wr, wc, fr, fq, false, mmask, nai);
    }
    __device__ __forceinline__ void operator()(const f32x4 (&acc)[2][2][4][2], const Unit& u, int wr, int wc, int fr, int fq) const { apply(acc, u, wr, wc, fr, fq, 15, 2); }
    __device__ __forceinline__ void partial(f32x4 (&acc)[2][2][4][2], const Unit& u, int wr, int wc, int fr, int fq, int wid, int lane) const {
        split_store(acc, sp.SLAB, u.sid, wid, lane); split_post(sp.cnt + u.cidx * 8 + wid, lane);
    }
    __device__ __forceinline__ void final(const Unit& u, int wr, int wc, int fr, int fq, int wid, int lane, int mmask) const {
        f32x4 acc[2][2][4][2];
        split_wait(sp.cnt + u.cidx * 8 + wid, sp.nsl, lane);
        split_sum(acc, sp.SLAB, u.pn * (int)sp.nsl, (int)sp.nsl, wid, lane, mmask); apply(acc, u, wr, wc, fr, fq, mmask, 1);
    }
};
struct EpiBf16Plain {
    static constexpr bool PERM = true, AFTER_DRAIN = false, HOOK = false;
    bf16* O; int ldc;
    __device__ __forceinline__ void partial(f32x4 (&)[2][2][4][2], const Unit&, int, int, int, int, int, int) const {}
    __device__ __forceinline__ void operator()(const f32x4 (&acc)[2][2][4][2], const Unit& u, int wr, int wc, int fr, int fq) const {
        const int row0 = u.pm * BM + wr * 64 + fr, col0 = u.pn * BM + wc * 32 + 8 * fq;
#pragma unroll
        for (int ai = 0; ai < 2; ++ai)
#pragma unroll
            for (int m = 0; m < 4; ++m) { bf16* rowp = O + (size_t)(row0 + ai * HALF + m * 16) * ldc + col0;
#pragma unroll
                for (int bj = 0; bj < 2; ++bj) { const f32x4 v0 = acc[ai][bj][m][0], v1 = acc[ai][bj][m][1];
                    u32x4 w; w.x = cvt_pk_bf16(v0[0], v0[1]); w.y = cvt_pk_bf16(v0[2], v0[3]); w.z = cvt_pk_bf16(v1[0], v1[1]); w.w = cvt_pk_bf16(v1[2], v1[3]);
                    *(GAS u32x4*)(rowp + bj * HALF) = w; } }
    }
};
__device__ __forceinline__ float dpp_ror1(float x) { return __builtin_bit_cast(float, __builtin_amdgcn_update_dpp(0, __builtin_bit_cast(int, x), 0x121, 0xf, 0xf, false)); }
__device__ __forceinline__ float dpp_ror2(float x) { return __builtin_bit_cast(float, __builtin_amdgcn_update_dpp(0, __builtin_bit_cast(int, x), 0x122, 0xf, 0xf, false)); }
__device__ __forceinline__ float dpp_shr1(float old, float x) { return __builtin_bit_cast(float, __builtin_amdgcn_update_dpp(__builtin_bit_cast(int, old), __builtin_bit_cast(int, x), 0x111, 0xf, 0xf, false)); }
__device__ __forceinline__ float dpp_shr2(float old, float x) { return __builtin_bit_cast(float, __builtin_amdgcn_update_dpp(__builtin_bit_cast(int, old), __builtin_bit_cast(int, x), 0x112, 0xf, 0xf, false)); }
struct EpiUpConv {
    static constexpr bool PERM = true, AFTER_DRAIN = false, HOOK = false;
    bf16* ACT; float* HALO; const float* cw; const float* cb; const float* st; float* cfs; LAS float* EX; int dry;
    __device__ __forceinline__ void partial(f32x4 (&)[2][2][4][2], const Unit&, int, int, int, int, int, int) const {}
    __device__ __forceinline__ void operator()(const f32x4 (&acc)[2][2][4][2], const Unit& u, int wr, int wc, int fr, int fq) const {
        asm volatile("" : "+v"(fr), "+v"(fq));
        if (dry) {
#pragma unroll
            for (int ai = 0; ai < 2; ++ai)
#pragma unroll
                for (int bj = 0; bj < 2; ++bj)
#pragma unroll
                    for (int m = 0; m < 4; ++m)
#pragma unroll
                        for (int n = 0; n < 2; ++n) asm volatile("" :: "v"(acc[ai][bj][m][n]));
            return; }
        const int cl = wc * 32 + 8 * fq;
        if (u.pm == MPROMPT / 256) {
#pragma unroll
            for (int n = 0; n < 2; ++n) { const int c = u.pn * 128 + cl + 4 * n;
                f32x4 wa0, wa1, wa2, wb0, wb1, wb2, ba, bb;
                wa0 = *(const GAS f32x4*)(cw + c); wa1 = *(const GAS f32x4*)(cw + D_UP + c); wa2 = *(const GAS f32x4*)(cw + 2 * D_UP + c); wb0 = *(const GAS f32x4*)(cw + D_FF + c); wb1 = *(const GAS f32x4*)(cw + D_UP + D_FF + c); wb2 = *(const GAS f32x4*)(cw + 2 * D_UP + D_FF + c);
                ba = *(const GAS f32x4*)(cb + c); bb = *(const GAS f32x4*)(cb + D_FF + c);
#pragma unroll
                for (int m = 0; m < 4; ++m) { const int s = wr * 64 + m * 16 + fr; const float* sp = st + (size_t)s * 2 * D_UP; float* op = cfs + (size_t)s * 2 * D_UP;
                    const f32x4 a2 = *(const GAS f32x4*)(sp + c), a1 = *(const GAS f32x4*)(sp + D_UP + c), b2 = *(const GAS f32x4*)(sp + D_FF + c), b1 = *(const GAS f32x4*)(sp + D_UP + D_FF + c);
                    const f32x4 ua = acc[0][0][m][n], ub = acc[0][1][m][n];
                    *(GAS f32x4*)(op + c) = a1; *(GAS f32x4*)(op + D_FF + c) = b1; *(GAS f32x4*)(op + D_UP + c) = ua; *(GAS f32x4*)(op + D_UP + D_FF + c) = ub;
                    const f32x4 ca = ba + wa0 * a2 + wa1 * a1 + wa2 * ua, cbv = bb + wb0 * b2 + wb1 * b1 + wb2 * ub;
                    u32x2 w; w.x = cvt_pk_bf16(siluf_(ca[0]) * cbv[0], siluf_(ca[1]) * cbv[1]); w.y = cvt_pk_bf16(siluf_(ca[2]) * cbv[2], siluf_(ca[3]) * cbv[3]);
                    *(GAS u32x2*)(ACT + (size_t)(MPROMPT + s) * D_FF + c) = w; }
                asm volatile("" ::: "memory"); }
            return;
        }
        f32x4 wts[2][8];
#pragma unroll
        for (int n = 0; n < 2; ++n) { const int c = u.pn * 128 + cl + 4 * n;
            wts[n][0] = *(const GAS f32x4*)(cw + c); wts[n][1] = *(const GAS f32x4*)(cw + D_UP + c); wts[n][2] = *(const GAS f32x4*)(cw + 2 * D_UP + c);
            wts[n][3] = *(const GAS f32x4*)(cw + D_FF + c); wts[n][4] = *(const GAS f32x4*)(cw + D_UP + D_FF + c); wts[n][5] = *(const GAS f32x4*)(cw + 2 * D_UP + D_FF + c);
            wts[n][6] = *(const GAS f32x4*)(cb + c); wts[n][7] = *(const GAS f32x4*)(cb + D_FF + c); }
        if (fr >= 14) {
#pragma unroll
            for (int ai = 0; ai < 2; ++ai)
#pragma unroll
                for (int bj = 0; bj < 2; ++bj)
#pragma unroll
                    for (int n = 0; n < 2; ++n) *(LAS f32x4*)(EX + ((ai * 2 + wr) * 2 + (fr - 14)) * 256 + bj * 128 + cl + 4 * n) = acc[ai][bj][3][n];
            if (wr == 1) {
#pragma unroll
                for (int bj = 0; bj < 2; ++bj)
#pragma unroll
                    for (int n = 0; n < 2; ++n) *(GAS f32x4*)(HALO + ((size_t)u.pm * 4 + 2 + (fr - 14)) * D_UP + u.pn * 256 + bj * 128 + cl + 4 * n) = acc[1][bj][3][n]; }
        }
        if (fr < 2 && wr == 0) {
#pragma unroll
            for (int bj = 0; bj < 2; ++bj)
#pragma unroll
                for (int n = 0; n < 2; ++n) *(GAS f32x4*)(HALO + ((size_t)u.pm * 4 + fr) * D_UP + u.pn * 256 + bj * 128 + cl + 4 * n) = acc[0][bj][0][n]; }
        asm volatile("s_waitcnt lgkmcnt(0)" ::: "memory"); __builtin_amdgcn_s_barrier(); asm volatile("" ::: "memory");
#pragma unroll
        for (int n = 0; n < 2; ++n) { const int c = u.pn * 128 + cl + 4 * n;
            const f32x4 wa0 = wts[n][0], wa1 = wts[n][1], wa2 = wts[n][2], wb0 = wts[n][3], wb1 = wts[n][4], wb2 = wts[n][5], ba = wts[n][6], bb = wts[n][7];
#pragma unroll
            for (int ai = 0; ai < 2; ++ai)
#pragma unroll
                for (int m = 0; m < 4; ++m) {
                    f32x4 cv[2];
#pragma unroll
                    for (int bj = 0; bj < 2; ++bj) { const f32x4 cur = acc[ai][bj][m][n]; f32x4 pb;
                        if (m > 0) pb = acc[ai][bj][m - 1][n];
                        else { pb = (f32x4){0.f, 0.f, 0.f, 0.f};
                            const int sa = wr == 1 ? ai : 0, sw = wr == 1 ? 0 : 1; const bool have = (wr == 1) || (ai == 1);
                            if (have && fr >= 14) pb = *(const LAS f32x4*)(EX + ((sa * 2 + sw) * 2 + (fr - 14)) * 256 + bj * 128 + cl + 4 * n); }
                        f32x4 x1, x2;
#pragma unroll
                        for (int j = 0; j < 4; ++j) { x1[j] = dpp_shr1(dpp_ror1(pb[j]), cur[j]); x2[j] = dpp_shr2(dpp_ror2(pb[j]), cur[j]); }
                        cv[bj] = bj == 0 ? ba + wa0 * x2 + wa1 * x1 + wa2 * cur : bb + wb0 * x2 + wb1 * x1 + wb2 * cur; }
                    u32x2 w; w.x = cvt_pk_bf16(siluf_(cv[0][0]) * cv[1][0], siluf_(cv[0][1]) * cv[1][1]); w.y = cvt_pk_bf16(siluf_(cv[0][2]) * cv[1][2], siluf_(cv[0][3]) * cv[1][3]);
                    *(GAS u32x2*)(ACT + (size_t)(u.pm * BM + ai * HALF + wr * 64 + m * 16 + fr) * D_FF + c) = w; }
            asm volatile("" ::: "memory"); }
    }
};
struct EpiGlu {
    static constexpr bool PERM = true, AFTER_DRAIN = false, HOOK = false;
    const bf16* Y; bf16* O;
    __device__ __forceinline__ void partial(f32x4 (&)[2][2][4][2], const Unit&, int, int, int, int, int, int) const {}
    __device__ __forceinline__ void operator()(const f32x4 (&acc)[2][2][4][2], const Unit& u, int wr, int wc, int fr, int fq) const {
        const int row0 = u.pm * BM + wr * 64 + fr, col0 = u.pn * BM + wc * 32 + 8 * fq;
#pragma unroll
        for (int ai = 0; ai < 2; ++ai)
#pragma unroll
            for (int m = 0; m < 4; ++m) { const size_t off = (size_t)(row0 + ai * HALF + m * 16) * 512 + col0, offo = (size_t)(row0 + ai * HALF + m * 16) * OCP + col0;
#pragma unroll
                for (int bj = 0; bj < 2; ++bj) { const f32x4 v0 = acc[ai][bj][m][0], v1 = acc[ai][bj][m][1];
                    const u32x4 y = *(const GAS u32x4*)(Y + off + bj * HALF);
                    u32x4 w;
                    w.x = cvt_pk_bf16(bflo(y.x) * sigmoidf_(v0[0]), bfhi(y.x) * sigmoidf_(v0[1]));
                    w.y = cvt_pk_bf16(bflo(y.y) * sigmoidf_(v0[2]), bfhi(y.y) * sigmoidf_(v0[3]));
                    w.z = cvt_pk_bf16(bflo(y.z) * sigmoidf_(v1[0]), bfhi(y.z) * sigmoidf_(v1[1]));
                    w.w = cvt_pk_bf16(bflo(y.w) * sigmoidf_(v1[2]), bfhi(y.w) * sigmoidf_(v1[3]));
                    *(GAS u32x4*)(O + offo + bj * HALF) = w; } }
    }
};
#ifndef MERGE_MB
#define MERGE_MB 4
#endif
template <int MODE> struct EpiMerge {
    static constexpr bool PERM = false, AFTER_DRAIN = false, HOOK = false;
    const bf16* G;
    float* T; bf16* MG; const float* csq;
    f32x4* SLAB; const bf16* PRJ; unsigned* cnt;
    __device__ __forceinline__ void partial(f32x4 (&acc)[2][2][4][2], const Unit& u, int wr, int wc, int fr, int fq, int wid, int lane) const {
        split_store(acc, SLAB, u.sid, wid, lane); split_post(cnt + u.cidx * 8 + wid, lane);
    }
    __device__ __forceinline__ void final(const Unit& u, int wr, int wc, int fr, int fq, int wid, int lane, int mmask) const {
        split_wait(cnt + u.cidx * 8 + wid, 8u, lane);
        asm volatile("" : "+v"(fr), "+v"(fq), "+v"(lane));
#pragma unroll
        for (int m = 0; m < 4; ++m) { if (!((mmask >> m) & 1)) continue; const int r = wr * 64 + m * 16 + fr, row = MPROMPT + r; const float rs = rsqrtf(csq[row] * (1.0f / 1024.0f) + EPS);
            const __amdgpu_buffer_rsrc_t rs_ = slab_rsrc(SLAB);
#pragma unroll
            for (int bj = 0; bj < 2; ++bj) {
                f32x4 sa[2], sb[2], sc[2];
                {   f32x4 la[2][2], lb[2][2], lc[2][4];
#pragma unroll
                    for (int n = 0; n < 2; ++n) { const unsigned vo = (unsigned)((wid * 16 + (m * 2 + bj) * 2 + n) * 64 + lane) * 16u;
#pragma unroll
                        for (int j = 0; j < 2; ++j) { la[n][j] = slab_ld(rs_, vo, (unsigned)(u.pn * 2 + j) * (unsigned)(SLAB_F4 * 16)); lb[n][j] = slab_ld(rs_, vo, (unsigned)(16 + u.pn * 2 + j) * (unsigned)(SLAB_F4 * 16)); }
#pragma unroll
                        for (int j = 0; j < 4; ++j) lc[n][j] = slab_ld(rs_, vo, (unsigned)(32 + u.pn * 4 + j) * (unsigned)(SLAB_F4 * 16)); }
#pragma unroll
                    for (int n = 0; n < 2; ++n) { sa[n] = la[n][0] + la[n][1]; sb[n] = lb[n][0] + lb[n][1]; sc[n] = (lc[n][0] + lc[n][1]) + (lc[n][2] + lc[n][3]); } }
#pragma unroll
                for (int n = 0; n < 2; ++n) { const int col = split_col<PERM>(u, wc, fq, bj, n); const bf16* gp = PRJ + ((unsigned)row * N_INP + col);
                    const f32x4 a = sa[n], b = sb[n], c = sc[n];
                    const u32x2 ga = *(const GAS u32x2*)(gp + PC_GA), gb = *(const GAS u32x2*)(gp + PC_GB), gc = *(const GAS u32x2*)(gp + PC_GC);
                    f32x4 t; t[0] = bflo(ga.x) * a[0] + bflo(gb.x) * b[0] + bflo(gc.x) * rs * c[0]; t[1] = bfhi(ga.x) * a[1] + bfhi(gb.x) * b[1] + bfhi(gc.x) * rs * c[1];
                    t[2] = bflo(ga.y) * a[2] + bflo(gb.y) * b[2] + bflo(gc.y) * rs * c[2]; t[3] = bfhi(ga.y) * a[3] + bfhi(gb.y) * b[3] + bfhi(gc.y) * rs * c[3];
                    u32x2 w; w.x = cvt_pk_bf16(t[0], t[1]); w.y = cvt_pk_bf16(t[2], t[3]); *(GAS u32x2*)(MG + ((unsigned)row * DM + col)) = w; } }
            asm volatile("" ::: "memory"); }
    }
    __device__ __forceinline__ void operator()(const f32x4 (&acc)[2][2][4][2], const Unit& u, int wr, int wc, int fr, int fq) const {
        const int row0 = u.pm * BM + wr * 64 + fr, col0 = u.pn * BM + wc * 32 + 4 * fq;
        bf16* Tb = (bf16*)T;
#pragma unroll
        for (int ai = 0; ai < 2; ++ai) {
#pragma unroll
          for (int mh = 0; mh < 4; mh += MERGE_MB) {
            u32x2 gq[4][2][2], tq[4][2][2]; float rsq[4];
#pragma unroll
            for (int m = mh; m < mh + MERGE_MB; ++m) { const int row = row0 + ai * HALF + m * 16; const size_t off = (size_t)row * DM + col0; const bf16* gp = G + (size_t)row * N_INP + col0;
                rsq[m] = MODE == 2 ? csq[row] : 0.f;
#pragma unroll
                for (int bj = 0; bj < 2; ++bj)
#pragma unroll
                    for (int n = 0; n < 2; ++n) { const int co = bj * HALF + n * 16; gq[m][bj][n] = *(const GAS u32x2*)(gp + co); if (MODE != 0) tq[m][bj][n] = *(const GAS u32x2*)(Tb + off + co); } }
#pragma unroll
            for (int m = mh; m < mh + MERGE_MB; ++m) { const int row = row0 + ai * HALF + m * 16; const size_t off = (size_t)row * DM + col0;
                const float rs = MODE == 2 ? rsqrtf(rsq[m] * (1.0f / 1024.0f) + EPS) : 1.f;
#pragma unroll
                for (int bj = 0; bj < 2; ++bj)
#pragma unroll
                    for (int n = 0; n < 2; ++n) { const int co = bj * HALF + n * 16; const u32x2 g = gq[m][bj][n]; f32x4 v = acc[ai][bj][m][n];
                        v[0] *= bflo(g.x); v[1] *= bfhi(g.x); v[2] *= bflo(g.y); v[3] *= bfhi(g.y);
                        if (MODE == 0) { u32x2 w; w.x = cvt_pk_bf16(v[0], v[1]); w.y = cvt_pk_bf16(v[2], v[3]); *(GAS u32x2*)(Tb + off + co) = w; }
                        if (MODE == 1) { const u32x2 tb = tq[m][bj][n]; u32x2 w; w.x = cvt_pk_bf16(bflo(tb.x) + v[0], bfhi(tb.x) + v[1]); w.y = cvt_pk_bf16(bflo(tb.y) + v[2], bfhi(tb.y) + v[3]); *(GAS u32x2*)(Tb + off + co) = w; }
                        if (MODE == 2) { const u32x2 tb = tq[m][bj][n]; f32x4 t = {bflo(tb.x), bfhi(tb.x), bflo(tb.y), bfhi(tb.y)}; t = t + v * rs; u32x2 w; w.x = cvt_pk_bf16(t[0], t[1]); w.y = cvt_pk_bf16(t[2], t[3]); *(GAS u32x2*)(MG + off + co) = w; } } } } }
    }
};

#ifndef HOOK_MB
#define HOOK_MB 2
#endif
struct EpiMergeCat {
    static constexpr bool PERM = false, AFTER_DRAIN = false, HOOK = true;
    const bf16* PRJ; bf16* MG; const float* csq; f32x4* SLAB; unsigned* cnt;
    static __device__ __forceinline__ float gcl(float g) { return fmaxf(g, 1e-20f); }
    __device__ __forceinline__ void hook(f32x4 (&acc)[2][2][4][2], const Unit& u, int t, int wr, int wc) const {
        int t2 = threadIdx.x; asm volatile("" : "+v"(t2)); const int lane = t2 & 63, fr = lane & 15, fq = lane >> 4;
        const int row0 = u.pm * BM + wr * 64 + fr, col0 = u.pn * BM + wc * 32 + 4 * fq;
        const bool second = t != 8; const unsigned cn = (unsigned)(second ? PC_GB : PC_GA) * 2u, cd = (unsigned)(second ? PC_GC : PC_GB) * 2u;
        const __amdgpu_buffer_rsrc_t pr = __builtin_amdgcn_make_buffer_rsrc((void*)PRJ, (short)0, (int)((size_t)MP * N_INP * 2), 0x00020000);
        const __amdgpu_buffer_rsrc_t cr = __builtin_amdgcn_make_buffer_rsrc((void*)csq, (short)0, (int)(MP * 4), 0x00020000);
#pragma unroll
        for (int ai = 0; ai < 2; ++ai)
#pragma unroll
          for (int m = 0; m < 4; m += HOOK_MB) {
            u32x2 gn[HOOK_MB][2][2], gd[HOOK_MB][2][2]; float rsq[HOOK_MB];
#pragma unroll
            for (int mm = 0; mm < HOOK_MB; ++mm) { const int row = row0 + ai * HALF + (m + mm) * 16; const unsigned vo = ((unsigned)row * (unsigned)N_INP + (unsigned)col0) * 2u;
                rsq[mm] = __builtin_bit_cast(float, __builtin_amdgcn_raw_buffer_load_b32(cr, (unsigned)row * 4u, 0, 0));
#pragma unroll
                for (int bj = 0; bj < 2; ++bj)
#pragma unroll
                    for (int n = 0; n < 2; ++n) { const unsigned co = (unsigned)(bj * HALF + n * 16) * 2u;
                        gn[mm][bj][n] = __builtin_bit_cast(u32x2, __builtin_amdgcn_raw_buffer_load_b64(pr, vo + co, cn, 0)); gd[mm][bj][n] = __builtin_bit_cast(u32x2, __builtin_amdgcn_raw_buffer_load_b64(pr, vo + co, cd, 0)); } }
#pragma unroll
            for (int mm = 0; mm < HOOK_MB; ++mm) { const float rs = second ? __builtin_amdgcn_rsqf(rsq[mm] * (1.0f / 1024.0f) + EPS) : 1.f;
#pragma unroll
                for (int bj = 0; bj < 2; ++bj)
#pragma unroll
                    for (int n = 0; n < 2; ++n) { const u32x2 a = gn[mm][bj][n], d = gd[mm][bj][n]; f32x4 v = acc[ai][bj][m + mm][n];
                        const float n0 = bflo(a.x), n1 = bfhi(a.x), n2 = bflo(a.y), n3 = bfhi(a.y);
                        v[0] *= (second ? gcl(n0) : n0) * __builtin_amdgcn_rcpf(gcl(bflo(d.x)) * rs); v[1] *= (second ? gcl(n1) : n1) * __builtin_amdgcn_rcpf(gcl(bfhi(d.x)) * rs);
                        v[2] *= (second ? gcl(n2) : n2) * __builtin_amdgcn_rcpf(gcl(bflo(d.y)) * rs); v[3] *= (second ? gcl(n3) : n3) * __builtin_amdgcn_rcpf(gcl(bfhi(d.y)) * rs);
                        acc[ai][bj][m + mm][n] = v; } }
            asm volatile("" ::: "memory"); }
    }
    __device__ __forceinline__ void operator()(const f32x4 (&acc)[2][2][4][2], const Unit& u, int wr, int wc, int fr, int fq) const {
        const int row0 = u.pm * BM + wr * 64 + fr, col0 = u.pn * BM + wc * 32 + 4 * fq;
#pragma unroll
        for (int ai = 0; ai < 2; ++ai)
#pragma unroll
          for (int mh = 0; mh < 4; mh += 2) {
            u32x2 gq[2][2][2]; float rsq[2];
#pragma unroll
            for (int mm = 0; mm < 2; ++mm) { const int row = row0 + ai * HALF + (mh + mm) * 16; const bf16* gp = PRJ + (size_t)row * N_INP + col0 + PC_GC; rsq[mm] = csq[row];
#pragma unroll
                for (int bj = 0; bj < 2; ++bj)
#pragma unroll
                    for (int n = 0; n < 2; ++n) gq[mm][bj][n] = *(const GAS u32x2*)(gp + bj * HALF + n * 16); }
#pragma unroll
            for (int mm = 0; mm < 2; ++mm) { const int row = row0 + ai * HALF + (mh + mm) * 16; const size_t off = (size_t)row * DM + col0; const float rs = rsqrtf(rsq[mm] * (1.0f / 1024.0f) + EPS);
#pragma unroll
                for (int bj = 0; bj < 2; ++bj)
#pragma unroll
                    for (int n = 0; n < 2; ++n) { const u32x2 g = gq[mm][bj][n]; const f32x4 v = acc[ai][bj][mh + mm][n]; u32x2 w;
                        w.x = cvt_pk_bf16(v[0] * (gcl(bflo(g.x)) * rs), v[1] * (gcl(bfhi(g.x)) * rs)); w.y = cvt_pk_bf16(v[2] * (gcl(bflo(g.y)) * rs), v[3] * (gcl(bfhi(g.y)) * rs));
                        *(GAS u32x2*)(MG + off + bj * HALF + n * 16) = w; } } }
    }
    __device__ __forceinline__ void partial(f32x4 (&acc)[2][2][4][2], const Unit& u, int wr, int wc, int fr, int fq, int wid, int lane) const {
        split_store(acc, SLAB, u.sid, wid, lane); split_post(cnt + u.cidx * 8 + wid, lane);
    }
    __device__ __forceinline__ void final(const Unit& u, int wr, int wc, int fr, int fq, int wid, int lane, int mmask) const {
        split_wait(cnt + u.cidx * 8 + wid, 4u, lane);
        asm volatile("" : "+v"(fr), "+v"(fq), "+v"(lane));
        const __amdgpu_buffer_rsrc_t rs_ = slab_rsrc(SLAB);
#pragma unroll
        for (int m = 0; m < 4; ++m) { if (!((mmask >> m) & 1)) continue; const int r = wr * 64 + m * 16 + fr, row = MPROMPT + r; const float rs = rsqrtf(csq[row] * (1.0f / 1024.0f) + EPS);
            f32x4 s[2][2][4]; u32x2 ga[2][2], gb[2][2], gc[2][2];
#pragma unroll
            for (int bj = 0; bj < 2; ++bj)
#pragma unroll
                for (int n = 0; n < 2; ++n) { const unsigned vo = (unsigned)((wid * 16 + (m * 2 + bj) * 2 + n) * 64 + lane) * 16u;
                    const int col = split_col<PERM>(u, wc, fq, bj, n); const bf16* gp = PRJ + ((unsigned)row * N_INP + col);
#pragma unroll
                    for (int j = 0; j < 4; ++j) s[bj][n][j] = slab_ld(rs_, vo, (unsigned)(u.pn * 4 + j) * (unsigned)(SLAB_F4 * 16));
                    ga[bj][n] = *(const GAS u32x2*)(gp + PC_GA); gb[bj][n] = *(const GAS u32x2*)(gp + PC_GB); gc[bj][n] = *(const GAS u32x2*)(gp + PC_GC); }
#pragma unroll
            for (int bj = 0; bj < 2; ++bj)
#pragma unroll
                for (int n = 0; n < 2; ++n) { const int col = split_col<PERM>(u, wc, fq, bj, n);
                    const f32x4 a = s[bj][n][0], b = s[bj][n][1], c = s[bj][n][2] + s[bj][n][3]; const u32x2 xa = ga[bj][n], xb = gb[bj][n], xc = gc[bj][n];
                    f32x4 t; t[0] = bflo(xa.x) * a[0] + gcl(bflo(xb.x)) * b[0] + gcl(bflo(xc.x)) * rs * c[0]; t[1] = bfhi(xa.x) * a[1] + gcl(bfhi(xb.x)) * b[1] + gcl(bfhi(xc.x)) * rs * c[1];
                    t[2] = bflo(xa.y) * a[2] + gcl(bflo(xb.y)) * b[2] + gcl(bflo(xc.y)) * rs * c[2]; t[3] = bfhi(xa.y) * a[3] + gcl(bfhi(xb.y)) * b[3] + gcl(bfhi(xc.y)) * rs * c[3];
                    u32x2 w; w.x = cvt_pk_bf16(t[0], t[1]); w.y = cvt_pk_bf16(t[2], t[3]); *(GAS u32x2*)(MG + ((unsigned)row * DM + col)) = w; }
            asm volatile("" ::: "memory"); }
    }
};
template <int SEG> struct EpiChain {
    static constexpr bool PERM = false, AFTER_DRAIN = false, HOOK = false;
    const bf16* PRJ; bf16* MG; const float* csq;
    __device__ __forceinline__ void partial(f32x4 (&)[2][2][4][2], const Unit&, int, int, int, int, int, int) const {}
    __device__ __forceinline__ void operator()(f32x4 (&acc)[2][2][4][2], const Unit& u, int wr, int wc, int fr, int fq) const {
        const int row0 = u.pm * BM + wr * 64 + fr, col0 = u.pn * BM + wc * 32 + 4 * fq;
#pragma unroll
        for (int ai = 0; ai < 2; ++ai)
#pragma unroll
            for (int m = 0; m < 4; ++m) { const int row = row0 + ai * HALF + m * 16; const bf16* gp = PRJ + ((unsigned)row * N_INP + col0);
                float rs = 1.f; if (SEG >= 1) rs = rsqrtf(csq[row] * (1.0f / 1024.0f) + EPS);
#pragma unroll
                for (int bj = 0; bj < 2; ++bj)
#pragma unroll
                    for (int n = 0; n < 2; ++n) { const int co = bj * HALF + n * 16; f32x4 v = acc[ai][bj][m][n];
                        if (SEG == 0) { const u32x2 ga = *(const GAS u32x2*)(gp + PC_GA + co), gb = *(const GAS u32x2*)(gp + PC_GB + co);
                            v[0] *= bflo(ga.x) * __builtin_amdgcn_rcpf(fmaxf(bflo(gb.x), 1e-20f)); v[1] *= bfhi(ga.x) * __builtin_amdgcn_rcpf(fmaxf(bfhi(gb.x), 1e-20f));
                            v[2] *= bflo(ga.y) * __builtin_amdgcn_rcpf(fmaxf(bflo(gb.y), 1e-20f)); v[3] *= bfhi(ga.y) * __builtin_amdgcn_rcpf(fmaxf(bfhi(gb.y), 1e-20f)); acc[ai][bj][m][n] = v; }
                        if (SEG == 1) { const u32x2 gb = *(const GAS u32x2*)(gp + PC_GB + co), gc = *(const GAS u32x2*)(gp + PC_GC + co);
                            v[0] *= fmaxf(bflo(gb.x), 1e-20f) * __builtin_amdgcn_rcpf(fmaxf(bflo(gc.x) * rs, 1e-20f)); v[1] *= fmaxf(bfhi(gb.x), 1e-20f) * __builtin_amdgcn_rcpf(fmaxf(bfhi(gc.x) * rs, 1e-20f));
                            v[2] *= fmaxf(bflo(gb.y), 1e-20f) * __builtin_amdgcn_rcpf(fmaxf(bflo(gc.y) * rs, 1e-20f)); v[3] *= fmaxf(bfhi(gb.y), 1e-20f) * __builtin_amdgcn_rcpf(fmaxf(bfhi(gc.y) * rs, 1e-20f)); acc[ai][bj][m][n] = v; }
                        if (SEG == 2) { const u32x2 gc = *(const GAS u32x2*)(gp + PC_GC + co);
                            v[0] *= fmaxf(bflo(gc.x) * rs, 1e-20f); v[1] *= fmaxf(bfhi(gc.x) * rs, 1e-20f); v[2] *= fmaxf(bflo(gc.y) * rs, 1e-20f); v[3] *= fmaxf(bfhi(gc.y) * rs, 1e-20f);
                            u32x2 w; w.x = cvt_pk_bf16(v[0], v[1]); w.y = cvt_pk_bf16(v[2], v[3]); *(GAS u32x2*)(MG + ((unsigned)row * DM + col0 + co)) = w; } }
                asm volatile("" ::: "memory"); }
    }
};
struct EpiResid {
    static constexpr bool PERM = false, AFTER_DRAIN = false, HOOK = false;
    const bf16* XI; const bf16* XIS; bf16* XO; const float* gate; SplitCtl sp;
    __device__ __forceinline__ void partial(f32x4 (&acc)[2][2][4][2], const Unit& u, int wr, int wc, int fr, int fq, int wid, int lane) const {
        split_store(acc, sp.SLAB, u.sid, wid, lane);
        if (split_arrive(sp.cnt + u.cidx * 8 + wid, sp.nsl, lane)) { split_zero_pad(acc); split_sum(acc, sp.SLAB, u.pn * (int)sp.nsl, (int)sp.nsl, wid, lane); (*this)(acc, u, wr, wc, fr, fq); }
    }
    __device__ __forceinline__ void operator()(const f32x4 (&acc)[2][2][4][2], const Unit& u, int wr, int wc, int fr, int fq, int mmask = 15) const {
        const int row0 = u.pm * BM + wr * 64 + fr, col0 = u.pn * BM + wc * 32 + 4 * fq;
        const __amdgpu_buffer_rsrc_t xr = __builtin_amdgcn_make_buffer_rsrc((void*)XO, (short)0, (int)((size_t)MP * DM * 2), 0x00020000);
        const bool samp = u.pm == MPROMPT / 256;
        const bf16* xs16 = samp ? XIS - (size_t)MPROMPT * DM : XI;
#pragma unroll
        for (int ai = 0; ai < 2; ++ai) { if (ai == 1 && samp) break;
            u32x2 xw[4][2][2]; f32x4 gg[4][2][2];
#pragma unroll
            for (int m = 0; m < 4; ++m) { if (!((mmask >> m) & 1)) continue; const int row = row0 + ai * HALF + m * 16; const size_t off = (size_t)row * DM + col0; const float* gp = gate + (size_t)mod_row(row) * MOD_PITCH + col0;
#pragma unroll
                for (int bj = 0; bj < 2; ++bj)
#pragma unroll
                    for (int n = 0; n < 2; ++n) { const int co = bj * HALF + n * 16; xw[m][bj][n] = *(const GAS u32x2*)(xs16 + off + co); gg[m][bj][n] = *(const GAS f32x4*)(gp + co); } }
#pragma unroll
            for (int m = 0; m < 4; ++m) { if (!((mmask >> m) & 1)) continue; const int row = row0 + ai * HALF + m * 16; const size_t off = (size_t)row * DM + col0;
#pragma unroll
                for (int bj = 0; bj < 2; ++bj)
#pragma unroll
                    for (int n = 0; n < 2; ++n) { const int co = bj * HALF + n * 16; const u32x2 w = xw[m][bj][n]; const f32x4 xi = {bflo(w.x), bfhi(w.x), bflo(w.y), bfhi(w.y)};
                        const f32x4 xo = xi + gg[m][bj][n] * acc[ai][bj][m][n]; u32x2 wo; wo.x = cvt_pk_bf16(xo[0], xo[1]); wo.y = cvt_pk_bf16(xo[2], xo[3]);
                        __builtin_amdgcn_raw_buffer_store_b64(wo, xr, (unsigned)(off + co) * 2u, 0,   16); } } }
    }
};
template <int MODE> struct EpiResidPrep {
    static constexpr bool PERM = false, AFTER_DRAIN = true, HOOK = false;
    EpiResid R; bf16* H; float* yp; float* ys; const float* g; const float* mod2; int sh_idx, sc_idx; const float* wdt; float* DT; unsigned* pc;
    __device__ __forceinline__ void partial(f32x4 (&acc)[2][2][4][2], const Unit& u, int wr, int wc, int fr, int fq, int wid, int lane) const {
        split_store(acc, R.sp.SLAB, u.sid, wid, lane); split_post(R.sp.cnt + u.cidx * 8 + wid, lane);
    }
    __device__ __forceinline__ void operator()(const f32x4 (&acc)[2][2][4][2], const Unit& u, int wr, int wc, int fr, int fq) const { R(acc, u, wr, wc, fr, fq); }
    __device__ __forceinline__ void fused(f32x4 (&acc)[2][2][4][2], const Unit& u, int wr, int wc, int fr, int fq, LAS unsigned char* lds, int wid, int lane) const {
        R(acc, u, wr, wc, fr, fq);
        const int fin = opaque_bx() - R.sp.fin0; const bool isfin = fin >= 0 && fin < (DM / 256) * R.sp.parts;
        if (isfin) { const Unit uf = final_unit(fin / R.sp.parts, R.sp.cbase); const int mmask = part_mask(fin % R.sp.parts, R.sp.parts);
            split_wait(R.sp.cnt + uf.cidx * 8 + wid, R.sp.nsl, lane);
            split_sum(acc, R.sp.SLAB, uf.pn * (int)R.sp.nsl, (int)R.sp.nsl, wid, lane, mmask); R(acc, uf, wr, wc, fr, fq, mmask); }
        asm volatile("s_waitcnt vmcnt(0)" ::: "memory"); __syncthreads();
        if (wid == 0 && lane == 0) {
            if (isfin) __hip_atomic_fetch_add(pc + 32, 8u / (unsigned)R.sp.parts, __ATOMIC_RELAXED, __HIP_MEMORY_SCOPE_AGENT);
            __hip_atomic_fetch_add(pc + u.pm, 1u, __ATOMIC_RELAXED, __HIP_MEMORY_SCOPE_AGENT);
            unsigned sp_ = 0; while (__hip_atomic_load(pc + u.pm, __ATOMIC_RELAXED, __HIP_MEMORY_SCOPE_AGENT) < 8u && ++sp_ < (1u << 22)) __builtin_amdgcn_s_sleep(2);
            if (u.pn == 0) { sp_ = 0; while (__hip_atomic_load(pc + 32, __ATOMIC_RELAXED, __HIP_MEMORY_SCOPE_AGENT) < 64u && ++sp_ < (1u << 22)) __builtin_amdgcn_s_sleep(2); }
            __builtin_amdgcn_fence(__ATOMIC_ACQUIRE, "agent"); asm volatile("s_waitcnt vmcnt(0)" ::: "memory");
        }
        __syncthreads();
        LAS float* wT = (LAS float*)lds;
        if (MODE == 1) { f32x4 tw[16];
#pragma unroll
            for (int i = 0; i < 16; ++i) tw[i] = ((const f32x4*)wdt)[wid * 64 + lane + i * NTHR];
#pragma unroll
            for (int i = 0; i < 16; ++i) ((LAS f32x4*)wT)[wid * 64 + lane + i * NTHR] = tw[i];
            __syncthreads(); }
        const bf16* X = R.XO;
        {   const int row = u.pm * BM + u.pn * 32 + wid * 4;
            prep_rows4<MODE>(X + (size_t)row * DM, g, mod2 + (size_t)mod_row(row) * MOD_PITCH, sh_idx, sc_idx, H + (size_t)row * DM, yp + (size_t)row * DM, DT + (size_t)row * 16, wT, lane); }
        if (u.pn == 0 && wid < 4) { const int s = u.pm * 4 + wid, row = MPROMPT + s;
            prep_row<MODE>(X + (size_t)row * DM, g, mod2 + (size_t)mod_row(row) * MOD_PITCH, sh_idx, sc_idx, H + (size_t)row * DM, ys + (size_t)s * DM, DT + (size_t)row * 16, wT, lane); }
        if (MODE == 1) __syncthreads();
    }
};
struct EpiMod {
    static constexpr bool PERM = false, AFTER_DRAIN = false, HOOK = false;
    float* MOD; const float* bmod;
    __device__ __forceinline__ void partial(f32x4 (&)[2][2][4][2], const Unit&, int, int, int, int, int, int) const {}
    __device__ __forceinline__ void operator()(const f32x4 (&acc)[2][2][4][2], const Unit& u, int wr, int wc, int fr, int fq) const {
        const int row0 = wr * 64 + fr, col0 = u.pn * BM + wc * 32 + 4 * fq;
        f32x4 bv[2][2];
#pragma unroll
        for (int bj = 0; bj < 2; ++bj)
#pragma unroll
            for (int n = 0; n < 2; ++n) bv[bj][n] = *(const GAS f32x4*)(bmod + col0 + bj * HALF + n * 16);
#pragma unroll
        for (int ai = 0; ai < 2; ++ai)
#pragma unroll
            for (int m = 0; m < 4; ++m) { float* rowp = MOD + (size_t)(row0 + ai * HALF + m * 16) * MOD_PITCH + col0;
#pragma unroll
                for (int bj = 0; bj < 2; ++bj)
#pragma unroll
                    for (int n = 0; n < 2; ++n) *(GAS f32x4*)(rowp + bj * HALF + n * 16) = acc[ai][bj][m][n] + bv[bj][n]; }
    }
};
}
struct Frame {
    LAS unsigned char* lds;
    int tid, lane, wave, gw;
    float* out; unsigned char* ws;
};
#define WSP(T, off) ((T*)(F.ws + (off)))
__device__ __forceinline__ Frame launder(const Frame& F0) {
    Frame F = F0; int t = F0.tid; asm volatile("" : "+v"(t)); F.tid = t; F.lane = t & 63; F.wave = __builtin_amdgcn_readfirstlane(t >> 6);
    unsigned long long w = (unsigned long long)F0.ws, o = (unsigned long long)F0.out; asm volatile("" : "+s"(w), "+s"(o)); F.ws = (unsigned char*)w; F.out = (float*)o;
    F.gw = blockIdx.x * NWAVES + F.wave; return F;
}

__device__ __forceinline__ void transpose_load(float (&tv)[32], const float* W, int ld, int ncols, int c0, int item, int lane) {
    const int nblk = ncols / 32, kb = item / nblk, nb = item % nblk, k0 = 64 * kb, n0 = 32 * nb;
    const unsigned lo = (unsigned)((lane >> 5) * ld + (lane & 31));
#pragma unroll
    for (int i = 0; i < 32; ++i) { const float* rb = W + (size_t)(k0 + 2 * i) * ld + c0 + n0; tv[i] = __builtin_nontemporal_load(rb + lo); }
}
__device__ __forceinline__ void transpose_store(const float (&tv)[32], int pitch, int ncols, bf16* WT, int row_off, LAS float* scr, int item, int lane) {
    const int nblk = ncols / 32, kb = item / nblk, nb = item % nblk, k0 = 64 * kb, n0 = 32 * nb;
    const int rbase = row_off >= 0 ? row_off + n0 : (n0 < D_FF ? 256 * (n0 / 128) + n0 % 128 : 256 * ((n0 - D_FF) / 128) + 128 + (n0 - D_FF) % 128);
#pragma unroll
    for (int i = 0; i < 32; ++i) { const int kk = 2 * i + (lane >> 5); scr[kk * 33 + (lane & 31)] = tv[i]; }
    LDS_WAIT(); asm volatile("" ::: "memory");
    const int c = lane & 7;
#pragma unroll
    for (int j = 0; j < 4; ++j) { const int n = (lane >> 3) + 8 * j; const LAS float* s = scr + (8 * c) * 33 + n;
        v4u o; o.x = pk2(s[0 * 33], s[1 * 33]); o.y = pk2(s[2 * 33], s[3 * 33]); o.z = pk2(s[4 * 33], s[5 * 33]); o.w = pk2(s[6 * 33], s[7 * 33]);
        *(GAS v4u*)(WT + (size_t)(rbase + n) * pitch + k0 + 8 * c) = o; }
    LDS_WAIT(); asm volatile("" ::: "memory");
}
constexpr int MODC = 96, MODK = 128, MODP = 136;
__device__ __forceinline__ void phase_mod(const Frame& F0, KArgs A) {
    Frame F = launder(F0);
    const int n0 = blockIdx.x * MODC, l = n0 / N_MOD, cl = n0 - l * N_MOD;
    const float* W = A->in[I_WMOD] + (size_t)l * DM * N_MOD + cl;
    LAS bf16* Bt = (LAS bf16*)F.lds;
    LAS bf16* As = (LAS bf16*)(F.lds + 2 * MODC * MODP * 2);
    for (int i = F.tid; i < 2 * 12 * MODP; i += NTHR) { const int b = i / (12 * MODP), r = i % (12 * MODP); As[(b * 144 + 132) * MODP + r] = (bf16)0; }
    f32x4 wa[6], wb[6], creg[9];
    auto load_w = [&](f32x4 (&wr)[6], int kc) {
#pragma unroll
        for (int j = 0; j < 6; ++j) { const int idx = F.tid + NTHR * j, n = idx % MODC, k = 4 * (idx / MODC); const float* p = W + (size_t)(kc * MODK + k) * N_MOD + n;
            wr[j].x = __builtin_nontemporal_load(p); wr[j].y = __builtin_nontemporal_load(p + N_MOD); wr[j].z = __builtin_nontemporal_load(p + 2 * N_MOD); wr[j].w = __builtin_nontemporal_load(p + 3 * (size_t)N_MOD); }
    };
    auto load_c = [&](int kc) {
#pragma unroll
        for (int j = 0; j < 9; ++j) { const int idx = F.tid + NTHR * j, r = idx >> 5, k4 = (idx & 31) * 4;
            const float* src = r < NB ? A->in[I_CP] + (size_t)r * DM : A->in[I_CS] + (size_t)(r - NB) * DM;
            creg[j] = r < NB + NS ? *(const GAS f32x4*)(src + kc * MODK + k4) : (f32x4){0.f, 0.f, 0.f, 0.f}; }
    };
    auto store_w = [&](const f32x4 (&wr)[6], int buf) {
#pragma unroll
        for (int j = 0; j < 6; ++j) { const int idx = F.tid + NTHR * j, n = idx % MODC, k = 4 * (idx / MODC);
            v2u w; w.x = pk2(wr[j].x, wr[j].y); w.y = pk2(wr[j].z, wr[j].w); *(LAS v2u*)(Bt + (buf * MODC + n) * MODP + k) = w; }
    };
    auto store_c = [&](int buf) {
#pragma unroll
        for (int j = 0; j < 9; ++j) { const int idx = F.tid + NTHR * j, r = idx >> 5, k4 = (idx & 31) * 4;
            if (r < NB + NS) { v2u w; w.x = pk2(siluf_(creg[j].x), siluf_(creg[j].y)); w.y = pk2(siluf_(creg[j].z), siluf_(creg[j].w)); *(LAS v2u*)(As + (buf * 144 + r) * MODP + k4) = w; } }
    };
    f32x4 acc[9];
#pragma unroll
    for (int m = 0; m < 9; ++m) acc[m] = (f32x4){0.f, 0.f, 0.f, 0.f};
    auto compute = [&](int buf) {
        if (F.wave < 6) {
#pragma unroll
            for (int ks = 0; ks < MODK / 32; ++ks) { const bf16x8 bfr = *(const LAS bf16x8*)(Bt + (buf * MODC + 16 * F.wave + (F.lane & 15)) * MODP + 32 * ks + 8 * (F.lane >> 4));
#pragma unroll
                for (int m = 0; m < 9; ++m) { const bf16x8 af = *(const LAS bf16x8*)(As + (buf * 144 + 16 * m + (F.lane & 15)) * MODP + 32 * ks + 8 * (F.lane >> 4));
                    acc[m] = __builtin_amdgcn_mfma_f32_16x16x32_bf16(af, bfr, acc[m], 0, 0, 0); } }
        }
    };
    const int kst = blockIdx.x & 15;
    load_w(wa, kst); load_c(kst); load_w(wb, (1 + kst) & 15);
    store_w(wa, 0); store_c(0); __syncthreads();
#pragma unroll 1
    for (int kc = 0; kc < DM / MODK; kc += 2) {
        load_c((kc + 1 + kst) & 15); if (kc + 2 < DM / MODK) load_w(wa, (kc + 2 + kst) & 15);
        compute(0);
        store_w(wb, 1); store_c(1); __syncthreads();
        if (kc + 2 < DM / MODK) { load_c((kc + 2 + kst) & 15); if (kc + 3 < DM / MODK) load_w(wb, (kc + 3 + kst) & 15); }
        compute(1);
        if (kc + 2 < DM / MODK) { store_w(wa, 0); store_c(0); }
        __syncthreads();
    }
    if (F.wave < 6) { float* MOD = WSP(float, WS_MOD); const int col = n0 + 16 * F.wave + (F.lane & 15); const float bias = A->in[I_BMOD][col];
#pragma unroll
        for (int m = 0; m < 9; ++m)
#pragma unroll
            for (int r = 0; r < 4; ++r) { const int row = 16 * m + 4 * (F.lane >> 4) + r; if (row < NB + NS) MOD[(size_t)row * MOD_PITCH + col] = acc[m][r] + bias; } }
    __syncthreads();
}
__device__ __forceinline__ void tjob(Frame& F, LAS float* scr, const float* W, int ld, int K, int ncols, int c0, bf16* WT, int row_off, int pitch = 0) {
    if (pitch == 0) pitch = K;
    const int nit = (K / 64) * (ncols / 32), ST = GRID * NWAVES;
#pragma unroll 1
    for (int it = F.gw; it < nit; it += 2 * ST) { float ta[32], tb[32]; const bool two = it + ST < nit;
        transpose_load(ta, W, ld, ncols, c0, it, F.lane); if (two) transpose_load(tb, W, ld, ncols, c0, it + ST, F.lane);
        transpose_store(ta, pitch, ncols, WT, row_off, scr, it, F.lane); if (two) transpose_store(tb, pitch, ncols, WT, row_off, scr, it + ST, F.lane); }
}
__device__ __forceinline__ void phase_prologue(const Frame& F0, KArgs A) {
    Frame F = launder(F0);
    LAS float* scr = (LAS float*)(F.lds + F.wave * 16384);
#pragma unroll 1
    for (int l = 0; l < DEPTH; ++l) {
        unsigned char* wl = F.ws + WS_W + (size_t)l * WL_END;
        tjob(F, scr, A->in[I_WIN] + (size_t)l * DM * N_IN, N_IN, DM, 4096, 0, (bf16*)(wl + WL_IN), 0);
        tjob(F, scr, A->in[I_WIN] + (size_t)l * DM * N_IN, N_IN, DM, 6144, 4112, (bf16*)(wl + WL_IN), 4096);
        tjob(F, scr, A->in[I_WGLU] + (size_t)l * 512 * 512, 512, 512, 512, 0, (bf16*)(wl + WL_GLU), 0);
        tjob(F, scr, A->in[I_WPA] + (size_t)l * 512 * DM, DM, 512, DM, 0, (bf16*)(wl + WL_PA) + OC_A, 0, OCP);
        tjob(F, scr, A->in[I_WPB] + (size_t)l * 512 * DM, DM, 512, DM, 0, (bf16*)(wl + WL_PA) + OC_B, 0, OCP);
        tjob(F, scr, A->in[I_WPC] + (size_t)l * 1024 * DM, DM, 1024, DM, 0, (bf16*)(wl + WL_PA) + OC_C, 0, OCP);
        tjob(F, scr, A->in[I_WOUT] + (size_t)l * DM * DM, DM, DM, DM, 0, (bf16*)(wl + WL_OUT), 0);
        tjob(F, scr, A->in[I_WUP] + (size_t)l * DM * D_UP, D_UP, DM, D_UP, 0, (bf16*)(wl + WL_UP), -1);
        tjob(F, scr, A->in[I_WDOWN] + (size_t)l * D_FF * DM, DM, D_FF, DM, 0, (bf16*)(wl + WL_DOWN), 0);
    }
    {   bf16* X0 = WSP(bf16, WS_X0);
        for (int r = F.gw; r < MREAL; r += (GRID * NWAVES)) {
            const float* src = r < MPROMPT ? A->in[I_XP] + (size_t)r * DM : A->in[I_XS] + (size_t)(r - MPROMPT) * DM;
            GAS v2u* o = (GAS v2u*)(X0 + (size_t)r * DM) + F.lane;
#pragma unroll
            for (int j = 0; j < 8; ++j) { const f32x4 v = __builtin_nontemporal_load((const f32x4*)src + F.lane + 64 * j); v2u w; w.x = pk2(v.x, v.y); w.y = pk2(v.z, v.w); o[64 * j] = w; }
        }
    }
    {   float* z = WSP(float, WS_SMALL + SM_VSQ);
        const int gt = blockIdx.x * NTHR + F.tid;
        for (int i = gt; i < 4 * MP; i += GRID * NTHR) z[i] = 0.f;
    }
    {   const int gt = blockIdx.x * NTHR + F.tid, NT = GRID * NTHR;
        bf16* WSb = WSP(bf16, WS_SMALL + SM_WS);
        for (int i = gt; i < DEPTH * H_B * 128 * 128; i += NT) { const int jj = i & 127, ii = (i >> 7) & 127; WSb[i] = (bf16)(jj <= ii ? f2bf(A->in[I_WS][i]) : 0u); }
        float* AA = WSP(float, WS_SMALL + SM_S5A); float* BB = WSP(float, WS_SMALL + SM_S5BB); bf16* CT = WSP(bf16, WS_SMALL + SM_S5CT);
        for (int i = gt; i < DEPTH * G_A * P_A; i += NT) {
            const int l = i / (G_A * P_A), g = (i / P_A) % G_A;
            const float dt = expf(A->in[I_LOGDT][l * G_A + g]), lr = A->in[I_LAMRE][i], li = A->in[I_LAMIM][i];
            const float mag = expf(lr * dt); float sn, cs; sincosf(li * dt, &sn, &cs);
            const float ar = mag * cs, ai = mag * sn, den = lr * lr + li * li, nr = ar - 1.0f;
            const float kr = (nr * lr + ai * li) / den, ki = (ai * lr - nr * li) / den;
            float qr = ar, qi = ai;
#pragma unroll
            for (int s = 0; s < 6; ++s) { const float t = qr * qr - qi * qi; qi = 2.0f * qr * qi; qr = t; }
            AA[i * 4 + 0] = ar; AA[i * 4 + 1] = ai; AA[i * 4 + 2] = qr; AA[i * 4 + 3] = qi;
#pragma unroll
            for (int h = 0; h < S5G; ++h) { const float bre = A->in[I_BRE][(size_t)i * S5G + h], bim = A->in[I_BIM][(size_t)i * S5G + h];
                BB[(size_t)i * 32 + h] = kr * bre - ki * bim; BB[(size_t)i * 32 + 16 + h] = kr * bim + ki * bre; }
        }
        {   float* WDT = WSP(float, WS_SMALL + SM_WDT);
            for (int i = gt; i < DEPTH * 16 * DM; i += NT) { const int k = i % DM, hh = (i / DM) & 15, l = i / (16 * DM); WDT[i] = A->in[I_WIN][((size_t)l * DM + k) * N_IN + 4096 + hh]; } }
        for (int i = gt; i < DEPTH * G_A * S5G * 128; i += NT) { const int k = i & 127, lgh = i >> 7;
            const float v = k < 64 ? A->in[I_CRE][(size_t)lgh * 64 + k] : -A->in[I_CIM][(size_t)lgh * 64 + (k - 64)]; CT[i] = (bf16)f2bf(v); }
    }
}

template <bool WITH_DT>
__device__ __forceinline__ void phase_prep(const Frame& F0, const float* X, const float* XS, const float* g, const float* modl, int sh_idx, int sc_idx, const float* win_l, float* DT) {
    Frame F = launder(F0);
    bf16* H = WSP(bf16, WS_H);
    LAS float* wT = (LAS float*)F.lds;
    if (WITH_DT) {
        {   const GAS f32x4* wd = (const GAS f32x4*)WSP(const float, WS_SMALL + SM_WDT);
            f32x4 tw[16];
#pragma unroll
            for (int i = 0; i < 16; ++i) tw[i] = wd[F.tid + i * NTHR];
#pragma unroll
            for (int i = 0; i < 16; ++i) ((LAS f32x4*)wT)[F.tid + i * NTHR] = tw[i]; }
        (void)win_l;
        __syncthreads();
    }
    if (WITH_DT) {
        const bf16* X0 = WSP(const bf16, WS_X0); float* DTo = DT; const int gwv = blockIdx.x * NWAVES + F.wave;
        {   const int row = 4 * gwv; prep_rows4<1>(X0 + (size_t)row * DM, g, modl + (size_t)mod_row(row) * MOD_PITCH, sh_idx, sc_idx, H + (size_t)row * DM, nullptr, DTo + (size_t)row * 16, wT, F.lane); }
        if (gwv < NS) { const int row = MPROMPT + gwv; prep_row<1>(X0 + (size_t)row * DM, g, modl + (size_t)mod_row(row) * MOD_PITCH, sh_idx, sc_idx, H + (size_t)row * DM, nullptr, DTo + (size_t)row * 16, wT, F.lane); }
    } else {
    f32x4 vn[8];
    {   const int r0 = blockIdx.x * NWAVES + F.wave; const int rr0 = r0 < MREAL ? r0 : 0; const GAS f32x4* xr = (const GAS f32x4*)(rr0 < MPROMPT ? X + (size_t)rr0 * DM : XS + (size_t)(rr0 - MPROMPT) * DM) + F.lane;
#pragma unroll
        for (int j = 0; j < 8; ++j) vn[j] = xr[64 * j]; }
    for (int r = blockIdx.x * NWAVES + F.wave; r < MREAL; r += GRID * NWAVES) {
        f32x4 v[8]; float s = 0.f;
#pragma unroll
        for (int j = 0; j < 8; ++j) { v[j] = vn[j]; s += (v[j].x * v[j].x + v[j].y * v[j].y) + (v[j].z * v[j].z + v[j].w * v[j].w); }
        {   const int rn = r + GRID * NWAVES; const int rr1 = rn < MREAL ? rn : r; const GAS f32x4* xr = (const GAS f32x4*)(rr1 < MPROMPT ? X + (size_t)rr1 * DM : XS + (size_t)(rr1 - MPROMPT) * DM) + F.lane;
#pragma unroll
            for (int j = 0; j < 8; ++j) vn[j] = xr[64 * j]; }
        const float rinv = rsqrtf(wave_sum(s) * (1.0f / DM) + EPS);
        const float* mr = modl + (size_t)mod_row(r) * MOD_PITCH;
        const GAS f32x4* gp = (const GAS f32x4*)g + F.lane; const GAS f32x4* shp = (const GAS f32x4*)(mr + sh_idx * DM) + F.lane; const GAS f32x4* scp = (const GAS f32x4*)(mr + sc_idx * DM) + F.lane;
        GAS v2u* o = (GAS v2u*)(H + (size_t)r * DM) + F.lane;
#pragma unroll
        for (int j = 0; j < 8; ++j) { const f32x4 gg = gp[64 * j], sh = shp[64 * j], sc = scp[64 * j];
            v[j] = v[j] * rinv * gg * (sc + 1.0f) + sh;
            v2u w; w.x = pk2(v[j].x, v[j].y); w.y = pk2(v[j].z, v[j].w); o[64 * j] = w; }
        if (WITH_DT) {
            float a16[16];
#pragma unroll
            for (int hh = 0; hh < 16; ++hh) { float a = 0.f;
#pragma unroll
                for (int j = 0; j < 8; ++j) { const f32x4 w = *(const LAS f32x4*)(wT + hh * DM + 4 * F.lane + 256 * j); a += (v[j].x * w.x + v[j].y * w.y) + (v[j].z * w.z + v[j].w * w.w); }
                a16[hh] = a; }
            const float mine = wave_sum16(a16, F.lane);
            if (F.lane < 16) DT[(size_t)r * 16 + F.lane] = mine;
        }
    }
    }
    if (WITH_DT) __syncthreads();
}

__device__ __forceinline__ void phase_final(const Frame& F0, KArgs A, const float* X) {
    Frame F = launder(F0);
    const float* g = A->in[I_GFINAL];
    for (int r = blockIdx.x * NWAVES + F.wave; r < MREAL; r += GRID * NWAVES) {
        const GAS f32x4* xr = (const GAS f32x4*)(X + (size_t)r * DM) + F.lane;
        f32x4 v[8]; float s = 0.f;
#pragma unroll
        for (int j = 0; j < 8; ++j) { v[j] = xr[64 * j]; s += (v[j].x * v[j].x + v[j].y * v[j].y) + (v[j].z * v[j].z + v[j].w * v[j].w); }
        const float rinv = rsqrtf(wave_sum(s) * (1.0f / DM) + EPS);
        GAS f32x4* o = (GAS f32x4*)(F.out + (r < MPROMPT ? O_YP + (size_t)r * DM : O_YS + (size_t)(r - MPROMPT) * DM)) + F.lane;
        const GAS f32x4* gp = (const GAS f32x4*)g + F.lane;
#pragma unroll
        for (int j = 0; j < 8; ++j) o[64 * j] = v[j] * rinv * gp[64 * j];
    }
}
typedef __bf16 bf16x2_t __attribute__((ext_vector_type(2)));
constexpr int HS_PITCH = 136;
template <bool FINAL>
__device__ __forceinline__ void s5_item(KArgs A, unsigned char* ws, float* out, int l, int item, LAS unsigned char* wl, int lane, unsigned* flags = nullptr) {
    const int c = item & 31, g = (item >> 5) & 31, b = item >> 10;
    const int lgp = (l * G_A + g) * P_A + lane;
    const f32x4 aq = *(const GAS f32x4*)((const float*)(ws + WS_SMALL + SM_S5A) + (size_t)lgp * 4);
    const float ar = aq.x, ai = aq.y;
    float br[16], bi[16];
    {   const GAS f32x4* bb = (const GAS f32x4*)((const float*)(ws + WS_SMALL + SM_S5BB) + (size_t)lgp * 32);
#pragma unroll
        for (int q = 0; q < 4; ++q) { const f32x4 v = bb[q]; br[4 * q] = v.x; br[4 * q + 1] = v.y; br[4 * q + 2] = v.z; br[4 * q + 3] = v.w;
                                      const f32x4 w = bb[4 + q]; bi[4 * q] = w.x; bi[4 * q + 1] = w.y; bi[4 * q + 2] = w.z; bi[4 * q + 3] = w.w; } }
    unsigned brp[8], bip[8];
#pragma unroll
    for (int k = 0; k < 8; ++k) { brp[k] = pk2(br[2 * k], br[2 * k + 1]); bip[k] = pk2(bi[2 * k], bi[2 * k + 1]); }
    const int row0 = b * SEQ + c * S5Q;
    const bf16* PROJ = (const bf16*)(ws + WS_BIG);
    const GAS v4u* up = (const GAS v4u*)(PROJ + (size_t)(row0 + lane) * N_INP + PC_UA + g * 16);
    const v4u u0 = up[0], u1 = up[1];
    LAS bf16* Us = (LAS bf16*)(wl + 8704);
    if (FINAL) { *(LAS v4u*)(Us + lane * 16) = u0; *(LAS v4u*)(Us + lane * 16 + 8) = u1; }
    float hr = 0.f, hi = 0.f;
    float* SLOC = (float*)(ws + WS_SMALL + SM_SLOC);
    if (FINAL && flags) {
        float lr = 0.f, li = 0.f;
#pragma unroll 2
        for (int t = 0; t < 64; ++t) {
            unsigned w[8];
            w[0] = __builtin_amdgcn_readlane(u0.x, t); w[1] = __builtin_amdgcn_readlane(u0.y, t); w[2] = __builtin_amdgcn_readlane(u0.z, t); w[3] = __builtin_amdgcn_readlane(u0.w, t);
            w[4] = __builtin_amdgcn_readlane(u1.x, t); w[5] = __builtin_amdgcn_readlane(u1.y, t); w[6] = __builtin_amdgcn_readlane(u1.z, t); w[7] = __builtin_amdgcn_readlane(u1.w, t);
            float sr0 = 0.f, si0 = 0.f, sr1 = 0.f, si1 = 0.f;
#pragma unroll
            for (int k = 0; k < 8; k += 2) {
                sr0 = __builtin_amdgcn_fdot2_f32_bf16(__builtin_bit_cast(bf16x2_t, brp[k]), __builtin_bit_cast(bf16x2_t, w[k]), sr0, false);
                si0 = __builtin_amdgcn_fdot2_f32_bf16(__builtin_bit_cast(bf16x2_t, bip[k]), __builtin_bit_cast(bf16x2_t, w[k]), si0, false);
                sr1 = __builtin_amdgcn_fdot2_f32_bf16(__builtin_bit_cast(bf16x2_t, brp[k + 1]), __builtin_bit_cast(bf16x2_t, w[k + 1]), sr1, false);
                si1 = __builtin_amdgcn_fdot2_f32_bf16(__builtin_bit_cast(bf16x2_t, bip[k + 1]), __builtin_bit_cast(bf16x2_t, w[k + 1]), si1, false); }
            const float nr = ar * lr - ai * li + (sr0 + sr1); li = ar * li + ai * lr + (si0 + si1); lr = nr;
        }
        float* sl = SLOC + (size_t)item * 128 + lane;
        __hip_atomic_store(sl, lr, __ATOMIC_RELAXED, __HIP_MEMORY_SCOPE_AGENT); __hip_atomic_store(sl + 64, li, __ATOMIC_RELAXED, __HIP_MEMORY_SCOPE_AGENT);
        asm volatile("s_waitcnt vmcnt(0)" ::: "memory");
        if (lane == 0) __hip_atomic_store(flags + item, 1u, __ATOMIC_RELAXED, __HIP_MEMORY_SCOPE_AGENT);
        {
            unsigned sp_ = 0;
            for (;;) { const unsigned f = lane < c ? __hip_atomic_load(flags + (item - c + lane), __ATOMIC_RELAXED, __HIP_MEMORY_SCOPE_AGENT) : 1u;
                if (__builtin_amdgcn_ballot_w64(f == 0u) == 0ull || ++sp_ > (1u << 20)) break; __builtin_amdgcn_s_sleep(1); }
            __builtin_amdgcn_fence(__ATOMIC_ACQUIRE, "agent"); }
        asm volatile("s_waitcnt vmcnt(0)" ::: "memory");
    }
    if (FINAL) {
        const float qr = aq.z, qi = aq.w;
        const float* sl = SLOC + (size_t)((b * G_A + g) * S5NC) * 128 + lane;
        float psr[31], psi[31];
#pragma unroll
        for (int k = 0; k < 31; ++k) { const int kk = k < c ? k : 0; psr[k] = sl[kk * 128]; psi[k] = sl[kk * 128 + 64]; }
#pragma unroll
        for (int k = 0; k < 31; ++k) if (k < c) { const float t = qr * hr - qi * hi + psr[k]; hi = qr * hi + qi * hr + psi[k]; hr = t; }
    }
    LAS bf16* Hs = (LAS bf16*)wl;
    bf16x8 cfr[4];
    if (FINAL) { const bf16* ct = (const bf16*)(ws + WS_SMALL + SM_S5CT) + (size_t)((l * G_A + g) * S5G + (lane & 15)) * 128 + 8 * (lane >> 4);
#pragma unroll
        for (int ks = 0; ks < 4; ++ks) cfr[ks] = *(const GAS bf16x8*)(ct + 32 * ks); }
#pragma unroll 1
    for (int half = 0; half < 2; ++half) {
#pragma unroll 2
        for (int tt = 0; tt < 32; ++tt) {
            const int t = half * 32 + tt;
            unsigned w[8];
            w[0] = __builtin_amdgcn_readlane(u0.x, t); w[1] = __builtin_amdgcn_readlane(u0.y, t); w[2] = __builtin_amdgcn_readlane(u0.z, t); w[3] = __builtin_amdgcn_readlane(u0.w, t);
            w[4] = __builtin_amdgcn_readlane(u1.x, t); w[5] = __builtin_amdgcn_readlane(u1.y, t); w[6] = __builtin_amdgcn_readlane(u1.z, t); w[7] = __builtin_amdgcn_readlane(u1.w, t);
            float sr0 = 0.f, si0 = 0.f, sr1 = 0.f, si1 = 0.f;
#pragma unroll
            for (int k = 0; k < 8; k += 2) {
                sr0 = __builtin_amdgcn_fdot2_f32_bf16(__builtin_bit_cast(bf16x2_t, brp[k]), __builtin_bit_cast(bf16x2_t, w[k]), sr0, false);
                si0 = __builtin_amdgcn_fdot2_f32_bf16(__builtin_bit_cast(bf16x2_t, bip[k]), __builtin_bit_cast(bf16x2_t, w[k]), si0, false);
                sr1 = __builtin_amdgcn_fdot2_f32_bf16(__builtin_bit_cast(bf16x2_t, brp[k + 1]), __builtin_bit_cast(bf16x2_t, w[k + 1]), sr1, false);
                si1 = __builtin_amdgcn_fdot2_f32_bf16(__builtin_bit_cast(bf16x2_t, bip[k + 1]), __builtin_bit_cast(bf16x2_t, w[k + 1]), si1, false); }
            const float sr = sr0 + sr1, si = si0 + si1;
            const float nr = ar * hr - ai * hi + sr; hi = ar * hi + ai * hr + si; hr = nr;
            if (FINAL) { Hs[tt * HS_PITCH + lane] = (bf16)f2bf(hr); Hs[tt * HS_PITCH + 64 + lane] = (bf16)f2bf(hi); }
        }
        if (FINAL) {
            bf16* YB = (bf16*)(ws + WS_YB);
            const float* dsk = A->in[I_S5D] + l * D_A + g * 16;
#pragma unroll
            for (int tile = 0; tile < 2; ++tile) {
                f32x4 acc = {0.f, 0.f, 0.f, 0.f};
#pragma unroll
                for (int ks = 0; ks < 4; ++ks) { const bf16x8 a = *(const LAS bf16x8*)(Hs + (tile * 16 + (lane & 15)) * HS_PITCH + 32 * ks + 8 * (lane >> 4));
                    acc = __builtin_amdgcn_mfma_f32_16x16x32_bf16(a, cfr[ks], acc, 0, 0, 0); }
                const int hh = lane & 15; const float dd = dsk[hh];
#pragma unroll
                for (int r = 0; r < 4; ++r) { const int row = row0 + half * 32 + tile * 16 + 4 * (lane >> 4) + r;
                    const float u = bf2f(Us[(row - row0) * 16 + hh]);
                    YB[(size_t)row * 512 + g * 16 + hh] = (bf16)f2bf(gelu_tanh(acc[r] + dd * u)); }
            }
        }
    }
    if (!FINAL) { float* sl = SLOC + (size_t)item * 128 + lane; sl[0] = hr; sl[64] = hi; }
    if (FINAL && c == S5NC - 1) { const size_t o = (size_t)((l * NB + b) * G_A + g) * P_A + lane; out[O_S5RP + o] = hr; out[O_S5IP + o] = hi; }
}

__device__ __forceinline__ void s5_sample_item(KArgs A, unsigned char* ws, float* out, int l, int item, int lane) {
    const int g = item & 31, s = item >> 5, row = MPROMPT + s;
    const int lgp = (l * G_A + g) * P_A + lane;
    const f32x4 aq = *(const GAS f32x4*)((const float*)(ws + WS_SMALL + SM_S5A) + (size_t)lgp * 4);
    const bf16* PROJ = (const bf16*)(ws + WS_BIG);
    const GAS v4u* up = (const GAS v4u*)(PROJ + (size_t)row * N_INP + PC_UA + g * 16);
    const v4u u0 = up[0], u1 = up[1];
    float u[16]; u[0] = bflo(u0.x); u[1] = bfhi(u0.x); u[2] = bflo(u0.y); u[3] = bfhi(u0.y); u[4] = bflo(u0.z); u[5] = bfhi(u0.z); u[6] = bflo(u0.w); u[7] = bfhi(u0.w);
    u[8] = bflo(u1.x); u[9] = bfhi(u1.x); u[10] = bflo(u1.y); u[11] = bfhi(u1.y); u[12] = bflo(u1.z); u[13] = bfhi(u1.z); u[14] = bflo(u1.w); u[15] = bfhi(u1.w);
    const GAS f32x4* bb = (const GAS f32x4*)((const float*)(ws + WS_SMALL + SM_S5BB) + (size_t)lgp * 32);
    float sr = 0.f, si = 0.f;
#pragma unroll
    for (int q = 0; q < 4; ++q) { const f32x4 v = bb[q], w = bb[4 + q];
        sr += v.x * u[4 * q] + v.y * u[4 * q + 1] + v.z * u[4 * q + 2] + v.w * u[4 * q + 3];
        si += w.x * u[4 * q] + w.y * u[4 * q + 1] + w.z * u[4 * q + 2] + w.w * u[4 * q + 3]; }
    const size_t so = (size_t)((l * NS + s) * G_A + g) * P_A + lane;
    const float h0r = A->in[I_S5RE][so], h0i = A->in[I_S5IM][so];
    const float hr = aq.x * h0r - aq.y * h0i + sr, hi = aq.x * h0i + aq.y * h0r + si;
    out[O_S5RS + so] = hr; out[O_S5IS + so] = hi;
    const float* cre = A->in[I_CRE] + (size_t)((l * G_A + g) * S5G) * P_A + lane; const float* cim = A->in[I_CIM] + (size_t)((l * G_A + g) * S5G) * P_A + lane;
    float y16[16];
#pragma unroll
    for (int hh = 0; hh < 16; ++hh) y16[hh] = cre[hh * P_A] * hr - cim[hh * P_A] * hi;
    const float mine = wave_sum16(y16, lane);
    if (lane < 16) { const float dd = A->in[I_S5D][l * D_A + g * 16 + lane]; float uu = 0.f;
#pragma unroll
        for (int hh = 0; hh < 16; ++hh) uu = (lane == hh) ? u[hh] : uu;
        ((bf16*)(ws + WS_YB))[(size_t)row * 512 + g * 16 + lane] = (bf16)f2bf(gelu_tanh(mine + dd * uu)); }
}
__device__ __forceinline__ void gmlp_sample_item(KArgs A, unsigned char* ws, float* out, int l, int s, int lane) {
    const int row = MPROMPT + s, ch0 = lane * 8;
    const bf16* PROJ = (const bf16*)(ws + WS_BIG);
    const v4u vv = *(const GAS v4u*)(PROJ + (size_t)row * N_INP + PC_VB + ch0), uu = *(const GAS v4u*)(PROJ + (size_t)row * N_INP + PC_UB + ch0);
    const float rinv = rsqrtf(((const float*)(ws + WS_SMALL + SM_VSQ))[l * MP + row] * (1.0f / D_B) + EPS);
    const int h = ch0 >> 6;
    const float w00 = A->in[I_WS][(size_t)(l * H_B + h) * 128 * 128], b0 = A->in[I_BS][(l * H_B + h) * 128];
    float v[8] = {bflo(vv.x), bfhi(vv.x), bflo(vv.y), bfhi(vv.y), bflo(vv.z), bfhi(vv.z), bflo(vv.w), bfhi(vv.w)};
    float u[8] = {bflo(uu.x), bfhi(uu.x), bflo(uu.y), bfhi(uu.y), bflo(uu.z), bfhi(uu.z), bflo(uu.w), bfhi(uu.w)};
    const float* gv = A->in[I_GV] + l * D_B + ch0;
    float o[8];
#pragma unroll
    for (int j = 0; j < 8; ++j) { const float vn = v[j] * rinv * gv[j]; out[O_GVS + (size_t)(l * NS + s) * D_B + ch0 + j] = vn; o[j] = u[j] * (w00 * vn + b0); }
    v4u w; w.x = pk2(o[0], o[1]); w.y = pk2(o[2], o[3]); w.z = pk2(o[4], o[5]); w.w = pk2(o[6], o[7]);
    *(GAS v4u*)((bf16*)(ws + WS_OCAT) + (size_t)row * OCP + OC_B + ch0) = w;
}
__device__ __forceinline__ void ssd_sample_item(KArgs A, unsigned char* ws, float* out, int l, int item, int lane, bool acc) {
    const int h = item & 15, s = item >> 4, row = MPROMPT + s, g = h >> 3;
    const bf16* PROJ = (const bf16*)(ws + WS_BIG);
    const float* cw = A->in[I_CONVW] + (size_t)l * K_C * D_XBC; const float* cb = A->in[I_CONVB] + l * D_XBC;
    const float* cst = A->in[I_SSDCONV] + (size_t)(l * NS + s) * 3 * D_XBC;
    float* cso = out + O_CCS + (size_t)(l * NS + s) * 3 * D_XBC;
    float x;
    {   const int ch = h * 64 + lane; const float p0 = cst[ch], p1 = cst[D_XBC + ch], p2 = cst[2 * D_XBC + ch], p3 = bf2f(PROJ[(size_t)row * N_INP + PC_XBC + ch]);
        x = siluf_(cb[ch] + cw[ch] * p0 + cw[D_XBC + ch] * p1 + cw[2 * D_XBC + ch] * p2 + cw[3 * D_XBC + ch] * p3);
        cso[ch] = p1; cso[D_XBC + ch] = p2; cso[2 * D_XBC + ch] = p3; }
    const int n4 = (lane & 31) * 4; float Bv[4], Cv[4];
#pragma unroll
    for (int j = 0; j < 4; ++j) {
        {   const int ch = D_C + g * N_C + n4 + j; const float p0 = cst[ch], p1 = cst[D_XBC + ch], p2 = cst[2 * D_XBC + ch], p3 = bf2f(PROJ[(size_t)row * N_INP + PC_XBC + ch]);
            Bv[j] = siluf_(cb[ch] + cw[ch] * p0 + cw[D_XBC + ch] * p1 + cw[2 * D_XBC + ch] * p2 + cw[3 * D_XBC + ch] * p3);
            if ((h & 7) == 0 && lane < 32) { cso[ch] = p1; cso[D_XBC + ch] = p2; cso[2 * D_XBC + ch] = p3; } }
        {   const int ch = D_C + G_C * N_C + g * N_C + n4 + j; const float p0 = cst[ch], p1 = cst[D_XBC + ch], p2 = cst[2 * D_XBC + ch], p3 = bf2f(PROJ[(size_t)row * N_INP + PC_XBC + ch]);
            Cv[j] = siluf_(cb[ch] + cw[ch] * p0 + cw[D_XBC + ch] * p1 + cw[2 * D_XBC + ch] * p2 + cw[3 * D_XBC + ch] * p3);
            if ((h & 7) == 0 && lane < 32) { cso[ch] = p1; cso[D_XBC + ch] = p2; cso[2 * D_XBC + ch] = p3; } }
    }
    const float dt = softplusf_(((const float*)(ws + WS_SMALL + SM_DT))[(size_t)row * 16 + h] + A->in[I_DTBIAS][l * H_C + h]);
    const float dA = __expf(dt * -__expf(A->in[I_ALOG][l * H_C + h]));
    const size_t sbase = (size_t)((l * NS + s) * H_C + h) * HD_C * N_C;
    const GAS f32x4* st = (const GAS f32x4*)(A->in[I_SSM] + sbase) + lane;
    GAS f32x4* so = (GAS f32x4*)(out + O_SSMS + sbase) + lane;
    float part[32];
#pragma unroll
    for (int i = 0; i < 32; ++i) {
        const float xe = lane_bcast(x, 2 * i), xo = lane_bcast(x, 2 * i + 1); const float xv = lane < 32 ? xe : xo; const float xd = xv * dt;
        f32x4 v = __builtin_nontemporal_load(st + 64 * i);
        v.x = v.x * dA + xd * Bv[0]; v.y = v.y * dA + xd * Bv[1]; v.z = v.z * dA + xd * Bv[2]; v.w = v.w * dA + xd * Bv[3];
        __builtin_nontemporal_store(v, so + 64 * i);
        part[i] = v.x * Cv[0] + v.y * Cv[1] + v.z * Cv[2] + v.w * Cv[3];
    }
    const float ymine = half_sum32(part, lane);
    const float xmine = __builtin_bit_cast(float, __builtin_amdgcn_ds_bpermute((2 * (lane & 31) + (lane >> 5)) << 2, __builtin_bit_cast(int, x)));
    const int p = 2 * (lane & 31) + (lane >> 5), ch = h * 64 + p;
    const float y = ymine + A->in[I_SSDD][l * H_C + h] * xmine;
    const float z = bf2f(PROJ[(size_t)row * N_INP + PC_Z + ch]);
    const float yz = y * siluf_(z);
    const float sq = wave_sum(yz * yz);
    if (lane == 0 && acc) atomicAdd((float*)(ws + WS_SMALL + SM_CSQ) + l * MP + row, sq);
    ((bf16*)(ws + WS_OCAT))[(size_t)row * OCP + OC_C + ch] = (bf16)f2bf(yz * A->in[I_GNORM][l * D_C + ch]);
}
constexpr int TP = 136;
__device__ __forceinline__ void gmlp_item(KArgs A, unsigned char* ws, int l, int item, LAS unsigned char* lds, int tid, int wave, int lane) {
    const int h = item & 7, c = (item >> 3) & 15, b = item >> 7, row0 = b * SEQ + c * GMC;
    const bf16* PROJ = (const bf16*)(ws + WS_BIG);
    LAS bf16* vT = (LAS bf16*)lds;
    {   const int tok = tid >> 2, part = tid & 3, d0 = part * 16, row = row0 + tok;
        const float rinv = rsqrtf(((const float*)(ws + WS_SMALL + SM_VSQ))[l * MP + row] * (1.0f / D_B) + EPS);
        const GAS v4u* vp = (const GAS v4u*)(PROJ + (size_t)row * N_INP + PC_VB + h * 64 + d0);
        const v4u a = vp[0], b2 = vp[1];
        const float* gv = A->in[I_GV] + l * D_B + h * 64 + d0;
        const unsigned wv[8] = {a.x, a.y, a.z, a.w, b2.x, b2.y, b2.z, b2.w};
#pragma unroll
        for (int k = 0; k < 8; ++k) { vT[(d0 + 2 * k) * TP + tok] = (bf16)f2bf(bflo(wv[k]) * rinv * gv[2 * k]); vT[(d0 + 2 * k + 1) * TP + tok] = (bf16)f2bf(bfhi(wv[k]) * rinv * gv[2 * k + 1]); }
    }
    const bf16* WSb = (const bf16*)(ws + WS_SMALL + SM_WS) + (size_t)(l * H_B + h) * 128 * 128;
    bf16x8 afr[4];
#pragma unroll
    for (int ks = 0; ks < 4; ++ks) afr[ks] = *(const GAS bf16x8*)(WSb + (size_t)(16 * wave + (lane & 15)) * 128 + 32 * ks + 8 * (lane >> 4));
    __syncthreads();
    f32x4 acc[4];
#pragma unroll
    for (int t = 0; t < 4; ++t) acc[t] = (f32x4){0.f, 0.f, 0.f, 0.f};
    const int nks = (wave >> 1) + 1;
#pragma unroll
    for (int ks = 0; ks < 4; ++ks) if (ks < nks) {
#pragma unroll
        for (int t = 0; t < 4; ++t) { const bf16x8 bfr = *(const LAS bf16x8*)(vT + (16 * t + (lane & 15)) * TP + 32 * ks + 8 * (lane >> 4));
            acc[t] = __builtin_amdgcn_mfma_f32_16x16x32_bf16(afr[ks], bfr, acc[t], 0, 0, 0); }
    }
    bf16* OB = (bf16*)(ws + WS_OCAT) + OC_B;
#pragma unroll
    for (int r = 0; r < 4; ++r) { const int i = 16 * wave + 4 * (lane >> 4) + r, row = row0 + i; const float bs = A->in[I_BS][(l * H_B + h) * 128 + i];
#pragma unroll
        for (int t = 0; t < 4; ++t) { const int ch = h * 64 + 16 * t + (lane & 15);
            const float u = bf2f(PROJ[(size_t)row * N_INP + PC_UB + ch]);
            OB[(size_t)row * OCP + ch] = (bf16)f2bf(u * (acc[t][r] + bs)); } }
    __syncthreads();
}

template <int NCH, bool TRANS>
__device__ __forceinline__ void conv_tile(KArgs A, const bf16* PROJ, int l, int b, int c, int chb, LAS bf16* tile, const LAS float* scale, int tid) {
    constexpr int LPR = NCH / 8, SLOTS = NTHR / LPR, TPT = 128 / SLOTS;
    const int cl = tid % LPR, slot = tid / LPR, ch0 = chb + cl * 8, t0 = slot * TPT;
    const float* cw = A->in[I_CONVW] + (size_t)l * K_C * D_XBC + ch0; const float* cb = A->in[I_CONVB] + l * D_XBC + ch0;
    float w[4][8], bias[8];
#pragma unroll
    for (int k = 0; k < 4; ++k) { const f32x4 a = *(const GAS f32x4*)(cw + k * D_XBC), b2 = *(const GAS f32x4*)(cw + k * D_XBC + 4);
        w[k][0] = a.x; w[k][1] = a.y; w[k][2] = a.z; w[k][3] = a.w; w[k][4] = b2.x; w[k][5] = b2.y; w[k][6] = b2.z; w[k][7] = b2.w; }
    {   const f32x4 a = *(const GAS f32x4*)cb, b2 = *(const GAS f32x4*)(cb + 4); bias[0] = a.x; bias[1] = a.y; bias[2] = a.z; bias[3] = a.w; bias[4] = b2.x; bias[5] = b2.y; bias[6] = b2.z; bias[7] = b2.w; }
    const int trow0 = c * SSDQ + t0;
    v4u raw[TPT + 3];
#pragma unroll
    for (int i = 0; i < TPT + 3; ++i) { const int tt = trow0 - 3 + i;
        raw[i] = tt >= 0 ? *(const GAS v4u*)(PROJ + (size_t)(b * SEQ + tt) * N_INP + PC_XBC + ch0) : (v4u){0u, 0u, 0u, 0u}; }
    float o[TPT][8];
#pragma unroll
    for (int t = 0; t < TPT; ++t) {
#pragma unroll
        for (int e = 0; e < 8; ++e) o[t][e] = bias[e];
#pragma unroll
        for (int k = 0; k < 4; ++k) { const v4u r = raw[t + k]; const unsigned rw[4] = {r.x, r.y, r.z, r.w};
#pragma unroll
            for (int e2 = 0; e2 < 4; ++e2) { o[t][2 * e2] = fmaf(w[k][2 * e2], bflo(rw[e2]), o[t][2 * e2]); o[t][2 * e2 + 1] = fmaf(w[k][2 * e2 + 1], bfhi(rw[e2]), o[t][2 * e2 + 1]); } }
        const float sc = scale ? scale[t0 + t] : 1.0f;
#pragma unroll
        for (int e = 0; e < 8; ++e) o[t][e] = siluf_(o[t][e]) * sc;
    }
    if (!TRANS) {
#pragma unroll
        for (int t = 0; t < TPT; ++t) { v4u wv; wv.x = pk2(o[t][0], o[t][1]); wv.y = pk2(o[t][2], o[t][3]); wv.z = pk2(o[t][4], o[t][5]); wv.w = pk2(o[t][6], o[t][7]);
            *(LAS v4u*)(tile + (t0 + t) * TP + cl * 8) = wv; }
    } else {
#pragma unroll
        for (int e = 0; e < 8; ++e) {
            if (TPT == 4) { v2u wv; wv.x = pk2(o[0][e], o[1][e]); wv.y = pk2(o[TPT > 2 ? 2 : 0][e], o[TPT > 3 ? 3 : 0][e]); *(LAS v2u*)(tile + (cl * 8 + e) * TP + t0) = wv; }
            else { *(LAS unsigned*)(tile + (cl * 8 + e) * TP + t0) = pk2(o[0][e], o[1][e]); }
        }
    }
}

__device__ __forceinline__ void ssd_dt_scan(KArgs A, unsigned char* ws, int l, int b, int c, int h, LAS float* dtv, LAS float* cs, int tid, int lane) {
    if (tid < 64) {
        const float* DT = (const float*)(ws + WS_SMALL + SM_DT); const float bias = A->in[I_DTBIAS][l * H_C + h], a = -__expf(A->in[I_ALOG][l * H_C + h]);
        const int row = b * SEQ + c * SSDQ + 2 * lane;
        const float d0 = softplusf_(DT[(size_t)row * 16 + h] + bias), d1 = softplusf_(DT[(size_t)(row + 1) * 16 + h] + bias);
        const float v0 = d0 * a, v1 = d1 * a; float s = v0 + v1;
#pragma unroll
        for (int o = 1; o < 64; o <<= 1) { const float t = __builtin_bit_cast(float, __builtin_amdgcn_ds_bpermute((lane - o) << 2, __builtin_bit_cast(int, s))); if (lane >= o) s += t; }
        dtv[2 * lane] = d0; dtv[2 * lane + 1] = d1; cs[2 * lane] = s - v1; cs[2 * lane + 1] = s;
    }
    __syncthreads();
}

constexpr int SL_CN = 0, SL_BN = 34816, SL_MW = 69632, SL_XT = 104448, SL_HP = 121856, SL_DT = 139264, SL_CS = SL_DT + 512, SL_SC = SL_CS + 512, SL_END = SL_SC + 512;

__device__ __forceinline__ void ssd_item1(KArgs A, unsigned char* ws, int l, int item, LAS unsigned char* lds, int tid, int wave, int lane) {
    const int h = item & 15, c = (item >> 4) & 15, b = item >> 8, g = h >> 3;
    const bf16* PROJ = (const bf16*)(ws + WS_BIG);
    LAS float* dtv = (LAS float*)(lds + SL_DT); LAS float* cs = (LAS float*)(lds + SL_CS); LAS float* sc = (LAS float*)(lds + SL_SC);
    LAS bf16* Xt = (LAS bf16*)(lds + SL_XT); LAS bf16* Bt = (LAS bf16*)(lds + SL_BN);
    (void)sc;
    conv_tile<64, true>(A, PROJ, l, b, c, h * 64, Xt, nullptr, tid);
    conv_tile<128, true>(A, PROJ, l, b, c, D_C + g * N_C, Bt, nullptr, tid);
    ssd_dt_scan(A, ws, l, b, c, h, dtv, cs, tid, lane);
    f32x4 acc[4];
#pragma unroll
    for (int t = 0; t < 4; ++t) acc[t] = (f32x4){0.f, 0.f, 0.f, 0.f};
    const float cse = cs[127];
#pragma unroll
    for (int ks = 0; ks < 4; ++ks) { const int j0 = 32 * ks + 8 * (lane >> 4);
        const v4u braw = *(const LAS v4u*)(Bt + (16 * wave + (lane & 15)) * TP + j0);
        const f32x4 d0 = *(const LAS f32x4*)(dtv + j0), d1 = *(const LAS f32x4*)(dtv + j0 + 4), c0 = *(const LAS f32x4*)(cs + j0), c1 = *(const LAS f32x4*)(cs + j0 + 4);
        v4u bs;
        bs.x = pk2(bflo(braw.x) * d0.x * __expf(cse - c0.x), bfhi(braw.x) * d0.y * __expf(cse - c0.y)); bs.y = pk2(bflo(braw.y) * d0.z * __expf(cse - c0.z), bfhi(braw.y) * d0.w * __expf(cse - c0.w));
        bs.z = pk2(bflo(braw.z) * d1.x * __expf(cse - c1.x), bfhi(braw.z) * d1.y * __expf(cse - c1.y)); bs.w = pk2(bflo(braw.w) * d1.z * __expf(cse - c1.z), bfhi(braw.w) * d1.w * __expf(cse - c1.w));
        const bf16x8 bfr = __builtin_bit_cast(bf16x8, bs);
#pragma unroll
        for (int t = 0; t < 4; ++t) { const bf16x8 af = *(const LAS bf16x8*)(Xt + (16 * t + (lane & 15)) * TP + 32 * ks + 8 * (lane >> 4));
            acc[t] = __builtin_amdgcn_mfma_f32_16x16x32_bf16(af, bfr, acc[t], 0, 0, 0); } }
    float* ST = (float*)(ws + WS_STATES) + (size_t)item * HD_C * N_C;
#pragma unroll
    for (int t = 0; t < 4; ++t)
#pragma unroll
        for (int r = 0; r < 4; ++r) ST[(size_t)(16 * t + 4 * (lane >> 4) + r) * N_C + 16 * wave + (lane & 15)] = acc[t][r];
    if (tid == 0) ((float*)(ws + WS_SMALL + SM_SDEC))[item] = __expf(cs[127]);
    __syncthreads();
}

__device__ __forceinline__ void ssd_item2(KArgs A, unsigned char* ws, float* out, int l, int item, LAS unsigned char* lds, int tid, int wave, int lane, bool acc) {
    const int h = item & 15, c = (item >> 4) & 15, b = item >> 8, g = h >> 3, row0 = b * SEQ + c * SSDQ;
    const bf16* PROJ = (const bf16*)(ws + WS_BIG);
    LAS float* dtv = (LAS float*)(lds + SL_DT); LAS float* cs = (LAS float*)(lds + SL_CS);
    LAS bf16* Cn = (LAS bf16*)(lds + SL_CN); LAS bf16* Bn = (LAS bf16*)(lds + SL_BN); LAS bf16* Mw = (LAS bf16*)(lds + SL_MW);
    LAS bf16* Xt = (LAS bf16*)(lds + SL_XT); LAS bf16* Hp = (LAS bf16*)(lds + SL_HP);
    conv_tile<64, true>(A, PROJ, l, b, c, h * 64, Xt, nullptr, tid);
    conv_tile<128, false>(A, PROJ, l, b, c, D_C + g * N_C, Bn, nullptr, tid);
    conv_tile<128, false>(A, PROJ, l, b, c, D_C + G_C * N_C + g * N_C, Cn, nullptr, tid);
    {   const float* ST = (const float*)(ws + WS_STATES) + (size_t)((b * 16) * 16 + h) * HD_C * N_C + tid * 4;
        const float* SD = (const float*)(ws + WS_SMALL + SM_SDEC) + (b * 16) * 16 + h;
        f32x4 hv[4];
#pragma unroll
        for (int k = 0; k < 4; ++k) hv[k] = (f32x4){0.f, 0.f, 0.f, 0.f};
        int cc = 0;
        for (; cc + 4 <= c; cc += 4) { f32x4 sv[4][4]; float d[4];
#pragma unroll
            for (int q = 0; q < 4; ++q) { d[q] = SD[(cc + q) * 16];
#pragma unroll
                for (int k = 0; k < 4; ++k) sv[q][k] = *(const GAS f32x4*)(ST + (size_t)(cc + q) * 16 * 8192 + 2048 * k); }
#pragma unroll
            for (int q = 0; q < 4; ++q)
#pragma unroll
                for (int k = 0; k < 4; ++k) hv[k] = hv[k] * d[q] + sv[q][k]; }
        for (; cc < c; ++cc) { const float d = SD[cc * 16];
#pragma unroll
            for (int k = 0; k < 4; ++k) hv[k] = hv[k] * d + *(const GAS f32x4*)(ST + (size_t)cc * 16 * 8192 + 2048 * k); }
#pragma unroll
        for (int k = 0; k < 4; ++k) { v2u wv; wv.x = pk2(hv[k].x, hv[k].y); wv.y = pk2(hv[k].z, hv[k].w); *(LAS v2u*)(Hp + ((tid >> 5) + 16 * k) * TP + (tid & 31) * 4) = wv; }
        if (c == SSDNC - 1) { const float d = SD[c * 16]; float* o = out + O_SSMP + (size_t)((l * NB + b) * H_C + h) * HD_C * N_C + tid * 4;
#pragma unroll
            for (int k = 0; k < 4; ++k) *(GAS f32x4*)(o + 2048 * k) = hv[k] * d + *(const GAS f32x4*)(ST + (size_t)c * 16 * 8192 + 2048 * k); }
    }
    ssd_dt_scan(A, ws, l, b, c, h, dtv, cs, tid, lane);
    bf16x8 cf[4];
#pragma unroll
    for (int ks = 0; ks < 4; ++ks) cf[ks] = *(const LAS bf16x8*)(Cn + (16 * wave + (lane & 15)) * TP + 32 * ks + 8 * (lane >> 4));
    const int jtmax = wave | 1;
    for (int jt = 0; jt <= jtmax; ++jt) {
        f32x4 gacc = {0.f, 0.f, 0.f, 0.f};
        if (jt <= wave) {
#pragma unroll
            for (int ks = 0; ks < 4; ++ks) { const bf16x8 bfr = *(const LAS bf16x8*)(Bn + (16 * jt + (lane & 15)) * TP + 32 * ks + 8 * (lane >> 4));
                gacc = __builtin_amdgcn_mfma_f32_16x16x32_bf16(cf[ks], bfr, gacc, 0, 0, 0); }
        }
        const int j = 16 * jt + (lane & 15); const float csj = cs[j], dtj = dtv[j];
#pragma unroll
        for (int r = 0; r < 4; ++r) { const int i = 16 * wave + 4 * (lane >> 4) + r;
            const float m = (j <= i) ? gacc[r] * __expf(cs[i] - csj) * dtj : 0.f;
            Mw[i * TP + j] = (bf16)f2bf(m); }
    }
    f32x4 yd[4], yo[4];
#pragma unroll
    for (int t = 0; t < 4; ++t) { yd[t] = (f32x4){0.f, 0.f, 0.f, 0.f}; yo[t] = (f32x4){0.f, 0.f, 0.f, 0.f}; }
    const int nks = (wave >> 1) + 1;
    for (int ks = 0; ks < nks; ++ks) { const bf16x8 mf = *(const LAS bf16x8*)(Mw + (16 * wave + (lane & 15)) * TP + 32 * ks + 8 * (lane >> 4));
#pragma unroll
        for (int t = 0; t < 4; ++t) { const bf16x8 xf = *(const LAS bf16x8*)(Xt + (16 * t + (lane & 15)) * TP + 32 * ks + 8 * (lane >> 4));
            yd[t] = __builtin_amdgcn_mfma_f32_16x16x32_bf16(mf, xf, yd[t], 0, 0, 0); } }
#pragma unroll
    for (int ks = 0; ks < 4; ++ks)
#pragma unroll
        for (int t = 0; t < 4; ++t) { const bf16x8 hf = *(const LAS bf16x8*)(Hp + (16 * t + (lane & 15)) * TP + 32 * ks + 8 * (lane >> 4));
            yo[t] = __builtin_amdgcn_mfma_f32_16x16x32_bf16(cf[ks], hf, yo[t], 0, 0, 0); }
    const float dsk = A->in[I_SSDD][l * H_C + h];
    bf16* OC = (bf16*)(ws + WS_OCAT) + OC_C; float* csq = (float*)(ws + WS_SMALL + SM_CSQ) + l * MP;
#pragma unroll
    for (int r = 0; r < 4; ++r) { const int i = 16 * wave + 4 * (lane >> 4) + r, row = row0 + i; const float ecs = __expf(cs[i]); float sq = 0.f;
#pragma unroll
        for (int t = 0; t < 4; ++t) { const int p = 16 * t + (lane & 15), ch = h * 64 + p;
            const float x = bf2f(Xt[p * TP + i]);
            const float y = yd[t][r] + ecs * yo[t][r] + dsk * x;
            const float z = bf2f(PROJ[(size_t)row * N_INP + PC_Z + ch]);
            const float yz = y * siluf_(z); sq += yz * yz;
            OC[(size_t)row * OCP + ch] = (bf16)f2bf(yz * A->in[I_GNORM][l * D_C + ch]); }
        sq += xor_lt32<1>(sq); sq += xor_lt32<2>(sq); sq += xor_lt32<4>(sq); sq += xor_lt32<8>(sq);
        if ((lane & 15) == 0 && acc) atomicAdd(csq + row, sq); }
    __syncthreads();
}

__device__ __forceinline__ void ssd_item_fused(KArgs A, unsigned char* ws, float* out, int l, int item, LAS unsigned char* lds, int tid, int wave, int lane, bool acc, unsigned* flags) {
    const int h = item & 15, c = (item >> 4) & 15, b = item >> 8, g = h >> 3, row0 = b * SEQ + c * SSDQ;
    const bf16* PROJ = (const bf16*)(ws + WS_BIG);
    LAS float* dtv = (LAS float*)(lds + SL_DT); LAS float* cs = (LAS float*)(lds + SL_CS);
    LAS bf16* Cn = (LAS bf16*)(lds + SL_CN); LAS bf16* Bn = (LAS bf16*)(lds + SL_BN); LAS bf16* Mw = (LAS bf16*)(lds + SL_MW);
    LAS bf16* Xt = (LAS bf16*)(lds + SL_XT); LAS bf16* Hp = (LAS bf16*)(lds + SL_HP);
    conv_tile<64, true>(A, PROJ, l, b, c, h * 64, Xt, nullptr, tid);
    conv_tile<128, false>(A, PROJ, l, b, c, D_C + g * N_C, Bn, nullptr, tid);
    conv_tile<128, true>(A, PROJ, l, b, c, D_C + g * N_C, Mw, nullptr, tid);
    conv_tile<128, false>(A, PROJ, l, b, c, D_C + G_C * N_C + g * N_C, Cn, nullptr, tid);
    bf16 zz[4][4];
#pragma unroll
    for (int r = 0; r < 4; ++r)
#pragma unroll
        for (int t = 0; t < 4; ++t) zz[r][t] = PROJ[(size_t)(row0 + 16 * wave + 4 * (lane >> 4) + r) * N_INP + PC_Z + h * 64 + 16 * t + (lane & 15)];
    ssd_dt_scan(A, ws, l, b, c, h, dtv, cs, tid, lane);
    {   f32x4 sacc[4];
#pragma unroll
        for (int t = 0; t < 4; ++t) sacc[t] = (f32x4){0.f, 0.f, 0.f, 0.f};
        const float cse = cs[127];
#pragma unroll
        for (int ks = 0; ks < 4; ++ks) { const int j0 = 32 * ks + 8 * (lane >> 4);
            const v4u braw = *(const LAS v4u*)(Mw + (16 * wave + (lane & 15)) * TP + j0);
            const f32x4 d0 = *(const LAS f32x4*)(dtv + j0), d1 = *(const LAS f32x4*)(dtv + j0 + 4), c0 = *(const LAS f32x4*)(cs + j0), c1 = *(const LAS f32x4*)(cs + j0 + 4);
            v4u bs;
            bs.x = pk2(bflo(braw.x) * d0.x * __expf(cse - c0.x), bfhi(braw.x) * d0.y * __expf(cse - c0.y)); bs.y = pk2(bflo(braw.y) * d0.z * __expf(cse - c0.z), bfhi(braw.y) * d0.w * __expf(cse - c0.w));
            bs.z = pk2(bflo(braw.z) * d1.x * __expf(cse - c1.x), bfhi(braw.z) * d1.y * __expf(cse - c1.y)); bs.w = pk2(bflo(braw.w) * d1.z * __expf(cse - c1.z), bfhi(braw.w) * d1.w * __expf(cse - c1.w));
            const bf16x8 bfr = __builtin_bit_cast(bf16x8, bs);
#pragma unroll
            for (int t = 0; t < 4; ++t) { const bf16x8 af = *(const LAS bf16x8*)(Xt + (16 * t + (lane & 15)) * TP + 32 * ks + 8 * (lane >> 4));
                sacc[t] = __builtin_amdgcn_mfma_f32_16x16x32_bf16(bfr, af, sacc[t], 0, 0, 0); } }
        {   const __amdgpu_buffer_rsrc_t srs = __builtin_amdgcn_make_buffer_rsrc((void*)((float*)(ws + WS_STATES) + (size_t)item * HD_C * N_C), (short)0, HD_C * N_C * 4, 0x00020000);
#pragma unroll
            for (int t = 0; t < 4; ++t) __builtin_amdgcn_raw_buffer_store_b128(__builtin_bit_cast(v4u, sacc[t]), srs, (unsigned)((16 * t + (lane & 15)) * N_C + 16 * wave + 4 * (lane >> 4)) * 4u, 0,   16); }
        if (tid == 0) __hip_atomic_store((float*)(ws + WS_SMALL + SM_SDEC) + item, __expf(cse), __ATOMIC_RELAXED, __HIP_MEMORY_SCOPE_AGENT);
        asm volatile("s_waitcnt vmcnt(0)" ::: "memory"); __syncthreads();
        if (tid == 0) __hip_atomic_store(flags + item, 1u, __ATOMIC_RELAXED, __HIP_MEMORY_SCOPE_AGENT);
    }
    bf16x8 cf[4];
#pragma unroll
    for (int ks = 0; ks < 4; ++ks) cf[ks] = *(const LAS bf16x8*)(Cn + (16 * wave + (lane & 15)) * TP + 32 * ks + 8 * (lane >> 4));
    const int jtmax = wave | 1;
    for (int jt = 0; jt <= jtmax; ++jt) {
        f32x4 gacc = {0.f, 0.f, 0.f, 0.f};
        if (jt <= wave) {
#pragma unroll
            for (int ks = 0; ks < 4; ++ks) { const bf16x8 bfr = *(const LAS bf16x8*)(Bn + (16 * jt + (lane & 15)) * TP + 32 * ks + 8 * (lane >> 4));
                gacc = __builtin_amdgcn_mfma_f32_16x16x32_bf16(cf[ks], bfr, gacc, 0, 0, 0); }
        }
        const int j = 16 * jt + (lane & 15); const float csj = cs[j], dtj = dtv[j];
#pragma unroll
        for (int r = 0; r < 4; ++r) { const int i = 16 * wave + 4 * (lane >> 4) + r;
            const float m = (j <= i) ? gacc[r] * __expf(cs[i] - csj) * dtj : 0.f;
            Mw[i * TP + j] = (bf16)f2bf(m); }
    }
    f32x4 yd[4], yo[4];
#pragma unroll
    for (int t = 0; t < 4; ++t) { yd[t] = (f32x4){0.f, 0.f, 0.f, 0.f}; yo[t] = (f32x4){0.f, 0.f, 0.f, 0.f}; }
    const int nks = (wave >> 1) + 1;
    for (int ks = 0; ks < nks; ++ks) { const bf16x8 mf = *(const LAS bf16x8*)(Mw + (16 * wave + (lane & 15)) * TP + 32 * ks + 8 * (lane >> 4));
#pragma unroll
        for (int t = 0; t < 4; ++t) { const bf16x8 xf = *(const LAS bf16x8*)(Xt + (16 * t + (lane & 15)) * TP + 32 * ks + 8 * (lane >> 4));
            yd[t] = __builtin_amdgcn_mfma_f32_16x16x32_bf16(mf, xf, yd[t], 0, 0, 0); } }
    if (tid < 64) {
        unsigned sp_ = 0;
        for (;;) { const unsigned f = lane < c ? __hip_atomic_load(flags + ((b * 16 + lane) * 16 + h), __ATOMIC_RELAXED, __HIP_MEMORY_SCOPE_AGENT) : 1u;
            if (__builtin_amdgcn_ballot_w64(f == 0u) == 0ull || ++sp_ > (1u << 20)) break; __builtin_amdgcn_s_sleep(1); }
        __builtin_amdgcn_fence(__ATOMIC_ACQUIRE, "agent"); asm volatile("s_waitcnt vmcnt(0)" ::: "memory"); }
    __syncthreads();
    {   const float* ST = (const float*)(ws + WS_STATES) + (size_t)((b * 16) * 16 + h) * HD_C * N_C + tid * 4;
        const float* SD = (const float*)(ws + WS_SMALL + SM_SDEC) + (b * 16) * 16 + h;
        f32x4 hv[4];
#pragma unroll
        for (int k = 0; k < 4; ++k) hv[k] = (f32x4){0.f, 0.f, 0.f, 0.f};
        for (int cc = 0; cc < c; cc += 4) { f32x4 sv[4][4]; float d[4];
#pragma unroll
            for (int q = 0; q < 4; ++q) { const int cq = cc + q < c ? cc + q : c - 1; d[q] = SD[cq * 16];
#pragma unroll
                for (int k = 0; k < 4; ++k) sv[q][k] = *(const GAS f32x4*)(ST + (size_t)cq * 16 * 8192 + 2048 * k); }
#pragma unroll
            for (int q = 0; q < 4; ++q) if (cc + q < c) {
#pragma unroll
                for (int k = 0; k < 4; ++k) hv[k] = hv[k] * d[q] + sv[q][k]; } }
#pragma unroll
        for (int k = 0; k < 4; ++k) { v2u wv; wv.x = pk2(hv[k].x, hv[k].y); wv.y = pk2(hv[k].z, hv[k].w); *(LAS v2u*)(Hp + ((tid >> 5) + 16 * k) * TP + (tid & 31) * 4) = wv; }
        if (c == SSDNC - 1) { const float d = SD[c * 16]; float* o = out + O_SSMP + (size_t)((l * NB + b) * H_C + h) * HD_C * N_C + tid * 4;
#pragma unroll
            for (int k = 0; k < 4; ++k) *(GAS f32x4*)(o + 2048 * k) = hv[k] * d + *(const GAS f32x4*)(ST + (size_t)c * 16 * 8192 + 2048 * k); }
    }
    __syncthreads();
#pragma unroll
    for (int ks = 0; ks < 4; ++ks)
#pragma unroll
        for (int t = 0; t < 4; ++t) { const bf16x8 hf = *(const LAS bf16x8*)(Hp + (16 * t + (lane & 15)) * TP + 32 * ks + 8 * (lane >> 4));
            yo[t] = __builtin_amdgcn_mfma_f32_16x16x32_bf16(cf[ks], hf, yo[t], 0, 0, 0); }
    const float dsk = A->in[I_SSDD][l * H_C + h];
    bf16* OC = (bf16*)(ws + WS_OCAT) + OC_C; float* csq = (float*)(ws + WS_SMALL + SM_CSQ) + l * MP;
#pragma unroll
    for (int r = 0; r < 4; ++r) { const int i = 16 * wave + 4 * (lane >> 4) + r, row = row0 + i; const float ecs = __expf(cs[i]); float sq = 0.f;
#pragma unroll
        for (int t = 0; t < 4; ++t) { const int p = 16 * t + (lane & 15), ch = h * 64 + p;
            const float x = bf2f(Xt[p * TP + i]);
            const float y = yd[t][r] + ecs * yo[t][r] + dsk * x;
            const float z = bf2f(zz[r][t]);
            const float yz = y * siluf_(z); sq += yz * yz;
            OC[(size_t)row * OCP + ch] = (bf16)f2bf(yz * A->in[I_GNORM][l * D_C + ch]); }
        sq += xor_lt32<1>(sq); sq += xor_lt32<2>(sq); sq += xor_lt32<4>(sq); sq += xor_lt32<8>(sq);
        if ((lane & 15) == 0 && acc) atomicAdd(csq + row, sq); }
    __syncthreads();
}
__device__ __forceinline__ void phase_upfix(const Frame& F0, KArgs A, int l) {
    Frame F = launder(F0);
    const float* HALO = WSP(const float, WS_HALO); bf16* ACT = WSP(bf16, WS_T);
    const float* cw = A->in[I_FCONVW] + (size_t)l * K_F * D_UP; const float* cb = A->in[I_FCONVB] + (size_t)l * D_UP;
    const int gt = blockIdx.x * NTHR + F.tid, NT = GRID * NTHR;
    for (int i = gt; i < 32 * D_FF; i += NT) { const int ch = i % D_FF, pm = i / D_FF; if ((pm & 7) == 0) continue;
        const int ca_ = 256 * (ch / 128) + ch % 128, cb_ = ca_ + 128;
        const float* hp = HALO + ((size_t)(pm - 1) * 4 + 2) * D_UP; const float* hc = HALO + (size_t)pm * 4 * D_UP;
        const float am2 = hp[ca_], am1 = hp[D_UP + ca_], a0 = hc[ca_], a1 = hc[D_UP + ca_], bm2 = hp[cb_], bm1 = hp[D_UP + cb_], b0 = hc[cb_], b1 = hc[D_UP + cb_];
        const float wa0 = cw[ch], wa1 = cw[D_UP + ch], wa2 = cw[2 * D_UP + ch], wb0 = cw[D_FF + ch], wb1 = cw[D_UP + D_FF + ch], wb2 = cw[2 * D_UP + D_FF + ch], ba = cb[ch], bb = cb[D_FF + ch];
        const float r0 = siluf_(ba + wa0 * am2 + wa1 * am1 + wa2 * a0) * (bb + wb0 * bm2 + wb1 * bm1 + wb2 * b0);
        const float r1 = siluf_(ba + wa0 * am1 + wa1 * a0 + wa2 * a1) * (bb + wb0 * bm1 + wb1 * b0 + wb2 * b1);
        ACT[(size_t)(pm * 256) * D_FF + ch] = (bf16)f2bf(r0); ACT[(size_t)(pm * 256 + 1) * D_FF + ch] = (bf16)f2bf(r1); }
    for (int i = gt; i < NB * 2 * D_UP; i += NT) { const int oc = i % D_UP, k = (i / D_UP) & 1, b = i / (2 * D_UP);
        const int c = oc < D_FF ? 256 * (oc / 128) + oc % 128 : 256 * ((oc - D_FF) / 128) + 128 + (oc - D_FF) % 128;
        F.out[O_CFP + (size_t)l * NB * 2 * D_UP + i] = HALO[((size_t)(8 * b + 7) * 4 + 2 + k) * D_UP + c]; }
}
__device__ __forceinline__ void ssd_conv_p_out(const Frame& F0, int l) {
    Frame F = launder(F0);
    const bf16* PROJ = WSP(const bf16, WS_BIG);
    const int gt = blockIdx.x * NTHR + F.tid, NT = GRID * NTHR;
    for (int i = gt; i < NB * 3 * D_XBC; i += NT) { const int ch = i % D_XBC, k = (i / D_XBC) % 3, b = i / (3 * D_XBC);
        F.out[O_CCP + (size_t)l * NB * 3 * D_XBC + i] = bf2f(PROJ[(size_t)(b * SEQ + SEQ - 3 + k) * N_INP + PC_XBC + ch]); }
}

__device__ __forceinline__ void phase_mix1(const Frame& F0, KArgs A, int l, bool acc) {
    {   Frame F = launder(F0);
        for (int it = F.gw; it < NS * G_A; it += (GRID * NWAVES)) s5_sample_item(A, F.ws, F.out, l, it, F.lane); }
    {   Frame F = launder(F0);
        for (int it = F.gw; it < NS; it += (GRID * NWAVES)) gmlp_sample_item(A, F.ws, F.out, l, it, F.lane); }
    {   Frame F = launder(F0);
        for (int it = F.gw; it < NS * H_C; it += (GRID * NWAVES)) ssd_sample_item(A, F.ws, F.out, l, it, F.lane, acc); }
    ssd_conv_p_out(F0, l);
}
__device__ __forceinline__ void phase_mix2(const Frame& F0, KArgs A, int l, bool acc) {
#ifndef REP_SSD2
#define REP_SSD2 1
#endif
#ifndef REP_GMLP
#define REP_GMLP 1
#endif
#ifndef REP_S5F
#define REP_S5F 1
#endif
    _Pragma("unroll 1") for (int r2 = 0; r2 < REP_SSD2; ++r2) {   Frame F = launder(F0);
        for (int it = blockIdx.x; it < NB * SSDNC * H_C; it += GRID) ssd_item_fused(A, F.ws, F.out, l, it, F.lds, F.tid, F.wave, F.lane, acc && r2 == 0, (unsigned*)(F.ws + WS_CTL) + CW_SSDF + l * 1024); }
    _Pragma("unroll 1") for (int r2 = 0; r2 < REP_GMLP; ++r2) {   Frame F = launder(F0);
        for (int it = blockIdx.x; it < NB * (SEQ / GMC) * H_B; it += GRID) gmlp_item(A, F.ws, l, it, F.lds, F.tid, F.wave, F.lane); }
    _Pragma("unroll 1") for (int r2 = 0; r2 < REP_S5F; ++r2) {   Frame F = launder(F0);
        for (int it = F.gw; it < NB * G_A * S5NC; it += (GRID * NWAVES)) s5_item<true>(A, F.ws, F.out, l, it, F.lds + F.wave * 10752, F.lane, (unsigned*)(F.ws + WS_CTL) + CW_S5F + l * 4096); }
}

constexpr int LDS_BYTES = 147456, MISC_OFF = 147456 - 256;
#ifndef GEMM_SP2
#define GEMM_SP2 true
#endif
template <class Epi>
__device__ __forceinline__ void run_gemm(const Frame& F, const bf16* Am, const bf16* Bt, int M, int N, int K, const Epi& E) {
    pg8::Gemm g{Am, Bt, M, N, K}; pg8::StaticOrder S; S.init(M, N, GRID, (int)blockIdx.x, K);
    pg8::gemm_phase<Epi, pg8::StaticOrder, true, GEMM_SP2>(F.lds, g, S, E);
}
struct SplitSched {
    pg8::StaticOrder P; int c, np, nsl, ntsl, ns, cbase, cu0, sid0;
    __device__ void init(int N, int K, int c_, int nsl_, int cbase_, int cu0_, int sid0_) { sid0 = sid0_; P.init(MPROMPT, N, GRID, c_, K); c = c_; np = (MPROMPT / 256) * (N / 256) / GRID; nsl = nsl_; ntsl = (K / 64) / nsl_; ns = (N / 256) * nsl_; cbase = cbase_; cu0 = cu0_; }
    __device__ bool next(int i, pg8::Unit& u) const {
        const int s = c - cu0; const bool has = s >= 0 && s < ns;
        if (!has || i > 0) return (i - (has ? 1 : 0)) < np ? P.next(i - (has ? 1 : 0), u) : false;
        u.pm = MPROMPT / 256; u.pn = s / nsl; u.k0 = (s % nsl) * ntsl * 64; u.nt = ntsl; u.cidx = cbase + u.pn; u.sid = sid0 + s; return true;
    }
    __device__ __forceinline__ void a_ready(const pg8::Unit&) const {}
    __device__ __forceinline__ void done(const pg8::Unit&) const {}
};
template <class Epi, bool CHAIN_IN>
__device__ __forceinline__ void run_gemm_chain(const Frame& F, const bf16* Am, const bf16* Bt, int K, const Epi& E, pg8::f32x4 (&acc)[2][2][4][2]) {
    pg8::Gemm g{Am, Bt, MPROMPT, DM, K}; pg8::StaticOrder S; S.init(MPROMPT, DM, GRID, (int)blockIdx.x, K);
    pg8::gemm_phase<Epi, pg8::StaticOrder, true, GEMM_SP2, CHAIN_IN>(F.lds, g, S, E, acc);
}
template <class Epi>
__device__ __forceinline__ void run_gemm_split(const Frame& F, const bf16* Am, const bf16* Bt, int N, int K, const Epi& E, int nsl, int cbase, int cu0, int sid0 = 0, int fin0 = -1, int parts = 1) {
    pg8::Gemm g{Am, Bt, MP, N, K}; SplitSched S; S.init(N, K, (int)blockIdx.x, nsl, cbase, cu0, sid0);
    pg8::gemm_phase<Epi, SplitSched, true, GEMM_SP2>(F.lds, g, S, E);
    if constexpr (!Epi::AFTER_DRAIN) {
        const int f = epi::opaque_bx() - fin0;
        if (fin0 >= 0 && f >= 0 && f < (N / 256) * parts) { int t2 = threadIdx.x; asm volatile("" : "+v"(t2)); const int lane = t2 & 63, wid = __builtin_amdgcn_readfirstlane(t2 >> 6);
            const pg8::Unit u = epi::final_unit(f / parts, cbase); E.final(u, wid >> 2, wid & 3, lane & 15, lane >> 4, wid, lane, epi::part_mask(f % parts, parts)); }
    }
}

#ifndef REP_PROLOGUE
#define REP_PROLOGUE 1
#endif
#ifndef REP_MOD
#define REP_MOD 1
#endif
#ifndef REP_PREP
#define REP_PREP 1
#endif
#ifndef REP_WIN
#define REP_WIN 1
#endif
#ifndef REP_MIX1
#define REP_MIX1 1
#endif
#ifndef REP_MIX2
#define REP_MIX2 1
#endif
#ifndef REP_GLU
#define REP_GLU 1
#endif
#ifndef REP_MERGE
#define REP_MERGE 1
#endif
#ifndef REP_OUT
#define REP_OUT 1
#endif
#ifndef REP_UP
#define REP_UP 1
#endif
#ifndef REP_CONV
#define REP_CONV 1
#endif
#ifndef REP_DOWN
#define REP_DOWN 1
#endif
#ifndef REP_BAR
#define REP_BAR 1
#endif
#define REP(n) _Pragma("unroll 1") for (int rep_ = 0; rep_ < (n); ++rep_)
__device__ __forceinline__ void grid_bar(const Frame& F0) {
    unsigned long long w = (unsigned long long)F0.ws; unsigned x = xb_xcc_id(); asm volatile("" : "+s"(w), "+s"(x));
    XcdBarrier b; b.bar = (unsigned*)((unsigned char*)w + WS_CTL) + CW_BAR; b.x = x; b.st = (volatile LAS unsigned*)(F0.lds + MISC_OFF) + 8;
    xcd_barrier(b);
}
__global__ void __launch_bounds__(NTHR, 2) mega_fwd(Args Aarg) {
    const KArgs A0 = (KArgs)__builtin_amdgcn_kernarg_segment_ptr(); (void)Aarg;
#define A launder_args(A0)
    extern __shared__ __attribute__((aligned(16))) unsigned char lds_raw[];
    Frame F;
    F.lds = (LAS unsigned char*)lds_raw;
    F.tid = threadIdx.x; F.lane = F.tid & 63; F.wave = __builtin_amdgcn_readfirstlane(F.tid >> 6);
    F.gw = blockIdx.x * NWAVES + F.wave;
    F.out = A0->out; F.ws = A0->ws;
    volatile LAS unsigned* MISC = (volatile LAS unsigned*)(F.lds + MISC_OFF);
    if (F.tid < 64) MISC[F.tid] = 0u;
    __syncthreads();
    (void)xcd_barrier_post((unsigned*)(F.ws + WS_CTL) + CW_BAR, MISC + 8);
#define GRID_BAR() do { REP(REP_BAR) grid_bar(F); } while (0)
#ifndef TIME_PHASE
#define TIME_PHASE -1
#endif
    unsigned long long tacc_ = 0ull, tbeg_ = 0ull;
#define TBEG(k) do { if (TIME_PHASE == (k)) tbeg_ = __builtin_amdgcn_s_memrealtime(); } while (0)
#define TEND(k) do { if (TIME_PHASE == (k)) tacc_ += __builtin_amdgcn_s_memrealtime() - tbeg_; } while (0)

#ifndef REP_MODS
#define REP_MODS 1
#endif
    TBEG(0); REP(REP_PROLOGUE) { _Pragma("unroll 1") for (int rm = 0; rm < REP_MODS; ++rm) phase_mod(F, A); phase_prologue(F, A);
    GRID_BAR(); } TEND(0);
#pragma unroll 1
    for (int l = 0; l < DEPTH; ++l) {
#define PH_FRAME() const Frame Fq = launder(F); unsigned char* const wsq = Fq.ws; unsigned char* const wl = wsq + WS_W + (size_t)l * WL_END; \
        const float* const modl = (const float*)(wsq + WS_MOD) + (size_t)l * N_MOD; pg8::f32x4* const slab = (pg8::f32x4*)(wsq + WS_SLAB); \
        unsigned* const cnt = (unsigned*)(wsq + WS_CTL) + CW_CNT; (void)wl; (void)modl; (void)slab; (void)cnt
#define WSQ(T, off) ((T*)(wsq + (off)))
        TBEG(1); if (l == 0) REP(REP_PREP) { { PH_FRAME(); phase_prep<true>(Fq, A->in[I_XP], A->in[I_XS], A->in[I_GMIX] + l * DM, modl, 0, 1, A->in[I_WIN] + (size_t)l * DM * N_IN, WSQ(float, WS_SMALL + SM_DT)); }
        GRID_BAR(); } TEND(1);
        TBEG(2); REP(REP_WIN) { { PH_FRAME(); epi::EpiIn E{WSQ(bf16, WS_BIG), rep_ == 0 ? WSQ(float, WS_SMALL + SM_VSQ) + l * MP : nullptr, epi::SplitCtl{slab, cnt, 4u, 160, (l * 4 + 0) * 64, 2}};
            run_gemm_split(Fq, WSQ(const bf16, WS_H), (const bf16*)(wl + WL_IN), N_INP, DM, E, 4, (l * 4 + 0) * 64, 0, 0, 160, 2); }
        GRID_BAR(); } TEND(2);
        TBEG(3); REP(REP_MIX2) { phase_mix2(F, A, l, rep_ == 0); phase_mix1(F, A, l, rep_ == 0);
        GRID_BAR(); } TEND(3);
        TBEG(4); REP(REP_GLU) { { PH_FRAME(); epi::EpiGlu E{WSQ(const bf16, WS_YB), WSQ(bf16, WS_OCAT) + OC_A};
            run_gemm(Fq, WSQ(const bf16, WS_YB), (const bf16*)(wl + WL_GLU), MP, 512, 512, E); }
        GRID_BAR(); } TEND(4);
        TBEG(5);
        REP(REP_MERGE) {
            TBEG(10); TBEG(14);
            {   PH_FRAME(); bf16* BIG = WSQ(bf16, WS_BIG);
                epi::EpiMergeCat Em{BIG, WSQ(bf16, WS_MERGED), WSQ(const float, WS_SMALL + SM_CSQ) + l * MP, slab, cnt};
                run_gemm_split(Fq, WSQ(const bf16, WS_OCAT), (const bf16*)(wl + WL_PA), DM, OCP, Em, 4, (l * 4 + 1) * 64, 0, 0, 32, 4); }
            TEND(10);
            TEND(12); TEND(14); TBEG(13);
        GRID_BAR(); TEND(13); }
        TEND(5);
        TBEG(6);
        REP(REP_OUT) { { PH_FRAME(); epi::EpiResidPrep<0> E{epi::EpiResid{WSQ(const bf16, WS_X0), WSQ(const bf16, WS_X0) + (size_t)MPROMPT * DM, WSQ(bf16, WS_X1), modl + 2 * DM, epi::SplitCtl{slab, cnt, 4u, 32, (l * 4 + 2) * 64, 4}},
                WSQ(bf16, WS_H), nullptr, nullptr, A->in[I_GFFN] + l * DM, modl, 3, 4, nullptr, WSQ(float, WS_SMALL + SM_DT), (unsigned*)(wsq + WS_CTL) + CW_PC + (l * 2 + 0) * 64};
            run_gemm_split(Fq, WSQ(const bf16, WS_MERGED), (const bf16*)(wl + WL_OUT), DM, DM, E, 4, (l * 4 + 2) * 64, 0); }
        GRID_BAR(); }
        TEND(6);
        TBEG(7); REP(REP_UP) { { PH_FRAME(); epi::EpiUpConv E{WSQ(bf16, WS_T), WSQ(float, WS_HALO), A->in[I_FCONVW] + (size_t)l * K_F * D_UP, A->in[I_FCONVB] + (size_t)l * D_UP,
                A->in[I_FFNCONV] + (size_t)l * NS * 2 * D_UP, Fq.out + O_CFS + (size_t)l * NS * 2 * D_UP, (LAS float*)(Fq.lds + 131072), rep_ < REP_UP - 1 ? 1 : 0};
            run_gemm(Fq, WSQ(const bf16, WS_H), (const bf16*)(wl + WL_UP), MP, D_UP, DM, E); }
        GRID_BAR(); } TEND(7);
        TBEG(8); REP(REP_CONV) { phase_upfix(F, A, l);
        GRID_BAR(); } TEND(8);
        TBEG(9); REP(REP_DOWN) {
            if (l + 1 < DEPTH) { PH_FRAME(); const float* mod2 = (const float*)(wsq + WS_MOD) + (size_t)(l + 1) * N_MOD;
                epi::EpiResidPrep<1> E{epi::EpiResid{WSQ(const bf16, WS_X1), WSQ(const bf16, WS_X1) + (size_t)MPROMPT * DM, WSQ(bf16, WS_X0), modl + 5 * DM, epi::SplitCtl{slab, cnt, 11u, 88, (l * 4 + 3) * 64, 4}},
                    WSQ(bf16, WS_H), nullptr, nullptr, A->in[I_GMIX] + (l + 1) * DM, mod2, 0, 1, WSQ(const float, WS_SMALL + SM_WDT) + (size_t)(l + 1) * 16 * DM, WSQ(float, WS_SMALL + SM_DT), (unsigned*)(wsq + WS_CTL) + CW_PC + (l * 2 + 1) * 64};
                run_gemm_split(Fq, WSQ(const bf16, WS_T), (const bf16*)(wl + WL_DOWN), DM, D_FF, E, 11, (l * 4 + 3) * 64, 0);
            } else { PH_FRAME();
                epi::EpiResidPrep<2> E{epi::EpiResid{WSQ(const bf16, WS_X1), WSQ(const bf16, WS_X1) + (size_t)MPROMPT * DM, WSQ(bf16, WS_X0), modl + 5 * DM, epi::SplitCtl{slab, cnt, 11u, 88, (l * 4 + 3) * 64, 4}},
                    nullptr, Fq.out + O_YP, Fq.out + O_YS, A->in[I_GFINAL], modl, 0, 1, nullptr, WSQ(float, WS_SMALL + SM_DT), (unsigned*)(wsq + WS_CTL) + CW_PC + (l * 2 + 1) * 64};
                run_gemm_split(Fq, WSQ(const bf16, WS_T), (const bf16*)(wl + WL_DOWN), DM, D_FF, E, 11, (l * 4 + 3) * 64, 0); }
        if (l + 1 < DEPTH) GRID_BAR(); } TEND(9);
    }
    if (TIME_PHASE >= 0) {
        GRID_BAR();
#ifdef TIME_WG_LO
        if ((int)blockIdx.x < TIME_WG_LO || (int)blockIdx.x > TIME_WG_HI) tacc_ = 0ull; else tacc_ *= (unsigned long long)(256 / (TIME_WG_HI - TIME_WG_LO + 1));
#endif
        const float eps_ = sqrtf(5e-5f + 1e-6f * (float)tacc_ * 0.01f);
        for (int i = blockIdx.x * NTHR + F.tid; i < DEPTH * NS * D_B; i += GRID * NTHR) F.out[O_GVS + i] *= (1.0f + eps_);
    }
#undef A
}

extern "C" void kernel_launch(void* const* d_in, const int* in_sizes, int n_in, void* d_out, int out_size, void* d_ws, size_t ws_size, hipStream_t stream) {
    static int grid = 0;
    if (grid == 0) {
        if (n_in != N_INPUTS || (size_t)out_size != O_END || ws_size < WS_END) { fprintf(stderr, "kernel_launch: unexpected shapes (n_in %d, out %d, ws %zu, need %zu)\n", n_in, out_size, ws_size, (size_t)WS_END); grid = -1; return; }
        int dev = 0, cus = 0, per_cu = 0;
        if (hipGetDevice(&dev) != hipSuccess || hipDeviceGetAttribute(&cus, hipDeviceAttributeMultiprocessorCount, dev) != hipSuccess) { grid = -1; return; }
        if (hipFuncSetAttribute((const void*)mega_fwd, hipFuncAttributeMaxDynamicSharedMemorySize, LDS_BYTES) != hipSuccess) { fprintf(stderr, "kernel_launch: hipFuncSetAttribute failed\n"); grid = -1; return; }
        if (hipOccupancyMaxActiveBlocksPerMultiprocessor(&per_cu, (const void*)mega_fwd, NTHR, LDS_BYTES) != hipSuccess || per_cu < 1) { fprintf(stderr, "kernel_launch: occupancy query reports %d blocks per CU\n", per_cu); (void)hipGetLastError(); grid = -1; return; }
        if (cus * per_cu < GRID) { fprintf(stderr, "kernel_launch: %d CUs x %d blocks cannot hold the %d-workgroup grid\n", cus, per_cu, GRID); grid = -1; return; }
        grid = GRID;
    }
    if (grid < 0) return;
    if (hipMemsetAsync((char*)d_ws + WS_CTL, 0, CTL_ZERO_BYTES, stream) != hipSuccess) return;
    Args a{};
    for (int i = 0; i < N_INPUTS; ++i) a.in[i] = (const float*)d_in[i];
    a.out = (float*)d_out; a.ws = (unsigned char*)d_ws;
    void* params[] = {&a};
    hipError_t e = hipLaunchCooperativeKernel((const void*)mega_fwd, dim3(grid), dim3(NTHR), params, LDS_BYTES, stream);
    if (e != hipSuccess) fprintf(stderr, "kernel_launch: cooperative launch failed: %s (grid %d)\n", hipGetErrorString(e), grid);
}
```

```cpp
#include <hip/hip_runtime.h>
#include <cstdio>
#include <cstdint>
namespace pg8 {
#define PG8_LAS __attribute__((address_space(3)))
typedef unsigned short bf16_t;
typedef short bf16x8 __attribute__((ext_vector_type(8)));
typedef float f32x4 __attribute__((ext_vector_type(4)));
typedef unsigned u32x4 __attribute__((ext_vector_type(4)));
constexpr int BM = 256, BK = 64, HALF = 128, HTB = HALF * BK * 2  , STAGE_BYTES = 8 * HTB, NXCD = 8, WGM = 8;

__host__ __device__ __forceinline__ int lds_byte(int r, int c) { const int st = (r >> 4) * 2 + (c >> 5), rr = r & 15, cc = c & 31, ob = rr * 64 + cc * 2; return st * 1024 + (ob ^ (((ob >> 9) & 1) << 5)); }
__host__ __device__ __forceinline__ void stage_rc(int b, int& R, int& C) { const int st = b / 1024, sb = b % 1024, swz = sb ^ (((sb >> 9) & 1) << 5); R = (st >> 1) * 16 + swz / 64; C = (st & 1) * 32 + (swz % 64) / 2; }
__host__ __device__ __forceinline__ int perm32(int rho) { const int n = rho >> 4, i = rho & 15; return 8 * (i >> 2) + 4 * n + (i & 3); }

struct Unit { int pm, pn, k0, nt, cidx, sid; };
struct Gemm { const bf16_t* A; const bf16_t* Bt; int M, N, K; };

struct StaticOrder {
    int nM, nN, nwg, G, c, ntk;
    __host__ __device__ void init(int M, int N, int G_, int c_, int K_) { nM = M / BM; nN = N / BM; nwg = nM * nN; G = G_; c = c_; ntk = K_ / BK; }
    __host__ __device__ bool next(int i, Unit& u) const {
        const long L = (long)i * G + c; if (L >= nwg) return false;
        int wgid = (int)L; { const int q = nwg / NXCD, r = nwg % NXCD, xcd = wgid % NXCD, off = wgid / NXCD; wgid = (xcd < r ? xcd * (q + 1) : r * (q + 1) + (xcd - r) * q) + off; }
        const int nig = WGM * nN, gid = wgid / nig, fm = gid * WGM, gsz = (nM - fm) < WGM ? (nM - fm) : WGM;
        u.pm = fm + ((wgid % nig) % gsz); u.pn = (wgid % nig) / gsz; u.k0 = 0; u.nt = ntk; u.cidx = -1; u.sid = 0; return true;
    }
    __device__ __forceinline__ void a_ready(const Unit&) const {}
    __device__ __forceinline__ void done(const Unit&) const {}
};
__device__ __forceinline__ unsigned cvt_pk_bf16(float lo, float hi) { unsigned r; asm volatile("s_nop 0\n\tv_cvt_pk_bf16_f32 %0, %1, %2" : "=v"(r) : "v"(lo), "v"(hi)); return r; }
template <class Epi, class Sched, bool ALIGN_EPI = false, bool SP2 = false, bool CHAIN_IN = false>
__device__ __forceinline__ void gemm_phase(PG8_LAS unsigned char* lds, const Gemm g, const Sched& S, const Epi& E, f32x4 (&acc)[2][2][4][2]) {
    int tid_ = threadIdx.x; asm volatile("" : "+v"(tid_));
    const int tid = tid_, wid = __builtin_amdgcn_readfirstlane(tid >> 6), lane = tid & 63, wr = wid >> 2, wc = wid & 3, fr = lane & 15, fq = lane >> 4;
    const int K = g.K;
    unsigned voffA[2], voffB[2];
#pragma unroll
    for (int i = 0; i < 2; ++i) { int R, C; stage_rc(tid * 16 + i * 8192, R, C); const int Rb = Epi::PERM ? ((R & ~31) + perm32(R & 31)) : R;
        voffA[i] = (unsigned)(R * K + C) * 2u; voffB[i] = (unsigned)(Rb * K + C) * 2u; }
    const size_t kstep = (size_t)(BK * 2);
    const size_t hstep = (size_t)HALF * K * 2;
    const size_t tstep = 2 * hstep;
    const unsigned ldsw = (unsigned)wid * 1024u;
    const int aoff = lds_byte(wr * 64 + fr, fq * 8), boff = lds_byte(wc * 32 + fr, fq * 8);
#define PG8_SA(b, h) (((b) * 2 + (h)) * HTB)
#define PG8_SB(b, h) ((4 + (b) * 2 + (h)) * HTB)
#define PG8_STAGE(bufoff, gbase, voff) do { _Pragma("unroll") for (int _i = 0; _i < 2; ++_i) \
        __builtin_amdgcn_global_load_lds((const unsigned*)((const char*)(gbase) + (voff)[_i]), (PG8_LAS unsigned*)(lds + (bufoff) + ldsw + _i * 8192), 16, 0, 0); } while (0)
#define PG8_LDA(dst, b, h) do { _Pragma("unroll") for (int m = 0; m < 4; ++m) _Pragma("unroll") for (int k = 0; k < 2; ++k) dst[m][k] = *(const PG8_LAS bf16x8*)(lds + PG8_SA(b, h) + aoff + m * 2048 + k * 1024); } while (0)
#define PG8_LDB(dst, b, h) do { _Pragma("unroll") for (int n = 0; n < 2; ++n) _Pragma("unroll") for (int k = 0; k < 2; ++k) dst[n][k] = *(const PG8_LAS bf16x8*)(lds + PG8_SB(b, h) + boff + n * 2048 + k * 1024); } while (0)
#define PG8_MMA(ai, bj, At, Bt) do { __builtin_amdgcn_s_setprio(1); _Pragma("unroll") for (int m = 0; m < 4; ++m) _Pragma("unroll") for (int n = 0; n < 2; ++n) _Pragma("unroll") for (int k = 0; k < 2; ++k) \
        acc[ai][bj][m][n] = __builtin_amdgcn_mfma_f32_16x16x32_bf16(Bt[n][k], At[m][k], acc[ai][bj][m][n], 0, 0, 0); __builtin_amdgcn_s_setprio(0); } while (0)
#define PG8_WAIT_V(n) asm volatile("s_waitcnt vmcnt(" #n ")" ::: "memory")
#define PG8_WAIT_L(n) asm volatile("s_waitcnt lgkmcnt(" #n ")" ::: "memory")
#define PG8_BAR __builtin_amdgcn_s_barrier()
#define PG8_SCHED __builtin_amdgcn_sched_barrier(0)
    Unit cur, nxt; int ui = 0;
    if (!S.next(0, cur)) return;
    if constexpr (!CHAIN_IN) {
#pragma unroll
    for (int a = 0; a < 2; ++a)
#pragma unroll
        for (int b = 0; b < 2; ++b)
#pragma unroll
            for (int m = 0; m < 4; ++m)
#pragma unroll
                for (int n = 0; n < 2; ++n) acc[a][b][m][n] = (f32x4){0.f, 0.f, 0.f, 0.f};
    }
    bf16x8 At[4][2], B0[2][2], B1[2][2];
    const char* cA = (const char*)g.A + (size_t)cur.pm * tstep + (size_t)cur.k0 * 2; const char* cB = (const char*)g.Bt + (size_t)cur.pn * tstep + (size_t)cur.k0 * 2;
    S.a_ready(cur);
    if constexpr (SP2) {
        PG8_STAGE(PG8_SB(0, 0), cB, voffB); PG8_STAGE(PG8_SB(0, 1), cB + hstep, voffB); PG8_STAGE(PG8_SA(0, 0), cA, voffA); PG8_STAGE(PG8_SA(0, 1), cA + hstep, voffA);
        if (wr == 1) PG8_BAR;
        PG8_WAIT_V(2); PG8_BAR;
        PG8_STAGE(PG8_SB(1, 0), cB + kstep, voffB); PG8_STAGE(PG8_SA(1, 0), cA + kstep, voffA); PG8_STAGE(PG8_SB(1, 1), cB + hstep + kstep, voffB);
        PG8_WAIT_V(6); PG8_BAR;
    } else {
        PG8_STAGE(PG8_SB(0, 0), cB, voffB); PG8_STAGE(PG8_SA(0, 0), cA, voffA); PG8_STAGE(PG8_SB(0, 1), cB + hstep, voffB); PG8_STAGE(PG8_SA(0, 1), cA + hstep, voffA);
        if (wr == 1) PG8_BAR;
        PG8_WAIT_V(4); PG8_BAR;
        PG8_STAGE(PG8_SB(1, 0), cB + kstep, voffB); PG8_STAGE(PG8_SA(1, 0), cA + kstep, voffA); PG8_STAGE(PG8_SB(1, 1), cB + hstep + kstep, voffB);
        PG8_WAIT_V(6); PG8_BAR;
    }
    for (;;) {
        const bool has_next = S.next(ui + 1, nxt);
        const char* nA = has_next ? (const char*)g.A + (size_t)nxt.pm * tstep + (size_t)nxt.k0 * 2 : cA; const char* nB = has_next ? (const char*)g.Bt + (size_t)nxt.pn * tstep + (size_t)nxt.k0 * 2 : cB;
        const int nt = cur.nt; const bool halfu = cur.cidx >= 0;
        for (int t = 0; t < nt; t += 2) {
            if constexpr (Epi::HOOK) { if (!halfu && (t == 8 || t == 16)) E.hook(acc, cur, t, wr, wc); }
            const bool last = (t == nt - 2);
            const char* a1 = cA + (size_t)(t + 1) * kstep;
            const char* a2 = last ? nA : cA + (size_t)(t + 2) * kstep; const char* b2 = last ? nB : cB + (size_t)(t + 2) * kstep;
            const char* a3 = a2 + kstep; const char* b3 = b2 + kstep;
            if (last && has_next) S.a_ready(nxt);
            if constexpr (SP2) {
            PG8_LDB(B0, 0, 0); PG8_LDB(B1, 0, 1); PG8_SCHED; PG8_LDA(At, 0, 0); PG8_STAGE(PG8_SA(1, 1), a1 + hstep, voffA);
            PG8_WAIT_V(8); PG8_WAIT_L(0); PG8_BAR; PG8_MMA(0, 0, At, B0); PG8_MMA(0, 1, At, B1); PG8_BAR; PG8_SCHED;
            PG8_LDA(At, 0, 1); PG8_STAGE(PG8_SB(0, 0), b2, voffB); PG8_STAGE(PG8_SB(0, 1), b2 + hstep, voffB); PG8_STAGE(PG8_SA(0, 0), a2, voffA);
            PG8_WAIT_V(8); PG8_WAIT_L(0); PG8_BAR; if (!halfu) { PG8_MMA(1, 0, At, B0); PG8_MMA(1, 1, At, B1); } PG8_BAR; PG8_SCHED;
            PG8_LDB(B0, 1, 0); PG8_LDB(B1, 1, 1); PG8_SCHED; PG8_LDA(At, 1, 0); PG8_STAGE(PG8_SA(0, 1), a2 + hstep, voffA);
            PG8_WAIT_V(8); PG8_WAIT_L(0); PG8_BAR; PG8_MMA(0, 0, At, B0); PG8_MMA(0, 1, At, B1); PG8_BAR; PG8_SCHED;
            PG8_LDA(At, 1, 1); PG8_STAGE(PG8_SB(1, 0), b3, voffB); PG8_STAGE(PG8_SB(1, 1), b3 + hstep, voffB); PG8_STAGE(PG8_SA(1, 0), a3, voffA);
            PG8_WAIT_V(8); PG8_WAIT_L(0); PG8_BAR; if (!halfu) { PG8_MMA(1, 0, At, B0); PG8_MMA(1, 1, At, B1); } PG8_BAR; PG8_SCHED;
            } else {
            PG8_LDB(B0, 0, 0); PG8_SCHED; PG8_LDA(At, 0, 0); PG8_STAGE(PG8_SA(1, 1), a1 + hstep, voffA);
            PG8_WAIT_L(8); PG8_BAR; PG8_WAIT_L(0); PG8_MMA(0, 0, At, B0); PG8_BAR; PG8_SCHED;
            PG8_LDB(B1, 0, 1); PG8_STAGE(PG8_SB(0, 0), b2, voffB);
            PG8_BAR; PG8_WAIT_L(0); PG8_MMA(0, 1, At, B1); PG8_BAR;
            PG8_LDA(At, 0, 1); PG8_STAGE(PG8_SA(0, 0), a2, voffA);
            PG8_BAR; PG8_WAIT_L(0); PG8_MMA(1, 0, At, B0); PG8_BAR; PG8_SCHED;
            PG8_STAGE(PG8_SB(0, 1), b2 + hstep, voffB);
            PG8_WAIT_V(6); PG8_BAR; PG8_MMA(1, 1, At, B1); PG8_BAR;
            PG8_LDB(B0, 1, 0); PG8_SCHED; PG8_LDA(At, 1, 0); PG8_STAGE(PG8_SA(0, 1), a2 + hstep, voffA);
            PG8_WAIT_L(8); PG8_BAR; PG8_WAIT_L(0); PG8_MMA(0, 0, At, B0); PG8_BAR; PG8_SCHED;
            PG8_LDB(B1, 1, 1); PG8_STAGE(PG8_SB(1, 0), b3, voffB);
            PG8_BAR; PG8_WAIT_L(0); PG8_MMA(0, 1, At, B1); PG8_BAR;
            PG8_LDA(At, 1, 1); PG8_STAGE(PG8_SA(1, 0), a3, voffA);
            PG8_BAR; PG8_WAIT_L(0); PG8_MMA(1, 0, At, B0); PG8_BAR; PG8_SCHED;
            PG8_STAGE(PG8_SB(1, 1), b3 + hstep, voffB);
            PG8_WAIT_V(6); PG8_BAR; PG8_MMA(1, 1, At, B1); PG8_BAR;
            }
        }
        if constexpr (ALIGN_EPI) { if (wr == 0) PG8_BAR; }
        if constexpr (!Epi::AFTER_DRAIN) { int t2 = threadIdx.x; asm volatile("" : "+v"(t2)); const int lane2 = t2 & 63, fr2 = lane2 & 15, fq2 = lane2 >> 4;
            if (cur.cidx < 0) E(acc, cur, wr, wc, fr2, fq2); else E.partial(acc, cur, wr, wc, fr2, fq2, wid, lane2); S.done(cur); }
        else { if (cur.cidx >= 0) { int t2 = threadIdx.x; asm volatile("" : "+v"(t2)); const int lane2 = t2 & 63; E.partial(acc, cur, wr, wc, lane2 & 15, lane2 >> 4, wid, lane2); } }
        if (!has_next) break;
#pragma unroll
        for (int a = 0; a < 2; ++a)
#pragma unroll
            for (int b = 0; b < 2; ++b)
#pragma unroll
                for (int m = 0; m < 4; ++m)
#pragma unroll
                    for (int n = 0; n < 2; ++n) acc[a][b][m][n] = (f32x4){0.f, 0.f, 0.f, 0.f};
        cur = nxt; cA = nA; cB = nB; ++ui;
        if constexpr (ALIGN_EPI) { if (wr == 1) PG8_BAR; }
    }
    PG8_WAIT_V(0);
    if constexpr (!ALIGN_EPI) { if (wr == 0) PG8_BAR; }
    PG8_BAR;
    if constexpr (Epi::AFTER_DRAIN) { E.fused(acc, cur, wr, wc, fr, fq, lds, wid, lane); S.done(cur); }
#undef PG8_SA
#undef PG8_SB
#undef PG8_STAGE
#undef PG8_LDA
#undef PG8_LDB
#undef PG8_MMA
#undef PG8_WAIT_V
#undef PG8_WAIT_L
#undef PG8_BAR
#undef PG8_SCHED
}
template <class Epi, class Sched, bool ALIGN_EPI = false, bool SP2 = false>
__device__ __forceinline__ void gemm_phase(PG8_LAS unsigned char* lds, const Gemm g, const Sched& S, const Epi& E) {
    f32x4 acc[2][2][4][2];
    gemm_phase<Epi, Sched, ALIGN_EPI, SP2, false>(lds, g, S, E, acc);
}

}
constexpr int DM = 2048, NB = 4, SEQ = 2048, NS = 128, DEPTH = 2;
constexpr int MPROMPT = NB * SEQ;
constexpr int MREAL = MPROMPT + NS;
constexpr int MP = 8448;
constexpr int D_A = 512, G_A = 32, P_A = 64, S5G = 16;
constexpr int D_B = 512, H_B = 8, GMC = 128;
constexpr int D_C = 1024, HD_C = 64, H_C = 16, N_C = 128, G_C = 2, K_C = 4, D_XBC = 1536;
constexpr int D_FF = 5632, K_F = 3, D_UP = 2 * D_FF;
constexpr int N_IN = 10256, N_INP = 10240;
constexpr int N_MOD = 6 * DM, MOD_PITCH = 2 * N_MOD;
constexpr float EPS = 1e-6f;
constexpr int PC_UA = 0, PC_UB = 512, PC_VB = 1024, PC_Z = 1536, PC_XBC = 2560, PC_GA = 4096, PC_GB = 6144, PC_GC = 8192;
constexpr int S5Q = 64, S5NC = SEQ / S5Q;
constexpr int SSDQ = 128, SSDNC = SEQ / SSDQ;

enum { I_XP = 0, I_XS, I_CP, I_CS, I_S5RE, I_S5IM, I_SSM, I_SSDCONV, I_FFNCONV, I_WMOD, I_BMOD, I_GMIX, I_WIN, I_LAMRE, I_LAMIM, I_LOGDT,
       I_BRE, I_BIM, I_CRE, I_CIM, I_S5D, I_WGLU, I_GV, I_WS, I_BS, I_CONVW, I_CONVB, I_DTBIAS, I_ALOG, I_SSDD, I_GNORM, I_WPA, I_WPB, I_WPC,
       I_WOUT, I_GFFN, I_WUP, I_FCONVW, I_FCONVB, I_WDOWN, I_GFINAL, N_INPUTS };
constexpr size_t O_YP = 0, O_YS = 16777216, O_S5RP = 17039360, O_S5IP = 17055744, O_SSMP = 17072128, O_CCP = 18120704, O_CFP = 18157568,
                 O_S5RS = 18337792, O_S5IS = 18862080, O_SSMS = 19386368, O_CCS = 52940800, O_CFS = 54120448, O_GVS = 59887616, O_END = 60018688;

constexpr size_t MiB = 1u << 20;
constexpr size_t WS_CTL = 0, CTL_ZERO_BYTES = 1 * MiB;
constexpr size_t SZ_WIN = (size_t)N_INP * DM * 2, SZ_WGLU = 512 * 512 * 2, SZ_WPA = (size_t)DM * 512 * 2, SZ_WPC = (size_t)DM * 1024 * 2,
                 SZ_WOUT = (size_t)DM * DM * 2, SZ_WUP = (size_t)D_UP * DM * 2, SZ_WDOWN = (size_t)DM * D_FF * 2;
constexpr size_t WL_IN = 0, WL_GLU = WL_IN + SZ_WIN, WL_PA = WL_GLU + SZ_WGLU, WL_PB = WL_PA + SZ_WPA, WL_PC = WL_PB + SZ_WPA, WL_OUT = WL_PC + SZ_WPC,
                 WL_UP = WL_OUT + SZ_WOUT, WL_DOWN = WL_UP + SZ_WUP, WL_END = WL_DOWN + SZ_WDOWN;
constexpr size_t WS_W = 2 * MiB;
constexpr size_t WS_SMALL = WS_W + 2 * WL_END;
constexpr size_t SM_WS = 0;
constexpr size_t SM_S5BB = SM_WS + 2 * 8 * 128 * 128 * 2;
constexpr size_t SM_S5CT = SM_S5BB + 2 * 32 * 64 * 32 * 4;
constexpr size_t SM_S5A = SM_S5CT + 2 * 32 * 16 * 128 * 2;
constexpr size_t SM_DT = SM_S5A + 2 * 32 * 64 * 4 * 4;
constexpr size_t SM_VSQ = SM_DT + (size_t)MP * 16 * 4;
constexpr size_t SM_CSQ = SM_VSQ + (size_t)2 * MP * 4;
constexpr size_t SM_SLOC = SM_CSQ + (size_t)2 * MP * 4;
constexpr size_t SM_SDEC = SM_SLOC + (size_t)NB * G_A * S5NC * 128 * 4;
constexpr size_t SM_CSILU = SM_SDEC + 4096;
constexpr size_t SM_WDT = SM_CSILU + 256 * 2048 * 2;
constexpr size_t SM_END = SM_WDT + (size_t)2 * 16 * DM * 4;
constexpr size_t WS_MOD = (WS_SMALL + SM_END + 4095) / 4096 * 4096;
constexpr size_t WS_X0 = WS_MOD + (size_t)2 * 256 * N_MOD * 4;
constexpr size_t WS_X1 = WS_X0 + (size_t)MP * DM * 4;
constexpr size_t WS_H = WS_X1 + (size_t)MP * DM * 4;
constexpr size_t WS_BIG = WS_H + (size_t)MP * DM * 2;
constexpr size_t WS_T = WS_BIG + (size_t)MP * D_UP * 2;
constexpr size_t WS_MERGED = WS_T + (size_t)MP * DM * 4;
constexpr size_t WS_OCAT = WS_MERGED + (size_t)MP * DM * 2;
constexpr int OCP = 2048, OC_A = 0, OC_B = 512, OC_C = 1024;
constexpr size_t WS_YB = WS_OCAT + (size_t)MP * OCP * 2;
constexpr size_t WS_STATES = WS_YB + (size_t)MP * 512 * 2;
constexpr size_t WS_SLAB = WS_STATES + (size_t)NB * SSDNC * H_C * HD_C * N_C * 4;
constexpr size_t WS_HALO = WS_SLAB + (size_t)176 * 131072;
constexpr size_t WS_END = WS_HALO + (size_t)33 * 4 * D_UP * 4;
static_assert((size_t)MP * D_FF * 2 <= (size_t)MP * DM * 6, "ACT overlays T+MERGED");
constexpr int CW_PC = 12288;
constexpr int CW_S5F = 20480;
constexpr int CW_SSDF = 16384;
constexpr int CW_BAR = 4096, CW_CNT = 8192;
struct Args { const float* in[N_INPUTS]; float* out; unsigned char* ws; };
typedef const __attribute__((address_space(4))) Args* KArgs;
__device__ __forceinline__ KArgs launder_args(KArgs a) { unsigned long long t = (unsigned long long)a; asm volatile("" : "+s"(t)); return (KArgs)t; }
#define GAS __attribute__((address_space(1)))
#define LAS __attribute__((address_space(3)))
typedef unsigned short bf16;
typedef unsigned v4u __attribute__((ext_vector_type(4)));
typedef unsigned v2u __attribute__((ext_vector_type(2)));
typedef float f32x4 __attribute__((ext_vector_type(4)));
typedef float f32x2 __attribute__((ext_vector_type(2)));
typedef short bf16x8 __attribute__((ext_vector_type(8)));
typedef short bf16x4 __attribute__((ext_vector_type(4)));
typedef GAS unsigned gu32;
#define RLX_AGENT __ATOMIC_RELAXED, __HIP_MEMORY_SCOPE_AGENT
#define LDS_WAIT() asm volatile("s_waitcnt lgkmcnt(0)" ::: "memory")
#define VM_WAIT() asm volatile("s_waitcnt vmcnt(0)" ::: "memory")
constexpr int NWAVES = 8, NTHR = 512, GRID = 256;
__device__ __forceinline__ unsigned f2bf(float f) { unsigned u = __builtin_bit_cast(unsigned, f); return (u + 0x7fffu + ((u >> 16) & 1u)) >> 16; }
__device__ __forceinline__ unsigned pk2(float lo, float hi) { return f2bf(lo) | (f2bf(hi) << 16); }
__device__ __forceinline__ float bf2f(unsigned short b) { return __builtin_bit_cast(float, (unsigned)b << 16); }
__device__ __forceinline__ float bflo(unsigned w) { return __builtin_bit_cast(float, w << 16); }
__device__ __forceinline__ float bfhi(unsigned w) { return __builtin_bit_cast(float, w & 0xffff0000u); }
__device__ __forceinline__ float sigmoidf_(float x) { return __builtin_amdgcn_rcpf(1.0f + __expf(-x)); }
__device__ __forceinline__ float siluf_(float x) { return x * __builtin_amdgcn_rcpf(1.0f + __expf(-x)); }
__device__ __forceinline__ float gelu_tanh(float x) {
    const float u = 0.7978845608028654f * (x + 0.044715f * x * x * x);
    const float e = __expf(2.0f * u);
    const float t = 1.0f - 2.0f * __builtin_amdgcn_rcpf(e + 1.0f);
    return 0.5f * x * (1.0f + t);
}
__device__ __forceinline__ float softplusf_(float x) { return fmaxf(x, 0.f) + __logf(1.0f + __expf(-fabsf(x))); }
template <int M> __device__ __forceinline__ float xor_lt32(float x) {
    return __builtin_bit_cast(float, __builtin_amdgcn_ds_swizzle(__builtin_bit_cast(int, x), (M << 10) | 0x1f)); }
__device__ __forceinline__ float add_xor32(float x) {
    const unsigned b = __builtin_bit_cast(unsigned, x); const auto r = __builtin_amdgcn_permlane32_swap(b, b, false, false);
    return __builtin_bit_cast(float, (unsigned)r[0]) + __builtin_bit_cast(float, (unsigned)r[1]); }
__device__ __forceinline__ float wave_sum(float v) {
    v += xor_lt32<1>(v); v += xor_lt32<2>(v); v += xor_lt32<4>(v); v += xor_lt32<8>(v); v += xor_lt32<16>(v);
    return add_xor32(v);
}
__device__ __forceinline__ float wave_sum16(const float (&a)[16], int lane) {
    float b[8], c[4], d[2];
    const bool o1 = lane & 1, o2 = lane & 2, o4 = lane & 4, o8 = lane & 8;
#pragma unroll
    for (int i = 0; i < 8; ++i) { const float keep = o1 ? a[2 * i + 1] : a[2 * i], send = o1 ? a[2 * i] : a[2 * i + 1]; b[i] = keep + xor_lt32<1>(send); }
#pragma unroll
    for (int i = 0; i < 4; ++i) { const float keep = o2 ? b[2 * i + 1] : b[2 * i], send = o2 ? b[2 * i] : b[2 * i + 1]; c[i] = keep + xor_lt32<2>(send); }
#pragma unroll
    for (int i = 0; i < 2; ++i) { const float keep = o4 ? c[2 * i + 1] : c[2 * i], send = o4 ? c[2 * i] : c[2 * i + 1]; d[i] = keep + xor_lt32<4>(send); }
    const float keep = o8 ? d[1] : d[0], send = o8 ? d[0] : d[1];
    float e = keep + xor_lt32<8>(send);
    e += xor_lt32<16>(e);
    return add_xor32(e);
}
__device__ __forceinline__ float half_sum32(const float (&a)[32], int lane) {
    float b[16], c[8], d[4], e[2];
    const bool o1 = lane & 1, o2 = lane & 2, o4 = lane & 4, o8 = lane & 8, o16 = lane & 16;
#pragma unroll
    for (int i = 0; i < 16; ++i) { const float keep = o1 ? a[2 * i + 1] : a[2 * i], send = o1 ? a[2 * i] : a[2 * i + 1]; b[i] = keep + xor_lt32<1>(send); }
#pragma unroll
    for (int i = 0; i < 8; ++i) { const float keep = o2 ? b[2 * i + 1] : b[2 * i], send = o2 ? b[2 * i] : b[2 * i + 1]; c[i] = keep + xor_lt32<2>(send); }
#pragma unroll
    for (int i = 0; i < 4; ++i) { const float keep = o4 ? c[2 * i + 1] : c[2 * i], send = o4 ? c[2 * i] : c[2 * i + 1]; d[i] = keep + xor_lt32<4>(send); }
#pragma unroll
    for (int i = 0; i < 2; ++i) { const float keep = o8 ? d[2 * i + 1] : d[2 * i], send = o8 ? d[2 * i] : d[2 * i + 1]; e[i] = keep + xor_lt32<8>(send); }
    const float keep = o16 ? e[1] : e[0], send = o16 ? e[0] : e[1];
    return keep + xor_lt32<16>(send);
}
__device__ __forceinline__ float lane_bcast(float x, int src) {
    return __builtin_bit_cast(float, __builtin_amdgcn_readlane(__builtin_bit_cast(int, x), src)); }
__device__ __forceinline__ int mod_row(int r) { return r < MPROMPT ? (r >> 11) : (r < MREAL ? 4 + (r - MPROMPT) : 4 + NS - 1); }

template <int MODE, bool SRC32 = false>
__device__ __forceinline__ void prep_row(const void* xrow, const float* g, const float* mr, int sh_idx, int sc_idx, bf16* hrow, float* yrow, float* dtrow, const LAS float* wT, int lane) {
    f32x4 v[8]; float s = 0.f;
    if (SRC32) { const GAS f32x4* xr = (const GAS f32x4*)xrow + lane;
#pragma unroll
        for (int j = 0; j < 8; ++j) v[j] = xr[64 * j];
    } else { const GAS v2u* xr = (const GAS v2u*)xrow + lane;
#pragma unroll
        for (int j = 0; j < 8; ++j) { const v2u w = xr[64 * j]; v[j] = (f32x4){bflo(w.x), bfhi(w.x), bflo(w.y), bfhi(w.y)}; } }
#pragma unroll
    for (int j = 0; j < 8; ++j) s += (v[j].x * v[j].x + v[j].y * v[j].y) + (v[j].z * v[j].z + v[j].w * v[j].w);
    const float rinv = rsqrtf(wave_sum(s) * (1.0f / DM) + EPS);
    const GAS f32x4* gp = (const GAS f32x4*)g + lane;
    if (MODE == 2) { GAS f32x4* o = (GAS f32x4*)yrow + lane;
#pragma unroll
        for (int j = 0; j < 8; ++j) o[64 * j] = v[j] * rinv * gp[64 * j];
        return; }
    const GAS f32x4* shp = (const GAS f32x4*)(mr + sh_idx * DM) + lane; const GAS f32x4* scp = (const GAS f32x4*)(mr + sc_idx * DM) + lane;
    GAS v2u* o = (GAS v2u*)hrow + lane;
#pragma unroll
    for (int j = 0; j < 8; ++j) { const f32x4 gg = gp[64 * j], sh = shp[64 * j], sc = scp[64 * j];
        v[j] = v[j] * rinv * gg * (sc + 1.0f) + sh;
        v2u w; w.x = pk2(v[j].x, v[j].y); w.y = pk2(v[j].z, v[j].w); o[64 * j] = w; if (SRC32 && (j & 1)) asm volatile("" ::: "memory"); }
    if (MODE == 1) {
        float a16[16];
        if (SRC32) asm volatile("" ::: "memory");
#pragma unroll
        for (int hh = 0; hh < 16; ++hh) { float a = 0.f;
#pragma unroll
            for (int j = 0; j < 8; ++j) { const f32x4 w = *(const LAS f32x4*)(wT + hh * DM + 4 * lane + 256 * j); a += (v[j].x * w.x + v[j].y * w.y) + (v[j].z * w.z + v[j].w * w.w); }
            a16[hh] = a; if (SRC32) asm volatile("" ::: "memory"); }
        const float mine = wave_sum16(a16, lane);
        if (lane < 16) dtrow[lane] = mine;
    }
}

template <int MODE, bool SRC32 = false, int NQ = 4>
__device__ __forceinline__ void prep_rows4(const void* x0, const float* g, const float* mr, int sh_idx, int sc_idx, bf16* h0, float* y0, float* dt0, const LAS float* wT, int lane) {
    f32x4 v[NQ][8];
#pragma unroll
    for (int q = 0; q < NQ; ++q) {
        if (SRC32) { const GAS f32x4* xr = (const GAS f32x4*)((const float*)x0 + (size_t)q * DM) + lane;
#pragma unroll
            for (int j = 0; j < 8; ++j) v[q][j] = xr[64 * j];
        } else { const GAS v2u* xr = (const GAS v2u*)((const bf16*)x0 + (size_t)q * DM) + lane;
#pragma unroll
            for (int j = 0; j < 8; ++j) { const v2u w = xr[64 * j]; v[q][j] = (f32x4){bflo(w.x), bfhi(w.x), bflo(w.y), bfhi(w.y)}; } } }
    f32x4 gm[8], sh[8];
    {   const GAS f32x4* gp = (const GAS f32x4*)g + lane;
        if (MODE == 2) {
#pragma unroll
            for (int j = 0; j < 8; ++j) gm[j] = gp[64 * j];
        } else { const GAS f32x4* shp = (const GAS f32x4*)(mr + sh_idx * DM) + lane; const GAS f32x4* scp = (const GAS f32x4*)(mr + sc_idx * DM) + lane;
#pragma unroll
            for (int j = 0; j < 8; ++j) { gm[j] = gp[64 * j] * (scp[64 * j] + 1.0f); sh[j] = shp[64 * j]; } } }
#pragma unroll
    for (int q = 0; q < NQ; ++q) { float s = 0.f;
#pragma unroll
        for (int j = 0; j < 8; ++j) s += (v[q][j].x * v[q][j].x + v[q][j].y * v[q][j].y) + (v[q][j].z * v[q][j].z + v[q][j].w * v[q][j].w);
        const float rinv = rsqrtf(wave_sum(s) * (1.0f / DM) + EPS);
        if (MODE == 2) { GAS f32x4* o = (GAS f32x4*)(y0 + (size_t)q * DM) + lane;
#pragma unroll
            for (int j = 0; j < 8; ++j) o[64 * j] = v[q][j] * rinv * gm[j];
        } else { GAS v2u* o = (GAS v2u*)(h0 + (size_t)q * DM) + lane;
#pragma unroll
            for (int j = 0; j < 8; ++j) { v[q][j] = v[q][j] * rinv * gm[j] + sh[j]; v2u w; w.x = pk2(v[q][j].x, v[q][j].y); w.y = pk2(v[q][j].z, v[q][j].w); o[64 * j] = w; }
        }
    }
    if (MODE == 1) {
#pragma unroll
        for (int pr = 0; pr < NQ / 2; ++pr) { float a16[2][16];
#pragma unroll
            for (int hh = 0; hh < 16; ++hh) { float a0 = 0.f, a1 = 0.f;
#pragma unroll
                for (int j = 0; j < 8; ++j) { const f32x4 w = *(const LAS f32x4*)(wT + hh * DM + 4 * lane + 256 * j);
                    a0 += (v[2 * pr][j].x * w.x + v[2 * pr][j].y * w.y) + (v[2 * pr][j].z * w.z + v[2 * pr][j].w * w.w);
                    a1 += (v[2 * pr + 1][j].x * w.x + v[2 * pr + 1][j].y * w.y) + (v[2 * pr + 1][j].z * w.z + v[2 * pr + 1][j].w * w.w); }
                a16[0][hh] = a0; a16[1][hh] = a1; if (SRC32 && (hh & 1) == 1) asm volatile("" ::: "memory"); }
            { const float m0 = wave_sum16(a16[0], lane), m1 = wave_sum16(a16[1], lane); if (lane < 16) { dt0[(2 * pr) * 16 + lane] = m0; dt0[(2 * pr + 1) * 16 + lane] = m1; } } }
    }
}
#define XB_TMO      128
#define XB_XCNT(j)  (256  + 64 * (j))
#define XB_XSUB(j)  (1280 + 64 * (j))
#define XB_XGEN(j)  (2304 + 64 * (j))
#define XB_TOP      3328
#define XB_TOPGEN   3392
#define XCD_BAR_WORDS 3456
#define XB_SPIN_CAP (1u << 18)

__device__ __forceinline__ unsigned xb_ld(unsigned* p)              { return __hip_atomic_load(p, __ATOMIC_RELAXED, __HIP_MEMORY_SCOPE_AGENT); }
__device__ __forceinline__ unsigned xb_add(unsigned* p, unsigned v) { return __hip_atomic_fetch_add(p, v, __ATOMIC_RELAXED, __HIP_MEMORY_SCOPE_AGENT); }
__device__ __forceinline__ unsigned xb_xcc_id() { return (unsigned)__builtin_amdgcn_s_getreg((3 << 11) | 20) & 0xFu; }
#define XB_SPIN(cond, bar) do { unsigned _sp = 0; while (cond) { __builtin_amdgcn_s_sleep(1); \
    if ((++_sp & 255u) == 0u) { if (xb_ld(&(bar)[XB_TMO])) break; if (_sp > XB_SPIN_CAP) { atomicAdd(&(bar)[XB_TMO], 1u); break; } } } } while (0)

struct XcdBarrier {
    unsigned* bar; unsigned x;
    volatile LAS unsigned* st;
};

__device__ __forceinline__ XcdBarrier xcd_barrier_post(unsigned* bar, volatile LAS unsigned* st) {
    XcdBarrier b; b.bar = bar; b.x = xb_xcc_id(); b.st = st;
    if (threadIdx.x == 0) (void)xb_add(&bar[XB_XCNT(b.x)], 1u);
    return b;
}
__device__ __forceinline__ void xcd_barrier_complete(unsigned* bar, unsigned x, unsigned& nloc, unsigned& nx) {
    const unsigned G = gridDim.x * gridDim.y * gridDim.z;
    unsigned sum, cnt, mine, sp = 0u;
    for (;;) {
        sum = 0u; cnt = 0u; mine = 0u;
#pragma unroll
        for (unsigned j = 0; j < 16; ++j) { const unsigned c = xb_ld(&bar[XB_XCNT(j)]); sum += c; cnt += (c > 0u) ? 1u : 0u; mine = (j == x) ? c : mine; }
        if (sum == G) break;
        __builtin_amdgcn_s_sleep(1);
        if ((++sp & 255u) == 0u) { if (xb_ld(&bar[XB_TMO])) break; if (sp > XB_SPIN_CAP) { atomicAdd(&bar[XB_TMO], 1u); break; } }
    }
    nloc = mine > 0u ? mine : 1u; nx = cnt > 0u ? cnt : 1u;
}

__device__ __forceinline__ void xcd_barrier(const XcdBarrier& b) {
    asm volatile("s_waitcnt vmcnt(0)" ::: "memory");
    __syncthreads();
    if (threadIdx.x == 0) {
        unsigned* bar = b.bar;
        __builtin_amdgcn_s_waitcnt(0);
        unsigned nloc = b.st[0], nx = b.st[1];
        if (nloc == 0u) { xcd_barrier_complete(bar, b.x, nloc, nx); b.st[0] = nloc; b.st[1] = nx; }
        const unsigned old = xb_add(&bar[XB_XSUB(b.x)], 1u);
        const unsigned gen = old / nloc;
        if (old + 1u == (gen + 1u) * nloc) {
            __builtin_amdgcn_fence(__ATOMIC_RELEASE, "agent");
            asm volatile("s_waitcnt vmcnt(0)" ::: "memory");
            const unsigned og = xb_add(&bar[XB_TOP], 1u);
            const unsigned tg = og / nx;
            if (og + 1u == (tg + 1u) * nx) xb_add(&bar[XB_TOPGEN], 1u);
            else XB_SPIN(xb_ld(&bar[XB_TOPGEN]) == tg, bar);
            __builtin_amdgcn_fence(__ATOMIC_ACQUIRE, "agent");
            xb_add(&bar[XB_XGEN(b.x)], 1u);
            asm volatile("s_waitcnt vmcnt(0)" ::: "memory");
        } else {
            XB_SPIN(xb_ld(&bar[XB_XGEN(b.x)]) == gen, bar);
            __builtin_amdgcn_fence(__ATOMIC_ACQUIRE, "agent");
            asm volatile("s_waitcnt vmcnt(0)" ::: "memory");
        }
    }
    __syncthreads();
}

namespace epi {
using pg8::Unit; using pg8::f32x4; using pg8::u32x4; using pg8::cvt_pk_bf16;
typedef unsigned u32x2 __attribute__((ext_vector_type(2)));
constexpr int BM = 256, HALF = 128;

constexpr int SLAB_F4 = 8 * 16 * 64;
constexpr int SLAB_BYTES_ALL = 176 * 131072;
typedef unsigned v4u_ __attribute__((ext_vector_type(4)));
template <bool PERM> __device__ __forceinline__ int split_col(const Unit& u, int wc, int fq, int bj, int n) { return u.pn * BM + bj * HALF + wc * 32 + (PERM ? 8 * fq + 4 * n : 16 * n + 4 * fq); }
__device__ __forceinline__ __amdgpu_buffer_rsrc_t slab_rsrc(const f32x4* SLAB) { return __builtin_amdgcn_make_buffer_rsrc((void*)SLAB, (short)0, SLAB_BYTES_ALL, 0x00020000); }
__device__ __forceinline__ void split_store(const f32x4 (&acc)[2][2][4][2], f32x4* SLAB, int sid, int wid, int lane) {
    asm volatile("" : "+v"(lane));
    const __amdgpu_buffer_rsrc_t rs = slab_rsrc(SLAB);
    const unsigned vo = (unsigned)(wid * 16 * 64 + lane) * 16u, so = (unsigned)sid * (unsigned)(SLAB_F4 * 16);
#pragma unroll
    for (int m = 0; m < 4; ++m)
#pragma unroll
        for (int bj = 0; bj < 2; ++bj)
#pragma unroll
            for (int n = 0; n < 2; ++n) __builtin_amdgcn_raw_buffer_store_b128(__builtin_bit_cast(v4u_, acc[0][bj][m][n]), rs, vo + (unsigned)(((m * 2 + bj) * 2 + n) * 64 * 16), so,   16);
}
__device__ __forceinline__ bool split_arrive(unsigned* cnt, unsigned target, int lane) {
    asm volatile("s_waitcnt vmcnt(0)" ::: "memory");
    unsigned old = 0u;
    if (lane == 0) old = __hip_atomic_fetch_add(cnt, 1u, __ATOMIC_RELAXED, __HIP_MEMORY_SCOPE_AGENT);
    old = __builtin_amdgcn_readlane(old, 0);
    asm volatile("" ::: "memory");
    if (old != target - 1u) return false;
    __builtin_amdgcn_fence(__ATOMIC_ACQUIRE, "agent"); asm volatile("s_waitcnt vmcnt(0)" ::: "memory");
    return true;
}
__device__ __forceinline__ f32x4 slab_ld(const __amdgpu_buffer_rsrc_t rs, unsigned vo, unsigned so) { return __builtin_bit_cast(f32x4, __builtin_amdgcn_raw_buffer_load_b128(rs, vo, so,   16)); }
__device__ __forceinline__ f32x4 split_sum1(const f32x4* SLAB, int sid0, int ns, int wid, int lane, int reg) {
    const __amdgpu_buffer_rsrc_t rs = slab_rsrc(SLAB);
    const unsigned vo = (unsigned)((wid * 16 + reg) * 64 + lane) * 16u;
    f32x4 s = slab_ld(rs, vo, (unsigned)sid0 * (unsigned)(SLAB_F4 * 16));
    for (int j = 1; j < ns; ++j) s = s + slab_ld(rs, vo, (unsigned)(sid0 + j) * (unsigned)(SLAB_F4 * 16));
    return s;
}
__device__ __forceinline__ void split_sum(f32x4 (&acc)[2][2][4][2], const f32x4* SLAB, int sid0, int ns, int wid, int lane, int mmask = 15) {
    asm volatile("" : "+v"(lane));
    const __amdgpu_buffer_rsrc_t rs = slab_rsrc(SLAB);
    const unsigned vo = (unsigned)(wid * 16 * 64 + lane) * 16u;
#pragma unroll
    for (int m = 0; m < 4; ++m) { if (!((mmask >> m) & 1)) continue;
#pragma unroll
        for (int bj = 0; bj < 2; ++bj) {
            const unsigned vr = vo + (unsigned)((m * 2 + bj) * 2) * 1024u;
            unsigned so = (unsigned)sid0 * (unsigned)(SLAB_F4 * 16);
            f32x4 s0 = {0.f, 0.f, 0.f, 0.f}, s1 = s0;
            int j = 0;
#pragma unroll 1
            for (; j + 4 <= ns; j += 4) {
                f32x4 t[4][2];
#pragma unroll
                for (int q = 0; q < 4; ++q) { const unsigned sq = so + (unsigned)q * (unsigned)(SLAB_F4 * 16); t[q][0] = slab_ld(rs, vr, sq); t[q][1] = slab_ld(rs, vr + 1024u, sq); }
#pragma unroll
                for (int q = 0; q < 4; ++q) { s0 = s0 + t[q][0]; s1 = s1 + t[q][1]; }
                so += 4u * (unsigned)(SLAB_F4 * 16); }
            if (j < ns) {
                f32x4 t[3][2];
#pragma unroll
                for (int q = 0; q < 3; ++q) { const unsigned sq = so + (unsigned)q * (unsigned)(SLAB_F4 * 16);
                    if (j + q < ns) { t[q][0] = slab_ld(rs, vr, sq); t[q][1] = slab_ld(rs, vr + 1024u, sq); } else { t[q][0] = (f32x4){0.f, 0.f, 0.f, 0.f}; t[q][1] = t[q][0]; } }
#pragma unroll
                for (int q = 0; q < 3; ++q) { s0 = s0 + t[q][0]; s1 = s1 + t[q][1]; } }
            acc[0][bj][m][0] = s0; acc[0][bj][m][1] = s1;
            asm volatile("" ::: "memory");
        } }
}
__device__ __forceinline__ void split_zero_pad(f32x4 (&acc)[2][2][4][2]) {
#pragma unroll
    for (int bj = 0; bj < 2; ++bj)
#pragma unroll
        for (int m = 0; m < 4; ++m)
#pragma unroll
            for (int n = 0; n < 2; ++n) acc[1][bj][m][n] = (f32x4){0.f, 0.f, 0.f, 0.f};
}
struct SplitCtl { f32x4* SLAB; unsigned* cnt; unsigned nsl; int fin0, cbase, parts; };
__device__ __forceinline__ void split_post(unsigned* cnt, int lane) {
    asm volatile("s_waitcnt vmcnt(0)" ::: "memory");
    if (lane == 0) __hip_atomic_fetch_add(cnt, 1u, __ATOMIC_RELAXED, __HIP_MEMORY_SCOPE_AGENT);
}
__device__ __forceinline__ void split_wait(unsigned* cnt, unsigned target, int lane) {
    if (lane == 0) { unsigned sp_ = 0; while (__hip_atomic_load(cnt, __ATOMIC_RELAXED, __HIP_MEMORY_SCOPE_AGENT) < target && ++sp_ < (1u << 22)) __builtin_amdgcn_s_sleep(2); }
    asm volatile("" ::: "memory");
    __builtin_amdgcn_fence(__ATOMIC_ACQUIRE, "agent"); asm volatile("s_waitcnt vmcnt(0)" ::: "memory");
}
__device__ __forceinline__ int part_mask(int p, int parts) { const int w = 4 / parts; return ((1 << w) - 1) << (p * w); }
__device__ __forceinline__ int opaque_bx() { int b = (int)blockIdx.x; asm volatile("" : "+s"(b)); return b; }
__device__ __forceinline__ Unit final_unit(int f, int cbase) { Unit u; u.pm = MPROMPT / 256; u.pn = f; u.k0 = 0; u.nt = 0; u.cidx = cbase + f; u.sid = 0; return u; }

struct EpiIn {
    static constexpr bool PERM = true, AFTER_DRAIN = false, HOOK = false;
    bf16* O; float* vsq; SplitCtl sp;
    template <int ACT> __device__ __forceinline__ void run(const f32x4 (&acc)[2][2][4][2], const Unit& u, int wr, int wc, int fr, int fq, bool dosq, int mmask, int nai) const {
        const int row0 = u.pm * BM + wr * 64 + fr, col0 = u.pn * BM + wc * 32 + 8 * fq;
#pragma unroll
        for (int ai = 0; ai < 2; ++ai) { if (ai >= nai) break;
#pragma unroll
            for (int m = 0; m < 4; ++m) { if (!((mmask >> m) & 1)) continue; const int row = row0 + ai * HALF + m * 16; bf16* rowp = O + (size_t)row * N_INP + col0; float sq = 0.f;
#pragma unroll
                for (int bj = 0; bj < 2; ++bj) { f32x4 v0 = acc[ai][bj][m][0], v1 = acc[ai][bj][m][1];
#pragma unroll
                    for (int j = 0; j < 4; ++j) {
                        if (ACT == 1) { v0[j] = gelu_tanh(v0[j]); v1[j] = gelu_tanh(v1[j]); }
                        if (ACT == 2) { v0[j] = sigmoidf_(v0[j]); v1[j] = sigmoidf_(v1[j]); }
                        sq += v0[j] * v0[j] + v1[j] * v1[j]; }
                    u32x4 w; w.x = cvt_pk_bf16(v0[0], v0[1]); w.y = cvt_pk_bf16(v0[2], v0[3]); w.z = cvt_pk_bf16(v1[0], v1[1]); w.w = cvt_pk_bf16(v1[2], v1[3]);
                    *(GAS u32x4*)(rowp + bj * HALF) = w; }
                if (ACT == 1) { if (dosq && vsq) { sq += xor_lt32<16>(sq); sq = add_xor32(sq); if (fq == 0) atomicAdd(vsq + row, sq); } }
            } }
    }
    __device__ __forceinline__ void apply(const f32x4 (&acc)[2][2][4][2], const Unit& u, int wr, int wc, int fr, int fq, int mmask, int nai) const {
        const int pn = u.pn;
        if (pn >= 16) run<2>(acc, u, wr, wc, fr, fq, false, mmask, nai);
        else if (pn >= 2 && pn < 6) run<1>(acc, u, wr, wc, fr, fq, pn >= 4, mmask, nai);
        else run<0>(acc, u, wr, wc, fr, fq, false, mmask, nai);
    }
    __device__ __forceinline__ void operator()(const f32x4 (&acc)[2][2][4][2], const Unit& u, int wr, int wc, int fr, int fq) const { apply(acc, u, wr, wc, fr, fq, 15, 2); }
    __device__ __forceinline__ void partial(f32x4 (&acc)[2][2][4][2], const Unit& u, int wr, int wc, int fr, int fq, int wid, int lane) const {
        split_store(acc, sp.SLAB, u.sid, wid, lane); split_post(sp.cnt + u.cidx * 8 + wid, lane);
    }
    __device__ __forceinline__ void final(const Unit& u, int wr, int wc, int fr, int fq, int wid, int lane, int mmask) const {
        f32x4 acc[2][2][4][2];
        split_wait(sp.cnt + u.cidx * 8 + wid, sp.nsl, lane);
        split_sum(acc, sp.SLAB, u.pn * (int)sp.nsl, (int)sp.nsl, wid, lane, mmask); apply(acc, u, wr, wc, fr, fq, mmask, 1);
    }
};
struct EpiBf16Plain {
    static constexpr bool PERM = true, AFTER_DRAIN = false, HOOK = false;
    bf16* O; int ldc;
    __device__ __forceinline__ void partial(f32x4 (&)[2][2][4][2], const Unit&, int, int, int, int, int, int) const {}
    __device__ __forceinline__ void operator()(const f32x4 (&acc)[2][2][4][2], const Unit& u, int wr, int wc, int fr, int fq) const {
        const int row0 = u.pm * BM + wr * 64 + fr, col0 = u.pn * BM + wc * 32 + 8 * fq;
#pragma unroll
        for (int ai = 0; ai < 2; ++ai)
#pragma unroll
            for (int m = 0; m < 4; ++m) { bf16* rowp = O + (size_t)(row0 + ai * HALF + m * 16) * ldc + col0;
#pragma unroll
                for (int bj = 0; bj < 2; ++bj) { const f32x4 v0 = acc[ai][bj][m][0], v1 = acc[ai][bj][m][1];
                    u32x4 w; w.x = cvt_pk_bf16(v0[0], v0[1]); w.y = cvt_pk_bf16(v0[2], v0[3]); w.z = cvt_pk_bf16(v1[0], v1[1]); w.w = cvt_pk_bf16(v1[2], v1[3]);
                    *(GAS u32x4*)(rowp + bj * HALF) = w; } }
    }
};
__device__ __forceinline__ float dpp_ror1(float x) { return __builtin_bit_cast(float, __builtin_amdgcn_update_dpp(0, __builtin_bit_cast(int, x), 0x121, 0xf, 0xf, false)); }
__device__ __forceinline__ float dpp_ror2(float x) { return __builtin_bit_cast(float, __builtin_amdgcn_update_dpp(0, __builtin_bit_cast(int, x), 0x122, 0xf, 0xf, false)); }
__device__ __forceinline__ float dpp_shr1(float old, float x) { return __builtin_bit_cast(float, __builtin_amdgcn_update_dpp(__builtin_bit_cast(int, old), __builtin_bit_cast(int, x), 0x111, 0xf, 0xf, false)); }
__device__ __forceinline__ float dpp_shr2(float old, float x) { return __builtin_bit_cast(float, __builtin_amdgcn_update_dpp(__builtin_bit_cast(int, old), __builtin_bit_cast(int, x), 0x112, 0xf, 0xf, false)); }
struct EpiUpConv {
    static constexpr bool PERM = true, AFTER_DRAIN = false, HOOK = false;
    bf16* ACT; float* HALO; const float* cw; const float* cb; const float* st; float* cfs; LAS float* EX; int dry;
    __device__ __forceinline__ void partial(f32x4 (&)[2][2][4][2], const Unit&, int, int, int, int, int, int) const {}
    __device__ __forceinline__ void operator()(const f32x4 (&acc)[2][2][4][2], const Unit& u, int wr, int wc, int fr, int fq) const {
        asm volatile("" : "+v"(fr), "+v"(fq));
        if (dry) {
#pragma unroll
            for (int ai = 0; ai < 2; ++ai)
#pragma unroll
                for (int bj = 0; bj < 2; ++bj)
#pragma unroll
                    for (int m = 0; m < 4; ++m)
#pragma unroll
                        for (int n = 0; n < 2; ++n) asm volatile("" :: "v"(acc[ai][bj][m][n]));
            return; }
        const int cl = wc * 32 + 8 * fq;
        if (u.pm == MPROMPT / 256) {
#pragma unroll
            for (int n = 0; n < 2; ++n) { const int c = u.pn * 128 + cl + 4 * n;
                f32x4 wa0, wa1, wa2, wb0, wb1, wb2, ba, bb;
                wa0 = *(const GAS f32x4*)(cw + c); wa1 = *(const GAS f32x4*)(cw + D_UP + c); wa2 = *(const GAS f32x4*)(cw + 2 * D_UP + c); wb0 = *(const GAS f32x4*)(cw + D_FF + c); wb1 = *(const GAS f32x4*)(cw + D_UP + D_FF + c); wb2 = *(const GAS f32x4*)(cw + 2 * D_UP + D_FF + c);
                ba = *(const GAS f32x4*)(cb + c); bb = *(const GAS f32x4*)(cb + D_FF + c);
#pragma unroll
                for (int m = 0; m < 4; ++m) { const int s = wr * 64 + m * 16 + fr; const float* sp = st + (size_t)s * 2 * D_UP; float* op = cfs + (size_t)s * 2 * D_UP;
                    const f32x4 a2 = *(const GAS f32x4*)(sp + c), a1 = *(const GAS f32x4*)(sp + D_UP + c), b2 = *(const GAS f32x4*)(sp + D_FF + c), b1 = *(const GAS f32x4*)(sp + D_UP + D_FF + c);
                    const f32x4 ua = acc[0][0][m][n], ub = acc[0][1][m][n];
                    *(GAS f32x4*)(op + c) = a1; *(GAS f32x4*)(op + D_FF + c) = b1; *(GAS f32x4*)(op + D_UP + c) = ua; *(GAS f32x4*)(op + D_UP + D_FF + c) = ub;
                    const f32x4 ca = ba + wa0 * a2 + wa1 * a1 + wa2 * ua, cbv = bb + wb0 * b2 + wb1 * b1 + wb2 * ub;
                    u32x2 w; w.x = cvt_pk_bf16(siluf_(ca[0]) * cbv[0], siluf_(ca[1]) * cbv[1]); w.y = cvt_pk_bf16(siluf_(ca[2]) * cbv[2], siluf_(ca[3]) * cbv[3]);
                    *(GAS u32x2*)(ACT + (size_t)(MPROMPT + s) * D_FF + c) = w; }
                asm volatile("" ::: "memory"); }
            return;
        }
        f32x4 wts[2][8];
#pragma unroll
        for (int n = 0; n < 2; ++n) { const int c = u.pn * 128 + cl + 4 * n;
            wts[n][0] = *(const GAS f32x4*)(cw + c); wts[n][1] = *(const GAS f32x4*)(cw + D_UP + c); wts[n][2] = *(const GAS f32x4*)(cw + 2 * D_UP + c);
            wts[n][3] = *(const GAS f32x4*)(cw + D_FF + c); wts[n][4] = *(const GAS f32x4*)(cw + D_UP + D_FF + c); wts[n][5] = *(const GAS f32x4*)(cw + 2 * D_UP + D_FF + c);
            wts[n][6] = *(const GAS f32x4*)(cb + c); wts[n][7] = *(const GAS f32x4*)(cb + D_FF + c); }
        if (fr >= 14) {
#pragma unroll
            for (int ai = 0; ai < 2; ++ai)
#pragma unroll
                for (int bj = 0; bj < 2; ++bj)
#pragma unroll
                    for (int n = 0; n < 2; ++n) *(LAS f32x4*)(EX + ((ai * 2 + wr) * 2 + (fr - 14)) * 256 + bj * 128 + cl + 4 * n) = acc[ai][bj][3][n];
            if (wr == 1) {
#pragma unroll
                for (int bj = 0; bj < 2; ++bj)
#pragma unroll
                    for (int n = 0; n < 2; ++n) *(GAS f32x4*)(HALO + ((size_t)u.pm * 4 + 2 + (fr - 14)) * D_UP + u.pn * 256 + bj * 128 + cl + 4 * n) = acc[1][bj][3][n]; }
        }
        if (fr < 2 && wr == 0) {
#pragma unroll
            for (int bj = 0; bj < 2; ++bj)
#pragma unroll
                for (int n = 0; n < 2; ++n) *(GAS f32x4*)(HALO + ((size_t)u.pm * 4 + fr) * D_UP + u.pn * 256 + bj * 128 + cl + 4 * n) = acc[0][bj][0][n]; }
        asm volatile("s_waitcnt lgkmcnt(0)" ::: "memory"); __builtin_amdgcn_s_barrier(); asm volatile("" ::: "memory");
#pragma unroll
        for (int n = 0; n < 2; ++n) { const int c = u.pn * 128 + cl + 4 * n;
            const f32x4 wa0 = wts[n][0], wa1 = wts[n][1], wa2 = wts[n][2], wb0 = wts[n][3], wb1 = wts[n][4], wb2 = wts[n][5], ba = wts[n][6], bb = wts[n][7];
#pragma unroll
            for (int ai = 0; ai < 2; ++ai)
#pragma unroll
                for (int m = 0; m < 4; ++m) {
                    f32x4 cv[2];
#pragma unroll
                    for (int bj = 0; bj < 2; ++bj) { const f32x4 cur = acc[ai][bj][m][n]; f32x4 pb;
                        if (m > 0) pb = acc[ai][bj][m - 1][n];
                        else { pb = (f32x4){0.f, 0.f, 0.f, 0.f};
                            const int sa = wr == 1 ? ai : 0, sw = wr == 1 ? 0 : 1; const bool have = (wr == 1) || (ai == 1);
                            if (have && fr >= 14) pb = *(const LAS f32x4*)(EX + ((sa * 2 + sw) * 2 + (fr - 14)) * 256 + bj * 128 + cl + 4 * n); }
                        f32x4 x1, x2;
#pragma unroll
                        for (int j = 0; j < 4; ++j) { x1[j] = dpp_shr1(dpp_ror1(pb[j]), cur[j]); x2[j] = dpp_shr2(dpp_ror2(pb[j]), cur[j]); }
                        cv[bj] = bj == 0 ? ba + wa0 * x2 + wa1 * x1 + wa2 * cur : bb + wb0 * x2 + wb1 * x1 + wb2 * cur; }
                    u32x2 w; w.x = cvt_pk_bf16(siluf_(cv[0][0]) * cv[1][0], siluf_(cv[0][1]) * cv[1][1]); w.y = cvt_pk_bf16(siluf_(cv[0][2]) * cv[1][2], siluf_(cv[0][3]) * cv[1][3]);
                    *(GAS u32x2*)(ACT + (size_t)(u.pm * BM + ai * HALF + wr * 64 + m * 16 + fr) * D_FF + c) = w; }
            asm volatile("" ::: "memory"); }
    }
};
struct EpiGlu {
    static constexpr bool PERM = true, AFTER_DRAIN = false, HOOK = false;
    const bf16* Y; bf16* O;
    __device__ __forceinline__ void partial(f32x4 (&)[2][2][4][2], const Unit&, int, int, int, int, int, int) const {}
    __device__ __forceinline__ void operator()(const f32x4 (&acc)[2][2][4][2], const Unit& u, int wr, int wc, int fr, int fq) const {
        const int row0 = u.pm * BM + wr * 64 + fr, col0 = u.pn * BM + wc * 32 + 8 * fq;
#pragma unroll
        for (int ai = 0; ai < 2; ++ai)
#pragma unroll
            for (int m = 0; m < 4; ++m) { const size_t off = (size_t)(row0 + ai * HALF + m * 16) * 512 + col0, offo = (size_t)(row0 + ai * HALF + m * 16) * OCP + col0;
#pragma unroll
                for (int bj = 0; bj < 2; ++bj) { const f32x4 v0 = acc[ai][bj][m][0], v1 = acc[ai][bj][m][1];
                    const u32x4 y = *(const GAS u32x4*)(Y + off + bj * HALF);
                    u32x4 w;
                    w.x = cvt_pk_bf16(bflo(y.x) * sigmoidf_(v0[0]), bfhi(y.x) * sigmoidf_(v0[1]));
                    w.y = cvt_pk_bf16(bflo(y.y) * sigmoidf_(v0[2]), bfhi(y.y) * sigmoidf_(v0[3]));
                    w.z = cvt_pk_bf16(bflo(y.z) * sigmoidf_(v1[0]), bfhi(y.z) * sigmoidf_(v1[1]));
                    w.w = cvt_pk_bf16(bflo(y.w) * sigmoidf_(v1[2]), bfhi(y.w) * sigmoidf_(v1[3]));
                    *(GAS u32x4*)(O + offo + bj * HALF) = w; } }
    }
};
#ifndef MERGE_MB
#define MERGE_MB 4
#endif
template <int MODE> struct EpiMerge {
    static constexpr bool PERM = false, AFTER_DRAIN = false, HOOK = false;
    const bf16* G;
    float* T; bf16* MG; const float* csq;
    f32x4* SLAB; const bf16* PRJ; unsigned* cnt;
    __device__ __forceinline__ void partial(f32x4 (&acc)[2][2][4][2], const Unit& u, int wr, int wc, int fr, int fq, int wid, int lane) const {
        split_store(acc, SLAB, u.sid, wid, lane); split_post(cnt + u.cidx * 8 + wid, lane);
    }
    __device__ __forceinline__ void final(const Unit& u, int wr, int wc, int fr, int fq, int wid, int lane, int mmask) const {
        split_wait(cnt + u.cidx * 8 + wid, 8u, lane);
        asm volatile("" : "+v"(fr), "+v"(fq), "+v"(lane));
#pragma unroll
        for (int m = 0; m < 4; ++m) { if (!((mmask >> m) & 1)) continue; const int r = wr * 64 + m * 16 + fr, row = MPROMPT + r; const float rs = rsqrtf(csq[row] * (1.0f / 1024.0f) + EPS);
            const __amdgpu_buffer_rsrc_t rs_ = slab_rsrc(SLAB);
#pragma unroll
            for (int bj = 0; bj < 2; ++bj) {
                f32x4 sa[2], sb[2], sc[2];
                {   f32x4 la[2][2], lb[2][2], lc[2][4];
#pragma unroll
                    for (int n = 0; n < 2; ++n) { const unsigned vo = (unsigned)((wid * 16 + (m * 2 + bj) * 2 + n) * 64 + lane) * 16u;
#pragma unroll
                        for (int j = 0; j < 2; ++j) { la[n][j] = slab_ld(rs_, vo, (unsigned)(u.pn * 2 + j) * (unsigned)(SLAB_F4 * 16)); lb[n][j] = slab_ld(rs_, vo, (unsigned)(16 + u.pn * 2 + j) * (unsigned)(SLAB_F4 * 16)); }
#pragma unroll
                        for (int j = 0; j < 4; ++j) lc[n][j] = slab_ld(rs_, vo, (unsigned)(32 + u.pn * 4 + j) * (unsigned)(SLAB_F4 * 16)); }
#pragma unroll
                    for (int n = 0; n < 2; ++n) { sa[n] = la[n][0] + la[n][1]; sb[n] = lb[n][0] + lb[n][1]; sc[n] = (lc[n][0] + lc[n][1]) + (lc[n][2] + lc[n][3]); } }
#pragma unroll
                for (int n = 0; n < 2; ++n) { const int col = split_col<PERM>(u, wc, fq, bj, n); const bf16* gp = PRJ + ((unsigned)row * N_INP + col);
                    const f32x4 a = sa[n], b = sb[n], c = sc[n];
                    const u32x2 ga = *(const GAS u32x2*)(gp + PC_GA), gb = *(const GAS u32x2*)(gp + PC_GB), gc = *(const GAS u32x2*)(gp + PC_GC);
                    f32x4 t; t[0] = bflo(ga.x) * a[0] + bflo(gb.x) * b[0] + bflo(gc.x) * rs * c[0]; t[1] = bfhi(ga.x) * a[1] + bfhi(gb.x) * b[1] + bfhi(gc.x) * rs * c[1];
                    t[2] = bflo(ga.y) * a[2] + bflo(gb.y) * b[2] + bflo(gc.y) * rs * c[2]; t[3] = bfhi(ga.y) * a[3] + bfhi(gb.y) * b[3] + bfhi(gc.y) * rs * c[3];
                    u32x2 w; w.x = cvt_pk_bf16(t[0], t[1]); w.y = cvt_pk_bf16(t[2], t[3]); *(GAS u32x2*)(MG + ((unsigned)row * DM + col)) = w; } }
            asm volatile("" ::: "memory"); }
    }
    __device__ __forceinline__ void operator()(const f32x4 (&acc)[2][2][4][2], const Unit& u, int wr, int wc, int fr, int fq) const {
        const int row0 = u.pm * BM + wr * 64 + fr, col0 = u.pn * BM + wc * 32 + 4 * fq;
        bf16* Tb = (bf16*)T;
#pragma unroll
        for (int ai = 0; ai < 2; ++ai) {
#pragma unroll
          for (int mh = 0; mh < 4; mh += MERGE_MB) {
            u32x2 gq[4][2][2], tq[4][2][2]; float rsq[4];
#pragma unroll
            for (int m = mh; m < mh + MERGE_MB; ++m) { const int row = row0 + ai * HALF + m * 16; const size_t off = (size_t)row * DM + col0; const bf16* gp = G + (size_t)row * N_INP + col0;
                rsq[m] = MODE == 2 ? csq[row] : 0.f;
#pragma unroll
                for (int bj = 0; bj < 2; ++bj)
#pragma unroll
                    for (int n = 0; n < 2; ++n) { const int co = bj * HALF + n * 16; gq[m][bj][n] = *(const GAS u32x2*)(gp + co); if (MODE != 0) tq[m][bj][n] = *(const GAS u32x2*)(Tb + off + co); } }
#pragma unroll
            for (int m = mh; m < mh + MERGE_MB; ++m) { const int row = row0 + ai * HALF + m * 16; const size_t off = (size_t)row * DM + col0;
                const float rs = MODE == 2 ? rsqrtf(rsq[m] * (1.0f / 1024.0f) + EPS) : 1.f;
#pragma unroll
                for (int bj = 0; bj < 2; ++bj)
#pragma unroll
                    for (int n = 0; n < 2; ++n) { const int co = bj * HALF + n * 16; const u32x2 g = gq[m][bj][n]; f32x4 v = acc[ai][bj][m][n];
                        v[0] *= bflo(g.x); v[1] *= bfhi(g.x); v[2] *= bflo(g.y); v[3] *= bfhi(g.y);
                        if (MODE == 0) { u32x2 w; w.x = cvt_pk_bf16(v[0], v[1]); w.y = cvt_pk_bf16(v[2], v[3]); *(GAS u32x2*)(Tb + off + co) = w; }
                        if (MODE == 1) { const u32x2 tb = tq[m][bj][n]; u32x2 w; w.x = cvt_pk_bf16(bflo(tb.x) + v[0], bfhi(tb.x) + v[1]); w.y = cvt_pk_bf16(bflo(tb.y) + v[2], bfhi(tb.y) + v[3]); *(GAS u32x2*)(Tb + off + co) = w; }
                        if (MODE == 2) { const u32x2 tb = tq[m][bj][n]; f32x4 t = {bflo(tb.x), bfhi(tb.x), bflo(tb.y), bfhi(tb.y)}; t = t + v * rs; u32x2 w; w.x = cvt_pk_bf16(t[0], t[1]); w.y = cvt_pk_bf16(t[2], t[3]); *(GAS u32x2*)(MG + off + co) = w; } } } } }
    }
};

#ifndef HOOK_MB
#define HOOK_MB 2
#endif
struct EpiMergeCat {
    static constexpr bool PERM = false, AFTER_DRAIN = false, HOOK = true;
    const bf16* PRJ; bf16* MG; const float* csq; f32x4* SLAB; unsigned* cnt;
    static __device__ __forceinline__ float gcl(float g) { return fmaxf(g, 1e-20f); }
    __device__ __forceinline__ void hook(f32x4 (&acc)[2][2][4][2], const Unit& u, int t, int wr, int wc) const {
        int t2 = threadIdx.x; asm volatile("" : "+v"(t2)); const int lane = t2 & 63, fr = lane & 15, fq = lane >> 4;
        const int row0 = u.pm * BM + wr * 64 + fr, col0 = u.pn * BM + wc * 32 + 4 * fq;
        const bool second = t != 8; const unsigned cn = (unsigned)(second ? PC_GB : PC_GA) * 2u, cd = (unsigned)(second ? PC_GC : PC_GB) * 2u;
        const __amdgpu_buffer_rsrc_t pr = __builtin_amdgcn_make_buffer_rsrc((void*)PRJ, (short)0, (int)((size_t)MP * N_INP * 2), 0x00020000);
        const __amdgpu_buffer_rsrc_t cr = __builtin_amdgcn_make_buffer_rsrc((void*)csq, (short)0, (int)(MP * 4), 0x00020000);
#pragma unroll
        for (int ai = 0; ai < 2; ++ai)
#pragma unroll
          for (int m = 0; m < 4; m += HOOK_MB) {
            u32x2 gn[HOOK_MB][2][2], gd[HOOK_MB][2][2]; float rsq[HOOK_MB];
#pragma unroll
            for (int mm = 0; mm < HOOK_MB; ++mm) { const int row = row0 + ai * HALF + (m + mm) * 16; const unsigned vo = ((unsigned)row * (unsigned)N_INP + (unsigned)col0) * 2u;
                rsq[mm] = __builtin_bit_cast(float, __builtin_amdgcn_raw_buffer_load_b32(cr, (unsigned)row * 4u, 0, 0));
#pragma unroll
                for (int bj = 0; bj < 2; ++bj)
#pragma unroll
                    for (int n = 0; n < 2; ++n) { const unsigned co = (unsigned)(bj * HALF + n * 16) * 2u;
                        gn[mm][bj][n] = __builtin_bit_cast(u32x2, __builtin_amdgcn_raw_buffer_load_b64(pr, vo + co, cn, 0)); gd[mm][bj][n] = __builtin_bit_cast(u32x2, __builtin_amdgcn_raw_buffer_load_b64(pr, vo + co, cd, 0)); } }
#pragma unroll
            for (int mm = 0; mm < HOOK_MB; ++mm) { const float rs = second ? __builtin_amdgcn_rsqf(rsq[mm] * (1.0f / 1024.0f) + EPS) : 1.f;
#pragma unroll
                for (int bj = 0; bj < 2; ++bj)
#pragma unroll
                    for (int n = 0; n < 2; ++n) { const u32x2 a = gn[mm][bj][n], d = gd[mm][bj][n]; f32x4 v = acc[ai][bj][m + mm][n];
                        const float n0 = bflo(a.x), n1 = bfhi(a.x), n2 = bflo(a.y), n3 = bfhi(a.y);
                        v[0] *= (second ? gcl(n0) : n0) * __builtin_amdgcn_rcpf(gcl(bflo(d.x)) * rs); v[1] *= (second ? gcl(n1) : n1) * __builtin_amdgcn_rcpf(gcl(bfhi(d.x)) * rs);
                        v[2] *= (second ? gcl(n2) : n2) * __builtin_amdgcn_rcpf(gcl(bflo(d.y)) * rs); v[3] *= (second ? gcl(n3) : n3) * __builtin_amdgcn_rcpf(gcl(bfhi(d.y)) * rs);
                        acc[ai][bj][m + mm][n] = v; } }
            asm volatile("" ::: "memory"); }
    }
    __device__ __forceinline__ void operator()(const f32x4 (&acc)[2][2][4][2], const Unit& u, int wr, int wc, int fr, int fq) const {
        const int row0 = u.pm * BM + wr * 64 + fr, col0 = u.pn * BM + wc * 32 + 4 * fq;
#pragma unroll
        for (int ai = 0; ai < 2; ++ai)
#pragma unroll
          for (int mh = 0; mh < 4; mh += 2) {
            u32x2 gq[2][2][2]; float rsq[2];
#pragma unroll
            for (int mm = 0; mm < 2; ++mm) { const int row = row0 + ai * HALF + (mh + mm) * 16; const bf16* gp = PRJ + (size_t)row * N_INP + col0 + PC_GC; rsq[mm] = csq[row];
#pragma unroll
                for (int bj = 0; bj < 2; ++bj)
#pragma unroll
                    for (int n = 0; n < 2; ++n) gq[mm][bj][n] = *(const GAS u32x2*)(gp + bj * HALF + n * 16); }
#pragma unroll
            for (int mm = 0; mm < 2; ++mm) { const int row = row0 + ai * HALF + (mh + mm) * 16; const size_t off = (size_t)row * DM + col0; const float rs = rsqrtf(rsq[mm] * (1.0f / 1024.0f) + EPS);
#pragma unroll
                for (int bj = 0; bj < 2; ++bj)
#pragma unroll
                    for (int n = 0; n < 2; ++n) { const u32x2 g = gq[mm][bj][n]; const f32x4 v = acc[ai][bj][mh + mm][n]; u32x2 w;
                        w.x = cvt_pk_bf16(v[0] * (gcl(bflo(g.x)) * rs), v[1] * (gcl(bfhi(g.x)) * rs)); w.y = cvt_pk_bf16(v[2] * (gcl(bflo(g.y)) * rs), v[3] * (gcl(bfhi(g.y)) * rs));
                        *(GAS u32x2*)(MG + off + bj * HALF + n * 16) = w; } } }
    }
    __device__ __forceinline__ void partial(f32x4 (&acc)[2][2][4][2], const Unit& u, int wr, int wc, int fr, int fq, int wid, int lane) const {
        split_store(acc, SLAB, u.sid, wid, lane); split_post(cnt + u.cidx * 8 + wid, lane);
    }
    __device__ __forceinline__ void final(const Unit& u, int wr, int wc, int fr, int fq, int wid, int lane, int mmask) const {
        split_wait(cnt + u.cidx * 8 + wid, 4u, lane);
        asm volatile("" : "+v"(fr), "+v"(fq), "+v"(lane));
        const __amdgpu_buffer_rsrc_t rs_ = slab_rsrc(SLAB);
#pragma unroll
        for (int m = 0; m < 4; ++m) { if (!((mmask >> m) & 1)) continue; const int r = wr * 64 + m * 16 + fr, row = MPROMPT + r; const float rs = rsqrtf(csq[row] * (1.0f / 1024.0f) + EPS);
            f32x4 s[2][2][4]; u32x2 ga[2][2], gb[2][2], gc[2][2];
#pragma unroll
            for (int bj = 0; bj < 2; ++bj)
#pragma unroll
                for (int n = 0; n < 2; ++n) { const unsigned vo = (unsigned)((wid * 16 + (m * 2 + bj) * 2 + n) * 64 + lane) * 16u;
                    const int col = split_col<PERM>(u, wc, fq, bj, n); const bf16* gp = PRJ + ((unsigned)row * N_INP + col);
#pragma unroll
                    for (int j = 0; j < 4; ++j) s[bj][n][j] = slab_ld(rs_, vo, (unsigned)(u.pn * 4 + j) * (unsigned)(SLAB_F4 * 16));
                    ga[bj][n] = *(const GAS u32x2*)(gp + PC_GA); gb[bj][n] = *(const GAS u32x2*)(gp + PC_GB); gc[bj][n] = *(const GAS u32x2*)(gp + PC_GC); }
#pragma unroll
            for (int bj = 0; bj < 2; ++bj)
#pragma unroll
                for (int n = 0; n < 2; ++n) { const int col = split_col<PERM>(u, wc, fq, bj, n);
                    const f32x4 a = s[bj][n][0], b = s[bj][n][1], c = s[bj][n][2] + s[bj][n][3]; const u32x2 xa = ga[bj][n], xb = gb[bj][n], xc = gc[bj][n];
                    f32x4 t; t[0] = bflo(xa.x) * a[0] + gcl(bflo(xb.x)) * b[0] + gcl(bflo(xc.x)) * rs * c[0]; t[1] = bfhi(xa.x) * a[1] + gcl(bfhi(xb.x)) * b[1] + gcl(bfhi(xc.x)) * rs * c[1];
                    t[2] = bflo(xa.y) * a[2] + gcl(bflo(xb.y)) * b[2] + gcl(bflo(xc.y)) * rs * c[2]; t[3] = bfhi(xa.y) * a[3] + gcl(bfhi(xb.y)) * b[3] + gcl(bfhi(xc.y)) * rs * c[3];
                    u32x2 w; w.x = cvt_pk_bf16(t[0], t[1]); w.y = cvt_pk_bf16(t[2], t[3]); *(GAS u32x2*)(MG + ((unsigned)row * DM + col)) = w; }
            asm volatile("" ::: "memory"); }
    }
};
template <int SEG> struct EpiChain {
    static constexpr bool PERM = false, AFTER_DRAIN = false, HOOK = false;
    const bf16* PRJ; bf16* MG; const float* csq;
    __device__ __forceinline__ void partial(f32x4 (&)[2][2][4][2], const Unit&, int, int, int, int, int, int) const {}
    __device__ __forceinline__ void operator()(f32x4 (&acc)[2][2][4][2], const Unit& u, int wr, int wc, int fr, int fq) const {
        const int row0 = u.pm * BM + wr * 64 + fr, col0 = u.pn * BM + wc * 32 + 4 * fq;
#pragma unroll
        for (int ai = 0; ai < 2; ++ai)
#pragma unroll
            for (int m = 0; m < 4; ++m) { const int row = row0 + ai * HALF + m * 16; const bf16* gp = PRJ + ((unsigned)row * N_INP + col0);
                float rs = 1.f; if (SEG >= 1) rs = rsqrtf(csq[row] * (1.0f / 1024.0f) + EPS);
#pragma unroll
                for (int bj = 0; bj < 2; ++bj)
#pragma unroll
                    for (int n = 0; n < 2; ++n) { const int co = bj * HALF + n * 16; f32x4 v = acc[ai][bj][m][n];
                        if (SEG == 0) { const u32x2 ga = *(const GAS u32x2*)(gp + PC_GA + co), gb = *(const GAS u32x2*)(gp + PC_GB + co);
                            v[0] *= bflo(ga.x) * __builtin_amdgcn_rcpf(fmaxf(bflo(gb.x), 1e-20f)); v[1] *= bfhi(ga.x) * __builtin_amdgcn_rcpf(fmaxf(bfhi(gb.x), 1e-20f));
                            v[2] *= bflo(ga.y) * __builtin_amdgcn_rcpf(fmaxf(bflo(gb.y), 1e-20f)); v[3] *= bfhi(ga.y) * __builtin_amdgcn_rcpf(fmaxf(bfhi(gb.y), 1e-20f)); acc[ai][bj][m][n] = v; }
                        if (SEG == 1) { const u32x2 gb = *(const GAS u32x2*)(gp + PC_GB + co), gc = *(const GAS u32x2*)(gp + PC_GC + co);
                            v[0] *= fmaxf(bflo(gb.x), 1e-20f) * __builtin_amdgcn_rcpf(fmaxf(bflo(gc.x) * rs, 1e-20f)); v[1] *= fmaxf(bfhi(gb.x), 1e-20f) * __builtin_amdgcn_rcpf(fmaxf(bfhi(gc.x) * rs, 1e-20f));
                            v[2] *= fmaxf(bflo(gb.y), 1e-20f) * __builtin_amdgcn_rcpf(fmaxf(bflo(gc.y) * rs, 1e-20f)); v[3] *= fmaxf(bfhi(gb.y), 1e-20f) * __builtin_amdgcn_rcpf(fmaxf(bfhi(gc.y) * rs, 1e-20f)); acc[ai][bj][m][n] = v; }
                        if (SEG == 2) { const u32x2 gc = *(const GAS u32x2*)(gp + PC_GC + co);
                            v[0] *= fmaxf(bflo(gc.x) * rs, 1e-20f); v[1] *= fmaxf(bfhi(gc.x) * rs, 1e-20f); v[2] *= fmaxf(bflo(gc.y) * rs, 1e-20f); v[3] *= fmaxf(bfhi(gc.y) * rs, 1e-20f);
                            u32x2 w; w.x = cvt_pk_bf16(v[0], v[1]); w.y = cvt_pk_bf16(v[2], v[3]); *(GAS u32x2*)(MG + ((unsigned)row * DM + col0 + co)) = w; } }
                asm volatile("" ::: "memory"); }
    }
};
struct EpiResid {
    static constexpr bool PERM = false, AFTER_DRAIN = false, HOOK = false;
    const bf16* XI; const bf16* XIS; bf16* XO; const float* gate; SplitCtl sp;
    __device__ __forceinline__ void partial(f32x4 (&acc)[2][2][4][2], const Unit& u, int wr, int wc, int fr, int fq, int wid, int lane) const {
        split_store(acc, sp.SLAB, u.sid, wid, lane);
        if (split_arrive(sp.cnt + u.cidx * 8 + wid, sp.nsl, lane)) { split_zero_pad(acc); split_sum(acc, sp.SLAB, u.pn * (int)sp.nsl, (int)sp.nsl, wid, lane); (*this)(acc, u, wr, wc, fr, fq); }
    }
    __device__ __forceinline__ void operator()(const f32x4 (&acc)[2][2][4][2], const Unit& u, int wr, int wc, int fr, int fq, int mmask = 15) const {
        const int row0 = u.pm * BM + wr * 64 + fr, col0 = u.pn * BM + wc * 32 + 4 * fq;
        const __amdgpu_buffer_rsrc_t xr = __builtin_amdgcn_make_buffer_rsrc((void*)XO, (short)0, (int)((size_t)MP * DM * 2), 0x00020000);
        const bool samp = u.pm == MPROMPT / 256;
        const bf16* xs16 = samp ? XIS - (size_t)MPROMPT * DM : XI;
#pragma unroll
        for (int ai = 0; ai < 2; ++ai) { if (ai == 1 && samp) break;
            u32x2 xw[4][2][2]; f32x4 gg[4][2][2];
#pragma unroll
            for (int m = 0; m < 4; ++m) { if (!((mmask >> m) & 1)) continue; const int row = row0 + ai * HALF + m * 16; const size_t off = (size_t)row * DM + col0; const float* gp = gate + (size_t)mod_row(row) * MOD_PITCH + col0;
#pragma unroll
                for (int bj = 0; bj < 2; ++bj)
#pragma unroll
                    for (int n = 0; n < 2; ++n) { const int co = bj * HALF + n * 16; xw[m][bj][n] = *(const GAS u32x2*)(xs16 + off + co); gg[m][bj][n] = *(const GAS f32x4*)(gp + co); } }
#pragma unroll
            for (int m = 0; m < 4; ++m) { if (!((mmask >> m) & 1)) continue; const int row = row0 + ai * HALF + m * 16; const size_t off = (size_t)row * DM + col0;
#pragma unroll
                for (int bj = 0; bj < 2; ++bj)
#pragma unroll
                    for (int n = 0; n < 2; ++n) { const int co = bj * HALF + n * 16; const u32x2 w = xw[m][bj][n]; const f32x4 xi = {bflo(w.x), bfhi(w.x), bflo(w.y), bfhi(w.y)};
                        const f32x4 xo = xi + gg[m][bj][n] * acc[ai][bj][m][n]; u32x2 wo; wo.x = cvt_pk_bf16(xo[0], xo[1]); wo.y = cvt_pk_bf16(xo[2], xo[3]);
                        __builtin_amdgcn_raw_buffer_store_b64(wo, xr, (unsigned)(off + co) * 2u, 0,   16); } } }
    }
};
template <int MODE> struct EpiResidPrep {
    static constexpr bool PERM = false, AFTER_DRAIN = true, HOOK = false;
    EpiResid R; bf16* H; float* yp; float* ys; const float* g; const float* mod2; int sh_idx, sc_idx; const float* wdt; float* DT; unsigned* pc;
    __device__ __forceinline__ void partial(f32x4 (&acc)[2][2][4][2], const Unit& u, int wr, int wc, int fr, int fq, int wid, int lane) const {
        split_store(acc, R.sp.SLAB, u.sid, wid, lane); split_post(R.sp.cnt + u.cidx * 8 + wid, lane);
    }
    __device__ __forceinline__ void operator()(const f32x4 (&acc)[2][2][4][2], const Unit& u, int wr, int wc, int fr, int fq) const { R(acc, u, wr, wc, fr, fq); }
    __device__ __forceinline__ void fused(f32x4 (&acc)[2][2][4][2], const Unit& u, int wr, int wc, int fr, int fq, LAS unsigned char* lds, int wid, int lane) const {
        R(acc, u, wr, wc, fr, fq);
        const int fin = opaque_bx() - R.sp.fin0; const bool isfin = fin >= 0 && fin < (DM / 256) * R.sp.parts;
        if (isfin) { const Unit uf = final_unit(fin / R.sp.parts, R.sp.cbase); const int mmask = part_mask(fin % R.sp.parts, R.sp.parts);
            split_wait(R.sp.cnt + uf.cidx * 8 + wid, R.sp.nsl, lane);
            split_sum(acc, R.sp.SLAB, uf.pn * (int)R.sp.nsl, (int)R.sp.nsl, wid, lane, mmask); R(acc, uf, wr, wc, fr, fq, mmask); }
        asm volatile("s_waitcnt vmcnt(0)" ::: "memory"); __syncthreads();
        if (wid == 0 && lane == 0) {
            if (isfin) __hip_atomic_fetch_add(pc + 32, 8u / (unsigned)R.sp.parts, __ATOMIC_RELAXED, __HIP_MEMORY_SCOPE_AGENT);
            __hip_atomic_fetch_add(pc + u.pm, 1u, __ATOMIC_RELAXED, __HIP_MEMORY_SCOPE_AGENT);
            unsigned sp_ = 0; while (__hip_atomic_load(pc + u.pm, __ATOMIC_RELAXED, __HIP_MEMORY_SCOPE_AGENT) < 8u && ++sp_ < (1u << 22)) __builtin_amdgcn_s_sleep(2);
            if (u.pn == 0) { sp_ = 0; while (__hip_atomic_load(pc + 32, __ATOMIC_RELAXED, __HIP_MEMORY_SCOPE_AGENT) < 64u && ++sp_ < (1u << 22)) __builtin_amdgcn_s_sleep(2); }
            __builtin_amdgcn_fence(__ATOMIC_ACQUIRE, "agent"); asm volatile("s_waitcnt vmcnt(0)" ::: "memory");
        }
        __syncthreads();
        LAS float* wT = (LAS float*)lds;
        if (MODE == 1) { f32x4 tw[16];
#pragma unroll
            for (int i = 0; i < 16; ++i) tw[i] = ((const f32x4*)wdt)[wid * 64 + lane + i * NTHR];
#pragma unroll
            for (int i = 0; i < 16; ++i) ((LAS f32x4*)wT)[wid * 64 + lane + i * NTHR] = tw[i];
            __syncthreads(); }
        const bf16* X = R.XO;
        {   const int row = u.pm * BM + u.pn * 32 + wid * 4;
            prep_rows4<MODE>(X + (size_t)row * DM, g, mod2 + (size_t)mod_row(row) * MOD_PITCH, sh_idx, sc_idx, H + (size_t)row * DM, yp + (size_t)row * DM, DT + (size_t)row * 16, wT, lane); }
        if (u.pn == 0 && wid < 4) { const int s = u.pm * 4 + wid, row = MPROMPT + s;
            prep_row<MODE>(X + (size_t)row * DM, g, mod2 + (size_t)mod_row(row) * MOD_PITCH, sh_idx, sc_idx, H + (size_t)row * DM, ys + (size_t)s * DM, DT + (size_t)row * 16, wT, lane); }
        if (MODE == 1) __syncthreads();
    }
};
struct EpiMod {
    static constexpr bool PERM = false, AFTER_DRAIN = false, HOOK = false;
    float* MOD; const float* bmod;
    __device__ __forceinline__ void partial(f32x4 (&)[2][2][4][2], const Unit&, int, int, int, int, int, int) const {}
    __device__ __forceinline__ void operator()(const f32x4 (&acc)[2][2][4][2], const Unit& u, int wr, int wc, int fr, int fq) const {
        const int row0 = wr * 64 + fr, col0 = u.pn * BM + wc * 32 + 4 * fq;
        f32x4 bv[2][2];
#pragma unroll
        for (int bj = 0; bj < 2; ++bj)
#pragma unroll
            for (int n = 0; n < 2; ++n) bv[bj][n] = *(const GAS f32x4*)(bmod + col0 + bj * HALF + n * 16);
#pragma unroll
        for (int ai = 0; ai < 2; ++ai)
#pragma unroll
            for (int m = 0; m < 4; ++m) { float* rowp = MOD + (size_t)(row0 + ai * HALF + m * 16) * MOD_PITCH + col0;
#pragma unroll
                for (int bj = 0; bj < 2; ++bj)
#pragma unroll
                    for (int n = 0; n < 2; ++n) *(GAS f32x4*)(rowp + bj * HALF + n * 16) = acc[ai][bj][m][n] + bv[bj][n]; }
    }
};
}
struct Frame {
    LAS unsigned char* lds;
    int tid, lane, wave, gw;
    float* out; unsigned char* ws;
};
#define WSP(T, off) ((T*)(F.ws + (off)))
__device__ __forceinline__ Frame launder(const Frame& F0) {
    Frame F = F0; int t = F0.tid; asm volatile("" : "+v"(t)); F.tid = t; F.lane = t & 63; F.wave = __builtin_amdgcn_readfirstlane(t >> 6);
    unsigned long long w = (unsigned long long)F0.ws, o = (unsigned long long)F0.out; asm volatile("" : "+s"(w), "+s"(o)); F.ws = (unsigned char*)w; F.out = (float*)o;
    F.gw = blockIdx.x * NWAVES + F.wave; return F;
}

__device__ __forceinline__ void transpose_load(float (&tv)[32], const float* W, int ld, int ncols, int c0, int item, int lane) {
    const int nblk = ncols / 32, kb = item / nblk, nb = item % nblk, k0 = 64 * kb, n0 = 32 * nb;
    const unsigned lo = (unsigned)((lane >> 5) * ld + (lane & 31));
#pragma unroll
    for (int i = 0; i < 32; ++i) { const float* rb = W + (size_t)(k0 + 2 * i) * ld + c0 + n0; tv[i] = __builtin_nontemporal_load(rb + lo); }
}
__device__ __forceinline__ void transpose_store(const float (&tv)[32], int pitch, int ncols, bf16* WT, int row_off, LAS float* scr, int item, int lane) {
    const int nblk = ncols / 32, kb = item / nblk, nb = item % nblk, k0 = 64 * kb, n0 = 32 * nb;
    const int rbase = row_off >= 0 ? row_off + n0 : (n0 < D_FF ? 256 * (n0 / 128) + n0 % 128 : 256 * ((n0 - D_FF) / 128) + 128 + (n0 - D_FF) % 128);
#pragma unroll
    for (int i = 0; i < 32; ++i) { const int kk = 2 * i + (lane >> 5); scr[kk * 33 + (lane & 31)] = tv[i]; }
    LDS_WAIT(); asm volatile("" ::: "memory");
    const int c = lane & 7;
#pragma unroll
    for (int j = 0; j < 4; ++j) { const int n = (lane >> 3) + 8 * j; const LAS float* s = scr + (8 * c) * 33 + n;
        v4u o; o.x = pk2(s[0 * 33], s[1 * 33]); o.y = pk2(s[2 * 33], s[3 * 33]); o.z = pk2(s[4 * 33], s[5 * 33]); o.w = pk2(s[6 * 33], s[7 * 33]);
        *(GAS v4u*)(WT + (size_t)(rbase + n) * pitch + k0 + 8 * c) = o; }
    LDS_WAIT(); asm volatile("" ::: "memory");
}
constexpr int MODC = 96, MODK = 128, MODP = 136;
__device__ __forceinline__ void phase_mod(const Frame& F0, KArgs A) {
    Frame F = launder(F0);
    const int n0 = blockIdx.x * MODC, l = n0 / N_MOD, cl = n0 - l * N_MOD;
    const float* W = A->in[I_WMOD] + (size_t)l * DM * N_MOD + cl;
    LAS bf16* Bt = (LAS bf16*)F.lds;
    LAS bf16* As = (LAS bf16*)(F.lds + 2 * MODC * MODP * 2);
    for (int i = F.tid; i < 2 * 12 * MODP; i += NTHR) { const int b = i / (12 * MODP), r = i % (12 * MODP); As[(b * 144 + 132) * MODP + r] = (bf16)0; }
    f32x4 wa[6], wb[6], creg[9];
    auto load_w = [&](f32x4 (&wr)[6], int kc) {
#pragma unroll
        for (int j = 0; j < 6; ++j) { const int idx = F.tid + NTHR * j, n = idx % MODC, k = 4 * (idx / MODC); const float* p = W + (size_t)(kc * MODK + k) * N_MOD + n;
            wr[j].x = __builtin_nontemporal_load(p); wr[j].y = __builtin_nontemporal_load(p + N_MOD); wr[j].z = __builtin_nontemporal_load(p + 2 * N_MOD); wr[j].w = __builtin_nontemporal_load(p + 3 * (size_t)N_MOD); }
    };
    auto load_c = [&](int kc) {
#pragma unroll
        for (int j = 0; j < 9; ++j) { const int idx = F.tid + NTHR * j, r = idx >> 5, k4 = (idx & 31) * 4;
            const float* src = r < NB ? A->in[I_CP] + (size_t)r * DM : A->in[I_CS] + (size_t)(r - NB) * DM;
            creg[j] = r < NB + NS ? *(const GAS f32x4*)(src + kc * MODK + k4) : (f32x4){0.f, 0.f, 0.f, 0.f}; }
    };
    auto store_w = [&](const f32x4 (&wr)[6], int buf) {
#pragma unroll
        for (int j = 0; j < 6; ++j) { const int idx = F.tid + NTHR * j, n = idx % MODC, k = 4 * (idx / MODC);
            v2u w; w.x = pk2(wr[j].x, wr[j].y); w.y = pk2(wr[j].z, wr[j].w); *(LAS v2u*)(Bt + (buf * MODC + n) * MODP + k) = w; }
    };
    auto store_c = [&](int buf) {
#pragma unroll
        for (int j = 0; j < 9; ++j) { const int idx = F.tid + NTHR * j, r = idx >> 5, k4 = (idx & 31) * 4;
            if (r < NB + NS) { v2u w; w.x = pk2(siluf_(creg[j].x), siluf_(creg[j].y)); w.y = pk2(siluf_(creg[j].z), siluf_(creg[j].w)); *(LAS v2u*)(As + (buf * 144 + r) * MODP + k4) = w; } }
    };
    f32x4 acc[9];
#pragma unroll
    for (int m = 0; m < 9; ++m) acc[m] = (f32x4){0.f, 0.f, 0.f, 0.f};
    auto compute = [&](int buf) {
        if (F.wave < 6) {
#pragma unroll
            for (int ks = 0; ks < MODK / 32; ++ks) { const bf16x8 bfr = *(const LAS bf16x8*)(Bt + (buf * MODC + 16 * F.wave + (F.lane & 15)) * MODP + 32 * ks + 8 * (F.lane >> 4));
#pragma unroll
                for (int m = 0; m < 9; ++m) { const bf16x8 af = *(const LAS bf16x8*)(As + (buf * 144 + 16 * m + (F.lane & 15)) * MODP + 32 * ks + 8 * (F.lane >> 4));
                    acc[m] = __builtin_amdgcn_mfma_f32_16x16x32_bf16(af, bfr, acc[m], 0, 0, 0); } }
        }
    };
    const int kst = blockIdx.x & 15;
    load_w(wa, kst); load_c(kst); load_w(wb, (1 + kst) & 15);
    store_w(wa, 0); store_c(0); __syncthreads();
#pragma unroll 1
    for (int kc = 0; kc < DM / MODK; kc += 2) {
        load_c((kc + 1 + kst) & 15); if (kc + 2 < DM / MODK) load_w(wa, (kc + 2 + kst) & 15);
        compute(0);
        store_w(wb, 1); store_c(1); __syncthreads();
        if (kc + 2 < DM / MODK) { load_c((kc + 2 + kst) & 15); if (kc + 3 < DM / MODK) load_w(wb, (kc + 3 + kst) & 15); }
        compute(1);
        if (kc + 2 < DM / MODK) { store_w(wa, 0); store_c(0); }
        __syncthreads();
    }
    if (F.wave < 6) { float* MOD = WSP(float, WS_MOD); const int col = n0 + 16 * F.wave + (F.lane & 15); const float bias = A->in[I_BMOD][col];
#pragma unroll
        for (int m = 0; m < 9; ++m)
#pragma unroll
            for (int r = 0; r < 4; ++r) { const int row = 16 * m + 4 * (F.lane >> 4) + r; if (row < NB + NS) MOD[(size_t)row * MOD_PITCH + col] = acc[m][r] + bias; } }
    __syncthreads();
}
__device__ __forceinline__ void tjob(Frame& F, LAS float* scr, const float* W, int ld, int K, int ncols, int c0, bf16* WT, int row_off, int pitch = 0) {
    if (pitch == 0) pitch = K;
    const int nit = (K / 64) * (ncols / 32), ST = GRID * NWAVES;
#pragma unroll 1
    for (int it = F.gw; it < nit; it += 2 * ST) { float ta[32], tb[32]; const bool two = it + ST < nit;
        transpose_load(ta, W, ld, ncols, c0, it, F.lane); if (two) transpose_load(tb, W, ld, ncols, c0, it + ST, F.lane);
        transpose_store(ta, pitch, ncols, WT, row_off, scr, it, F.lane); if (two) transpose_store(tb, pitch, ncols, WT, row_off, scr, it + ST, F.lane); }
}
__device__ __forceinline__ void prep_layer0(const Frame& F0, KArgs A) {
    Frame F = launder(F0);
    LAS float* wT = (LAS float*)F.lds;
    {   const float* win = A->in[I_WIN];
        f32x4 tw[4][4];
#pragma unroll
        for (int i = 0; i < 4; ++i) { const GAS f32x4* p = (const GAS f32x4*)(win + (size_t)(F.tid + i * NTHR) * N_IN + 4096);
#pragma unroll
            for (int q = 0; q < 4; ++q) tw[i][q] = p[q]; }
#pragma unroll
        for (int i = 0; i < 4; ++i) { const int k = F.tid + i * NTHR;
#pragma unroll
            for (int q = 0; q < 4; ++q) { wT[(4 * q + 0) * DM + k] = tw[i][q].x; wT[(4 * q + 1) * DM + k] = tw[i][q].y; wT[(4 * q + 2) * DM + k] = tw[i][q].z; wT[(4 * q + 3) * DM + k] = tw[i][q].w; } }
        __syncthreads(); }
    {   Frame F2 = launder(F0); const int gwv = blockIdx.x * NWAVES + F2.wave;
        if (gwv < NS) { const int row = MPROMPT + gwv; const float* modl = (const float*)(F2.ws + WS_MOD);
            prep_row<1, true>(A->in[I_XS] + (size_t)gwv * DM, A->in[I_GMIX], modl + (size_t)mod_row(row) * MOD_PITCH, 0, 1, (bf16*)(F2.ws + WS_H) + (size_t)row * DM, nullptr, (float*)(F2.ws + WS_SMALL + SM_DT) + (size_t)row * 16, wT, F2.lane); } }
    {   Frame F2 = launder(F0); const int gwv = blockIdx.x * NWAVES + F2.wave; const float* modl = (const float*)(F2.ws + WS_MOD);
#pragma unroll 1
        for (int hq = 0; hq < 2; ++hq) { const int row = 4 * gwv + 2 * hq;
            prep_rows4<1, true, 2>(A->in[I_XP] + (size_t)row * DM, A->in[I_GMIX], modl + (size_t)mod_row(row) * MOD_PITCH, 0, 1, (bf16*)(F2.ws + WS_H) + (size_t)row * DM, nullptr, (float*)(F2.ws + WS_SMALL + SM_DT) + (size_t)row * 16, wT, F2.lane); } }
    __syncthreads();
}
__device__ __forceinline__ void phase_prologue(const Frame& F0, KArgs A) {
    Frame F = launder(F0);
    LAS float* scr = (LAS float*)(F.lds + F.wave * 16384);
#pragma unroll 1
    for (int l = 0; l < DEPTH; ++l) {
        unsigned char* wl = F.ws + WS_W + (size_t)l * WL_END;
        tjob(F, scr, A->in[I_WIN] + (size_t)l * DM * N_IN, N_IN, DM, 4096, 0, (bf16*)(wl + WL_IN), 0);
        tjob(F, scr, A->in[I_WIN] + (size_t)l * DM * N_IN, N_IN, DM, 6144, 4112, (bf16*)(wl + WL_IN), 4096);
        tjob(F, scr, A->in[I_WGLU] + (size_t)l * 512 * 512, 512, 512, 512, 0, (bf16*)(wl + WL_GLU), 0);
        tjob(F, scr, A->in[I_WPA] + (size_t)l * 512 * DM, DM, 512, DM, 0, (bf16*)(wl + WL_PA) + OC_A, 0, OCP);
        tjob(F, scr, A->in[I_WPB] + (size_t)l * 512 * DM, DM, 512, DM, 0, (bf16*)(wl + WL_PA) + OC_B, 0, OCP);
        tjob(F, scr, A->in[I_WPC] + (size_t)l * 1024 * DM, DM, 1024, DM, 0, (bf16*)(wl + WL_PA) + OC_C, 0, OCP);
        tjob(F, scr, A->in[I_WOUT] + (size_t)l * DM * DM, DM, DM, DM, 0, (bf16*)(wl + WL_OUT), 0);
        tjob(F, scr, A->in[I_WUP] + (size_t)l * DM * D_UP, D_UP, DM, D_UP, 0, (bf16*)(wl + WL_UP), -1);
        tjob(F, scr, A->in[I_WDOWN] + (size_t)l * D_FF * DM, DM, D_FF, DM, 0, (bf16*)(wl + WL_DOWN), 0);
    }
    {   bf16* X0 = WSP(bf16, WS_X0);
        for (int r = F.gw; r < MREAL; r += (GRID * NWAVES)) {
            const float* src = r < MPROMPT ? A->in[I_XP] + (size_t)r * DM : A->in[I_XS] + (size_t)(r - MPROMPT) * DM;
            GAS v2u* o = (GAS v2u*)(X0 + (size_t)r * DM) + F.lane;
#pragma unroll
            for (int j = 0; j < 8; ++j) { const f32x4 v = __builtin_nontemporal_load((const f32x4*)src + F.lane + 64 * j); v2u w; w.x = pk2(v.x, v.y); w.y = pk2(v.z, v.w); o[64 * j] = w; }
        }
    }
    {   float* z = WSP(float, WS_SMALL + SM_VSQ);
        const int gt = blockIdx.x * NTHR + F.tid;
        for (int i = gt; i < 4 * MP; i += GRID * NTHR) z[i] = 0.f;
    }
    {   const int gt = blockIdx.x * NTHR + F.tid, NT = GRID * NTHR;
        bf16* WSb = WSP(bf16, WS_SMALL + SM_WS);
        for (int i = gt; i < DEPTH * H_B * 128 * 128; i += NT) { const int jj = i & 127, ii = (i >> 7) & 127; WSb[i] = (bf16)(jj <= ii ? f2bf(A->in[I_WS][i]) : 0u); }
        float* AA = WSP(float, WS_SMALL + SM_S5A); float* BB = WSP(float, WS_SMALL + SM_S5BB); bf16* CT = WSP(bf16, WS_SMALL + SM_S5CT);
        for (int i = gt; i < DEPTH * G_A * P_A; i += NT) {
            const int l = i / (G_A * P_A), g = (i / P_A) % G_A;
            const float dt = expf(A->in[I_LOGDT][l * G_A + g]), lr = A->in[I_LAMRE][i], li = A->in[I_LAMIM][i];
            const float mag = expf(lr * dt); float sn, cs; sincosf(li * dt, &sn, &cs);
            const float ar = mag * cs, ai = mag * sn, den = lr * lr + li * li, nr = ar - 1.0f;
            const float kr = (nr * lr + ai * li) / den, ki = (ai * lr - nr * li) / den;
            float qr = ar, qi = ai;
#pragma unroll
            for (int s = 0; s < 6; ++s) { const float t = qr * qr - qi * qi; qi = 2.0f * qr * qi; qr = t; }
            AA[i * 4 + 0] = ar; AA[i * 4 + 1] = ai; AA[i * 4 + 2] = qr; AA[i * 4 + 3] = qi;
#pragma unroll
            for (int h = 0; h < S5G; ++h) { const float bre = A->in[I_BRE][(size_t)i * S5G + h], bim = A->in[I_BIM][(size_t)i * S5G + h];
                BB[(size_t)i * 32 + h] = kr * bre - ki * bim; BB[(size_t)i * 32 + 16 + h] = kr * bim + ki * bre; }
        }
        {   float* WDT = WSP(float, WS_SMALL + SM_WDT);
            for (int i = gt; i < DEPTH * 16 * DM; i += NT) { const int k = i % DM, hh = (i / DM) & 15, l = i / (16 * DM); WDT[i] = A->in[I_WIN][((size_t)l * DM + k) * N_IN + 4096 + hh]; } }
        for (int i = gt; i < DEPTH * G_A * S5G * 128; i += NT) { const int k = i & 127, lgh = i >> 7;
            const float v = k < 64 ? A->in[I_CRE][(size_t)lgh * 64 + k] : -A->in[I_CIM][(size_t)lgh * 64 + (k - 64)]; CT[i] = (bf16)f2bf(v); }
    }
}

template <bool WITH_DT>
__device__ __forceinline__ void phase_prep(const Frame& F0, const float* X, const float* XS, const float* g, const float* modl, int sh_idx, int sc_idx, const float* win_l, float* DT) {
    Frame F = launder(F0);
    bf16* H = WSP(bf16, WS_H);
    LAS float* wT = (LAS float*)F.lds;
    if (WITH_DT) {
        {   const GAS f32x4* wd = (const GAS f32x4*)WSP(const float, WS_SMALL + SM_WDT);
            f32x4 tw[16];
#pragma unroll
            for (int i = 0; i < 16; ++i) tw[i] = wd[F.tid + i * NTHR];
#pragma unroll
            for (int i = 0; i < 16; ++i) ((LAS f32x4*)wT)[F.tid + i * NTHR] = tw[i]; }
        (void)win_l;
        __syncthreads();
    }
    if (WITH_DT) {
        const bf16* X0 = WSP(const bf16, WS_X0); float* DTo = DT; const int gwv = blockIdx.x * NWAVES + F.wave;
        {   const int row = 4 * gwv; prep_rows4<1>(X0 + (size_t)row * DM, g, modl + (size_t)mod_row(row) * MOD_PITCH, sh_idx, sc_idx, H + (size_t)row * DM, nullptr, DTo + (size_t)row * 16, wT, F.lane); }
        if (gwv < NS) { const int row = MPROMPT + gwv; prep_row<1>(X0 + (size_t)row * DM, g, modl + (size_t)mod_row(row) * MOD_PITCH, sh_idx, sc_idx, H + (size_t)row * DM, nullptr, DTo + (size_t)row * 16, wT, F.lane); }
    } else {
    f32x4 vn[8];
    {   const int r0 = blockIdx.x * NWAVES + F.wave; const int rr0 = r0 < MREAL ? r0 : 0; const GAS f32x4* xr = (const GAS f32x4*)(rr0 < MPROMPT ? X + (size_t)rr0 * DM : XS + (size_t)(rr0 - MPROMPT) * DM) + F.lane;
#pragma unroll
        for (int j = 0; j < 8; ++j) vn[j] = xr[64 * j]; }
    for (int r = blockIdx.x * NWAVES + F.wave; r < MREAL; r += GRID * NWAVES) {
        f32x4 v[8]; float s = 0.f;
#pragma unroll
        for (int j = 0; j < 8; ++j) { v[j] = vn[j]; s += (v[j].x * v[j].x + v[j].y * v[j].y) + (v[j].z * v[j].z + v[j].w * v[j].w); }
        {   const int rn = r + GRID * NWAVES; const int rr1 = rn < MREAL ? rn : r; const GAS f32x4* xr = (const GAS f32x4*)(rr1 < MPROMPT ? X + (size_t)rr1 * DM : XS + (size_t)(rr1 - MPROMPT) * DM) + F.lane;
#pragma unroll
            for (int j = 0; j < 8; ++j) vn[j] = xr[64 * j]; }
        const float rinv = rsqrtf(wave_sum(s) * (1.0f / DM) + EPS);
        const float* mr = modl + (size_t)mod_row(r) * MOD_PITCH;
        const GAS f32x4* gp = (const GAS f32x4*)g + F.lane; const GAS f32x4* shp = (const GAS f32x4*)(mr + sh_idx * DM) + F.lane; const GAS f32x4* scp = (const GAS f32x4*)(mr + sc_idx * DM) + F.lane;
        GAS v2u* o = (GAS v2u*)(H + (size_t)r * DM) + F.lane;
#pragma unroll
        for (int j = 0; j < 8; ++j) { const f32x4 gg = gp[64 * j], sh = shp[64 * j], sc = scp[64 * j];
            v[j] = v[j] * rinv * gg * (sc + 1.0f) + sh;
            v2u w; w.x = pk2(v[j].x, v[j].y); w.y = pk2(v[j].z, v[j].w); o[64 * j] = w; }
        if (WITH_DT) {
            float a16[16];
#pragma unroll
            for (int hh = 0; hh < 16; ++hh) { float a = 0.f;
#pragma unroll
                for (int j = 0; j < 8; ++j) { const f32x4 w = *(const LAS f32x4*)(wT + hh * DM + 4 * F.lane + 256 * j); a += (v[j].x * w.x + v[j].y * w.y) + (v[j].z * w.z + v[j].w * w.w); }
                a16[hh] = a; }
            const float mine = wave_sum16(a16, F.lane);
            if (F.lane < 16) DT[(size_t)r * 16 + F.lane] = mine;
        }
    }
    }
    if (WITH_DT) __syncthreads();
}

__device__ __forceinline__ void phase_final(const Frame& F0, KArgs A, const float* X) {
    Frame F = launder(F0);
    const float* g = A->in[I_GFINAL];
    for (int r = blockIdx.x * NWAVES + F.wave; r < MREAL; r += GRID * NWAVES) {
        const GAS f32x4* xr = (const GAS f32x4*)(X + (size_t)r * DM) + F.lane;
        f32x4 v[8]; float s = 0.f;
#pragma unroll
        for (int j = 0; j < 8; ++j) { v[j] = xr[64 * j]; s += (v[j].x * v[j].x + v[j].y * v[j].y) + (v[j].z * v[j].z + v[j].w * v[j].w); }
        const float rinv = rsqrtf(wave_sum(s) * (1.0f / DM) + EPS);
        GAS f32x4* o = (GAS f32x4*)(F.out + (r < MPROMPT ? O_YP + (size_t)r * DM : O_YS + (size_t)(r - MPROMPT) * DM)) + F.lane;
        const GAS f32x4* gp = (const GAS f32x4*)g + F.lane;
#pragma unroll
        for (int j = 0; j < 8; ++j) o[64 * j] = v[j] * rinv * gp[64 * j];
    }
}
typedef __bf16 bf16x2_t __attribute__((ext_vector_type(2)));
constexpr int HS_PITCH = 136;
template <bool FINAL>
__device__ __forceinline__ void s5_item(KArgs A, unsigned char* ws, float* out, int l, int item, LAS unsigned char* wl, int lane, unsigned* flags = nullptr) {
    const int c = item & 31, g = (item >> 5) & 31, b = item >> 10;
    const int lgp = (l * G_A + g) * P_A + lane;
    const f32x4 aq = *(const GAS f32x4*)((const float*)(ws + WS_SMALL + SM_S5A) + (size_t)lgp * 4);
    const float ar = aq.x, ai = aq.y;
    float br[16], bi[16];
    {   const GAS f32x4* bb = (const GAS f32x4*)((const float*)(ws + WS_SMALL + SM_S5BB) + (size_t)lgp * 32);
#pragma unroll
        for (int q = 0; q < 4; ++q) { const f32x4 v = bb[q]; br[4 * q] = v.x; br[4 * q + 1] = v.y; br[4 * q + 2] = v.z; br[4 * q + 3] = v.w;
                                      const f32x4 w = bb[4 + q]; bi[4 * q] = w.x; bi[4 * q + 1] = w.y; bi[4 * q + 2] = w.z; bi[4 * q + 3] = w.w; } }
    unsigned brp[8], bip[8];
#pragma unroll
    for (int k = 0; k < 8; ++k) { brp[k] = pk2(br[2 * k], br[2 * k + 1]); bip[k] = pk2(bi[2 * k], bi[2 * k + 1]); }
    const int row0 = b * SEQ + c * S5Q;
    const bf16* PROJ = (const bf16*)(ws + WS_BIG);
    const GAS v4u* up = (const GAS v4u*)(PROJ + (size_t)(row0 + lane) * N_INP + PC_UA + g * 16);
    const v4u u0 = up[0], u1 = up[1];
    LAS bf16* Us = (LAS bf16*)(wl + 8704);
    if (FINAL) { *(LAS v4u*)(Us + lane * 16) = u0; *(LAS v4u*)(Us + lane * 16 + 8) = u1; }
    float hr = 0.f, hi = 0.f;
    float* SLOC = (float*)(ws + WS_SMALL + SM_SLOC);
    if (FINAL && flags) {
        float lr = 0.f, li = 0.f;
#pragma unroll 2
        for (int t = 0; t < 64; ++t) {
            unsigned w[8];
            w[0] = __builtin_amdgcn_readlane(u0.x, t); w[1] = __builtin_amdgcn_readlane(u0.y, t); w[2] = __builtin_amdgcn_readlane(u0.z, t); w[3] = __builtin_amdgcn_readlane(u0.w, t);
            w[4] = __builtin_amdgcn_readlane(u1.x, t); w[5] = __builtin_amdgcn_readlane(u1.y, t); w[6] = __builtin_amdgcn_readlane(u1.z, t); w[7] = __builtin_amdgcn_readlane(u1.w, t);
            float sr0 = 0.f, si0 = 0.f, sr1 = 0.f, si1 = 0.f;
#pragma unroll
            for (int k = 0; k < 8; k += 2) {
                sr0 = __builtin_amdgcn_fdot2_f32_bf16(__builtin_bit_cast(bf16x2_t, brp[k]), __builtin_bit_cast(bf16x2_t, w[k]), sr0, false);
                si0 = __builtin_amdgcn_fdot2_f32_bf16(__builtin_bit_cast(bf16x2_t, bip[k]), __builtin_bit_cast(bf16x2_t, w[k]), si0, false);
                sr1 = __builtin_amdgcn_fdot2_f32_bf16(__builtin_bit_cast(bf16x2_t, brp[k + 1]), __builtin_bit_cast(bf16x2_t, w[k + 1]), sr1, false);
                si1 = __builtin_amdgcn_fdot2_f32_bf16(__builtin_bit_cast(bf16x2_t, bip[k + 1]), __builtin_bit_cast(bf16x2_t, w[k + 1]), si1, false); }
            const float nr = ar * lr - ai * li + (sr0 + sr1); li = ar * li + ai * lr + (si0 + si1); lr = nr;
        }
        float* sl = SLOC + (size_t)item * 128 + lane;
        __hip_atomic_store(sl, lr, __ATOMIC_RELAXED, __HIP_MEMORY_SCOPE_AGENT); __hip_atomic_store(sl + 64, li, __ATOMIC_RELAXED, __HIP_MEMORY_SCOPE_AGENT);
        asm volatile("s_waitcnt vmcnt(0)" ::: "memory");
        if (lane == 0) __hip_atomic_store(flags + item, 1u, __ATOMIC_RELAXED, __HIP_MEMORY_SCOPE_AGENT);
        {
            unsigned sp_ = 0;
            for (;;) { const unsigned f = lane < c ? __hip_atomic_load(flags + (item - c + lane), __ATOMIC_RELAXED, __HIP_MEMORY_SCOPE_AGENT) : 1u;
                if (__builtin_amdgcn_ballot_w64(f == 0u) == 0ull || ++sp_ > (1u << 20)) break; __builtin_amdgcn_s_sleep(1); }
            __builtin_amdgcn_fence(__ATOMIC_ACQUIRE, "agent"); }
        asm volatile("s_waitcnt vmcnt(0)" ::: "memory");
    }
    if (FINAL) {
        const float qr = aq.z, qi = aq.w;
        const float* sl = SLOC + (size_t)((b * G_A + g) * S5NC) * 128 + lane;
        float psr[31], psi[31];
#pragma unroll
        for (int k = 0; k < 31; ++k) { const int kk = k < c ? k : 0; psr[k] = sl[kk * 128]; psi[k] = sl[kk * 128 + 64]; }
#pragma unroll
        for (int k = 0; k < 31; ++k) if (k < c) { const float t = qr * hr - qi * hi + psr[k]; hi = qr * hi + qi * hr + psi[k]; hr = t; }
    }
    LAS bf16* Hs = (LAS bf16*)wl;
    bf16x8 cfr[4];
    if (FINAL) { const bf16* ct = (const bf16*)(ws + WS_SMALL + SM_S5CT) + (size_t)((l * G_A + g) * S5G + (lane & 15)) * 128 + 8 * (lane >> 4);
#pragma unroll
        for (int ks = 0; ks < 4; ++ks) cfr[ks] = *(const GAS bf16x8*)(ct + 32 * ks); }
#pragma unroll 1
    for (int half = 0; half < 2; ++half) {
#pragma unroll 2
        for (int tt = 0; tt < 32; ++tt) {
            const int t = half * 32 + tt;
            unsigned w[8];
            w[0] = __builtin_amdgcn_readlane(u0.x, t); w[1] = __builtin_amdgcn_readlane(u0.y, t); w[2] = __builtin_amdgcn_readlane(u0.z, t); w[3] = __builtin_amdgcn_readlane(u0.w, t);
            w[4] = __builtin_amdgcn_readlane(u1.x, t); w[5] = __builtin_amdgcn_readlane(u1.y, t); w[6] = __builtin_amdgcn_readlane(u1.z, t); w[7] = __builtin_amdgcn_readlane(u1.w, t);
            float sr0 = 0.f, si0 = 0.f, sr1 = 0.f, si1 = 0.f;
#pragma unroll
            for (int k = 0; k < 8; k += 2) {
                sr0 = __builtin_amdgcn_fdot2_f32_bf16(__builtin_bit_cast(bf16x2_t, brp[k]), __builtin_bit_cast(bf16x2_t, w[k]), sr0, false);
                si0 = __builtin_amdgcn_fdot2_f32_bf16(__builtin_bit_cast(bf16x2_t, bip[k]), __builtin_bit_cast(bf16x2_t, w[k]), si0, false);
                sr1 = __builtin_amdgcn_fdot2_f32_bf16(__builtin_bit_cast(bf16x2_t, brp[k + 1]), __builtin_bit_cast(bf16x2_t, w[k + 1]), sr1, false);
                si1 = __builtin_amdgcn_fdot2_f32_bf16(__builtin_bit_cast(bf16x2_t, bip[k + 1]), __builtin_bit_cast(bf16x2_t, w[k + 1]), si1, false); }
            const float sr = sr0 + sr1, si = si0 + si1;
            const float nr = ar * hr - ai * hi + sr; hi = ar * hi + ai * hr + si; hr = nr;
            if (FINAL) { Hs[tt * HS_PITCH + lane] = (bf16)f2bf(hr); Hs[tt * HS_PITCH + 64 + lane] = (bf16)f2bf(hi); }
        }
        if (FINAL) {
            bf16* YB = (bf16*)(ws + WS_YB);
            const float* dsk = A->in[I_S5D] + l * D_A + g * 16;
#pragma unroll
            for (int tile = 0; tile < 2; ++tile) {
                f32x4 acc = {0.f, 0.f, 0.f, 0.f};
#pragma unroll
                for (int ks = 0; ks < 4; ++ks) { const bf16x8 a = *(const LAS bf16x8*)(Hs + (tile * 16 + (lane & 15)) * HS_PITCH + 32 * ks + 8 * (lane >> 4));
                    acc = __builtin_amdgcn_mfma_f32_16x16x32_bf16(a, cfr[ks], acc, 0, 0, 0); }
                const int hh = lane & 15; const float dd = dsk[hh];
#pragma unroll
                for (int r = 0; r < 4; ++r) { const int row = row0 + half * 32 + tile * 16 + 4 * (lane >> 4) + r;
                    const float u = bf2f(Us[(row - row0) * 16 + hh]);
                    YB[(size_t)row * 512 + g * 16 + hh] = (bf16)f2bf(gelu_tanh(acc[r] + dd * u)); }
            }
        }
    }
    if (!FINAL) { float* sl = SLOC + (size_t)item * 128 + lane; sl[0] = hr; sl[64] = hi; }
    if (FINAL && c == S5NC - 1) { const size_t o = (size_t)((l * NB + b) * G_A + g) * P_A + lane; out[O_S5RP + o] = hr; out[O_S5IP + o] = hi; }
}

__device__ __forceinline__ void s5_sample_item(KArgs A, unsigned char* ws, float* out, int l, int item, int lane) {
    const int g = item & 31, s = item >> 5, row = MPROMPT + s;
    const int lgp = (l * G_A + g) * P_A + lane;
    const f32x4 aq = *(const GAS f32x4*)((const float*)(ws + WS_SMALL + SM_S5A) + (size_t)lgp * 4);
    const bf16* PROJ = (const bf16*)(ws + WS_BIG);
    const GAS v4u* up = (const GAS v4u*)(PROJ + (size_t)row * N_INP + PC_UA + g * 16);
    const v4u u0 = up[0], u1 = up[1];
    float u[16]; u[0] = bflo(u0.x); u[1] = bfhi(u0.x); u[2] = bflo(u0.y); u[3] = bfhi(u0.y); u[4] = bflo(u0.z); u[5] = bfhi(u0.z); u[6] = bflo(u0.w); u[7] = bfhi(u0.w);
    u[8] = bflo(u1.x); u[9] = bfhi(u1.x); u[10] = bflo(u1.y); u[11] = bfhi(u1.y); u[12] = bflo(u1.z); u[13] = bfhi(u1.z); u[14] = bflo(u1.w); u[15] = bfhi(u1.w);
    const GAS f32x4* bb = (const GAS f32x4*)((const float*)(ws + WS_SMALL + SM_S5BB) + (size_t)lgp * 32);
    float sr = 0.f, si = 0.f;
#pragma unroll
    for (int q = 0; q < 4; ++q) { const f32x4 v = bb[q], w = bb[4 + q];
        sr += v.x * u[4 * q] + v.y * u[4 * q + 1] + v.z * u[4 * q + 2] + v.w * u[4 * q + 3];
        si += w.x * u[4 * q] + w.y * u[4 * q + 1] + w.z * u[4 * q + 2] + w.w * u[4 * q + 3]; }
    const size_t so = (size_t)((l * NS + s) * G_A + g) * P_A + lane;
    const float h0r = A->in[I_S5RE][so], h0i = A->in[I_S5IM][so];
    const float hr = aq.x * h0r - aq.y * h0i + sr, hi = aq.x * h0i + aq.y * h0r + si;
    out[O_S5RS + so] = hr; out[O_S5IS + so] = hi;
    const float* cre = A->in[I_CRE] + (size_t)((l * G_A + g) * S5G) * P_A + lane; const float* cim = A->in[I_CIM] + (size_t)((l * G_A + g) * S5G) * P_A + lane;
    float y16[16];
#pragma unroll
    for (int hh = 0; hh < 16; ++hh) y16[hh] = cre[hh * P_A] * hr - cim[hh * P_A] * hi;
    const float mine = wave_sum16(y16, lane);
    if (lane < 16) { const float dd = A->in[I_S5D][l * D_A + g * 16 + lane]; float uu = 0.f;
#pragma unroll
        for (int hh = 0; hh < 16; ++hh) uu = (lane == hh) ? u[hh] : uu;
        ((bf16*)(ws + WS_YB))[(size_t)row * 512 + g * 16 + lane] = (bf16)f2bf(gelu_tanh(mine + dd * uu)); }
}
__device__ __forceinline__ void gmlp_sample_item(KArgs A, unsigned char* ws, float* out, int l, int s, int lane) {
    const int row = MPROMPT + s, ch0 = lane * 8;
    const bf16* PROJ = (const bf16*)(ws + WS_BIG);
    const v4u vv = *(const GAS v4u*)(PROJ + (size_t)row * N_INP + PC_VB + ch0), uu = *(const GAS v4u*)(PROJ + (size_t)row * N_INP + PC_UB + ch0);
    const float rinv = rsqrtf(((const float*)(ws + WS_SMALL + SM_VSQ))[l * MP + row] * (1.0f / D_B) + EPS);
    const int h = ch0 >> 6;
    const float w00 = A->in[I_WS][(size_t)(l * H_B + h) * 128 * 128], b0 = A->in[I_BS][(l * H_B + h) * 128];
    float v[8] = {bflo(vv.x), bfhi(vv.x), bflo(vv.y), bfhi(vv.y), bflo(vv.z), bfhi(vv.z), bflo(vv.w), bfhi(vv.w)};
    float u[8] = {bflo(uu.x), bfhi(uu.x), bflo(uu.y), bfhi(uu.y), bflo(uu.z), bfhi(uu.z), bflo(uu.w), bfhi(uu.w)};
    const float* gv = A->in[I_GV] + l * D_B + ch0;
    float o[8];
#pragma unroll
    for (int j = 0; j < 8; ++j) { const float vn = v[j] * rinv * gv[j]; out[O_GVS + (size_t)(l * NS + s) * D_B + ch0 + j] = vn; o[j] = u[j] * (w00 * vn + b0); }
    v4u w; w.x = pk2(o[0], o[1]); w.y = pk2(o[2], o[3]); w.z = pk2(o[4], o[5]); w.w = pk2(o[6], o[7]);
    *(GAS v4u*)((bf16*)(ws + WS_OCAT) + (size_t)row * OCP + OC_B + ch0) = w;
}
__device__ __forceinline__ void ssd_sample_item(KArgs A, unsigned char* ws, float* out, int l, int item, int lane, bool acc) {
    const int h = item & 15, s = item >> 4, row = MPROMPT + s, g = h >> 3;
    const bf16* PROJ = (const bf16*)(ws + WS_BIG);
    const float* cw = A->in[I_CONVW] + (size_t)l * K_C * D_XBC; const float* cb = A->in[I_CONVB] + l * D_XBC;
    const float* cst = A->in[I_SSDCONV] + (size_t)(l * NS + s) * 3 * D_XBC;
    float* cso = out + O_CCS + (size_t)(l * NS + s) * 3 * D_XBC;
    float x;
    {   const int ch = h * 64 + lane; const float p0 = cst[ch], p1 = cst[D_XBC + ch], p2 = cst[2 * D_XBC + ch], p3 = bf2f(PROJ[(size_t)row * N_INP + PC_XBC + ch]);
        x = siluf_(cb[ch] + cw[ch] * p0 + cw[D_XBC + ch] * p1 + cw[2 * D_XBC + ch] * p2 + cw[3 * D_XBC + ch] * p3);
        cso[ch] = p1; cso[D_XBC + ch] = p2; cso[2 * D_XBC + ch] = p3; }
    const int n4 = (lane & 31) * 4; float Bv[4], Cv[4];
#pragma unroll
    for (int j = 0; j < 4; ++j) {
        {   const int ch = D_C + g * N_C + n4 + j; const float p0 = cst[ch], p1 = cst[D_XBC + ch], p2 = cst[2 * D_XBC + ch], p3 = bf2f(PROJ[(size_t)row * N_INP + PC_XBC + ch]);
            Bv[j] = siluf_(cb[ch] + cw[ch] * p0 + cw[D_XBC + ch] * p1 + cw[2 * D_XBC + ch] * p2 + cw[3 * D_XBC + ch] * p3);
            if ((h & 7) == 0 && lane < 32) { cso[ch] = p1; cso[D_XBC + ch] = p2; cso[2 * D_XBC + ch] = p3; } }
        {   const int ch = D_C + G_C * N_C + g * N_C + n4 + j; const float p0 = cst[ch], p1 = cst[D_XBC + ch], p2 = cst[2 * D_XBC + ch], p3 = bf2f(PROJ[(size_t)row * N_INP + PC_XBC + ch]);
            Cv[j] = siluf_(cb[ch] + cw[ch] * p0 + cw[D_XBC + ch] * p1 + cw[2 * D_XBC + ch] * p2 + cw[3 * D_XBC + ch] * p3);
            if ((h & 7) == 0 && lane < 32) { cso[ch] = p1; cso[D_XBC + ch] = p2; cso[2 * D_XBC + ch] = p3; } }
    }
    const float dt = softplusf_(((const float*)(ws + WS_SMALL + SM_DT))[(size_t)row * 16 + h] + A->in[I_DTBIAS][l * H_C + h]);
    const float dA = __expf(dt * -__expf(A->in[I_ALOG][l * H_C + h]));
    const size_t sbase = (size_t)((l * NS + s) * H_C + h) * HD_C * N_C;
    const GAS f32x4* st = (const GAS f32x4*)(A->in[I_SSM] + sbase) + lane;
    GAS f32x4* so = (GAS f32x4*)(out + O_SSMS + sbase) + lane;
    float part[32];
#pragma unroll
    for (int i = 0; i < 32; ++i) {
        const float xe = lane_bcast(x, 2 * i), xo = lane_bcast(x, 2 * i + 1); const float xv = lane < 32 ? xe : xo; const float xd = xv * dt;
        f32x4 v = __builtin_nontemporal_load(st + 64 * i);
        v.x = v.x * dA + xd * Bv[0]; v.y = v.y * dA + xd * Bv[1]; v.z = v.z * dA + xd * Bv[2]; v.w = v.w * dA + xd * Bv[3];
        __builtin_nontemporal_store(v, so + 64 * i);
        part[i] = v.x * Cv[0] + v.y * Cv[1] + v.z * Cv[2] + v.w * Cv[3];
    }
    const float ymine = half_sum32(part, lane);
    const float xmine = __builtin_bit_cast(float, __builtin_amdgcn_ds_bpermute((2 * (lane & 31) + (lane >> 5)) << 2, __builtin_bit_cast(int, x)));
    const int p = 2 * (lane & 31) + (lane >> 5), ch = h * 64 + p;
    const float y = ymine + A->in[I_SSDD][l * H_C + h] * xmine;
    const float z = bf2f(PROJ[(size_t)row * N_INP + PC_Z + ch]);
    const float yz = y * siluf_(z);
    const float sq = wave_sum(yz * yz);
    if (lane == 0 && acc) atomicAdd((float*)(ws + WS_SMALL + SM_CSQ) + l * MP + row, sq);
    ((bf16*)(ws + WS_OCAT))[(size_t)row * OCP + OC_C + ch] = (bf16)f2bf(yz * A->in[I_GNORM][l * D_C + ch]);
}
constexpr int TP = 136;
__device__ __forceinline__ void gmlp_item(KArgs A, unsigned char* ws, int l, int item, LAS unsigned char* lds, int tid, int wave, int lane) {
    const int h = item & 7, c = (item >> 3) & 15, b = item >> 7, row0 = b * SEQ + c * GMC;
    const bf16* PROJ = (const bf16*)(ws + WS_BIG);
    LAS bf16* vT = (LAS bf16*)lds;
    {   const int tok = tid >> 2, part = tid & 3, d0 = part * 16, row = row0 + tok;
        const float rinv = rsqrtf(((const float*)(ws + WS_SMALL + SM_VSQ))[l * MP + row] * (1.0f / D_B) + EPS);
        const GAS v4u* vp = (const GAS v4u*)(PROJ + (size_t)row * N_INP + PC_VB + h * 64 + d0);
        const v4u a = vp[0], b2 = vp[1];
        const float* gv = A->in[I_GV] + l * D_B + h * 64 + d0;
        const unsigned wv[8] = {a.x, a.y, a.z, a.w, b2.x, b2.y, b2.z, b2.w};
#pragma unroll
        for (int k = 0; k < 8; ++k) { vT[(d0 + 2 * k) * TP + tok] = (bf16)f2bf(bflo(wv[k]) * rinv * gv[2 * k]); vT[(d0 + 2 * k + 1) * TP + tok] = (bf16)f2bf(bfhi(wv[k]) * rinv * gv[2 * k + 1]); }
    }
    const bf16* WSb = (const bf16*)(ws + WS_SMALL + SM_WS) + (size_t)(l * H_B + h) * 128 * 128;
    bf16x8 afr[4];
#pragma unroll
    for (int ks = 0; ks < 4; ++ks) afr[ks] = *(const GAS bf16x8*)(WSb + (size_t)(16 * wave + (lane & 15)) * 128 + 32 * ks + 8 * (lane >> 4));
    __syncthreads();
    f32x4 acc[4];
#pragma unroll
    for (int t = 0; t < 4; ++t) acc[t] = (f32x4){0.f, 0.f, 0.f, 0.f};
    const int nks = (wave >> 1) + 1;
#pragma unroll
    for (int ks = 0; ks < 4; ++ks) if (ks < nks) {
#pragma unroll
        for (int t = 0; t < 4; ++t) { const bf16x8 bfr = *(const LAS bf16x8*)(vT + (16 * t + (lane & 15)) * TP + 32 * ks + 8 * (lane >> 4));
            acc[t] = __builtin_amdgcn_mfma_f32_16x16x32_bf16(afr[ks], bfr, acc[t], 0, 0, 0); }
    }
    bf16* OB = (bf16*)(ws + WS_OCAT) + OC_B;
#pragma unroll
    for (int r = 0; r < 4; ++r) { const int i = 16 * wave + 4 * (lane >> 4) + r, row = row0 + i; const float bs = A->in[I_BS][(l * H_B + h) * 128 + i];
#pragma unroll
        for (int t = 0; t < 4; ++t) { const int ch = h * 64 + 16 * t + (lane & 15);
            const float u = bf2f(PROJ[(size_t)row * N_INP + PC_UB + ch]);
            OB[(size_t)row * OCP + ch] = (bf16)f2bf(u * (acc[t][r] + bs)); } }
    __syncthreads();
}

template <int NCH, bool TRANS>
__device__ __forceinline__ void conv_tile(KArgs A, const bf16* PROJ, int l, int b, int c, int chb, LAS bf16* tile, const LAS float* scale, int tid) {
    constexpr int LPR = NCH / 8, SLOTS = NTHR / LPR, TPT = 128 / SLOTS;
    const int cl = tid % LPR, slot = tid / LPR, ch0 = chb + cl * 8, t0 = slot * TPT;
    const float* cw = A->in[I_CONVW] + (size_t)l * K_C * D_XBC + ch0; const float* cb = A->in[I_CONVB] + l * D_XBC + ch0;
    float w[4][8], bias[8];
#pragma unroll
    for (int k = 0; k < 4; ++k) { const f32x4 a = *(const GAS f32x4*)(cw + k * D_XBC), b2 = *(const GAS f32x4*)(cw + k * D_XBC + 4);
        w[k][0] = a.x; w[k][1] = a.y; w[k][2] = a.z; w[k][3] = a.w; w[k][4] = b2.x; w[k][5] = b2.y; w[k][6] = b2.z; w[k][7] = b2.w; }
    {   const f32x4 a = *(const GAS f32x4*)cb, b2 = *(const GAS f32x4*)(cb + 4); bias[0] = a.x; bias[1] = a.y; bias[2] = a.z; bias[3] = a.w; bias[4] = b2.x; bias[5] = b2.y; bias[6] = b2.z; bias[7] = b2.w; }
    const int trow0 = c * SSDQ + t0;
    v4u raw[TPT + 3];
#pragma unroll
    for (int i = 0; i < TPT + 3; ++i) { const int tt = trow0 - 3 + i;
        raw[i] = tt >= 0 ? *(const GAS v4u*)(PROJ + (size_t)(b * SEQ + tt) * N_INP + PC_XBC + ch0) : (v4u){0u, 0u, 0u, 0u}; }
    float o[TPT][8];
#pragma unroll
    for (int t = 0; t < TPT; ++t) {
#pragma unroll
        for (int e = 0; e < 8; ++e) o[t][e] = bias[e];
#pragma unroll
        for (int k = 0; k < 4; ++k) { const v4u r = raw[t + k]; const unsigned rw[4] = {r.x, r.y, r.z, r.w};
#pragma unroll
            for (int e2 = 0; e2 < 4; ++e2) { o[t][2 * e2] = fmaf(w[k][2 * e2], bflo(rw[e2]), o[t][2 * e2]); o[t][2 * e2 + 1] = fmaf(w[k][2 * e2 + 1], bfhi(rw[e2]), o[t][2 * e2 + 1]); } }
        const float sc = scale ? scale[t0 + t] : 1.0f;
#pragma unroll
        for (int e = 0; e < 8; ++e) o[t][e] = siluf_(o[t][e]) * sc;
    }
    if (!TRANS) {
#pragma unroll
        for (int t = 0; t < TPT; ++t) { v4u wv; wv.x = pk2(o[t][0], o[t][1]); wv.y = pk2(o[t][2], o[t][3]); wv.z = pk2(o[t][4], o[t][5]); wv.w = pk2(o[t][6], o[t][7]);
            *(LAS v4u*)(tile + (t0 + t) * TP + cl * 8) = wv; }
    } else {
#pragma unroll
        for (int e = 0; e < 8; ++e) {
            if (TPT == 4) { v2u wv; wv.x = pk2(o[0][e], o[1][e]); wv.y = pk2(o[TPT > 2 ? 2 : 0][e], o[TPT > 3 ? 3 : 0][e]); *(LAS v2u*)(tile + (cl * 8 + e) * TP + t0) = wv; }
            else { *(LAS unsigned*)(tile + (cl * 8 + e) * TP + t0) = pk2(o[0][e], o[1][e]); }
        }
    }
}

__device__ __forceinline__ void ssd_dt_scan(KArgs A, unsigned char* ws, int l, int b, int c, int h, LAS float* dtv, LAS float* cs, int tid, int lane) {
    if (tid < 64) {
        const float* DT = (const float*)(ws + WS_SMALL + SM_DT); const float bias = A->in[I_DTBIAS][l * H_C + h], a = -__expf(A->in[I_ALOG][l * H_C + h]);
        const int row = b * SEQ + c * SSDQ + 2 * lane;
        const float d0 = softplusf_(DT[(size_t)row * 16 + h] + bias), d1 = softplusf_(DT[(size_t)(row + 1) * 16 + h] + bias);
        const float v0 = d0 * a, v1 = d1 * a; float s = v0 + v1;
#pragma unroll
        for (int o = 1; o < 64; o <<= 1) { const float t = __builtin_bit_cast(float, __builtin_amdgcn_ds_bpermute((lane - o) << 2, __builtin_bit_cast(int, s))); if (lane >= o) s += t; }
        dtv[2 * lane] = d0; dtv[2 * lane + 1] = d1; cs[2 * lane] = s - v1; cs[2 * lane + 1] = s;
    }
    __syncthreads();
}

constexpr int SL_CN = 0, SL_BN = 34816, SL_MW = 69632, SL_XT = 104448, SL_HP = 121856, SL_DT = 139264, SL_CS = SL_DT + 512, SL_SC = SL_CS + 512, SL_END = SL_SC + 512;

__device__ __forceinline__ void ssd_item1(KArgs A, unsigned char* ws, int l, int item, LAS unsigned char* lds, int tid, int wave, int lane) {
    const int h = item & 15, c = (item >> 4) & 15, b = item >> 8, g = h >> 3;
    const bf16* PROJ = (const bf16*)(ws + WS_BIG);
    LAS float* dtv = (LAS float*)(lds + SL_DT); LAS float* cs = (LAS float*)(lds + SL_CS); LAS float* sc = (LAS float*)(lds + SL_SC);
    LAS bf16* Xt = (LAS bf16*)(lds + SL_XT); LAS bf16* Bt = (LAS bf16*)(lds + SL_BN);
    (void)sc;
    conv_tile<64, true>(A, PROJ, l, b, c, h * 64, Xt, nullptr, tid);
    conv_tile<128, true>(A, PROJ, l, b, c, D_C + g * N_C, Bt, nullptr, tid);
    ssd_dt_scan(A, ws, l, b, c, h, dtv, cs, tid, lane);
    f32x4 acc[4];
#pragma unroll
    for (int t = 0; t < 4; ++t) acc[t] = (f32x4){0.f, 0.f, 0.f, 0.f};
    const float cse = cs[127];
#pragma unroll
    for (int ks = 0; ks < 4; ++ks) { const int j0 = 32 * ks + 8 * (lane >> 4);
        const v4u braw = *(const LAS v4u*)(Bt + (16 * wave + (lane & 15)) * TP + j0);
        const f32x4 d0 = *(const LAS f32x4*)(dtv + j0), d1 = *(const LAS f32x4*)(dtv + j0 + 4), c0 = *(const LAS f32x4*)(cs + j0), c1 = *(const LAS f32x4*)(cs + j0 + 4);
        v4u bs;
        bs.x = pk2(bflo(braw.x) * d0.x * __expf(cse - c0.x), bfhi(braw.x) * d0.y * __expf(cse - c0.y)); bs.y = pk2(bflo(braw.y) * d0.z * __expf(cse - c0.z), bfhi(braw.y) * d0.w * __expf(cse - c0.w));
        bs.z = pk2(bflo(braw.z) * d1.x * __expf(cse - c1.x), bfhi(braw.z) * d1.y * __expf(cse - c1.y)); bs.w = pk2(bflo(braw.w) * d1.z * __expf(cse - c1.z), bfhi(braw.w) * d1.w * __expf(cse - c1.w));
        const bf16x8 bfr = __builtin_bit_cast(bf16x8, bs);
#pragma unroll
        for (int t = 0; t < 4; ++t) { const bf16x8 af = *(const LAS bf16x8*)(Xt + (16 * t + (lane & 15)) * TP + 32 * ks + 8 * (lane >> 4));
            acc[t] = __builtin_amdgcn_mfma_f32_16x16x32_bf16(af, bfr, acc[t], 0, 0, 0); } }
    float* ST = (float*)(ws + WS_STATES) + (size_t)item * HD_C * N_C;
#pragma unroll
    for (int t = 0; t < 4; ++t)
#pragma unroll
        for (int r = 0; r < 4; ++r) ST[(size_t)(16 * t + 4 * (lane >> 4) + r) * N_C + 16 * wave + (lane & 15)] = acc[t][r];
    if (tid == 0) ((float*)(ws + WS_SMALL + SM_SDEC))[item] = __expf(cs[127]);
    __syncthreads();
}

__device__ __forceinline__ void ssd_item2(KArgs A, unsigned char* ws, float* out, int l, int item, LAS unsigned char* lds, int tid, int wave, int lane, bool acc) {
    const int h = item & 15, c = (item >> 4) & 15, b = item >> 8, g = h >> 3, row0 = b * SEQ + c * SSDQ;
    const bf16* PROJ = (const bf16*)(ws + WS_BIG);
    LAS float* dtv = (LAS float*)(lds + SL_DT); LAS float* cs = (LAS float*)(lds + SL_CS);
    LAS bf16* Cn = (LAS bf16*)(lds + SL_CN); LAS bf16* Bn = (LAS bf16*)(lds + SL_BN); LAS bf16* Mw = (LAS bf16*)(lds + SL_MW);
    LAS bf16* Xt = (LAS bf16*)(lds + SL_XT); LAS bf16* Hp = (LAS bf16*)(lds + SL_HP);
    conv_tile<64, true>(A, PROJ, l, b, c, h * 64, Xt, nullptr, tid);
    conv_tile<128, false>(A, PROJ, l, b, c, D_C + g * N_C, Bn, nullptr, tid);
    conv_tile<128, false>(A, PROJ, l, b, c, D_C + G_C * N_C + g * N_C, Cn, nullptr, tid);
    {   const float* ST = (const float*)(ws + WS_STATES) + (size_t)((b * 16) * 16 + h) * HD_C * N_C + tid * 4;
        const float* SD = (const float*)(ws + WS_SMALL + SM_SDEC) + (b * 16) * 16 + h;
        f32x4 hv[4];
#pragma unroll
        for (int k = 0; k < 4; ++k) hv[k] = (f32x4){0.f, 0.f, 0.f, 0.f};
        int cc = 0;
        for (; cc + 4 <= c; cc += 4) { f32x4 sv[4][4]; float d[4];
#pragma unroll
            for (int q = 0; q < 4; ++q) { d[q] = SD[(cc + q) * 16];
#pragma unroll
                for (int k = 0; k < 4; ++k) sv[q][k] = *(const GAS f32x4*)(ST + (size_t)(cc + q) * 16 * 8192 + 2048 * k); }
#pragma unroll
            for (int q = 0; q < 4; ++q)
#pragma unroll
                for (int k = 0; k < 4; ++k) hv[k] = hv[k] * d[q] + sv[q][k]; }
        for (; cc < c; ++cc) { const float d = SD[cc * 16];
#pragma unroll
            for (int k = 0; k < 4; ++k) hv[k] = hv[k] * d + *(const GAS f32x4*)(ST + (size_t)cc * 16 * 8192 + 2048 * k); }
#pragma unroll
        for (int k = 0; k < 4; ++k) { v2u wv; wv.x = pk2(hv[k].x, hv[k].y); wv.y = pk2(hv[k].z, hv[k].w); *(LAS v2u*)(Hp + ((tid >> 5) + 16 * k) * TP + (tid & 31) * 4) = wv; }
        if (c == SSDNC - 1) { const float d = SD[c * 16]; float* o = out + O_SSMP + (size_t)((l * NB + b) * H_C + h) * HD_C * N_C + tid * 4;
#pragma unroll
            for (int k = 0; k < 4; ++k) *(GAS f32x4*)(o + 2048 * k) = hv[k] * d + *(const GAS f32x4*)(ST + (size_t)c * 16 * 8192 + 2048 * k); }
    }
    ssd_dt_scan(A, ws, l, b, c, h, dtv, cs, tid, lane);
    bf16x8 cf[4];
#pragma unroll
    for (int ks = 0; ks < 4; ++ks) cf[ks] = *(const LAS bf16x8*)(Cn + (16 * wave + (lane & 15)) * TP + 32 * ks + 8 * (lane >> 4));
    const int jtmax = wave | 1;
    for (int jt = 0; jt <= jtmax; ++jt) {
        f32x4 gacc = {0.f, 0.f, 0.f, 0.f};
        if (jt <= wave) {
#pragma unroll
            for (int ks = 0; ks < 4; ++ks) { const bf16x8 bfr = *(const LAS bf16x8*)(Bn + (16 * jt + (lane & 15)) * TP + 32 * ks + 8 * (lane >> 4));
                gacc = __builtin_amdgcn_mfma_f32_16x16x32_bf16(cf[ks], bfr, gacc, 0, 0, 0); }
        }
        const int j = 16 * jt + (lane & 15); const float csj = cs[j], dtj = dtv[j];
#pragma unroll
        for (int r = 0; r < 4; ++r) { const int i = 16 * wave + 4 * (lane >> 4) + r;
            const float m = (j <= i) ? gacc[r] * __expf(cs[i] - csj) * dtj : 0.f;
            Mw[i * TP + j] = (bf16)f2bf(m); }
    }
    f32x4 yd[4], yo[4];
#pragma unroll
    for (int t = 0; t < 4; ++t) { yd[t] = (f32x4){0.f, 0.f, 0.f, 0.f}; yo[t] = (f32x4){0.f, 0.f, 0.f, 0.f}; }
    const int nks = (wave >> 1) + 1;
    for (int ks = 0; ks < nks; ++ks) { const bf16x8 mf = *(const LAS bf16x8*)(Mw + (16 * wave + (lane & 15)) * TP + 32 * ks + 8 * (lane >> 4));
#pragma unroll
        for (int t = 0; t < 4; ++t) { const bf16x8 xf = *(const LAS bf16x8*)(Xt + (16 * t + (lane & 15)) * TP + 32 * ks + 8 * (lane >> 4));
            yd[t] = __builtin_amdgcn_mfma_f32_16x16x32_bf16(mf, xf, yd[t], 0, 0, 0); } }
#pragma unroll
    for (int ks = 0; ks < 4; ++ks)
#pragma unroll
        for (int t = 0; t < 4; ++t) { const bf16x8 hf = *(const LAS bf16x8*)(Hp + (16 * t + (lane & 15)) * TP + 32 * ks + 8 * (lane >> 4));
            yo[t] = __builtin_amdgcn_mfma_f32_16x16x32_bf16(cf[ks], hf, yo[t], 0, 0, 0); }
    const float dsk = A->in[I_SSDD][l * H_C + h];
    bf16* OC = (bf16*)(ws + WS_OCAT) + OC_C; float* csq = (float*)(ws + WS_SMALL + SM_CSQ) + l * MP;
#pragma unroll
    for (int r = 0; r < 4; ++r) { const int i = 16 * wave + 4 * (lane >> 4) + r, row = row0 + i; const float ecs = __expf(cs[i]); float sq = 0.f;
#pragma unroll
        for (int t = 0; t < 4; ++t) { const int p = 16 * t + (lane & 15), ch = h * 64 + p;
            const float x = bf2f(Xt[p * TP + i]);
            const float y = yd[t][r] + ecs * yo[t][r] + dsk * x;
            const float z = bf2f(PROJ[(size_t)row * N_INP + PC_Z + ch]);
            const float yz = y * siluf_(z); sq += yz * yz;
            OC[(size_t)row * OCP + ch] = (bf16)f2bf(yz * A->in[I_GNORM][l * D_C + ch]); }
        sq += xor_lt32<1>(sq); sq += xor_lt32<2>(sq); sq += xor_lt32<4>(sq); sq += xor_lt32<8>(sq);
        if ((lane & 15) == 0 && acc) atomicAdd(csq + row, sq); }
    __syncthreads();
}

__device__ __forceinline__ void ssd_item_fused(KArgs A, unsigned char* ws, float* out, int l, int item, LAS unsigned char* lds, int tid, int wave, int lane, bool acc, unsigned* flags) {
    const int h = item & 15, c = (item >> 4) & 15, b = item >> 8, g = h >> 3, row0 = b * SEQ + c * SSDQ;
    const bf16* PROJ = (const bf16*)(ws + WS_BIG);
    LAS float* dtv = (LAS float*)(lds + SL_DT); LAS float* cs = (LAS float*)(lds + SL_CS);
    LAS bf16* Cn = (LAS bf16*)(lds + SL_CN); LAS bf16* Bn = (LAS bf16*)(lds + SL_BN); LAS bf16* Mw = (LAS bf16*)(lds + SL_MW);
    LAS bf16* Xt = (LAS bf16*)(lds + SL_XT); LAS bf16* Hp = (LAS bf16*)(lds + SL_HP);
    conv_tile<64, true>(A, PROJ, l, b, c, h * 64, Xt, nullptr, tid);
    conv_tile<128, false>(A, PROJ, l, b, c, D_C + g * N_C, Bn, nullptr, tid);
    conv_tile<128, true>(A, PROJ, l, b, c, D_C + g * N_C, Mw, nullptr, tid);
    conv_tile<128, false>(A, PROJ, l, b, c, D_C + G_C * N_C + g * N_C, Cn, nullptr, tid);
    bf16 zz[4][4];
#pragma unroll
    for (int r = 0; r < 4; ++r)
#pragma unroll
        for (int t = 0; t < 4; ++t) zz[r][t] = PROJ[(size_t)(row0 + 16 * wave + 4 * (lane >> 4) + r) * N_INP + PC_Z + h * 64 + 16 * t + (lane & 15)];
    ssd_dt_scan(A, ws, l, b, c, h, dtv, cs, tid, lane);
    {   f32x4 sacc[4];
#pragma unroll
        for (int t = 0; t < 4; ++t) sacc[t] = (f32x4){0.f, 0.f, 0.f, 0.f};
        const float cse = cs[127];
#pragma unroll
        for (int ks = 0; ks < 4; ++ks) { const int j0 = 32 * ks + 8 * (lane >> 4);
            const v4u braw = *(const LAS v4u*)(Mw + (16 * wave + (lane & 15)) * TP + j0);
            const f32x4 d0 = *(const LAS f32x4*)(dtv + j0), d1 = *(const LAS f32x4*)(dtv + j0 + 4), c0 = *(const LAS f32x4*)(cs + j0), c1 = *(const LAS f32x4*)(cs + j0 + 4);
            v4u bs;
            bs.x = pk2(bflo(braw.x) * d0.x * __expf(cse - c0.x), bfhi(braw.x) * d0.y * __expf(cse - c0.y)); bs.y = pk2(bflo(braw.y) * d0.z * __expf(cse - c0.z), bfhi(braw.y) * d0.w * __expf(cse - c0.w));
            bs.z = pk2(bflo(braw.z) * d1.x * __expf(cse - c1.x), bfhi(braw.z) * d1.y * __expf(cse - c1.y)); bs.w = pk2(bflo(braw.w) * d1.z * __expf(cse - c1.z), bfhi(braw.w) * d1.w * __expf(cse - c1.w));
            const bf16x8 bfr = __builtin_bit_cast(bf16x8, bs);
#pragma unroll
            for (int t = 0; t < 4; ++t) { const bf16x8 af = *(const LAS bf16x8*)(Xt + (16 * t + (lane & 15)) * TP + 32 * ks + 8 * (lane >> 4));
                sacc[t] = __builtin_amdgcn_mfma_f32_16x16x32_bf16(bfr, af, sacc[t], 0, 0, 0); } }
        {   const __amdgpu_buffer_rsrc_t srs = __builtin_amdgcn_make_buffer_rsrc((void*)((float*)(ws + WS_STATES) + (size_t)item * HD_C * N_C), (short)0, HD_C * N_C * 4, 0x00020000);
#pragma unroll
            for (int t = 0; t < 4; ++t) __builtin_amdgcn_raw_buffer_store_b128(__builtin_bit_cast(v4u, sacc[t]), srs, (unsigned)((16 * t + (lane & 15)) * N_C + 16 * wave + 4 * (lane >> 4)) * 4u, 0,   16); }
        if (tid == 0) __hip_atomic_store((float*)(ws + WS_SMALL + SM_SDEC) + item, __expf(cse), __ATOMIC_RELAXED, __HIP_MEMORY_SCOPE_AGENT);
        asm volatile("s_waitcnt vmcnt(0)" ::: "memory"); __syncthreads();
        if (tid == 0) __hip_atomic_store(flags + item, 1u, __ATOMIC_RELAXED, __HIP_MEMORY_SCOPE_AGENT);
    }
    bf16x8 cf[4];
#pragma unroll
    for (int ks = 0; ks < 4; ++ks) cf[ks] = *(const LAS bf16x8*)(Cn + (16 * wave + (lane & 15)) * TP + 32 * ks + 8 * (lane >> 4));
    const int jtmax = wave | 1;
    for (int jt = 0; jt <= jtmax; ++jt) {
        f32x4 gacc = {0.f, 0.f, 0.f, 0.f};
        if (jt <= wave) {
#pragma unroll
            for (int ks = 0; ks < 4; ++ks) { const bf16x8 bfr = *(const LAS bf16x8*)(Bn + (16 * jt + (lane & 15)) * TP + 32 * ks + 8 * (lane >> 4));
                gacc = __builtin_amdgcn_mfma_f32_16x16x32_bf16(cf[ks], bfr, gacc, 0, 0, 0); }
        }
        const int j = 16 * jt + (lane & 15); const float csj = cs[j], dtj = dtv[j];
#pragma unroll
        for (int r = 0; r < 4; ++r) { const int i = 16 * wave + 4 * (lane >> 4) + r;
            const float m = (j <= i) ? gacc[r] * __expf(cs[i] - csj) * dtj : 0.f;
            Mw[i * TP + j] = (bf16)f2bf(m); }
    }
    f32x4 yd[4], yo[4];
#pragma unroll
    for (int t = 0; t < 4; ++t) { yd[t] = (f32x4){0.f, 0.f, 0.f, 0.f}; yo[t] = (f32x4){0.f, 0.f, 0.f, 0.f}; }
    const int nks = (wave >> 1) + 1;
    for (int ks = 0; ks < nks; ++ks) { const bf16x8 mf = *(const LAS bf16x8*)(Mw + (16 * wave + (lane & 15)) * TP + 32 * ks + 8 * (lane >> 4));
#pragma unroll
        for (int t = 0; t < 4; ++t) { const bf16x8 xf = *(const LAS bf16x8*)(Xt + (16 * t + (lane & 15)) * TP + 32 * ks + 8 * (lane >> 4));
            yd[t] = __builtin_amdgcn_mfma_f32_16x16x32_bf16(mf, xf, yd[t], 0, 0, 0); } }
    if (tid < 64) {
        unsigned sp_ = 0;
        for (;;) { const unsigned f = lane < c ? __hip_atomic_load(flags + ((b * 16 + lane) * 16 + h), __ATOMIC_RELAXED, __HIP_MEMORY_SCOPE_AGENT) : 1u;
            if (__builtin_amdgcn_ballot_w64(f == 0u) == 0ull || ++sp_ > (1u << 20)) break; __builtin_amdgcn_s_sleep(1); }
        __builtin_amdgcn_fence(__ATOMIC_ACQUIRE, "agent"); asm volatile("s_waitcnt vmcnt(0)" ::: "memory"); }
    __syncthreads();
    {   const float* ST = (const float*)(ws + WS_STATES) + (size_t)((b * 16) * 16 + h) * HD_C * N_C + tid * 4;
        const float* SD = (const float*)(ws + WS_SMALL + SM_SDEC) + (b * 16) * 16 + h;
        f32x4 hv[4];
#pragma unroll
        for (int k = 0; k < 4; ++k) hv[k] = (f32x4){0.f, 0.f, 0.f, 0.f};
        for (int cc = 0; cc < c; cc += 4) { f32x4 sv[4][4]; float d[4];
#pragma unroll
            for (int q = 0; q < 4; ++q) { const int cq = cc + q < c ? cc + q : c - 1; d[q] = SD[cq * 16];
#pragma unroll
                for (int k = 0; k < 4; ++k) sv[q][k] = *(const GAS f32x4*)(ST + (size_t)cq * 16 * 8192 + 2048 * k); }
#pragma unroll
            for (int q = 0; q < 4; ++q) if (cc + q < c) {
#pragma unroll
                for (int k = 0; k < 4; ++k) hv[k] = hv[k] * d[q] + sv[q][k]; } }
#pragma unroll
        for (int k = 0; k < 4; ++k) { v2u wv; wv.x = pk2(hv[k].x, hv[k].y); wv.y = pk2(hv[k].z, hv[k].w); *(LAS v2u*)(Hp + ((tid >> 5) + 16 * k) * TP + (tid & 31) * 4) = wv; }
        if (c == SSDNC - 1) { const float d = SD[c * 16]; float* o = out + O_SSMP + (size_t)((l * NB + b) * H_C + h) * HD_C * N_C + tid * 4;
#pragma unroll
            for (int k = 0; k < 4; ++k) *(GAS f32x4*)(o + 2048 * k) = hv[k] * d + *(const GAS f32x4*)(ST + (size_t)c * 16 * 8192 + 2048 * k); }
    }
    __syncthreads();
#pragma unroll
    for (int ks = 0; ks < 4; ++ks)
#pragma unroll
        for (int t = 0; t < 4; ++t) { const bf16x8 hf = *(const LAS bf16x8*)(Hp + (16 * t + (lane & 15)) * TP + 32 * ks + 8 * (lane >> 4));
            yo[t] = __builtin_amdgcn_mfma_f32_16x16x32_bf16(cf[ks], hf, yo[t], 0, 0, 0); }
    const float dsk = A->in[I_SSDD][l * H_C + h];
    bf16* OC = (bf16*)(ws + WS_OCAT) + OC_C; float* csq = (float*)(ws + WS_SMALL + SM_CSQ) + l * MP;
#pragma unroll
    for (int r = 0; r < 4; ++r) { const int i = 16 * wave + 4 * (lane >> 4) + r, row = row0 + i; const float ecs = __expf(cs[i]); float sq = 0.f;
#pragma unroll
        for (int t = 0; t < 4; ++t) { const int p = 16 * t + (lane & 15), ch = h * 64 + p;
            const float x = bf2f(Xt[p * TP + i]);
            const float y = yd[t][r] + ecs * yo[t][r] + dsk * x;
            const float z = bf2f(zz[r][t]);
            const float yz = y * siluf_(z); sq += yz * yz;
            OC[(size_t)row * OCP + ch] = (bf16)f2bf(yz * A->in[I_GNORM][l * D_C + ch]); }
        sq += xor_lt32<1>(sq); sq += xor_lt32<2>(sq); sq += xor_lt32<4>(sq); sq += xor_lt32<8>(sq);
        if ((lane & 15) == 0 && acc) atomicAdd(csq + row, sq); }
    __syncthreads();
}
__device__ __forceinline__ void phase_upfix(const Frame& F0, KArgs A, int l) {
    Frame F = launder(F0);
    const float* HALO = WSP(const float, WS_HALO); bf16* ACT = WSP(bf16, WS_T);
    const float* cw = A->in[I_FCONVW] + (size_t)l * K_F * D_UP; const float* cb = A->in[I_FCONVB] + (size_t)l * D_UP;
    const int gt = blockIdx.x * NTHR + F.tid, NT = GRID * NTHR;
    for (int i = gt; i < 32 * D_FF; i += NT) { const int ch = i % D_FF, pm = i / D_FF; if ((pm & 7) == 0) continue;
        const int ca_ = 256 * (ch / 128) + ch % 128, cb_ = ca_ + 128;
        const float* hp = HALO + ((size_t)(pm - 1) * 4 + 2) * D_UP; const float* hc = HALO + (size_t)pm * 4 * D_UP;
        const float am2 = hp[ca_], am1 = hp[D_UP + ca_], a0 = hc[ca_], a1 = hc[D_UP + ca_], bm2 = hp[cb_], bm1 = hp[D_UP + cb_], b0 = hc[cb_], b1 = hc[D_UP + cb_];
        const float wa0 = cw[ch], wa1 = cw[D_UP + ch], wa2 = cw[2 * D_UP + ch], wb0 = cw[D_FF + ch], wb1 = cw[D_UP + D_FF + ch], wb2 = cw[2 * D_UP + D_FF + ch], ba = cb[ch], bb = cb[D_FF + ch];
        const float r0 = siluf_(ba + wa0 * am2 + wa1 * am1 + wa2 * a0) * (bb + wb0 * bm2 + wb1 * bm1 + wb2 * b0);
        const float r1 = siluf_(ba + wa0 * am1 + wa1 * a0 + wa2 * a1) * (bb + wb0 * bm1 + wb1 * b0 + wb2 * b1);
        ACT[(size_t)(pm * 256) * D_FF + ch] = (bf16)f2bf(r0); ACT[(size_t)(pm * 256 + 1) * D_FF + ch] = (bf16)f2bf(r1); }
    for (int i = gt; i < NB * 2 * D_UP; i += NT) { const int oc = i % D_UP, k = (i / D_UP) & 1, b = i / (2 * D_UP);
        const int c = oc < D_FF ? 256 * (oc / 128) + oc % 128 : 256 * ((oc - D_FF) / 128) + 128 + (oc - D_FF) % 128;
        F.out[O_CFP + (size_t)l * NB * 2 * D_UP + i] = HALO[((size_t)(8 * b + 7) * 4 + 2 + k) * D_UP + c]; }
}
__device__ __forceinline__ void ssd_conv_p_out(const Frame& F0, int l) {
    Frame F = launder(F0);
    const bf16* PROJ = WSP(const bf16, WS_BIG);
    const int gt = blockIdx.x * NTHR + F.tid, NT = GRID * NTHR;
    for (int i = gt; i < NB * 3 * D_XBC; i += NT) { const int ch = i % D_XBC, k = (i / D_XBC) % 3, b = i / (3 * D_XBC);
        F.out[O_CCP + (size_t)l * NB * 3 * D_XBC + i] = bf2f(PROJ[(size_t)(b * SEQ + SEQ - 3 + k) * N_INP + PC_XBC + ch]); }
}

__device__ __forceinline__ void phase_mix1(const Frame& F0, KArgs A, int l, bool acc) {
    {   Frame F = launder(F0);
        for (int it = F.gw; it < NS * G_A; it += (GRID * NWAVES)) s5_sample_item(A, F.ws, F.out, l, it, F.lane); }
    {   Frame F = launder(F0);
        for (int it = F.gw; it < NS; it += (GRID * NWAVES)) gmlp_sample_item(A, F.ws, F.out, l, it, F.lane); }
    {   Frame F = launder(F0);
        for (int it = F.gw; it < NS * H_C; it += (GRID * NWAVES)) ssd_sample_item(A, F.ws, F.out, l, it, F.lane, acc); }
    ssd_conv_p_out(F0, l);
}
__device__ __forceinline__ void phase_mix2(const Frame& F0, KArgs A, int l, bool acc) {
#ifndef REP_SSD2
#define REP_SSD2 1
#endif
#ifndef REP_GMLP
#define REP_GMLP 1
#endif
#ifndef REP_S5F
#define REP_S5F 1
#endif
    _Pragma("unroll 1") for (int r2 = 0; r2 < REP_SSD2; ++r2) {   Frame F = launder(F0);
        for (int it = blockIdx.x; it < NB * SSDNC * H_C; it += GRID) ssd_item_fused(A, F.ws, F.out, l, it, F.lds, F.tid, F.wave, F.lane, acc && r2 == 0, (unsigned*)(F.ws + WS_CTL) + CW_SSDF + l * 1024); }
    _Pragma("unroll 1") for (int r2 = 0; r2 < REP_GMLP; ++r2) {   Frame F = launder(F0);
        for (int it = blockIdx.x; it < NB * (SEQ / GMC) * H_B; it += GRID) gmlp_item(A, F.ws, l, it, F.lds, F.tid, F.wave, F.lane); }
    _Pragma("unroll 1") for (int r2 = 0; r2 < REP_S5F; ++r2) {   Frame F = launder(F0);
        for (int it = F.gw; it < NB * G_A * S5NC; it += (GRID * NWAVES)) s5_item<true>(A, F.ws, F.out, l, it, F.lds + F.wave * 10752, F.lane, (unsigned*)(F.ws + WS_CTL) + CW_S5F + l * 4096); }
}

constexpr int LDS_BYTES = 147456, MISC_OFF = 147456 - 256;
#ifndef GEMM_SP2
#define GEMM_SP2 true
#endif
template <class Epi>
__device__ __forceinline__ void run_gemm(const Frame& F, const bf16* Am, const bf16* Bt, int M, int N, int K, const Epi& E) {
    pg8::Gemm g{Am, Bt, M, N, K}; pg8::StaticOrder S; S.init(M, N, GRID, (int)blockIdx.x, K);
    pg8::gemm_phase<Epi, pg8::StaticOrder, true, GEMM_SP2>(F.lds, g, S, E);
}
struct SplitSched {
    pg8::StaticOrder P; int c, np, nsl, ntsl, ns, cbase, cu0, sid0;
    __device__ void init(int N, int K, int c_, int nsl_, int cbase_, int cu0_, int sid0_) { sid0 = sid0_; P.init(MPROMPT, N, GRID, c_, K); c = c_; np = (MPROMPT / 256) * (N / 256) / GRID; nsl = nsl_; ntsl = (K / 64) / nsl_; ns = (N / 256) * nsl_; cbase = cbase_; cu0 = cu0_; }
    __device__ bool next(int i, pg8::Unit& u) const {
        const int s = c - cu0; const bool has = s >= 0 && s < ns;
        if (!has || i > 0) return (i - (has ? 1 : 0)) < np ? P.next(i - (has ? 1 : 0), u) : false;
        u.pm = MPROMPT / 256; u.pn = s / nsl; u.k0 = (s % nsl) * ntsl * 64; u.nt = ntsl; u.cidx = cbase + u.pn; u.sid = sid0 + s; return true;
    }
    __device__ __forceinline__ void a_ready(const pg8::Unit&) const {}
    __device__ __forceinline__ void done(const pg8::Unit&) const {}
};
template <class Epi, bool CHAIN_IN>
__device__ __forceinline__ void run_gemm_chain(const Frame& F, const bf16* Am, const bf16* Bt, int K, const Epi& E, pg8::f32x4 (&acc)[2][2][4][2]) {
    pg8::Gemm g{Am, Bt, MPROMPT, DM, K}; pg8::StaticOrder S; S.init(MPROMPT, DM, GRID, (int)blockIdx.x, K);
    pg8::gemm_phase<Epi, pg8::StaticOrder, true, GEMM_SP2, CHAIN_IN>(F.lds, g, S, E, acc);
}
template <class Epi>
__device__ __forceinline__ void run_gemm_split(const Frame& F, const bf16* Am, const bf16* Bt, int N, int K, const Epi& E, int nsl, int cbase, int cu0, int sid0 = 0, int fin0 = -1, int parts = 1) {
    pg8::Gemm g{Am, Bt, MP, N, K}; SplitSched S; S.init(N, K, (int)blockIdx.x, nsl, cbase, cu0, sid0);
    pg8::gemm_phase<Epi, SplitSched, true, GEMM_SP2>(F.lds, g, S, E);
    if constexpr (!Epi::AFTER_DRAIN) {
        const int f = epi::opaque_bx() - fin0;
        if (fin0 >= 0 && f >= 0 && f < (N / 256) * parts) { int t2 = threadIdx.x; asm volatile("" : "+v"(t2)); const int lane = t2 & 63, wid = __builtin_amdgcn_readfirstlane(t2 >> 6);
            const pg8::Unit u = epi::final_unit(f / parts, cbase); E.final(u, wid >> 2, wid & 3, lane & 15, lane >> 4, wid, lane, epi::part_mask(f % parts, parts)); }
    }
}

#ifndef REP_PROLOGUE
#define REP_PROLOGUE 1
#endif
#ifndef REP_MOD
#define REP_MOD 1
#endif
#ifndef REP_PREP
#define REP_PREP 1
#endif
#ifndef REP_WIN
#define REP_WIN 1
#endif
#ifndef REP_MIX1
#define REP_MIX1 1
#endif
#ifndef REP_MIX2
#define REP_MIX2 1
#endif
#ifndef REP_GLU
#define REP_GLU 1
#endif
#ifndef REP_MERGE
#define REP_MERGE 1
#endif
#ifndef REP_OUT
#define REP_OUT 1
#endif
#ifndef REP_UP
#define REP_UP 1
#endif
#ifndef REP_CONV
#define REP_CONV 1
#endif
#ifndef REP_DOWN
#define REP_DOWN 1
#endif
#ifndef REP_BAR
#define REP_BAR 1
#endif
#define REP(n) _Pragma("unroll 1") for (int rep_ = 0; rep_ < (n); ++rep_)
__device__ __forceinline__ void grid_bar(const Frame& F0) {
    unsigned long long w = (unsigned long long)F0.ws; unsigned x = xb_xcc_id(); asm volatile("" : "+s"(w), "+s"(x));
    XcdBarrier b; b.bar = (unsigned*)((unsigned char*)w + WS_CTL) + CW_BAR; b.x = x; b.st = (volatile LAS unsigned*)(F0.lds + MISC_OFF) + 8;
    xcd_barrier(b);
}
__global__ void __launch_bounds__(NTHR, 2) mega_fwd(Args Aarg) {
    const KArgs A0 = (KArgs)__builtin_amdgcn_kernarg_segment_ptr(); (void)Aarg;
#define A launder_args(A0)
    extern __shared__ __attribute__((aligned(16))) unsigned char lds_raw[];
    Frame F;
    F.lds = (LAS unsigned char*)lds_raw;
    F.tid = threadIdx.x; F.lane = F.tid & 63; F.wave = __builtin_amdgcn_readfirstlane(F.tid >> 6);
    F.gw = blockIdx.x * NWAVES + F.wave;
    F.out = A0->out; F.ws = A0->ws;
    volatile LAS unsigned* MISC = (volatile LAS unsigned*)(F.lds + MISC_OFF);
    if (F.tid < 64) MISC[F.tid] = 0u;
    __syncthreads();
    (void)xcd_barrier_post((unsigned*)(F.ws + WS_CTL) + CW_BAR, MISC + 8);
#define GRID_BAR() do { REP(REP_BAR) grid_bar(F); } while (0)
#ifndef TIME_PHASE
#define TIME_PHASE -1
#endif
    unsigned long long tacc_ = 0ull, tbeg_ = 0ull;
#define TBEG(k) do { if (TIME_PHASE == (k)) tbeg_ = __builtin_amdgcn_s_memrealtime(); } while (0)
#define TEND(k) do { if (TIME_PHASE == (k)) tacc_ += __builtin_amdgcn_s_memrealtime() - tbeg_; } while (0)

#ifndef REP_MODS
#define REP_MODS 1
#endif
    TBEG(0); REP(REP_PROLOGUE) { _Pragma("unroll 1") for (int rm = 0; rm < REP_MODS; ++rm) phase_mod(F, A);
    GRID_BAR();
    prep_layer0(F, A); phase_prologue(F, A);
    GRID_BAR(); } TEND(0);
#pragma unroll 1
    for (int l = 0; l < DEPTH; ++l) {
#define PH_FRAME() const Frame Fq = launder(F); unsigned char* const wsq = Fq.ws; unsigned char* const wl = wsq + WS_W + (size_t)l * WL_END; \
        const float* const modl = (const float*)(wsq + WS_MOD) + (size_t)l * N_MOD; pg8::f32x4* const slab = (pg8::f32x4*)(wsq + WS_SLAB); \
        unsigned* const cnt = (unsigned*)(wsq + WS_CTL) + CW_CNT; (void)wl; (void)modl; (void)slab; (void)cnt
#define WSQ(T, off) ((T*)(wsq + (off)))
        TBEG(2); REP(REP_WIN) { { PH_FRAME(); epi::EpiIn E{WSQ(bf16, WS_BIG), rep_ == 0 ? WSQ(float, WS_SMALL + SM_VSQ) + l * MP : nullptr, epi::SplitCtl{slab, cnt, 4u, 160, (l * 4 + 0) * 64, 2}};
            run_gemm_split(Fq, WSQ(const bf16, WS_H), (const bf16*)(wl + WL_IN), N_INP, DM, E, 4, (l * 4 + 0) * 64, 0, 0, 160, 2); }
        GRID_BAR(); } TEND(2);
        TBEG(3); REP(REP_MIX2) { phase_mix2(F, A, l, rep_ == 0); phase_mix1(F, A, l, rep_ == 0);
        GRID_BAR(); } TEND(3);
        TBEG(4); REP(REP_GLU) { { PH_FRAME(); epi::EpiGlu E{WSQ(const bf16, WS_YB), WSQ(bf16, WS_OCAT) + OC_A};
            run_gemm(Fq, WSQ(const bf16, WS_YB), (const bf16*)(wl + WL_GLU), MP, 512, 512, E); }
        GRID_BAR(); } TEND(4);
        TBEG(5);
        REP(REP_MERGE) {
            TBEG(10); TBEG(14);
            {   PH_FRAME(); bf16* BIG = WSQ(bf16, WS_BIG);
                epi::EpiMergeCat Em{BIG, WSQ(bf16, WS_MERGED), WSQ(const float, WS_SMALL + SM_CSQ) + l * MP, slab, cnt};
                run_gemm_split(Fq, WSQ(const bf16, WS_OCAT), (const bf16*)(wl + WL_PA), DM, OCP, Em, 4, (l * 4 + 1) * 64, 0, 0, 32, 4); }
            TEND(10);
            TEND(12); TEND(14); TBEG(13);
        GRID_BAR(); TEND(13); }
        TEND(5);
        TBEG(6);
        REP(REP_OUT) { { PH_FRAME(); epi::EpiResidPrep<0> E{epi::EpiResid{WSQ(const bf16, WS_X0), WSQ(const bf16, WS_X0) + (size_t)MPROMPT * DM, WSQ(bf16, WS_X1), modl + 2 * DM, epi::SplitCtl{slab, cnt, 4u, 32, (l * 4 + 2) * 64, 4}},
                WSQ(bf16, WS_H), nullptr, nullptr, A->in[I_GFFN] + l * DM, modl, 3, 4, nullptr, WSQ(float, WS_SMALL + SM_DT), (unsigned*)(wsq + WS_CTL) + CW_PC + (l * 2 + 0) * 64};
            run_gemm_split(Fq, WSQ(const bf16, WS_MERGED), (const bf16*)(wl + WL_OUT), DM, DM, E, 4, (l * 4 + 2) * 64, 0); }
        GRID_BAR(); }
        TEND(6);
        TBEG(7); REP(REP_UP) { { PH_FRAME(); epi::EpiUpConv E{WSQ(bf16, WS_T), WSQ(float, WS_HALO), A->in[I_FCONVW] + (size_t)l * K_F * D_UP, A->in[I_FCONVB] + (size_t)l * D_UP,
                A->in[I_FFNCONV] + (size_t)l * NS * 2 * D_UP, Fq.out + O_CFS + (size_t)l * NS * 2 * D_UP, (LAS float*)(Fq.lds + 131072), rep_ < REP_UP - 1 ? 1 : 0};
            run_gemm(Fq, WSQ(const bf16, WS_H), (const bf16*)(wl + WL_UP), MP, D_UP, DM, E); }
        GRID_BAR(); } TEND(7);
        TBEG(8); REP(REP_CONV) { phase_upfix(F, A, l);
        GRID_BAR(); } TEND(8);
        TBEG(9); REP(REP_DOWN) {
            if (l + 1 < DEPTH) { PH_FRAME(); const float* mod2 = (const float*)(wsq + WS_MOD) + (size_t)(l + 1) * N_MOD;
                epi::EpiResidPrep<1> E{epi::EpiResid{WSQ(const bf16, WS_X1), WSQ(const bf16, WS_X1) + (size_t)MPROMPT * DM, WSQ(bf16, WS_X0), modl + 5 * DM, epi::SplitCtl{slab, cnt, 11u, 88, (l * 4 + 3) * 64, 4}},
                    WSQ(bf16, WS_H), nullptr, nullptr, A->in[I_GMIX] + (l + 1) * DM, mod2, 0, 1, WSQ(const float, WS_SMALL + SM_WDT) + (size_t)(l + 1) * 16 * DM, WSQ(float, WS_SMALL + SM_DT), (unsigned*)(wsq + WS_CTL) + CW_PC + (l * 2 + 1) * 64};
                run_gemm_split(Fq, WSQ(const bf16, WS_T), (const bf16*)(wl + WL_DOWN), DM, D_FF, E, 11, (l * 4 + 3) * 64, 0);
            } else { PH_FRAME();
                epi::EpiResidPrep<2> E{epi::EpiResid{WSQ(const bf16, WS_X1), WSQ(const bf16, WS_X1) + (size_t)MPROMPT * DM, WSQ(bf16, WS_X0), modl + 5 * DM, epi::SplitCtl{slab, cnt, 11u, 88, (l * 4 + 3) * 64, 4}},
                    nullptr, Fq.out + O_YP, Fq.out + O_YS, A->in[I_GFINAL], modl, 0, 1, nullptr, WSQ(float, WS_SMALL + SM_DT), (unsigned*)(wsq + WS_CTL) + CW_PC + (l * 2 + 1) * 64};
                run_gemm_split(Fq, WSQ(const bf16, WS_T), (const bf16*)(wl + WL_DOWN), DM, D_FF, E, 11, (l * 4 + 3) * 64, 0); }
        if (l + 1 < DEPTH) GRID_BAR(); } TEND(9);
    }
    if (TIME_PHASE >= 0) {
        GRID_BAR();
#ifdef TIME_WG_LO
        if ((int)blockIdx.x < TIME_WG_LO || (int)blockIdx.x > TIME_WG_HI) tacc_ = 0ull; else tacc_ *= (unsigned long long)(256 / (TIME_WG_HI - TIME_WG_LO + 1));
#endif
        const float eps_ = sqrtf(5e-5f + 1e-6f * (float)tacc_ * 0.01f);
        for (int i = blockIdx.x * NTHR + F.tid; i < DEPTH * NS * D_B; i += GRID * NTHR) F.out[O_GVS + i] *= (1.0f + eps_);
    }
#undef A
}

extern "C" void kernel_launch(void* const* d_in, const int* in_sizes, int n_in, void* d_out, int out_size, void* d_ws, size_t ws_size, hipStream_t stream) {
    static int grid = 0;
    if (grid == 0) {
        if (n_in != N_INPUTS || (size_t)out_size != O_END || ws_size < WS_END) { fprintf(stderr, "kernel_launch: unexpected shapes (n_in %d, out %d, ws %zu, need %zu)\n", n_in, out_size, ws_size, (size_t)WS_END); grid = -1; return; }
        int dev = 0, cus = 0, per_cu = 0;
        if (hipGetDevice(&dev) != hipSuccess || hipDeviceGetAttribute(&cus, hipDeviceAttributeMultiprocessorCount, dev) != hipSuccess) { grid = -1; return; }
        if (hipFuncSetAttribute((const void*)mega_fwd, hipFuncAttributeMaxDynamicSharedMemorySize, LDS_BYTES) != hipSuccess) { fprintf(stderr, "kernel_launch: hipFuncSetAttribute failed\n"); grid = -1; return; }
        if (hipOccupancyMaxActiveBlocksPerMultiprocessor(&per_cu, (const void*)mega_fwd, NTHR, LDS_BYTES) != hipSuccess || per_cu < 1) { fprintf(stderr, "kernel_launch: occupancy query reports %d blocks per CU\n", per_cu); (void)hipGetLastError(); grid = -1; return; }
        if (cus * per_cu < GRID) { fprintf(stderr, "kernel_launch: %d CUs x %d blocks cannot hold the %d-workgroup grid\n", cus, per_cu, GRID); grid = -1; return; }
        grid = GRID;
    }
    if (grid < 0) return;
    if (hipMemsetAsync((char*)d_ws + WS_CTL, 0, CTL_ZERO_BYTES, stream) != hipSuccess) return;
    Args a{};
    for (int i = 0; i < N_INPUTS; ++i) a.in[i] = (const float*)d_in[i];
    a.out = (float*)d_out; a.ws = (unsigned char*)d_ws;
    void* params[] = {&a};
    hipError_t e = hipLaunchCooperativeKernel((const void*)mega_fwd, dim3(grid), dim3(NTHR), params, LDS_BYTES, stream);
    if (e != hipSuccess) fprintf(stderr, "kernel_launch: cooperative launch failed: %s (grid %d)\n", hipGetErrorString(e), grid);
}
```

```cpp
#include <hip/hip_runtime.h>
#include <cstdio>
#include <cstdint>
namespace pg8 {
#define PG8_LAS __attribute__((address_space(3)))
typedef unsigned short bf16_t;
typedef short bf16x8 __attribute__((ext_vector_type(8)));
typedef float f32x4 __attribute__((ext_vector_type(4)));
typedef unsigned u32x4 __attribute__((ext_vector_type(4)));
constexpr int BM = 256, BK = 64, HALF = 128, HTB = HALF * BK * 2  , STAGE_BYTES = 8 * HTB, NXCD = 8, WGM = 8;

__host__ __device__ __forceinline__ int lds_byte(int r, int c) { const int st = (r >> 4) * 2 + (c >> 5), rr = r & 15, cc = c & 31, ob = rr * 64 + cc * 2; return st * 1024 + (ob ^ (((ob >> 9) & 1) << 5)); }
__host__ __device__ __forceinline__ void stage_rc(int b, int& R, int& C) { const int st = b / 1024, sb = b % 1024, swz = sb ^ (((sb >> 9) & 1) << 5); R = (st >> 1) * 16 + swz / 64; C = (st & 1) * 32 + (swz % 64) / 2; }
__host__ __device__ __forceinline__ int perm32(int rho) { const int n = rho >> 4, i = rho & 15; return 8 * (i >> 2) + 4 * n + (i & 3); }

struct Unit { int pm, pn, k0, nt, cidx, sid; };
struct Gemm { const bf16_t* A; const bf16_t* Bt; int M, N, K; };

struct StaticOrder {
    int nM, nN, nwg, G, c, ntk;
    __host__ __device__ void init(int M, int N, int G_, int c_, int K_) { nM = M / BM; nN = N / BM; nwg = nM * nN; G = G_; c = c_; ntk = K_ / BK; }
    __host__ __device__ bool next(int i, Unit& u) const {
        const long L = (long)i * G + c; if (L >= nwg) return false;
        int wgid = (int)L; { const int q = nwg / NXCD, r = nwg % NXCD, xcd = wgid % NXCD, off = wgid / NXCD; wgid = (xcd < r ? xcd * (q + 1) : r * (q + 1) + (xcd - r) * q) + off; }
        const int nig = WGM * nN, gid = wgid / nig, fm = gid * WGM, gsz = (nM - fm) < WGM ? (nM - fm) : WGM;
        u.pm = fm + ((wgid % nig) % gsz); u.pn = (wgid % nig) / gsz; u.k0 = 0; u.nt = ntk; u.cidx = -1; u.sid = 0; return true;
    }
    __device__ __forceinline__ void a_ready(const Unit&) const {}
    __device__ __forceinline__ void done(const Unit&) const {}
};
__device__ __forceinline__ unsigned cvt_pk_bf16(float lo, float hi) { unsigned r; asm volatile("s_nop 0\n\tv_cvt_pk_bf16_f32 %0, %1, %2" : "=v"(r) : "v"(lo), "v"(hi)); return r; }
template <class Epi, class Sched, bool ALIGN_EPI = false, bool SP2 = false, bool CHAIN_IN = false>
__device__ __forceinline__ void gemm_phase(PG8_LAS unsigned char* lds, const Gemm g, const Sched& S, const Epi& E, f32x4 (&acc)[2][2][4][2]) {
    int tid_ = threadIdx.x; asm volatile("" : "+v"(tid_));
    const int tid = tid_, wid = __builtin_amdgcn_readfirstlane(tid >> 6), lane = tid & 63, wr = wid >> 2, wc = wid & 3, fr = lane & 15, fq = lane >> 4;
    const int K = g.K;
    unsigned voffA[2], voffB[2];
#pragma unroll
    for (int i = 0; i < 2; ++i) { int R, C; stage_rc(tid * 16 + i * 8192, R, C); const int Rb = Epi::PERM ? ((R & ~31) + perm32(R & 31)) : R;
        voffA[i] = (unsigned)(R * K + C) * 2u; voffB[i] = (unsigned)(Rb * K + C) * 2u; }
    const size_t kstep = (size_t)(BK * 2);
    const size_t hstep = (size_t)HALF * K * 2;
    const size_t tstep = 2 * hstep;
    const unsigned ldsw = (unsigned)wid * 1024u;
    const int aoff = lds_byte(wr * 64 + fr, fq * 8), boff = lds_byte(wc * 32 + fr, fq * 8);
#define PG8_SA(b, h) (((b) * 2 + (h)) * HTB)
#define PG8_SB(b, h) ((4 + (b) * 2 + (h)) * HTB)
#define PG8_STAGE(bufoff, gbase, voff) do { _Pragma("unroll") for (int _i = 0; _i < 2; ++_i) \
        __builtin_amdgcn_global_load_lds((const unsigned*)((const char*)(gbase) + (voff)[_i]), (PG8_LAS unsigned*)(lds + (bufoff) + ldsw + _i * 8192), 16, 0, 0); } while (0)
#define PG8_LDA(dst, b, h) do { _Pragma("unroll") for (int m = 0; m < 4; ++m) _Pragma("unroll") for (int k = 0; k < 2; ++k) dst[m][k] = *(const PG8_LAS bf16x8*)(lds + PG8_SA(b, h) + aoff + m * 2048 + k * 1024); } while (0)
#define PG8_LDB(dst, b, h) do { _Pragma("unroll") for (int n = 0; n < 2; ++n) _Pragma("unroll") for (int k = 0; k < 2; ++k) dst[n][k] = *(const PG8_LAS bf16x8*)(lds + PG8_SB(b, h) + boff + n * 2048 + k * 1024); } while (0)
#define PG8_MMA(ai, bj, At, Bt) do { __builtin_amdgcn_s_setprio(1); _Pragma("unroll") for (int m = 0; m < 4; ++m) _Pragma("unroll") for (int n = 0; n < 2; ++n) _Pragma("unroll") for (int k = 0; k < 2; ++k) \
        acc[ai][bj][m][n] = __builtin_amdgcn_mfma_f32_16x16x32_bf16(Bt[n][k], At[m][k], acc[ai][bj][m][n], 0, 0, 0); __builtin_amdgcn_s_setprio(0); } while (0)
#define PG8_WAIT_V(n) asm volatile("s_waitcnt vmcnt(" #n ")" ::: "memory")
#define PG8_WAIT_L(n) asm volatile("s_waitcnt lgkmcnt(" #n ")" ::: "memory")
#define PG8_BAR __builtin_amdgcn_s_barrier()
#define PG8_SCHED __builtin_amdgcn_sched_barrier(0)
    Unit cur, nxt; int ui = 0;
    if (!S.next(0, cur)) return;
    if constexpr (!CHAIN_IN) {
#pragma unroll
    for (int a = 0; a < 2; ++a)
#pragma unroll
        for (int b = 0; b < 2; ++b)
#pragma unroll
            for (int m = 0; m < 4; ++m)
#pragma unroll
                for (int n = 0; n < 2; ++n) acc[a][b][m][n] = (f32x4){0.f, 0.f, 0.f, 0.f};
    }
    bf16x8 At[4][2], B0[2][2], B1[2][2];
    const char* cA = (const char*)g.A + (size_t)cur.pm * tstep + (size_t)cur.k0 * 2; const char* cB = (const char*)g.Bt + (size_t)cur.pn * tstep + (size_t)cur.k0 * 2;
    S.a_ready(cur);
    if constexpr (SP2) {
        PG8_STAGE(PG8_SB(0, 0), cB, voffB); PG8_STAGE(PG8_SB(0, 1), cB + hstep, voffB); PG8_STAGE(PG8_SA(0, 0), cA, voffA); PG8_STAGE(PG8_SA(0, 1), cA + hstep, voffA);
        if (wr == 1) PG8_BAR;
        PG8_WAIT_V(2); PG8_BAR;
        PG8_STAGE(PG8_SB(1, 0), cB + kstep, voffB); PG8_STAGE(PG8_SA(1, 0), cA + kstep, voffA); PG8_STAGE(PG8_SB(1, 1), cB + hstep + kstep, voffB);
        PG8_WAIT_V(6); PG8_BAR;
    } else {
        PG8_STAGE(PG8_SB(0, 0), cB, voffB); PG8_STAGE(PG8_SA(0, 0), cA, voffA); PG8_STAGE(PG8_SB(0, 1), cB + hstep, voffB); PG8_STAGE(PG8_SA(0, 1), cA + hstep, voffA);
        if (wr == 1) PG8_BAR;
        PG8_WAIT_V(4); PG8_BAR;
        PG8_STAGE(PG8_SB(1, 0), cB + kstep, voffB); PG8_STAGE(PG8_SA(1, 0), cA + kstep, voffA); PG8_STAGE(PG8_SB(1, 1), cB + hstep + kstep, voffB);
        PG8_WAIT_V(6); PG8_BAR;
    }
    for (;;) {
        const bool has_next = S.next(ui + 1, nxt);
        const char* nA = has_next ? (const char*)g.A + (size_t)nxt.pm * tstep + (size_t)nxt.k0 * 2 : cA; const char* nB = has_next ? (const char*)g.Bt + (size_t)nxt.pn * tstep + (size_t)nxt.k0 * 2 : cB;
        const int nt = cur.nt; const bool halfu = cur.cidx >= 0;
        for (int t = 0; t < nt; t += 2) {
            if constexpr (Epi::HOOK) { if (!halfu && (t == 8 || t == 16)) E.hook(acc, cur, t, wr, wc); }
            const bool last = (t == nt - 2);
            const char* a1 = cA + (size_t)(t + 1) * kstep;
            const char* a2 = last ? nA : cA + (size_t)(t + 2) * kstep; const char* b2 = last ? nB : cB + (size_t)(t + 2) * kstep;
            const char* a3 = a2 + kstep; const char* b3 = b2 + kstep;
            if (last && has_next) S.a_ready(nxt);
            if constexpr (SP2) {
            PG8_LDB(B0, 0, 0); PG8_LDB(B1, 0, 1); PG8_SCHED; PG8_LDA(At, 0, 0); PG8_STAGE(PG8_SA(1, 1), a1 + hstep, voffA);
            PG8_WAIT_V(8); PG8_WAIT_L(0); PG8_BAR; PG8_MMA(0, 0, At, B0); PG8_MMA(0, 1, At, B1); PG8_BAR; PG8_SCHED;
            PG8_LDA(At, 0, 1); PG8_STAGE(PG8_SB(0, 0), b2, voffB); PG8_STAGE(PG8_SB(0, 1), b2 + hstep, voffB); PG8_STAGE(PG8_SA(0, 0), a2, voffA);
            PG8_WAIT_V(8); PG8_WAIT_L(0); PG8_BAR; if (!halfu) { PG8_MMA(1, 0, At, B0); PG8_MMA(1, 1, At, B1); } PG8_BAR; PG8_SCHED;
            PG8_LDB(B0, 1, 0); PG8_LDB(B1, 1, 1); PG8_SCHED; PG8_LDA(At, 1, 0); PG8_STAGE(PG8_SA(0, 1), a2 + hstep, voffA);
            PG8_WAIT_V(8); PG8_WAIT_L(0); PG8_BAR; PG8_MMA(0, 0, At, B0); PG8_MMA(0, 1, At, B1); PG8_BAR; PG8_SCHED;
            PG8_LDA(At, 1, 1); PG8_STAGE(PG8_SB(1, 0), b3, voffB); PG8_STAGE(PG8_SB(1, 1), b3 + hstep, voffB); PG8_STAGE(PG8_SA(1, 0), a3, voffA);
            PG8_WAIT_V(8); PG8_WAIT_L(0); PG8_BAR; if (!halfu) { PG8_MMA(1, 0, At, B0); PG8_MMA(1, 1, At, B1); } PG8_BAR; PG8_SCHED;
            } else {
            PG8_LDB(B0, 0, 0); PG8_SCHED; PG8_LDA(At, 0, 0); PG8_STAGE(PG8_SA(1, 1), a1 + hstep, voffA);
            PG8_WAIT_L(8); PG8_BAR; PG8_WAIT_L(0); PG8_MMA(0, 0, At, B0); PG8_BAR; PG8_SCHED;
            PG8_LDB(B1, 0, 1); PG8_STAGE(PG8_SB(0, 0), b2, voffB);
            PG8_BAR; PG8_WAIT_L(0); PG8_MMA(0, 1, At, B1); PG8_BAR;
            PG8_LDA(At, 0, 1); PG8_STAGE(PG8_SA(0, 0), a2, voffA);
            PG8_BAR; PG8_WAIT_L(0); PG8_MMA(1, 0, At, B0); PG8_BAR; PG8_SCHED;
            PG8_STAGE(PG8_SB(0, 1), b2 + hstep, voffB);
            PG8_WAIT_V(6); PG8_BAR; PG8_MMA(1, 1, At, B1); PG8_BAR;
            PG8_LDB(B0, 1, 0); PG8_SCHED; PG8_LDA(At, 1, 0); PG8_STAGE(PG8_SA(0, 1), a2 + hstep, voffA);
            PG8_WAIT_L(8); PG8_BAR; PG8_WAIT_L(0); PG8_MMA(0, 0, At, B0); PG8_BAR; PG8_SCHED;
            PG8_LDB(B1, 1, 1); PG8_STAGE(PG8_SB(1, 0), b3, voffB);
            PG8_BAR; PG8_WAIT_L(0); PG8_MMA(0, 1, At, B1); PG8_BAR;
            PG8_LDA(At, 1, 1); PG8_STAGE(PG8_SA(1, 0), a3, voffA);
            PG8_BAR; PG8_WAIT_L(0); PG8_MMA(1, 0, At, B0); PG8_BAR; PG8_SCHED;
            PG8_STAGE(PG8_SB(1, 1), b3 + hstep, voffB);
            PG8_WAIT_V(6); PG8_BAR; PG8_MMA(1, 1, At, B1); PG8_BAR;
            }
        }
        if constexpr (ALIGN_EPI) { if (wr == 0) PG8_BAR; }
        if constexpr (!Epi::AFTER_DRAIN) { int t2 = threadIdx.x; asm volatile("" : "+v"(t2)); const int lane2 = t2 & 63, fr2 = lane2 & 15, fq2 = lane2 >> 4;
            if (cur.cidx < 0) E(acc, cur, wr, wc, fr2, fq2); else E.partial(acc, cur, wr, wc, fr2, fq2, wid, lane2); S.done(cur); }
        else { if (cur.cidx >= 0) { int t2 = threadIdx.x; asm volatile("" : "+v"(t2)); const int lane2 = t2 & 63; E.partial(acc, cur, wr, wc, lane2 & 15, lane2 >> 4, wid, lane2); } }
        if (!has_next) break;
#pragma unroll
        for (int a = 0; a < 2; ++a)
#pragma unroll
            for (int b = 0; b < 2; ++b)
#pragma unroll
                for (int m = 0; m < 4; ++m)
#pragma unroll
                    for (int n = 0; n < 2; ++n) acc[a][b][m][n] = (f32x4){0.f, 0.f, 0.f, 0.f};
        cur = nxt; cA = nA; cB = nB; ++ui;
        if constexpr (ALIGN_EPI) { if (wr == 1) PG8_BAR; }
    }
    PG8_WAIT_V(0);
    if constexpr (!ALIGN_EPI) { if (wr == 0) PG8_BAR; }
    PG8_BAR;
    if constexpr (Epi::AFTER_DRAIN) { E.fused(acc, cur, wr, wc, fr, fq, lds, wid, lane); S.done(cur); }
#undef PG8_SA
#undef PG8_SB
#undef PG8_STAGE
#undef PG8_LDA
#undef PG8_LDB
#undef PG8_MMA
#undef PG8_WAIT_V
#undef PG8_WAIT_L
#undef PG8_BAR
#undef PG8_SCHED
}
template <class Epi, class Sched, bool ALIGN_EPI = false, bool SP2 = false>
__device__ __forceinline__ void gemm_phase(PG8_LAS unsigned char* lds, const Gemm g, const Sched& S, const Epi& E) {
    f32x4 acc[2][2][4][2];
    gemm_phase<Epi, Sched, ALIGN_EPI, SP2, false>(lds, g, S, E, acc);
}

}
constexpr int DM = 2048, NB = 4, SEQ = 2048, NS = 128, DEPTH = 2;
constexpr int MPROMPT = NB * SEQ;
constexpr int MREAL = MPROMPT + NS;
constexpr int MP = 8448;
constexpr int D_A = 512, G_A = 32, P_A = 64, S5G = 16;
constexpr int D_B = 512, H_B = 8, GMC = 128;
constexpr int D_C = 1024, HD_C = 64, H_C = 16, N_C = 128, G_C = 2, K_C = 4, D_XBC = 1536;
constexpr int D_FF = 5632, K_F = 3, D_UP = 2 * D_FF;
constexpr int N_IN = 10256, N_INP = 10240;
constexpr int N_MOD = 6 * DM, MOD_PITCH = 2 * N_MOD;
constexpr float EPS = 1e-6f;
constexpr int PC_UA = 0, PC_UB = 512, PC_VB = 1024, PC_Z = 1536, PC_XBC = 2560, PC_GA = 4096, PC_GB = 6144, PC_GC = 8192;
constexpr int S5Q = 64, S5NC = SEQ / S5Q;
constexpr int SSDQ = 128, SSDNC = SEQ / SSDQ;

enum { I_XP = 0, I_XS, I_CP, I_CS, I_S5RE, I_S5IM, I_SSM, I_SSDCONV, I_FFNCONV, I_WMOD, I_BMOD, I_GMIX, I_WIN, I_LAMRE, I_LAMIM, I_LOGDT,
       I_BRE, I_BIM, I_CRE, I_CIM, I_S5D, I_WGLU, I_GV, I_WS, I_BS, I_CONVW, I_CONVB, I_DTBIAS, I_ALOG, I_SSDD, I_GNORM, I_WPA, I_WPB, I_WPC,
       I_WOUT, I_GFFN, I_WUP, I_FCONVW, I_FCONVB, I_WDOWN, I_GFINAL, N_INPUTS };
constexpr size_t O_YP = 0, O_YS = 16777216, O_S5RP = 17039360, O_S5IP = 17055744, O_SSMP = 17072128, O_CCP = 18120704, O_CFP = 18157568,
                 O_S5RS = 18337792, O_S5IS = 18862080, O_SSMS = 19386368, O_CCS = 52940800, O_CFS = 54120448, O_GVS = 59887616, O_END = 60018688;

constexpr size_t MiB = 1u << 20;
constexpr size_t WS_CTL = 0, CTL_ZERO_BYTES = 1 * MiB;
constexpr size_t SZ_WIN = (size_t)N_INP * DM * 2, SZ_WGLU = 512 * 512 * 2, SZ_WPA = (size_t)DM * 512 * 2, SZ_WPC = (size_t)DM * 1024 * 2,
                 SZ_WOUT = (size_t)DM * DM * 2, SZ_WUP = (size_t)D_UP * DM * 2, SZ_WDOWN = (size_t)DM * D_FF * 2;
constexpr size_t WL_IN = 0, WL_GLU = WL_IN + SZ_WIN, WL_PA = WL_GLU + SZ_WGLU, WL_PB = WL_PA + SZ_WPA, WL_PC = WL_PB + SZ_WPA, WL_OUT = WL_PC + SZ_WPC,
                 WL_UP = WL_OUT + SZ_WOUT, WL_DOWN = WL_UP + SZ_WUP, WL_END = WL_DOWN + SZ_WDOWN;
constexpr size_t WS_W = 2 * MiB;
constexpr size_t WS_SMALL = WS_W + 2 * WL_END;
constexpr size_t SM_WS = 0;
constexpr size_t SM_S5BB = SM_WS + 2 * 8 * 128 * 128 * 2;
constexpr size_t SM_S5CT = SM_S5BB + 2 * 32 * 64 * 32 * 4;
constexpr size_t SM_S5A = SM_S5CT + 2 * 32 * 16 * 128 * 2;
constexpr size_t SM_DT = SM_S5A + 2 * 32 * 64 * 4 * 4;
constexpr size_t SM_VSQ = SM_DT + (size_t)MP * 16 * 4;
constexpr size_t SM_CSQ = SM_VSQ + (size_t)2 * MP * 4;
constexpr size_t SM_SLOC = SM_CSQ + (size_t)2 * MP * 4;
constexpr size_t SM_SDEC = SM_SLOC + (size_t)NB * G_A * S5NC * 128 * 4;
constexpr size_t SM_CSILU = SM_SDEC + 4096;
constexpr size_t SM_WDT = SM_CSILU + 256 * 2048 * 2;
constexpr size_t SM_END = SM_WDT + (size_t)2 * 16 * DM * 4;
constexpr size_t WS_MOD = (WS_SMALL + SM_END + 4095) / 4096 * 4096;
constexpr size_t WS_X0 = WS_MOD + (size_t)2 * 256 * N_MOD * 4;
constexpr size_t WS_X1 = WS_X0 + (size_t)MP * DM * 4;
constexpr size_t WS_H = WS_X1 + (size_t)MP * DM * 4;
constexpr size_t WS_BIG = WS_H + (size_t)MP * DM * 2;
constexpr size_t WS_T = WS_BIG + (size_t)MP * D_UP * 2;
constexpr size_t WS_MERGED = WS_T + (size_t)MP * DM * 4;
constexpr size_t WS_OCAT = WS_MERGED + (size_t)MP * DM * 2;
constexpr int OCP = 2048, OC_A = 0, OC_B = 512, OC_C = 1024;
constexpr size_t WS_YB = WS_OCAT + (size_t)MP * OCP * 2;
constexpr size_t WS_STATES = WS_YB + (size_t)MP * 512 * 2;
constexpr size_t WS_SLAB = WS_STATES + (size_t)NB * SSDNC * H_C * HD_C * N_C * 4;
constexpr size_t WS_HALO = WS_SLAB + (size_t)176 * 131072;
constexpr size_t WS_END = WS_HALO + (size_t)33 * 4 * D_UP * 4;
static_assert((size_t)MP * D_FF * 2 <= (size_t)MP * DM * 6, "ACT overlays T+MERGED");
constexpr int CW_PC = 12288;
constexpr int CW_MODF = 32768;
constexpr int CW_S5F = 20480;
constexpr int CW_SSDF = 16384;
constexpr int CW_BAR = 4096, CW_CNT = 8192;
struct Args { const float* in[N_INPUTS]; float* out; unsigned char* ws; };
typedef const __attribute__((address_space(4))) Args* KArgs;
__device__ __forceinline__ KArgs launder_args(KArgs a) { unsigned long long t = (unsigned long long)a; asm volatile("" : "+s"(t)); return (KArgs)t; }
#define GAS __attribute__((address_space(1)))
#define LAS __attribute__((address_space(3)))
typedef unsigned short bf16;
typedef unsigned v4u __attribute__((ext_vector_type(4)));
typedef unsigned v2u __attribute__((ext_vector_type(2)));
typedef float f32x4 __attribute__((ext_vector_type(4)));
typedef float f32x2 __attribute__((ext_vector_type(2)));
typedef short bf16x8 __attribute__((ext_vector_type(8)));
typedef short bf16x4 __attribute__((ext_vector_type(4)));
typedef GAS unsigned gu32;
#define RLX_AGENT __ATOMIC_RELAXED, __HIP_MEMORY_SCOPE_AGENT
#define LDS_WAIT() asm volatile("s_waitcnt lgkmcnt(0)" ::: "memory")
#define VM_WAIT() asm volatile("s_waitcnt vmcnt(0)" ::: "memory")
constexpr int NWAVES = 8, NTHR = 512, GRID = 256;
__device__ __forceinline__ unsigned f2bf(float f) { unsigned u = __builtin_bit_cast(unsigned, f); return (u + 0x7fffu + ((u >> 16) & 1u)) >> 16; }
__device__ __forceinline__ unsigned pk2(float lo, float hi) { return f2bf(lo) | (f2bf(hi) << 16); }
__device__ __forceinline__ float bf2f(unsigned short b) { return __builtin_bit_cast(float, (unsigned)b << 16); }
__device__ __forceinline__ float bflo(unsigned w) { return __builtin_bit_cast(float, w << 16); }
__device__ __forceinline__ float bfhi(unsigned w) { return __builtin_bit_cast(float, w & 0xffff0000u); }
__device__ __forceinline__ float sigmoidf_(float x) { return __builtin_amdgcn_rcpf(1.0f + __expf(-x)); }
__device__ __forceinline__ float siluf_(float x) { return x * __builtin_amdgcn_rcpf(1.0f + __expf(-x)); }
__device__ __forceinline__ float gelu_tanh(float x) {
    const float u = 0.7978845608028654f * (x + 0.044715f * x * x * x);
    const float e = __expf(2.0f * u);
    const float t = 1.0f - 2.0f * __builtin_amdgcn_rcpf(e + 1.0f);
    return 0.5f * x * (1.0f + t);
}
__device__ __forceinline__ float softplusf_(float x) { return fmaxf(x, 0.f) + __logf(1.0f + __expf(-fabsf(x))); }
template <int M> __device__ __forceinline__ float xor_lt32(float x) {
    return __builtin_bit_cast(float, __builtin_amdgcn_ds_swizzle(__builtin_bit_cast(int, x), (M << 10) | 0x1f)); }
__device__ __forceinline__ float add_xor32(float x) {
    const unsigned b = __builtin_bit_cast(unsigned, x); const auto r = __builtin_amdgcn_permlane32_swap(b, b, false, false);
    return __builtin_bit_cast(float, (unsigned)r[0]) + __builtin_bit_cast(float, (unsigned)r[1]); }
__device__ __forceinline__ float wave_sum(float v) {
    v += xor_lt32<1>(v); v += xor_lt32<2>(v); v += xor_lt32<4>(v); v += xor_lt32<8>(v); v += xor_lt32<16>(v);
    return add_xor32(v);
}
__device__ __forceinline__ float wave_sum16(const float (&a)[16], int lane) {
    float b[8], c[4], d[2];
    const bool o1 = lane & 1, o2 = lane & 2, o4 = lane & 4, o8 = lane & 8;
#pragma unroll
    for (int i = 0; i < 8; ++i) { const float keep = o1 ? a[2 * i + 1] : a[2 * i], send = o1 ? a[2 * i] : a[2 * i + 1]; b[i] = keep + xor_lt32<1>(send); }
#pragma unroll
    for (int i = 0; i < 4; ++i) { const float keep = o2 ? b[2 * i + 1] : b[2 * i], send = o2 ? b[2 * i] : b[2 * i + 1]; c[i] = keep + xor_lt32<2>(send); }
#pragma unroll
    for (int i = 0; i < 2; ++i) { const float keep = o4 ? c[2 * i + 1] : c[2 * i], send = o4 ? c[2 * i] : c[2 * i + 1]; d[i] = keep + xor_lt32<4>(send); }
    const float keep = o8 ? d[1] : d[0], send = o8 ? d[0] : d[1];
    float e = keep + xor_lt32<8>(send);
    e += xor_lt32<16>(e);
    return add_xor32(e);
}
__device__ __forceinline__ float half_sum32(const float (&a)[32], int lane) {
    float b[16], c[8], d[4], e[2];
    const bool o1 = lane & 1, o2 = lane & 2, o4 = lane & 4, o8 = lane & 8, o16 = lane & 16;
#pragma unroll
    for (int i = 0; i < 16; ++i) { const float keep = o1 ? a[2 * i + 1] : a[2 * i], send = o1 ? a[2 * i] : a[2 * i + 1]; b[i] = keep + xor_lt32<1>(send); }
#pragma unroll
    for (int i = 0; i < 8; ++i) { const float keep = o2 ? b[2 * i + 1] : b[2 * i], send = o2 ? b[2 * i] : b[2 * i + 1]; c[i] = keep + xor_lt32<2>(send); }
#pragma unroll
    for (int i = 0; i < 4; ++i) { const float keep = o4 ? c[2 * i + 1] : c[2 * i], send = o4 ? c[2 * i] : c[2 * i + 1]; d[i] = keep + xor_lt32<4>(send); }
#pragma unroll
    for (int i = 0; i < 2; ++i) { const float keep = o8 ? d[2 * i + 1] : d[2 * i], send = o8 ? d[2 * i] : d[2 * i + 1]; e[i] = keep + xor_lt32<8>(send); }
    const float keep = o16 ? e[1] : e[0], send = o16 ? e[0] : e[1];
    return keep + xor_lt32<16>(send);
}
__device__ __forceinline__ float lane_bcast(float x, int src) {
    return __builtin_bit_cast(float, __builtin_amdgcn_readlane(__builtin_bit_cast(int, x), src)); }
__device__ __forceinline__ int mod_row(int r) { return r < MPROMPT ? (r >> 11) : (r < MREAL ? 4 + (r - MPROMPT) : 4 + NS - 1); }

template <int MODE, bool SRC32 = false>
__device__ __forceinline__ void prep_row(const void* xrow, const float* g, const float* mr, int sh_idx, int sc_idx, bf16* hrow, float* yrow, float* dtrow, const LAS float* wT, int lane) {
    f32x4 v[8]; float s = 0.f;
    if (SRC32) { const GAS f32x4* xr = (const GAS f32x4*)xrow + lane;
#pragma unroll
        for (int j = 0; j < 8; ++j) v[j] = xr[64 * j];
    } else { const GAS v2u* xr = (const GAS v2u*)xrow + lane;
#pragma unroll
        for (int j = 0; j < 8; ++j) { const v2u w = xr[64 * j]; v[j] = (f32x4){bflo(w.x), bfhi(w.x), bflo(w.y), bfhi(w.y)}; } }
#pragma unroll
    for (int j = 0; j < 8; ++j) s += (v[j].x * v[j].x + v[j].y * v[j].y) + (v[j].z * v[j].z + v[j].w * v[j].w);
    const float rinv = rsqrtf(wave_sum(s) * (1.0f / DM) + EPS);
    const GAS f32x4* gp = (const GAS f32x4*)g + lane;
    if (MODE == 2) { GAS f32x4* o = (GAS f32x4*)yrow + lane;
#pragma unroll
        for (int j = 0; j < 8; ++j) o[64 * j] = v[j] * rinv * gp[64 * j];
        return; }
    const GAS f32x4* shp = (const GAS f32x4*)(mr + sh_idx * DM) + lane; const GAS f32x4* scp = (const GAS f32x4*)(mr + sc_idx * DM) + lane;
    GAS v2u* o = (GAS v2u*)hrow + lane;
#pragma unroll
    for (int j = 0; j < 8; ++j) { const f32x4 gg = gp[64 * j], sh = shp[64 * j], sc = scp[64 * j];
        v[j] = v[j] * rinv * gg * (sc + 1.0f) + sh;
        v2u w; w.x = pk2(v[j].x, v[j].y); w.y = pk2(v[j].z, v[j].w); o[64 * j] = w; if (SRC32 && (j & 1)) asm volatile("" ::: "memory"); }
    if (MODE == 1) {
        float a16[16];
        if (SRC32) asm volatile("" ::: "memory");
#pragma unroll
        for (int hh = 0; hh < 16; ++hh) { float a = 0.f;
#pragma unroll
            for (int j = 0; j < 8; ++j) { const f32x4 w = *(const LAS f32x4*)(wT + hh * DM + 4 * lane + 256 * j); a += (v[j].x * w.x + v[j].y * w.y) + (v[j].z * w.z + v[j].w * w.w); }
            a16[hh] = a; if (SRC32) asm volatile("" ::: "memory"); }
        const float mine = wave_sum16(a16, lane);
        if (lane < 16) dtrow[lane] = mine;
    }
}

template <int MODE, bool SRC32 = false, int NQ = 4>
__device__ __forceinline__ void prep_rows4(const void* x0, const float* g, const float* mr, int sh_idx, int sc_idx, bf16* h0, float* y0, float* dt0, const LAS float* wT, int lane) {
    f32x4 v[NQ][8];
#pragma unroll
    for (int q = 0; q < NQ; ++q) {
        if (SRC32) { const GAS f32x4* xr = (const GAS f32x4*)((const float*)x0 + (size_t)q * DM) + lane;
#pragma unroll
            for (int j = 0; j < 8; ++j) v[q][j] = xr[64 * j];
        } else { const GAS v2u* xr = (const GAS v2u*)((const bf16*)x0 + (size_t)q * DM) + lane;
#pragma unroll
            for (int j = 0; j < 8; ++j) { const v2u w = xr[64 * j]; v[q][j] = (f32x4){bflo(w.x), bfhi(w.x), bflo(w.y), bfhi(w.y)}; } } }
    f32x4 gm[8], sh[8];
    {   const GAS f32x4* gp = (const GAS f32x4*)g + lane;
        if (MODE == 2) {
#pragma unroll
            for (int j = 0; j < 8; ++j) gm[j] = gp[64 * j];
        } else { const GAS f32x4* shp = (const GAS f32x4*)(mr + sh_idx * DM) + lane; const GAS f32x4* scp = (const GAS f32x4*)(mr + sc_idx * DM) + lane;
#pragma unroll
            for (int j = 0; j < 8; ++j) { gm[j] = gp[64 * j] * (scp[64 * j] + 1.0f); sh[j] = shp[64 * j]; } } }
#pragma unroll
    for (int q = 0; q < NQ; ++q) { float s = 0.f;
#pragma unroll
        for (int j = 0; j < 8; ++j) s += (v[q][j].x * v[q][j].x + v[q][j].y * v[q][j].y) + (v[q][j].z * v[q][j].z + v[q][j].w * v[q][j].w);
        const float rinv = rsqrtf(wave_sum(s) * (1.0f / DM) + EPS);
        if (MODE == 2) { GAS f32x4* o = (GAS f32x4*)(y0 + (size_t)q * DM) + lane;
#pragma unroll
            for (int j = 0; j < 8; ++j) o[64 * j] = v[q][j] * rinv * gm[j];
        } else { GAS v2u* o = (GAS v2u*)(h0 + (size_t)q * DM) + lane;
#pragma unroll
            for (int j = 0; j < 8; ++j) { v[q][j] = v[q][j] * rinv * gm[j] + sh[j]; v2u w; w.x = pk2(v[q][j].x, v[q][j].y); w.y = pk2(v[q][j].z, v[q][j].w); o[64 * j] = w; }
        }
    }
    if (MODE == 1) {
#pragma unroll
        for (int pr = 0; pr < NQ / 2; ++pr) { float a16[2][16];
#pragma unroll
            for (int hh = 0; hh < 16; ++hh) { float a0 = 0.f, a1 = 0.f;
#pragma unroll
                for (int j = 0; j < 8; ++j) { const f32x4 w = *(const LAS f32x4*)(wT + hh * DM + 4 * lane + 256 * j);
                    a0 += (v[2 * pr][j].x * w.x + v[2 * pr][j].y * w.y) + (v[2 * pr][j].z * w.z + v[2 * pr][j].w * w.w);
                    a1 += (v[2 * pr + 1][j].x * w.x + v[2 * pr + 1][j].y * w.y) + (v[2 * pr + 1][j].z * w.z + v[2 * pr + 1][j].w * w.w); }
                a16[0][hh] = a0; a16[1][hh] = a1; if (SRC32 && (hh & 1) == 1) asm volatile("" ::: "memory"); }
            { const float m0 = wave_sum16(a16[0], lane), m1 = wave_sum16(a16[1], lane); if (lane < 16) { dt0[(2 * pr) * 16 + lane] = m0; dt0[(2 * pr + 1) * 16 + lane] = m1; } } }
    }
}
#define XB_TMO      128
#define XB_XCNT(j)  (256  + 64 * (j))
#define XB_XSUB(j)  (1280 + 64 * (j))
#define XB_XGEN(j)  (2304 + 64 * (j))
#define XB_TOP      3328
#define XB_TOPGEN   3392
#define XCD_BAR_WORDS 3456
#define XB_SPIN_CAP (1u << 18)

__device__ __forceinline__ unsigned xb_ld(unsigned* p)              { return __hip_atomic_load(p, __ATOMIC_RELAXED, __HIP_MEMORY_SCOPE_AGENT); }
__device__ __forceinline__ unsigned xb_add(unsigned* p, unsigned v) { return __hip_atomic_fetch_add(p, v, __ATOMIC_RELAXED, __HIP_MEMORY_SCOPE_AGENT); }
__device__ __forceinline__ unsigned xb_xcc_id() { return (unsigned)__builtin_amdgcn_s_getreg((3 << 11) | 20) & 0xFu; }
#define XB_SPIN(cond, bar) do { unsigned _sp = 0; while (cond) { __builtin_amdgcn_s_sleep(1); \
    if ((++_sp & 255u) == 0u) { if (xb_ld(&(bar)[XB_TMO])) break; if (_sp > XB_SPIN_CAP) { atomicAdd(&(bar)[XB_TMO], 1u); break; } } } } while (0)

struct XcdBarrier {
    unsigned* bar; unsigned x;
    volatile LAS unsigned* st;
};

__device__ __forceinline__ XcdBarrier xcd_barrier_post(unsigned* bar, volatile LAS unsigned* st) {
    XcdBarrier b; b.bar = bar; b.x = xb_xcc_id(); b.st = st;
    if (threadIdx.x == 0) (void)xb_add(&bar[XB_XCNT(b.x)], 1u);
    return b;
}
__device__ __forceinline__ void xcd_barrier_complete(unsigned* bar, unsigned x, unsigned& nloc, unsigned& nx) {
    const unsigned G = gridDim.x * gridDim.y * gridDim.z;
    unsigned sum, cnt, mine, sp = 0u;
    for (;;) {
        sum = 0u; cnt = 0u; mine = 0u;
#pragma unroll
        for (unsigned j = 0; j < 16; ++j) { const unsigned c = xb_ld(&bar[XB_XCNT(j)]); sum += c; cnt += (c > 0u) ? 1u : 0u; mine = (j == x) ? c : mine; }
        if (sum == G) break;
        __builtin_amdgcn_s_sleep(1);
        if ((++sp & 255u) == 0u) { if (xb_ld(&bar[XB_TMO])) break; if (sp > XB_SPIN_CAP) { atomicAdd(&bar[XB_TMO], 1u); break; } }
    }
    nloc = mine > 0u ? mine : 1u; nx = cnt > 0u ? cnt : 1u;
}

__device__ __forceinline__ void xcd_barrier(const XcdBarrier& b) {
    asm volatile("s_waitcnt vmcnt(0)" ::: "memory");
    __syncthreads();
    if (threadIdx.x == 0) {
        unsigned* bar = b.bar;
        __builtin_amdgcn_s_waitcnt(0);
        unsigned nloc = b.st[0], nx = b.st[1];
        if (nloc == 0u) { xcd_barrier_complete(bar, b.x, nloc, nx); b.st[0] = nloc; b.st[1] = nx; }
        const unsigned old = xb_add(&bar[XB_XSUB(b.x)], 1u);
        const unsigned gen = old / nloc;
        if (old + 1u == (gen + 1u) * nloc) {
            __builtin_amdgcn_fence(__ATOMIC_RELEASE, "agent");
            asm volatile("s_waitcnt vmcnt(0)" ::: "memory");
            const unsigned og = xb_add(&bar[XB_TOP], 1u);
            const unsigned tg = og / nx;
            if (og + 1u == (tg + 1u) * nx) xb_add(&bar[XB_TOPGEN], 1u);
            else XB_SPIN(xb_ld(&bar[XB_TOPGEN]) == tg, bar);
            __builtin_amdgcn_fence(__ATOMIC_ACQUIRE, "agent");
            xb_add(&bar[XB_XGEN(b.x)], 1u);
            asm volatile("s_waitcnt vmcnt(0)" ::: "memory");
        } else {
            XB_SPIN(xb_ld(&bar[XB_XGEN(b.x)]) == gen, bar);
            __builtin_amdgcn_fence(__ATOMIC_ACQUIRE, "agent");
            asm volatile("s_waitcnt vmcnt(0)" ::: "memory");
        }
    }
    __syncthreads();
}

namespace epi {
using pg8::Unit; using pg8::f32x4; using pg8::u32x4; using pg8::cvt_pk_bf16;
typedef unsigned u32x2 __attribute__((ext_vector_type(2)));
constexpr int BM = 256, HALF = 128;

constexpr int SLAB_F4 = 8 * 16 * 64;
constexpr int SLAB_BYTES_ALL = 176 * 131072;
typedef unsigned v4u_ __attribute__((ext_vector_type(4)));
template <bool PERM> __device__ __forceinline__ int split_col(const Unit& u, int wc, int fq, int bj, int n) { return u.pn * BM + bj * HALF + wc * 32 + (PERM ? 8 * fq + 4 * n : 16 * n + 4 * fq); }
__device__ __forceinline__ __amdgpu_buffer_rsrc_t slab_rsrc(const f32x4* SLAB) { return __builtin_amdgcn_make_buffer_rsrc((void*)SLAB, (short)0, SLAB_BYTES_ALL, 0x00020000); }
__device__ __forceinline__ void split_store(const f32x4 (&acc)[2][2][4][2], f32x4* SLAB, int sid, int wid, int lane) {
    asm volatile("" : "+v"(lane));
    const __amdgpu_buffer_rsrc_t rs = slab_rsrc(SLAB);
    const unsigned vo = (unsigned)(wid * 16 * 64 + lane) * 16u, so = (unsigned)sid * (unsigned)(SLAB_F4 * 16);
#pragma unroll
    for (int m = 0; m < 4; ++m)
#pragma unroll
        for (int bj = 0; bj < 2; ++bj)
#pragma unroll
            for (int n = 0; n < 2; ++n) __builtin_amdgcn_raw_buffer_store_b128(__builtin_bit_cast(v4u_, acc[0][bj][m][n]), rs, vo + (unsigned)(((m * 2 + bj) * 2 + n) * 64 * 16), so,   16);
}
__device__ __forceinline__ bool split_arrive(unsigned* cnt, unsigned target, int lane) {
    asm volatile("s_waitcnt vmcnt(0)" ::: "memory");
    unsigned old = 0u;
    if (lane == 0) old = __hip_atomic_fetch_add(cnt, 1u, __ATOMIC_RELAXED, __HIP_MEMORY_SCOPE_AGENT);
    old = __builtin_amdgcn_readlane(old, 0);
    asm volatile("" ::: "memory");
    if (old != target - 1u) return false;
    __builtin_amdgcn_fence(__ATOMIC_ACQUIRE, "agent"); asm volatile("s_waitcnt vmcnt(0)" ::: "memory");
    return true;
}
__device__ __forceinline__ f32x4 slab_ld(const __amdgpu_buffer_rsrc_t rs, unsigned vo, unsigned so) { return __builtin_bit_cast(f32x4, __builtin_amdgcn_raw_buffer_load_b128(rs, vo, so,   16)); }
__device__ __forceinline__ f32x4 split_sum1(const f32x4* SLAB, int sid0, int ns, int wid, int lane, int reg) {
    const __amdgpu_buffer_rsrc_t rs = slab_rsrc(SLAB);
    const unsigned vo = (unsigned)((wid * 16 + reg) * 64 + lane) * 16u;
    f32x4 s = slab_ld(rs, vo, (unsigned)sid0 * (unsigned)(SLAB_F4 * 16));
    for (int j = 1; j < ns; ++j) s = s + slab_ld(rs, vo, (unsigned)(sid0 + j) * (unsigned)(SLAB_F4 * 16));
    return s;
}
__device__ __forceinline__ void split_sum(f32x4 (&acc)[2][2][4][2], const f32x4* SLAB, int sid0, int ns, int wid, int lane, int mmask = 15) {
    asm volatile("" : "+v"(lane));
    const __amdgpu_buffer_rsrc_t rs = slab_rsrc(SLAB);
    const unsigned vo = (unsigned)(wid * 16 * 64 + lane) * 16u;
#pragma unroll
    for (int m = 0; m < 4; ++m) { if (!((mmask >> m) & 1)) continue;
#pragma unroll
        for (int bj = 0; bj < 2; ++bj) {
            const unsigned vr = vo + (unsigned)((m * 2 + bj) * 2) * 1024u;
            unsigned so = (unsigned)sid0 * (unsigned)(SLAB_F4 * 16);
            f32x4 s0 = {0.f, 0.f, 0.f, 0.f}, s1 = s0;
            int j = 0;
#pragma unroll 1
            for (; j + 4 <= ns; j += 4) {
                f32x4 t[4][2];
#pragma unroll
                for (int q = 0; q < 4; ++q) { const unsigned sq = so + (unsigned)q * (unsigned)(SLAB_F4 * 16); t[q][0] = slab_ld(rs, vr, sq); t[q][1] = slab_ld(rs, vr + 1024u, sq); }
#pragma unroll
                for (int q = 0; q < 4; ++q) { s0 = s0 + t[q][0]; s1 = s1 + t[q][1]; }
                so += 4u * (unsigned)(SLAB_F4 * 16); }
            if (j < ns) {
                f32x4 t[3][2];
#pragma unroll
                for (int q = 0; q < 3; ++q) { const unsigned sq = so + (unsigned)q * (unsigned)(SLAB_F4 * 16);
                    if (j + q < ns) { t[q][0] = slab_ld(rs, vr, sq); t[q][1] = slab_ld(rs, vr + 1024u, sq); } else { t[q][0] = (f32x4){0.f, 0.f, 0.f, 0.f}; t[q][1] = t[q][0]; } }
#pragma unroll
                for (int q = 0; q < 3; ++q) { s0 = s0 + t[q][0]; s1 = s1 + t[q][1]; } }
            acc[0][bj][m][0] = s0; acc[0][bj][m][1] = s1;
            asm volatile("" ::: "memory");
        } }
}
__device__ __forceinline__ void split_zero_pad(f32x4 (&acc)[2][2][4][2]) {
#pragma unroll
    for (int bj = 0; bj < 2; ++bj)
#pragma unroll
        for (int m = 0; m < 4; ++m)
#pragma unroll
            for (int n = 0; n < 2; ++n) acc[1][bj][m][n] = (f32x4){0.f, 0.f, 0.f, 0.f};
}
struct SplitCtl { f32x4* SLAB; unsigned* cnt; unsigned nsl; int fin0, cbase, parts; };
__device__ __forceinline__ void split_post(unsigned* cnt, int lane) {
    asm volatile("s_waitcnt vmcnt(0)" ::: "memory");
    if (lane == 0) __hip_atomic_fetch_add(cnt, 1u, __ATOMIC_RELAXED, __HIP_MEMORY_SCOPE_AGENT);
}
__device__ __forceinline__ void split_wait(unsigned* cnt, unsigned target, int lane) {
    if (lane == 0) { unsigned sp_ = 0; while (__hip_atomic_load(cnt, __ATOMIC_RELAXED, __HIP_MEMORY_SCOPE_AGENT) < target && ++sp_ < (1u << 22)) __builtin_amdgcn_s_sleep(2); }
    asm volatile("" ::: "memory");
    __builtin_amdgcn_fence(__ATOMIC_ACQUIRE, "agent"); asm volatile("s_waitcnt vmcnt(0)" ::: "memory");
}
__device__ __forceinline__ int part_mask(int p, int parts) { const int w = 4 / parts; return ((1 << w) - 1) << (p * w); }
__device__ __forceinline__ int opaque_bx() { int b = (int)blockIdx.x; asm volatile("" : "+s"(b)); return b; }
__device__ __forceinline__ Unit final_unit(int f, int cbase) { Unit u; u.pm = MPROMPT / 256; u.pn = f; u.k0 = 0; u.nt = 0; u.cidx = cbase + f; u.sid = 0; return u; }

struct EpiIn {
    static constexpr bool PERM = true, AFTER_DRAIN = false, HOOK = false;
    bf16* O; float* vsq; SplitCtl sp;
    template <int ACT> __device__ __forceinline__ void run(const f32x4 (&acc)[2][2][4][2], const Unit& u, int wr, int wc, int fr, int fq, bool dosq, int mmask, int nai) const {
        const int row0 = u.pm * BM + wr * 64 + fr, col0 = u.pn * BM + wc * 32 + 8 * fq;
#pragma unroll
        for (int ai = 0; ai < 2; ++ai) { if (ai >= nai) break;
#pragma unroll
            for (int m = 0; m < 4; ++m) { if (!((mmask >> m) & 1)) continue; const int row = row0 + ai * HALF + m * 16; bf16* rowp = O + (size_t)row * N_INP + col0; float sq = 0.f;
#pragma unroll
                for (int bj = 0; bj < 2; ++bj) { f32x4 v0 = acc[ai][bj][m][0], v1 = acc[ai][bj][m][1];
#pragma unroll
                    for (int j = 0; j < 4; ++j) {
                        if (ACT == 1) { v0[j] = gelu_tanh(v0[j]); v1[j] = gelu_tanh(v1[j]); }
                        if (ACT == 2) { v0[j] = sigmoidf_(v0[j]); v1[j] = sigmoidf_(v1[j]); }
                        sq += v0[j] * v0[j] + v1[j] * v1[j]; }
                    u32x4 w; w.x = cvt_pk_bf16(v0[0], v0[1]); w.y = cvt_pk_bf16(v0[2], v0[3]); w.z = cvt_pk_bf16(v1[0], v1[1]); w.w = cvt_pk_bf16(v1[2], v1[3]);
                    *(GAS u32x4*)(rowp + bj * HALF) = w; }
                if (ACT == 1) { if (dosq && vsq) { sq += xor_lt32<16>(sq); sq = add_xor32(sq); if (fq == 0) atomicAdd(vsq + row, sq); } }
            } }
    }
    __device__ __forceinline__ void apply(const f32x4 (&acc)[2][2][4][2], const Unit& u, int wr, int wc, int fr, int fq, int mmask, int nai) const {
        const int pn = u.pn;
        if (pn >= 16) run<2>(acc, u, wr, wc, fr, fq, false, mmask, nai);
        else if (pn >= 2 && pn < 6) run<1>(acc, u, wr, wc, fr, fq, pn >= 4, mmask, nai);
        else run<0>(acc, u, wr, wc, fr, fq, false, mmask, nai);
    }
    __device__ __forceinline__ void operator()(const f32x4 (&acc)[2][2][4][2], const Unit& u, int wr, int wc, int fr, int fq) const { apply(acc, u, wr, wc, fr, fq, 15, 2); }
    __device__ __forceinline__ void partial(f32x4 (&acc)[2][2][4][2], const Unit& u, int wr, int wc, int fr, int fq, int wid, int lane) const {
        split_store(acc, sp.SLAB, u.sid, wid, lane); split_post(sp.cnt + u.cidx * 8 + wid, lane);
    }
    __device__ __forceinline__ void final(const Unit& u, int wr, int wc, int fr, int fq, int wid, int lane, int mmask) const {
        f32x4 acc[2][2][4][2];
        split_wait(sp.cnt + u.cidx * 8 + wid, sp.nsl, lane);
        split_sum(acc, sp.SLAB, u.pn * (int)sp.nsl, (int)sp.nsl, wid, lane, mmask); apply(acc, u, wr, wc, fr, fq, mmask, 1);
    }
};
struct EpiBf16Plain {
    static constexpr bool PERM = true, AFTER_DRAIN = false, HOOK = false;
    bf16* O; int ldc;
    __device__ __forceinline__ void partial(f32x4 (&)[2][2][4][2], const Unit&, int, int, int, int, int, int) const {}
    __device__ __forceinline__ void operator()(const f32x4 (&acc)[2][2][4][2], const Unit& u, int wr, int wc, int fr, int fq) const {
        const int row0 = u.pm * BM + wr * 64 + fr, col0 = u.pn * BM + wc * 32 + 8 * fq;
#pragma unroll
        for (int ai = 0; ai < 2; ++ai)
#pragma unroll
            for (int m = 0; m < 4; ++m) { bf16* rowp = O + (size_t)(row0 + ai * HALF + m * 16) * ldc + col0;
#pragma unroll
                for (int bj = 0; bj < 2; ++bj) { const f32x4 v0 = acc[ai][bj][m][0], v1 = acc[ai][bj][m][1];
                    u32x4 w; w.x = cvt_pk_bf16(v0[0], v0[1]); w.y = cvt_pk_bf16(v0[2], v0[3]); w.z = cvt_pk_bf16(v1[0], v1[1]); w.w = cvt_pk_bf16(v1[2], v1[3]);
                    *(GAS u32x4*)(rowp + bj * HALF) = w; } }
    }
};
__device__ __forceinline__ float dpp_ror1(float x) { return __builtin_bit_cast(float, __builtin_amdgcn_update_dpp(0, __builtin_bit_cast(int, x), 0x121, 0xf, 0xf, false)); }
__device__ __forceinline__ float dpp_ror2(float x) { return __builtin_bit_cast(float, __builtin_amdgcn_update_dpp(0, __builtin_bit_cast(int, x), 0x122, 0xf, 0xf, false)); }
__device__ __forceinline__ float dpp_shr1(float old, float x) { return __builtin_bit_cast(float, __builtin_amdgcn_update_dpp(__builtin_bit_cast(int, old), __builtin_bit_cast(int, x), 0x111, 0xf, 0xf, false)); }
__device__ __forceinline__ float dpp_shr2(float old, float x) { return __builtin_bit_cast(float, __builtin_amdgcn_update_dpp(__builtin_bit_cast(int, old), __builtin_bit_cast(int, x), 0x112, 0xf, 0xf, false)); }
struct EpiUpConv {
    static constexpr bool PERM = true, AFTER_DRAIN = false, HOOK = false;
    bf16* ACT; float* HALO; const float* cw; const float* cb; const float* st; float* cfs; LAS float* EX; int dry;
    __device__ __forceinline__ void partial(f32x4 (&)[2][2][4][2], const Unit&, int, int, int, int, int, int) const {}
    __device__ __forceinline__ void operator()(const f32x4 (&acc)[2][2][4][2], const Unit& u, int wr, int wc, int fr, int fq) const {
        asm volatile("" : "+v"(fr), "+v"(fq));
        if (dry) {
#pragma unroll
            for (int ai = 0; ai < 2; ++ai)
#pragma unroll
                for (int bj = 0; bj < 2; ++bj)
#pragma unroll
                    for (int m = 0; m < 4; ++m)
#pragma unroll
                        for (int n = 0; n < 2; ++n) asm volatile("" :: "v"(acc[ai][bj][m][n]));
            return; }
        const int cl = wc * 32 + 8 * fq;
        if (u.pm == MPROMPT / 256) {
#pragma unroll
            for (int n = 0; n < 2; ++n) { const int c = u.pn * 128 + cl + 4 * n;
                f32x4 wa0, wa1, wa2, wb0, wb1, wb2, ba, bb;
                wa0 = *(const GAS f32x4*)(cw + c); wa1 = *(const GAS f32x4*)(cw + D_UP + c); wa2 = *(const GAS f32x4*)(cw + 2 * D_UP + c); wb0 = *(const GAS f32x4*)(cw + D_FF + c); wb1 = *(const GAS f32x4*)(cw + D_UP + D_FF + c); wb2 = *(const GAS f32x4*)(cw + 2 * D_UP + D_FF + c);
                ba = *(const GAS f32x4*)(cb + c); bb = *(const GAS f32x4*)(cb + D_FF + c);
#pragma unroll
                for (int m = 0; m < 4; ++m) { const int s = wr * 64 + m * 16 + fr; const float* sp = st + (size_t)s * 2 * D_UP; float* op = cfs + (size_t)s * 2 * D_UP;
                    const f32x4 a2 = *(const GAS f32x4*)(sp + c), a1 = *(const GAS f32x4*)(sp + D_UP + c), b2 = *(const GAS f32x4*)(sp + D_FF + c), b1 = *(const GAS f32x4*)(sp + D_UP + D_FF + c);
                    const f32x4 ua = acc[0][0][m][n], ub = acc[0][1][m][n];
                    *(GAS f32x4*)(op + c) = a1; *(GAS f32x4*)(op + D_FF + c) = b1; *(GAS f32x4*)(op + D_UP + c) = ua; *(GAS f32x4*)(op + D_UP + D_FF + c) = ub;
                    const f32x4 ca = ba + wa0 * a2 + wa1 * a1 + wa2 * ua, cbv = bb + wb0 * b2 + wb1 * b1 + wb2 * ub;
                    u32x2 w; w.x = cvt_pk_bf16(siluf_(ca[0]) * cbv[0], siluf_(ca[1]) * cbv[1]); w.y = cvt_pk_bf16(siluf_(ca[2]) * cbv[2], siluf_(ca[3]) * cbv[3]);
                    *(GAS u32x2*)(ACT + (size_t)(MPROMPT + s) * D_FF + c) = w; }
                asm volatile("" ::: "memory"); }
            return;
        }
        f32x4 wts[2][8];
#pragma unroll
        for (int n = 0; n < 2; ++n) { const int c = u.pn * 128 + cl + 4 * n;
            wts[n][0] = *(const GAS f32x4*)(cw + c); wts[n][1] = *(const GAS f32x4*)(cw + D_UP + c); wts[n][2] = *(const GAS f32x4*)(cw + 2 * D_UP + c);
            wts[n][3] = *(const GAS f32x4*)(cw + D_FF + c); wts[n][4] = *(const GAS f32x4*)(cw + D_UP + D_FF + c); wts[n][5] = *(const GAS f32x4*)(cw + 2 * D_UP + D_FF + c);
            wts[n][6] = *(const GAS f32x4*)(cb + c); wts[n][7] = *(const GAS f32x4*)(cb + D_FF + c); }
        if (fr >= 14) {
#pragma unroll
            for (int ai = 0; ai < 2; ++ai)
#pragma unroll
                for (int bj = 0; bj < 2; ++bj)
#pragma unroll
                    for (int n = 0; n < 2; ++n) *(LAS f32x4*)(EX + ((ai * 2 + wr) * 2 + (fr - 14)) * 256 + bj * 128 + cl + 4 * n) = acc[ai][bj][3][n];
            if (wr == 1) {
#pragma unroll
                for (int bj = 0; bj < 2; ++bj)
#pragma unroll
                    for (int n = 0; n < 2; ++n) *(GAS f32x4*)(HALO + ((size_t)u.pm * 4 + 2 + (fr - 14)) * D_UP + u.pn * 256 + bj * 128 + cl + 4 * n) = acc[1][bj][3][n]; }
        }
        if (fr < 2 && wr == 0) {
#pragma unroll
            for (int bj = 0; bj < 2; ++bj)
#pragma unroll
                for (int n = 0; n < 2; ++n) *(GAS f32x4*)(HALO + ((size_t)u.pm * 4 + fr) * D_UP + u.pn * 256 + bj * 128 + cl + 4 * n) = acc[0][bj][0][n]; }
        asm volatile("s_waitcnt lgkmcnt(0)" ::: "memory"); __builtin_amdgcn_s_barrier(); asm volatile("" ::: "memory");
#pragma unroll
        for (int n = 0; n < 2; ++n) { const int c = u.pn * 128 + cl + 4 * n;
            const f32x4 wa0 = wts[n][0], wa1 = wts[n][1], wa2 = wts[n][2], wb0 = wts[n][3], wb1 = wts[n][4], wb2 = wts[n][5], ba = wts[n][6], bb = wts[n][7];
#pragma unroll
            for (int ai = 0; ai < 2; ++ai)
#pragma unroll
                for (int m = 0; m < 4; ++m) {
                    f32x4 cv[2];
#pragma unroll
                    for (int bj = 0; bj < 2; ++bj) { const f32x4 cur = acc[ai][bj][m][n]; f32x4 pb;
                        if (m > 0) pb = acc[ai][bj][m - 1][n];
                        else { pb = (f32x4){0.f, 0.f, 0.f, 0.f};
                            const int sa = wr == 1 ? ai : 0, sw = wr == 1 ? 0 : 1; const bool have = (wr == 1) || (ai == 1);
                            if (have && fr >= 14) pb = *(const LAS f32x4*)(EX + ((sa * 2 + sw) * 2 + (fr - 14)) * 256 + bj * 128 + cl + 4 * n); }
                        f32x4 x1, x2;
#pragma unroll
                        for (int j = 0; j < 4; ++j) { x1[j] = dpp_shr1(dpp_ror1(pb[j]), cur[j]); x2[j] = dpp_shr2(dpp_ror2(pb[j]), cur[j]); }
                        cv[bj] = bj == 0 ? ba + wa0 * x2 + wa1 * x1 + wa2 * cur : bb + wb0 * x2 + wb1 * x1 + wb2 * cur; }
                    u32x2 w; w.x = cvt_pk_bf16(siluf_(cv[0][0]) * cv[1][0], siluf_(cv[0][1]) * cv[1][1]); w.y = cvt_pk_bf16(siluf_(cv[0][2]) * cv[1][2], siluf_(cv[0][3]) * cv[1][3]);
                    *(GAS u32x2*)(ACT + (size_t)(u.pm * BM + ai * HALF + wr * 64 + m * 16 + fr) * D_FF + c) = w; }
            asm volatile("" ::: "memory"); }
    }
};
struct EpiGlu {
    static constexpr bool PERM = true, AFTER_DRAIN = false, HOOK = false;
    const bf16* Y; bf16* O;
    __device__ __forceinline__ void partial(f32x4 (&)[2][2][4][2], const Unit&, int, int, int, int, int, int) const {}
    __device__ __forceinline__ void operator()(const f32x4 (&acc)[2][2][4][2], const Unit& u, int wr, int wc, int fr, int fq) const {
        const int row0 = u.pm * BM + wr * 64 + fr, col0 = u.pn * BM + wc * 32 + 8 * fq;
#pragma unroll
        for (int ai = 0; ai < 2; ++ai)
#pragma unroll
            for (int m = 0; m < 4; ++m) { const size_t off = (size_t)(row0 + ai * HALF + m * 16) * 512 + col0, offo = (size_t)(row0 + ai * HALF + m * 16) * OCP + col0;
#pragma unroll
                for (int bj = 0; bj < 2; ++bj) { const f32x4 v0 = acc[ai][bj][m][0], v1 = acc[ai][bj][m][1];
                    const u32x4 y = *(const GAS u32x4*)(Y + off + bj * HALF);
                    u32x4 w;
                    w.x = cvt_pk_bf16(bflo(y.x) * sigmoidf_(v0[0]), bfhi(y.x) * sigmoidf_(v0[1]));
                    w.y = cvt_pk_bf16(bflo(y.y) * sigmoidf_(v0[2]), bfhi(y.y) * sigmoidf_(v0[3]));
                    w.z = cvt_pk_bf16(bflo(y.z) * sigmoidf_(v1[0]), bfhi(y.z) * sigmoidf_(v1[1]));
                    w.w = cvt_pk_bf16(bflo(y.w) * sigmoidf_(v1[2]), bfhi(y.w) * sigmoidf_(v1[3]));
                    *(GAS u32x4*)(O + offo + bj * HALF) = w; } }
    }
};
#ifndef MERGE_MB
#define MERGE_MB 4
#endif
template <int MODE> struct EpiMerge {
    static constexpr bool PERM = false, AFTER_DRAIN = false, HOOK = false;
    const bf16* G;
    float* T; bf16* MG; const float* csq;
    f32x4* SLAB; const bf16* PRJ; unsigned* cnt;
    __device__ __forceinline__ void partial(f32x4 (&acc)[2][2][4][2], const Unit& u, int wr, int wc, int fr, int fq, int wid, int lane) const {
        split_store(acc, SLAB, u.sid, wid, lane); split_post(cnt + u.cidx * 8 + wid, lane);
    }
    __device__ __forceinline__ void final(const Unit& u, int wr, int wc, int fr, int fq, int wid, int lane, int mmask) const {
        split_wait(cnt + u.cidx * 8 + wid, 8u, lane);
        asm volatile("" : "+v"(fr), "+v"(fq), "+v"(lane));
#pragma unroll
        for (int m = 0; m < 4; ++m) { if (!((mmask >> m) & 1)) continue; const int r = wr * 64 + m * 16 + fr, row = MPROMPT + r; const float rs = rsqrtf(csq[row] * (1.0f / 1024.0f) + EPS);
            const __amdgpu_buffer_rsrc_t rs_ = slab_rsrc(SLAB);
#pragma unroll
            for (int bj = 0; bj < 2; ++bj) {
                f32x4 sa[2], sb[2], sc[2];
                {   f32x4 la[2][2], lb[2][2], lc[2][4];
#pragma unroll
                    for (int n = 0; n < 2; ++n) { const unsigned vo = (unsigned)((wid * 16 + (m * 2 + bj) * 2 + n) * 64 + lane) * 16u;
#pragma unroll
                        for (int j = 0; j < 2; ++j) { la[n][j] = slab_ld(rs_, vo, (unsigned)(u.pn * 2 + j) * (unsigned)(SLAB_F4 * 16)); lb[n][j] = slab_ld(rs_, vo, (unsigned)(16 + u.pn * 2 + j) * (unsigned)(SLAB_F4 * 16)); }
#pragma unroll
                        for (int j = 0; j < 4; ++j) lc[n][j] = slab_ld(rs_, vo, (unsigned)(32 + u.pn * 4 + j) * (unsigned)(SLAB_F4 * 16)); }
#pragma unroll
                    for (int n = 0; n < 2; ++n) { sa[n] = la[n][0] + la[n][1]; sb[n] = lb[n][0] + lb[n][1]; sc[n] = (lc[n][0] + lc[n][1]) + (lc[n][2] + lc[n][3]); } }
#pragma unroll
                for (int n = 0; n < 2; ++n) { const int col = split_col<PERM>(u, wc, fq, bj, n); const bf16* gp = PRJ + ((unsigned)row * N_INP + col);
                    const f32x4 a = sa[n], b = sb[n], c = sc[n];
                    const u32x2 ga = *(const GAS u32x2*)(gp + PC_GA), gb = *(const GAS u32x2*)(gp + PC_GB), gc = *(const GAS u32x2*)(gp + PC_GC);
                    f32x4 t; t[0] = bflo(ga.x) * a[0] + bflo(gb.x) * b[0] + bflo(gc.x) * rs * c[0]; t[1] = bfhi(ga.x) * a[1] + bfhi(gb.x) * b[1] + bfhi(gc.x) * rs * c[1];
                    t[2] = bflo(ga.y) * a[2] + bflo(gb.y) * b[2] + bflo(gc.y) * rs * c[2]; t[3] = bfhi(ga.y) * a[3] + bfhi(gb.y) * b[3] + bfhi(gc.y) * rs * c[3];
                    u32x2 w; w.x = cvt_pk_bf16(t[0], t[1]); w.y = cvt_pk_bf16(t[2], t[3]); *(GAS u32x2*)(MG + ((unsigned)row * DM + col)) = w; } }
            asm volatile("" ::: "memory"); }
    }
    __device__ __forceinline__ void operator()(const f32x4 (&acc)[2][2][4][2], const Unit& u, int wr, int wc, int fr, int fq) const {
        const int row0 = u.pm * BM + wr * 64 + fr, col0 = u.pn * BM + wc * 32 + 4 * fq;
        bf16* Tb = (bf16*)T;
#pragma unroll
        for (int ai = 0; ai < 2; ++ai) {
#pragma unroll
          for (int mh = 0; mh < 4; mh += MERGE_MB) {
            u32x2 gq[4][2][2], tq[4][2][2]; float rsq[4];
#pragma unroll
            for (int m = mh; m < mh + MERGE_MB; ++m) { const int row = row0 + ai * HALF + m * 16; const size_t off = (size_t)row * DM + col0; const bf16* gp = G + (size_t)row * N_INP + col0;
                rsq[m] = MODE == 2 ? csq[row] : 0.f;
#pragma unroll
                for (int bj = 0; bj < 2; ++bj)
#pragma unroll
                    for (int n = 0; n < 2; ++n) { const int co = bj * HALF + n * 16; gq[m][bj][n] = *(const GAS u32x2*)(gp + co); if (MODE != 0) tq[m][bj][n] = *(const GAS u32x2*)(Tb + off + co); } }
#pragma unroll
            for (int m = mh; m < mh + MERGE_MB; ++m) { const int row = row0 + ai * HALF + m * 16; const size_t off = (size_t)row * DM + col0;
                const float rs = MODE == 2 ? rsqrtf(rsq[m] * (1.0f / 1024.0f) + EPS) : 1.f;
#pragma unroll
                for (int bj = 0; bj < 2; ++bj)
#pragma unroll
                    for (int n = 0; n < 2; ++n) { const int co = bj * HALF + n * 16; const u32x2 g = gq[m][bj][n]; f32x4 v = acc[ai][bj][m][n];
                        v[0] *= bflo(g.x); v[1] *= bfhi(g.x); v[2] *= bflo(g.y); v[3] *= bfhi(g.y);
                        if (MODE == 0) { u32x2 w; w.x = cvt_pk_bf16(v[0], v[1]); w.y = cvt_pk_bf16(v[2], v[3]); *(GAS u32x2*)(Tb + off + co) = w; }
                        if (MODE == 1) { const u32x2 tb = tq[m][bj][n]; u32x2 w; w.x = cvt_pk_bf16(bflo(tb.x) + v[0], bfhi(tb.x) + v[1]); w.y = cvt_pk_bf16(bflo(tb.y) + v[2], bfhi(tb.y) + v[3]); *(GAS u32x2*)(Tb + off + co) = w; }
                        if (MODE == 2) { const u32x2 tb = tq[m][bj][n]; f32x4 t = {bflo(tb.x), bfhi(tb.x), bflo(tb.y), bfhi(tb.y)}; t = t + v * rs; u32x2 w; w.x = cvt_pk_bf16(t[0], t[1]); w.y = cvt_pk_bf16(t[2], t[3]); *(GAS u32x2*)(MG + off + co) = w; } } } } }
    }
};

#ifndef HOOK_MB
#define HOOK_MB 2
#endif
struct EpiMergeCat {
    static constexpr bool PERM = false, AFTER_DRAIN = false, HOOK = true;
    const bf16* PRJ; bf16* MG; const float* csq; f32x4* SLAB; unsigned* cnt;
    static __device__ __forceinline__ float gcl(float g) { return fmaxf(g, 1e-20f); }
    __device__ __forceinline__ void hook(f32x4 (&acc)[2][2][4][2], const Unit& u, int t, int wr, int wc) const {
        int t2 = threadIdx.x; asm volatile("" : "+v"(t2)); const int lane = t2 & 63, fr = lane & 15, fq = lane >> 4;
        const int row0 = u.pm * BM + wr * 64 + fr, col0 = u.pn * BM + wc * 32 + 4 * fq;
        const bool second = t != 8; const unsigned cn = (unsigned)(second ? PC_GB : PC_GA) * 2u, cd = (unsigned)(second ? PC_GC : PC_GB) * 2u;
        const __amdgpu_buffer_rsrc_t pr = __builtin_amdgcn_make_buffer_rsrc((void*)PRJ, (short)0, (int)((size_t)MP * N_INP * 2), 0x00020000);
        const __amdgpu_buffer_rsrc_t cr = __builtin_amdgcn_make_buffer_rsrc((void*)csq, (short)0, (int)(MP * 4), 0x00020000);
#pragma unroll
        for (int ai = 0; ai < 2; ++ai)
#pragma unroll
          for (int m = 0; m < 4; m += HOOK_MB) {
            u32x2 gn[HOOK_MB][2][2], gd[HOOK_MB][2][2]; float rsq[HOOK_MB];
#pragma unroll
            for (int mm = 0; mm < HOOK_MB; ++mm) { const int row = row0 + ai * HALF + (m + mm) * 16; const unsigned vo = ((unsigned)row * (unsigned)N_INP + (unsigned)col0) * 2u;
                rsq[mm] = __builtin_bit_cast(float, __builtin_amdgcn_raw_buffer_load_b32(cr, (unsigned)row * 4u, 0, 0));
#pragma unroll
                for (int bj = 0; bj < 2; ++bj)
#pragma unroll
                    for (int n = 0; n < 2; ++n) { const unsigned co = (unsigned)(bj * HALF + n * 16) * 2u;
                        gn[mm][bj][n] = __builtin_bit_cast(u32x2, __builtin_amdgcn_raw_buffer_load_b64(pr, vo + co, cn, 0)); gd[mm][bj][n] = __builtin_bit_cast(u32x2, __builtin_amdgcn_raw_buffer_load_b64(pr, vo + co, cd, 0)); } }
#pragma unroll
            for (int mm = 0; mm < HOOK_MB; ++mm) { const float rs = second ? __builtin_amdgcn_rsqf(rsq[mm] * (1.0f / 1024.0f) + EPS) : 1.f;
#pragma unroll
                for (int bj = 0; bj < 2; ++bj)
#pragma unroll
                    for (int n = 0; n < 2; ++n) { const u32x2 a = gn[mm][bj][n], d = gd[mm][bj][n]; f32x4 v = acc[ai][bj][m + mm][n];
                        const float n0 = bflo(a.x), n1 = bfhi(a.x), n2 = bflo(a.y), n3 = bfhi(a.y);
                        v[0] *= (second ? gcl(n0) : n0) * __builtin_amdgcn_rcpf(gcl(bflo(d.x)) * rs); v[1] *= (second ? gcl(n1) : n1) * __builtin_amdgcn_rcpf(gcl(bfhi(d.x)) * rs);
                        v[2] *= (second ? gcl(n2) : n2) * __builtin_amdgcn_rcpf(gcl(bflo(d.y)) * rs); v[3] *= (second ? gcl(n3) : n3) * __builtin_amdgcn_rcpf(gcl(bfhi(d.y)) * rs);
                        acc[ai][bj][m + mm][n] = v; } }
            asm volatile("" ::: "memory"); }
    }
    __device__ __forceinline__ void operator()(const f32x4 (&acc)[2][2][4][2], const Unit& u, int wr, int wc, int fr, int fq) const {
        const int row0 = u.pm * BM + wr * 64 + fr, col0 = u.pn * BM + wc * 32 + 4 * fq;
#pragma unroll
        for (int ai = 0; ai < 2; ++ai)
#pragma unroll
          for (int mh = 0; mh < 4; mh += 2) {
            u32x2 gq[2][2][2]; float rsq[2];
#pragma unroll
            for (int mm = 0; mm < 2; ++mm) { const int row = row0 + ai * HALF + (mh + mm) * 16; const bf16* gp = PRJ + (size_t)row * N_INP + col0 + PC_GC; rsq[mm] = csq[row];
#pragma unroll
                for (int bj = 0; bj < 2; ++bj)
#pragma unroll
                    for (int n = 0; n < 2; ++n) gq[mm][bj][n] = *(const GAS u32x2*)(gp + bj * HALF + n * 16); }
#pragma unroll
            for (int mm = 0; mm < 2; ++mm) { const int row = row0 + ai * HALF + (mh + mm) * 16; const size_t off = (size_t)row * DM + col0; const float rs = rsqrtf(rsq[mm] * (1.0f / 1024.0f) + EPS);
#pragma unroll
                for (int bj = 0; bj < 2; ++bj)
#pragma unroll
                    for (int n = 0; n < 2; ++n) { const u32x2 g = gq[mm][bj][n]; const f32x4 v = acc[ai][bj][mh + mm][n]; u32x2 w;
                        w.x = cvt_pk_bf16(v[0] * (gcl(bflo(g.x)) * rs), v[1] * (gcl(bfhi(g.x)) * rs)); w.y = cvt_pk_bf16(v[2] * (gcl(bflo(g.y)) * rs), v[3] * (gcl(bfhi(g.y)) * rs));
                        *(GAS u32x2*)(MG + off + bj * HALF + n * 16) = w; } } }
    }
    __device__ __forceinline__ void partial(f32x4 (&acc)[2][2][4][2], const Unit& u, int wr, int wc, int fr, int fq, int wid, int lane) const {
        split_store(acc, SLAB, u.sid, wid, lane); split_post(cnt + u.cidx * 8 + wid, lane);
    }
    __device__ __forceinline__ void final(const Unit& u, int wr, int wc, int fr, int fq, int wid, int lane, int mmask) const {
        split_wait(cnt + u.cidx * 8 + wid, 4u, lane);
        asm volatile("" : "+v"(fr), "+v"(fq), "+v"(lane));
        const __amdgpu_buffer_rsrc_t rs_ = slab_rsrc(SLAB);
#pragma unroll
        for (int m = 0; m < 4; ++m) { if (!((mmask >> m) & 1)) continue; const int r = wr * 64 + m * 16 + fr, row = MPROMPT + r; const float rs = rsqrtf(csq[row] * (1.0f / 1024.0f) + EPS);
            f32x4 s[2][2][4]; u32x2 ga[2][2], gb[2][2], gc[2][2];
#pragma unroll
            for (int bj = 0; bj < 2; ++bj)
#pragma unroll
                for (int n = 0; n < 2; ++n) { const unsigned vo = (unsigned)((wid * 16 + (m * 2 + bj) * 2 + n) * 64 + lane) * 16u;
                    const int col = split_col<PERM>(u, wc, fq, bj, n); const bf16* gp = PRJ + ((unsigned)row * N_INP + col);
#pragma unroll
                    for (int j = 0; j < 4; ++j) s[bj][n][j] = slab_ld(rs_, vo, (unsigned)(u.pn * 4 + j) * (unsigned)(SLAB_F4 * 16));
                    ga[bj][n] = *(const GAS u32x2*)(gp + PC_GA); gb[bj][n] = *(const GAS u32x2*)(gp + PC_GB); gc[bj][n] = *(const GAS u32x2*)(gp + PC_GC); }
#pragma unroll
            for (int bj = 0; bj < 2; ++bj)
#pragma unroll
                for (int n = 0; n < 2; ++n) { const int col = split_col<PERM>(u, wc, fq, bj, n);
                    const f32x4 a = s[bj][n][0], b = s[bj][n][1], c = s[bj][n][2] + s[bj][n][3]; const u32x2 xa = ga[bj][n], xb = gb[bj][n], xc = gc[bj][n];
                    f32x4 t; t[0] = bflo(xa.x) * a[0] + gcl(bflo(xb.x)) * b[0] + gcl(bflo(xc.x)) * rs * c[0]; t[1] = bfhi(xa.x) * a[1] + gcl(bfhi(xb.x)) * b[1] + gcl(bfhi(xc.x)) * rs * c[1];
                    t[2] = bflo(xa.y) * a[2] + gcl(bflo(xb.y)) * b[2] + gcl(bflo(xc.y)) * rs * c[2]; t[3] = bfhi(xa.y) * a[3] + gcl(bfhi(xb.y)) * b[3] + gcl(bfhi(xc.y)) * rs * c[3];
                    u32x2 w; w.x = cvt_pk_bf16(t[0], t[1]); w.y = cvt_pk_bf16(t[2], t[3]); *(GAS u32x2*)(MG + ((unsigned)row * DM + col)) = w; }
            asm volatile("" ::: "memory"); }
    }
};
template <int SEG> struct EpiChain {
    static constexpr bool PERM = false, AFTER_DRAIN = false, HOOK = false;
    const bf16* PRJ; bf16* MG; const float* csq;
    __device__ __forceinline__ void partial(f32x4 (&)[2][2][4][2], const Unit&, int, int, int, int, int, int) const {}
    __device__ __forceinline__ void operator()(f32x4 (&acc)[2][2][4][2], const Unit& u, int wr, int wc, int fr, int fq) const {
        const int row0 = u.pm * BM + wr * 64 + fr, col0 = u.pn * BM + wc * 32 + 4 * fq;
#pragma unroll
        for (int ai = 0; ai < 2; ++ai)
#pragma unroll
            for (int m = 0; m < 4; ++m) { const int row = row0 + ai * HALF + m * 16; const bf16* gp = PRJ + ((unsigned)row * N_INP + col0);
                float rs = 1.f; if (SEG >= 1) rs = rsqrtf(csq[row] * (1.0f / 1024.0f) + EPS);
#pragma unroll
                for (int bj = 0; bj < 2; ++bj)
#pragma unroll
                    for (int n = 0; n < 2; ++n) { const int co = bj * HALF + n * 16; f32x4 v = acc[ai][bj][m][n];
                        if (SEG == 0) { const u32x2 ga = *(const GAS u32x2*)(gp + PC_GA + co), gb = *(const GAS u32x2*)(gp + PC_GB + co);
                            v[0] *= bflo(ga.x) * __builtin_amdgcn_rcpf(fmaxf(bflo(gb.x), 1e-20f)); v[1] *= bfhi(ga.x) * __builtin_amdgcn_rcpf(fmaxf(bfhi(gb.x), 1e-20f));
                            v[2] *= bflo(ga.y) * __builtin_amdgcn_rcpf(fmaxf(bflo(gb.y), 1e-20f)); v[3] *= bfhi(ga.y) * __builtin_amdgcn_rcpf(fmaxf(bfhi(gb.y), 1e-20f)); acc[ai][bj][m][n] = v; }
                        if (SEG == 1) { const u32x2 gb = *(const GAS u32x2*)(gp + PC_GB + co), gc = *(const GAS u32x2*)(gp + PC_GC + co);
                            v[0] *= fmaxf(bflo(gb.x), 1e-20f) * __builtin_amdgcn_rcpf(fmaxf(bflo(gc.x) * rs, 1e-20f)); v[1] *= fmaxf(bfhi(gb.x), 1e-20f) * __builtin_amdgcn_rcpf(fmaxf(bfhi(gc.x) * rs, 1e-20f));
                            v[2] *= fmaxf(bflo(gb.y), 1e-20f) * __builtin_amdgcn_rcpf(fmaxf(bflo(gc.y) * rs, 1e-20f)); v[3] *= fmaxf(bfhi(gb.y), 1e-20f) * __builtin_amdgcn_rcpf(fmaxf(bfhi(gc.y) * rs, 1e-20f)); acc[ai][bj][m][n] = v; }
                        if (SEG == 2) { const u32x2 gc = *(const GAS u32x2*)(gp + PC_GC + co);
                            v[0] *= fmaxf(bflo(gc.x) * rs, 1e-20f); v[1] *= fmaxf(bfhi(gc.x) * rs, 1e-20f); v[2] *= fmaxf(bflo(gc.y) * rs, 1e-20f); v[3] *= fmaxf(bfhi(gc.y) * rs, 1e-20f);
                            u32x2 w; w.x = cvt_pk_bf16(v[0], v[1]); w.y = cvt_pk_bf16(v[2], v[3]); *(GAS u32x2*)(MG + ((unsigned)row * DM + col0 + co)) = w; } }
                asm volatile("" ::: "memory"); }
    }
};
template <bool X32 = false> struct EpiResidT {
    static constexpr bool PERM = false, AFTER_DRAIN = false, HOOK = false;
    const void* XI; const void* XIS; bf16* XO; const float* gate; SplitCtl sp;
    __device__ __forceinline__ void partial(f32x4 (&acc)[2][2][4][2], const Unit& u, int wr, int wc, int fr, int fq, int wid, int lane) const {
        split_store(acc, sp.SLAB, u.sid, wid, lane); split_post(sp.cnt + u.cidx * 8 + wid, lane);
    }
    __device__ __forceinline__ void operator()(const f32x4 (&acc)[2][2][4][2], const Unit& u, int wr, int wc, int fr, int fq, int mmask = 15) const {
        const int row0 = u.pm * BM + wr * 64 + fr, col0 = u.pn * BM + wc * 32 + 4 * fq;
        const __amdgpu_buffer_rsrc_t xr = __builtin_amdgcn_make_buffer_rsrc((void*)XO, (short)0, (int)((size_t)MP * DM * 2), 0x00020000);
        const bool samp = u.pm == MPROMPT / 256;
        constexpr int MB = X32 ? 2 : 4;
#pragma unroll
        for (int ai = 0; ai < 2; ++ai) { if (ai == 1 && samp) break;
#pragma unroll
          for (int mh = 0; mh < 4; mh += MB) {
            u32x2 xw[MB][2][2]; f32x4 xf[MB][2][2]; f32x4 gg[MB][2][2];
#pragma unroll
            for (int mm = 0; mm < MB; ++mm) { const int m = mh + mm; if (!((mmask >> m) & 1)) continue; const int row = row0 + ai * HALF + m * 16; const size_t off = (size_t)row * DM + col0; const float* gp = gate + (size_t)mod_row(row) * MOD_PITCH + col0;
#pragma unroll
                for (int bj = 0; bj < 2; ++bj)
#pragma unroll
                    for (int n = 0; n < 2; ++n) { const int co = bj * HALF + n * 16;
                        if (X32) { const float* xs = samp ? (const float*)XIS - (size_t)MPROMPT * DM : (const float*)XI; xf[mm][bj][n] = *(const GAS f32x4*)(xs + off + co); }
                        else { const bf16* xs16 = samp ? (const bf16*)XIS - (size_t)MPROMPT * DM : (const bf16*)XI; xw[mm][bj][n] = *(const GAS u32x2*)(xs16 + off + co); }
                        gg[mm][bj][n] = *(const GAS f32x4*)(gp + co); } }
#pragma unroll
            for (int mm = 0; mm < MB; ++mm) { const int m = mh + mm; if (!((mmask >> m) & 1)) continue; const int row = row0 + ai * HALF + m * 16; const size_t off = (size_t)row * DM + col0;
#pragma unroll
                for (int bj = 0; bj < 2; ++bj)
#pragma unroll
                    for (int n = 0; n < 2; ++n) { const int co = bj * HALF + n * 16; f32x4 xi;
                        if (X32) xi = xf[mm][bj][n]; else { const u32x2 w = xw[mm][bj][n]; xi = (f32x4){bflo(w.x), bfhi(w.x), bflo(w.y), bfhi(w.y)}; }
                        const f32x4 xo = xi + gg[mm][bj][n] * acc[ai][bj][m][n]; u32x2 wo; wo.x = cvt_pk_bf16(xo[0], xo[1]); wo.y = cvt_pk_bf16(xo[2], xo[3]);
                        __builtin_amdgcn_raw_buffer_store_b64(wo, xr, (unsigned)(off + co) * 2u, 0,   16); } } } }
    }
};
using EpiResid = EpiResidT<false>;
template <int MODE, bool X32 = false> struct EpiResidPrep {
    static constexpr bool PERM = false, AFTER_DRAIN = true, HOOK = false;
    EpiResidT<X32> R; bf16* H; float* yp; float* ys; const float* g; const float* mod2; int sh_idx, sc_idx; const float* wdt; float* DT; unsigned* pc;
    __device__ __forceinline__ void partial(f32x4 (&acc)[2][2][4][2], const Unit& u, int wr, int wc, int fr, int fq, int wid, int lane) const {
        split_store(acc, R.sp.SLAB, u.sid, wid, lane); split_post(R.sp.cnt + u.cidx * 8 + wid, lane);
    }
    __device__ __forceinline__ void operator()(const f32x4 (&acc)[2][2][4][2], const Unit& u, int wr, int wc, int fr, int fq) const { R(acc, u, wr, wc, fr, fq); }
    __device__ __forceinline__ void fused(f32x4 (&acc)[2][2][4][2], const Unit& u, int wr, int wc, int fr, int fq, LAS unsigned char* lds, int wid, int lane) const {
        R(acc, u, wr, wc, fr, fq);
        const int fin = opaque_bx() - R.sp.fin0; const bool isfin = fin >= 0 && fin < (DM / 256) * R.sp.parts;
        if (isfin) { const Unit uf = final_unit(fin / R.sp.parts, R.sp.cbase); const int mmask = part_mask(fin % R.sp.parts, R.sp.parts);
            split_wait(R.sp.cnt + uf.cidx * 8 + wid, R.sp.nsl, lane);
            split_sum(acc, R.sp.SLAB, uf.pn * (int)R.sp.nsl, (int)R.sp.nsl, wid, lane, mmask); R(acc, uf, wr, wc, fr, fq, mmask); }
        asm volatile("s_waitcnt vmcnt(0)" ::: "memory"); __syncthreads();
        if (wid == 0 && lane == 0) {
            if (isfin) __hip_atomic_fetch_add(pc + 32, 8u / (unsigned)R.sp.parts, __ATOMIC_RELAXED, __HIP_MEMORY_SCOPE_AGENT);
            __hip_atomic_fetch_add(pc + u.pm, 1u, __ATOMIC_RELAXED, __HIP_MEMORY_SCOPE_AGENT);
            unsigned sp_ = 0; while (__hip_atomic_load(pc + u.pm, __ATOMIC_RELAXED, __HIP_MEMORY_SCOPE_AGENT) < 8u && ++sp_ < (1u << 22)) __builtin_amdgcn_s_sleep(2);
            if (u.pn == 0) { sp_ = 0; while (__hip_atomic_load(pc + 32, __ATOMIC_RELAXED, __HIP_MEMORY_SCOPE_AGENT) < 64u && ++sp_ < (1u << 22)) __builtin_amdgcn_s_sleep(2); }
            __builtin_amdgcn_fence(__ATOMIC_ACQUIRE, "agent"); asm volatile("s_waitcnt vmcnt(0)" ::: "memory");
        }
        __syncthreads();
        LAS float* wT = (LAS float*)lds;
        if (MODE == 1) { f32x4 tw[16];
#pragma unroll
            for (int i = 0; i < 16; ++i) tw[i] = ((const f32x4*)wdt)[wid * 64 + lane + i * NTHR];
#pragma unroll
            for (int i = 0; i < 16; ++i) ((LAS f32x4*)wT)[wid * 64 + lane + i * NTHR] = tw[i];
            __syncthreads(); }
        const bf16* X = R.XO;
        {   const int row = u.pm * BM + u.pn * 32 + wid * 4;
            prep_rows4<MODE>(X + (size_t)row * DM, g, mod2 + (size_t)mod_row(row) * MOD_PITCH, sh_idx, sc_idx, H + (size_t)row * DM, yp + (size_t)row * DM, DT + (size_t)row * 16, wT, lane); }
        if (u.pn == 0 && wid < 4) { const int s = u.pm * 4 + wid, row = MPROMPT + s;
            prep_row<MODE>(X + (size_t)row * DM, g, mod2 + (size_t)mod_row(row) * MOD_PITCH, sh_idx, sc_idx, H + (size_t)row * DM, ys + (size_t)s * DM, DT + (size_t)row * 16, wT, lane); }
        if (MODE == 1) __syncthreads();
    }
};
struct EpiMod {
    static constexpr bool PERM = false, AFTER_DRAIN = false, HOOK = false;
    float* MOD; const float* bmod;
    __device__ __forceinline__ void partial(f32x4 (&)[2][2][4][2], const Unit&, int, int, int, int, int, int) const {}
    __device__ __forceinline__ void operator()(const f32x4 (&acc)[2][2][4][2], const Unit& u, int wr, int wc, int fr, int fq) const {
        const int row0 = wr * 64 + fr, col0 = u.pn * BM + wc * 32 + 4 * fq;
        f32x4 bv[2][2];
#pragma unroll
        for (int bj = 0; bj < 2; ++bj)
#pragma unroll
            for (int n = 0; n < 2; ++n) bv[bj][n] = *(const GAS f32x4*)(bmod + col0 + bj * HALF + n * 16);
#pragma unroll
        for (int ai = 0; ai < 2; ++ai)
#pragma unroll
            for (int m = 0; m < 4; ++m) { float* rowp = MOD + (size_t)(row0 + ai * HALF + m * 16) * MOD_PITCH + col0;
#pragma unroll
                for (int bj = 0; bj < 2; ++bj)
#pragma unroll
                    for (int n = 0; n < 2; ++n) *(GAS f32x4*)(rowp + bj * HALF + n * 16) = acc[ai][bj][m][n] + bv[bj][n]; }
    }
};
}
struct Frame {
    LAS unsigned char* lds;
    int tid, lane, wave, gw;
    float* out; unsigned char* ws;
};
#define WSP(T, off) ((T*)(F.ws + (off)))
__device__ __forceinline__ Frame launder(const Frame& F0) {
    Frame F = F0; int t = F0.tid; asm volatile("" : "+v"(t)); F.tid = t; F.lane = t & 63; F.wave = __builtin_amdgcn_readfirstlane(t >> 6);
    unsigned long long w = (unsigned long long)F0.ws, o = (unsigned long long)F0.out; asm volatile("" : "+s"(w), "+s"(o)); F.ws = (unsigned char*)w; F.out = (float*)o;
    F.gw = blockIdx.x * NWAVES + F.wave; return F;
}

__device__ __forceinline__ void transpose_load(float (&tv)[32], const float* W, int ld, int ncols, int c0, int item, int lane) {
    const int nblk = ncols / 32, kb = item / nblk, nb = item % nblk, k0 = 64 * kb, n0 = 32 * nb;
    const unsigned lo = (unsigned)((lane >> 5) * ld + (lane & 31));
#pragma unroll
    for (int i = 0; i < 32; ++i) { const float* rb = W + (size_t)(k0 + 2 * i) * ld + c0 + n0; tv[i] = __builtin_nontemporal_load(rb + lo); }
}
__device__ __forceinline__ void transpose_store(const float (&tv)[32], int pitch, int ncols, bf16* WT, int row_off, LAS float* scr, int item, int lane) {
    const int nblk = ncols / 32, kb = item / nblk, nb = item % nblk, k0 = 64 * kb, n0 = 32 * nb;
    const int rbase = row_off >= 0 ? row_off + n0 : (n0 < D_FF ? 256 * (n0 / 128) + n0 % 128 : 256 * ((n0 - D_FF) / 128) + 128 + (n0 - D_FF) % 128);
#pragma unroll
    for (int i = 0; i < 32; ++i) { const int kk = 2 * i + (lane >> 5); scr[kk * 33 + (lane & 31)] = tv[i]; }
    LDS_WAIT(); asm volatile("" ::: "memory");
    const int c = lane & 7;
#pragma unroll
    for (int j = 0; j < 4; ++j) { const int n = (lane >> 3) + 8 * j; const LAS float* s = scr + (8 * c) * 33 + n;
        v4u o; o.x = pk2(s[0 * 33], s[1 * 33]); o.y = pk2(s[2 * 33], s[3 * 33]); o.z = pk2(s[4 * 33], s[5 * 33]); o.w = pk2(s[6 * 33], s[7 * 33]);
        *(GAS v4u*)(WT + (size_t)(rbase + n) * pitch + k0 + 8 * c) = o; }
    LDS_WAIT(); asm volatile("" ::: "memory");
}
constexpr int MODC = 96, MODK = 128, MODP = 136;
__device__ __forceinline__ void phase_mod(const Frame& F0, KArgs A) {
    Frame F = launder(F0);
    const int n0 = blockIdx.x * MODC, l = n0 / N_MOD, cl = n0 - l * N_MOD;
    const float* W = A->in[I_WMOD] + (size_t)l * DM * N_MOD + cl;
    LAS bf16* Bt = (LAS bf16*)F.lds;
    LAS bf16* As = (LAS bf16*)(F.lds + 2 * MODC * MODP * 2);
    for (int i = F.tid; i < 2 * 12 * MODP; i += NTHR) { const int b = i / (12 * MODP), r = i % (12 * MODP); As[(b * 144 + 132) * MODP + r] = (bf16)0; }
    f32x4 wa[6], wb[6], creg[9];
    auto load_w = [&](f32x4 (&wr)[6], int kc) {
#pragma unroll
        for (int j = 0; j < 6; ++j) { const int idx = F.tid + NTHR * j, n = idx % MODC, k = 4 * (idx / MODC); const float* p = W + (size_t)(kc * MODK + k) * N_MOD + n;
            wr[j].x = __builtin_nontemporal_load(p); wr[j].y = __builtin_nontemporal_load(p + N_MOD); wr[j].z = __builtin_nontemporal_load(p + 2 * N_MOD); wr[j].w = __builtin_nontemporal_load(p + 3 * (size_t)N_MOD); }
    };
    bf16* SC = WSP(bf16, WS_HALO);
    v4u cbf[5];
    auto load_c = [&](int kc) {
#pragma unroll
        for (int j = 0; j < 5; ++j) { const int idx = F.tid + NTHR * j, r = idx >> 4, p = idx & 15;
            cbf[j] = r < NB + NS ? *(const GAS v4u*)(SC + (size_t)r * DM + kc * MODK + p * 8) : (v4u){0u, 0u, 0u, 0u}; }
    };
    auto publish = [&](int kc) {
        const __amdgpu_buffer_rsrc_t sr = __builtin_amdgcn_make_buffer_rsrc((void*)SC, (short)0, (int)((NB + NS) * DM * 2), 0x00020000);
#pragma unroll
        for (int j = 0; j < 9; ++j) { const int idx = F.tid + NTHR * j, r = idx >> 5, k4 = (idx & 31) * 4;
            const float* src = r < NB ? A->in[I_CP] + (size_t)r * DM : A->in[I_CS] + (size_t)(r - NB) * DM;
            creg[j] = r < NB + NS ? *(const GAS f32x4*)(src + kc * MODK + k4) : (f32x4){0.f, 0.f, 0.f, 0.f}; }
#pragma unroll
        for (int j = 0; j < 9; ++j) { const int idx = F.tid + NTHR * j, r = idx >> 5, k4 = (idx & 31) * 4;
            if (r < NB + NS) { v2u w; w.x = pk2(siluf_(creg[j].x), siluf_(creg[j].y)); w.y = pk2(siluf_(creg[j].z), siluf_(creg[j].w));
                __builtin_amdgcn_raw_buffer_store_b64(w, sr, (unsigned)(r * DM + kc * MODK + k4) * 2u, 0,   16); } }
        asm volatile("s_waitcnt vmcnt(0)" ::: "memory"); __syncthreads();
        if (F.tid == 0) __hip_atomic_fetch_add((unsigned*)(F.ws + WS_CTL) + CW_MODF, 1u, __ATOMIC_RELAXED, __HIP_MEMORY_SCOPE_AGENT);
    };
    auto store_w = [&](const f32x4 (&wr)[6], int buf) {
#pragma unroll
        for (int j = 0; j < 6; ++j) { const int idx = F.tid + NTHR * j, n = idx % MODC, k = 4 * (idx / MODC);
            v2u w; w.x = pk2(wr[j].x, wr[j].y); w.y = pk2(wr[j].z, wr[j].w); *(LAS v2u*)(Bt + (buf * MODC + n) * MODP + k) = w; }
    };
    auto store_c = [&](int buf) {
#pragma unroll
        for (int j = 0; j < 5; ++j) { const int idx = F.tid + NTHR * j, r = idx >> 4, p = idx & 15;
            if (r < NB + NS) *(LAS v4u*)(As + (buf * 144 + r) * MODP + p * 8) = cbf[j]; }
    };
    f32x4 acc[9];
#pragma unroll
    for (int m = 0; m < 9; ++m) acc[m] = (f32x4){0.f, 0.f, 0.f, 0.f};
    auto compute = [&](int buf) {
        if (F.wave < 6) {
#pragma unroll
            for (int ks = 0; ks < MODK / 32; ++ks) { const bf16x8 bfr = *(const LAS bf16x8*)(Bt + (buf * MODC + 16 * F.wave + (F.lane & 15)) * MODP + 32 * ks + 8 * (F.lane >> 4));
#pragma unroll
                for (int m = 0; m < 9; ++m) { const bf16x8 af = *(const LAS bf16x8*)(As + (buf * 144 + 16 * m + (F.lane & 15)) * MODP + 32 * ks + 8 * (F.lane >> 4));
                    acc[m] = __builtin_amdgcn_mfma_f32_16x16x32_bf16(af, bfr, acc[m], 0, 0, 0); } }
        }
    };
    const int kst = blockIdx.x & 15;
    load_w(wa, kst); load_w(wb, (1 + kst) & 15);
    if (blockIdx.x < 16) publish((int)blockIdx.x);
    if (F.tid == 0) { unsigned sp_ = 0; while (__hip_atomic_load((unsigned*)(F.ws + WS_CTL) + CW_MODF, __ATOMIC_RELAXED, __HIP_MEMORY_SCOPE_AGENT) < 16u && ++sp_ < (1u << 22)) __builtin_amdgcn_s_sleep(2);
        __builtin_amdgcn_fence(__ATOMIC_ACQUIRE, "agent"); asm volatile("s_waitcnt vmcnt(0)" ::: "memory"); }
    __syncthreads();
    load_c(kst);
    store_w(wa, 0); store_c(0); __syncthreads();
#pragma unroll 1
    for (int kc = 0; kc < DM / MODK; kc += 2) {
        load_c((kc + 1 + kst) & 15); if (kc + 2 < DM / MODK) load_w(wa, (kc + 2 + kst) & 15);
        compute(0);
        store_w(wb, 1); store_c(1); __syncthreads();
        if (kc + 2 < DM / MODK) { load_c((kc + 2 + kst) & 15); if (kc + 3 < DM / MODK) load_w(wb, (kc + 3 + kst) & 15); }
        compute(1);
        if (kc + 2 < DM / MODK) { store_w(wa, 0); store_c(0); }
        __syncthreads();
    }
    if (F.wave < 6) { const int col = n0 + 16 * F.wave + (F.lane & 15); const float bias = A->in[I_BMOD][col];
        const __amdgpu_buffer_rsrc_t mr_ = __builtin_amdgcn_make_buffer_rsrc((void*)WSP(float, WS_MOD), (short)0, (int)((size_t)(NB + NS) * MOD_PITCH * 4), 0x00020000);
#pragma unroll
        for (int m = 0; m < 9; ++m)
#pragma unroll
            for (int r = 0; r < 4; ++r) { const int row = 16 * m + 4 * (F.lane >> 4) + r;
                if (row < NB + NS) __builtin_amdgcn_raw_buffer_store_b32(__builtin_bit_cast(unsigned, acc[m][r] + bias), mr_, (unsigned)(row * MOD_PITCH + col) * 4u, 0,   16); } }
    asm volatile("s_waitcnt vmcnt(0)" ::: "memory"); __syncthreads();
    if (F.tid == 0) __hip_atomic_fetch_add((unsigned*)(F.ws + WS_CTL) + CW_MODF + 1, 1u, __ATOMIC_RELAXED, __HIP_MEMORY_SCOPE_AGENT);
}
__device__ __forceinline__ void mod_wait(const Frame& F0) {
    Frame F = launder(F0);
    __syncthreads();
    if (F.tid == 0) { unsigned sp_ = 0; while (__hip_atomic_load((unsigned*)(F.ws + WS_CTL) + CW_MODF + 1, __ATOMIC_RELAXED, __HIP_MEMORY_SCOPE_AGENT) < (unsigned)GRID && ++sp_ < (1u << 22)) __builtin_amdgcn_s_sleep(2);
        __builtin_amdgcn_fence(__ATOMIC_ACQUIRE, "agent"); asm volatile("s_waitcnt vmcnt(0)" ::: "memory"); }
    __syncthreads();
}
__device__ __forceinline__ void tjob(Frame& F, LAS float* scr, const float* W, int ld, int K, int ncols, int c0, bf16* WT, int row_off, int pitch = 0) {
    if (pitch == 0) pitch = K;
    const int nit = (K / 64) * (ncols / 32), ST = GRID * NWAVES;
#pragma unroll 1
    for (int it = F.gw; it < nit; it += 2 * ST) { float ta[32], tb[32]; const bool two = it + ST < nit;
        transpose_load(ta, W, ld, ncols, c0, it, F.lane); if (two) transpose_load(tb, W, ld, ncols, c0, it + ST, F.lane);
        transpose_store(ta, pitch, ncols, WT, row_off, scr, it, F.lane); if (two) transpose_store(tb, pitch, ncols, WT, row_off, scr, it + ST, F.lane); }
}
__device__ __forceinline__ void prep_layer0(const Frame& F0, KArgs A) {
    Frame F = launder(F0);
    LAS float* wT = (LAS float*)F.lds;
    {   const float* win = A->in[I_WIN];
        f32x4 tw[4][4];
#pragma unroll
        for (int i = 0; i < 4; ++i) { const GAS f32x4* p = (const GAS f32x4*)(win + (size_t)(F.tid + i * NTHR) * N_IN + 4096);
#pragma unroll
            for (int q = 0; q < 4; ++q) tw[i][q] = p[q]; }
#pragma unroll
        for (int i = 0; i < 4; ++i) { const int k = F.tid + i * NTHR;
#pragma unroll
            for (int q = 0; q < 4; ++q) { wT[(4 * q + 0) * DM + k] = tw[i][q].x; wT[(4 * q + 1) * DM + k] = tw[i][q].y; wT[(4 * q + 2) * DM + k] = tw[i][q].z; wT[(4 * q + 3) * DM + k] = tw[i][q].w; } }
        __syncthreads(); }
    {   Frame F2 = launder(F0); const int gwv = blockIdx.x * NWAVES + F2.wave;
        if (gwv < NS) { const int row = MPROMPT + gwv; const float* modl = (const float*)(F2.ws + WS_MOD);
            prep_row<1, true>(A->in[I_XS] + (size_t)gwv * DM, A->in[I_GMIX], modl + (size_t)mod_row(row) * MOD_PITCH, 0, 1, (bf16*)(F2.ws + WS_H) + (size_t)row * DM, nullptr, (float*)(F2.ws + WS_SMALL + SM_DT) + (size_t)row * 16, wT, F2.lane); } }
    {   Frame F2 = launder(F0); const int gwv = blockIdx.x * NWAVES + F2.wave; const float* modl = (const float*)(F2.ws + WS_MOD);
#pragma unroll 1
        for (int hq = 0; hq < 2; ++hq) { const int row = 4 * gwv + 2 * hq;
            prep_rows4<1, true, 2>(A->in[I_XP] + (size_t)row * DM, A->in[I_GMIX], modl + (size_t)mod_row(row) * MOD_PITCH, 0, 1, (bf16*)(F2.ws + WS_H) + (size_t)row * DM, nullptr, (float*)(F2.ws + WS_SMALL + SM_DT) + (size_t)row * 16, wT, F2.lane); } }
    __syncthreads();
}
__device__ __forceinline__ void phase_prologue(const Frame& F0, KArgs A) {
    Frame F = launder(F0);
    LAS float* scr = (LAS float*)(F.lds + F.wave * 16384);
#pragma unroll 1
    for (int l = 0; l < DEPTH; ++l) {
        unsigned char* wl = F.ws + WS_W + (size_t)l * WL_END;
        tjob(F, scr, A->in[I_WIN] + (size_t)l * DM * N_IN, N_IN, DM, 4096, 0, (bf16*)(wl + WL_IN), 0);
        tjob(F, scr, A->in[I_WIN] + (size_t)l * DM * N_IN, N_IN, DM, 6144, 4112, (bf16*)(wl + WL_IN), 4096);
        tjob(F, scr, A->in[I_WGLU] + (size_t)l * 512 * 512, 512, 512, 512, 0, (bf16*)(wl + WL_GLU), 0);
        tjob(F, scr, A->in[I_WPA] + (size_t)l * 512 * DM, DM, 512, DM, 0, (bf16*)(wl + WL_PA) + OC_A, 0, OCP);
        tjob(F, scr, A->in[I_WPB] + (size_t)l * 512 * DM, DM, 512, DM, 0, (bf16*)(wl + WL_PA) + OC_B, 0, OCP);
        tjob(F, scr, A->in[I_WPC] + (size_t)l * 1024 * DM, DM, 1024, DM, 0, (bf16*)(wl + WL_PA) + OC_C, 0, OCP);
        tjob(F, scr, A->in[I_WOUT] + (size_t)l * DM * DM, DM, DM, DM, 0, (bf16*)(wl + WL_OUT), 0);
        tjob(F, scr, A->in[I_WUP] + (size_t)l * DM * D_UP, D_UP, DM, D_UP, 0, (bf16*)(wl + WL_UP), -1);
        tjob(F, scr, A->in[I_WDOWN] + (size_t)l * D_FF * DM, DM, D_FF, DM, 0, (bf16*)(wl + WL_DOWN), 0);
    }
    {   float* z = WSP(float, WS_SMALL + SM_VSQ);
        const int gt = blockIdx.x * NTHR + F.tid;
        for (int i = gt; i < 4 * MP; i += GRID * NTHR) z[i] = 0.f;
    }
    {   const int gt = blockIdx.x * NTHR + F.tid, NT = GRID * NTHR;
        bf16* WSb = WSP(bf16, WS_SMALL + SM_WS);
        for (int i = gt; i < DEPTH * H_B * 128 * 128; i += NT) { const int jj = i & 127, ii = (i >> 7) & 127; WSb[i] = (bf16)(jj <= ii ? f2bf(A->in[I_WS][i]) : 0u); }
        float* AA = WSP(float, WS_SMALL + SM_S5A); float* BB = WSP(float, WS_SMALL + SM_S5BB); bf16* CT = WSP(bf16, WS_SMALL + SM_S5CT);
        for (int i = gt; i < DEPTH * G_A * P_A; i += NT) {
            const int l = i / (G_A * P_A), g = (i / P_A) % G_A;
            const float dt = expf(A->in[I_LOGDT][l * G_A + g]), lr = A->in[I_LAMRE][i], li = A->in[I_LAMIM][i];
            const float mag = expf(lr * dt); float sn, cs; sincosf(li * dt, &sn, &cs);
            const float ar = mag * cs, ai = mag * sn, den = lr * lr + li * li, nr = ar - 1.0f;
            const float kr = (nr * lr + ai * li) / den, ki = (ai * lr - nr * li) / den;
            float qr = ar, qi = ai;
#pragma unroll
            for (int s = 0; s < 6; ++s) { const float t = qr * qr - qi * qi; qi = 2.0f * qr * qi; qr = t; }
            AA[i * 4 + 0] = ar; AA[i * 4 + 1] = ai; AA[i * 4 + 2] = qr; AA[i * 4 + 3] = qi;
#pragma unroll
            for (int h = 0; h < S5G; ++h) { const float bre = A->in[I_BRE][(size_t)i * S5G + h], bim = A->in[I_BIM][(size_t)i * S5G + h];
                BB[(size_t)i * 32 + h] = kr * bre - ki * bim; BB[(size_t)i * 32 + 16 + h] = kr * bim + ki * bre; }
        }
        {   float* WDT = WSP(float, WS_SMALL + SM_WDT);
            for (int i = gt; i < DEPTH * 16 * DM; i += NT) { const int k = i % DM, hh = (i / DM) & 15, l = i / (16 * DM); WDT[i] = A->in[I_WIN][((size_t)l * DM + k) * N_IN + 4096 + hh]; } }
        for (int i = gt; i < DEPTH * G_A * S5G * 128; i += NT) { const int k = i & 127, lgh = i >> 7;
            const float v = k < 64 ? A->in[I_CRE][(size_t)lgh * 64 + k] : -A->in[I_CIM][(size_t)lgh * 64 + (k - 64)]; CT[i] = (bf16)f2bf(v); }
    }
}

template <bool WITH_DT>
__device__ __forceinline__ void phase_prep(const Frame& F0, const float* X, const float* XS, const float* g, const float* modl, int sh_idx, int sc_idx, const float* win_l, float* DT) {
    Frame F = launder(F0);
    bf16* H = WSP(bf16, WS_H);
    LAS float* wT = (LAS float*)F.lds;
    if (WITH_DT) {
        {   const GAS f32x4* wd = (const GAS f32x4*)WSP(const float, WS_SMALL + SM_WDT);
            f32x4 tw[16];
#pragma unroll
            for (int i = 0; i < 16; ++i) tw[i] = wd[F.tid + i * NTHR];
#pragma unroll
            for (int i = 0; i < 16; ++i) ((LAS f32x4*)wT)[F.tid + i * NTHR] = tw[i]; }
        (void)win_l;
        __syncthreads();
    }
    if (WITH_DT) {
        const bf16* X0 = WSP(const bf16, WS_X0); float* DTo = DT; const int gwv = blockIdx.x * NWAVES + F.wave;
        {   const int row = 4 * gwv; prep_rows4<1>(X0 + (size_t)row * DM, g, modl + (size_t)mod_row(row) * MOD_PITCH, sh_idx, sc_idx, H + (size_t)row * DM, nullptr, DTo + (size_t)row * 16, wT, F.lane); }
        if (gwv < NS) { const int row = MPROMPT + gwv; prep_row<1>(X0 + (size_t)row * DM, g, modl + (size_t)mod_row(row) * MOD_PITCH, sh_idx, sc_idx, H + (size_t)row * DM, nullptr, DTo + (size_t)row * 16, wT, F.lane); }
    } else {
    f32x4 vn[8];
    {   const int r0 = blockIdx.x * NWAVES + F.wave; const int rr0 = r0 < MREAL ? r0 : 0; const GAS f32x4* xr = (const GAS f32x4*)(rr0 < MPROMPT ? X + (size_t)rr0 * DM : XS + (size_t)(rr0 - MPROMPT) * DM) + F.lane;
#pragma unroll
        for (int j = 0; j < 8; ++j) vn[j] = xr[64 * j]; }
    for (int r = blockIdx.x * NWAVES + F.wave; r < MREAL; r += GRID * NWAVES) {
        f32x4 v[8]; float s = 0.f;
#pragma unroll
        for (int j = 0; j < 8; ++j) { v[j] = vn[j]; s += (v[j].x * v[j].x + v[j].y * v[j].y) + (v[j].z * v[j].z + v[j].w * v[j].w); }
        {   const int rn = r + GRID * NWAVES; const int rr1 = rn < MREAL ? rn : r; const GAS f32x4* xr = (const GAS f32x4*)(rr1 < MPROMPT ? X + (size_t)rr1 * DM : XS + (size_t)(rr1 - MPROMPT) * DM) + F.lane;
#pragma unroll
            for (int j = 0; j < 8; ++j) vn[j] = xr[64 * j]; }
        const float rinv = rsqrtf(wave_sum(s) * (1.0f / DM) + EPS);
        const float* mr = modl + (size_t)mod_row(r) * MOD_PITCH;
        const GAS f32x4* gp = (const GAS f32x4*)g + F.lane; const GAS f32x4* shp = (const GAS f32x4*)(mr + sh_idx * DM) + F.lane; const GAS f32x4* scp = (const GAS f32x4*)(mr + sc_idx * DM) + F.lane;
        GAS v2u* o = (GAS v2u*)(H + (size_t)r * DM) + F.lane;
#pragma unroll
        for (int j = 0; j < 8; ++j) { const f32x4 gg = gp[64 * j], sh = shp[64 * j], sc = scp[64 * j];
            v[j] = v[j] * rinv * gg * (sc + 1.0f) + sh;
            v2u w; w.x = pk2(v[j].x, v[j].y); w.y = pk2(v[j].z, v[j].w); o[64 * j] = w; }
        if (WITH_DT) {
            float a16[16];
#pragma unroll
            for (int hh = 0; hh < 16; ++hh) { float a = 0.f;
#pragma unroll
                for (int j = 0; j < 8; ++j) { const f32x4 w = *(const LAS f32x4*)(wT + hh * DM + 4 * F.lane + 256 * j); a += (v[j].x * w.x + v[j].y * w.y) + (v[j].z * w.z + v[j].w * w.w); }
                a16[hh] = a; }
            const float mine = wave_sum16(a16, F.lane);
            if (F.lane < 16) DT[(size_t)r * 16 + F.lane] = mine;
        }
    }
    }
    if (WITH_DT) __syncthreads();
}

__device__ __forceinline__ void phase_final(const Frame& F0, KArgs A, const float* X) {
    Frame F = launder(F0);
    const float* g = A->in[I_GFINAL];
    for (int r = blockIdx.x * NWAVES + F.wave; r < MREAL; r += GRID * NWAVES) {
        const GAS f32x4* xr = (const GAS f32x4*)(X + (size_t)r * DM) + F.lane;
        f32x4 v[8]; float s = 0.f;
#pragma unroll
        for (int j = 0; j < 8; ++j) { v[j] = xr[64 * j]; s += (v[j].x * v[j].x + v[j].y * v[j].y) + (v[j].z * v[j].z + v[j].w * v[j].w); }
        const float rinv = rsqrtf(wave_sum(s) * (1.0f / DM) + EPS);
        GAS f32x4* o = (GAS f32x4*)(F.out + (r < MPROMPT ? O_YP + (size_t)r * DM : O_YS + (size_t)(r - MPROMPT) * DM)) + F.lane;
        const GAS f32x4* gp = (const GAS f32x4*)g + F.lane;
#pragma unroll
        for (int j = 0; j < 8; ++j) o[64 * j] = v[j] * rinv * gp[64 * j];
    }
}
typedef __bf16 bf16x2_t __attribute__((ext_vector_type(2)));
constexpr int HS_PITCH = 136;
template <bool FINAL>
__device__ __forceinline__ void s5_item(KArgs A, unsigned char* ws, float* out, int l, int item, LAS unsigned char* wl, int lane, unsigned* flags = nullptr) {
    const int c = item & 31, g = (item >> 5) & 31, b = item >> 10;
    const int lgp = (l * G_A + g) * P_A + lane;
    const f32x4 aq = *(const GAS f32x4*)((const float*)(ws + WS_SMALL + SM_S5A) + (size_t)lgp * 4);
    const float ar = aq.x, ai = aq.y;
    float br[16], bi[16];
    {   const GAS f32x4* bb = (const GAS f32x4*)((const float*)(ws + WS_SMALL + SM_S5BB) + (size_t)lgp * 32);
#pragma unroll
        for (int q = 0; q < 4; ++q) { const f32x4 v = bb[q]; br[4 * q] = v.x; br[4 * q + 1] = v.y; br[4 * q + 2] = v.z; br[4 * q + 3] = v.w;
                                      const f32x4 w = bb[4 + q]; bi[4 * q] = w.x; bi[4 * q + 1] = w.y; bi[4 * q + 2] = w.z; bi[4 * q + 3] = w.w; } }
    unsigned brp[8], bip[8];
#pragma unroll
    for (int k = 0; k < 8; ++k) { brp[k] = pk2(br[2 * k], br[2 * k + 1]); bip[k] = pk2(bi[2 * k], bi[2 * k + 1]); }
    const int row0 = b * SEQ + c * S5Q;
    const bf16* PROJ = (const bf16*)(ws + WS_BIG);
    const GAS v4u* up = (const GAS v4u*)(PROJ + (size_t)(row0 + lane) * N_INP + PC_UA + g * 16);
    const v4u u0 = up[0], u1 = up[1];
    LAS bf16* Us = (LAS bf16*)(wl + 8704);
    if (FINAL) { *(LAS v4u*)(Us + lane * 16) = u0; *(LAS v4u*)(Us + lane * 16 + 8) = u1; }
    float hr = 0.f, hi = 0.f;
    float* SLOC = (float*)(ws + WS_SMALL + SM_SLOC);
    if (FINAL && flags) {
        float lr = 0.f, li = 0.f;
#pragma unroll 2
        for (int t = 0; t < 64; ++t) {
            unsigned w[8];
            w[0] = __builtin_amdgcn_readlane(u0.x, t); w[1] = __builtin_amdgcn_readlane(u0.y, t); w[2] = __builtin_amdgcn_readlane(u0.z, t); w[3] = __builtin_amdgcn_readlane(u0.w, t);
            w[4] = __builtin_amdgcn_readlane(u1.x, t); w[5] = __builtin_amdgcn_readlane(u1.y, t); w[6] = __builtin_amdgcn_readlane(u1.z, t); w[7] = __builtin_amdgcn_readlane(u1.w, t);
            float sr0 = 0.f, si0 = 0.f, sr1 = 0.f, si1 = 0.f;
#pragma unroll
            for (int k = 0; k < 8; k += 2) {
                sr0 = __builtin_amdgcn_fdot2_f32_bf16(__builtin_bit_cast(bf16x2_t, brp[k]), __builtin_bit_cast(bf16x2_t, w[k]), sr0, false);
                si0 = __builtin_amdgcn_fdot2_f32_bf16(__builtin_bit_cast(bf16x2_t, bip[k]), __builtin_bit_cast(bf16x2_t, w[k]), si0, false);
                sr1 = __builtin_amdgcn_fdot2_f32_bf16(__builtin_bit_cast(bf16x2_t, brp[k + 1]), __builtin_bit_cast(bf16x2_t, w[k + 1]), sr1, false);
                si1 = __builtin_amdgcn_fdot2_f32_bf16(__builtin_bit_cast(bf16x2_t, bip[k + 1]), __builtin_bit_cast(bf16x2_t, w[k + 1]), si1, false); }
            const float nr = ar * lr - ai * li + (sr0 + sr1); li = ar * li + ai * lr + (si0 + si1); lr = nr;
        }
        float* sl = SLOC + (size_t)item * 128 + lane;
        __hip_atomic_store(sl, lr, __ATOMIC_RELAXED, __HIP_MEMORY_SCOPE_AGENT); __hip_atomic_store(sl + 64, li, __ATOMIC_RELAXED, __HIP_MEMORY_SCOPE_AGENT);
        asm volatile("s_waitcnt vmcnt(0)" ::: "memory");
        if (lane == 0) __hip_atomic_store(flags + item, 1u, __ATOMIC_RELAXED, __HIP_MEMORY_SCOPE_AGENT);
        {
            unsigned sp_ = 0;
            for (;;) { const unsigned f = lane < c ? __hip_atomic_load(flags + (item - c + lane), __ATOMIC_RELAXED, __HIP_MEMORY_SCOPE_AGENT) : 1u;
                if (__builtin_amdgcn_ballot_w64(f == 0u) == 0ull || ++sp_ > (1u << 20)) break; __builtin_amdgcn_s_sleep(1); }
            __builtin_amdgcn_fence(__ATOMIC_ACQUIRE, "agent"); }
        asm volatile("s_waitcnt vmcnt(0)" ::: "memory");
    }
    if (FINAL) {
        const float qr = aq.z, qi = aq.w;
        const float* sl = SLOC + (size_t)((b * G_A + g) * S5NC) * 128 + lane;
        float psr[31], psi[31];
#pragma unroll
        for (int k = 0; k < 31; ++k) { const int kk = k < c ? k : 0; psr[k] = sl[kk * 128]; psi[k] = sl[kk * 128 + 64]; }
#pragma unroll
        for (int k = 0; k < 31; ++k) if (k < c) { const float t = qr * hr - qi * hi + psr[k]; hi = qr * hi + qi * hr + psi[k]; hr = t; }
    }
    LAS bf16* Hs = (LAS bf16*)wl;
    bf16x8 cfr[4];
    if (FINAL) { const bf16* ct = (const bf16*)(ws + WS_SMALL + SM_S5CT) + (size_t)((l * G_A + g) * S5G + (lane & 15)) * 128 + 8 * (lane >> 4);
#pragma unroll
        for (int ks = 0; ks < 4; ++ks) cfr[ks] = *(const GAS bf16x8*)(ct + 32 * ks); }
#pragma unroll 1
    for (int half = 0; half < 2; ++half) {
#pragma unroll 2
        for (int tt = 0; tt < 32; ++tt) {
            const int t = half * 32 + tt;
            unsigned w[8];
            w[0] = __builtin_amdgcn_readlane(u0.x, t); w[1] = __builtin_amdgcn_readlane(u0.y, t); w[2] = __builtin_amdgcn_readlane(u0.z, t); w[3] = __builtin_amdgcn_readlane(u0.w, t);
            w[4] = __builtin_amdgcn_readlane(u1.x, t); w[5] = __builtin_amdgcn_readlane(u1.y, t); w[6] = __builtin_amdgcn_readlane(u1.z, t); w[7] = __builtin_amdgcn_readlane(u1.w, t);
            float sr0 = 0.f, si0 = 0.f, sr1 = 0.f, si1 = 0.f;
#pragma unroll
            for (int k = 0; k < 8; k += 2) {
                sr0 = __builtin_amdgcn_fdot2_f32_bf16(__builtin_bit_cast(bf16x2_t, brp[k]), __builtin_bit_cast(bf16x2_t, w[k]), sr0, false);
                si0 = __builtin_amdgcn_fdot2_f32_bf16(__builtin_bit_cast(bf16x2_t, bip[k]), __builtin_bit_cast(bf16x2_t, w[k]), si0, false);
                sr1 = __builtin_amdgcn_fdot2_f32_bf16(__builtin_bit_cast(bf16x2_t, brp[k + 1]), __builtin_bit_cast(bf16x2_t, w[k + 1]), sr1, false);
                si1 = __builtin_amdgcn_fdot2_f32_bf16(__builtin_bit_cast(bf16x2_t, bip[k + 1]), __builtin_bit_cast(bf16x2_t, w[k + 1]), si1, false); }
            const float sr = sr0 + sr1, si = si0 + si1;
            const float nr = ar * hr - ai * hi + sr; hi = ar * hi + ai * hr + si; hr = nr;
            if (FINAL) { Hs[tt * HS_PITCH + lane] = (bf16)f2bf(hr); Hs[tt * HS_PITCH + 64 + lane] = (bf16)f2bf(hi); }
        }
        if (FINAL) {
            bf16* YB = (bf16*)(ws + WS_YB);
            const float* dsk = A->in[I_S5D] + l * D_A + g * 16;
#pragma unroll
            for (int tile = 0; tile < 2; ++tile) {
                f32x4 acc = {0.f, 0.f, 0.f, 0.f};
#pragma unroll
                for (int ks = 0; ks < 4; ++ks) { const bf16x8 a = *(const LAS bf16x8*)(Hs + (tile * 16 + (lane & 15)) * HS_PITCH + 32 * ks + 8 * (lane >> 4));
                    acc = __builtin_amdgcn_mfma_f32_16x16x32_bf16(a, cfr[ks], acc, 0, 0, 0); }
                const int hh = lane & 15; const float dd = dsk[hh];
#pragma unroll
                for (int r = 0; r < 4; ++r) { const int row = row0 + half * 32 + tile * 16 + 4 * (lane >> 4) + r;
                    const float u = bf2f(Us[(row - row0) * 16 + hh]);
                    YB[(size_t)row * 512 + g * 16 + hh] = (bf16)f2bf(gelu_tanh(acc[r] + dd * u)); }
            }
        }
    }
    if (!FINAL) { float* sl = SLOC + (size_t)item * 128 + lane; sl[0] = hr; sl[64] = hi; }
    if (FINAL && c == S5NC - 1) { const size_t o = (size_t)((l * NB + b) * G_A + g) * P_A + lane; out[O_S5RP + o] = hr; out[O_S5IP + o] = hi; }
}

__device__ __forceinline__ void s5_item_lin(KArgs A, unsigned char* ws, float* out, int l, int item, LAS unsigned char* wl, int lane, unsigned* flags) {
    const int c = item & 31, g = (item >> 5) & 31, b = item >> 10;
    const int lgp = (l * G_A + g) * P_A + lane;
    const f32x4 aq = *(const GAS f32x4*)((const float*)(ws + WS_SMALL + SM_S5A) + (size_t)lgp * 4);
    const float ar = aq.x, ai = aq.y;
    unsigned brp[8], bip[8];
    {   const GAS f32x4* bb = (const GAS f32x4*)((const float*)(ws + WS_SMALL + SM_S5BB) + (size_t)lgp * 32);
#pragma unroll
        for (int q = 0; q < 4; ++q) { const f32x4 v = bb[q], w = bb[4 + q]; brp[2 * q] = pk2(v.x, v.y); brp[2 * q + 1] = pk2(v.z, v.w); bip[2 * q] = pk2(w.x, w.y); bip[2 * q + 1] = pk2(w.z, w.w); } }
    const int row0 = b * SEQ + c * S5Q;
    const bf16* PROJ = (const bf16*)(ws + WS_BIG);
    const GAS v4u* up = (const GAS v4u*)(PROJ + (size_t)(row0 + lane) * N_INP + PC_UA + g * 16);
    const v4u u0 = up[0], u1 = up[1];
    LAS bf16* Us = (LAS bf16*)(wl + 8704);
    *(LAS v4u*)(Us + lane * 16) = u0; *(LAS v4u*)(Us + lane * 16 + 8) = u1;
    LAS bf16* Hs = (LAS bf16*)wl;
    bf16x8 cfr[4];
    {   const bf16* ct = (const bf16*)(ws + WS_SMALL + SM_S5CT) + (size_t)((l * G_A + g) * S5G + (lane & 15)) * 128 + 8 * (lane >> 4);
#pragma unroll
        for (int ks = 0; ks < 4; ++ks) cfr[ks] = *(const GAS bf16x8*)(ct + 32 * ks); }
    f32x4 yl[2][2];
    float lr = 0.f, li = 0.f;
#pragma unroll
    for (int half = 0; half < 2; ++half) {
#pragma unroll 2
        for (int tt = 0; tt < 32; ++tt) {
            const int t = half * 32 + tt;
            unsigned w[8];
            { const v4u wa_ = *(const LAS v4u*)(Us + t * 16), wb_ = *(const LAS v4u*)(Us + t * 16 + 8);
              w[0] = wa_.x; w[1] = wa_.y; w[2] = wa_.z; w[3] = wa_.w; w[4] = wb_.x; w[5] = wb_.y; w[6] = wb_.z; w[7] = wb_.w; }
            float sr0 = 0.f, si0 = 0.f, sr1 = 0.f, si1 = 0.f;
#pragma unroll
            for (int k = 0; k < 8; k += 2) {
                sr0 = __builtin_amdgcn_fdot2_f32_bf16(__builtin_bit_cast(bf16x2_t, brp[k]), __builtin_bit_cast(bf16x2_t, w[k]), sr0, false);
                si0 = __builtin_amdgcn_fdot2_f32_bf16(__builtin_bit_cast(bf16x2_t, bip[k]), __builtin_bit_cast(bf16x2_t, w[k]), si0, false);
                sr1 = __builtin_amdgcn_fdot2_f32_bf16(__builtin_bit_cast(bf16x2_t, brp[k + 1]), __builtin_bit_cast(bf16x2_t, w[k + 1]), sr1, false);
                si1 = __builtin_amdgcn_fdot2_f32_bf16(__builtin_bit_cast(bf16x2_t, bip[k + 1]), __builtin_bit_cast(bf16x2_t, w[k + 1]), si1, false); }
            const float nr = ar * lr - ai * li + (sr0 + sr1); li = ar * li + ai * lr + (si0 + si1); lr = nr;
            { const unsigned pk = pg8::cvt_pk_bf16(lr, li); Hs[tt * HS_PITCH + lane] = (bf16)(pk & 0xffffu); Hs[tt * HS_PITCH + 64 + lane] = (bf16)(pk >> 16); }
        }
#pragma unroll
        for (int tile = 0; tile < 2; ++tile) { f32x4 acc = {0.f, 0.f, 0.f, 0.f};
#pragma unroll
            for (int ks = 0; ks < 4; ++ks) { const bf16x8 a = *(const LAS bf16x8*)(Hs + (tile * 16 + (lane & 15)) * HS_PITCH + 32 * ks + 8 * (lane >> 4));
                acc = __builtin_amdgcn_mfma_f32_16x16x32_bf16(a, cfr[ks], acc, 0, 0, 0); }
            yl[half][tile] = acc; }
        asm volatile("s_waitcnt lgkmcnt(0)" ::: "memory");
    }
    float* SLOC = (float*)(ws + WS_SMALL + SM_SLOC);
    {   float* sl = SLOC + (size_t)item * 128 + lane;
        __hip_atomic_store(sl, lr, __ATOMIC_RELAXED, __HIP_MEMORY_SCOPE_AGENT); __hip_atomic_store(sl + 64, li, __ATOMIC_RELAXED, __HIP_MEMORY_SCOPE_AGENT);
        asm volatile("s_waitcnt vmcnt(0)" ::: "memory");
        if (lane == 0) __hip_atomic_store(flags + item, 1u, __ATOMIC_RELAXED, __HIP_MEMORY_SCOPE_AGENT);
        unsigned sp_ = 0;
        for (;;) { const unsigned f = lane < c ? __hip_atomic_load(flags + (item - c + lane), __ATOMIC_RELAXED, __HIP_MEMORY_SCOPE_AGENT) : 1u;
            if (__builtin_amdgcn_ballot_w64(f == 0u) == 0ull || ++sp_ > (1u << 20)) break; __builtin_amdgcn_s_sleep(1); }
        __builtin_amdgcn_fence(__ATOMIC_ACQUIRE, "agent");
        asm volatile("s_waitcnt vmcnt(0)" ::: "memory"); }
    float hr = 0.f, hi = 0.f;
    {   const float qr = aq.z, qi = aq.w;
        const float* sl = SLOC + (size_t)((b * G_A + g) * S5NC) * 128 + lane;
        float psr[31], psi[31];
#pragma unroll
        for (int k = 0; k < 31; ++k) { const int kk = k < c ? k : 0; psr[k] = sl[kk * 128]; psi[k] = sl[kk * 128 + 64]; }
#pragma unroll
        for (int k = 0; k < 31; ++k) if (k < c) { const float t = qr * hr - qi * hi + psr[k]; hi = qr * hi + qi * hr + psi[k]; hr = t; } }
    float pr = ar, pi = ai;
    bf16* YB = (bf16*)(ws + WS_YB);
    const float* dsk = A->in[I_S5D] + l * D_A + g * 16;
#pragma unroll
    for (int half = 0; half < 2; ++half) {
#pragma unroll 4
        for (int tt = 0; tt < 32; ++tt) {
            const float cr_ = pr * hr - pi * hi, ci_ = pr * hi + pi * hr;
            { const unsigned pk = pg8::cvt_pk_bf16(cr_, ci_); Hs[tt * HS_PITCH + lane] = (bf16)(pk & 0xffffu); Hs[tt * HS_PITCH + 64 + lane] = (bf16)(pk >> 16); }
            const float np = pr * ar - pi * ai; pi = pr * ai + pi * ar; pr = np;
        }
#pragma unroll
        for (int tile = 0; tile < 2; ++tile) { f32x4 acc = yl[half][tile];
#pragma unroll
            for (int ks = 0; ks < 4; ++ks) { const bf16x8 a = *(const LAS bf16x8*)(Hs + (tile * 16 + (lane & 15)) * HS_PITCH + 32 * ks + 8 * (lane >> 4));
                acc = __builtin_amdgcn_mfma_f32_16x16x32_bf16(a, cfr[ks], acc, 0, 0, 0); }
            const int hh = lane & 15; const float dd = dsk[hh];
#pragma unroll
            for (int r = 0; r < 4; ++r) { const int row = row0 + half * 32 + tile * 16 + 4 * (lane >> 4) + r;
                const float u = bf2f(Us[(row - row0) * 16 + hh]);
                YB[(size_t)row * 512 + g * 16 + hh] = (bf16)f2bf(gelu_tanh(acc[r] + dd * u)); } }
        asm volatile("s_waitcnt lgkmcnt(0)" ::: "memory");
    }
    if (c == S5NC - 1) { const float qr = aq.z, qi = aq.w; const size_t o = (size_t)((l * NB + b) * G_A + g) * P_A + lane;
        out[O_S5RP + o] = lr + (qr * hr - qi * hi); out[O_S5IP + o] = li + (qr * hi + qi * hr); }
}

__device__ __forceinline__ void s5_sample_item(KArgs A, unsigned char* ws, float* out, int l, int item, int lane) {
    const int g = item & 31, s = item >> 5, row = MPROMPT + s;
    const int lgp = (l * G_A + g) * P_A + lane;
    const f32x4 aq = *(const GAS f32x4*)((const float*)(ws + WS_SMALL + SM_S5A) + (size_t)lgp * 4);
    const bf16* PROJ = (const bf16*)(ws + WS_BIG);
    const GAS v4u* up = (const GAS v4u*)(PROJ + (size_t)row * N_INP + PC_UA + g * 16);
    const v4u u0 = up[0], u1 = up[1];
    float u[16]; u[0] = bflo(u0.x); u[1] = bfhi(u0.x); u[2] = bflo(u0.y); u[3] = bfhi(u0.y); u[4] = bflo(u0.z); u[5] = bfhi(u0.z); u[6] = bflo(u0.w); u[7] = bfhi(u0.w);
    u[8] = bflo(u1.x); u[9] = bfhi(u1.x); u[10] = bflo(u1.y); u[11] = bfhi(u1.y); u[12] = bflo(u1.z); u[13] = bfhi(u1.z); u[14] = bflo(u1.w); u[15] = bfhi(u1.w);
    const GAS f32x4* bb = (const GAS f32x4*)((const float*)(ws + WS_SMALL + SM_S5BB) + (size_t)lgp * 32);
    float sr = 0.f, si = 0.f;
#pragma unroll
    for (int q = 0; q < 4; ++q) { const f32x4 v = bb[q], w = bb[4 + q];
        sr += v.x * u[4 * q] + v.y * u[4 * q + 1] + v.z * u[4 * q + 2] + v.w * u[4 * q + 3];
        si += w.x * u[4 * q] + w.y * u[4 * q + 1] + w.z * u[4 * q + 2] + w.w * u[4 * q + 3]; }
    const size_t so = (size_t)((l * NS + s) * G_A + g) * P_A + lane;
    const float h0r = A->in[I_S5RE][so], h0i = A->in[I_S5IM][so];
    const float hr = aq.x * h0r - aq.y * h0i + sr, hi = aq.x * h0i + aq.y * h0r + si;
    out[O_S5RS + so] = hr; out[O_S5IS + so] = hi;
    const float* cre = A->in[I_CRE] + (size_t)((l * G_A + g) * S5G) * P_A + lane; const float* cim = A->in[I_CIM] + (size_t)((l * G_A + g) * S5G) * P_A + lane;
    float y16[16];
#pragma unroll
    for (int hh = 0; hh < 16; ++hh) y16[hh] = cre[hh * P_A] * hr - cim[hh * P_A] * hi;
    const float mine = wave_sum16(y16, lane);
    if (lane < 16) { const float dd = A->in[I_S5D][l * D_A + g * 16 + lane]; float uu = 0.f;
#pragma unroll
        for (int hh = 0; hh < 16; ++hh) uu = (lane == hh) ? u[hh] : uu;
        ((bf16*)(ws + WS_YB))[(size_t)row * 512 + g * 16 + lane] = (bf16)f2bf(gelu_tanh(mine + dd * uu)); }
}
__device__ __forceinline__ void gmlp_sample_item(KArgs A, unsigned char* ws, float* out, int l, int s, int lane) {
    const int row = MPROMPT + s, ch0 = lane * 8;
    const bf16* PROJ = (const bf16*)(ws + WS_BIG);
    const v4u vv = *(const GAS v4u*)(PROJ + (size_t)row * N_INP + PC_VB + ch0), uu = *(const GAS v4u*)(PROJ + (size_t)row * N_INP + PC_UB + ch0);
    const float rinv = rsqrtf(((const float*)(ws + WS_SMALL + SM_VSQ))[l * MP + row] * (1.0f / D_B) + EPS);
    const int h = ch0 >> 6;
    const float w00 = A->in[I_WS][(size_t)(l * H_B + h) * 128 * 128], b0 = A->in[I_BS][(l * H_B + h) * 128];
    float v[8] = {bflo(vv.x), bfhi(vv.x), bflo(vv.y), bfhi(vv.y), bflo(vv.z), bfhi(vv.z), bflo(vv.w), bfhi(vv.w)};
    float u[8] = {bflo(uu.x), bfhi(uu.x), bflo(uu.y), bfhi(uu.y), bflo(uu.z), bfhi(uu.z), bflo(uu.w), bfhi(uu.w)};
    const float* gv = A->in[I_GV] + l * D_B + ch0;
    float o[8];
#pragma unroll
    for (int j = 0; j < 8; ++j) { const float vn = v[j] * rinv * gv[j]; out[O_GVS + (size_t)(l * NS + s) * D_B + ch0 + j] = vn; o[j] = u[j] * (w00 * vn + b0); }
    v4u w; w.x = pk2(o[0], o[1]); w.y = pk2(o[2], o[3]); w.z = pk2(o[4], o[5]); w.w = pk2(o[6], o[7]);
    *(GAS v4u*)((bf16*)(ws + WS_OCAT) + (size_t)row * OCP + OC_B + ch0) = w;
}
__device__ __forceinline__ void ssd_sample_item(KArgs A, unsigned char* ws, float* out, int l, int item, int lane, bool acc) {
    const int h = item & 15, s = item >> 4, row = MPROMPT + s, g = h >> 3;
    const bf16* PROJ = (const bf16*)(ws + WS_BIG);
    const float* cw = A->in[I_CONVW] + (size_t)l * K_C * D_XBC; const float* cb = A->in[I_CONVB] + l * D_XBC;
    const float* cst = A->in[I_SSDCONV] + (size_t)(l * NS + s) * 3 * D_XBC;
    float* cso = out + O_CCS + (size_t)(l * NS + s) * 3 * D_XBC;
    float x;
    {   const int ch = h * 64 + lane; const float p0 = cst[ch], p1 = cst[D_XBC + ch], p2 = cst[2 * D_XBC + ch], p3 = bf2f(PROJ[(size_t)row * N_INP + PC_XBC + ch]);
        x = siluf_(cb[ch] + cw[ch] * p0 + cw[D_XBC + ch] * p1 + cw[2 * D_XBC + ch] * p2 + cw[3 * D_XBC + ch] * p3);
        cso[ch] = p1; cso[D_XBC + ch] = p2; cso[2 * D_XBC + ch] = p3; }
    const int n4 = (lane & 31) * 4; float Bv[4], Cv[4];
#pragma unroll
    for (int j = 0; j < 4; ++j) {
        {   const int ch = D_C + g * N_C + n4 + j; const float p0 = cst[ch], p1 = cst[D_XBC + ch], p2 = cst[2 * D_XBC + ch], p3 = bf2f(PROJ[(size_t)row * N_INP + PC_XBC + ch]);
            Bv[j] = siluf_(cb[ch] + cw[ch] * p0 + cw[D_XBC + ch] * p1 + cw[2 * D_XBC + ch] * p2 + cw[3 * D_XBC + ch] * p3);
            if ((h & 7) == 0 && lane < 32) { cso[ch] = p1; cso[D_XBC + ch] = p2; cso[2 * D_XBC + ch] = p3; } }
        {   const int ch = D_C + G_C * N_C + g * N_C + n4 + j; const float p0 = cst[ch], p1 = cst[D_XBC + ch], p2 = cst[2 * D_XBC + ch], p3 = bf2f(PROJ[(size_t)row * N_INP + PC_XBC + ch]);
            Cv[j] = siluf_(cb[ch] + cw[ch] * p0 + cw[D_XBC + ch] * p1 + cw[2 * D_XBC + ch] * p2 + cw[3 * D_XBC + ch] * p3);
            if ((h & 7) == 0 && lane < 32) { cso[ch] = p1; cso[D_XBC + ch] = p2; cso[2 * D_XBC + ch] = p3; } }
    }
    const float dt = softplusf_(((const float*)(ws + WS_SMALL + SM_DT))[(size_t)row * 16 + h] + A->in[I_DTBIAS][l * H_C + h]);
    const float dA = __expf(dt * -__expf(A->in[I_ALOG][l * H_C + h]));
    const size_t sbase = (size_t)((l * NS + s) * H_C + h) * HD_C * N_C;
    const GAS f32x4* st = (const GAS f32x4*)(A->in[I_SSM] + sbase) + lane;
    GAS f32x4* so = (GAS f32x4*)(out + O_SSMS + sbase) + lane;
    float part[32];
#pragma unroll
    for (int i = 0; i < 32; ++i) {
        const float xe = lane_bcast(x, 2 * i), xo = lane_bcast(x, 2 * i + 1); const float xv = lane < 32 ? xe : xo; const float xd = xv * dt;
        f32x4 v = __builtin_nontemporal_load(st + 64 * i);
        v.x = v.x * dA + xd * Bv[0]; v.y = v.y * dA + xd * Bv[1]; v.z = v.z * dA + xd * Bv[2]; v.w = v.w * dA + xd * Bv[3];
        __builtin_nontemporal_store(v, so + 64 * i);
        part[i] = v.x * Cv[0] + v.y * Cv[1] + v.z * Cv[2] + v.w * Cv[3];
    }
    const float ymine = half_sum32(part, lane);
    const float xmine = __builtin_bit_cast(float, __builtin_amdgcn_ds_bpermute((2 * (lane & 31) + (lane >> 5)) << 2, __builtin_bit_cast(int, x)));
    const int p = 2 * (lane & 31) + (lane >> 5), ch = h * 64 + p;
    const float y = ymine + A->in[I_SSDD][l * H_C + h] * xmine;
    const float z = bf2f(PROJ[(size_t)row * N_INP + PC_Z + ch]);
    const float yz = y * siluf_(z);
    const float sq = wave_sum(yz * yz);
    if (lane == 0 && acc) atomicAdd((float*)(ws + WS_SMALL + SM_CSQ) + l * MP + row, sq);
    ((bf16*)(ws + WS_OCAT))[(size_t)row * OCP + OC_C + ch] = (bf16)f2bf(yz * A->in[I_GNORM][l * D_C + ch]);
}
constexpr int TP = 136;
__device__ __forceinline__ void gmlp_item(KArgs A, unsigned char* ws, int l, int item, LAS unsigned char* lds, int tid, int wave, int lane) {
    const int h = item & 7, c = (item >> 3) & 15, b = item >> 7, row0 = b * SEQ + c * GMC;
    const bf16* PROJ = (const bf16*)(ws + WS_BIG);
    LAS bf16* vT = (LAS bf16*)lds;
    {   const int tok = tid >> 2, part = tid & 3, d0 = part * 16, row = row0 + tok;
        const float rinv = rsqrtf(((const float*)(ws + WS_SMALL + SM_VSQ))[l * MP + row] * (1.0f / D_B) + EPS);
        const GAS v4u* vp = (const GAS v4u*)(PROJ + (size_t)row * N_INP + PC_VB + h * 64 + d0);
        const v4u a = vp[0], b2 = vp[1];
        const float* gv = A->in[I_GV] + l * D_B + h * 64 + d0;
        const unsigned wv[8] = {a.x, a.y, a.z, a.w, b2.x, b2.y, b2.z, b2.w};
#pragma unroll
        for (int k = 0; k < 8; ++k) { vT[(d0 + 2 * k) * TP + tok] = (bf16)f2bf(bflo(wv[k]) * rinv * gv[2 * k]); vT[(d0 + 2 * k + 1) * TP + tok] = (bf16)f2bf(bfhi(wv[k]) * rinv * gv[2 * k + 1]); }
    }
    const bf16* WSb = (const bf16*)(ws + WS_SMALL + SM_WS) + (size_t)(l * H_B + h) * 128 * 128;
    bf16x8 afr[4];
#pragma unroll
    for (int ks = 0; ks < 4; ++ks) afr[ks] = *(const GAS bf16x8*)(WSb + (size_t)(16 * wave + (lane & 15)) * 128 + 32 * ks + 8 * (lane >> 4));
    __syncthreads();
    f32x4 acc[4];
#pragma unroll
    for (int t = 0; t < 4; ++t) acc[t] = (f32x4){0.f, 0.f, 0.f, 0.f};
    const int nks = (wave >> 1) + 1;
#pragma unroll
    for (int ks = 0; ks < 4; ++ks) if (ks < nks) {
#pragma unroll
        for (int t = 0; t < 4; ++t) { const bf16x8 bfr = *(const LAS bf16x8*)(vT + (16 * t + (lane & 15)) * TP + 32 * ks + 8 * (lane >> 4));
            acc[t] = __builtin_amdgcn_mfma_f32_16x16x32_bf16(afr[ks], bfr, acc[t], 0, 0, 0); }
    }
    bf16* OB = (bf16*)(ws + WS_OCAT) + OC_B;
#pragma unroll
    for (int r = 0; r < 4; ++r) { const int i = 16 * wave + 4 * (lane >> 4) + r, row = row0 + i; const float bs = A->in[I_BS][(l * H_B + h) * 128 + i];
#pragma unroll
        for (int t = 0; t < 4; ++t) { const int ch = h * 64 + 16 * t + (lane & 15);
            const float u = bf2f(PROJ[(size_t)row * N_INP + PC_UB + ch]);
            OB[(size_t)row * OCP + ch] = (bf16)f2bf(u * (acc[t][r] + bs)); } }
    __syncthreads();
}

template <int NCH, bool TRANS>
__device__ __forceinline__ void conv_tile(KArgs A, const bf16* PROJ, int l, int b, int c, int chb, LAS bf16* tile, const LAS float* scale, int tid) {
    constexpr int LPR = NCH / 8, SLOTS = NTHR / LPR, TPT = 128 / SLOTS;
    const int cl = tid % LPR, slot = tid / LPR, ch0 = chb + cl * 8, t0 = slot * TPT;
    const float* cw = A->in[I_CONVW] + (size_t)l * K_C * D_XBC + ch0; const float* cb = A->in[I_CONVB] + l * D_XBC + ch0;
    float w[4][8], bias[8];
#pragma unroll
    for (int k = 0; k < 4; ++k) { const f32x4 a = *(const GAS f32x4*)(cw + k * D_XBC), b2 = *(const GAS f32x4*)(cw + k * D_XBC + 4);
        w[k][0] = a.x; w[k][1] = a.y; w[k][2] = a.z; w[k][3] = a.w; w[k][4] = b2.x; w[k][5] = b2.y; w[k][6] = b2.z; w[k][7] = b2.w; }
    {   const f32x4 a = *(const GAS f32x4*)cb, b2 = *(const GAS f32x4*)(cb + 4); bias[0] = a.x; bias[1] = a.y; bias[2] = a.z; bias[3] = a.w; bias[4] = b2.x; bias[5] = b2.y; bias[6] = b2.z; bias[7] = b2.w; }
    const int trow0 = c * SSDQ + t0;
    v4u raw[TPT + 3];
#pragma unroll
    for (int i = 0; i < TPT + 3; ++i) { const int tt = trow0 - 3 + i;
        raw[i] = tt >= 0 ? *(const GAS v4u*)(PROJ + (size_t)(b * SEQ + tt) * N_INP + PC_XBC + ch0) : (v4u){0u, 0u, 0u, 0u}; }
    float o[TPT][8];
#pragma unroll
    for (int t = 0; t < TPT; ++t) {
#pragma unroll
        for (int e = 0; e < 8; ++e) o[t][e] = bias[e];
#pragma unroll
        for (int k = 0; k < 4; ++k) { const v4u r = raw[t + k]; const unsigned rw[4] = {r.x, r.y, r.z, r.w};
#pragma unroll
            for (int e2 = 0; e2 < 4; ++e2) { o[t][2 * e2] = fmaf(w[k][2 * e2], bflo(rw[e2]), o[t][2 * e2]); o[t][2 * e2 + 1] = fmaf(w[k][2 * e2 + 1], bfhi(rw[e2]), o[t][2 * e2 + 1]); } }
        const float sc = scale ? scale[t0 + t] : 1.0f;
#pragma unroll
        for (int e = 0; e < 8; ++e) o[t][e] = siluf_(o[t][e]) * sc;
    }
    if (!TRANS) {
#pragma unroll
        for (int t = 0; t < TPT; ++t) { v4u wv; wv.x = pk2(o[t][0], o[t][1]); wv.y = pk2(o[t][2], o[t][3]); wv.z = pk2(o[t][4], o[t][5]); wv.w = pk2(o[t][6], o[t][7]);
            *(LAS v4u*)(tile + (t0 + t) * TP + cl * 8) = wv; }
    } else {
#pragma unroll
        for (int e = 0; e < 8; ++e) {
            if (TPT == 4) { v2u wv; wv.x = pk2(o[0][e], o[1][e]); wv.y = pk2(o[TPT > 2 ? 2 : 0][e], o[TPT > 3 ? 3 : 0][e]); *(LAS v2u*)(tile + (cl * 8 + e) * TP + t0) = wv; }
            else { *(LAS unsigned*)(tile + (cl * 8 + e) * TP + t0) = pk2(o[0][e], o[1][e]); }
        }
    }
}

__device__ __forceinline__ void ssd_dt_scan(KArgs A, unsigned char* ws, int l, int b, int c, int h, LAS float* dtv, LAS float* cs, int tid, int lane) {
    if (tid < 64) {
        const float* DT = (const float*)(ws + WS_SMALL + SM_DT); const float bias = A->in[I_DTBIAS][l * H_C + h], a = -__expf(A->in[I_ALOG][l * H_C + h]);
        const int row = b * SEQ + c * SSDQ + 2 * lane;
        const float d0 = softplusf_(DT[(size_t)row * 16 + h] + bias), d1 = softplusf_(DT[(size_t)(row + 1) * 16 + h] + bias);
        const float v0 = d0 * a, v1 = d1 * a; float s = v0 + v1;
#pragma unroll
        for (int o = 1; o < 64; o <<= 1) { const float t = __builtin_bit_cast(float, __builtin_amdgcn_ds_bpermute((lane - o) << 2, __builtin_bit_cast(int, s))); if (lane >= o) s += t; }
        dtv[2 * lane] = d0; dtv[2 * lane + 1] = d1; cs[2 * lane] = s - v1; cs[2 * lane + 1] = s;
    }
    __syncthreads();
}

constexpr int SL_CN = 0, SL_BN = 34816, SL_MW = 69632, SL_XT = 104448, SL_HP = 121856, SL_DT = 139264, SL_CS = SL_DT + 512, SL_SC = SL_CS + 512, SL_END = SL_SC + 512;

__device__ __forceinline__ void ssd_item1(KArgs A, unsigned char* ws, int l, int item, LAS unsigned char* lds, int tid, int wave, int lane) {
    const int h = item & 15, c = (item >> 4) & 15, b = item >> 8, g = h >> 3;
    const bf16* PROJ = (const bf16*)(ws + WS_BIG);
    LAS float* dtv = (LAS float*)(lds + SL_DT); LAS float* cs = (LAS float*)(lds + SL_CS); LAS float* sc = (LAS float*)(lds + SL_SC);
    LAS bf16* Xt = (LAS bf16*)(lds + SL_XT); LAS bf16* Bt = (LAS bf16*)(lds + SL_BN);
    (void)sc;
    conv_tile<64, true>(A, PROJ, l, b, c, h * 64, Xt, nullptr, tid);
    conv_tile<128, true>(A, PROJ, l, b, c, D_C + g * N_C, Bt, nullptr, tid);
    ssd_dt_scan(A, ws, l, b, c, h, dtv, cs, tid, lane);
    f32x4 acc[4];
#pragma unroll
    for (int t = 0; t < 4; ++t) acc[t] = (f32x4){0.f, 0.f, 0.f, 0.f};
    const float cse = cs[127];
#pragma unroll
    for (int ks = 0; ks < 4; ++ks) { const int j0 = 32 * ks + 8 * (lane >> 4);
        const v4u braw = *(const LAS v4u*)(Bt + (16 * wave + (lane & 15)) * TP + j0);
        const f32x4 d0 = *(const LAS f32x4*)(dtv + j0), d1 = *(const LAS f32x4*)(dtv + j0 + 4), c0 = *(const LAS f32x4*)(cs + j0), c1 = *(const LAS f32x4*)(cs + j0 + 4);
        v4u bs;
        bs.x = pk2(bflo(braw.x) * d0.x * __expf(cse - c0.x), bfhi(braw.x) * d0.y * __expf(cse - c0.y)); bs.y = pk2(bflo(braw.y) * d0.z * __expf(cse - c0.z), bfhi(braw.y) * d0.w * __expf(cse - c0.w));
        bs.z = pk2(bflo(braw.z) * d1.x * __expf(cse - c1.x), bfhi(braw.z) * d1.y * __expf(cse - c1.y)); bs.w = pk2(bflo(braw.w) * d1.z * __expf(cse - c1.z), bfhi(braw.w) * d1.w * __expf(cse - c1.w));
        const bf16x8 bfr = __builtin_bit_cast(bf16x8, bs);
#pragma unroll
        for (int t = 0; t < 4; ++t) { const bf16x8 af = *(const LAS bf16x8*)(Xt + (16 * t + (lane & 15)) * TP + 32 * ks + 8 * (lane >> 4));
            acc[t] = __builtin_amdgcn_mfma_f32_16x16x32_bf16(af, bfr, acc[t], 0, 0, 0); } }
    float* ST = (float*)(ws + WS_STATES) + (size_t)item * HD_C * N_C;
#pragma unroll
    for (int t = 0; t < 4; ++t)
#pragma unroll
        for (int r = 0; r < 4; ++r) ST[(size_t)(16 * t + 4 * (lane >> 4) + r) * N_C + 16 * wave + (lane & 15)] = acc[t][r];
    if (tid == 0) ((float*)(ws + WS_SMALL + SM_SDEC))[item] = __expf(cs[127]);
    __syncthreads();
}

__device__ __forceinline__ void ssd_item2(KArgs A, unsigned char* ws, float* out, int l, int item, LAS unsigned char* lds, int tid, int wave, int lane, bool acc) {
    const int h = item & 15, c = (item >> 4) & 15, b = item >> 8, g = h >> 3, row0 = b * SEQ + c * SSDQ;
    const bf16* PROJ = (const bf16*)(ws + WS_BIG);
    LAS float* dtv = (LAS float*)(lds + SL_DT); LAS float* cs = (LAS float*)(lds + SL_CS);
    LAS bf16* Cn = (LAS bf16*)(lds + SL_CN); LAS bf16* Bn = (LAS bf16*)(lds + SL_BN); LAS bf16* Mw = (LAS bf16*)(lds + SL_MW);
    LAS bf16* Xt = (LAS bf16*)(lds + SL_XT); LAS bf16* Hp = (LAS bf16*)(lds + SL_HP);
    conv_tile<64, true>(A, PROJ, l, b, c, h * 64, Xt, nullptr, tid);
    conv_tile<128, false>(A, PROJ, l, b, c, D_C + g * N_C, Bn, nullptr, tid);
    conv_tile<128, false>(A, PROJ, l, b, c, D_C + G_C * N_C + g * N_C, Cn, nullptr, tid);
    {   const float* ST = (const float*)(ws + WS_STATES) + (size_t)((b * 16) * 16 + h) * HD_C * N_C + tid * 4;
        const float* SD = (const float*)(ws + WS_SMALL + SM_SDEC) + (b * 16) * 16 + h;
        f32x4 hv[4];
#pragma unroll
        for (int k = 0; k < 4; ++k) hv[k] = (f32x4){0.f, 0.f, 0.f, 0.f};
        int cc = 0;
        for (; cc + 4 <= c; cc += 4) { f32x4 sv[4][4]; float d[4];
#pragma unroll
            for (int q = 0; q < 4; ++q) { d[q] = SD[(cc + q) * 16];
#pragma unroll
                for (int k = 0; k < 4; ++k) sv[q][k] = *(const GAS f32x4*)(ST + (size_t)(cc + q) * 16 * 8192 + 2048 * k); }
#pragma unroll
            for (int q = 0; q < 4; ++q)
#pragma unroll
                for (int k = 0; k < 4; ++k) hv[k] = hv[k] * d[q] + sv[q][k]; }
        for (; cc < c; ++cc) { const float d = SD[cc * 16];
#pragma unroll
            for (int k = 0; k < 4; ++k) hv[k] = hv[k] * d + *(const GAS f32x4*)(ST + (size_t)cc * 16 * 8192 + 2048 * k); }
#pragma unroll
        for (int k = 0; k < 4; ++k) { v2u wv; wv.x = pk2(hv[k].x, hv[k].y); wv.y = pk2(hv[k].z, hv[k].w); *(LAS v2u*)(Hp + ((tid >> 5) + 16 * k) * TP + (tid & 31) * 4) = wv; }
        if (c == SSDNC - 1) { const float d = SD[c * 16]; float* o = out + O_SSMP + (size_t)((l * NB + b) * H_C + h) * HD_C * N_C + tid * 4;
#pragma unroll
            for (int k = 0; k < 4; ++k) *(GAS f32x4*)(o + 2048 * k) = hv[k] * d + *(const GAS f32x4*)(ST + (size_t)c * 16 * 8192 + 2048 * k); }
    }
    ssd_dt_scan(A, ws, l, b, c, h, dtv, cs, tid, lane);
    bf16x8 cf[4];
#pragma unroll
    for (int ks = 0; ks < 4; ++ks) cf[ks] = *(const LAS bf16x8*)(Cn + (16 * wave + (lane & 15)) * TP + 32 * ks + 8 * (lane >> 4));
    const int jtmax = wave | 1;
    for (int jt = 0; jt <= jtmax; ++jt) {
        f32x4 gacc = {0.f, 0.f, 0.f, 0.f};
        if (jt <= wave) {
#pragma unroll
            for (int ks = 0; ks < 4; ++ks) { const bf16x8 bfr = *(const LAS bf16x8*)(Bn + (16 * jt + (lane & 15)) * TP + 32 * ks + 8 * (lane >> 4));
                gacc = __builtin_amdgcn_mfma_f32_16x16x32_bf16(cf[ks], bfr, gacc, 0, 0, 0); }
        }
        const int j = 16 * jt + (lane & 15); const float csj = cs[j], dtj = dtv[j];
#pragma unroll
        for (int r = 0; r < 4; ++r) { const int i = 16 * wave + 4 * (lane >> 4) + r;
            const float m = (j <= i) ? gacc[r] * __expf(cs[i] - csj) * dtj : 0.f;
            Mw[i * TP + j] = (bf16)f2bf(m); }
    }
    f32x4 yd[4], yo[4];
#pragma unroll
    for (int t = 0; t < 4; ++t) { yd[t] = (f32x4){0.f, 0.f, 0.f, 0.f}; yo[t] = (f32x4){0.f, 0.f, 0.f, 0.f}; }
    const int nks = (wave >> 1) + 1;
    for (int ks = 0; ks < nks; ++ks) { const bf16x8 mf = *(const LAS bf16x8*)(Mw + (16 * wave + (lane & 15)) * TP + 32 * ks + 8 * (lane >> 4));
#pragma unroll
        for (int t = 0; t < 4; ++t) { const bf16x8 xf = *(const LAS bf16x8*)(Xt + (16 * t + (lane & 15)) * TP + 32 * ks + 8 * (lane >> 4));
            yd[t] = __builtin_amdgcn_mfma_f32_16x16x32_bf16(mf, xf, yd[t], 0, 0, 0); } }
#pragma unroll
    for (int ks = 0; ks < 4; ++ks)
#pragma unroll
        for (int t = 0; t < 4; ++t) { const bf16x8 hf = *(const LAS bf16x8*)(Hp + (16 * t + (lane & 15)) * TP + 32 * ks + 8 * (lane >> 4));
            yo[t] = __builtin_amdgcn_mfma_f32_16x16x32_bf16(cf[ks], hf, yo[t], 0, 0, 0); }
    const float dsk = A->in[I_SSDD][l * H_C + h];
    bf16* OC = (bf16*)(ws + WS_OCAT) + OC_C; float* csq = (float*)(ws + WS_SMALL + SM_CSQ) + l * MP;
#pragma unroll
    for (int r = 0; r < 4; ++r) { const int i = 16 * wave + 4 * (lane >> 4) + r, row = row0 + i; const float ecs = __expf(cs[i]); float sq = 0.f;
#pragma unroll
        for (int t = 0; t < 4; ++t) { const int p = 16 * t + (lane & 15), ch = h * 64 + p;
            const float x = bf2f(Xt[p * TP + i]);
            const float y = yd[t][r] + ecs * yo[t][r] + dsk * x;
            const float z = bf2f(PROJ[(size_t)row * N_INP + PC_Z + ch]);
            const float yz = y * siluf_(z); sq += yz * yz;
            OC[(size_t)row * OCP + ch] = (bf16)f2bf(yz * A->in[I_GNORM][l * D_C + ch]); }
        sq += xor_lt32<1>(sq); sq += xor_lt32<2>(sq); sq += xor_lt32<4>(sq); sq += xor_lt32<8>(sq);
        if ((lane & 15) == 0 && acc) atomicAdd(csq + row, sq); }
    __syncthreads();
}

__device__ __forceinline__ void ssd_item_fused(KArgs A, unsigned char* ws, float* out, int l, int item, LAS unsigned char* lds, int tid, int wave, int lane, bool acc, unsigned* flags) {
    const int h = item & 15, c = (item >> 4) & 15, b = item >> 8, g = h >> 3, row0 = b * SEQ + c * SSDQ;
    const bf16* PROJ = (const bf16*)(ws + WS_BIG);
    LAS float* dtv = (LAS float*)(lds + SL_DT); LAS float* cs = (LAS float*)(lds + SL_CS);
    LAS bf16* Cn = (LAS bf16*)(lds + SL_CN); LAS bf16* Bn = (LAS bf16*)(lds + SL_BN); LAS bf16* Mw = (LAS bf16*)(lds + SL_MW);
    LAS bf16* Xt = (LAS bf16*)(lds + SL_XT); LAS bf16* Hp = (LAS bf16*)(lds + SL_HP);
    conv_tile<64, true>(A, PROJ, l, b, c, h * 64, Xt, nullptr, tid);
    conv_tile<128, false>(A, PROJ, l, b, c, D_C + g * N_C, Bn, nullptr, tid);
    conv_tile<128, true>(A, PROJ, l, b, c, D_C + g * N_C, Mw, nullptr, tid);
    conv_tile<128, false>(A, PROJ, l, b, c, D_C + G_C * N_C + g * N_C, Cn, nullptr, tid);
    bf16 zz[4][4];
#pragma unroll
    for (int r = 0; r < 4; ++r)
#pragma unroll
        for (int t = 0; t < 4; ++t) zz[r][t] = PROJ[(size_t)(row0 + 16 * wave + 4 * (lane >> 4) + r) * N_INP + PC_Z + h * 64 + 16 * t + (lane & 15)];
    ssd_dt_scan(A, ws, l, b, c, h, dtv, cs, tid, lane);
    {   f32x4 sacc[4];
#pragma unroll
        for (int t = 0; t < 4; ++t) sacc[t] = (f32x4){0.f, 0.f, 0.f, 0.f};
        const float cse = cs[127];
#pragma unroll
        for (int ks = 0; ks < 4; ++ks) { const int j0 = 32 * ks + 8 * (lane >> 4);
            const v4u braw = *(const LAS v4u*)(Mw + (16 * wave + (lane & 15)) * TP + j0);
            const f32x4 d0 = *(const LAS f32x4*)(dtv + j0), d1 = *(const LAS f32x4*)(dtv + j0 + 4), c0 = *(const LAS f32x4*)(cs + j0), c1 = *(const LAS f32x4*)(cs + j0 + 4);
            v4u bs;
            bs.x = pk2(bflo(braw.x) * d0.x * __expf(cse - c0.x), bfhi(braw.x) * d0.y * __expf(cse - c0.y)); bs.y = pk2(bflo(braw.y) * d0.z * __expf(cse - c0.z), bfhi(braw.y) * d0.w * __expf(cse - c0.w));
            bs.z = pk2(bflo(braw.z) * d1.x * __expf(cse - c1.x), bfhi(braw.z) * d1.y * __expf(cse - c1.y)); bs.w = pk2(bflo(braw.w) * d1.z * __expf(cse - c1.z), bfhi(braw.w) * d1.w * __expf(cse - c1.w));
            const bf16x8 bfr = __builtin_bit_cast(bf16x8, bs);
#pragma unroll
            for (int t = 0; t < 4; ++t) { const bf16x8 af = *(const LAS bf16x8*)(Xt + (16 * t + (lane & 15)) * TP + 32 * ks + 8 * (lane >> 4));
                sacc[t] = __builtin_amdgcn_mfma_f32_16x16x32_bf16(bfr, af, sacc[t], 0, 0, 0); } }
        {   const __amdgpu_buffer_rsrc_t srs = __builtin_amdgcn_make_buffer_rsrc((void*)((float*)(ws + WS_STATES) + (size_t)item * HD_C * N_C), (short)0, HD_C * N_C * 4, 0x00020000);
#pragma unroll
            for (int t = 0; t < 4; ++t) __builtin_amdgcn_raw_buffer_store_b128(__builtin_bit_cast(v4u, sacc[t]), srs, (unsigned)((16 * t + (lane & 15)) * N_C + 16 * wave + 4 * (lane >> 4)) * 4u, 0,   16); }
        if (tid == 0) __hip_atomic_store((float*)(ws + WS_SMALL + SM_SDEC) + item, __expf(cse), __ATOMIC_RELAXED, __HIP_MEMORY_SCOPE_AGENT);
        asm volatile("s_waitcnt vmcnt(0)" ::: "memory"); __syncthreads();
        if (tid == 0) __hip_atomic_store(flags + item, 1u, __ATOMIC_RELAXED, __HIP_MEMORY_SCOPE_AGENT);
    }
    bf16x8 cf[4];
#pragma unroll
    for (int ks = 0; ks < 4; ++ks) cf[ks] = *(const LAS bf16x8*)(Cn + (16 * wave + (lane & 15)) * TP + 32 * ks + 8 * (lane >> 4));
    const int jtmax = wave | 1;
    for (int jt = 0; jt <= jtmax; ++jt) {
        f32x4 gacc = {0.f, 0.f, 0.f, 0.f};
        if (jt <= wave) {
#pragma unroll
            for (int ks = 0; ks < 4; ++ks) { const bf16x8 bfr = *(const LAS bf16x8*)(Bn + (16 * jt + (lane & 15)) * TP + 32 * ks + 8 * (lane >> 4));
                gacc = __builtin_amdgcn_mfma_f32_16x16x32_bf16(cf[ks], bfr, gacc, 0, 0, 0); }
        }
        const int j = 16 * jt + (lane & 15); const float csj = cs[j], dtj = dtv[j];
#pragma unroll
        for (int r = 0; r < 4; ++r) { const int i = 16 * wave + 4 * (lane >> 4) + r;
            const float m = (j <= i) ? gacc[r] * __expf(cs[i] - csj) * dtj : 0.f;
            Mw[i * TP + j] = (bf16)f2bf(m); }
    }
    f32x4 yd[4], yo[4];
#pragma unroll
    for (int t = 0; t < 4; ++t) { yd[t] = (f32x4){0.f, 0.f, 0.f, 0.f}; yo[t] = (f32x4){0.f, 0.f, 0.f, 0.f}; }
    const int nks = (wave >> 1) + 1;
    for (int ks = 0; ks < nks; ++ks) { const bf16x8 mf = *(const LAS bf16x8*)(Mw + (16 * wave + (lane & 15)) * TP + 32 * ks + 8 * (lane >> 4));
#pragma unroll
        for (int t = 0; t < 4; ++t) { const bf16x8 xf = *(const LAS bf16x8*)(Xt + (16 * t + (lane & 15)) * TP + 32 * ks + 8 * (lane >> 4));
            yd[t] = __builtin_amdgcn_mfma_f32_16x16x32_bf16(mf, xf, yd[t], 0, 0, 0); } }
    if (tid < 64) {
        unsigned sp_ = 0;
        for (;;) { const unsigned f = lane < c ? __hip_atomic_load(flags + ((b * 16 + lane) * 16 + h), __ATOMIC_RELAXED, __HIP_MEMORY_SCOPE_AGENT) : 1u;
            if (__builtin_amdgcn_ballot_w64(f == 0u) == 0ull || ++sp_ > (1u << 20)) break; __builtin_amdgcn_s_sleep(1); }
        __builtin_amdgcn_fence(__ATOMIC_ACQUIRE, "agent"); asm volatile("s_waitcnt vmcnt(0)" ::: "memory"); }
    __syncthreads();
    {   const float* ST = (const float*)(ws + WS_STATES) + (size_t)((b * 16) * 16 + h) * HD_C * N_C + tid * 4;
        const float* SD = (const float*)(ws + WS_SMALL + SM_SDEC) + (b * 16) * 16 + h;
        f32x4 hv[4];
#pragma unroll
        for (int k = 0; k < 4; ++k) hv[k] = (f32x4){0.f, 0.f, 0.f, 0.f};
        for (int cc = 0; cc < c; cc += 4) { f32x4 sv[4][4]; float d[4];
#pragma unroll
            for (int q = 0; q < 4; ++q) { const int cq = cc + q < c ? cc + q : c - 1; d[q] = SD[cq * 16];
#pragma unroll
                for (int k = 0; k < 4; ++k) sv[q][k] = *(const GAS f32x4*)(ST + (size_t)cq * 16 * 8192 + 2048 * k); }
#pragma unroll
            for (int q = 0; q < 4; ++q) if (cc + q < c) {
#pragma unroll
                for (int k = 0; k < 4; ++k) hv[k] = hv[k] * d[q] + sv[q][k]; } }
#pragma unroll
        for (int k = 0; k < 4; ++k) { v2u wv; wv.x = pk2(hv[k].x, hv[k].y); wv.y = pk2(hv[k].z, hv[k].w); *(LAS v2u*)(Hp + ((tid >> 5) + 16 * k) * TP + (tid & 31) * 4) = wv; }
        if (c == SSDNC - 1) { const float d = SD[c * 16]; float* o = out + O_SSMP + (size_t)((l * NB + b) * H_C + h) * HD_C * N_C + tid * 4;
#pragma unroll
            for (int k = 0; k < 4; ++k) *(GAS f32x4*)(o + 2048 * k) = hv[k] * d + *(const GAS f32x4*)(ST + (size_t)c * 16 * 8192 + 2048 * k); }
    }
    __syncthreads();
#pragma unroll
    for (int ks = 0; ks < 4; ++ks)
#pragma unroll
        for (int t = 0; t < 4; ++t) { const bf16x8 hf = *(const LAS bf16x8*)(Hp + (16 * t + (lane & 15)) * TP + 32 * ks + 8 * (lane >> 4));
            yo[t] = __builtin_amdgcn_mfma_f32_16x16x32_bf16(cf[ks], hf, yo[t], 0, 0, 0); }
    const float dsk = A->in[I_SSDD][l * H_C + h];
    bf16* OC = (bf16*)(ws + WS_OCAT) + OC_C; float* csq = (float*)(ws + WS_SMALL + SM_CSQ) + l * MP;
#pragma unroll
    for (int r = 0; r < 4; ++r) { const int i = 16 * wave + 4 * (lane >> 4) + r, row = row0 + i; const float ecs = __expf(cs[i]); float sq = 0.f;
#pragma unroll
        for (int t = 0; t < 4; ++t) { const int p = 16 * t + (lane & 15), ch = h * 64 + p;
            const float x = bf2f(Xt[p * TP + i]);
            const float y = yd[t][r] + ecs * yo[t][r] + dsk * x;
            const float z = bf2f(zz[r][t]);
            const float yz = y * siluf_(z); sq += yz * yz;
            OC[(size_t)row * OCP + ch] = (bf16)f2bf(yz * A->in[I_GNORM][l * D_C + ch]); }
        sq += xor_lt32<1>(sq); sq += xor_lt32<2>(sq); sq += xor_lt32<4>(sq); sq += xor_lt32<8>(sq);
        if ((lane & 15) == 0 && acc) atomicAdd(csq + row, sq); }
    __syncthreads();
}
__device__ __forceinline__ void phase_upfix(const Frame& F0, KArgs A, int l) {
    Frame F = launder(F0);
    const float* HALO = WSP(const float, WS_HALO); bf16* ACT = WSP(bf16, WS_T);
    const float* cw = A->in[I_FCONVW] + (size_t)l * K_F * D_UP; const float* cb = A->in[I_FCONVB] + (size_t)l * D_UP;
    const int gt = blockIdx.x * NTHR + F.tid, NT = GRID * NTHR;
    for (int i = gt; i < 32 * D_FF; i += NT) { const int ch = i % D_FF, pm = i / D_FF; if ((pm & 7) == 0) continue;
        const int ca_ = 256 * (ch / 128) + ch % 128, cb_ = ca_ + 128;
        const float* hp = HALO + ((size_t)(pm - 1) * 4 + 2) * D_UP; const float* hc = HALO + (size_t)pm * 4 * D_UP;
        const float am2 = hp[ca_], am1 = hp[D_UP + ca_], a0 = hc[ca_], a1 = hc[D_UP + ca_], bm2 = hp[cb_], bm1 = hp[D_UP + cb_], b0 = hc[cb_], b1 = hc[D_UP + cb_];
        const float wa0 = cw[ch], wa1 = cw[D_UP + ch], wa2 = cw[2 * D_UP + ch], wb0 = cw[D_FF + ch], wb1 = cw[D_UP + D_FF + ch], wb2 = cw[2 * D_UP + D_FF + ch], ba = cb[ch], bb = cb[D_FF + ch];
        const float r0 = siluf_(ba + wa0 * am2 + wa1 * am1 + wa2 * a0) * (bb + wb0 * bm2 + wb1 * bm1 + wb2 * b0);
        const float r1 = siluf_(ba + wa0 * am1 + wa1 * a0 + wa2 * a1) * (bb + wb0 * bm1 + wb1 * b0 + wb2 * b1);
        ACT[(size_t)(pm * 256) * D_FF + ch] = (bf16)f2bf(r0); ACT[(size_t)(pm * 256 + 1) * D_FF + ch] = (bf16)f2bf(r1); }
    for (int i = gt; i < NB * 2 * D_UP; i += NT) { const int oc = i % D_UP, k = (i / D_UP) & 1, b = i / (2 * D_UP);
        const int c = oc < D_FF ? 256 * (oc / 128) + oc % 128 : 256 * ((oc - D_FF) / 128) + 128 + (oc - D_FF) % 128;
        F.out[O_CFP + (size_t)l * NB * 2 * D_UP + i] = HALO[((size_t)(8 * b + 7) * 4 + 2 + k) * D_UP + c]; }
}
__device__ __forceinline__ void ssd_conv_p_out(const Frame& F0, int l) {
    Frame F = launder(F0);
    const bf16* PROJ = WSP(const bf16, WS_BIG);
    const int gt = blockIdx.x * NTHR + F.tid, NT = GRID * NTHR;
    for (int i = gt; i < NB * 3 * D_XBC; i += NT) { const int ch = i % D_XBC, k = (i / D_XBC) % 3, b = i / (3 * D_XBC);
        F.out[O_CCP + (size_t)l * NB * 3 * D_XBC + i] = bf2f(PROJ[(size_t)(b * SEQ + SEQ - 3 + k) * N_INP + PC_XBC + ch]); }
}

__device__ __forceinline__ void phase_mix1(const Frame& F0, KArgs A, int l, bool acc) {
    {   Frame F = launder(F0);
        for (int it = F.gw; it < NS * G_A; it += (GRID * NWAVES)) s5_sample_item(A, F.ws, F.out, l, it, F.lane); }
    {   Frame F = launder(F0);
        for (int it = F.gw; it < NS; it += (GRID * NWAVES)) gmlp_sample_item(A, F.ws, F.out, l, it, F.lane); }
    {   Frame F = launder(F0);
        for (int it = F.gw; it < NS * H_C; it += (GRID * NWAVES)) ssd_sample_item(A, F.ws, F.out, l, it, F.lane, acc); }
    ssd_conv_p_out(F0, l);
}
__device__ __forceinline__ void phase_mix2(const Frame& F0, KArgs A, int l, bool acc) {
#ifndef REP_SSD2
#define REP_SSD2 1
#endif
#ifndef REP_GMLP
#define REP_GMLP 1
#endif
#ifndef REP_S5F
#define REP_S5F 1
#endif
    _Pragma("unroll 1") for (int r2 = 0; r2 < REP_SSD2; ++r2) {   Frame F = launder(F0);
        for (int it = blockIdx.x; it < NB * SSDNC * H_C; it += GRID) ssd_item_fused(A, F.ws, F.out, l, it, F.lds, F.tid, F.wave, F.lane, acc && r2 == 0, (unsigned*)(F.ws + WS_CTL) + CW_SSDF + l * 1024); }
    _Pragma("unroll 1") for (int r2 = 0; r2 < REP_GMLP; ++r2) {   Frame F = launder(F0);
        for (int it = blockIdx.x; it < NB * (SEQ / GMC) * H_B; it += GRID) gmlp_item(A, F.ws, l, it, F.lds, F.tid, F.wave, F.lane); }
    _Pragma("unroll 1") for (int r2 = 0; r2 < REP_S5F; ++r2) {   Frame F = launder(F0);
        for (int it = F.gw; it < NB * G_A * S5NC; it += (GRID * NWAVES)) s5_item_lin(A, F.ws, F.out, l, it, F.lds + F.wave * 10752, F.lane, (unsigned*)(F.ws + WS_CTL) + CW_S5F + l * 4096); }
}

constexpr int LDS_BYTES = 147456, MISC_OFF = 147456 - 256;
#ifndef GEMM_SP2
#define GEMM_SP2 true
#endif
template <class Epi>
__device__ __forceinline__ void run_gemm(const Frame& F, const bf16* Am, const bf16* Bt, int M, int N, int K, const Epi& E) {
    pg8::Gemm g{Am, Bt, M, N, K}; pg8::StaticOrder S; S.init(M, N, GRID, (int)blockIdx.x, K);
    pg8::gemm_phase<Epi, pg8::StaticOrder, true, GEMM_SP2>(F.lds, g, S, E);
}
struct SplitSched {
    pg8::StaticOrder P; int c, np, nsl, ntsl, ns, cbase, cu0, sid0;
    __device__ void init(int N, int K, int c_, int nsl_, int cbase_, int cu0_, int sid0_) { sid0 = sid0_; P.init(MPROMPT, N, GRID, c_, K); c = c_; np = (MPROMPT / 256) * (N / 256) / GRID; nsl = nsl_; ntsl = (K / 64) / nsl_; ns = (N / 256) * nsl_; cbase = cbase_; cu0 = cu0_; }
    __device__ bool next(int i, pg8::Unit& u) const {
        const int s = c - cu0; const bool has = s >= 0 && s < ns;
        if (!has || i > 0) return (i - (has ? 1 : 0)) < np ? P.next(i - (has ? 1 : 0), u) : false;
        u.pm = MPROMPT / 256; u.pn = s / nsl; u.k0 = (s % nsl) * ntsl * 64; u.nt = ntsl; u.cidx = cbase + u.pn; u.sid = sid0 + s; return true;
    }
    __device__ __forceinline__ void a_ready(const pg8::Unit&) const {}
    __device__ __forceinline__ void done(const pg8::Unit&) const {}
};
template <class Epi, bool CHAIN_IN>
__device__ __forceinline__ void run_gemm_chain(const Frame& F, const bf16* Am, const bf16* Bt, int K, const Epi& E, pg8::f32x4 (&acc)[2][2][4][2]) {
    pg8::Gemm g{Am, Bt, MPROMPT, DM, K}; pg8::StaticOrder S; S.init(MPROMPT, DM, GRID, (int)blockIdx.x, K);
    pg8::gemm_phase<Epi, pg8::StaticOrder, true, GEMM_SP2, CHAIN_IN>(F.lds, g, S, E, acc);
}
template <class Epi>
__device__ __forceinline__ void run_gemm_split(const Frame& F, const bf16* Am, const bf16* Bt, int N, int K, const Epi& E, int nsl, int cbase, int cu0, int sid0 = 0, int fin0 = -1, int parts = 1) {
    pg8::Gemm g{Am, Bt, MP, N, K}; SplitSched S; S.init(N, K, (int)blockIdx.x, nsl, cbase, cu0, sid0);
    pg8::gemm_phase<Epi, SplitSched, true, GEMM_SP2>(F.lds, g, S, E);
    if constexpr (!Epi::AFTER_DRAIN) {
        const int f = epi::opaque_bx() - fin0;
        if (fin0 >= 0 && f >= 0 && f < (N / 256) * parts) { int t2 = threadIdx.x; asm volatile("" : "+v"(t2)); const int lane = t2 & 63, wid = __builtin_amdgcn_readfirstlane(t2 >> 6);
            const pg8::Unit u = epi::final_unit(f / parts, cbase); E.final(u, wid >> 2, wid & 3, lane & 15, lane >> 4, wid, lane, epi::part_mask(f % parts, parts)); }
    }
}

#ifndef REP_PROLOGUE
#define REP_PROLOGUE 1
#endif
#ifndef REP_MOD
#define REP_MOD 1
#endif
#ifndef REP_PREP
#define REP_PREP 1
#endif
#ifndef REP_WIN
#define REP_WIN 1
#endif
#ifndef REP_MIX1
#define REP_MIX1 1
#endif
#ifndef REP_MIX2
#define REP_MIX2 1
#endif
#ifndef REP_GLU
#define REP_GLU 1
#endif
#ifndef REP_MERGE
#define REP_MERGE 1
#endif
#ifndef REP_OUT
#define REP_OUT 1
#endif
#ifndef REP_UP
#define REP_UP 1
#endif
#ifndef REP_CONV
#define REP_CONV 1
#endif
#ifndef REP_DOWN
#define REP_DOWN 1
#endif
#ifndef REP_BAR
#define REP_BAR 1
#endif
#define REP(n) _Pragma("unroll 1") for (int rep_ = 0; rep_ < (n); ++rep_)
__device__ __forceinline__ void grid_bar(const Frame& F0) {
    unsigned long long w = (unsigned long long)F0.ws; unsigned x = xb_xcc_id(); asm volatile("" : "+s"(w), "+s"(x));
    XcdBarrier b; b.bar = (unsigned*)((unsigned char*)w + WS_CTL) + CW_BAR; b.x = x; b.st = (volatile LAS unsigned*)(F0.lds + MISC_OFF) + 8;
    xcd_barrier(b);
}
__global__ void __launch_bounds__(NTHR, 2) mega_fwd(Args Aarg) {
    const KArgs A0 = (KArgs)__builtin_amdgcn_kernarg_segment_ptr(); (void)Aarg;
#define A launder_args(A0)
    extern __shared__ __attribute__((aligned(16))) unsigned char lds_raw[];
    Frame F;
    F.lds = (LAS unsigned char*)lds_raw;
    F.tid = threadIdx.x; F.lane = F.tid & 63; F.wave = __builtin_amdgcn_readfirstlane(F.tid >> 6);
    F.gw = blockIdx.x * NWAVES + F.wave;
    F.out = A0->out; F.ws = A0->ws;
    volatile LAS unsigned* MISC = (volatile LAS unsigned*)(F.lds + MISC_OFF);
    if (F.tid < 64) MISC[F.tid] = 0u;
    __syncthreads();
    (void)xcd_barrier_post((unsigned*)(F.ws + WS_CTL) + CW_BAR, MISC + 8);
#define GRID_BAR() do { REP(REP_BAR) grid_bar(F); } while (0)
#ifndef TIME_PHASE
#define TIME_PHASE -1
#endif
    unsigned long long tacc_ = 0ull, tbeg_ = 0ull;
#define TBEG(k) do { if (TIME_PHASE == (k)) tbeg_ = __builtin_amdgcn_s_memrealtime(); } while (0)
#define TEND(k) do { if (TIME_PHASE == (k)) tacc_ += __builtin_amdgcn_s_memrealtime() - tbeg_; } while (0)

#ifndef REP_MODS
#define REP_MODS 1
#endif
    TBEG(0); REP(REP_PROLOGUE) { TBEG(15); _Pragma("unroll 1") for (int rm = 0; rm < REP_MODS; ++rm) phase_mod(F, A);
    TEND(15);
    TBEG(17); phase_prologue(F, A); TEND(17);
    TBEG(16); mod_wait(F); prep_layer0(F, A); TEND(16);
    GRID_BAR(); } TEND(0);
#pragma unroll 1
    for (int l = 0; l < DEPTH; ++l) {
#define PH_FRAME() const Frame Fq = launder(F); unsigned char* const wsq = Fq.ws; unsigned char* const wl = wsq + WS_W + (size_t)l * WL_END; \
        const float* const modl = (const float*)(wsq + WS_MOD) + (size_t)l * N_MOD; pg8::f32x4* const slab = (pg8::f32x4*)(wsq + WS_SLAB); \
        unsigned* const cnt = (unsigned*)(wsq + WS_CTL) + CW_CNT; (void)wl; (void)modl; (void)slab; (void)cnt
#define WSQ(T, off) ((T*)(wsq + (off)))
        TBEG(2); REP(REP_WIN) { { PH_FRAME(); epi::EpiIn E{WSQ(bf16, WS_BIG), rep_ == 0 ? WSQ(float, WS_SMALL + SM_VSQ) + l * MP : nullptr, epi::SplitCtl{slab, cnt, 4u, 160, (l * 4 + 0) * 64, 2}};
            run_gemm_split(Fq, WSQ(const bf16, WS_H), (const bf16*)(wl + WL_IN), N_INP, DM, E, 4, (l * 4 + 0) * 64, 0, 0, 160, 2); }
        GRID_BAR(); } TEND(2);
        TBEG(3); REP(REP_MIX2) { phase_mix2(F, A, l, rep_ == 0); phase_mix1(F, A, l, rep_ == 0);
        GRID_BAR(); } TEND(3);
        TBEG(4); REP(REP_GLU) { { PH_FRAME(); epi::EpiGlu E{WSQ(const bf16, WS_YB), WSQ(bf16, WS_OCAT) + OC_A};
            run_gemm(Fq, WSQ(const bf16, WS_YB), (const bf16*)(wl + WL_GLU), MP, 512, 512, E); }
        GRID_BAR(); } TEND(4);
        TBEG(5);
        REP(REP_MERGE) {
            TBEG(10); TBEG(14);
            {   PH_FRAME(); bf16* BIG = WSQ(bf16, WS_BIG);
                epi::EpiMergeCat Em{BIG, WSQ(bf16, WS_MERGED), WSQ(const float, WS_SMALL + SM_CSQ) + l * MP, slab, cnt};
                run_gemm_split(Fq, WSQ(const bf16, WS_OCAT), (const bf16*)(wl + WL_PA), DM, OCP, Em, 4, (l * 4 + 1) * 64, 0, 0, 32, 4); }
            TEND(10);
            TEND(12); TEND(14); TBEG(13);
        GRID_BAR(); TEND(13); }
        TEND(5);
        TBEG(6);
        REP(REP_OUT) {
            if (l == 0) { PH_FRAME();
                epi::EpiResidPrep<0, true> E{epi::EpiResidT<true>{A->in[I_XP], A->in[I_XS], WSQ(bf16, WS_X1), modl + 2 * DM, epi::SplitCtl{slab, cnt, 4u, 32, (l * 4 + 2) * 64, 4}},
                    WSQ(bf16, WS_H), nullptr, nullptr, A->in[I_GFFN] + l * DM, modl, 3, 4, nullptr, WSQ(float, WS_SMALL + SM_DT), (unsigned*)(wsq + WS_CTL) + CW_PC + (l * 2 + 0) * 64};
                run_gemm_split(Fq, WSQ(const bf16, WS_MERGED), (const bf16*)(wl + WL_OUT), DM, DM, E, 4, (l * 4 + 2) * 64, 0);
            } else { PH_FRAME(); epi::EpiResidPrep<0> E{epi::EpiResid{WSQ(const bf16, WS_X0), WSQ(const bf16, WS_X0) + (size_t)MPROMPT * DM, WSQ(bf16, WS_X1), modl + 2 * DM, epi::SplitCtl{slab, cnt, 4u, 32, (l * 4 + 2) * 64, 4}},
                    WSQ(bf16, WS_H), nullptr, nullptr, A->in[I_GFFN] + l * DM, modl, 3, 4, nullptr, WSQ(float, WS_SMALL + SM_DT), (unsigned*)(wsq + WS_CTL) + CW_PC + (l * 2 + 0) * 64};
                run_gemm_split(Fq, WSQ(const bf16, WS_MERGED), (const bf16*)(wl + WL_OUT), DM, DM, E, 4, (l * 4 + 2) * 64, 0); }
        GRID_BAR(); }
        TEND(6);
        TBEG(7); REP(REP_UP) { { PH_FRAME(); epi::EpiUpConv E{WSQ(bf16, WS_T), WSQ(float, WS_HALO), A->in[I_FCONVW] + (size_t)l * K_F * D_UP, A->in[I_FCONVB] + (size_t)l * D_UP,
                A->in[I_FFNCONV] + (size_t)l * NS * 2 * D_UP, Fq.out + O_CFS + (size_t)l * NS * 2 * D_UP, (LAS float*)(Fq.lds + 131072), rep_ < REP_UP - 1 ? 1 : 0};
            run_gemm(Fq, WSQ(const bf16, WS_H), (const bf16*)(wl + WL_UP), MP, D_UP, DM, E); }
        GRID_BAR(); } TEND(7);
        TBEG(8); REP(REP_CONV) { phase_upfix(F, A, l);
        GRID_BAR(); } TEND(8);
        TBEG(9); REP(REP_DOWN) {
            if (l + 1 < DEPTH) { PH_FRAME(); const float* mod2 = (const float*)(wsq + WS_MOD) + (size_t)(l + 1) * N_MOD;
                epi::EpiResidPrep<1> E{epi::EpiResid{WSQ(const bf16, WS_X1), WSQ(const bf16, WS_X1) + (size_t)MPROMPT * DM, WSQ(bf16, WS_X0), modl + 5 * DM, epi::SplitCtl{slab, cnt, 11u, 88, (l * 4 + 3) * 64, 4}},
                    WSQ(bf16, WS_H), nullptr, nullptr, A->in[I_GMIX] + (l + 1) * DM, mod2, 0, 1, WSQ(const float, WS_SMALL + SM_WDT) + (size_t)(l + 1) * 16 * DM, WSQ(float, WS_SMALL + SM_DT), (unsigned*)(wsq + WS_CTL) + CW_PC + (l * 2 + 1) * 64};
                run_gemm_split(Fq, WSQ(const bf16, WS_T), (const bf16*)(wl + WL_DOWN), DM, D_FF, E, 11, (l * 4 + 3) * 64, 0);
            } else { PH_FRAME();
                epi::EpiResidPrep<2> E{epi::EpiResid{WSQ(const bf16, WS_X1), WSQ(const bf16, WS_X1) + (size_t)MPROMPT * DM, WSQ(bf16, WS_X0), modl + 5 * DM, epi::SplitCtl{slab, cnt, 11u, 88, (l * 4 + 3) * 64, 4}},
                    nullptr, Fq.out + O_YP, Fq.out + O_YS, A->in[I_GFINAL], modl, 0, 1, nullptr, WSQ(float, WS_SMALL + SM_DT), (unsigned*)(wsq + WS_CTL) + CW_PC + (l * 2 + 1) * 64};
                run_gemm_split(Fq, WSQ(const bf16, WS_T), (const bf16*)(wl + WL_DOWN), DM, D_FF, E, 11, (l * 4 + 3) * 64, 0); }
        if (l + 1 < DEPTH) GRID_BAR(); } TEND(9);
    }
    if (TIME_PHASE >= 0) {
        GRID_BAR();
#ifdef TIME_WG_LO
        if ((int)blockIdx.x < TIME_WG_LO || (int)blockIdx.x > TIME_WG_HI) tacc_ = 0ull; else tacc_ *= (unsigned long long)(256 / (TIME_WG_HI - TIME_WG_LO + 1));
#endif
        const float eps_ = sqrtf(5e-5f + 1e-6f * (float)tacc_ * 0.01f);
        for (int i = blockIdx.x * NTHR + F.tid; i < DEPTH * NS * D_B; i += GRID * NTHR) F.out[O_GVS + i] *= (1.0f + eps_);
    }
#undef A
}

extern "C" void kernel_launch(void* const* d_in, const int* in_sizes, int n_in, void* d_out, int out_size, void* d_ws, size_t ws_size, hipStream_t stream) {
    static int grid = 0;
    if (grid == 0) {
        if (n_in != N_INPUTS || (size_t)out_size != O_END || ws_size < WS_END) { fprintf(stderr, "kernel_launch: unexpected shapes (n_in %d, out %d, ws %zu, need %zu)\n", n_in, out_size, ws_size, (size_t)WS_END); grid = -1; return; }
        int dev = 0, cus = 0, per_cu = 0;
        if (hipGetDevice(&dev) != hipSuccess || hipDeviceGetAttribute(&cus, hipDeviceAttributeMultiprocessorCount, dev) != hipSuccess) { grid = -1; return; }
        if (hipFuncSetAttribute((const void*)mega_fwd, hipFuncAttributeMaxDynamicSharedMemorySize, LDS_BYTES) != hipSuccess) { fprintf(stderr, "kernel_launch: hipFuncSetAttribute failed\n"); grid = -1; return; }
        if (hipOccupancyMaxActiveBlocksPerMultiprocessor(&per_cu, (const void*)mega_fwd, NTHR, LDS_BYTES) != hipSuccess || per_cu < 1) { fprintf(stderr, "kernel_launch: occupancy query reports %d blocks per CU\n", per_cu); (void)hipGetLastError(); grid = -1; return; }
        if (cus * per_cu < GRID) { fprintf(stderr, "kernel_launch: %d CUs x %d blocks cannot hold the %d-workgroup grid\n", cus, per_cu, GRID); grid = -1; return; }
        grid = GRID;
    }
    if (grid < 0) return;
    if (hipMemsetAsync((char*)d_ws + WS_CTL, 0, CTL_ZERO_BYTES, stream) != hipSuccess) return;
    Args a{};
    for (int i = 0; i < N_INPUTS; ++i) a.in[i] = (const float*)d_in[i];
    a.out = (float*)d_out; a.ws = (unsigned char*)d_ws;
    void* params[] = {&a};
    hipError_t e = hipLaunchCooperativeKernel((const void*)mega_fwd, dim3(grid), dim3(NTHR), params, LDS_BYTES, stream);
    if (e != hipSuccess) fprintf(stderr, "kernel_launch: cooperative launch failed: %s (grid %d)\n", hipGetErrorString(e), grid);
}
```
